# Optimizing an MI355X kernel written in HIP

```python
import jax
import jax.numpy as jnp
from jax import lax
import numpy as np

D_MODEL = 1024
BATCH = 4
SEQ = 8192
DEPTH = 2

GRID_W = 64
CTX_LEN = 256
N_BRANCH = 4
BRANCH_W = 512
MLA_HEADS = 8
MLA_NOPE = 64
MLA_ROPE = 32
MLA_V = 64
MLA_QK = MLA_NOPE + MLA_ROPE
Q_LORA = 256
KV_LORA = 128
Q_BLOCK = 128
ROPE_BASE = 10000.0
NAT_HEADS = 8
NAT_DH = 64
NAT_KH = 8
NAT_KW = 16
HG_HEADS = 4
HG_DK = 128
HG_DV = 128
GLA_HEADS = 4
GLA_DK = 64
GLA_DV = 128
GLA_LOWRANK = 16
GLA_NORMALIZER = 16.0
CHUNK = 64
EPS = 1e-6

W_MLA = Q_LORA + KV_LORA + MLA_ROPE
W_NAT = 3 * NAT_HEADS * NAT_DH
W_HG = 3 * HG_HEADS * HG_DK + HG_HEADS * HG_DV
W_GLA = 2 * GLA_HEADS * GLA_DK + GLA_HEADS * GLA_DV + 2 * GLA_LOWRANK
SEGMENTS = (W_MLA, W_NAT, W_HG, W_GLA, BRANCH_W, BRANCH_W, BRANCH_W, BRANCH_W)
IN_W = W_MLA + W_NAT + W_HG + W_GLA + N_BRANCH * BRANCH_W

kernel_name = 'hybrid_diffusion_mla_nat_hgrn2_gla'


def rms_norm(x, g):
    xf = x.astype(jnp.float32)
    y = xf * lax.rsqrt(jnp.mean(xf * xf, axis=-1, keepdims=True) + EPS)
    return (y * g.astype(jnp.float32)).astype(x.dtype)


def split_cols(t, widths):
    out, start = [], 0
    for w in widths:
        out.append(t[..., start:start + w])
        start += w
    return out


def axial_rope(n_tok, dtype):
    quarter = MLA_ROPE // 4
    inv_freq = ROPE_BASE ** (-jnp.arange(quarter, dtype=jnp.float32) / quarter)
    t = jnp.arange(n_tok, dtype=jnp.int32)
    row = (t // GRID_W).astype(jnp.float32)
    col = (t % GRID_W).astype(jnp.float32)
    ang = jnp.concatenate([row[:, None] * inv_freq, col[:, None] * inv_freq], axis=-1)
    return jnp.cos(ang).astype(dtype), jnp.sin(ang).astype(dtype)


def apply_rope(x, cos, sin):
    x1, x2 = jnp.split(x, 2, axis=-1)
    cs, sn = cos[None, :, None, :], sin[None, :, None, :]
    return jnp.concatenate([x1 * cs - x2 * sn, x1 * sn + x2 * cs], axis=-1)


def softmax_attend(q, k, v, scale):
    s = jnp.einsum('bqhd,bkhd->bhqk', q, k).astype(jnp.float32) * scale
    p = jax.nn.softmax(s, axis=-1).astype(v.dtype)
    return jnp.einsum('bhqk,bkhd->bqhd', p, v)


def joint_attend(q_a, k_a, v_a, q_b, k_b, v_b, scale):
    s_a = jnp.einsum('bqhd,bkhd->bhqk', q_a, k_a).astype(jnp.float32)
    s_b = jnp.einsum('bqhd,bkhd->bhqk', q_b, k_b).astype(jnp.float32)
    p = jax.nn.softmax(jnp.concatenate([s_a, s_b], axis=-1) * scale, axis=-1).astype(v_a.dtype)
    n_a = k_a.shape[1]
    return (jnp.einsum('bhqk,bkhd->bqhd', p[..., :n_a], v_a)
            + jnp.einsum('bhqk,bkhd->bqhd', p[..., n_a:], v_b))


def blocked_joint_attend(q_a, q_b, k_a, v_a, k_b, v_b, scale):
    B, N, H, _ = q_a.shape

    def blocks(t):
        return t.reshape(B, N // Q_BLOCK, Q_BLOCK, H, t.shape[-1]).transpose(1, 0, 2, 3, 4)

    o = lax.map(lambda qs: joint_attend(qs[0], k_a, v_a, qs[1], k_b, v_b, scale), (blocks(q_a), blocks(q_b)))
    return o.transpose(1, 0, 2, 3, 4).reshape(B, N, H, v_a.shape[-1])


def mla_mixer(pl, pc, w_uq, w_ukv, g_cq, g_ckv, g_q, g_k, need_ctx):
    B, n = pl.shape[:2]

    def queries(c_q):
        q = (rms_norm(c_q, g_cq) @ w_uq).reshape(c_q.shape[0], c_q.shape[1], MLA_HEADS, MLA_QK)
        return rms_norm(q, g_q)

    def keys_values(c_kv, k_r):
        b, m = c_kv.shape[:2]
        kv = (rms_norm(c_kv, g_ckv) @ w_ukv).reshape(b, m, MLA_HEADS, MLA_NOPE + MLA_V)
        k_rope = jnp.broadcast_to(k_r[:, :, None, :], (b, m, MLA_HEADS, MLA_ROPE))
        k = jnp.concatenate([kv[..., :MLA_NOPE], k_rope], axis=-1)
        return rms_norm(k, g_k), kv[..., MLA_NOPE:]

    cq_l, ckv_l, kr_l = split_cols(pl, (Q_LORA, KV_LORA, MLA_ROPE))
    cq_c, ckv_c, kr_c = split_cols(pc, (Q_LORA, KV_LORA, MLA_ROPE))
    cos, sin = axial_rope(n, pl.dtype)

    def rotate(t):
        return jnp.concatenate([t[..., :MLA_NOPE], apply_rope(t[..., MLA_NOPE:], cos, sin)], axis=-1)

    q_plain = queries(cq_l)
    k_l, v_l = keys_values(ckv_l, kr_l)
    k_c, v_c = keys_values(ckv_c, kr_c)
    scale = MLA_QK ** -0.5
    o_l = blocked_joint_attend(rotate(q_plain), q_plain, rotate(k_l), v_l, k_c, v_c, scale)
    o_c = softmax_attend(queries(cq_c), k_c, v_c, scale).reshape(B, -1, BRANCH_W) if need_ctx else None
    return o_l.reshape(B, n, BRANCH_W), o_c


def nat_mixer(pl, pc, rpb, g_q, g_k, need_ctx):
    B, n = pl.shape[:2]
    rows = n // GRID_W
    kh, kw = min(NAT_KH, rows), min(NAT_KW, GRID_W)

    def heads(t, g=None):
        t = t.reshape(t.shape[0], t.shape[1], NAT_HEADS, NAT_DH)
        return t if g is None else rms_norm(t, g)

    q_l, k_l, v_l = split_cols(pl, (BRANCH_W,) * 3)
    q_c, k_c, v_c = split_cols(pc, (BRANCH_W,) * 3)
    k_c, v_c = heads(k_c, g_k), heads(v_c)
    grid = (B, rows, GRID_W, NAT_HEADS, NAT_DH)
    kg = heads(k_l, g_k).reshape(grid)
    vg = heads(v_l).reshape(grid)
    qg = heads(q_l, g_q).reshape(grid).transpose(1, 0, 2, 3, 4)
    scale = NAT_DH ** -0.5
    col = jnp.arange(GRID_W)
    c0 = jnp.clip(col - kw // 2, 0, GRID_W - kw)
    col_ok = (col[None, :] >= c0[:, None]) & (col[None, :] < c0[:, None] + kw)
    dc = jnp.clip(col[None, :] - col[:, None], -(NAT_KW - 1), NAT_KW - 1) + NAT_KW - 1

    def row_block(args):
        r, q_r = args
        r0 = jnp.clip(r - kh // 2, 0, rows - kh)
        k_r = lax.dynamic_slice_in_dim(kg, r0, kh, axis=1)
        v_r = lax.dynamic_slice_in_dim(vg, r0, kh, axis=1)
        s_win = jnp.einsum('bqhd,brkhd->bhqrk', q_r, k_r).astype(jnp.float32) * scale
        dr = r0 + jnp.arange(kh) - r + NAT_KH - 1
        bias = rpb[:, dr][:, :, dc].transpose(0, 2, 1, 3)
        s_win = jnp.where(col_ok[None, None, :, None, :], s_win + bias[None].astype(jnp.float32), -jnp.inf)
        s_ctx = jnp.einsum('bqhd,bkhd->bhqk', q_r, k_c).astype(jnp.float32) * scale
        s = jnp.concatenate([s_win.reshape(B, NAT_HEADS, GRID_W, kh * GRID_W), s_ctx], axis=-1)
        p = jax.nn.softmax(s, axis=-1).astype(v_r.dtype)
        p_win = p[..., :kh * GRID_W].reshape(B, NAT_HEADS, GRID_W, kh, GRID_W)
        return (jnp.einsum('bhqrk,brkhd->bqhd', p_win, v_r)
                + jnp.einsum('bhqk,bkhd->bqhd', p[..., kh * GRID_W:], v_c))

    og = lax.map(row_block, (jnp.arange(rows), qg))
    o_l = og.transpose(1, 0, 2, 3, 4).reshape(B, n, BRANCH_W)
    o_c = softmax_attend(heads(q_c, g_q), k_c, v_c, scale).reshape(B, -1, BRANCH_W) if need_ctx else None
    return o_l, o_c


def chunk_scan(q, k, v, log_a, s0):
    B, n, H, _ = k.shape
    dv = v.shape[-1]
    nc = n // CHUNK

    def chunks(t):
        return t.astype(jnp.float32).reshape(B, nc, CHUNK, H, t.shape[-1]).transpose(1, 0, 3, 2, 4)

    lower = jnp.tril(jnp.ones((CHUNK, CHUNK), dtype=bool))[:, :, None]

    def step(S, xs):
        kc, vc, ac = xs[:3]
        b = jnp.cumsum(ac, axis=2)
        b_end = b[:, :, -1:, :]
        S_new = (jnp.exp(b_end[:, :, 0, :])[..., None] * S
                 + jnp.einsum('bhjd,bhjv->bhdv', kc * jnp.exp(b_end - b), vc))
        if len(xs) == 3:
            return S_new, None
        qc = xs[3]
        rel = jnp.exp(jnp.where(lower, b[:, :, :, None, :] - b[:, :, None, :, :], -jnp.inf))
        scores = jnp.einsum('bhid,bhjd,bhijd->bhij', qc, kc, rel)
        o = jnp.einsum('bhij,bhjv->bhiv', scores, vc) + jnp.einsum('bhid,bhdv->bhiv', qc * jnp.exp(b), S)
        return S_new, o

    xs = (chunks(k), chunks(v), chunks(log_a))
    if q is None:
        S, _ = lax.scan(step, s0, xs)
        return None, S
    S, o = lax.scan(step, s0, xs + (chunks(q),))
    return o.transpose(1, 0, 3, 2, 4).reshape(B, n, H, dv).astype(v.dtype), S


def _dirn(t, d):
    if t is None or d == 0:
        return t
    return jnp.flip(t, axis=1)


def bidir_scan(lat, ctx, need_ctx):
    q_l, v_l, k_l, a_l = lat
    q_c, v_c, k_c, a_c = ctx
    B, _, H, dk = k_l[0].shape
    s0 = jnp.zeros((B, H, dk, v_l.shape[-1]), jnp.float32)
    o_lat, o_ctx = None, None
    for d in range(2):
        oc, s_ctx = chunk_scan(_dirn(q_c, d), _dirn(k_c[d], d), _dirn(v_c, d), _dirn(a_c[d], d), s0)
        ol, _ = chunk_scan(_dirn(q_l, d), _dirn(k_l[d], d), _dirn(v_l, d), _dirn(a_l[d], d), s_ctx)
        ol = _dirn(ol, d)
        o_lat = ol if o_lat is None else o_lat + ol
        if need_ctx:
            oc = _dirn(oc, d)
            o_ctx = oc if o_ctx is None else o_ctx + oc
    return o_lat, o_ctx


def hgrn2_mixer(pl, pc, lb, g_o, need_ctx):
    def feats(p, with_q):
        b, m = p.shape[:2]
        shp = (b, m, HG_HEADS, HG_DK)
        q, f_f, f_b, i = split_cols(p, (HG_HEADS * HG_DK,) * 3 + (HG_HEADS * HG_DV,))
        ks, las = [], []
        for d, f in enumerate((f_f, f_b)):
            f = f.astype(jnp.float32)
            lbd = lb[d]
            log_f = jnp.logaddexp(jnp.log(lbd), jnp.log1p(-lbd) + jax.nn.log_sigmoid(f))
            ks.append(((1.0 - lbd) * jax.nn.sigmoid(-f)).reshape(shp))
            las.append(log_f.reshape(shp))
        qq = (jax.nn.silu(q) * HG_DK ** -0.5).reshape(shp) if with_q else None
        return qq, i.reshape(b, m, HG_HEADS, HG_DV), ks, las

    o_l, o_c = bidir_scan(feats(pl, True), feats(pc, need_ctx), need_ctx)
    B, n = pl.shape[:2]
    o_l = rms_norm(o_l, g_o).reshape(B, n, BRANCH_W)
    if need_ctx:
        o_c = rms_norm(o_c, g_o).reshape(B, -1, BRANCH_W)
    return o_l, o_c


def gla_mixer(pl, pc, w2, b2, g_o, need_ctx):
    def feats(p, with_q):
        b, m = p.shape[:2]
        shp = (b, m, GLA_HEADS, GLA_DK)
        q, k, v, r_f, r_b = split_cols(p, (GLA_HEADS * GLA_DK,) * 2 + (GLA_HEADS * GLA_DV,) + (GLA_LOWRANK,) * 2)
        las = [(jax.nn.log_sigmoid((r @ w2[d] + b2[d]).astype(jnp.float32)) / GLA_NORMALIZER).reshape(shp)
               for d, r in enumerate((r_f, r_b))]
        k = k.reshape(shp)
        qq = (q * GLA_DK ** -0.5).reshape(shp) if with_q else None
        return qq, v.reshape(b, m, GLA_HEADS, GLA_DV), (k, k), las

    o_l, o_c = bidir_scan(feats(pl, True), feats(pc, need_ctx), need_ctx)
    B, n = pl.shape[:2]
    o_l = rms_norm(o_l, g_o).reshape(B, n, BRANCH_W)
    if need_ctx:
        o_c = rms_norm(o_c, g_o).reshape(B, -1, BRANCH_W)
    return o_l, o_c


def branch_merge(h, ys, zs, w_br, w_merge, b_merge, w_out):
    acc = None
    for br in range(N_BRANCH):
        gate = jax.nn.sigmoid(h @ w_merge[br] + b_merge[br])
        part = gate * ((ys[br] * jax.nn.silu(zs[br])) @ w_br[br])
        acc = part if acc is None else acc + part
    return acc @ w_out


def setup_inputs(seed: int = 0) -> dict:
    key = jax.random.key(seed)
    ks = iter(jax.random.split(key, 32))

    def nrm(shape, std):
        return jax.random.normal(next(ks), shape, jnp.float32) * std

    def gain(shape):
        return 1.0 + nrm(shape, 0.02)

    L, D = DEPTH, D_MODEL
    return {
        'x': nrm((BATCH, SEQ, D), 1.0),
        'c': nrm((BATCH, D), 1.0),
        'ctx': nrm((BATCH, CTX_LEN, D), 1.0),
        'c_ctx': nrm((D,), 1.0),
        'ada_w': nrm((L, D, 3 * D), 0.5 * D ** -0.5),
        'ada_b': nrm((L, 3 * D), 0.02),
        'norm_g': gain((L, D)),
        'w_in': nrm((L, D, IN_W), D ** -0.5),
        'mla_w_uq': nrm((L, Q_LORA, MLA_HEADS * MLA_QK), Q_LORA ** -0.5),
        'mla_w_ukv': nrm((L, KV_LORA, MLA_HEADS * (MLA_NOPE + MLA_V)), KV_LORA ** -0.5),
        'mla_g_cq': gain((L, Q_LORA)),
        'mla_g_ckv': gain((L, KV_LORA)),
        'mla_g_q': gain((L, MLA_QK)),
        'mla_g_k': gain((L, MLA_QK)),
        'nat_rpb': nrm((L, NAT_HEADS, 2 * NAT_KH - 1, 2 * NAT_KW - 1), 0.2),
        'nat_g_q': gain((L, NAT_DH)),
        'nat_g_k': gain((L, NAT_DH)),
        'hg_lb_logits': nrm((L, 2, HG_HEADS * HG_DK), 1.0),
        'hg_g_o': gain((L, HG_DV)),
        'gla_w2': nrm((L, 2, GLA_LOWRANK, GLA_HEADS * GLA_DK), GLA_LOWRANK ** -0.5),
        'gla_b2': nrm((L, 2, GLA_HEADS * GLA_DK), 0.1),
        'gla_g_o': gain((L, GLA_DV)),
        'w_br': nrm((L, N_BRANCH, BRANCH_W, D), BRANCH_W ** -0.5),
        'w_merge': nrm((L, N_BRANCH, D, D), D ** -0.5),
        'b_merge': nrm((L, N_BRANCH, D), 0.02),
        'w_out': nrm((L, D, D), D ** -0.5),
    }


def reference(x, c, ctx, c_ctx, ada_w, ada_b, norm_g, w_in, mla_w_uq, mla_w_ukv, mla_g_cq, mla_g_ckv, mla_g_q,
              mla_g_k, nat_rpb, nat_g_q, nat_g_k, hg_lb_logits, hg_g_o, gla_w2, gla_b2, gla_g_o, w_br, w_merge,
              b_merge, w_out):
    sm = jax.nn.softmax(hg_lb_logits.astype(jnp.float32), axis=0)
    lower_bounds = jnp.maximum(jnp.cumsum(sm, axis=0) - sm[0], 0.0)
    cx = ctx
    for l in range(DEPTH):
        need_ctx = l < DEPTH - 1
        sh, sc, gt = jnp.split(jax.nn.silu(c) @ ada_w[l] + ada_b[l], 3, axis=-1)
        sh_c, sc_c, gt_c = jnp.split(jax.nn.silu(c_ctx) @ ada_w[l] + ada_b[l], 3, axis=-1)
        h = rms_norm(x, norm_g[l]) * (1.0 + sc[:, None]) + sh[:, None]
        hc = rms_norm(cx, norm_g[l]) * (1.0 + sc_c) + sh_c
        seg_l = split_cols(h @ w_in[l], SEGMENTS)
        seg_c = split_cols(hc @ w_in[l], SEGMENTS)
        out_a = mla_mixer(seg_l[0], seg_c[0], mla_w_uq[l], mla_w_ukv[l], mla_g_cq[l], mla_g_ckv[l],
                          mla_g_q[l], mla_g_k[l], need_ctx)
        out_b = nat_mixer(seg_l[1], seg_c[1], nat_rpb[l], nat_g_q[l], nat_g_k[l], need_ctx)
        out_c = hgrn2_mixer(seg_l[2], seg_c[2], lower_bounds[l], hg_g_o[l], need_ctx)
        out_d = gla_mixer(seg_l[3], seg_c[3], gla_w2[l], gla_b2[l], gla_g_o[l], need_ctx)
        outs = (out_a, out_b, out_c, out_d)
        x = x + gt[:, None] * branch_merge(h, [o[0] for o in outs], seg_l[4:], w_br[l], w_merge[l],
                                           b_merge[l], w_out[l])
        if need_ctx:
            cx = cx + gt_c * branch_merge(hc, [o[1] for o in outs], seg_c[4:], w_br[l], w_merge[l],
                                          b_merge[l], w_out[l])
    return x
```

```cpp
#include <hip/hip_runtime.h>
#include <hip/hip_cooperative_groups.h>
#include <stdint.h>
#include <stdio.h>
namespace cg = cooperative_groups;

typedef unsigned short bf16_t;
typedef short bf16x8 __attribute__((ext_vector_type(8)));
typedef short bf16x4 __attribute__((ext_vector_type(4)));
typedef float f32x16 __attribute__((ext_vector_type(16)));

#ifndef SINGLE_LAUNCH
#define SINGLE_LAUNCH 0
#endif

constexpr int D = 1024, SEQ = 8192, CTXL = 256, TB = SEQ + CTXL  , NTH = 2 * TB  ;
constexpr int INW = 7104, PW = 7104;
constexpr int C_CQ = 0, C_CKV = 256, C_KR = 384, C_NQ = 416, C_NK = 928, C_NV = 1440, C_HQ = 1952, C_HF = 2464, C_HI = 3488,
              C_GQ = 4000, C_GK = 4256, C_GV = 4512, C_GR = 5024, C_Z = 5056;
constexpr float EPS = 1e-6f;
constexpr float LOG2E = 1.4426950408889634f;
constexpr int LDS_BYTES = 73728;
constexpr int NPHASE = 33;

constexpr size_t al256(size_t v) { return (v + 255) & ~(size_t)255; }
constexpr size_t OFF_CTL = 0;
constexpr size_t OFF_MOD = 4096;
constexpr size_t OFF_CX1 = al256(OFF_MOD + 2 * 5 * 3072 * 4);
constexpr size_t OFF_WIN = al256(OFF_CX1 + (size_t)4 * 256 * 1024 * 4);
constexpr size_t OFF_WM = al256(OFF_WIN + (size_t)2 * 7168 * 1024 * 2);
constexpr size_t OFF_WBR = al256(OFF_WM + (size_t)8 * 1024 * 1024 * 2);
constexpr size_t OFF_WO = al256(OFF_WBR + (size_t)8 * 1024 * 512 * 2);
constexpr size_t OFF_WUQ = al256(OFF_WO + (size_t)2 * 1024 * 1024 * 2);
constexpr size_t OFF_WUKV = al256(OFF_WUQ + (size_t)2 * 768 * 256 * 2);
constexpr size_t OFF_H = al256(OFF_WUKV + (size_t)2 * 1024 * 128 * 2);
constexpr size_t OFF_PB = al256(OFF_H + (size_t)NTH * 1024 * 2);
constexpr size_t OFF_QF = al256(OFF_PB + (size_t)NTH * PW * 2);
constexpr size_t OFF_KV = al256(OFF_QF + (size_t)NTH * 768 * 2);
constexpr size_t OFF_KF = al256(OFF_KV + (size_t)NTH * 1024 * 2);
constexpr size_t OFF_VTM = al256(OFF_KF + (size_t)NTH * 768 * 2);
constexpr size_t OFF_VTN = al256(OFF_VTM + (size_t)2 * 8 * 64 * TB * 2);
constexpr size_t OFF_OSG = al256(OFF_VTN + (size_t)2 * 8 * 64 * TB * 2);
constexpr size_t WS_END = al256(OFF_OSG + (size_t)2 * NTH * 512 * 2);

static_assert(WS_END <= (size_t)512 * 1024 * 1024, "workspace map exceeds 512 MiB");
struct Params {
    const float *x, *c, *ctx, *c_ctx, *ada_w, *ada_b, *norm_g, *w_in, *w_uq, *w_ukv, *g_cq, *g_ckv, *g_q, *g_k, *rpb, *ng_q, *ng_k,
        *lb_logits, *hg_g_o, *gla_w2, *gla_b2, *gla_g_o, *w_br, *w_merge, *b_merge, *w_out;
    float* out;
    unsigned char* ws;
    int ph_lo, ph_hi;
};

__device__ __forceinline__ float bf2f(bf16_t v) { return __uint_as_float(((unsigned)v) << 16); }
__device__ __forceinline__ unsigned cvt_pk(float lo, float hi) { unsigned r; asm("v_cvt_pk_bf16_f32 %0, %1, %2" : "=v"(r) : "v"(lo), "v"(hi)); return r; }
__device__ __forceinline__ bf16_t f2bf(float f) { return (bf16_t)(cvt_pk(f, 0.f) & 0xffffu); }
__device__ __forceinline__ float lo16(unsigned u) { return __uint_as_float(u << 16); }
__device__ __forceinline__ float hi16(unsigned u) { return __uint_as_float(u & 0xffff0000u); }
__device__ __forceinline__ float sigmoidf_(float x) { return 1.f / (1.f + __expf(-x)); }
__device__ __forceinline__ float siluf_(float x) { return x / (1.f + __expf(-x)); }
__device__ __forceinline__ float wave_sum(float v) {
#pragma unroll
    for (int o = 32; o > 0; o >>= 1) v += __shfl_xor(v, o);
    return v;
}
__device__ __forceinline__ void unpack8(uint4 u, float* f) {
    f[0] = lo16(u.x); f[1] = hi16(u.x); f[2] = lo16(u.y); f[3] = hi16(u.y); f[4] = lo16(u.z); f[5] = hi16(u.z); f[6] = lo16(u.w); f[7] = hi16(u.w);
}
__device__ __forceinline__ uint4 pack8(const float* f) { uint4 u; u.x = cvt_pk(f[0], f[1]); u.y = cvt_pk(f[2], f[3]); u.z = cvt_pk(f[4], f[5]); u.w = cvt_pk(f[6], f[7]); return u; }

__device__ __forceinline__ int tid_opaque() { int t = threadIdx.x; asm volatile("" : "+v"(t)); return t; }
__shared__ int s_item;
__device__ __forceinline__ int next_item(const Params& P, int ph) {
    __syncthreads();
    if (threadIdx.x == 0) s_item = atomicAdd((int*)(P.ws + OFF_CTL) + ph, 1);
    __syncthreads();
    return s_item;
}

constexpr int GS = 72;
__device__ __forceinline__ void gemm_tile(f32x16 (&acc)[2][2], const bf16_t* __restrict__ A, int lda, const bf16_t* __restrict__ Bt, int ldb, int K, unsigned char* smem) {
    const int tid = tid_opaque(), lane = tid & 63, wave = tid >> 6, wr = wave >> 1, wc = wave & 1;
    bf16_t* sA = (bf16_t*)smem;
    bf16_t* sB = sA + 2 * 128 * GS;
    const int lrow = tid >> 3, lch = (tid & 7) * 8;
    uint4 ra[4], rb[4];
    const bf16_t* Ap = A + (size_t)lrow * lda + lch;
    const bf16_t* Bp = Bt + (size_t)lrow * ldb + lch;
#pragma unroll
    for (int i = 0; i < 4; ++i) { ra[i] = *(const uint4*)(Ap + (size_t)(32 * i) * lda); rb[i] = *(const uint4*)(Bp + (size_t)(32 * i) * ldb); }
#pragma unroll
    for (int i = 0; i < 4; ++i) { *(uint4*)(sA + (lrow + 32 * i) * GS + lch) = ra[i]; *(uint4*)(sB + (lrow + 32 * i) * GS + lch) = rb[i]; }
    __syncthreads();
    const int nk = K >> 6;
    const int aoff = (wr * 64 + (lane & 31)) * GS + (lane >> 5) * 8, boff = (wc * 64 + (lane & 31)) * GS + (lane >> 5) * 8;
    for (int kt = 0; kt < nk; ++kt) {
        const bool more = kt + 1 < nk;
        if (more) {
#pragma unroll
            for (int i = 0; i < 4; ++i) { ra[i] = *(const uint4*)(Ap + (size_t)(32 * i) * lda + (kt + 1) * 64); rb[i] = *(const uint4*)(Bp + (size_t)(32 * i) * ldb + (kt + 1) * 64); }
        }
        const bf16_t* a = sA + (kt & 1) * 128 * GS + aoff;
        const bf16_t* b = sB + (kt & 1) * 128 * GS + boff;
#pragma unroll
        for (int ks = 0; ks < 4; ++ks) {
            bf16x8 a0 = *(const bf16x8*)(a + ks * 16), a1 = *(const bf16x8*)(a + 32 * GS + ks * 16);
            bf16x8 b0 = *(const bf16x8*)(b + ks * 16), b1 = *(const bf16x8*)(b + 32 * GS + ks * 16);
            acc[0][0] = __builtin_amdgcn_mfma_f32_32x32x16_bf16(a0, b0, acc[0][0], 0, 0, 0);
            acc[0][1] = __builtin_amdgcn_mfma_f32_32x32x16_bf16(a0, b1, acc[0][1], 0, 0, 0);
            acc[1][0] = __builtin_amdgcn_mfma_f32_32x32x16_bf16(a1, b0, acc[1][0], 0, 0, 0);
            acc[1][1] = __builtin_amdgcn_mfma_f32_32x32x16_bf16(a1, b1, acc[1][1], 0, 0, 0);
        }
        if (more) {
            bf16_t* wa = sA + ((kt + 1) & 1) * 128 * GS;
            bf16_t* wb = sB + ((kt + 1) & 1) * 128 * GS;
#pragma unroll
            for (int i = 0; i < 4; ++i) { *(uint4*)(wa + (lrow + 32 * i) * GS + lch) = ra[i]; *(uint4*)(wb + (lrow + 32 * i) * GS + lch) = rb[i]; }
        }
        __syncthreads();
    }
}
__device__ __forceinline__ void zero_acc(f32x16 (&acc)[2][2]) {
#pragma unroll
    for (int i = 0; i < 2; ++i)
#pragma unroll
        for (int j = 0; j < 2; ++j)
#pragma unroll
            for (int r = 0; r < 16; ++r) acc[i][j][r] = 0.f;
}
#define ACC_ROW(mi, r) (wr * 64 + (mi) * 32 + ((r) & 3) + 8 * ((r) >> 2) + 4 * (lane >> 5))
#define ACC_COL(ni) (wc * 64 + (ni) * 32 + (lane & 31))

__device__ void tr_tile(const float* __restrict__ src, int K, int N, int kt, int nt, bf16_t* __restrict__ dst, const float* __restrict__ scale, float* s) {
    const int tid = tid_opaque(), r = tid >> 4, c4 = (tid & 15) * 4;
#pragma unroll
    for (int i = 0; i < 4; ++i) {
        const int k = kt * 64 + r + 16 * i;
        float4 v = *(const float4*)(src + (size_t)k * N + nt * 64 + c4);
        const float sc = scale ? scale[k] : 1.f;
        float* d = s + (r + 16 * i) * 65 + c4;
        d[0] = v.x * sc; d[1] = v.y * sc; d[2] = v.z * sc; d[3] = v.w * sc;
    }
    __syncthreads();
    const int n = tid >> 2, k0 = (tid & 3) * 16;
    float f[16];
#pragma unroll
    for (int j = 0; j < 16; ++j) f[j] = s[(k0 + j) * 65 + n];
    bf16_t* o = dst + (size_t)(nt * 64 + n) * K + kt * 64 + k0;
    *(uint4*)o = pack8(f);
    *(uint4*)(o + 8) = pack8(f + 8);
    __syncthreads();
}
__device__ void phase_prologue(const Params& P, int ph, unsigned char* smem) {
    float* s = (float*)smem;
    const int NTR = 7296, NMOD = 96;
    for (;;) {
        const int u = next_item(P, ph);
        if (u >= NTR + NMOD) break;
        if (u < NMOD) {
            const int l = u / 48, cb = u % 48, tid = threadIdx.x, lane = tid & 63, wave = tid >> 6;
            float* sc = s;
            float* red = s + 5 * 1024;
            for (int i = tid; i < 5 * 1024; i += 256) { const int r = i >> 10, k = i & 1023; const float v = (r < 4) ? P.c[r * 1024 + k] : P.c_ctx[k]; sc[i] = siluf_(v); }
            __syncthreads();
            const int col = cb * 64 + lane;
            float acc[5] = {0.f, 0.f, 0.f, 0.f, 0.f};
            const float* w = P.ada_w + (size_t)l * 1024 * 3072 + col;
#pragma unroll 8
            for (int k = wave * 256; k < wave * 256 + 256; ++k) {
                const float wv = w[(size_t)k * 3072];
#pragma unroll
                for (int r = 0; r < 5; ++r) acc[r] += sc[r * 1024 + k] * wv;
            }
#pragma unroll
            for (int r = 0; r < 5; ++r) red[(wave * 5 + r) * 64 + lane] = acc[r];
            __syncthreads();
            if (wave == 0) {
                float* mod = (float*)(P.ws + OFF_MOD);
#pragma unroll
                for (int r = 0; r < 5; ++r) mod[(l * 5 + r) * 3072 + col] = red[r * 64 + lane] + red[(5 + r) * 64 + lane] + red[(10 + r) * 64 + lane] + red[(15 + r) * 64 + lane] + P.ada_b[l * 3072 + col];
            }
            continue;
        }
        const int v = u - NMOD, l = v / 3648, r = v % 3648;
        if (r < 1776) tr_tile(P.w_in + (size_t)l * 1024 * INW, 1024, INW, r / 111, r % 111, (bf16_t*)(P.ws + OFF_WIN) + (size_t)l * 7168 * 1024, nullptr, s);
        else if (r < 2800) { const int r2 = r - 1776, br = r2 >> 8, t = r2 & 255; tr_tile(P.w_merge + (size_t)(l * 4 + br) * 1024 * 1024, 1024, 1024, t >> 4, t & 15, (bf16_t*)(P.ws + OFF_WM) + (size_t)(l * 4 + br) * 1024 * 1024, nullptr, s); }
        else if (r < 3312) { const int r2 = r - 2800, br = r2 >> 7, t = r2 & 127; tr_tile(P.w_br + (size_t)(l * 4 + br) * 512 * 1024, 512, 1024, t >> 4, t & 15, (bf16_t*)(P.ws + OFF_WBR) + (size_t)(l * 4 + br) * 1024 * 512, nullptr, s); }
        else if (r < 3568) { const int t = r - 3312; tr_tile(P.w_out + (size_t)l * 1024 * 1024, 1024, 1024, t >> 4, t & 15, (bf16_t*)(P.ws + OFF_WO) + (size_t)l * 1024 * 1024, nullptr, s); }
        else if (r < 3616) { const int t = r - 3568; tr_tile(P.w_uq + (size_t)l * 256 * 768, 256, 768, t / 12, t % 12, (bf16_t*)(P.ws + OFF_WUQ) + (size_t)l * 768 * 256, P.g_cq + l * 256, s); }
        else { const int t = r - 3616; tr_tile(P.w_ukv + (size_t)l * 128 * 1024, 128, 1024, t >> 4, t & 15, (bf16_t*)(P.ws + OFF_WUKV) + (size_t)l * 1024 * 128, P.g_ckv + l * 128, s); }
    }
}

__device__ void phase_norm(const Params& P, int ph, int l, int hf) {
    const int tid = tid_opaque(), lane = tid & 63, wave = tid >> 6;
    const float* mod = (const float*)(P.ws + OFF_MOD);
    bf16_t* H = (bf16_t*)(P.ws + OFF_H);
    for (;;) {
        const int u = next_item(P, ph);
        if (u >= NTH / 32) break;
        for (int rr = 0; rr < 8; ++rr) {
            const int t = u * 32 + wave * 8 + rr, bl = t / TB, p = t % TB, b = hf * 2 + bl;
            const float* src; int mr;
            if (p < CTXL) { src = (l == 0 ? P.ctx : (const float*)(P.ws + OFF_CX1)) + ((size_t)b * CTXL + p) * D; mr = 4; }
            else { src = (l == 0 ? P.x : (const float*)P.out) + ((size_t)b * SEQ + (p - CTXL)) * D; mr = b; }
            float4 v[4]; float ss = 0.f;
#pragma unroll
            for (int i = 0; i < 4; ++i) { v[i] = *(const float4*)(src + lane * 4 + 256 * i); ss += v[i].x * v[i].x + v[i].y * v[i].y + v[i].z * v[i].z + v[i].w * v[i].w; }
            ss = wave_sum(ss);
            const float rstd = rsqrtf(ss * (1.f / D) + EPS);
            const float* sh = mod + (l * 5 + mr) * 3072; const float* sc = sh + 1024; const float* g = P.norm_g + l * D;
#pragma unroll
            for (int i = 0; i < 4; ++i) {
                const int c = lane * 4 + 256 * i;
                const float4 gv = *(const float4*)(g + c), s1 = *(const float4*)(sc + c), s0 = *(const float4*)(sh + c);
                uint2 o;
                o.x = cvt_pk(v[i].x * rstd * gv.x * (1.f + s1.x) + s0.x, v[i].y * rstd * gv.y * (1.f + s1.y) + s0.y);
                o.y = cvt_pk(v[i].z * rstd * gv.z * (1.f + s1.z) + s0.z, v[i].w * rstd * gv.w * (1.f + s1.w) + s0.w);
                *(uint2*)(H + (size_t)t * D + c) = o;
            }
        }
    }
}

__device__ void phase_gemm1(const Params& P, int ph, int l, unsigned char* smem) {
    const int tid_ = tid_opaque(), lane = tid_ & 63, wave = tid_ >> 6, wr = wave >> 1, wc = wave & 1;
    const bf16_t* H = (const bf16_t*)(P.ws + OFF_H);
    const bf16_t* W = (const bf16_t*)(P.ws + OFF_WIN) + (size_t)l * 7168 * 1024;
    bf16_t* PB = (bf16_t*)(P.ws + OFF_PB);
    for (;;) {
        const int u = next_item(P, ph);
        if (u >= 132 * 56) break;
        const int mt = u / 56, nt = u % 56;
        f32x16 acc[2][2]; zero_acc(acc);
        gemm_tile(acc, H + (size_t)mt * 128 * D, D, W + (size_t)nt * 128 * D, D, D, smem);
#pragma unroll
        for (int mi = 0; mi < 2; ++mi)
#pragma unroll
            for (int ni = 0; ni < 2; ++ni) {
                const int col = nt * 128 + ACC_COL(ni);
                if (col < PW) {
#pragma unroll
                    for (int r = 0; r < 16; ++r) PB[(size_t)(mt * 128 + ACC_ROW(mi, r)) * PW + col] = f2bf(acc[mi][ni][r]);
                }
            }
    }
}

__device__ void phase_gemm2(const Params& P, int ph, int l, unsigned char* smem) {
    const int tid_ = tid_opaque(), lane = tid_ & 63, wave = tid_ >> 6, wr = wave >> 1, wc = wave & 1;
    const bf16_t* PB = (const bf16_t*)(P.ws + OFF_PB);
    for (;;) {
        const int u = next_item(P, ph);
        if (u >= 132 * 14) break;
        const int mt = u / 14, n14 = u % 14;
        f32x16 acc[2][2]; zero_acc(acc);
        bf16_t* O; int ldo, nt;
        if (n14 < 6) { nt = n14; O = (bf16_t*)(P.ws + OFF_QF); ldo = 768;
            gemm_tile(acc, PB + (size_t)mt * 128 * PW + C_CQ, PW, (const bf16_t*)(P.ws + OFF_WUQ) + (size_t)l * 768 * 256 + (size_t)nt * 128 * 256, 256, 256, smem); }
        else { nt = n14 - 6; O = (bf16_t*)(P.ws + OFF_KV); ldo = 1024;
            gemm_tile(acc, PB + (size_t)mt * 128 * PW + C_CKV, PW, (const bf16_t*)(P.ws + OFF_WUKV) + (size_t)l * 1024 * 128 + (size_t)nt * 128 * 128, 128, 128, smem); }
#pragma unroll
        for (int mi = 0; mi < 2; ++mi)
#pragma unroll
            for (int ni = 0; ni < 2; ++ni)
#pragma unroll
                for (int r = 0; r < 16; ++r) O[(size_t)(mt * 128 + ACC_ROW(mi, r)) * ldo + nt * 128 + ACC_COL(ni)] = f2bf(acc[mi][ni][r]);
    }
}

__device__ void phase_finalize(const Params& P, int ph, int l, unsigned char* smem) {
    const int tid = tid_opaque(), lane = tid & 63, wave = tid >> 6;
    bf16_t* PB = (bf16_t*)(P.ws + OFF_PB);
    bf16_t* QF = (bf16_t*)(P.ws + OFF_QF);
    const bf16_t* KV = (const bf16_t*)(P.ws + OFF_KV);
    bf16_t* KF = (bf16_t*)(P.ws + OFF_KF);
    bf16_t* VTM = (bf16_t*)(P.ws + OFF_VTM);
    bf16_t* VTN = (bf16_t*)(P.ws + OFF_VTN);
    float* rs = (float*)smem;
    const int hd = lane >> 3, j = lane & 7;
    const float invf = __powf(10000.f, -(float)j * 0.125f);
    for (;;) {
        const int u = next_item(P, ph);
        if (u >= NTH / 32) break;
        const int t0 = u * 32, bl = t0 / TB, p0 = t0 % TB;
        for (int rr = 0; rr < 8; ++rr) {
            const int tl = wave * 8 + rr, t = t0 + tl, p = p0 + tl;
            bf16_t* prow = PB + (size_t)t * PW;
            float s1 = 0.f, s2 = 0.f;
            { const uint2 a = *(const uint2*)(prow + C_CQ + lane * 4); const float f0 = lo16(a.x), f1 = hi16(a.x), f2 = lo16(a.y), f3 = hi16(a.y); s1 = f0 * f0 + f1 * f1 + f2 * f2 + f3 * f3;
              const unsigned b = *(const unsigned*)(prow + C_CKV + lane * 2); const float g0 = lo16(b), g1 = hi16(b); s2 = g0 * g0 + g1 * g1; }
            s1 = wave_sum(s1); s2 = wave_sum(s2);
            const float rcq = rsqrtf(s1 * (1.f / 256.f) + EPS), rckv = rsqrtf(s2 * (1.f / 128.f) + EPS);
            if (lane == 0) rs[tl] = rckv;
            {
                bf16_t* q = QF + (size_t)t * 768 + hd * 96;
                float v[12], ss = 0.f;
#pragma unroll
                for (int m = 0; m < 12; ++m) { v[m] = bf2f(q[j + 8 * m]) * rcq; ss += v[m] * v[m]; }
                ss += __shfl_xor(ss, 1); ss += __shfl_xor(ss, 2); ss += __shfl_xor(ss, 4);
                const float rn = rsqrtf(ss * (1.f / 96.f) + EPS);
#pragma unroll
                for (int m = 0; m < 12; ++m) q[j + 8 * m] = f2bf(v[m] * rn * P.g_q[l * 96 + j + 8 * m]);
            }
            {
                const bf16_t* kvr = KV + (size_t)t * 1024 + hd * 128;
                float v[12], ss = 0.f;
#pragma unroll
                for (int m = 0; m < 8; ++m) { v[m] = bf2f(kvr[j + 8 * m]) * rckv; ss += v[m] * v[m]; }
#pragma unroll
                for (int m = 8; m < 12; ++m) { v[m] = bf2f(prow[C_KR + j + 8 * (m - 8)]); ss += v[m] * v[m]; }
                ss += __shfl_xor(ss, 1); ss += __shfl_xor(ss, 2); ss += __shfl_xor(ss, 4);
                const float rn = rsqrtf(ss * (1.f / 96.f) + EPS);
#pragma unroll
                for (int m = 0; m < 12; ++m) v[m] = v[m] * rn * P.g_k[l * 96 + j + 8 * m];
                if (p >= CTXL) {
                    const int pos = p - CTXL;
                    const float ar = (float)(pos >> 6) * invf, ac = (float)(pos & 63) * invf;
                    double fr = (double)ar * 0.15915494309189535; fr -= rint(fr);
                    double fc = (double)ac * 0.15915494309189535; fc -= rint(fc);
                    const float sr = __builtin_amdgcn_sinf((float)fr), cr = __builtin_amdgcn_cosf((float)fr);
                    const float sc = __builtin_amdgcn_sinf((float)fc), cc = __builtin_amdgcn_cosf((float)fc);
                    const float x1a = v[8], x2a = v[10], x1b = v[9], x2b = v[11];
                    v[8] = x1a * cr - x2a * sr; v[10] = x1a * sr + x2a * cr;
                    v[9] = x1b * cc - x2b * sc; v[11] = x1b * sc + x2b * cc;
                }
                bf16_t* ko = KF + ((size_t)t * 8 + hd) * 96;
#pragma unroll
                for (int m = 0; m < 12; ++m) ko[j + 8 * m] = f2bf(v[m]);
            }
#pragma unroll
            for (int w = 0; w < 2; ++w) {
                bf16_t* q = prow + (w ? C_NK : C_NQ) + hd * 64 + j * 8;
                const float* g = (w ? P.ng_k : P.ng_q) + l * 64 + j * 8;
                float v[8], ss = 0.f;
                unpack8(*(const uint4*)q, v);
#pragma unroll
                for (int m = 0; m < 8; ++m) ss += v[m] * v[m];
                ss += __shfl_xor(ss, 1); ss += __shfl_xor(ss, 2); ss += __shfl_xor(ss, 4);
                const float rn = rsqrtf(ss * (1.f / 64.f) + EPS);
#pragma unroll
                for (int m = 0; m < 8; ++m) v[m] = v[m] * rn * g[m];
                *(uint4*)q = pack8(v);
            }
        }
        __syncthreads();
#pragma unroll
        for (int cc = 0; cc < 2; ++cc) {
            const int c = tid + 256 * cc, h2 = c >> 6, dv = c & 63;
#pragma unroll
            for (int grp = 0; grp < 4; ++grp) {
                float fm[8], fn[8];
#pragma unroll
                for (int i = 0; i < 8; ++i) {
                    const int tl = grp * 8 + i;
                    fm[i] = bf2f(KV[(size_t)(t0 + tl) * 1024 + h2 * 128 + 64 + dv]) * rs[tl];
                    fn[i] = bf2f(PB[(size_t)(t0 + tl) * PW + C_NV + c]);
                }
                const size_t o = ((size_t)(bl * 8 + h2) * 64 + dv) * TB + p0 + grp * 8;
                *(uint4*)(VTM + o) = pack8(fm);
                *(uint4*)(VTN + o) = pack8(fn);
            }
        }
    }
}

template <int DQK, bool NAT>
__device__ void attn_item(const Params& P, int l, int bl, int head, int qb, unsigned char* smem) {
    constexpr int NKS = DQK / 16, KSTR = DQK + 8, VSTR = 68, KCH = DQK / 8, KLD = (DQK * 64 / 8) / 256;
    const int tid = tid_opaque(), lane = tid & 63, wave = tid >> 6, hh = lane >> 5, r32 = lane & 31;
    bf16_t* Ks = (bf16_t*)smem;
    bf16_t* Vs = Ks + 2 * 64 * KSTR;
    float* rpb_s = (float*)(Vs + 2 * 64 * VSTR);
    bf16_t* PB = (bf16_t*)(P.ws + OFF_PB);
    const int rowbase = bl * TB, q_p0 = qb * 128, ql = wave * 32 + r32;
    const bool q_ctx = qb < 2;
    int lt0 = 0, lt1 = 0;
    int qr = 0, qc = 0, r0w = 0, c0 = 0;
    if (!q_ctx) {
        if (NAT) { const int rp = qb - 2, ra = 2 * rp, rb = ra + 1; lt0 = min(max(ra - 4, 0), 120); lt1 = min(max(rb - 4, 0), 120) + 8;
            qr = ra + (wave >> 1); qc = (wave & 1) * 32 + r32; r0w = min(max(qr - 4, 0), 120); c0 = min(max(qc - 8, 0), 48); }
        else { lt0 = 0; lt1 = 128; }
    }
    const int ntiles = 4 + (lt1 - lt0);
    const bf16_t* Kbase; const bf16_t* VT; const bf16_t* qptr; int k_ld;
    if (NAT) { Kbase = PB + (size_t)rowbase * PW + C_NK + head * 64; k_ld = PW; VT = (const bf16_t*)(P.ws + OFF_VTN) + (size_t)(bl * 8 + head) * 64 * TB;
        qptr = PB + (size_t)(rowbase + q_p0 + ql) * PW + C_NQ + head * 64; }
    else { Kbase = (const bf16_t*)(P.ws + OFF_KF) + (size_t)rowbase * 768 + head * 96; k_ld = 768; VT = (const bf16_t*)(P.ws + OFF_VTM) + (size_t)(bl * 8 + head) * 64 * TB;
        qptr = (const bf16_t*)(P.ws + OFF_QF) + (size_t)(rowbase + q_p0 + ql) * 768 + head * 96; }
    if (NAT) { for (int i = tid; i < 465; i += 256) rpb_s[i] = P.rpb[(size_t)(l * 8 + head) * 465 + i] * LOG2E; }
    bf16x8 qf[NKS];
#pragma unroll
    for (int ks = 0; ks < NKS; ++ks) qf[ks] = *(const bf16x8*)(qptr + ks * 16 + hh * 8);
    bf16x8 qrot4 = qf[NKS - 2], qrot5 = qf[NKS - 1];
    if (!NAT && !q_ctx) {
        const int pos = q_p0 - CTXL + ql;
        const float base = hh ? (float)(pos & 63) : (float)(pos >> 6);
#pragma unroll
        for (int jj = 0; jj < 8; ++jj) {
            const float invf = __powf(10000.f, -(float)jj * 0.125f);
            const float ang = base * invf;
            double fr = (double)ang * 0.15915494309189535; fr -= rint(fr);
            const float sn = __builtin_amdgcn_sinf((float)fr), cs = __builtin_amdgcn_cosf((float)fr);
            const float x1 = bf2f((bf16_t)qf[4][jj]), x2 = bf2f((bf16_t)qf[5][jj]);
            qrot4[jj] = (short)f2bf(x1 * cs - x2 * sn);
            qrot5[jj] = (short)f2bf(x1 * sn + x2 * cs);
        }
    }
    const float sc2 = (NAT ? 0.125f : 0.10206207261596575f) * LOG2E;
    float m_run = -1e30f, lsum = 0.f;
    f32x16 oacc[2];
#pragma unroll
    for (int r = 0; r < 16; ++r) { oacc[0][r] = 0.f; oacc[1][r] = 0.f; }
    uint4 kreg0, kreg1, kreg2, vreg0, vreg1;
    kreg2 = make_uint4(0, 0, 0, 0);
    const int kid0 = tid, kid1 = tid + 256, kid2 = tid + 512;
    const int krow0 = kid0 / KCH, kch0 = kid0 % KCH, krow1 = kid1 / KCH, kch1 = kid1 % KCH, krow2 = kid2 / KCH, kch2 = kid2 % KCH;
    const int vrow0 = tid >> 3, vch = tid & 7, vrow1 = vrow0 + 32;
#define TILE_P(ti) ((ti) < 4 ? (ti) * 64 : CTXL + (lt0 + (ti) - 4) * 64)
#define GLOAD(ti) { const int p_ = TILE_P(ti); \
        kreg0 = *(const uint4*)(Kbase + (size_t)(p_ + krow0) * k_ld + kch0 * 8); \
        kreg1 = *(const uint4*)(Kbase + (size_t)(p_ + krow1) * k_ld + kch1 * 8); \
        if (KLD > 2) kreg2 = *(const uint4*)(Kbase + (size_t)(p_ + krow2) * k_ld + kch2 * 8); \
        vreg0 = *(const uint4*)(VT + (size_t)vrow0 * TB + p_ + vch * 8); \
        vreg1 = *(const uint4*)(VT + (size_t)vrow1 * TB + p_ + vch * 8); }
#define SWRITE(buf_) { bf16_t* kd_ = Ks + (buf_) * 64 * KSTR; \
        *(uint4*)(kd_ + krow0 * KSTR + kch0 * 8) = kreg0; *(uint4*)(kd_ + krow1 * KSTR + kch1 * 8) = kreg1; \
        if (KLD > 2) *(uint4*)(kd_ + krow2 * KSTR + kch2 * 8) = kreg2; \
        bf16_t* vd_ = Vs + (buf_) * 64 * VSTR + vch * 8; \
        *(uint2*)(vd_ + vrow0 * VSTR) = make_uint2(vreg0.x, vreg0.y); *(uint2*)(vd_ + vrow0 * VSTR + 4) = make_uint2(vreg0.z, vreg0.w); \
        *(uint2*)(vd_ + vrow1 * VSTR) = make_uint2(vreg1.x, vreg1.y); *(uint2*)(vd_ + vrow1 * VSTR + 4) = make_uint2(vreg1.z, vreg1.w); }
    GLOAD(0); SWRITE(0);
    __syncthreads();
    for (int ti = 0; ti < ntiles; ++ti) {
        const int buf = ti & 1;
        const bool more = ti + 1 < ntiles;
        if (more) GLOAD(ti + 1);
        if (!NAT && ti == 4) { qf[NKS - 2] = qrot4; qf[NKS - 1] = qrot5; }
        const int kr = lt0 + ti - 4;
        const bool active = !NAT || ti < 4 || (kr >= r0w && kr < r0w + 8);
        if (active) {
            const bf16_t* kb = Ks + buf * 64 * KSTR + r32 * KSTR + hh * 8;
            f32x16 st0, st1;
#pragma unroll
            for (int r = 0; r < 16; ++r) { st0[r] = 0.f; st1[r] = 0.f; }
#pragma unroll
            for (int ks = 0; ks < NKS; ++ks) {
                const bf16x8 k0 = *(const bf16x8*)(kb + ks * 16), k1 = *(const bf16x8*)(kb + 32 * KSTR + ks * 16);
                st0 = __builtin_amdgcn_mfma_f32_32x32x16_bf16(k0, qf[ks], st0, 0, 0, 0);
                st1 = __builtin_amdgcn_mfma_f32_32x32x16_bf16(k1, qf[ks], st1, 0, 0, 0);
            }
            float x[32];
#pragma unroll
            for (int r = 0; r < 16; ++r) { x[r] = st0[r] * sc2; x[16 + r] = st1[r] * sc2; }
            if (NAT && ti >= 4) {
                const int dr = kr - qr + 7;
#pragma unroll
                for (int e = 0; e < 32; ++e) {
                    const int r = e & 15, kc = (e >> 4) * 32 + (r & 3) + 8 * (r >> 2) + 4 * hh;
                    const int dc = min(max(kc - qc, -15), 15) + 15;
                    const bool ok = (kc >= c0) && (kc < c0 + 16);
                    x[e] = ok ? x[e] + rpb_s[dr * 31 + dc] : -1e30f;
                }
            }
            float mx = x[0];
#pragma unroll
            for (int e = 1; e < 32; ++e) mx = fmaxf(mx, x[e]);
            mx = fmaxf(mx, __shfl_xor(mx, 32));
            const float m_new = fmaxf(m_run, mx);
            const float alpha = __builtin_amdgcn_exp2f(m_run - m_new);
            m_run = m_new;
            float ps = 0.f;
#pragma unroll
            for (int e = 0; e < 32; ++e) { x[e] = __builtin_amdgcn_exp2f(x[e] - m_new); ps += x[e]; }
            lsum = lsum * alpha + ps;
#pragma unroll
            for (int r = 0; r < 16; ++r) { oacc[0][r] *= alpha; oacc[1][r] *= alpha; }
            bf16x8 pf[2][2];
#pragma unroll
            for (int t = 0; t < 2; ++t)
#pragma unroll
                for (int s = 0; s < 2; ++s) {
                    union { bf16x8 v; unsigned u[4]; } cv;
#pragma unroll
                    for (int q = 0; q < 4; ++q) cv.u[q] = cvt_pk(x[16 * t + 8 * s + 2 * q], x[16 * t + 8 * s + 2 * q + 1]);
                    pf[t][s] = cv.v;
                }
            const bf16_t* vb = Vs + buf * 64 * VSTR + r32 * VSTR + 4 * hh;
#pragma unroll
            for (int uu = 0; uu < 2; ++uu)
#pragma unroll
                for (int t = 0; t < 2; ++t)
#pragma unroll
                    for (int s = 0; s < 2; ++s) {
                        const bf16_t* a = vb + uu * 32 * VSTR + t * 32 + s * 16;
                        union { bf16x8 v; uint2 h[2]; } cv;
                        cv.h[0] = *(const uint2*)a; cv.h[1] = *(const uint2*)(a + 8);
                        oacc[uu] = __builtin_amdgcn_mfma_f32_32x32x16_bf16(cv.v, pf[t][s], oacc[uu], 0, 0, 0);
                    }
        }
        if (more) SWRITE((ti + 1) & 1);
        __syncthreads();
    }
#undef TILE_P
#undef GLOAD
#undef SWRITE
    lsum += __shfl_xor(lsum, 32);
    const float inv = 1.f / lsum;
    bf16_t* zrow = PB + (size_t)(rowbase + q_p0 + ql) * PW + C_Z + (NAT ? 512 : 0) + head * 64;
#pragma unroll
    for (int uu = 0; uu < 2; ++uu)
#pragma unroll
        for (int g = 0; g < 4; ++g) {
            bf16_t* zp = zrow + uu * 32 + 8 * g + 4 * hh;
            const uint2 z = *(const uint2*)zp;
            uint2 o;
            o.x = cvt_pk(oacc[uu][4 * g + 0] * inv * siluf_(lo16(z.x)), oacc[uu][4 * g + 1] * inv * siluf_(hi16(z.x)));
            o.y = cvt_pk(oacc[uu][4 * g + 2] * inv * siluf_(lo16(z.y)), oacc[uu][4 * g + 3] * inv * siluf_(hi16(z.y)));
            *(uint2*)zp = o;
        }
}

__device__ void scan_hg_item(const Params& P, int l, int item, unsigned char* smem) {
    const int tid = tid_opaque(), lane = tid & 63, wave = tid >> 6;
    const int slice = item & 7, dir = (item >> 3) & 1, head = (item >> 4) & 3, bl = item >> 6;
    float* a_s = (float*)smem;
    float* q_s = a_s + 64 * 128;
    float* v_s = q_s + 64 * 128;
    float* o_s = v_s + 64 * 16;
    const bf16_t* PB = (const bf16_t*)(P.ws + OFF_PB) + (size_t)bl * TB * PW;
    bf16_t* OS = (bf16_t*)(P.ws + OFF_KV) + ((size_t)dir * NTH + (size_t)bl * TB) * 512 + head * 128 + slice * 16;
    const int prow = tid >> 4, pd = (tid & 15) * 8;
    float lb[8];
#pragma unroll
    for (int e = 0; e < 8; ++e) {
        const int cidx = dir * 512 + head * 128 + pd + e;
        lb[e] = (l == 0) ? 0.f : sigmoidf_(P.lb_logits[1024 + cidx] - P.lb_logits[cidx]);
    }
    const int fcol = (dir ? C_HF + 512 : C_HF) + head * 128 + pd, qcol = C_HQ + head * 128 + pd, vcol = C_HI + head * 128 + slice * 16 + (tid & 1) * 8;
    uint4 rq[4], rf[4], rv;
    auto chunk_p = [&](int c) { const int ci = dir ? (c < 4 ? 3 - c : 135 - c) : c; return ci * 64; };
    auto gload = [&](int c) {
        const int p = chunk_p(c);
#pragma unroll
        for (int r = 0; r < 4; ++r) { const bf16_t* row = PB + (size_t)(p + prow + 16 * r) * PW; rq[r] = *(const uint4*)(row + qcol); rf[r] = *(const uint4*)(row + fcol); }
        if (tid < 128) rv = *(const uint4*)(PB + (size_t)(p + (tid >> 1)) * PW + vcol);
    };
    const int dg = lane & 15, col = wave * 4 + (lane >> 4);
    float S[8];
#pragma unroll
    for (int e = 0; e < 8; ++e) S[e] = 0.f;
    gload(0);
    for (int c = 0; c < 132; ++c) {
        __syncthreads();
#pragma unroll
        for (int r = 0; r < 4; ++r) {
            float fq[8], ff[8];
            unpack8(rq[r], fq); unpack8(rf[r], ff);
            float* ad = a_s + (prow + 16 * r) * 128 + pd; float* qd = q_s + (prow + 16 * r) * 128 + pd;
#pragma unroll
            for (int e = 0; e < 8; ++e) { ad[e] = lb[e] + (1.f - lb[e]) * sigmoidf_(ff[e]); qd[e] = siluf_(fq[e]) * 0.08838834764831845f; }
        }
        if (tid < 128) { float fv[8]; unpack8(rv, fv); float* vd = v_s + (tid >> 1) * 16 + (tid & 1) * 8;
#pragma unroll
            for (int e = 0; e < 8; ++e) vd[e] = fv[e]; }
        __syncthreads();
        if (c + 1 < 132) gload(c + 1);
        for (int tt = 0; tt < 64; ++tt) {
            const int i = dir ? 63 - tt : tt;
            const float4 a0 = *(const float4*)(a_s + i * 128 + dg * 8), a1 = *(const float4*)(a_s + i * 128 + dg * 8 + 4);
            const float4 q0 = *(const float4*)(q_s + i * 128 + dg * 8), q1 = *(const float4*)(q_s + i * 128 + dg * 8 + 4);
            const float v = v_s[i * 16 + col];
            float op;
            S[0] = fmaf(a0.x, S[0] - v, v); op = q0.x * S[0];
            S[1] = fmaf(a0.y, S[1] - v, v); op = fmaf(q0.y, S[1], op);
            S[2] = fmaf(a0.z, S[2] - v, v); op = fmaf(q0.z, S[2], op);
            S[3] = fmaf(a0.w, S[3] - v, v); op = fmaf(q0.w, S[3], op);
            S[4] = fmaf(a1.x, S[4] - v, v); op = fmaf(q1.x, S[4], op);
            S[5] = fmaf(a1.y, S[5] - v, v); op = fmaf(q1.y, S[5], op);
            S[6] = fmaf(a1.z, S[6] - v, v); op = fmaf(q1.z, S[6], op);
            S[7] = fmaf(a1.w, S[7] - v, v); op = fmaf(q1.w, S[7], op);
            op += __shfl_xor(op, 1); op += __shfl_xor(op, 2); op += __shfl_xor(op, 4); op += __shfl_xor(op, 8);
            if (dg == 0) o_s[i * 16 + col] = op;
        }
        __syncthreads();
        if (tid < 128) {
            const int p = chunk_p(c) + (tid >> 1);
            *(uint4*)(OS + (size_t)p * 512 + (tid & 1) * 8) = pack8(o_s + (tid >> 1) * 16 + (tid & 1) * 8);
        }
    }
}

__device__ void scan_gla_item(const Params& P, int l, int item, unsigned char* smem) {
    const int tid = tid_opaque(), lane = tid & 63, wave = tid >> 6;
    const int slice = item & 3, dir = (item >> 2) & 1, head = (item >> 3) & 3, bl = item >> 5;
    float* a_s = (float*)smem;
    float* q_s = a_s + 64 * 64;
    float* k_s = q_s + 64 * 64;
    float* v_s = k_s + 64 * 64;
    float* o_s = v_s + 64 * 32;
    float* r_s = o_s + 64 * 32;
    const bf16_t* PB = (const bf16_t*)(P.ws + OFF_PB) + (size_t)bl * TB * PW;
    bf16_t* OS = (bf16_t*)(P.ws + OFF_OSG) + ((size_t)dir * NTH + (size_t)bl * TB) * 512 + head * 128 + slice * 32;
    const int gd = tid & 63, gt0 = tid >> 6;
    float w2[16];
#pragma unroll
    for (int jx = 0; jx < 16; ++jx) w2[jx] = P.gla_w2[((size_t)(l * 2 + dir) * 16 + jx) * 256 + head * 64 + gd];
    const float b2 = P.gla_b2[(l * 2 + dir) * 256 + head * 64 + gd];
    uint4 rq[2], rk[2], rv, rr;
    auto chunk_p = [&](int c) { const int ci = dir ? (c < 4 ? 3 - c : 135 - c) : c; return ci * 64; };
    auto gload = [&](int c) {
        const int p = chunk_p(c);
#pragma unroll
        for (int i = 0; i < 2; ++i) { const int id = tid + 256 * i, row = id >> 3, ch = id & 7; const bf16_t* rp = PB + (size_t)(p + row) * PW;
            rq[i] = *(const uint4*)(rp + C_GQ + head * 64 + ch * 8); rk[i] = *(const uint4*)(rp + C_GK + head * 64 + ch * 8); }
        { const int row = tid >> 2, ch = tid & 3; rv = *(const uint4*)(PB + (size_t)(p + row) * PW + C_GV + head * 128 + slice * 32 + ch * 8); }
        if (tid < 128) { const int row = tid >> 1, ch = tid & 1; rr = *(const uint4*)(PB + (size_t)(p + row) * PW + C_GR + dir * 16 + ch * 8); }
    };
    const int dg = lane & 7, col = wave * 8 + (lane >> 3);
    float S[8];
#pragma unroll
    for (int e = 0; e < 8; ++e) S[e] = 0.f;
    gload(0);
    for (int c = 0; c < 132; ++c) {
        __syncthreads();
#pragma unroll
        for (int i = 0; i < 2; ++i) { const int id = tid + 256 * i, row = id >> 3, ch = id & 7; float fq[8], fk[8]; unpack8(rq[i], fq); unpack8(rk[i], fk);
#pragma unroll
            for (int e = 0; e < 8; ++e) { q_s[row * 64 + ch * 8 + e] = fq[e] * 0.125f; k_s[row * 64 + ch * 8 + e] = fk[e]; } }
        { const int row = tid >> 2, ch = tid & 3; float fv[8]; unpack8(rv, fv);
#pragma unroll
            for (int e = 0; e < 8; ++e) v_s[row * 32 + ch * 8 + e] = fv[e]; }
        if (tid < 128) { const int row = tid >> 1, ch = tid & 1; float fr[8]; unpack8(rr, fr);
#pragma unroll
            for (int e = 0; e < 8; ++e) r_s[row * 16 + ch * 8 + e] = fr[e]; }
        __syncthreads();
        if (c + 1 < 132) gload(c + 1);
#pragma unroll 4
        for (int m = 0; m < 16; ++m) {
            const int i = gt0 + 4 * m;
            float g = b2;
#pragma unroll
            for (int jx = 0; jx < 16; ++jx) g = fmaf(r_s[i * 16 + jx], w2[jx], g);
            const float ls = fminf(g, 0.f) - __logf(1.f + __expf(-fabsf(g)));
            a_s[i * 64 + gd] = __expf(ls * 0.0625f);
        }
        __syncthreads();
        for (int tt = 0; tt < 64; ++tt) {
            const int i = dir ? 63 - tt : tt;
            const float4 a0 = *(const float4*)(a_s + i * 64 + dg * 8), a1 = *(const float4*)(a_s + i * 64 + dg * 8 + 4);
            const float4 q0 = *(const float4*)(q_s + i * 64 + dg * 8), q1 = *(const float4*)(q_s + i * 64 + dg * 8 + 4);
            const float4 k0 = *(const float4*)(k_s + i * 64 + dg * 8), k1 = *(const float4*)(k_s + i * 64 + dg * 8 + 4);
            const float v = v_s[i * 32 + col];
            float op;
            S[0] = fmaf(a0.x, S[0], k0.x * v); op = q0.x * S[0];
            S[1] = fmaf(a0.y, S[1], k0.y * v); op = fmaf(q0.y, S[1], op);
            S[2] = fmaf(a0.z, S[2], k0.z * v); op = fmaf(q0.z, S[2], op);
            S[3] = fmaf(a0.w, S[3], k0.w * v); op = fmaf(q0.w, S[3], op);
            S[4] = fmaf(a1.x, S[4], k1.x * v); op = fmaf(q1.x, S[4], op);
            S[5] = fmaf(a1.y, S[5], k1.y * v); op = fmaf(q1.y, S[5], op);
            S[6] = fmaf(a1.z, S[6], k1.z * v); op = fmaf(q1.z, S[6], op);
            S[7] = fmaf(a1.w, S[7], k1.w * v); op = fmaf(q1.w, S[7], op);
            op += __shfl_xor(op, 1); op += __shfl_xor(op, 2); op += __shfl_xor(op, 4);
            if (dg == 0) o_s[i * 32 + col] = op;
        }
        __syncthreads();
        { const int row = tid >> 2, ch = tid & 3; const int p = chunk_p(c) + row;
          *(uint4*)(OS + (size_t)p * 512 + ch * 8) = pack8(o_s + row * 32 + ch * 8); }
    }
}

#ifdef ONLYI
#define IT_ON(n) (ONLYI == (n))
#else
#define IT_ON(n) true
#endif
__device__ void phase_mixers(const Params& P, int ph, int l, unsigned char* smem) {
    constexpr int N_HG = 128, N_GLA = 64, N_ATT = 2 * 8 * 66;
    for (;;) {
        int it = next_item(P, ph);
        if (it >= N_HG + N_GLA + 2 * N_ATT) break;
        if (it < N_HG) { if (IT_ON(0)) scan_hg_item(P, l, it, smem); continue; }
        it -= N_HG;
        if (it < N_GLA) { if (IT_ON(1)) scan_gla_item(P, l, it, smem); continue; }
        it -= N_GLA;
        if (it < N_ATT) { const int bl = it / 528, rem = it % 528; if (IT_ON(2)) attn_item<96, false>(P, l, bl, rem / 66, rem % 66, smem); continue; }
        it -= N_ATT;
        { const int bl = it / 528, rem = it % 528; if (IT_ON(3)) attn_item<64, true>(P, l, bl, rem / 66, rem % 66, smem); }
    }
}

__device__ void phase_scanfin(const Params& P, int ph, int l) {
    const int tid = tid_opaque(), lane = tid & 63, wave = tid >> 6;
    bf16_t* PB = (bf16_t*)(P.ws + OFF_PB);
    for (;;) {
        const int u = next_item(P, ph);
        if (u >= NTH / 16) break;
        for (int rr = 0; rr < 8; ++rr) {
            const int w = u * 32 + wave * 8 + rr, t = w >> 1, mx = w & 1;
            const bf16_t* OS = (const bf16_t*)(P.ws + (mx ? OFF_OSG : OFF_KV));
            float a[8], b[8];
            unpack8(*(const uint4*)(OS + (size_t)t * 512 + lane * 8), a);
            unpack8(*(const uint4*)(OS + ((size_t)NTH + t) * 512 + lane * 8), b);
            float ss = 0.f;
#pragma unroll
            for (int e = 0; e < 8; ++e) { a[e] += b[e]; ss += a[e] * a[e]; }
            ss += __shfl_xor(ss, 1); ss += __shfl_xor(ss, 2); ss += __shfl_xor(ss, 4); ss += __shfl_xor(ss, 8);
            const float rn = rsqrtf(ss * (1.f / 128.f) + EPS);
            const float* g = (mx ? P.gla_g_o : P.hg_g_o) + l * 128 + (lane & 15) * 8;
            bf16_t* zp = PB + (size_t)t * PW + C_Z + (2 + mx) * 512 + lane * 8;
            float z[8];
            unpack8(*(const uint4*)zp, z);
#pragma unroll
            for (int e = 0; e < 8; ++e) a[e] = a[e] * rn * g[e] * siluf_(z[e]);
            *(uint4*)zp = pack8(a);
        }
    }
}

__device__ void phase_merge(const Params& P, int ph, int l, unsigned char* smem) {
    const int tid_ = tid_opaque(), lane = tid_ & 63, wave = tid_ >> 6, wr = wave >> 1, wc = wave & 1;
    const bf16_t* H = (const bf16_t*)(P.ws + OFF_H);
    const bf16_t* PB = (const bf16_t*)(P.ws + OFF_PB);
    bf16_t* ACC = (bf16_t*)(P.ws + OFF_KV);
    for (;;) {
        const int u = next_item(P, ph);
        if (u >= 132 * 8) break;
        const int mt = u >> 3, nt = u & 7;
        f32x16 tot[2][2]; zero_acc(tot);
        for (int br = 0; br < 4; ++br) {
            unsigned gate[2][2][8];
            {
                f32x16 g[2][2]; zero_acc(g);
                gemm_tile(g, H + (size_t)mt * 128 * D, D, (const bf16_t*)(P.ws + OFF_WM) + ((size_t)(l * 4 + br) * 1024 + nt * 128) * 1024, 1024, 1024, smem);
#pragma unroll
                for (int mi = 0; mi < 2; ++mi)
#pragma unroll
                    for (int ni = 0; ni < 2; ++ni) {
                        const float bm = P.b_merge[(l * 4 + br) * 1024 + nt * 128 + ACC_COL(ni)];
#pragma unroll
                        for (int r = 0; r < 8; ++r) gate[mi][ni][r] = cvt_pk(sigmoidf_(g[mi][ni][2 * r] + bm), sigmoidf_(g[mi][ni][2 * r + 1] + bm));
                    }
            }
            f32x16 pa[2][2]; zero_acc(pa);
            gemm_tile(pa, PB + (size_t)mt * 128 * PW + C_Z + br * 512, PW, (const bf16_t*)(P.ws + OFF_WBR) + ((size_t)(l * 4 + br) * 1024 + nt * 128) * 512, 512, 512, smem);
#pragma unroll
            for (int mi = 0; mi < 2; ++mi)
#pragma unroll
                for (int ni = 0; ni < 2; ++ni)
#pragma unroll
                    for (int r = 0; r < 8; ++r) {
                        tot[mi][ni][2 * r] = fmaf(lo16(gate[mi][ni][r]), pa[mi][ni][2 * r], tot[mi][ni][2 * r]);
                        tot[mi][ni][2 * r + 1] = fmaf(hi16(gate[mi][ni][r]), pa[mi][ni][2 * r + 1], tot[mi][ni][2 * r + 1]);
                    }
        }
#pragma unroll
        for (int mi = 0; mi < 2; ++mi)
#pragma unroll
            for (int ni = 0; ni < 2; ++ni)
#pragma unroll
                for (int r = 0; r < 16; ++r) ACC[(size_t)(mt * 128 + ACC_ROW(mi, r)) * 1024 + nt * 128 + ACC_COL(ni)] = f2bf(tot[mi][ni][r]);
    }
}

__device__ void phase_out(const Params& P, int ph, int l, int hf, unsigned char* smem) {
    const int tid_ = tid_opaque(), lane = tid_ & 63, wave = tid_ >> 6, wr = wave >> 1, wc = wave & 1;
    const bf16_t* ACC = (const bf16_t*)(P.ws + OFF_KV);
    const float* mod = (const float*)(P.ws + OFF_MOD);
    for (;;) {
        const int u = next_item(P, ph);
        if (u >= 132 * 8) break;
        const int mt = u >> 3, nt = u & 7;
        const int t0 = mt * 128, bl = t0 / TB, p0 = t0 % TB, b = hf * 2 + bl;
        const bool isctx = p0 < CTXL;
        if (isctx && l == 1) continue;
        f32x16 acc[2][2]; zero_acc(acc);
        gemm_tile(acc, ACC + (size_t)mt * 128 * 1024, 1024, (const bf16_t*)(P.ws + OFF_WO) + ((size_t)l * 1024 + nt * 128) * 1024, 1024, 1024, smem);
        const float* gt = mod + (l * 5 + (isctx ? 4 : b)) * 3072 + 2048 + nt * 128;
        const float* src; float* dst;
        if (isctx) { src = P.ctx + ((size_t)b * CTXL + p0) * D; dst = (float*)(P.ws + OFF_CX1) + ((size_t)b * CTXL + p0) * D; }
        else { const size_t o = ((size_t)b * SEQ + (p0 - CTXL)) * D; src = (l == 0 ? P.x : (const float*)P.out) + o; dst = P.out + o; }
#pragma unroll
        for (int mi = 0; mi < 2; ++mi)
#pragma unroll
            for (int ni = 0; ni < 2; ++ni) {
                const int cl = ACC_COL(ni);
                const float g = gt[cl];
#pragma unroll
                for (int r = 0; r < 16; ++r) { const size_t o = (size_t)ACC_ROW(mi, r) * D + nt * 128 + cl; dst[o] = src[o] + g * acc[mi][ni][r]; }
            }
    }
}

__global__ void __launch_bounds__(256, 2) mega(Params P) {
    extern __shared__ __attribute__((aligned(16))) unsigned char smem[];
    for (int ph = P.ph_lo; ph < P.ph_hi; ++ph) {
        if (ph > P.ph_lo) cg::this_grid().sync();
#ifdef ONLYP
#define PH_ON(n) ((ONLYP >> (n)) & 1)
#else
#define PH_ON(n) true
#endif
        if (ph == 0) { if (PH_ON(8)) phase_prologue(P, ph, smem); continue; }
        const int q = ph - 1, pass = q >> 3, sub = q & 7, l = pass >> 1, hf = pass & 1;
        switch (sub) {
            case 0: if (PH_ON(0)) phase_norm(P, ph, l, hf); break;
            case 1: if (PH_ON(1)) phase_gemm1(P, ph, l, smem); break;
            case 2: if (PH_ON(2)) phase_gemm2(P, ph, l, smem); break;
            case 3: if (PH_ON(3)) phase_finalize(P, ph, l, smem); break;
            case 4: if (PH_ON(4)) phase_mixers(P, ph, l, smem); break;
            case 5: if (PH_ON(5)) phase_scanfin(P, ph, l); break;
            case 6: if (PH_ON(6)) phase_merge(P, ph, l, smem); break;
            default: if (PH_ON(7)) phase_out(P, ph, l, hf, smem); break;
        }
    }
}

extern "C" void kernel_launch(void* const* d_in, const int* in_sizes, int n_in, void* d_out, int out_size, void* d_ws, size_t ws_size, hipStream_t stream) {
    static int grid = 0;
    if (grid == 0) {
        if (ws_size < WS_END) { fprintf(stderr, "workspace too small: %zu < %zu\n", ws_size, (size_t)WS_END); grid = -1; return; }
        int dev = 0, cus = 0, per_cu = 0;
        hipGetDevice(&dev);
        hipDeviceGetAttribute(&cus, hipDeviceAttributeMultiprocessorCount, dev);
        hipFuncSetAttribute((const void*)mega, hipFuncAttributeMaxDynamicSharedMemorySize, LDS_BYTES);
        hipOccupancyMaxActiveBlocksPerMultiprocessor(&per_cu, (const void*)mega, 256, LDS_BYTES);
        if (per_cu < 1) per_cu = 1;
        if (per_cu > 2) per_cu = 2;
        grid = cus * per_cu;
        (void)hipGetLastError();
    }
    if (grid < 0) return;
    hipMemsetAsync((unsigned char*)d_ws + OFF_CTL, 0, 4096, stream);
    Params p{};
    const float** pp = (const float**)&p;
    for (int i = 0; i < 26; ++i) pp[i] = (const float*)d_in[i];
    p.out = (float*)d_out; p.ws = (unsigned char*)d_ws;
#if SINGLE_LAUNCH
    p.ph_lo = 0; p.ph_hi = NPHASE;
    void* args[] = {&p};
    hipError_t e = hipLaunchCooperativeKernel((const void*)mega, dim3(grid), dim3(256), args, LDS_BYTES, stream);
    if (e != hipSuccess) fprintf(stderr, "cooperative launch failed: %s (grid %d)\n", hipGetErrorString(e), grid);
#else
    for (int ph = 0; ph < NPHASE; ++ph) {
        p.ph_lo = ph; p.ph_hi = ph + 1;
        hipLaunchKernelGGL(mega, dim3(grid), dim3(256), LDS_BYTES, stream, p);
    }
#endif
}
```

```cpp
#include <hip/hip_runtime.h>
#include <hip/hip_cooperative_groups.h>
#include <stdint.h>
#include <stdio.h>
namespace cg = cooperative_groups;

typedef unsigned short bf16_t;
typedef short bf16x8 __attribute__((ext_vector_type(8)));
typedef short bf16x4 __attribute__((ext_vector_type(4)));
typedef float f32x16 __attribute__((ext_vector_type(16)));

#ifndef SINGLE_LAUNCH
#define SINGLE_LAUNCH 1
#endif

constexpr int D = 1024, SEQ = 8192, CTXL = 256, TB = SEQ + CTXL  , NTH = 2 * TB  ;
constexpr int INW = 7104, PW = 7104;
constexpr int C_CQ = 0, C_CKV = 256, C_KR = 384, C_NQ = 416, C_NK = 928, C_NV = 1440, C_HQ = 1952, C_HF = 2464, C_HI = 3488,
              C_GQ = 4000, C_GK = 4256, C_GV = 4512, C_GR = 5024, C_Z = 5056;
constexpr float EPS = 1e-6f;
constexpr float LOG2E = 1.4426950408889634f;
constexpr int LDS_BYTES = 73728;
constexpr int NPHASE = 33;

constexpr size_t al256(size_t v) { return (v + 255) & ~(size_t)255; }
constexpr size_t OFF_CTL = 0;
constexpr size_t OFF_MOD = 4096;
constexpr size_t OFF_CX1 = al256(OFF_MOD + 2 * 5 * 3072 * 4);
constexpr size_t OFF_WIN = al256(OFF_CX1 + (size_t)4 * 256 * 1024 * 4);
constexpr size_t OFF_WM = al256(OFF_WIN + (size_t)2 * 7168 * 1024 * 2);
constexpr size_t OFF_WBR = al256(OFF_WM + (size_t)8 * 1024 * 1024 * 2);
constexpr size_t OFF_WO = al256(OFF_WBR + (size_t)8 * 1024 * 512 * 2);
constexpr size_t OFF_WUQ = al256(OFF_WO + (size_t)2 * 1024 * 1024 * 2);
constexpr size_t OFF_WUKV = al256(OFF_WUQ + (size_t)2 * 768 * 256 * 2);
constexpr size_t OFF_H = al256(OFF_WUKV + (size_t)2 * 1024 * 128 * 2);
constexpr size_t OFF_PB = al256(OFF_H + (size_t)NTH * 1024 * 2);
constexpr size_t OFF_QF = al256(OFF_PB + (size_t)NTH * PW * 2);
constexpr size_t OFF_KV = al256(OFF_QF + (size_t)NTH * 768 * 2);
constexpr size_t OFF_KF = al256(OFF_KV + (size_t)NTH * 1024 * 2);
constexpr size_t OFF_VTM = al256(OFF_KF + (size_t)NTH * 768 * 2);
constexpr size_t OFF_VTN = al256(OFF_VTM + (size_t)2 * 8 * 64 * TB * 2);
constexpr size_t OFF_OSG = al256(OFF_VTN + (size_t)2 * 8 * 64 * TB * 2);
constexpr size_t WS_END = al256(OFF_OSG + (size_t)2 * NTH * 512 * 2);

static_assert(WS_END <= (size_t)512 * 1024 * 1024, "workspace map exceeds 512 MiB");
struct Params {
    const float *x, *c, *ctx, *c_ctx, *ada_w, *ada_b, *norm_g, *w_in, *w_uq, *w_ukv, *g_cq, *g_ckv, *g_q, *g_k, *rpb, *ng_q, *ng_k,
        *lb_logits, *hg_g_o, *gla_w2, *gla_b2, *gla_g_o, *w_br, *w_merge, *b_merge, *w_out;
    float* out;
    unsigned char* ws;
    int ph_lo, ph_hi;
};

__device__ __forceinline__ float bf2f(bf16_t v) { return __uint_as_float(((unsigned)v) << 16); }
__device__ __forceinline__ unsigned cvt_pk(float lo, float hi) { unsigned r; asm("v_cvt_pk_bf16_f32 %0, %1, %2" : "=v"(r) : "v"(lo), "v"(hi)); return r; }
__device__ __forceinline__ bf16_t f2bf(float f) { return (bf16_t)(cvt_pk(f, 0.f) & 0xffffu); }
__device__ __forceinline__ float lo16(unsigned u) { return __uint_as_float(u << 16); }
__device__ __forceinline__ float hi16(unsigned u) { return __uint_as_float(u & 0xffff0000u); }
__device__ __forceinline__ float sigmoidf_(float x) { return 1.f / (1.f + __expf(-x)); }
__device__ __forceinline__ float siluf_(float x) { return x / (1.f + __expf(-x)); }
__device__ __forceinline__ float wave_sum(float v) {
#pragma unroll
    for (int o = 32; o > 0; o >>= 1) v += __shfl_xor(v, o);
    return v;
}
__device__ __forceinline__ void unpack8(uint4 u, float* f) {
    f[0] = lo16(u.x); f[1] = hi16(u.x); f[2] = lo16(u.y); f[3] = hi16(u.y); f[4] = lo16(u.z); f[5] = hi16(u.z); f[6] = lo16(u.w); f[7] = hi16(u.w);
}
__device__ __forceinline__ uint4 pack8(const float* f) { uint4 u; u.x = cvt_pk(f[0], f[1]); u.y = cvt_pk(f[2], f[3]); u.z = cvt_pk(f[4], f[5]); u.w = cvt_pk(f[6], f[7]); return u; }

__device__ __forceinline__ int tid_opaque() { int t = threadIdx.x; asm volatile("" : "+v"(t)); return t; }
__shared__ int s_item;
__device__ __forceinline__ int next_item(const Params& P, int ph) {
    __syncthreads();
    if (threadIdx.x == 0) s_item = atomicAdd((int*)(P.ws + OFF_CTL) + ph, 1);
    __syncthreads();
    return s_item;
}

constexpr int GS = 72;
__device__ __forceinline__ void gemm_tile(f32x16 (&acc)[2][2], const bf16_t* __restrict__ A, int lda, const bf16_t* __restrict__ Bt, int ldb, int K, unsigned char* smem) {
    const int tid = tid_opaque(), lane = tid & 63, wave = tid >> 6, wr = wave >> 1, wc = wave & 1;
    bf16_t* sA = (bf16_t*)smem;
    bf16_t* sB = sA + 2 * 128 * GS;
    const int lrow = tid >> 3, lch = (tid & 7) * 8;
    uint4 ra[4], rb[4];
    const bf16_t* Ap = A + (size_t)lrow * lda + lch;
    const bf16_t* Bp = Bt + (size_t)lrow * ldb + lch;
#pragma unroll
    for (int i = 0; i < 4; ++i) { ra[i] = *(const uint4*)(Ap + (size_t)(32 * i) * lda); rb[i] = *(const uint4*)(Bp + (size_t)(32 * i) * ldb); }
#pragma unroll
    for (int i = 0; i < 4; ++i) { *(uint4*)(sA + (lrow + 32 * i) * GS + lch) = ra[i]; *(uint4*)(sB + (lrow + 32 * i) * GS + lch) = rb[i]; }
    __syncthreads();
    const int nk = K >> 6;
    const int aoff = (wr * 64 + (lane & 31)) * GS + (lane >> 5) * 8, boff = (wc * 64 + (lane & 31)) * GS + (lane >> 5) * 8;
    for (int kt = 0; kt < nk; ++kt) {
        const bool more = kt + 1 < nk;
        if (more) {
#pragma unroll
            for (int i = 0; i < 4; ++i) { ra[i] = *(const uint4*)(Ap + (size_t)(32 * i) * lda + (kt + 1) * 64); rb[i] = *(const uint4*)(Bp + (size_t)(32 * i) * ldb + (kt + 1) * 64); }
        }
        const bf16_t* a = sA + (kt & 1) * 128 * GS + aoff;
        const bf16_t* b = sB + (kt & 1) * 128 * GS + boff;
#pragma unroll
        for (int ks = 0; ks < 4; ++ks) {
            bf16x8 a0 = *(const bf16x8*)(a + ks * 16), a1 = *(const bf16x8*)(a + 32 * GS + ks * 16);
            bf16x8 b0 = *(const bf16x8*)(b + ks * 16), b1 = *(const bf16x8*)(b + 32 * GS + ks * 16);
            acc[0][0] = __builtin_amdgcn_mfma_f32_32x32x16_bf16(a0, b0, acc[0][0], 0, 0, 0);
            acc[0][1] = __builtin_amdgcn_mfma_f32_32x32x16_bf16(a0, b1, acc[0][1], 0, 0, 0);
            acc[1][0] = __builtin_amdgcn_mfma_f32_32x32x16_bf16(a1, b0, acc[1][0], 0, 0, 0);
            acc[1][1] = __builtin_amdgcn_mfma_f32_32x32x16_bf16(a1, b1, acc[1][1], 0, 0, 0);
        }
        if (more) {
            bf16_t* wa = sA + ((kt + 1) & 1) * 128 * GS;
            bf16_t* wb = sB + ((kt + 1) & 1) * 128 * GS;
#pragma unroll
            for (int i = 0; i < 4; ++i) { *(uint4*)(wa + (lrow + 32 * i) * GS + lch) = ra[i]; *(uint4*)(wb + (lrow + 32 * i) * GS + lch) = rb[i]; }
        }
        __syncthreads();
    }
}
__device__ __forceinline__ void zero_acc(f32x16 (&acc)[2][2]) {
#pragma unroll
    for (int i = 0; i < 2; ++i)
#pragma unroll
        for (int j = 0; j < 2; ++j)
#pragma unroll
            for (int r = 0; r < 16; ++r) acc[i][j][r] = 0.f;
}
#define ACC_ROW(mi, r) (wr * 64 + (mi) * 32 + ((r) & 3) + 8 * ((r) >> 2) + 4 * (lane >> 5))
#define ACC_COL(ni) (wc * 64 + (ni) * 32 + (lane & 31))

__device__ void tr_tile(const float* __restrict__ src, int K, int N, int kt, int nt, bf16_t* __restrict__ dst, const float* __restrict__ scale, float* s) {
    const int tid = tid_opaque(), r = tid >> 4, c4 = (tid & 15) * 4;
#pragma unroll
    for (int i = 0; i < 4; ++i) {
        const int k = kt * 64 + r + 16 * i;
        float4 v = *(const float4*)(src + (size_t)k * N + nt * 64 + c4);
        const float sc = scale ? scale[k] : 1.f;
        float* d = s + (r + 16 * i) * 65 + c4;
        d[0] = v.x * sc; d[1] = v.y * sc; d[2] = v.z * sc; d[3] = v.w * sc;
    }
    __syncthreads();
    const int n = tid >> 2, k0 = (tid & 3) * 16;
    float f[16];
#pragma unroll
    for (int j = 0; j < 16; ++j) f[j] = s[(k0 + j) * 65 + n];
    bf16_t* o = dst + (size_t)(nt * 64 + n) * K + kt * 64 + k0;
    *(uint4*)o = pack8(f);
    *(uint4*)(o + 8) = pack8(f + 8);
    __syncthreads();
}
__device__ void phase_prologue(const Params& P, int ph, unsigned char* smem) {
    float* s = (float*)smem;
    const int NTR = 7296, NMOD = 96;
    for (;;) {
        const int u = next_item(P, ph);
        if (u >= NTR + NMOD) break;
        if (u < NMOD) {
            const int l = u / 48, cb = u % 48, tid = threadIdx.x, lane = tid & 63, wave = tid >> 6;
            float* sc = s;
            float* red = s + 5 * 1024;
            for (int i = tid; i < 5 * 1024; i += 256) { const int r = i >> 10, k = i & 1023; const float v = (r < 4) ? P.c[r * 1024 + k] : P.c_ctx[k]; sc[i] = siluf_(v); }
            __syncthreads();
            const int col = cb * 64 + lane;
            float acc[5] = {0.f, 0.f, 0.f, 0.f, 0.f};
            const float* w = P.ada_w + (size_t)l * 1024 * 3072 + col;
#pragma unroll 8
            for (int k = wave * 256; k < wave * 256 + 256; ++k) {
                const float wv = w[(size_t)k * 3072];
#pragma unroll
                for (int r = 0; r < 5; ++r) acc[r] += sc[r * 1024 + k] * wv;
            }
#pragma unroll
            for (int r = 0; r < 5; ++r) red[(wave * 5 + r) * 64 + lane] = acc[r];
            __syncthreads();
            if (wave == 0) {
                float* mod = (float*)(P.ws + OFF_MOD);
#pragma unroll
                for (int r = 0; r < 5; ++r) mod[(l * 5 + r) * 3072 + col] = red[r * 64 + lane] + red[(5 + r) * 64 + lane] + red[(10 + r) * 64 + lane] + red[(15 + r) * 64 + lane] + P.ada_b[l * 3072 + col];
            }
            continue;
        }
        const int v = u - NMOD, l = v / 3648, r = v % 3648;
        if (r < 1776) tr_tile(P.w_in + (size_t)l * 1024 * INW, 1024, INW, r / 111, r % 111, (bf16_t*)(P.ws + OFF_WIN) + (size_t)l * 7168 * 1024, nullptr, s);
        else if (r < 2800) { const int r2 = r - 1776, br = r2 >> 8, t = r2 & 255; tr_tile(P.w_merge + (size_t)(l * 4 + br) * 1024 * 1024, 1024, 1024, t >> 4, t & 15, (bf16_t*)(P.ws + OFF_WM) + (size_t)(l * 4 + br) * 1024 * 1024, nullptr, s); }
        else if (r < 3312) { const int r2 = r - 2800, br = r2 >> 7, t = r2 & 127; tr_tile(P.w_br + (size_t)(l * 4 + br) * 512 * 1024, 512, 1024, t >> 4, t & 15, (bf16_t*)(P.ws + OFF_WBR) + (size_t)(l * 4 + br) * 1024 * 512, nullptr, s); }
        else if (r < 3568) { const int t = r - 3312; tr_tile(P.w_out + (size_t)l * 1024 * 1024, 1024, 1024, t >> 4, t & 15, (bf16_t*)(P.ws + OFF_WO) + (size_t)l * 1024 * 1024, nullptr, s); }
        else if (r < 3616) { const int t = r - 3568; tr_tile(P.w_uq + (size_t)l * 256 * 768, 256, 768, t / 12, t % 12, (bf16_t*)(P.ws + OFF_WUQ) + (size_t)l * 768 * 256, P.g_cq + l * 256, s); }
        else { const int t = r - 3616; tr_tile(P.w_ukv + (size_t)l * 128 * 1024, 128, 1024, t >> 4, t & 15, (bf16_t*)(P.ws + OFF_WUKV) + (size_t)l * 1024 * 128, P.g_ckv + l * 128, s); }
    }
}

__device__ void phase_norm(const Params& P, int ph, int l, int hf) {
    const int tid = tid_opaque(), lane = tid & 63, wave = tid >> 6;
    const float* mod = (const float*)(P.ws + OFF_MOD);
    bf16_t* H = (bf16_t*)(P.ws + OFF_H);
    for (;;) {
        const int u = next_item(P, ph);
        if (u >= NTH / 32) break;
        for (int rr = 0; rr < 8; ++rr) {
            const int t = u * 32 + wave * 8 + rr, bl = t / TB, p = t % TB, b = hf * 2 + bl;
            const float* src; int mr;
            if (p < CTXL) { src = (l == 0 ? P.ctx : (const float*)(P.ws + OFF_CX1)) + ((size_t)b * CTXL + p) * D; mr = 4; }
            else { src = (l == 0 ? P.x : (const float*)P.out) + ((size_t)b * SEQ + (p - CTXL)) * D; mr = b; }
            float4 v[4]; float ss = 0.f;
#pragma unroll
            for (int i = 0; i < 4; ++i) { v[i] = *(const float4*)(src + lane * 4 + 256 * i); ss += v[i].x * v[i].x + v[i].y * v[i].y + v[i].z * v[i].z + v[i].w * v[i].w; }
            ss = wave_sum(ss);
            const float rstd = rsqrtf(ss * (1.f / D) + EPS);
            const float* sh = mod + (l * 5 + mr) * 3072; const float* sc = sh + 1024; const float* g = P.norm_g + l * D;
#pragma unroll
            for (int i = 0; i < 4; ++i) {
                const int c = lane * 4 + 256 * i;
                const float4 gv = *(const float4*)(g + c), s1 = *(const float4*)(sc + c), s0 = *(const float4*)(sh + c);
                uint2 o;
                o.x = cvt_pk(v[i].x * rstd * gv.x * (1.f + s1.x) + s0.x, v[i].y * rstd * gv.y * (1.f + s1.y) + s0.y);
                o.y = cvt_pk(v[i].z * rstd * gv.z * (1.f + s1.z) + s0.z, v[i].w * rstd * gv.w * (1.f + s1.w) + s0.w);
                *(uint2*)(H + (size_t)t * D + c) = o;
            }
        }
    }
}

__device__ void phase_gemm1(const Params& P, int ph, int l, unsigned char* smem) {
    const int tid_ = tid_opaque(), lane = tid_ & 63, wave = tid_ >> 6, wr = wave >> 1, wc = wave & 1;
    const bf16_t* H = (const bf16_t*)(P.ws + OFF_H);
    const bf16_t* W = (const bf16_t*)(P.ws + OFF_WIN) + (size_t)l * 7168 * 1024;
    bf16_t* PB = (bf16_t*)(P.ws + OFF_PB);
    for (;;) {
        const int u = next_item(P, ph);
        if (u >= 132 * 56) break;
        const int mt = u / 56, nt = u % 56;
        f32x16 acc[2][2]; zero_acc(acc);
        gemm_tile(acc, H + (size_t)mt * 128 * D, D, W + (size_t)nt * 128 * D, D, D, smem);
#pragma unroll
        for (int mi = 0; mi < 2; ++mi)
#pragma unroll
            for (int ni = 0; ni < 2; ++ni) {
                const int col = nt * 128 + ACC_COL(ni);
                if (col < PW) {
#pragma unroll
                    for (int r = 0; r < 16; ++r) PB[(size_t)(mt * 128 + ACC_ROW(mi, r)) * PW + col] = f2bf(acc[mi][ni][r]);
                }
            }
    }
}

__device__ void phase_gemm2(const Params& P, int ph, int l, unsigned char* smem) {
    const int tid_ = tid_opaque(), lane = tid_ & 63, wave = tid_ >> 6, wr = wave >> 1, wc = wave & 1;
    const bf16_t* PB = (const bf16_t*)(P.ws + OFF_PB);
    for (;;) {
        const int u = next_item(P, ph);
        if (u >= 132 * 14) break;
        const int mt = u / 14, n14 = u % 14;
        f32x16 acc[2][2]; zero_acc(acc);
        bf16_t* O; int ldo, nt;
        if (n14 < 6) { nt = n14; O = (bf16_t*)(P.ws + OFF_QF); ldo = 768;
            gemm_tile(acc, PB + (size_t)mt * 128 * PW + C_CQ, PW, (const bf16_t*)(P.ws + OFF_WUQ) + (size_t)l * 768 * 256 + (size_t)nt * 128 * 256, 256, 256, smem); }
        else { nt = n14 - 6; O = (bf16_t*)(P.ws + OFF_KV); ldo = 1024;
            gemm_tile(acc, PB + (size_t)mt * 128 * PW + C_CKV, PW, (const bf16_t*)(P.ws + OFF_WUKV) + (size_t)l * 1024 * 128 + (size_t)nt * 128 * 128, 128, 128, smem); }
#pragma unroll
        for (int mi = 0; mi < 2; ++mi)
#pragma unroll
            for (int ni = 0; ni < 2; ++ni)
#pragma unroll
                for (int r = 0; r < 16; ++r) O[(size_t)(mt * 128 + ACC_ROW(mi, r)) * ldo + nt * 128 + ACC_COL(ni)] = f2bf(acc[mi][ni][r]);
    }
}

__device__ void phase_finalize(const Params& P, int ph, int l, unsigned char* smem) {
    const int tid = tid_opaque(), lane = tid & 63, wave = tid >> 6;
    bf16_t* PB = (bf16_t*)(P.ws + OFF_PB);
    bf16_t* QF = (bf16_t*)(P.ws + OFF_QF);
    const bf16_t* KV = (const bf16_t*)(P.ws + OFF_KV);
    bf16_t* KF = (bf16_t*)(P.ws + OFF_KF);
    bf16_t* VTM = (bf16_t*)(P.ws + OFF_VTM);
    bf16_t* VTN = (bf16_t*)(P.ws + OFF_VTN);
    float* rs = (float*)smem;
    const int hd = lane >> 3, j = lane & 7;
    const float invf = __powf(10000.f, -(float)j * 0.125f);
    for (;;) {
        const int u = next_item(P, ph);
        if (u >= NTH / 32) break;
        const int t0 = u * 32, bl = t0 / TB, p0 = t0 % TB;
        for (int rr = 0; rr < 8; ++rr) {
            const int tl = wave * 8 + rr, t = t0 + tl, p = p0 + tl;
            bf16_t* prow = PB + (size_t)t * PW;
            float s1 = 0.f, s2 = 0.f;
            { const uint2 a = *(const uint2*)(prow + C_CQ + lane * 4); const float f0 = lo16(a.x), f1 = hi16(a.x), f2 = lo16(a.y), f3 = hi16(a.y); s1 = f0 * f0 + f1 * f1 + f2 * f2 + f3 * f3;
              const unsigned b = *(const unsigned*)(prow + C_CKV + lane * 2); const float g0 = lo16(b), g1 = hi16(b); s2 = g0 * g0 + g1 * g1; }
            s1 = wave_sum(s1); s2 = wave_sum(s2);
            const float rcq = rsqrtf(s1 * (1.f / 256.f) + EPS), rckv = rsqrtf(s2 * (1.f / 128.f) + EPS);
            if (lane == 0) rs[tl] = rckv;
            {
                bf16_t* q = QF + (size_t)t * 768 + hd * 96;
                float v[12], ss = 0.f;
#pragma unroll
                for (int m = 0; m < 12; ++m) { v[m] = bf2f(q[j + 8 * m]) * rcq; ss += v[m] * v[m]; }
                ss += __shfl_xor(ss, 1); ss += __shfl_xor(ss, 2); ss += __shfl_xor(ss, 4);
                const float rn = rsqrtf(ss * (1.f / 96.f) + EPS);
#pragma unroll
                for (int m = 0; m < 12; ++m) q[j + 8 * m] = f2bf(v[m] * rn * P.g_q[l * 96 + j + 8 * m]);
            }
            {
                const bf16_t* kvr = KV + (size_t)t * 1024 + hd * 128;
                float v[12], ss = 0.f;
#pragma unroll
                for (int m = 0; m < 8; ++m) { v[m] = bf2f(kvr[j + 8 * m]) * rckv; ss += v[m] * v[m]; }
#pragma unroll
                for (int m = 8; m < 12; ++m) { v[m] = bf2f(prow[C_KR + j + 8 * (m - 8)]); ss += v[m] * v[m]; }
                ss += __shfl_xor(ss, 1); ss += __shfl_xor(ss, 2); ss += __shfl_xor(ss, 4);
                const float rn = rsqrtf(ss * (1.f / 96.f) + EPS);
#pragma unroll
                for (int m = 0; m < 12; ++m) v[m] = v[m] * rn * P.g_k[l * 96 + j + 8 * m];
                if (p >= CTXL) {
                    const int pos = p - CTXL;
                    const float ar = (float)(pos >> 6) * invf, ac = (float)(pos & 63) * invf;
                    double fr = (double)ar * 0.15915494309189535; fr -= rint(fr);
                    double fc = (double)ac * 0.15915494309189535; fc -= rint(fc);
                    const float sr = __builtin_amdgcn_sinf((float)fr), cr = __builtin_amdgcn_cosf((float)fr);
                    const float sc = __builtin_amdgcn_sinf((float)fc), cc = __builtin_amdgcn_cosf((float)fc);
                    const float x1a = v[8], x2a = v[10], x1b = v[9], x2b = v[11];
                    v[8] = x1a * cr - x2a * sr; v[10] = x1a * sr + x2a * cr;
                    v[9] = x1b * cc - x2b * sc; v[11] = x1b * sc + x2b * cc;
                }
                bf16_t* ko = KF + ((size_t)t * 8 + hd) * 96;
#pragma unroll
                for (int m = 0; m < 12; ++m) ko[j + 8 * m] = f2bf(v[m]);
            }
#pragma unroll
            for (int w = 0; w < 2; ++w) {
                bf16_t* q = prow + (w ? C_NK : C_NQ) + hd * 64 + j * 8;
                const float* g = (w ? P.ng_k : P.ng_q) + l * 64 + j * 8;
                float v[8], ss = 0.f;
                unpack8(*(const uint4*)q, v);
#pragma unroll
                for (int m = 0; m < 8; ++m) ss += v[m] * v[m];
                ss += __shfl_xor(ss, 1); ss += __shfl_xor(ss, 2); ss += __shfl_xor(ss, 4);
                const float rn = rsqrtf(ss * (1.f / 64.f) + EPS);
#pragma unroll
                for (int m = 0; m < 8; ++m) v[m] = v[m] * rn * g[m];
                *(uint4*)q = pack8(v);
            }
        }
        __syncthreads();
#pragma unroll
        for (int cc = 0; cc < 2; ++cc) {
            const int c = tid + 256 * cc, h2 = c >> 6, dv = c & 63;
#pragma unroll
            for (int grp = 0; grp < 4; ++grp) {
                float fm[8], fn[8];
#pragma unroll
                for (int i = 0; i < 8; ++i) {
                    const int tl = grp * 8 + i;
                    fm[i] = bf2f(KV[(size_t)(t0 + tl) * 1024 + h2 * 128 + 64 + dv]) * rs[tl];
                    fn[i] = bf2f(PB[(size_t)(t0 + tl) * PW + C_NV + c]);
                }
                const size_t o = ((size_t)(bl * 8 + h2) * 64 + dv) * TB + p0 + grp * 8;
                *(uint4*)(VTM + o) = pack8(fm);
                *(uint4*)(VTN + o) = pack8(fn);
            }
        }
    }
}

template <int DQK, bool NAT>
__device__ void attn_item(const Params& P, int l, int bl, int head, int qb, unsigned char* smem) {
    constexpr int NKS = DQK / 16, KSTR = DQK + 8, VSTR = 68, KCH = DQK / 8, KLD = (DQK * 64 / 8) / 256;
    const int tid = tid_opaque(), lane = tid & 63, wave = tid >> 6, hh = lane >> 5, r32 = lane & 31;
    bf16_t* Ks = (bf16_t*)smem;
    bf16_t* Vs = Ks + 2 * 64 * KSTR;
    float* rpb_s = (float*)(Vs + 2 * 64 * VSTR);
    bf16_t* PB = (bf16_t*)(P.ws + OFF_PB);
    const int rowbase = bl * TB, q_p0 = qb * 128, ql = wave * 32 + r32;
    const bool q_ctx = qb < 2;
    int lt0 = 0, lt1 = 0;
    int qr = 0, qc = 0, r0w = 0, c0 = 0;
    if (!q_ctx) {
        if (NAT) { const int rp = qb - 2, ra = 2 * rp, rb = ra + 1; lt0 = min(max(ra - 4, 0), 120); lt1 = min(max(rb - 4, 0), 120) + 8;
            qr = ra + (wave >> 1); qc = (wave & 1) * 32 + r32; r0w = min(max(qr - 4, 0), 120); c0 = min(max(qc - 8, 0), 48); }
        else { lt0 = 0; lt1 = 128; }
    }
    const int ntiles = 4 + (lt1 - lt0);
    const bf16_t* Kbase; const bf16_t* VT; const bf16_t* qptr; int k_ld;
    if (NAT) { Kbase = PB + (size_t)rowbase * PW + C_NK + head * 64; k_ld = PW; VT = (const bf16_t*)(P.ws + OFF_VTN) + (size_t)(bl * 8 + head) * 64 * TB;
        qptr = PB + (size_t)(rowbase + q_p0 + ql) * PW + C_NQ + head * 64; }
    else { Kbase = (const bf16_t*)(P.ws + OFF_KF) + (size_t)rowbase * 768 + head * 96; k_ld = 768; VT = (const bf16_t*)(P.ws + OFF_VTM) + (size_t)(bl * 8 + head) * 64 * TB;
        qptr = (const bf16_t*)(P.ws + OFF_QF) + (size_t)(rowbase + q_p0 + ql) * 768 + head * 96; }
    if (NAT) { for (int i = tid; i < 465; i += 256) rpb_s[i] = P.rpb[(size_t)(l * 8 + head) * 465 + i] * LOG2E; }
    bf16x8 qf[NKS];
#pragma unroll
    for (int ks = 0; ks < NKS; ++ks) qf[ks] = *(const bf16x8*)(qptr + ks * 16 + hh * 8);
    bf16x8 qrot4 = qf[NKS - 2], qrot5 = qf[NKS - 1];
    if (!NAT && !q_ctx) {
        const int pos = q_p0 - CTXL + ql;
        const float base = hh ? (float)(pos & 63) : (float)(pos >> 6);
#pragma unroll
        for (int jj = 0; jj < 8; ++jj) {
            const float invf = __powf(10000.f, -(float)jj * 0.125f);
            const float ang = base * invf;
            double fr = (double)ang * 0.15915494309189535; fr -= rint(fr);
            const float sn = __builtin_amdgcn_sinf((float)fr), cs = __builtin_amdgcn_cosf((float)fr);
            const float x1 = bf2f((bf16_t)qf[4][jj]), x2 = bf2f((bf16_t)qf[5][jj]);
            qrot4[jj] = (short)f2bf(x1 * cs - x2 * sn);
            qrot5[jj] = (short)f2bf(x1 * sn + x2 * cs);
        }
    }
    const float sc2 = (NAT ? 0.125f : 0.10206207261596575f) * LOG2E;
    float m_run = -1e30f, lsum = 0.f;
    f32x16 oacc[2];
#pragma unroll
    for (int r = 0; r < 16; ++r) { oacc[0][r] = 0.f; oacc[1][r] = 0.f; }
    uint4 kreg0, kreg1, kreg2, vreg0, vreg1;
    kreg2 = make_uint4(0, 0, 0, 0);
    const int kid0 = tid, kid1 = tid + 256, kid2 = tid + 512;
    const int krow0 = kid0 / KCH, kch0 = kid0 % KCH, krow1 = kid1 / KCH, kch1 = kid1 % KCH, krow2 = kid2 / KCH, kch2 = kid2 % KCH;
    const int vrow0 = tid >> 3, vch = tid & 7, vrow1 = vrow0 + 32;
#define TILE_P(ti) ((ti) < 4 ? (ti) * 64 : CTXL + (lt0 + (ti) - 4) * 64)
#define GLOAD(ti) { const int p_ = TILE_P(ti); \
        kreg0 = *(const uint4*)(Kbase + (size_t)(p_ + krow0) * k_ld + kch0 * 8); \
        kreg1 = *(const uint4*)(Kbase + (size_t)(p_ + krow1) * k_ld + kch1 * 8); \
        if (KLD > 2) kreg2 = *(const uint4*)(Kbase + (size_t)(p_ + krow2) * k_ld + kch2 * 8); \
        vreg0 = *(const uint4*)(VT + (size_t)vrow0 * TB + p_ + vch * 8); \
        vreg1 = *(const uint4*)(VT + (size_t)vrow1 * TB + p_ + vch * 8); }
#define SWRITE(buf_) { bf16_t* kd_ = Ks + (buf_) * 64 * KSTR; \
        *(uint4*)(kd_ + krow0 * KSTR + kch0 * 8) = kreg0; *(uint4*)(kd_ + krow1 * KSTR + kch1 * 8) = kreg1; \
        if (KLD > 2) *(uint4*)(kd_ + krow2 * KSTR + kch2 * 8) = kreg2; \
        bf16_t* vd_ = Vs + (buf_) * 64 * VSTR + vch * 8; \
        *(uint2*)(vd_ + vrow0 * VSTR) = make_uint2(vreg0.x, vreg0.y); *(uint2*)(vd_ + vrow0 * VSTR + 4) = make_uint2(vreg0.z, vreg0.w); \
        *(uint2*)(vd_ + vrow1 * VSTR) = make_uint2(vreg1.x, vreg1.y); *(uint2*)(vd_ + vrow1 * VSTR + 4) = make_uint2(vreg1.z, vreg1.w); }
    GLOAD(0); SWRITE(0);
    __syncthreads();
    for (int ti = 0; ti < ntiles; ++ti) {
        const int buf = ti & 1;
        const bool more = ti + 1 < ntiles;
        if (more) GLOAD(ti + 1);
        if (!NAT && ti == 4) { qf[NKS - 2] = qrot4; qf[NKS - 1] = qrot5; }
        const int kr = lt0 + ti - 4;
        const bool active = !NAT || ti < 4 || (kr >= r0w && kr < r0w + 8);
        if (active) {
            const bf16_t* kb = Ks + buf * 64 * KSTR + r32 * KSTR + hh * 8;
            f32x16 st0, st1;
#pragma unroll
            for (int r = 0; r < 16; ++r) { st0[r] = 0.f; st1[r] = 0.f; }
#pragma unroll
            for (int ks = 0; ks < NKS; ++ks) {
                const bf16x8 k0 = *(const bf16x8*)(kb + ks * 16), k1 = *(const bf16x8*)(kb + 32 * KSTR + ks * 16);
                st0 = __builtin_amdgcn_mfma_f32_32x32x16_bf16(k0, qf[ks], st0, 0, 0, 0);
                st1 = __builtin_amdgcn_mfma_f32_32x32x16_bf16(k1, qf[ks], st1, 0, 0, 0);
            }
            float x[32];
#pragma unroll
            for (int r = 0; r < 16; ++r) { x[r] = st0[r] * sc2; x[16 + r] = st1[r] * sc2; }
            if (NAT && ti >= 4) {
                const int dr = kr - qr + 7;
#pragma unroll
                for (int e = 0; e < 32; ++e) {
                    const int r = e & 15, kc = (e >> 4) * 32 + (r & 3) + 8 * (r >> 2) + 4 * hh;
                    const int dc = min(max(kc - qc, -15), 15) + 15;
                    const bool ok = (kc >= c0) && (kc < c0 + 16);
                    x[e] = ok ? x[e] + rpb_s[dr * 31 + dc] : -1e30f;
                }
            }
            float mx = x[0];
#pragma unroll
            for (int e = 1; e < 32; ++e) mx = fmaxf(mx, x[e]);
            mx = fmaxf(mx, __shfl_xor(mx, 32));
            const float m_new = fmaxf(m_run, mx);
            const float alpha = __builtin_amdgcn_exp2f(m_run - m_new);
            m_run = m_new;
            float ps = 0.f;
#pragma unroll
            for (int e = 0; e < 32; ++e) { x[e] = __builtin_amdgcn_exp2f(x[e] - m_new); ps += x[e]; }
            lsum = lsum * alpha + ps;
#pragma unroll
            for (int r = 0; r < 16; ++r) { oacc[0][r] *= alpha; oacc[1][r] *= alpha; }
            bf16x8 pf[2][2];
#pragma unroll
            for (int t = 0; t < 2; ++t)
#pragma unroll
                for (int s = 0; s < 2; ++s) {
                    union { bf16x8 v; unsigned u[4]; } cv;
#pragma unroll
                    for (int q = 0; q < 4; ++q) cv.u[q] = cvt_pk(x[16 * t + 8 * s + 2 * q], x[16 * t + 8 * s + 2 * q + 1]);
                    pf[t][s] = cv.v;
                }
            const bf16_t* vb = Vs + buf * 64 * VSTR + r32 * VSTR + 4 * hh;
#pragma unroll
            for (int uu = 0; uu < 2; ++uu)
#pragma unroll
                for (int t = 0; t < 2; ++t)
#pragma unroll
                    for (int s = 0; s < 2; ++s) {
                        const bf16_t* a = vb + uu * 32 * VSTR + t * 32 + s * 16;
                        union { bf16x8 v; uint2 h[2]; } cv;
                        cv.h[0] = *(const uint2*)a; cv.h[1] = *(const uint2*)(a + 8);
                        oacc[uu] = __builtin_amdgcn_mfma_f32_32x32x16_bf16(cv.v, pf[t][s], oacc[uu], 0, 0, 0);
                    }
        }
        if (more) SWRITE((ti + 1) & 1);
        __syncthreads();
    }
#undef TILE_P
#undef GLOAD
#undef SWRITE
    lsum += __shfl_xor(lsum, 32);
    const float inv = 1.f / lsum;
    bf16_t* zrow = PB + (size_t)(rowbase + q_p0 + ql) * PW + C_Z + (NAT ? 512 : 0) + head * 64;
#pragma unroll
    for (int uu = 0; uu < 2; ++uu)
#pragma unroll
        for (int g = 0; g < 4; ++g) {
            bf16_t* zp = zrow + uu * 32 + 8 * g + 4 * hh;
            const uint2 z = *(const uint2*)zp;
            uint2 o;
            o.x = cvt_pk(oacc[uu][4 * g + 0] * inv * siluf_(lo16(z.x)), oacc[uu][4 * g + 1] * inv * siluf_(hi16(z.x)));
            o.y = cvt_pk(oacc[uu][4 * g + 2] * inv * siluf_(lo16(z.y)), oacc[uu][4 * g + 3] * inv * siluf_(hi16(z.y)));
            *(uint2*)zp = o;
        }
}

__device__ void scan_hg_item(const Params& P, int l, int item, unsigned char* smem) {
    const int tid = tid_opaque(), lane = tid & 63, wave = tid >> 6;
    const int slice = item & 7, dir = (item >> 3) & 1, head = (item >> 4) & 3, bl = item >> 6;
    float* a_s = (float*)smem;
    float* q_s = a_s + 64 * 128;
    float* v_s = q_s + 64 * 128;
    float* o_s = v_s + 64 * 16;
    const bf16_t* PB = (const bf16_t*)(P.ws + OFF_PB) + (size_t)bl * TB * PW;
    bf16_t* OS = (bf16_t*)(P.ws + OFF_KV) + ((size_t)dir * NTH + (size_t)bl * TB) * 512 + head * 128 + slice * 16;
    const int prow = tid >> 4, pd = (tid & 15) * 8;
    float lb[8];
#pragma unroll
    for (int e = 0; e < 8; ++e) {
        const int cidx = dir * 512 + head * 128 + pd + e;
        lb[e] = (l == 0) ? 0.f : sigmoidf_(P.lb_logits[1024 + cidx] - P.lb_logits[cidx]);
    }
    const int fcol = (dir ? C_HF + 512 : C_HF) + head * 128 + pd, qcol = C_HQ + head * 128 + pd, vcol = C_HI + head * 128 + slice * 16 + (tid & 1) * 8;
    uint4 rq[4], rf[4], rv;
    auto chunk_p = [&](int c) { const int ci = dir ? (c < 4 ? 3 - c : 135 - c) : c; return ci * 64; };
    auto gload = [&](int c) {
        const int p = chunk_p(c);
#pragma unroll
        for (int r = 0; r < 4; ++r) { const bf16_t* row = PB + (size_t)(p + prow + 16 * r) * PW; rq[r] = *(const uint4*)(row + qcol); rf[r] = *(const uint4*)(row + fcol); }
        if (tid < 128) rv = *(const uint4*)(PB + (size_t)(p + (tid >> 1)) * PW + vcol);
    };
    const int dg = lane & 15, col = wave * 4 + (lane >> 4);
    float S[8];
#pragma unroll
    for (int e = 0; e < 8; ++e) S[e] = 0.f;
    gload(0);
    for (int c = 0; c < 132; ++c) {
        __syncthreads();
#pragma unroll
        for (int r = 0; r < 4; ++r) {
            float fq[8], ff[8];
            unpack8(rq[r], fq); unpack8(rf[r], ff);
            float* ad = a_s + (prow + 16 * r) * 128 + pd; float* qd = q_s + (prow + 16 * r) * 128 + pd;
#pragma unroll
            for (int e = 0; e < 8; ++e) { ad[e] = lb[e] + (1.f - lb[e]) * sigmoidf_(ff[e]); qd[e] = siluf_(fq[e]) * 0.08838834764831845f; }
        }
        if (tid < 128) { float fv[8]; unpack8(rv, fv); float* vd = v_s + (tid >> 1) * 16 + (tid & 1) * 8;
#pragma unroll
            for (int e = 0; e < 8; ++e) vd[e] = fv[e]; }
        __syncthreads();
        if (c + 1 < 132) gload(c + 1);
        for (int tt = 0; tt < 64; ++tt) {
            const int i = dir ? 63 - tt : tt;
            const float4 a0 = *(const float4*)(a_s + i * 128 + dg * 8), a1 = *(const float4*)(a_s + i * 128 + dg * 8 + 4);
            const float4 q0 = *(const float4*)(q_s + i * 128 + dg * 8), q1 = *(const float4*)(q_s + i * 128 + dg * 8 + 4);
            const float v = v_s[i * 16 + col];
            float op;
            S[0] = fmaf(a0.x, S[0] - v, v); op = q0.x * S[0];
            S[1] = fmaf(a0.y, S[1] - v, v); op = fmaf(q0.y, S[1], op);
            S[2] = fmaf(a0.z, S[2] - v, v); op = fmaf(q0.z, S[2], op);
            S[3] = fmaf(a0.w, S[3] - v, v); op = fmaf(q0.w, S[3], op);
            S[4] = fmaf(a1.x, S[4] - v, v); op = fmaf(q1.x, S[4], op);
            S[5] = fmaf(a1.y, S[5] - v, v); op = fmaf(q1.y, S[5], op);
            S[6] = fmaf(a1.z, S[6] - v, v); op = fmaf(q1.z, S[6], op);
            S[7] = fmaf(a1.w, S[7] - v, v); op = fmaf(q1.w, S[7], op);
            op += __shfl_xor(op, 1); op += __shfl_xor(op, 2); op += __shfl_xor(op, 4); op += __shfl_xor(op, 8);
            if (dg == 0) o_s[i * 16 + col] = op;
        }
        __syncthreads();
        if (tid < 128) {
            const int p = chunk_p(c) + (tid >> 1);
            *(uint4*)(OS + (size_t)p * 512 + (tid & 1) * 8) = pack8(o_s + (tid >> 1) * 16 + (tid & 1) * 8);
        }
    }
}

__device__ void scan_gla_item(const Params& P, int l, int item, unsigned char* smem) {
    const int tid = tid_opaque(), lane = tid & 63, wave = tid >> 6;
    const int slice = item & 3, dir = (item >> 2) & 1, head = (item >> 3) & 3, bl = item >> 5;
    float* a_s = (float*)smem;
    float* q_s = a_s + 64 * 64;
    float* k_s = q_s + 64 * 64;
    float* v_s = k_s + 64 * 64;
    float* o_s = v_s + 64 * 32;
    float* r_s = o_s + 64 * 32;
    const bf16_t* PB = (const bf16_t*)(P.ws + OFF_PB) + (size_t)bl * TB * PW;
    bf16_t* OS = (bf16_t*)(P.ws + OFF_OSG) + ((size_t)dir * NTH + (size_t)bl * TB) * 512 + head * 128 + slice * 32;
    const int gd = tid & 63, gt0 = tid >> 6;
    float w2[16];
#pragma unroll
    for (int jx = 0; jx < 16; ++jx) w2[jx] = P.gla_w2[((size_t)(l * 2 + dir) * 16 + jx) * 256 + head * 64 + gd];
    const float b2 = P.gla_b2[(l * 2 + dir) * 256 + head * 64 + gd];
    uint4 rq[2], rk[2], rv, rr;
    auto chunk_p = [&](int c) { const int ci = dir ? (c < 4 ? 3 - c : 135 - c) : c; return ci * 64; };
    auto gload = [&](int c) {
        const int p = chunk_p(c);
#pragma unroll
        for (int i = 0; i < 2; ++i) { const int id = tid + 256 * i, row = id >> 3, ch = id & 7; const bf16_t* rp = PB + (size_t)(p + row) * PW;
            rq[i] = *(const uint4*)(rp + C_GQ + head * 64 + ch * 8); rk[i] = *(const uint4*)(rp + C_GK + head * 64 + ch * 8); }
        { const int row = tid >> 2, ch = tid & 3; rv = *(const uint4*)(PB + (size_t)(p + row) * PW + C_GV + head * 128 + slice * 32 + ch * 8); }
        if (tid < 128) { const int row = tid >> 1, ch = tid & 1; rr = *(const uint4*)(PB + (size_t)(p + row) * PW + C_GR + dir * 16 + ch * 8); }
    };
    const int dg = lane & 7, col = wave * 8 + (lane >> 3);
    float S[8];
#pragma unroll
    for (int e = 0; e < 8; ++e) S[e] = 0.f;
    gload(0);
    for (int c = 0; c < 132; ++c) {
        __syncthreads();
#pragma unroll
        for (int i = 0; i < 2; ++i) { const int id = tid + 256 * i, row = id >> 3, ch = id & 7; float fq[8], fk[8]; unpack8(rq[i], fq); unpack8(rk[i], fk);
#pragma unroll
            for (int e = 0; e < 8; ++e) { q_s[row * 64 + ch * 8 + e] = fq[e] * 0.125f; k_s[row * 64 + ch * 8 + e] = fk[e]; } }
        { const int row = tid >> 2, ch = tid & 3; float fv[8]; unpack8(rv, fv);
#pragma unroll
            for (int e = 0; e < 8; ++e) v_s[row * 32 + ch * 8 + e] = fv[e]; }
        if (tid < 128) { const int row = tid >> 1, ch = tid & 1; float fr[8]; unpack8(rr, fr);
#pragma unroll
            for (int e = 0; e < 8; ++e) r_s[row * 16 + ch * 8 + e] = fr[e]; }
        __syncthreads();
        if (c + 1 < 132) gload(c + 1);
#pragma unroll 4
        for (int m = 0; m < 16; ++m) {
            const int i = gt0 + 4 * m;
            float g = b2;
#pragma unroll
            for (int jx = 0; jx < 16; ++jx) g = fmaf(r_s[i * 16 + jx], w2[jx], g);
            const float ls = fminf(g, 0.f) - __logf(1.f + __expf(-fabsf(g)));
            a_s[i * 64 + gd] = __expf(ls * 0.0625f);
        }
        __syncthreads();
        for (int tt = 0; tt < 64; ++tt) {
            const int i = dir ? 63 - tt : tt;
            const float4 a0 = *(const float4*)(a_s + i * 64 + dg * 8), a1 = *(const float4*)(a_s + i * 64 + dg * 8 + 4);
            const float4 q0 = *(const float4*)(q_s + i * 64 + dg * 8), q1 = *(const float4*)(q_s + i * 64 + dg * 8 + 4);
            const float4 k0 = *(const float4*)(k_s + i * 64 + dg * 8), k1 = *(const float4*)(k_s + i * 64 + dg * 8 + 4);
            const float v = v_s[i * 32 + col];
            float op;
            S[0] = fmaf(a0.x, S[0], k0.x * v); op = q0.x * S[0];
            S[1] = fmaf(a0.y, S[1], k0.y * v); op = fmaf(q0.y, S[1], op);
            S[2] = fmaf(a0.z, S[2], k0.z * v); op = fmaf(q0.z, S[2], op);
            S[3] = fmaf(a0.w, S[3], k0.w * v); op = fmaf(q0.w, S[3], op);
            S[4] = fmaf(a1.x, S[4], k1.x * v); op = fmaf(q1.x, S[4], op);
            S[5] = fmaf(a1.y, S[5], k1.y * v); op = fmaf(q1.y, S[5], op);
            S[6] = fmaf(a1.z, S[6], k1.z * v); op = fmaf(q1.z, S[6], op);
            S[7] = fmaf(a1.w, S[7], k1.w * v); op = fmaf(q1.w, S[7], op);
            op += __shfl_xor(op, 1); op += __shfl_xor(op, 2); op += __shfl_xor(op, 4);
            if (dg == 0) o_s[i * 32 + col] = op;
        }
        __syncthreads();
        { const int row = tid >> 2, ch = tid & 3; const int p = chunk_p(c) + row;
          *(uint4*)(OS + (size_t)p * 512 + ch * 8) = pack8(o_s + row * 32 + ch * 8); }
    }
}

#ifdef ONLYI
#define IT_ON(n) (ONLYI == (n))
#else
#define IT_ON(n) true
#endif
__device__ void phase_mixers(const Params& P, int ph, int l, unsigned char* smem) {
    constexpr int N_HG = 128, N_GLA = 64, N_ATT = 2 * 8 * 66;
    for (;;) {
        int it = next_item(P, ph);
        if (it >= N_HG + N_GLA + 2 * N_ATT) break;
        if (it < N_HG) { if (IT_ON(0)) scan_hg_item(P, l, it, smem); continue; }
        it -= N_HG;
        if (it < N_GLA) { if (IT_ON(1)) scan_gla_item(P, l, it, smem); continue; }
        it -= N_GLA;
        if (it < N_ATT) { const int bl = it / 528, rem = it % 528; if (IT_ON(2)) attn_item<96, false>(P, l, bl, rem / 66, rem % 66, smem); continue; }
        it -= N_ATT;
        { const int bl = it / 528, rem = it % 528; if (IT_ON(3)) attn_item<64, true>(P, l, bl, rem / 66, rem % 66, smem); }
    }
}

__device__ void phase_scanfin(const Params& P, int ph, int l) {
    const int tid = tid_opaque(), lane = tid & 63, wave = tid >> 6;
    bf16_t* PB = (bf16_t*)(P.ws + OFF_PB);
    for (;;) {
        const int u = next_item(P, ph);
        if (u >= NTH / 16) break;
        for (int rr = 0; rr < 8; ++rr) {
            const int w = u * 32 + wave * 8 + rr, t = w >> 1, mx = w & 1;
            const bf16_t* OS = (const bf16_t*)(P.ws + (mx ? OFF_OSG : OFF_KV));
            float a[8], b[8];
            unpack8(*(const uint4*)(OS + (size_t)t * 512 + lane * 8), a);
            unpack8(*(const uint4*)(OS + ((size_t)NTH + t) * 512 + lane * 8), b);
            float ss = 0.f;
#pragma unroll
            for (int e = 0; e < 8; ++e) { a[e] += b[e]; ss += a[e] * a[e]; }
            ss += __shfl_xor(ss, 1); ss += __shfl_xor(ss, 2); ss += __shfl_xor(ss, 4); ss += __shfl_xor(ss, 8);
            const float rn = rsqrtf(ss * (1.f / 128.f) + EPS);
            const float* g = (mx ? P.gla_g_o : P.hg_g_o) + l * 128 + (lane & 15) * 8;
            bf16_t* zp = PB + (size_t)t * PW + C_Z + (2 + mx) * 512 + lane * 8;
            float z[8];
            unpack8(*(const uint4*)zp, z);
#pragma unroll
            for (int e = 0; e < 8; ++e) a[e] = a[e] * rn * g[e] * siluf_(z[e]);
            *(uint4*)zp = pack8(a);
        }
    }
}

__device__ void phase_merge(const Params& P, int ph, int l, unsigned char* smem) {
    const int tid_ = tid_opaque(), lane = tid_ & 63, wave = tid_ >> 6, wr = wave >> 1, wc = wave & 1;
    const bf16_t* H = (const bf16_t*)(P.ws + OFF_H);
    const bf16_t* PB = (const bf16_t*)(P.ws + OFF_PB);
    bf16_t* ACC = (bf16_t*)(P.ws + OFF_KV);
    for (;;) {
        const int u = next_item(P, ph);
        if (u >= 132 * 8) break;
        const int mt = u >> 3, nt = u & 7;
        f32x16 tot[2][2]; zero_acc(tot);
        for (int br = 0; br < 4; ++br) {
            unsigned gate[2][2][8];
            {
                f32x16 g[2][2]; zero_acc(g);
                gemm_tile(g, H + (size_t)mt * 128 * D, D, (const bf16_t*)(P.ws + OFF_WM) + ((size_t)(l * 4 + br) * 1024 + nt * 128) * 1024, 1024, 1024, smem);
#pragma unroll
                for (int mi = 0; mi < 2; ++mi)
#pragma unroll
                    for (int ni = 0; ni < 2; ++ni) {
                        const float bm = P.b_merge[(l * 4 + br) * 1024 + nt * 128 + ACC_COL(ni)];
#pragma unroll
                        for (int r = 0; r < 8; ++r) gate[mi][ni][r] = cvt_pk(sigmoidf_(g[mi][ni][2 * r] + bm), sigmoidf_(g[mi][ni][2 * r + 1] + bm));
                    }
            }
            f32x16 pa[2][2]; zero_acc(pa);
            gemm_tile(pa, PB + (size_t)mt * 128 * PW + C_Z + br * 512, PW, (const bf16_t*)(P.ws + OFF_WBR) + ((size_t)(l * 4 + br) * 1024 + nt * 128) * 512, 512, 512, smem);
#pragma unroll
            for (int mi = 0; mi < 2; ++mi)
#pragma unroll
                for (int ni = 0; ni < 2; ++ni)
#pragma unroll
                    for (int r = 0; r < 8; ++r) {
                        tot[mi][ni][2 * r] = fmaf(lo16(gate[mi][ni][r]), pa[mi][ni][2 * r], tot[mi][ni][2 * r]);
                        tot[mi][ni][2 * r + 1] = fmaf(hi16(gate[mi][ni][r]), pa[mi][ni][2 * r + 1], tot[mi][ni][2 * r + 1]);
                    }
        }
#pragma unroll
        for (int mi = 0; mi < 2; ++mi)
#pragma unroll
            for (int ni = 0; ni < 2; ++ni)
#pragma unroll
                for (int r = 0; r < 16; ++r) ACC[(size_t)(mt * 128 + ACC_ROW(mi, r)) * 1024 + nt * 128 + ACC_COL(ni)] = f2bf(tot[mi][ni][r]);
    }
}

__device__ void phase_out(const Params& P, int ph, int l, int hf, unsigned char* smem) {
    const int tid_ = tid_opaque(), lane = tid_ & 63, wave = tid_ >> 6, wr = wave >> 1, wc = wave & 1;
    const bf16_t* ACC = (const bf16_t*)(P.ws + OFF_KV);
    const float* mod = (const float*)(P.ws + OFF_MOD);
    for (;;) {
        const int u = next_item(P, ph);
        if (u >= 132 * 8) break;
        const int mt = u >> 3, nt = u & 7;
        const int t0 = mt * 128, bl = t0 / TB, p0 = t0 % TB, b = hf * 2 + bl;
        const bool isctx = p0 < CTXL;
        if (isctx && l == 1) continue;
        f32x16 acc[2][2]; zero_acc(acc);
        gemm_tile(acc, ACC + (size_t)mt * 128 * 1024, 1024, (const bf16_t*)(P.ws + OFF_WO) + ((size_t)l * 1024 + nt * 128) * 1024, 1024, 1024, smem);
        const float* gt = mod + (l * 5 + (isctx ? 4 : b)) * 3072 + 2048 + nt * 128;
        const float* src; float* dst;
        if (isctx) { src = P.ctx + ((size_t)b * CTXL + p0) * D; dst = (float*)(P.ws + OFF_CX1) + ((size_t)b * CTXL + p0) * D; }
        else { const size_t o = ((size_t)b * SEQ + (p0 - CTXL)) * D; src = (l == 0 ? P.x : (const float*)P.out) + o; dst = P.out + o; }
#pragma unroll
        for (int mi = 0; mi < 2; ++mi)
#pragma unroll
            for (int ni = 0; ni < 2; ++ni) {
                const int cl = ACC_COL(ni);
                const float g = gt[cl];
#pragma unroll
                for (int r = 0; r < 16; ++r) { const size_t o = (size_t)ACC_ROW(mi, r) * D + nt * 128 + cl; dst[o] = src[o] + g * acc[mi][ni][r]; }
            }
    }
}

__global__ void __launch_bounds__(256, 2) mega(Params P) {
    extern __shared__ __attribute__((aligned(16))) unsigned char smem[];
    for (int ph = P.ph_lo; ph < P.ph_hi; ++ph) {
        if (ph > P.ph_lo) cg::this_grid().sync();
#ifdef ONLYP
#define PH_ON(n) ((ONLYP >> (n)) & 1)
#else
#define PH_ON(n) true
#endif
        if (ph == 0) { if (PH_ON(8)) phase_prologue(P, ph, smem); continue; }
        const int q = ph - 1, pass = q >> 3, sub = q & 7, l = pass >> 1, hf = pass & 1;
        switch (sub) {
            case 0: if (PH_ON(0)) phase_norm(P, ph, l, hf); break;
            case 1: if (PH_ON(1)) phase_gemm1(P, ph, l, smem); break;
            case 2: if (PH_ON(2)) phase_gemm2(P, ph, l, smem); break;
            case 3: if (PH_ON(3)) phase_finalize(P, ph, l, smem); break;
            case 4: if (PH_ON(4)) phase_mixers(P, ph, l, smem); break;
            case 5: if (PH_ON(5)) phase_scanfin(P, ph, l); break;
            case 6: if (PH_ON(6)) phase_merge(P, ph, l, smem); break;
            default: if (PH_ON(7)) phase_out(P, ph, l, hf, smem); break;
        }
    }
}

extern "C" void kernel_launch(void* const* d_in, const int* in_sizes, int n_in, void* d_out, int out_size, void* d_ws, size_t ws_size, hipStream_t stream) {
    static int grid = 0;
    if (grid == 0) {
        if (ws_size < WS_END) { fprintf(stderr, "workspace too small: %zu < %zu\n", ws_size, (size_t)WS_END); grid = -1; return; }
        int dev = 0, cus = 0, per_cu = 0;
        hipGetDevice(&dev);
        hipDeviceGetAttribute(&cus, hipDeviceAttributeMultiprocessorCount, dev);
        hipFuncSetAttribute((const void*)mega, hipFuncAttributeMaxDynamicSharedMemorySize, LDS_BYTES);
        hipOccupancyMaxActiveBlocksPerMultiprocessor(&per_cu, (const void*)mega, 256, LDS_BYTES);
        if (per_cu < 1) per_cu = 1;
        if (per_cu > 2) per_cu = 2;
        grid = cus * per_cu;
        (void)hipGetLastError();
    }
    if (grid < 0) return;
    hipMemsetAsync((unsigned char*)d_ws + OFF_CTL, 0, 4096, stream);
    Params p{};
    const float** pp = (const float**)&p;
    for (int i = 0; i < 26; ++i) pp[i] = (const float*)d_in[i];
    p.out = (float*)d_out; p.ws = (unsigned char*)d_ws;
#if SINGLE_LAUNCH
    p.ph_lo = 0; p.ph_hi = NPHASE;
    void* args[] = {&p};
    hipError_t e = hipLaunchCooperativeKernel((const void*)mega, dim3(grid), dim3(256), args, LDS_BYTES, stream);
    if (e != hipSuccess) fprintf(stderr, "cooperative launch failed: %s (grid %d)\n", hipGetErrorString(e), grid);
#else
    for (int ph = 0; ph < NPHASE; ++ph) {
        p.ph_lo = ph; p.ph_hi = ph + 1;
        hipLaunchKernelGGL(mega, dim3(grid), dim3(256), LDS_BYTES, stream, p);
    }
#endif
}
```

```cpp
#include <hip/hip_runtime.h>
#include <hip/hip_cooperative_groups.h>
#include <stdint.h>
#include <stdio.h>
namespace cg = cooperative_groups;

typedef unsigned short bf16_t;
typedef short bf16x8 __attribute__((ext_vector_type(8)));
typedef short bf16x4 __attribute__((ext_vector_type(4)));
typedef float f32x16 __attribute__((ext_vector_type(16)));

#ifndef SINGLE_LAUNCH
#define SINGLE_LAUNCH 1
#endif

constexpr int D = 1024, SEQ = 8192, CTXL = 256, TB = SEQ + CTXL  , NTH = 2 * TB  ;
constexpr int INW = 7104, PW = 7104;
constexpr int C_CQ = 0, C_CKV = 256, C_KR = 384, C_NQ = 416, C_NK = 928, C_NV = 1440, C_HQ = 1952, C_HF = 2464, C_HI = 3488,
              C_GQ = 4000, C_GK = 4256, C_GV = 4512, C_GR = 5024, C_Z = 5056;
constexpr float EPS = 1e-6f;
constexpr float LOG2E = 1.4426950408889634f;
constexpr int LDS_BYTES = 73728;
#ifdef SPLIT_MIX
constexpr int NPHASE = 37;
#else
constexpr int NPHASE = 33;
#endif

constexpr size_t al256(size_t v) { return (v + 255) & ~(size_t)255; }
constexpr size_t OFF_CTL = 0;
constexpr size_t OFF_TAB = 1024;
constexpr size_t OFF_MOD = 4096;
constexpr size_t OFF_CX1 = al256(OFF_MOD + 2 * 5 * 3072 * 4);
constexpr size_t OFF_WIN = al256(OFF_CX1 + (size_t)4 * 256 * 1024 * 4);
constexpr size_t OFF_WM = al256(OFF_WIN + (size_t)2 * 7168 * 1024 * 2);
constexpr size_t OFF_WBR = al256(OFF_WM + (size_t)8 * 1024 * 1024 * 2);
constexpr size_t OFF_WO = al256(OFF_WBR + (size_t)8 * 1024 * 512 * 2);
constexpr size_t OFF_WUQ = al256(OFF_WO + (size_t)2 * 1024 * 1024 * 2);
constexpr size_t OFF_WUKV = al256(OFF_WUQ + (size_t)2 * 768 * 256 * 2);
constexpr size_t OFF_H = al256(OFF_WUKV + (size_t)2 * 1024 * 128 * 2);
constexpr size_t OFF_PB = al256(OFF_H + (size_t)NTH * 1024 * 2);
constexpr size_t OFF_QF = al256(OFF_PB + (size_t)NTH * PW * 2);
constexpr size_t OFF_KV = al256(OFF_QF + (size_t)NTH * 768 * 2);
constexpr size_t OFF_KF = al256(OFF_KV + (size_t)NTH * 1024 * 2);
constexpr size_t OFF_VTM = al256(OFF_KF + (size_t)NTH * 768 * 2);
constexpr size_t OFF_VTN = al256(OFF_VTM + (size_t)2 * 8 * 64 * TB * 2);
constexpr size_t OFF_OSG = al256(OFF_VTN + (size_t)2 * 8 * 64 * TB * 2);
constexpr size_t OFF_XH = al256(OFF_OSG + (size_t)2 * NTH * 512 * 2);
constexpr size_t OFF_XG = al256(OFF_XH + (size_t)NTH * 512 * 2);
constexpr size_t OFF_EBH = al256(OFF_XG + (size_t)NTH * 512 * 2);
constexpr size_t OFF_EBG = al256(OFF_EBH + (size_t)528 * 2 * 512 * 4);
constexpr size_t WS_END = al256(OFF_EBG + (size_t)528 * 2 * 256 * 4);

static_assert(WS_END <= (size_t)512 * 1024 * 1024, "workspace map exceeds 512 MiB");
struct Params {
    const float *x, *c, *ctx, *c_ctx, *ada_w, *ada_b, *norm_g, *w_in, *w_uq, *w_ukv, *g_cq, *g_ckv, *g_q, *g_k, *rpb, *ng_q, *ng_k,
        *lb_logits, *hg_g_o, *gla_w2, *gla_b2, *gla_g_o, *w_br, *w_merge, *b_merge, *w_out;
    float* out;
    unsigned char* ws;
    int ph_lo, ph_hi;
};

__device__ __forceinline__ float bf2f(bf16_t v) { return __uint_as_float(((unsigned)v) << 16); }
typedef float f32x2_t __attribute__((ext_vector_type(2)));
typedef __bf16 bf16x2_t __attribute__((ext_vector_type(2)));
__device__ __forceinline__ unsigned cvt_pk(float lo, float hi) { f32x2_t v = {lo, hi}; bf16x2_t b = __builtin_convertvector(v, bf16x2_t); return __builtin_bit_cast(unsigned, b); }
__device__ __forceinline__ unsigned cvt_pk_asm(float lo, float hi) { unsigned r; asm("s_nop 1\n\tv_cvt_pk_bf16_f32 %0, %1, %2" : "=v"(r) : "v"(lo), "v"(hi)); return r; }
__device__ __forceinline__ bf16_t f2bf(float f) { return (bf16_t)(cvt_pk(f, 0.f) & 0xffffu); }
__device__ __forceinline__ float lo16(unsigned u) { return __uint_as_float(u << 16); }
__device__ __forceinline__ float hi16(unsigned u) { return __uint_as_float(u & 0xffff0000u); }
__device__ __forceinline__ float sigmoidf_(float x) { return 1.f / (1.f + __expf(-x)); }
__device__ __forceinline__ float siluf_(float x) { return x / (1.f + __expf(-x)); }
__device__ __forceinline__ float wave_sum(float v) {
#pragma unroll
    for (int o = 32; o > 0; o >>= 1) v += __shfl_xor(v, o);
    return v;
}
__device__ __forceinline__ void unpack8(uint4 u, float* f) {
    f[0] = lo16(u.x); f[1] = hi16(u.x); f[2] = lo16(u.y); f[3] = hi16(u.y); f[4] = lo16(u.z); f[5] = hi16(u.z); f[6] = lo16(u.w); f[7] = hi16(u.w);
}
__device__ __forceinline__ uint4 pack8(const float* f) { uint4 u; u.x = cvt_pk(f[0], f[1]); u.y = cvt_pk(f[2], f[3]); u.z = cvt_pk(f[4], f[5]); u.w = cvt_pk(f[6], f[7]); return u; }

__device__ __forceinline__ int tid_opaque() { int t = threadIdx.x; asm volatile("" : "+v"(t)); return t; }
__shared__ int s_item;
__device__ __forceinline__ int next_item(const Params& P, int ph) {
    __syncthreads();
    if (threadIdx.x == 0) s_item = atomicAdd((int*)(P.ws + OFF_CTL) + ph, 1);
    __syncthreads();
    return s_item;
}

constexpr int GS = 72;
__device__ __forceinline__ void gemm_tile(f32x16 (&acc)[2][2], const bf16_t* __restrict__ A, int lda, const bf16_t* __restrict__ Bt, int ldb, int K, unsigned char* smem) {
    const int tid = tid_opaque(), lane = tid & 63, wave = tid >> 6, wr = wave >> 1, wc = wave & 1;
    bf16_t* sA = (bf16_t*)smem;
    bf16_t* sB = sA + 2 * 128 * GS;
    const int lrow = tid >> 3, lch = (tid & 7) * 8;
    uint4 ra[4], rb[4];
    const bf16_t* Ap = A + (size_t)lrow * lda + lch;
    const bf16_t* Bp = Bt + (size_t)lrow * ldb + lch;
#pragma unroll
    for (int i = 0; i < 4; ++i) { ra[i] = *(const uint4*)(Ap + (size_t)(32 * i) * lda); rb[i] = *(const uint4*)(Bp + (size_t)(32 * i) * ldb); }
#pragma unroll
    for (int i = 0; i < 4; ++i) { *(uint4*)(sA + (lrow + 32 * i) * GS + lch) = ra[i]; *(uint4*)(sB + (lrow + 32 * i) * GS + lch) = rb[i]; }
    __syncthreads();
    const int nk = K >> 6;
    const int aoff = (wr * 64 + (lane & 31)) * GS + (lane >> 5) * 8, boff = (wc * 64 + (lane & 31)) * GS + (lane >> 5) * 8;
    for (int kt = 0; kt < nk; ++kt) {
        const bool more = kt + 1 < nk;
        if (more) {
#pragma unroll
            for (int i = 0; i < 4; ++i) { ra[i] = *(const uint4*)(Ap + (size_t)(32 * i) * lda + (kt + 1) * 64); rb[i] = *(const uint4*)(Bp + (size_t)(32 * i) * ldb + (kt + 1) * 64); }
        }
        const bf16_t* a = sA + (kt & 1) * 128 * GS + aoff;
        const bf16_t* b = sB + (kt & 1) * 128 * GS + boff;
#pragma unroll
        for (int ks = 0; ks < 4; ++ks) {
            bf16x8 a0 = *(const bf16x8*)(a + ks * 16), a1 = *(const bf16x8*)(a + 32 * GS + ks * 16);
            bf16x8 b0 = *(const bf16x8*)(b + ks * 16), b1 = *(const bf16x8*)(b + 32 * GS + ks * 16);
            acc[0][0] = __builtin_amdgcn_mfma_f32_32x32x16_bf16(a0, b0, acc[0][0], 0, 0, 0);
            acc[0][1] = __builtin_amdgcn_mfma_f32_32x32x16_bf16(a0, b1, acc[0][1], 0, 0, 0);
            acc[1][0] = __builtin_amdgcn_mfma_f32_32x32x16_bf16(a1, b0, acc[1][0], 0, 0, 0);
            acc[1][1] = __builtin_amdgcn_mfma_f32_32x32x16_bf16(a1, b1, acc[1][1], 0, 0, 0);
        }
        if (more) {
            bf16_t* wa = sA + ((kt + 1) & 1) * 128 * GS;
            bf16_t* wb = sB + ((kt + 1) & 1) * 128 * GS;
#pragma unroll
            for (int i = 0; i < 4; ++i) { *(uint4*)(wa + (lrow + 32 * i) * GS + lch) = ra[i]; *(uint4*)(wb + (lrow + 32 * i) * GS + lch) = rb[i]; }
        }
        __syncthreads();
    }
}

__device__ __forceinline__ void gemm_tile_pf2(f32x16 (&acc)[2][2], const bf16_t* __restrict__ A, int lda, const bf16_t* __restrict__ Bt, int ldb, int K, unsigned char* smem) {
    const int tid = tid_opaque(), lane = tid & 63, wave = tid >> 6, wr = wave >> 1, wc = wave & 1;
    bf16_t* sA = (bf16_t*)smem;
    bf16_t* sB = sA + 2 * 128 * GS;
    const int lrow = tid >> 3, lch = (tid & 7) * 8;
    uint4 pa0, pa1, pa2, pa3, pb0, pb1, pb2, pb3, qa0, qa1, qa2, qa3, qb0, qb1, qb2, qb3;
    const bf16_t* Ap = A + (size_t)lrow * lda + lch;
    const bf16_t* Bp = Bt + (size_t)lrow * ldb + lch;
    const int nk = K >> 6;
#define PF2_LD1(RA, RB, kt_, i) { RA##i = *(const uint4*)(Ap + (size_t)(32 * i) * lda + (kt_) * 64); RB##i = *(const uint4*)(Bp + (size_t)(32 * i) * ldb + (kt_) * 64); }
#define PF2_LOAD(RA, RB, kt_) { PF2_LD1(RA, RB, kt_, 0) PF2_LD1(RA, RB, kt_, 1) PF2_LD1(RA, RB, kt_, 2) PF2_LD1(RA, RB, kt_, 3) }
#define PF2_WR1(RA, RB, i) { *(uint4*)(wa + (lrow + 32 * i) * GS + lch) = RA##i; *(uint4*)(wb + (lrow + 32 * i) * GS + lch) = RB##i; }
#define PF2_WRITE(RA, RB, buf_) { bf16_t* wa = sA + (buf_) * 128 * GS; bf16_t* wb = sB + (buf_) * 128 * GS; PF2_WR1(RA, RB, 0) PF2_WR1(RA, RB, 1) PF2_WR1(RA, RB, 2) PF2_WR1(RA, RB, 3) }
#define PF2_COMPUTE(buf_) { const bf16_t* a = sA + (buf_) * 128 * GS + aoff; const bf16_t* b = sB + (buf_) * 128 * GS + boff; _Pragma("unroll") for (int ks = 0; ks < 4; ++ks) { \
        bf16x8 a0 = *(const bf16x8*)(a + ks * 16), a1 = *(const bf16x8*)(a + 32 * GS + ks * 16); bf16x8 b0 = *(const bf16x8*)(b + ks * 16), b1 = *(const bf16x8*)(b + 32 * GS + ks * 16); \
        acc[0][0] = __builtin_amdgcn_mfma_f32_32x32x16_bf16(a0, b0, acc[0][0], 0, 0, 0); acc[0][1] = __builtin_amdgcn_mfma_f32_32x32x16_bf16(a0, b1, acc[0][1], 0, 0, 0); \
        acc[1][0] = __builtin_amdgcn_mfma_f32_32x32x16_bf16(a1, b0, acc[1][0], 0, 0, 0); acc[1][1] = __builtin_amdgcn_mfma_f32_32x32x16_bf16(a1, b1, acc[1][1], 0, 0, 0); } }
    const int aoff = (wr * 64 + (lane & 31)) * GS + (lane >> 5) * 8, boff = (wc * 64 + (lane & 31)) * GS + (lane >> 5) * 8;
    PF2_LOAD(pa, pb, 0);
    PF2_LOAD(qa, qb, 1);
    PF2_WRITE(pa, pb, 0);
    __syncthreads();
    for (int kt = 0; kt < nk; kt += 2) {
        if (kt + 2 < nk) PF2_LOAD(pa, pb, kt + 2);
        PF2_COMPUTE(0);
        PF2_WRITE(qa, qb, 1);
        __syncthreads();
        if (kt + 3 < nk) PF2_LOAD(qa, qb, kt + 3);
        PF2_COMPUTE(1);
        if (kt + 2 < nk) PF2_WRITE(pa, pb, 0);
        __syncthreads();
    }
#undef PF2_LOAD
#undef PF2_LD1
#undef PF2_WR1
#undef PF2_WRITE
#undef PF2_COMPUTE
}

__device__ __forceinline__ void gemm_tile_n64(f32x16 (&acc)[2], const bf16_t* __restrict__ A, int lda, const bf16_t* __restrict__ Bt, int ldb, int K, unsigned char* smem) {
    const int tid = tid_opaque(), lane = tid & 63, wave = tid >> 6, wr = wave >> 1, wc = wave & 1;
    bf16_t* sA = (bf16_t*)smem;
    bf16_t* sB = sA + 2 * 128 * GS;
    const int lrow = tid >> 3, lch = (tid & 7) * 8;
    uint4 pa0, pa1, pa2, pa3, pb0, pb1, qa0, qa1, qa2, qa3, qb0, qb1;
    const bf16_t* Ap = A + (size_t)lrow * lda + lch;
    const bf16_t* Bp = Bt + (size_t)lrow * ldb + lch;
    const int nk = K >> 6;
#define N64_LOAD(RA, RB, kt_) { RA##0 = *(const uint4*)(Ap + (kt_) * 64); RA##1 = *(const uint4*)(Ap + (size_t)32 * lda + (kt_) * 64); RA##2 = *(const uint4*)(Ap + (size_t)64 * lda + (kt_) * 64); RA##3 = *(const uint4*)(Ap + (size_t)96 * lda + (kt_) * 64); \
        RB##0 = *(const uint4*)(Bp + (kt_) * 64); RB##1 = *(const uint4*)(Bp + (size_t)32 * ldb + (kt_) * 64); }
#define N64_WRITE(RA, RB, buf_) { bf16_t* wa = sA + (buf_) * 128 * GS + lrow * GS + lch; bf16_t* wb = sB + (buf_) * 64 * GS + lrow * GS + lch; \
        *(uint4*)wa = RA##0; *(uint4*)(wa + 32 * GS) = RA##1; *(uint4*)(wa + 64 * GS) = RA##2; *(uint4*)(wa + 96 * GS) = RA##3; *(uint4*)wb = RB##0; *(uint4*)(wb + 32 * GS) = RB##1; }
#define N64_COMPUTE(buf_) { const bf16_t* a = sA + (buf_) * 128 * GS + aoff; const bf16_t* b = sB + (buf_) * 64 * GS + boff; _Pragma("unroll") for (int ks = 0; ks < 4; ++ks) { \
        bf16x8 a0 = *(const bf16x8*)(a + ks * 16), a1 = *(const bf16x8*)(a + 32 * GS + ks * 16); bf16x8 b0 = *(const bf16x8*)(b + ks * 16); \
        acc[0] = __builtin_amdgcn_mfma_f32_32x32x16_bf16(a0, b0, acc[0], 0, 0, 0); acc[1] = __builtin_amdgcn_mfma_f32_32x32x16_bf16(a1, b0, acc[1], 0, 0, 0); } }
    const int aoff = (wr * 64 + (lane & 31)) * GS + (lane >> 5) * 8, boff = (wc * 32 + (lane & 31)) * GS + (lane >> 5) * 8;
    N64_LOAD(pa, pb, 0);
    N64_LOAD(qa, qb, 1);
    N64_WRITE(pa, pb, 0);
    __syncthreads();
    for (int kt = 0; kt < nk; kt += 2) {
        if (kt + 2 < nk) N64_LOAD(pa, pb, kt + 2);
        N64_COMPUTE(0);
        N64_WRITE(qa, qb, 1);
        __syncthreads();
        if (kt + 3 < nk) N64_LOAD(qa, qb, kt + 3);
        N64_COMPUTE(1);
        if (kt + 2 < nk) N64_WRITE(pa, pb, 0);
        __syncthreads();
    }
#undef N64_LOAD
#undef N64_WRITE
#undef N64_COMPUTE
}
__device__ __forceinline__ void zero_acc(f32x16 (&acc)[2][2]) {
#pragma unroll
    for (int i = 0; i < 2; ++i)
#pragma unroll
        for (int j = 0; j < 2; ++j)
#pragma unroll
            for (int r = 0; r < 16; ++r) acc[i][j][r] = 0.f;
}
#define ACC_ROW(mi, r) (wr * 64 + (mi) * 32 + ((r) & 3) + 8 * ((r) >> 2) + 4 * (lane >> 5))
#define ACC_COL(ni) (wc * 64 + (ni) * 32 + (lane & 31))

__device__ void tr_tile(const float* __restrict__ src, int K, int N, int kt, int nt, bf16_t* __restrict__ dst, const float* __restrict__ scale, float* s) {
    const int tid = tid_opaque(), r = tid >> 4, c4 = (tid & 15) * 4;
#pragma unroll
    for (int i = 0; i < 4; ++i) {
        const int k = kt * 64 + r + 16 * i;
        float4 v = *(const float4*)(src + (size_t)k * N + nt * 64 + c4);
        const float sc = scale ? scale[k] : 1.f;
        float* d = s + (r + 16 * i) * 65 + c4;
        d[0] = v.x * sc; d[1] = v.y * sc; d[2] = v.z * sc; d[3] = v.w * sc;
    }
    __syncthreads();
    const int n = tid >> 2, k0 = (tid & 3) * 16;
    float f[16];
#pragma unroll
    for (int j = 0; j < 16; ++j) f[j] = s[(k0 + j) * 65 + n];
    bf16_t* o = dst + (size_t)(nt * 64 + n) * K + kt * 64 + k0;
    *(uint4*)o = pack8(f);
    *(uint4*)(o + 8) = pack8(f + 8);
    __syncthreads();
}
__device__ void phase_prologue(const Params& P, int ph, unsigned char* smem) {
    float* s = (float*)smem;
    const int NTR = 7296, NMOD = 96;
    for (;;) {
        const int u = next_item(P, ph);
        if (u >= NTR + NMOD) break;
        if (u < NMOD) {
            const int l = u / 48, cb = u % 48, tid = threadIdx.x, lane = tid & 63, wave = tid >> 6;
            float* sc = s;
            float* red = s + 5 * 1024;
            for (int i = tid; i < 5 * 1024; i += 256) { const int r = i >> 10, k = i & 1023; const float v = (r < 4) ? P.c[r * 1024 + k] : P.c_ctx[k]; sc[i] = siluf_(v); }
            __syncthreads();
            const int col = cb * 64 + lane;
            float acc[5] = {0.f, 0.f, 0.f, 0.f, 0.f};
            const float* w = P.ada_w + (size_t)l * 1024 * 3072 + col;
#pragma unroll 8
            for (int k = wave * 256; k < wave * 256 + 256; ++k) {
                const float wv = w[(size_t)k * 3072];
#pragma unroll
                for (int r = 0; r < 5; ++r) acc[r] += sc[r * 1024 + k] * wv;
            }
#pragma unroll
            for (int r = 0; r < 5; ++r) red[(wave * 5 + r) * 64 + lane] = acc[r];
            __syncthreads();
            if (wave == 0) {
                float* mod = (float*)(P.ws + OFF_MOD);
#pragma unroll
                for (int r = 0; r < 5; ++r) mod[(l * 5 + r) * 3072 + col] = red[r * 64 + lane] + red[(5 + r) * 64 + lane] + red[(10 + r) * 64 + lane] + red[(15 + r) * 64 + lane] + P.ada_b[l * 3072 + col];
            }
            continue;
        }
        const int v = u - NMOD, l = v / 3648, r = v % 3648;
        if (r < 1776) tr_tile(P.w_in + (size_t)l * 1024 * INW, 1024, INW, r / 111, r % 111, (bf16_t*)(P.ws + OFF_WIN) + (size_t)l * 7168 * 1024, nullptr, s);
        else if (r < 2800) { const int r2 = r - 1776, br = r2 >> 8, t = r2 & 255; tr_tile(P.w_merge + (size_t)(l * 4 + br) * 1024 * 1024, 1024, 1024, t >> 4, t & 15, (bf16_t*)(P.ws + OFF_WM) + (size_t)(l * 4 + br) * 1024 * 1024, nullptr, s); }
        else if (r < 3312) { const int r2 = r - 2800, br = r2 >> 7, t = r2 & 127; tr_tile(P.w_br + (size_t)(l * 4 + br) * 512 * 1024, 512, 1024, t >> 4, t & 15, (bf16_t*)(P.ws + OFF_WBR) + (size_t)(l * 4 + br) * 1024 * 512, nullptr, s); }
        else if (r < 3568) { const int t = r - 3312; tr_tile(P.w_out + (size_t)l * 1024 * 1024, 1024, 1024, t >> 4, t & 15, (bf16_t*)(P.ws + OFF_WO) + (size_t)l * 1024 * 1024, nullptr, s); }
        else if (r < 3616) { const int t = r - 3568; tr_tile(P.w_uq + (size_t)l * 256 * 768, 256, 768, t / 12, t % 12, (bf16_t*)(P.ws + OFF_WUQ) + (size_t)l * 768 * 256, P.g_cq + l * 256, s); }
        else { const int t = r - 3616; tr_tile(P.w_ukv + (size_t)l * 128 * 1024, 128, 1024, t >> 4, t & 15, (bf16_t*)(P.ws + OFF_WUKV) + (size_t)l * 1024 * 128, P.g_ckv + l * 128, s); }
    }
}

__device__ void phase_norm(const Params& P, int ph, int l, int hf) {
    const int tid = tid_opaque(), lane = tid & 63, wave = tid >> 6;
    const float* mod = (const float*)(P.ws + OFF_MOD);
    bf16_t* H = (bf16_t*)(P.ws + OFF_H);
    for (;;) {
        const int u = next_item(P, ph);
        if (u >= NTH / 8) break;
        for (int rr = 0; rr < 2; ++rr) {
            const int t = u * 8 + wave * 2 + rr, bl = t / TB, p = t % TB, b = hf * 2 + bl;
            const float* src; int mr;
            if (p < CTXL) { src = (l == 0 ? P.ctx : (const float*)(P.ws + OFF_CX1)) + ((size_t)b * CTXL + p) * D; mr = 4; }
            else { src = (l == 0 ? P.x : (const float*)P.out) + ((size_t)b * SEQ + (p - CTXL)) * D; mr = b; }
            float4 v[4]; float ss = 0.f;
#pragma unroll
            for (int i = 0; i < 4; ++i) { v[i] = *(const float4*)(src + lane * 4 + 256 * i); ss += v[i].x * v[i].x + v[i].y * v[i].y + v[i].z * v[i].z + v[i].w * v[i].w; }
            ss = wave_sum(ss);
            const float rstd = rsqrtf(ss * (1.f / D) + EPS);
            const float* sh = mod + (l * 5 + mr) * 3072; const float* sc = sh + 1024; const float* g = P.norm_g + l * D;
#pragma unroll
            for (int i = 0; i < 4; ++i) {
                const int c = lane * 4 + 256 * i;
                const float4 gv = *(const float4*)(g + c), s1 = *(const float4*)(sc + c), s0 = *(const float4*)(sh + c);
                uint2 o;
                o.x = cvt_pk(v[i].x * rstd * gv.x * (1.f + s1.x) + s0.x, v[i].y * rstd * gv.y * (1.f + s1.y) + s0.y);
                o.y = cvt_pk(v[i].z * rstd * gv.z * (1.f + s1.z) + s0.z, v[i].w * rstd * gv.w * (1.f + s1.w) + s0.w);
                *(uint2*)(H + (size_t)t * D + c) = o;
            }
        }
    }
}

__device__ void phase_gemm1(const Params& P, int ph, int l, unsigned char* smem) {
    const int tid_ = tid_opaque(), lane = tid_ & 63, wave = tid_ >> 6, wr = wave >> 1, wc = wave & 1;
    const bf16_t* H = (const bf16_t*)(P.ws + OFF_H);
    const bf16_t* W = (const bf16_t*)(P.ws + OFF_WIN) + (size_t)l * 7168 * 1024;
    bf16_t* PB = (bf16_t*)(P.ws + OFF_PB);
    for (;;) {
        const int u = next_item(P, ph);
        if (u >= 132 * 56) break;
        const int mt = u / 56, nt = u % 56;
        f32x16 acc[2][2]; zero_acc(acc);
        gemm_tile_pf2(acc, H + (size_t)mt * 128 * D, D, W + (size_t)nt * 128 * D, D, D, smem);
#pragma unroll
        for (int mi = 0; mi < 2; ++mi)
#pragma unroll
            for (int ni = 0; ni < 2; ++ni) {
                const int col = nt * 128 + ACC_COL(ni);
                if (col < PW) {
#pragma unroll
                    for (int r = 0; r < 16; ++r) PB[(size_t)(mt * 128 + ACC_ROW(mi, r)) * PW + col] = f2bf(acc[mi][ni][r]);
                }
            }
    }
}

__device__ void phase_gemm2(const Params& P, int ph, int l, unsigned char* smem) {
    const int tid_ = tid_opaque(), lane = tid_ & 63, wave = tid_ >> 6, wr = wave >> 1, wc = wave & 1;
    const bf16_t* PB = (const bf16_t*)(P.ws + OFF_PB);
    for (;;) {
        const int u = next_item(P, ph);
        if (u >= 132 * 14) break;
        const int mt = u / 14, n14 = u % 14;
        f32x16 acc[2][2]; zero_acc(acc);
        bf16_t* O; int ldo, nt;
        if (n14 < 6) { nt = n14; O = (bf16_t*)(P.ws + OFF_QF); ldo = 768;
            gemm_tile_pf2(acc, PB + (size_t)mt * 128 * PW + C_CQ, PW, (const bf16_t*)(P.ws + OFF_WUQ) + (size_t)l * 768 * 256 + (size_t)nt * 128 * 256, 256, 256, smem); }
        else { nt = n14 - 6; O = (bf16_t*)(P.ws + OFF_KV); ldo = 1024;
            gemm_tile_pf2(acc, PB + (size_t)mt * 128 * PW + C_CKV, PW, (const bf16_t*)(P.ws + OFF_WUKV) + (size_t)l * 1024 * 128 + (size_t)nt * 128 * 128, 128, 128, smem); }
#pragma unroll
        for (int mi = 0; mi < 2; ++mi)
#pragma unroll
            for (int ni = 0; ni < 2; ++ni)
#pragma unroll
                for (int r = 0; r < 16; ++r) O[(size_t)(mt * 128 + ACC_ROW(mi, r)) * ldo + nt * 128 + ACC_COL(ni)] = f2bf(acc[mi][ni][r]);
    }
}

__device__ void phase_finalize(const Params& P, int ph, int l, unsigned char* smem) {
    const int tid = tid_opaque(), lane = tid & 63, wave = tid >> 6;
    bf16_t* PB = (bf16_t*)(P.ws + OFF_PB);
    bf16_t* QF = (bf16_t*)(P.ws + OFF_QF);
    const bf16_t* KV = (const bf16_t*)(P.ws + OFF_KV);
    bf16_t* KF = (bf16_t*)(P.ws + OFF_KF);
    bf16_t* VTM = (bf16_t*)(P.ws + OFF_VTM);
    bf16_t* VTN = (bf16_t*)(P.ws + OFF_VTN);
    float* rs = (float*)smem;
    const int hd = lane >> 3, j = lane & 7;
    const float invf = __powf(10000.f, -(float)j * 0.125f);
    for (;;) {
        const int u7 = next_item(P, ph);
        if (u7 >= (NTH / 32) * 11) break;
        const int u = u7 / 11, sub = u7 % 11;
        const int t0 = u * 32, bl = t0 / TB, p0 = t0 % TB;
        if (sub >= 1 && sub <= 4) {
        for (int rr = 0; rr < 2; ++rr) {
            const int tl = (sub - 1) * 8 + wave * 2 + rr, t = t0 + tl, p = p0 + tl;
            bf16_t* prow = PB + (size_t)t * PW;
            float s1 = 0.f, s2 = 0.f;
            { const uint2 a = *(const uint2*)(prow + C_CQ + lane * 4); const float f0 = lo16(a.x), f1 = hi16(a.x), f2 = lo16(a.y), f3 = hi16(a.y); s1 = f0 * f0 + f1 * f1 + f2 * f2 + f3 * f3;
              const unsigned b = *(const unsigned*)(prow + C_CKV + lane * 2); const float g0 = lo16(b), g1 = hi16(b); s2 = g0 * g0 + g1 * g1; }
            s1 = wave_sum(s1); s2 = wave_sum(s2);
            const float rcq = rsqrtf(s1 * (1.f / 256.f) + EPS), rckv = rsqrtf(s2 * (1.f / 128.f) + EPS);
            if (lane == 0) rs[tl] = rckv;
            {
                bf16_t* q = QF + (size_t)t * 768 + hd * 96;
                float v[12], ss = 0.f;
#pragma unroll
                for (int m = 0; m < 12; ++m) { v[m] = bf2f(q[j + 8 * m]) * rcq; ss += v[m] * v[m]; }
                ss += __shfl_xor(ss, 1); ss += __shfl_xor(ss, 2); ss += __shfl_xor(ss, 4);
                const float rn = rsqrtf(ss * (1.f / 96.f) + EPS);
#pragma unroll
                for (int m = 0; m < 12; ++m) q[j + 8 * m] = f2bf(v[m] * rn * P.g_q[l * 96 + j + 8 * m]);
            }
            {
                const bf16_t* kvr = KV + (size_t)t * 1024 + hd * 128;
                float v[12], ss = 0.f;
#pragma unroll
                for (int m = 0; m < 8; ++m) { v[m] = bf2f(kvr[j + 8 * m]) * rckv; ss += v[m] * v[m]; }
#pragma unroll
                for (int m = 8; m < 12; ++m) { v[m] = bf2f(prow[C_KR + j + 8 * (m - 8)]); ss += v[m] * v[m]; }
                ss += __shfl_xor(ss, 1); ss += __shfl_xor(ss, 2); ss += __shfl_xor(ss, 4);
                const float rn = rsqrtf(ss * (1.f / 96.f) + EPS);
#pragma unroll
                for (int m = 0; m < 12; ++m) v[m] = v[m] * rn * P.g_k[l * 96 + j + 8 * m];
                if (p >= CTXL) {
                    const int pos = p - CTXL;
                    const float ar = (float)(pos >> 6) * invf, ac = (float)(pos & 63) * invf;
                    double fr = (double)ar * 0.15915494309189535; fr -= rint(fr);
                    double fc = (double)ac * 0.15915494309189535; fc -= rint(fc);
                    const float sr = __builtin_amdgcn_sinf((float)fr), cr = __builtin_amdgcn_cosf((float)fr);
                    const float sc = __builtin_amdgcn_sinf((float)fc), cc = __builtin_amdgcn_cosf((float)fc);
                    const float x1a = v[8], x2a = v[10], x1b = v[9], x2b = v[11];
                    v[8] = x1a * cr - x2a * sr; v[10] = x1a * sr + x2a * cr;
                    v[9] = x1b * cc - x2b * sc; v[11] = x1b * sc + x2b * cc;
                }
                bf16_t* ko = KF + ((size_t)t * 8 + hd) * 96;
#pragma unroll
                for (int m = 0; m < 12; ++m) ko[j + 8 * m] = f2bf(v[m]);
            }
#pragma unroll
            for (int w = 0; w < 2; ++w) {
                bf16_t* q = prow + (w ? C_NK : C_NQ) + hd * 64 + j * 8;
                const float* g = (w ? P.ng_k : P.ng_q) + l * 64 + j * 8;
                float v[8], ss = 0.f;
                unpack8(*(const uint4*)q, v);
#pragma unroll
                for (int m = 0; m < 8; ++m) ss += v[m] * v[m];
                ss += __shfl_xor(ss, 1); ss += __shfl_xor(ss, 2); ss += __shfl_xor(ss, 4);
                const float rn = rsqrtf(ss * (1.f / 64.f) + EPS);
#pragma unroll
                for (int m = 0; m < 8; ++m) v[m] = v[m] * rn * g[m];
                *(uint4*)q = pack8(v);
            }
        }
        } else if (sub == 0) {
        {
            for (int rr = 0; rr < 8; ++rr) {
                const int tl = wave * 8 + rr;
                const unsigned bq = *(const unsigned*)(PB + (size_t)(t0 + tl) * PW + C_CKV + lane * 2);
                const float g0 = lo16(bq), g1 = hi16(bq);
                const float s2 = wave_sum(g0 * g0 + g1 * g1);
                if (lane == 0) rs[tl] = rsqrtf(s2 * (1.f / 128.f) + EPS);
            }
            __syncthreads();
            bf16_t* tile = (bf16_t*)(smem + 8192);
#pragma unroll
            for (int which = 0; which < 2; ++which) {
#pragma unroll
                for (int k8 = 0; k8 < 8; ++k8) {
                    const int id = tid + 256 * k8, i = id >> 6, c8 = id & 63;
                    const bf16_t* src = which ? PB + (size_t)(t0 + i) * PW + C_NV + c8 * 8
                                              : KV + (size_t)(t0 + i) * 1024 + (c8 >> 3) * 128 + 64 + (c8 & 7) * 8;
                    *(uint4*)(tile + i * 512 + c8 * 8) = *(const uint4*)src;
                }
                __syncthreads();
                bf16_t* VT = which ? VTN : VTM;
#pragma unroll
                for (int k8 = 0; k8 < 8; ++k8) {
                    const int id = tid + 256 * k8, r = id >> 2, g = id & 3;
                    float fv[8];
#pragma unroll
                    for (int i = 0; i < 8; ++i) fv[i] = bf2f(tile[(g * 8 + i) * 512 + r]) * (which ? 1.f : rs[g * 8 + i]);
                    *(uint4*)(VT + ((size_t)(bl * 8 + (r >> 6)) * 64 + (r & 63)) * TB + p0 + g * 8) = pack8(fv);
                }
                __syncthreads();
            }
        }
        } else
        {
            const int chunk = t0 >> 5;
            bf16_t* XH = (bf16_t*)(P.ws + OFF_XH);
            bf16_t* XG = (bf16_t*)(P.ws + OFF_XG);
            float* EBH = (float*)(P.ws + OFF_EBH);
            float* EBG = (float*)(P.ws + OFF_EBG);
            bf16_t* base = PB + (size_t)t0 * PW;
            float* rsh = (float*)smem + 256;
            bf16_t* inA = (bf16_t*)(smem + 8192);
            bf16_t* inB = inA + 32 * 128;
            bf16_t* inC = inB + 32 * 128;
            bf16_t* outT = inC + 32 * 128;
#pragma unroll
            for (int k4 = 0; k4 < 4; ++k4) { const int id = tid + 256 * k4, i = id >> 5, jx = id & 31; rsh[id] = bf2f(base[(size_t)i * PW + C_GR + jx]); }
            const int d = tid & 127, dr = tid >> 7;
            { const int grp = sub - 5;
                const bool isg = grp >= 4;
                const int gcol = isg ? (grp - 4) * 128 : grp * 128;
                const int cA = isg ? C_GQ + gcol : C_HQ + gcol, cB = isg ? C_GK + gcol : C_HF + gcol, cC = C_HF + 512 + gcol;
#pragma unroll
                for (int k2 = 0; k2 < 2; ++k2) {
                    const int id = tid + 256 * k2, i = id >> 4, ch = id & 15;
                    const bf16_t* row = base + (size_t)i * PW;
                    *(uint4*)(inA + i * 128 + ch * 8) = *(const uint4*)(row + cA + ch * 8);
                    *(uint4*)(inB + i * 128 + ch * 8) = *(const uint4*)(row + cB + ch * 8);
                    if (!isg) *(uint4*)(inC + i * 128 + ch * 8) = *(const uint4*)(row + cC + ch * 8);
                }
                __syncthreads();
                {
                    const int col = gcol + d;
                    float lb = 0.f, b2 = 0.f, w2[16];
#pragma unroll
                    for (int jx = 0; jx < 16; ++jx) w2[jx] = 0.f;
                    if (isg) {
#pragma unroll
                        for (int jx = 0; jx < 16; ++jx) w2[jx] = P.gla_w2[((size_t)(l * 2 + dr) * 16 + jx) * 256 + col];
                        b2 = P.gla_b2[(l * 2 + dr) * 256 + col];
                    } else if (l != 0) lb = sigmoidf_(P.lb_logits[1024 + dr * 512 + col] - P.lb_logits[dr * 512 + col]);
                    const bf16_t* fsrc = (dr && !isg) ? inC : inB;
                    bf16_t* oq = outT + (dr ? 2 : 0) * 32 * 128;
                    bf16_t* ok = oq + 32 * 128;
                    float cum = 0.f;
#pragma unroll 4
                    for (int sx = 0; sx < 32; ++sx) {
                        const int i = dr ? 31 - sx : sx;
                        const float qv = bf2f(inA[i * 128 + d]), fv = bf2f(fsrc[i * 128 + d]);
                        float qq, kk, la;
                        if (isg) {
                            float g = b2;
#pragma unroll
                            for (int jx = 0; jx < 16; ++jx) g = fmaf(rsh[i * 32 + dr * 16 + jx], w2[jx], g);
                            la = (fminf(g, 0.f) - __logf(1.f + __expf(-fabsf(g)))) * 0.0625f;
                            qq = qv * 0.125f; kk = fv;
                        } else {
                            const float av = lb + (1.f - lb) * sigmoidf_(fv);
                            la = __logf(av); kk = 1.f - av;
                            qq = siluf_(qv) * 0.08838834764831845f;
                        }
                        cum += la;
                        oq[i * 128 + d] = f2bf(qq * __expf(cum));
                        ok[i * 128 + d] = f2bf(kk * __expf(-cum));
                    }
                    if (isg) EBG[(size_t)(chunk * 2 + dr) * 256 + col] = __expf(cum);
                    else EBH[(size_t)(chunk * 2 + dr) * 512 + col] = __expf(cum);
                }
                __syncthreads();
#pragma unroll
                for (int k2 = 0; k2 < 2; ++k2) {
                    const int id = tid + 256 * k2, i = id >> 4, ch = id & 15;
                    bf16_t* row = base + (size_t)i * PW;
                    const uint4 v0 = *(const uint4*)(outT + (0 * 32 + i) * 128 + ch * 8), v1 = *(const uint4*)(outT + (1 * 32 + i) * 128 + ch * 8);
                    const uint4 v2 = *(const uint4*)(outT + (2 * 32 + i) * 128 + ch * 8), v3 = *(const uint4*)(outT + (3 * 32 + i) * 128 + ch * 8);
                    *(uint4*)(row + cA + ch * 8) = v0;
                    *(uint4*)(row + cB + ch * 8) = v1;
                    if (isg) { bf16_t* xr = XG + (size_t)(t0 + i) * 512 + gcol + ch * 8; *(uint4*)xr = v2; *(uint4*)(xr + 256) = v3; }
                    else { *(uint4*)(XH + (size_t)(t0 + i) * 512 + gcol + ch * 8) = v2; *(uint4*)(row + cC + ch * 8) = v3; }
                }
                __syncthreads();
            }
        }
    }
}

template <int DQK, bool NAT>
__device__ void attn_item(const Params& P, int l, int bl, int head, int qb, unsigned char* smem) {
    constexpr int NKS = DQK / 16, KSTR = DQK + 8, VSTR = 68, KCH = DQK / 8, KLD = (DQK * 64 / 8) / 256;
    const int tid = tid_opaque(), lane = tid & 63, wave = tid >> 6, hh = lane >> 5, r32 = lane & 31;
    bf16_t* Ks = (bf16_t*)smem;
    bf16_t* Vs = Ks + 2 * 64 * KSTR;
    float* rpb_s = (float*)(Vs + 2 * 64 * VSTR);
    bf16_t* PB = (bf16_t*)(P.ws + OFF_PB);
    const int rowbase = bl * TB, q_p0 = qb * 128, ql = wave * 32 + r32;
    const bool q_ctx = qb < 2;
    int lt0 = 0, lt1 = 0;
    int qr = 0, qc = 0, r0w = 0, c0 = 0;
    if (!q_ctx) {
        if (NAT) { const int rp = qb - 2, ra = 2 * rp, rb = ra + 1; lt0 = min(max(ra - 4, 0), 120); lt1 = min(max(rb - 4, 0), 120) + 8;
            qr = ra + (wave >> 1); qc = (wave & 1) * 32 + r32; r0w = min(max(qr - 4, 0), 120); c0 = min(max(qc - 8, 0), 48); }
        else { lt0 = 0; lt1 = 128; }
    }
    const int ntiles = 4 + (lt1 - lt0);
    const bf16_t* Kbase; const bf16_t* VT; const bf16_t* qptr; int k_ld;
    if (NAT) { Kbase = PB + (size_t)rowbase * PW + C_NK + head * 64; k_ld = PW; VT = (const bf16_t*)(P.ws + OFF_VTN) + (size_t)(bl * 8 + head) * 64 * TB;
        qptr = PB + (size_t)(rowbase + q_p0 + ql) * PW + C_NQ + head * 64; }
    else { Kbase = (const bf16_t*)(P.ws + OFF_KF) + (size_t)rowbase * 768 + head * 96; k_ld = 768; VT = (const bf16_t*)(P.ws + OFF_VTM) + (size_t)(bl * 8 + head) * 64 * TB;
        qptr = (const bf16_t*)(P.ws + OFF_QF) + (size_t)(rowbase + q_p0 + ql) * 768 + head * 96; }
    if (NAT) { for (int i = tid; i < 465; i += 256) rpb_s[i] = P.rpb[(size_t)(l * 8 + head) * 465 + i] * LOG2E; }
    bf16x8 qf[NKS];
#pragma unroll
    for (int ks = 0; ks < NKS; ++ks) qf[ks] = *(const bf16x8*)(qptr + ks * 16 + hh * 8);
    bf16x8 qrot4 = qf[NKS - 2], qrot5 = qf[NKS - 1];
    if (!NAT && !q_ctx) {
        const int pos = q_p0 - CTXL + ql;
        const float base = hh ? (float)(pos & 63) : (float)(pos >> 6);
#pragma unroll
        for (int jj = 0; jj < 8; ++jj) {
            const float invf = __powf(10000.f, -(float)jj * 0.125f);
            const float ang = base * invf;
            double fr = (double)ang * 0.15915494309189535; fr -= rint(fr);
            const float sn = __builtin_amdgcn_sinf((float)fr), cs = __builtin_amdgcn_cosf((float)fr);
            const float x1 = bf2f((bf16_t)qf[4][jj]), x2 = bf2f((bf16_t)qf[5][jj]);
            qrot4[jj] = (short)f2bf(x1 * cs - x2 * sn);
            qrot5[jj] = (short)f2bf(x1 * sn + x2 * cs);
        }
    }
    const float sc2 = (NAT ? 0.125f : 0.10206207261596575f) * LOG2E;
    float m_run = -1e30f, lsum = 0.f;
    f32x16 oacc[2];
#pragma unroll
    for (int r = 0; r < 16; ++r) { oacc[0][r] = 0.f; oacc[1][r] = 0.f; }
    uint4 kreg0, kreg1, kreg2, vreg0, vreg1;
    kreg2 = make_uint4(0, 0, 0, 0);
    const int kid0 = tid, kid1 = tid + 256, kid2 = tid + 512;
    const int krow0 = kid0 / KCH, kch0 = kid0 % KCH, krow1 = kid1 / KCH, kch1 = kid1 % KCH, krow2 = kid2 / KCH, kch2 = kid2 % KCH;
    const int vrow0 = tid >> 3, vch = tid & 7, vrow1 = vrow0 + 32;
#define TILE_P(ti) ((ti) < 4 ? (ti) * 64 : CTXL + (lt0 + (ti) - 4) * 64)
#define GLOAD(ti) { const int p_ = TILE_P(ti); \
        kreg0 = *(const uint4*)(Kbase + (size_t)(p_ + krow0) * k_ld + kch0 * 8); \
        kreg1 = *(const uint4*)(Kbase + (size_t)(p_ + krow1) * k_ld + kch1 * 8); \
        if (KLD > 2) kreg2 = *(const uint4*)(Kbase + (size_t)(p_ + krow2) * k_ld + kch2 * 8); \
        vreg0 = *(const uint4*)(VT + (size_t)vrow0 * TB + p_ + vch * 8); \
        vreg1 = *(const uint4*)(VT + (size_t)vrow1 * TB + p_ + vch * 8); }
#define SWRITE(buf_) { bf16_t* kd_ = Ks + (buf_) * 64 * KSTR; \
        *(uint4*)(kd_ + krow0 * KSTR + kch0 * 8) = kreg0; *(uint4*)(kd_ + krow1 * KSTR + kch1 * 8) = kreg1; \
        if (KLD > 2) *(uint4*)(kd_ + krow2 * KSTR + kch2 * 8) = kreg2; \
        bf16_t* vd_ = Vs + (buf_) * 64 * VSTR + vch * 8; \
        *(uint2*)(vd_ + vrow0 * VSTR) = make_uint2(vreg0.x, vreg0.y); *(uint2*)(vd_ + vrow0 * VSTR + 4) = make_uint2(vreg0.z, vreg0.w); \
        *(uint2*)(vd_ + vrow1 * VSTR) = make_uint2(vreg1.x, vreg1.y); *(uint2*)(vd_ + vrow1 * VSTR + 4) = make_uint2(vreg1.z, vreg1.w); }
    GLOAD(0); SWRITE(0);
    __syncthreads();
    for (int ti = 0; ti < ntiles; ++ti) {
        const int buf = ti & 1;
        const bool more = ti + 1 < ntiles;
        if (more) GLOAD(ti + 1);
        if (!NAT && ti == 4) { qf[NKS - 2] = qrot4; qf[NKS - 1] = qrot5; }
        const int kr = lt0 + ti - 4;
        const bool active = !NAT || ti < 4 || (kr >= r0w && kr < r0w + 8);
        if (active) {
            const bf16_t* kb = Ks + buf * 64 * KSTR + r32 * KSTR + hh * 8;
            f32x16 st0, st1;
#pragma unroll
            for (int r = 0; r < 16; ++r) { st0[r] = 0.f; st1[r] = 0.f; }
            bf16x8 kf0[NKS], kf1[NKS];
#pragma unroll
            for (int ks = 0; ks < NKS; ++ks) { kf0[ks] = *(const bf16x8*)(kb + ks * 16); kf1[ks] = *(const bf16x8*)(kb + 32 * KSTR + ks * 16); }
            asm volatile("s_waitcnt lgkmcnt(0)" ::: "memory");
#pragma unroll
            for (int ks = 0; ks < NKS; ++ks) {
                st0 = __builtin_amdgcn_mfma_f32_32x32x16_bf16(kf0[ks], qf[ks], st0, 0, 0, 0);
                st1 = __builtin_amdgcn_mfma_f32_32x32x16_bf16(kf1[ks], qf[ks], st1, 0, 0, 0);
            }
            const bf16_t* vb = Vs + buf * 64 * VSTR + r32 * VSTR + 4 * hh;
            uint2 vfr[2][2][2][2];
#pragma unroll
            for (int uu = 0; uu < 2; ++uu)
#pragma unroll
                for (int t = 0; t < 2; ++t)
#pragma unroll
                    for (int s2 = 0; s2 < 2; ++s2) {
                        const bf16_t* a = vb + uu * 32 * VSTR + t * 32 + s2 * 16;
                        vfr[uu][t][s2][0] = *(const uint2*)a; vfr[uu][t][s2][1] = *(const uint2*)(a + 8);
                    }
            float x[32];
#pragma unroll
            for (int r = 0; r < 16; ++r) { x[r] = st0[r] * sc2; x[16 + r] = st1[r] * sc2; }
            if (NAT && ti >= 4) {
                const int dr = kr - qr + 7;
#pragma unroll
                for (int e = 0; e < 32; ++e) {
                    const int r = e & 15, kc = (e >> 4) * 32 + (r & 3) + 8 * (r >> 2) + 4 * hh;
                    const int dc = min(max(kc - qc, -15), 15) + 15;
                    const bool ok = (kc >= c0) && (kc < c0 + 16);
                    x[e] = ok ? x[e] + rpb_s[dr * 31 + dc] : -1e30f;
                }
            }
            float mx = x[0];
#pragma unroll
            for (int e = 1; e < 32; ++e) mx = fmaxf(mx, x[e]);
            mx = fmaxf(mx, __shfl_xor(mx, 32));
            const float m_new = fmaxf(m_run, mx);
            const float alpha = __builtin_amdgcn_exp2f(m_run - m_new);
            m_run = m_new;
            float ps = 0.f;
#pragma unroll
            for (int e = 0; e < 32; ++e) { x[e] = __builtin_amdgcn_exp2f(x[e] - m_new); ps += x[e]; }
            lsum = lsum * alpha + ps;
#pragma unroll
            for (int r = 0; r < 16; ++r) { oacc[0][r] *= alpha; oacc[1][r] *= alpha; }
            bf16x8 pf[2][2];
#pragma unroll
            for (int t = 0; t < 2; ++t)
#pragma unroll
                for (int s = 0; s < 2; ++s) {
                    union { bf16x8 v; unsigned u[4]; } cv;
#pragma unroll
                    for (int q = 0; q < 4; ++q) cv.u[q] = cvt_pk(x[16 * t + 8 * s + 2 * q], x[16 * t + 8 * s + 2 * q + 1]);
                    pf[t][s] = cv.v;
                }
#pragma unroll
            for (int uu = 0; uu < 2; ++uu)
#pragma unroll
                for (int t = 0; t < 2; ++t)
#pragma unroll
                    for (int s = 0; s < 2; ++s) {
                        union { bf16x8 v; uint2 h[2]; } cv;
                        cv.h[0] = vfr[uu][t][s][0]; cv.h[1] = vfr[uu][t][s][1];
                        oacc[uu] = __builtin_amdgcn_mfma_f32_32x32x16_bf16(cv.v, pf[t][s], oacc[uu], 0, 0, 0);
                    }
        }
        if (more) SWRITE((ti + 1) & 1);
        __syncthreads();
    }
#undef TILE_P
#undef GLOAD
#undef SWRITE
    lsum += __shfl_xor(lsum, 32);
    const float inv = 1.f / lsum;
    bf16_t* zrow = PB + (size_t)(rowbase + q_p0 + ql) * PW + C_Z + (NAT ? 512 : 0) + head * 64;
#pragma unroll
    for (int uu = 0; uu < 2; ++uu)
#pragma unroll
        for (int g = 0; g < 4; ++g) {
            bf16_t* zp = zrow + uu * 32 + 8 * g + 4 * hh;
            const uint2 z = *(const uint2*)zp;
            uint2 o;
            o.x = cvt_pk(oacc[uu][4 * g + 0] * inv * siluf_(lo16(z.x)), oacc[uu][4 * g + 1] * inv * siluf_(hi16(z.x)));
            o.y = cvt_pk(oacc[uu][4 * g + 2] * inv * siluf_(lo16(z.y)), oacc[uu][4 * g + 3] * inv * siluf_(hi16(z.y)));
            *(uint2*)zp = o;
        }
}

__device__ void scan_hg_item(const Params& P, int l, int item, unsigned char* smem) {
    const int tid = tid_opaque(), lane = tid & 63, wave = tid >> 6;
    const int slice = item & 7, dir = (item >> 3) & 1, head = (item >> 4) & 3, bl = item >> 6;
    float* a_s = (float*)smem;
    float* q_s = a_s + 64 * 128;
    float* v_s = q_s + 64 * 128;
    float* o_s = v_s + 64 * 16;
    const bf16_t* PB = (const bf16_t*)(P.ws + OFF_PB) + (size_t)bl * TB * PW;
    bf16_t* OS = (bf16_t*)(P.ws + OFF_KV) + ((size_t)dir * NTH + (size_t)bl * TB) * 512 + head * 128 + slice * 16;
    const int prow = tid >> 4, pd = (tid & 15) * 8;
    float lb[8];
#pragma unroll
    for (int e = 0; e < 8; ++e) {
        const int cidx = dir * 512 + head * 128 + pd + e;
        lb[e] = (l == 0) ? 0.f : sigmoidf_(P.lb_logits[1024 + cidx] - P.lb_logits[cidx]);
    }
    const int fcol = (dir ? C_HF + 512 : C_HF) + head * 128 + pd, qcol = C_HQ + head * 128 + pd, vcol = C_HI + head * 128 + slice * 16 + (tid & 1) * 8;
    uint4 rq[4], rf[4], rv;
    auto chunk_p = [&](int c) { const int ci = dir ? (c < 4 ? 3 - c : 135 - c) : c; return ci * 64; };
    auto gload = [&](int c) {
        const int p = chunk_p(c);
#pragma unroll
        for (int r = 0; r < 4; ++r) { const bf16_t* row = PB + (size_t)(p + prow + 16 * r) * PW; rq[r] = *(const uint4*)(row + qcol); rf[r] = *(const uint4*)(row + fcol); }
        if (tid < 128) rv = *(const uint4*)(PB + (size_t)(p + (tid >> 1)) * PW + vcol);
    };
    const int dg = lane & 15, col = wave * 4 + (lane >> 4);
    float S[8];
#pragma unroll
    for (int e = 0; e < 8; ++e) S[e] = 0.f;
    gload(0);
    for (int c = 0; c < 132; ++c) {
        __syncthreads();
#pragma unroll
        for (int r = 0; r < 4; ++r) {
            float fq[8], ff[8];
            unpack8(rq[r], fq); unpack8(rf[r], ff);
            float* ad = a_s + (prow + 16 * r) * 128 + pd; float* qd = q_s + (prow + 16 * r) * 128 + pd;
#pragma unroll
            for (int e = 0; e < 8; ++e) { ad[e] = lb[e] + (1.f - lb[e]) * sigmoidf_(ff[e]); qd[e] = siluf_(fq[e]) * 0.08838834764831845f; }
        }
        if (tid < 128) { float fv[8]; unpack8(rv, fv); float* vd = v_s + (tid >> 1) * 16 + (tid & 1) * 8;
#pragma unroll
            for (int e = 0; e < 8; ++e) vd[e] = fv[e]; }
        __syncthreads();
        if (c + 1 < 132) gload(c + 1);
        for (int tt = 0; tt < 64; tt += 8) {
            float op[8];
#pragma unroll
            for (int u = 0; u < 8; ++u) {
                const int i = dir ? 63 - (tt + u) : tt + u;
                const float4 a0 = *(const float4*)(a_s + i * 128 + dg * 8), a1 = *(const float4*)(a_s + i * 128 + dg * 8 + 4);
                const float4 q0 = *(const float4*)(q_s + i * 128 + dg * 8), q1 = *(const float4*)(q_s + i * 128 + dg * 8 + 4);
                const float v = v_s[i * 16 + col];
                float o;
                S[0] = fmaf(a0.x, S[0] - v, v); o = q0.x * S[0];
                S[1] = fmaf(a0.y, S[1] - v, v); o = fmaf(q0.y, S[1], o);
                S[2] = fmaf(a0.z, S[2] - v, v); o = fmaf(q0.z, S[2], o);
                S[3] = fmaf(a0.w, S[3] - v, v); o = fmaf(q0.w, S[3], o);
                S[4] = fmaf(a1.x, S[4] - v, v); o = fmaf(q1.x, S[4], o);
                S[5] = fmaf(a1.y, S[5] - v, v); o = fmaf(q1.y, S[5], o);
                S[6] = fmaf(a1.z, S[6] - v, v); o = fmaf(q1.z, S[6], o);
                S[7] = fmaf(a1.w, S[7] - v, v); o = fmaf(q1.w, S[7], o);
                op[u] = o;
            }
            float r4[4], r2[2];
            const bool b8 = dg & 8, b4 = dg & 4, b2 = dg & 2;
#pragma unroll
            for (int k = 0; k < 4; ++k) { const float snd = b8 ? op[k] : op[k + 4], kp = b8 ? op[k + 4] : op[k]; r4[k] = kp + __shfl_xor(snd, 8); }
#pragma unroll
            for (int k = 0; k < 2; ++k) { const float snd = b4 ? r4[k] : r4[k + 2], kp = b4 ? r4[k + 2] : r4[k]; r2[k] = kp + __shfl_xor(snd, 4); }
            float r1; { const float snd = b2 ? r2[0] : r2[1], kp = b2 ? r2[1] : r2[0]; r1 = kp + __shfl_xor(snd, 2); }
            r1 += __shfl_xor(r1, 1);
            if ((dg & 1) == 0) { const int tok = tt + (b8 ? 4 : 0) + (b4 ? 2 : 0) + (b2 ? 1 : 0); const int i = dir ? 63 - tok : tok; o_s[i * 16 + col] = r1; }
        }
        __syncthreads();
        if (tid < 128) {
            const int p = chunk_p(c) + (tid >> 1);
            *(uint4*)(OS + (size_t)p * 512 + (tid & 1) * 8) = pack8(o_s + (tid >> 1) * 16 + (tid & 1) * 8);
        }
    }
}

__device__ void scan_gla_item(const Params& P, int l, int item, unsigned char* smem) {
    const int tid = tid_opaque(), lane = tid & 63, wave = tid >> 6;
    const int slice = item & 3, dir = (item >> 2) & 1, head = (item >> 3) & 3, bl = item >> 5;
    float* a_s = (float*)smem;
    float* q_s = a_s + 64 * 64;
    float* k_s = q_s + 64 * 64;
    float* v_s = k_s + 64 * 64;
    float* o_s = v_s + 64 * 32;
    float* r_s = o_s + 64 * 32;
    const bf16_t* PB = (const bf16_t*)(P.ws + OFF_PB) + (size_t)bl * TB * PW;
    bf16_t* OS = (bf16_t*)(P.ws + OFF_OSG) + ((size_t)dir * NTH + (size_t)bl * TB) * 512 + head * 128 + slice * 32;
    const int gd = tid & 63, gt0 = tid >> 6;
    float w2[16];
#pragma unroll
    for (int jx = 0; jx < 16; ++jx) w2[jx] = P.gla_w2[((size_t)(l * 2 + dir) * 16 + jx) * 256 + head * 64 + gd];
    const float b2 = P.gla_b2[(l * 2 + dir) * 256 + head * 64 + gd];
    uint4 rq[2], rk[2], rv, rr;
    auto chunk_p = [&](int c) { const int ci = dir ? (c < 4 ? 3 - c : 135 - c) : c; return ci * 64; };
    auto gload = [&](int c) {
        const int p = chunk_p(c);
#pragma unroll
        for (int i = 0; i < 2; ++i) { const int id = tid + 256 * i, row = id >> 3, ch = id & 7; const bf16_t* rp = PB + (size_t)(p + row) * PW;
            rq[i] = *(const uint4*)(rp + C_GQ + head * 64 + ch * 8); rk[i] = *(const uint4*)(rp + C_GK + head * 64 + ch * 8); }
        { const int row = tid >> 2, ch = tid & 3; rv = *(const uint4*)(PB + (size_t)(p + row) * PW + C_GV + head * 128 + slice * 32 + ch * 8); }
        if (tid < 128) { const int row = tid >> 1, ch = tid & 1; rr = *(const uint4*)(PB + (size_t)(p + row) * PW + C_GR + dir * 16 + ch * 8); }
    };
    const int dg = lane & 7, col = wave * 8 + (lane >> 3);
    float S[8];
#pragma unroll
    for (int e = 0; e < 8; ++e) S[e] = 0.f;
    gload(0);
    for (int c = 0; c < 132; ++c) {
        __syncthreads();
#pragma unroll
        for (int i = 0; i < 2; ++i) { const int id = tid + 256 * i, row = id >> 3, ch = id & 7; float fq[8], fk[8]; unpack8(rq[i], fq); unpack8(rk[i], fk);
#pragma unroll
            for (int e = 0; e < 8; ++e) { q_s[row * 64 + ch * 8 + e] = fq[e] * 0.125f; k_s[row * 64 + ch * 8 + e] = fk[e]; } }
        { const int row = tid >> 2, ch = tid & 3; float fv[8]; unpack8(rv, fv);
#pragma unroll
            for (int e = 0; e < 8; ++e) v_s[row * 32 + ch * 8 + e] = fv[e]; }
        if (tid < 128) { const int row = tid >> 1, ch = tid & 1; float fr[8]; unpack8(rr, fr);
#pragma unroll
            for (int e = 0; e < 8; ++e) r_s[row * 16 + ch * 8 + e] = fr[e]; }
        __syncthreads();
        if (c + 1 < 132) gload(c + 1);
#pragma unroll 4
        for (int m = 0; m < 16; ++m) {
            const int i = gt0 + 4 * m;
            float g = b2;
#pragma unroll
            for (int jx = 0; jx < 16; ++jx) g = fmaf(r_s[i * 16 + jx], w2[jx], g);
            const float ls = fminf(g, 0.f) - __logf(1.f + __expf(-fabsf(g)));
            a_s[i * 64 + gd] = __expf(ls * 0.0625f);
        }
        __syncthreads();
        for (int tt = 0; tt < 64; tt += 8) {
            float op[8];
#pragma unroll
            for (int u = 0; u < 8; ++u) {
                const int i = dir ? 63 - (tt + u) : tt + u;
                const float4 a0 = *(const float4*)(a_s + i * 64 + dg * 8), a1 = *(const float4*)(a_s + i * 64 + dg * 8 + 4);
                const float4 q0 = *(const float4*)(q_s + i * 64 + dg * 8), q1 = *(const float4*)(q_s + i * 64 + dg * 8 + 4);
                const float4 k0 = *(const float4*)(k_s + i * 64 + dg * 8), k1 = *(const float4*)(k_s + i * 64 + dg * 8 + 4);
                const float v = v_s[i * 32 + col];
                float o;
                S[0] = fmaf(a0.x, S[0], k0.x * v); o = q0.x * S[0];
                S[1] = fmaf(a0.y, S[1], k0.y * v); o = fmaf(q0.y, S[1], o);
                S[2] = fmaf(a0.z, S[2], k0.z * v); o = fmaf(q0.z, S[2], o);
                S[3] = fmaf(a0.w, S[3], k0.w * v); o = fmaf(q0.w, S[3], o);
                S[4] = fmaf(a1.x, S[4], k1.x * v); o = fmaf(q1.x, S[4], o);
                S[5] = fmaf(a1.y, S[5], k1.y * v); o = fmaf(q1.y, S[5], o);
                S[6] = fmaf(a1.z, S[6], k1.z * v); o = fmaf(q1.z, S[6], o);
                S[7] = fmaf(a1.w, S[7], k1.w * v); o = fmaf(q1.w, S[7], o);
                op[u] = o;
            }
            float r4[4], r2[2];
            const bool b4 = dg & 4, b2 = dg & 2, b1 = dg & 1;
#pragma unroll
            for (int k = 0; k < 4; ++k) { const float snd = b4 ? op[k] : op[k + 4], kp = b4 ? op[k + 4] : op[k]; r4[k] = kp + __shfl_xor(snd, 4); }
#pragma unroll
            for (int k = 0; k < 2; ++k) { const float snd = b2 ? r4[k] : r4[k + 2], kp = b2 ? r4[k + 2] : r4[k]; r2[k] = kp + __shfl_xor(snd, 2); }
            float r1; { const float snd = b1 ? r2[0] : r2[1], kp = b1 ? r2[1] : r2[0]; r1 = kp + __shfl_xor(snd, 1); }
            { const int tok = tt + (b4 ? 4 : 0) + (b2 ? 2 : 0) + (b1 ? 1 : 0); const int i = dir ? 63 - tok : tok; o_s[i * 32 + col] = r1; }
        }
        __syncthreads();
        { const int row = tid >> 2, ch = tid & 3; const int p = chunk_p(c) + row;
          *(uint4*)(OS + (size_t)p * 512 + ch * 8) = pack8(o_s + row * 32 + ch * 8); }
    }
}


template <bool GLA>
__device__ void scan2_item(const Params& P, int l, int item, unsigned char* smem) {
    constexpr int DK = GLA ? 64 : 128, NT = DK / 32, QS = DK + 8, TS = 40, NSEG = GLA ? 4 : 2, TPS = 32 / NSEG, QCH = DK / 8;
    const int tid = tid_opaque(), lane = tid & 63, wave = tid >> 6, r32 = lane & 31, hh = lane >> 5;
    const int dir = item & 1, head = (item >> 1) & 3, bl = item >> 3;
    bf16_t* Qh = (bf16_t*)smem;
    bf16_t* Kh = Qh + 32 * QS;
    bf16_t* Kt = Kh + 32 * QS;
    bf16_t* Vt = Kt + DK * TS;
    float* eb = (float*)(Vt + 128 * TS);
    float* tot = eb + DK;
    bf16_t* qraw = (bf16_t*)(tot + 4 * DK);
    bf16_t* fraw = qraw + 32 * DK;
    bf16_t* vraw = fraw + 32 * DK;
    bf16_t* rraw = vraw + 32 * 128;
    const bf16_t* PB = (const bf16_t*)(P.ws + OFF_PB) + (size_t)bl * TB * PW;
    bf16_t* OS = (bf16_t*)(P.ws + (GLA ? OFF_OSG : OFF_KV)) + ((size_t)dir * NTH + (size_t)bl * TB) * 512 + head * 128 + wave * 32;
    const int qcol = (GLA ? C_GQ : C_HQ) + head * DK, fcol = GLA ? (C_GK + head * 64) : ((dir ? C_HF + 512 : C_HF) + head * 128),
              vcol = (GLA ? C_GV : C_HI) + head * 128, rcol = C_GR + dir * 16;
    const int pd = tid & (DK - 1), seg = tid / DK;
    float lbv = 0.f, b2 = 0.f, w2[16];
#pragma unroll
    for (int jx = 0; jx < 16; ++jx) w2[jx] = 0.f;
    if (GLA) {
#pragma unroll
        for (int jx = 0; jx < 16; ++jx) w2[jx] = P.gla_w2[((size_t)(l * 2 + dir) * 16 + jx) * 256 + head * 64 + pd];
        b2 = P.gla_b2[(l * 2 + dir) * 256 + head * 64 + pd];
    } else if (l != 0) { const int cidx = dir * 512 + head * 128 + pd; lbv = sigmoidf_(P.lb_logits[1024 + cidx] - P.lb_logits[cidx]); }
    uint4 pq0, pq1, pf0, pf1, pv0, pv1, pr;
    pq1 = pf1 = pr = make_uint4(0, 0, 0, 0);
#define CH_P0(c) (dir ? ((c) < 8 ? (7 - (c)) * 32 : CTXL + (263 - (c)) * 32) : (c) * 32)
#define ROWP(p0_, i_) ((p0_) + (dir ? 31 - (i_) : (i_)))
#define SC_GLOAD(c) { const int p0_ = CH_P0(c); \
        { const int id = tid, i = id / QCH, ch = id % QCH; const bf16_t* rp = PB + (size_t)ROWP(p0_, i) * PW; pq0 = *(const uint4*)(rp + qcol + ch * 8); pf0 = *(const uint4*)(rp + fcol + ch * 8); } \
        if (!GLA) { const int id = tid + 256, i = id / QCH, ch = id % QCH; const bf16_t* rp = PB + (size_t)ROWP(p0_, i) * PW; pq1 = *(const uint4*)(rp + qcol + ch * 8); pf1 = *(const uint4*)(rp + fcol + ch * 8); } \
        { const int i = tid >> 4, ch = tid & 15; pv0 = *(const uint4*)(PB + (size_t)ROWP(p0_, i) * PW + vcol + ch * 8); pv1 = *(const uint4*)(PB + (size_t)ROWP(p0_, i + 16) * PW + vcol + ch * 8); } \
        if (GLA && tid < 64) { const int i = tid >> 1, ch = tid & 1; pr = *(const uint4*)(PB + (size_t)ROWP(p0_, i) * PW + rcol + ch * 8); } }
    f32x16 ST[NT];
#pragma unroll
    for (int T = 0; T < NT; ++T)
#pragma unroll
        for (int r = 0; r < 16; ++r) ST[T][r] = 0.f;
    SC_GLOAD(0);
    for (int c = 0; c < 264; ++c) {
        __syncthreads();
        { const int id = tid, i = id / QCH, ch = id % QCH; *(uint4*)(qraw + i * DK + ch * 8) = pq0; *(uint4*)(fraw + i * DK + ch * 8) = pf0; }
        if (!GLA) { const int id = tid + 256, i = id / QCH, ch = id % QCH; *(uint4*)(qraw + i * DK + ch * 8) = pq1; *(uint4*)(fraw + i * DK + ch * 8) = pf1; }
        { const int i = tid >> 4, ch = tid & 15; *(uint4*)(vraw + i * 128 + ch * 8) = pv0; *(uint4*)(vraw + (i + 16) * 128 + ch * 8) = pv1; }
        if (GLA && tid < 64) { const int i = tid >> 1, ch = tid & 1; *(uint4*)(rraw + i * 16 + ch * 8) = pr; }
        __syncthreads();
        if (c + 1 < 264) SC_GLOAD(c + 1);
        float bl_[TPS], kk[TPS], qq[TPS];
        float cum = 0.f;
#pragma unroll
        for (int tt = 0; tt < TPS; ++tt) {
            const int i = seg * TPS + tt;
            float la;
            if (GLA) {
                float g = b2;
#pragma unroll
                for (int jx = 0; jx < 16; ++jx) g = fmaf(bf2f(rraw[i * 16 + jx]), w2[jx], g);
                la = (fminf(g, 0.f) - __logf(1.f + __expf(-fabsf(g)))) * 0.0625f;
                kk[tt] = bf2f(fraw[i * DK + pd]);
                qq[tt] = bf2f(qraw[i * DK + pd]) * 0.125f;
            } else {
                const float f = bf2f(fraw[i * DK + pd]);
                const float a = lbv + (1.f - lbv) * sigmoidf_(f);
                la = __logf(a);
                kk[tt] = 1.f - a;
                qq[tt] = siluf_(bf2f(qraw[i * DK + pd])) * 0.08838834764831845f;
            }
            cum += la;
            bl_[tt] = cum;
        }
        tot[seg * DK + pd] = cum;
        __syncthreads();
        {
            float off = 0.f, bend = 0.f;
#pragma unroll
            for (int sg = 0; sg < NSEG; ++sg) { const float tv = tot[sg * DK + pd]; bend += tv; if (sg < seg) off += tv; }
            const float eend = __expf(bend);
            if (seg == 0) eb[pd] = eend;
            float kt[TPS];
#pragma unroll
            for (int tt = 0; tt < TPS; ++tt) {
                const int i = seg * TPS + tt;
                const float b = bl_[tt] + off;
                const float e1 = __expf(b), e2 = __expf(-b);
                const float kh = kk[tt] * e2;
                Qh[i * QS + pd] = f2bf(qq[tt] * e1);
                Kh[i * QS + pd] = f2bf(kh);
                kt[tt] = kh * eend;
            }
#pragma unroll
            for (int g8 = 0; g8 < TPS / 8; ++g8) *(uint4*)(Kt + pd * TS + seg * TPS + g8 * 8) = pack8(kt + g8 * 8);
            const int vc = tid & 127, vs = tid >> 7;
            float vv[16];
#pragma unroll
            for (int tt = 0; tt < 16; ++tt) vv[tt] = bf2f(vraw[(vs * 16 + tt) * 128 + vc]);
            *(uint4*)(Vt + vc * TS + vs * 16) = pack8(vv);
            *(uint4*)(Vt + vc * TS + vs * 16 + 8) = pack8(vv + 8);
        }
        __syncthreads();
        f32x16 st;
#pragma unroll
        for (int r = 0; r < 16; ++r) st[r] = 0.f;
#pragma unroll
        for (int ks = 0; ks < DK / 16; ++ks) {
            const bf16x8 ka = *(const bf16x8*)(Kh + r32 * QS + ks * 16 + hh * 8);
            const bf16x8 qb = *(const bf16x8*)(Qh + r32 * QS + ks * 16 + hh * 8);
            st = __builtin_amdgcn_mfma_f32_32x32x16_bf16(ka, qb, st, 0, 0, 0);
        }
        bf16x8 pfr[2];
#pragma unroll
        for (int sI = 0; sI < 2; ++sI) {
            union { bf16x8 v; unsigned u[4]; } cv;
#pragma unroll
            for (int q = 0; q < 4; ++q) {
                const int ra = 8 * sI + 2 * q, rb = ra + 1;
                const int ja = (ra & 3) + 8 * (ra >> 2) + 4 * hh, jb = (rb & 3) + 8 * (rb >> 2) + 4 * hh;
                cv.u[q] = cvt_pk(ja <= r32 ? st[ra] : 0.f, jb <= r32 ? st[rb] : 0.f);
            }
            pfr[sI] = cv.v;
        }
        f32x16 oT;
#pragma unroll
        for (int r = 0; r < 16; ++r) oT[r] = 0.f;
#pragma unroll
        for (int sI = 0; sI < 2; ++sI) {
            const bf16_t* a = Vt + (wave * 32 + r32) * TS + sI * 16 + 4 * hh;
            union { bf16x8 v; uint2 h[2]; } cv;
            cv.h[0] = *(const uint2*)a; cv.h[1] = *(const uint2*)(a + 8);
            oT = __builtin_amdgcn_mfma_f32_32x32x16_bf16(cv.v, pfr[sI], oT, 0, 0, 0);
        }
#pragma unroll
        for (int T = 0; T < NT; ++T)
#pragma unroll
            for (int sI = 0; sI < 2; ++sI) {
                union { bf16x8 v; unsigned u[4]; } ca;
#pragma unroll
                for (int q = 0; q < 4; ++q) ca.u[q] = cvt_pk(ST[T][8 * sI + 2 * q], ST[T][8 * sI + 2 * q + 1]);
                const bf16_t* b = Qh + r32 * QS + T * 32 + sI * 16 + 4 * hh;
                union { bf16x8 v; uint2 h[2]; } cb;
                cb.h[0] = *(const uint2*)b; cb.h[1] = *(const uint2*)(b + 8);
                oT = __builtin_amdgcn_mfma_f32_32x32x16_bf16(ca.v, cb.v, oT, 0, 0, 0);
            }
#pragma unroll
        for (int T = 0; T < NT; ++T) {
#pragma unroll
            for (int g = 0; g < 4; ++g) {
                const float4 e4 = *(const float4*)(eb + T * 32 + 8 * g + 4 * hh);
                ST[T][4 * g + 0] *= e4.x; ST[T][4 * g + 1] *= e4.y; ST[T][4 * g + 2] *= e4.z; ST[T][4 * g + 3] *= e4.w;
            }
#pragma unroll
            for (int ks = 0; ks < 2; ++ks) {
                const bf16x8 ka = *(const bf16x8*)(Kt + (T * 32 + r32) * TS + ks * 16 + hh * 8);
                const bf16x8 vb = *(const bf16x8*)(Vt + (wave * 32 + r32) * TS + ks * 16 + hh * 8);
                ST[T] = __builtin_amdgcn_mfma_f32_32x32x16_bf16(ka, vb, ST[T], 0, 0, 0);
            }
        }
        {
            const int p = ROWP(CH_P0(c), r32);
            bf16_t* op = OS + (size_t)p * 512 + 4 * hh;
#pragma unroll
            for (int g = 0; g < 4; ++g) { uint2 o; o.x = cvt_pk(oT[4 * g], oT[4 * g + 1]); o.y = cvt_pk(oT[4 * g + 2], oT[4 * g + 3]); *(uint2*)(op + 8 * g) = o; }
        }
    }
#undef CH_P0
#undef ROWP
#undef SC_GLOAD
}


template <bool GLA>
__device__ __forceinline__ void scan3_rest(f32x16 (&ST)[GLA ? 2 : 4], bf16_t* Qh, bf16_t* Kh, bf16_t* Kt, bf16_t* Vt, float* eb, bf16_t* vraw, bf16_t* OS,
                                           int tid, int wave, int r32, int hh, int pd, int seg, int c, int dir) {
    constexpr int DK = GLA ? 64 : 128, NT = DK / 32, QS = DK + 8, TS = 40, NSEG = GLA ? 4 : 2, TPS = 32 / NSEG;
#define CH_P0(c) (dir ? ((c) < 8 ? (7 - (c)) * 32 : CTXL + (263 - (c)) * 32) : (c) * 32)
#define ROWP(p0_, i_) ((p0_) + (dir ? 31 - (i_) : (i_)))
        {
            const float eend = eb[pd];
            float kt[TPS];
#pragma unroll
            for (int tt = 0; tt < TPS; ++tt) kt[tt] = bf2f(Kh[(seg * TPS + tt) * QS + pd]) * eend;
#pragma unroll
            for (int g8 = 0; g8 < TPS / 8; ++g8) *(uint4*)(Kt + pd * TS + seg * TPS + g8 * 8) = pack8(kt + g8 * 8);
            const int vc = tid & 127, vs = tid >> 7;
            float vv[16];
#pragma unroll
            for (int tt = 0; tt < 16; ++tt) vv[tt] = bf2f(vraw[(vs * 16 + tt) * 128 + vc]);
            *(uint4*)(Vt + vc * TS + vs * 16) = pack8(vv);
            *(uint4*)(Vt + vc * TS + vs * 16 + 8) = pack8(vv + 8);
        }
        __syncthreads();
        f32x16 st;
#pragma unroll
        for (int r = 0; r < 16; ++r) st[r] = 0.f;
#pragma unroll
        for (int ks = 0; ks < DK / 16; ++ks) {
            const bf16x8 ka = *(const bf16x8*)(Kh + r32 * QS + ks * 16 + hh * 8);
            const bf16x8 qb = *(const bf16x8*)(Qh + r32 * QS + ks * 16 + hh * 8);
            st = __builtin_amdgcn_mfma_f32_32x32x16_bf16(ka, qb, st, 0, 0, 0);
        }
        bf16x8 pfr[2];
#pragma unroll
        for (int sI = 0; sI < 2; ++sI) {
            union { bf16x8 v; unsigned u[4]; } cv;
#pragma unroll
            for (int q = 0; q < 4; ++q) {
                const int ra = 8 * sI + 2 * q, rb = ra + 1;
                const int ja = (ra & 3) + 8 * (ra >> 2) + 4 * hh, jb = (rb & 3) + 8 * (rb >> 2) + 4 * hh;
                cv.u[q] = cvt_pk(ja <= r32 ? st[ra] : 0.f, jb <= r32 ? st[rb] : 0.f);
            }
            pfr[sI] = cv.v;
        }
        f32x16 oT;
#pragma unroll
        for (int r = 0; r < 16; ++r) oT[r] = 0.f;
#pragma unroll
        for (int sI = 0; sI < 2; ++sI) {
            const bf16_t* a = Vt + (wave * 32 + r32) * TS + sI * 16 + 4 * hh;
            union { bf16x8 v; uint2 h[2]; } cv;
            cv.h[0] = *(const uint2*)a; cv.h[1] = *(const uint2*)(a + 8);
            oT = __builtin_amdgcn_mfma_f32_32x32x16_bf16(cv.v, pfr[sI], oT, 0, 0, 0);
        }
#pragma unroll
        for (int T = 0; T < NT; ++T)
#pragma unroll
            for (int sI = 0; sI < 2; ++sI) {
                union { bf16x8 v; unsigned u[4]; } ca;
#pragma unroll
                for (int q = 0; q < 4; ++q) ca.u[q] = cvt_pk(ST[T][8 * sI + 2 * q], ST[T][8 * sI + 2 * q + 1]);
                const bf16_t* b = Qh + r32 * QS + T * 32 + sI * 16 + 4 * hh;
                union { bf16x8 v; uint2 h[2]; } cb;
                cb.h[0] = *(const uint2*)b; cb.h[1] = *(const uint2*)(b + 8);
                oT = __builtin_amdgcn_mfma_f32_32x32x16_bf16(ca.v, cb.v, oT, 0, 0, 0);
            }
#pragma unroll
        for (int T = 0; T < NT; ++T) {
#pragma unroll
            for (int g = 0; g < 4; ++g) {
                const float4 e4 = *(const float4*)(eb + T * 32 + 8 * g + 4 * hh);
                ST[T][4 * g + 0] *= e4.x; ST[T][4 * g + 1] *= e4.y; ST[T][4 * g + 2] *= e4.z; ST[T][4 * g + 3] *= e4.w;
            }
#pragma unroll
            for (int ks = 0; ks < 2; ++ks) {
                const bf16x8 ka = *(const bf16x8*)(Kt + (T * 32 + r32) * TS + ks * 16 + hh * 8);
                const bf16x8 vb = *(const bf16x8*)(Vt + (wave * 32 + r32) * TS + ks * 16 + hh * 8);
                ST[T] = __builtin_amdgcn_mfma_f32_32x32x16_bf16(ka, vb, ST[T], 0, 0, 0);
            }
        }
        {
            const int p = ROWP(CH_P0(c), r32);
            bf16_t* op = OS + (size_t)p * 512 + 4 * hh;
#pragma unroll
            for (int g = 0; g < 4; ++g) { uint2 o; o.x = cvt_pk(oT[4 * g], oT[4 * g + 1]); o.y = cvt_pk(oT[4 * g + 2], oT[4 * g + 3]); *(uint2*)(op + 8 * g) = o; }
        }
#undef CH_P0
#undef ROWP
}

template <bool GLA>
__device__ void scan3_item(const Params& P, int l, int item, unsigned char* smem) {
    constexpr int DK = GLA ? 64 : 128, NT = DK / 32, QS = DK + 8, TS = 40, NSEG = GLA ? 4 : 2, TPS = 32 / NSEG, QCH = DK / 8;
    const int tid = tid_opaque(), lane = tid & 63, wave = tid >> 6, r32 = lane & 31, hh = lane >> 5;
    const int dir = item & 1, head = (item >> 1) & 3, bl = item >> 3;
    __builtin_amdgcn_s_setprio(3);
    bf16_t* Qh = (bf16_t*)smem;
    bf16_t* Kh = Qh + 32 * QS;
    bf16_t* Kt = Kh + 32 * QS;
    bf16_t* Vt = Kt + DK * TS;
    float* eb = (float*)(Vt + 128 * TS);
    bf16_t* vraw = (bf16_t*)(eb + DK);
    const bf16_t* PB = (const bf16_t*)(P.ws + OFF_PB) + (size_t)bl * TB * PW;
    bf16_t* OS = (bf16_t*)(P.ws + (GLA ? OFF_OSG : OFF_KV)) + ((size_t)dir * NTH + (size_t)bl * TB) * 512 + head * 128 + wave * 32;
    const bf16_t* qsrc; const bf16_t* ksrc; int qld, kld;
    if (GLA) {
        if (dir == 0) { qsrc = PB + C_GQ + head * 64; qld = PW; ksrc = PB + C_GK + head * 64; kld = PW; }
        else { const bf16_t* X = (const bf16_t*)(P.ws + OFF_XG) + (size_t)bl * TB * 512; qsrc = X + head * 64; qld = 512; ksrc = X + 256 + head * 64; kld = 512; }
    } else {
        if (dir == 0) { qsrc = PB + C_HQ + head * 128; qld = PW; ksrc = PB + C_HF + head * 128; kld = PW; }
        else { qsrc = (const bf16_t*)(P.ws + OFF_XH) + (size_t)bl * TB * 512 + head * 128; qld = 512; ksrc = PB + C_HF + 512 + head * 128; kld = PW; }
    }
    const float* ebsrc = (const float*)(P.ws + (GLA ? OFF_EBG : OFF_EBH)) + ((size_t)(bl * 264) * 2 + dir) * (4 * DK) + head * DK;
    const int vcol = (GLA ? C_GV : C_HI) + head * 128;
    const int pd = tid & (DK - 1), seg = tid / DK;
    uint4 pq0A, pq1A, pk0A, pk1A, pv0A, pv1A, pq0B, pq1B, pk0B, pk1B, pv0B, pv1B; float peA = 0.f, peB = 0.f;
    pq1A = pk1A = pq1B = pk1B = make_uint4(0, 0, 0, 0);
#define CH_P0(c) (dir ? ((c) < 8 ? (7 - (c)) * 32 : CTXL + (263 - (c)) * 32) : (c) * 32)
#define ROWP(p0_, i_) ((p0_) + (dir ? 31 - (i_) : (i_)))
#define SC_GLOAD(c, S) { const int p0_ = CH_P0(c); \
        { const int id = tid, i = id / QCH, ch = id % QCH; const size_t rr_ = (size_t)ROWP(p0_, i); pq0##S = *(const uint4*)(qsrc + rr_ * qld + ch * 8); pk0##S = *(const uint4*)(ksrc + rr_ * kld + ch * 8); } \
        if (!GLA) { const int id = tid + 256, i = id / QCH, ch = id % QCH; const size_t rr_ = (size_t)ROWP(p0_, i); pq1##S = *(const uint4*)(qsrc + rr_ * qld + ch * 8); pk1##S = *(const uint4*)(ksrc + rr_ * kld + ch * 8); } \
        { const int i = tid >> 4, ch = tid & 15; pv0##S = *(const uint4*)(PB + (size_t)ROWP(p0_, i) * PW + vcol + ch * 8); pv1##S = *(const uint4*)(PB + (size_t)ROWP(p0_, i + 16) * PW + vcol + ch * 8); } \
        if (tid < DK) pe##S = ebsrc[(size_t)(p0_ >> 5) * 2 * (4 * DK) + tid]; }
    f32x16 ST[NT];
#pragma unroll
    for (int T = 0; T < NT; ++T)
#pragma unroll
        for (int r = 0; r < 16; ++r) ST[T][r] = 0.f;
#define SC_COPY(S) { \
        { const int id = tid, i = id / QCH, ch = id % QCH; *(uint4*)(Qh + i * QS + ch * 8) = pq0##S; *(uint4*)(Kh + i * QS + ch * 8) = pk0##S; } \
        if (!GLA) { const int id = tid + 256, i = id / QCH, ch = id % QCH; *(uint4*)(Qh + i * QS + ch * 8) = pq1##S; *(uint4*)(Kh + i * QS + ch * 8) = pk1##S; } \
        { const int i = tid >> 4, ch = tid & 15; *(uint4*)(vraw + i * 128 + ch * 8) = pv0##S; *(uint4*)(vraw + (i + 16) * 128 + ch * 8) = pv1##S; } \
        if (tid < DK) eb[tid] = pe##S; }
    SC_GLOAD(0, A);
    SC_GLOAD(1, B);
    for (int c = 0; c < 264; c += 2) {
        __syncthreads();
        SC_COPY(A);
        __syncthreads();
        if (c + 2 < 264) SC_GLOAD(c + 2, A);
        scan3_rest<GLA>(ST, Qh, Kh, Kt, Vt, eb, vraw, OS, tid, wave, r32, hh, pd, seg, c, dir);
        __syncthreads();
        SC_COPY(B);
        __syncthreads();
        if (c + 3 < 264) SC_GLOAD(c + 3, B);
        scan3_rest<GLA>(ST, Qh, Kh, Kt, Vt, eb, vraw, OS, tid, wave, r32, hh, pd, seg, c + 1, dir);
    }
#undef SC_COPY
#undef CH_P0
#undef ROWP
#undef SC_GLOAD
    __builtin_amdgcn_s_setprio(0);
}

#ifdef ONLYI
#define IT_ON(n) (ONLYI == (n))
#else
#define IT_ON(n) true
#endif
__device__ void phase_mixers(const Params& P, int ph, int l, unsigned char* smem, int mode = 0) {
    constexpr int N_HG = 16, N_GLA = 16, N_ATT = 2 * 8 * 66;
    for (;;) {
        int it = next_item(P, ph);
        if (mode == 2) it += N_HG + N_GLA;
        if (it >= N_HG + N_GLA + 2 * N_ATT || (mode == 1 && it >= N_HG + N_GLA)) break;
        if (it < N_HG) { if (IT_ON(0)) scan3_item<false>(P, l, it, smem); continue; }
        it -= N_HG;
        if (it < N_GLA) { if (IT_ON(1)) scan3_item<true>(P, l, it, smem); continue; }
        it -= N_GLA;
        if (it < N_ATT) { const int bl = it / 528, rem = it % 528; if (IT_ON(2)) attn_item<96, false>(P, l, bl, rem / 66, rem % 66, smem); continue; }
        it -= N_ATT;
        { const int bl = it / 528, rem = it % 528; if (IT_ON(3)) attn_item<64, true>(P, l, bl, rem / 66, rem % 66, smem); }
    }
}

__device__ void phase_scanfin(const Params& P, int ph, int l) {
    const int tid = tid_opaque(), lane = tid & 63, wave = tid >> 6;
    bf16_t* PB = (bf16_t*)(P.ws + OFF_PB);
    const bf16_t* OSH = (const bf16_t*)(P.ws + OFF_KV);
    const bf16_t* OSGp = (const bf16_t*)(P.ws + OFF_OSG);
    float gh[8], gg[8];
#pragma unroll
    for (int e = 0; e < 8; ++e) { gh[e] = P.hg_g_o[l * 128 + (lane & 15) * 8 + e]; gg[e] = P.gla_g_o[l * 128 + (lane & 15) * 8 + e]; }
    for (;;) {
        const int u = next_item(P, ph);
        if (u >= NTH / 16) break;
        uint4 ra[8], rb[8], rz[8];
#pragma unroll
        for (int k = 0; k < 8; ++k) {
            const int t = u * 16 + wave * 4 + (k >> 1), mx = k & 1;
            const bf16_t* OS = mx ? OSGp : OSH;
            ra[k] = *(const uint4*)(OS + (size_t)t * 512 + lane * 8);
            rb[k] = *(const uint4*)(OS + ((size_t)NTH + t) * 512 + lane * 8);
            rz[k] = *(const uint4*)(PB + (size_t)t * PW + C_Z + (2 + mx) * 512 + lane * 8);
        }
#pragma unroll
        for (int k = 0; k < 8; ++k) {
            const int t = u * 16 + wave * 4 + (k >> 1), mx = k & 1;
            float a[8], b[8], z[8];
            unpack8(ra[k], a); unpack8(rb[k], b); unpack8(rz[k], z);
            float ss = 0.f;
#pragma unroll
            for (int e = 0; e < 8; ++e) { a[e] += b[e]; ss += a[e] * a[e]; }
            ss += __shfl_xor(ss, 1); ss += __shfl_xor(ss, 2); ss += __shfl_xor(ss, 4); ss += __shfl_xor(ss, 8);
            const float rn = rsqrtf(ss * (1.f / 128.f) + EPS);
#pragma unroll
            for (int e = 0; e < 8; ++e) a[e] = a[e] * rn * (mx ? gg[e] : gh[e]) * siluf_(z[e]);
            *(uint4*)(PB + (size_t)t * PW + C_Z + (2 + mx) * 512 + lane * 8) = pack8(a);
        }
    }
}

__device__ void phase_merge(const Params& P, int ph, int l, unsigned char* smem) {
    const int tid_ = tid_opaque(), lane = tid_ & 63, wave = tid_ >> 6, wr = wave >> 1, wc = wave & 1;
    const bf16_t* H = (const bf16_t*)(P.ws + OFF_H);
    const bf16_t* PB = (const bf16_t*)(P.ws + OFF_PB);
    bf16_t* ACC = (bf16_t*)(P.ws + OFF_KV);
    for (;;) {
        const int u = next_item(P, ph);
        if (u >= 132 * 16) break;
        const int mt = u >> 4, nt = u & 15;
        const int col = nt * 64 + wc * 32 + (lane & 31);
        f32x16 tot[2];
#pragma unroll
        for (int r = 0; r < 16; ++r) { tot[0][r] = 0.f; tot[1][r] = 0.f; }
        for (int br = 0; br < 4; ++br) {
            unsigned gate[2][8];
            {
                f32x16 g[2];
#pragma unroll
                for (int r = 0; r < 16; ++r) { g[0][r] = 0.f; g[1][r] = 0.f; }
                gemm_tile_n64(g, H + (size_t)mt * 128 * D, D, (const bf16_t*)(P.ws + OFF_WM) + ((size_t)(l * 4 + br) * 1024 + nt * 64) * 1024, 1024, 1024, smem);
                const float bm = P.b_merge[(l * 4 + br) * 1024 + col];
#pragma unroll
                for (int mi = 0; mi < 2; ++mi)
#pragma unroll
                    for (int r = 0; r < 8; ++r) gate[mi][r] = cvt_pk_asm(sigmoidf_(g[mi][2 * r] + bm), sigmoidf_(g[mi][2 * r + 1] + bm));
            }
            f32x16 pa[2];
#pragma unroll
            for (int r = 0; r < 16; ++r) { pa[0][r] = 0.f; pa[1][r] = 0.f; }
            gemm_tile_n64(pa, PB + (size_t)mt * 128 * PW + C_Z + br * 512, PW, (const bf16_t*)(P.ws + OFF_WBR) + ((size_t)(l * 4 + br) * 1024 + nt * 64) * 512, 512, 512, smem);
#pragma unroll
            for (int mi = 0; mi < 2; ++mi)
#pragma unroll
                for (int r = 0; r < 8; ++r) {
                    tot[mi][2 * r] = fmaf(lo16(gate[mi][r]), pa[mi][2 * r], tot[mi][2 * r]);
                    tot[mi][2 * r + 1] = fmaf(hi16(gate[mi][r]), pa[mi][2 * r + 1], tot[mi][2 * r + 1]);
                }
        }
#pragma unroll
        for (int mi = 0; mi < 2; ++mi)
#pragma unroll
            for (int r = 0; r < 16; ++r) ACC[(size_t)(mt * 128 + ACC_ROW(mi, r)) * 1024 + col] = f2bf(tot[mi][r]);
    }
}

__device__ void phase_out(const Params& P, int ph, int l, int hf, unsigned char* smem) {
    const int tid_ = tid_opaque(), lane = tid_ & 63, wave = tid_ >> 6, wr = wave >> 1, wc = wave & 1;
    const bf16_t* ACC = (const bf16_t*)(P.ws + OFF_KV);
    const float* mod = (const float*)(P.ws + OFF_MOD);
    for (;;) {
        const int u = next_item(P, ph);
        if (u >= 132 * 8) break;
        const int mt = u >> 3, nt = u & 7;
        const int t0 = mt * 128, bl = t0 / TB, p0 = t0 % TB, b = hf * 2 + bl;
        const bool isctx = p0 < CTXL;
        if (isctx && l == 1) continue;
        f32x16 acc[2][2]; zero_acc(acc);
        gemm_tile_pf2(acc, ACC + (size_t)mt * 128 * 1024, 1024, (const bf16_t*)(P.ws + OFF_WO) + ((size_t)l * 1024 + nt * 128) * 1024, 1024, 1024, smem);
        const float* gt = mod + (l * 5 + (isctx ? 4 : b)) * 3072 + 2048 + nt * 128;
        const float* src; float* dst;
        if (isctx) { src = P.ctx + ((size_t)b * CTXL + p0) * D; dst = (float*)(P.ws + OFF_CX1) + ((size_t)b * CTXL + p0) * D; }
        else { const size_t o = ((size_t)b * SEQ + (p0 - CTXL)) * D; src = (l == 0 ? P.x : (const float*)P.out) + o; dst = P.out + o; }
#pragma unroll
        for (int mi = 0; mi < 2; ++mi)
#pragma unroll
            for (int ni = 0; ni < 2; ++ni) {
                const int cl = ACC_COL(ni);
                const float g = gt[cl];
#pragma unroll
                for (int r = 0; r < 16; ++r) { const size_t o = (size_t)ACC_ROW(mi, r) * D + nt * 128 + cl; dst[o] = src[o] + g * acc[mi][ni][r]; }
            }
    }
}

__global__ void __launch_bounds__(256, 2) mega(Params PK) {
    extern __shared__ __attribute__((aligned(16))) unsigned char smem[];
    if (blockIdx.x == 0 && threadIdx.x == 0) {
        Params* T = (Params*)(PK.ws + OFF_TAB);
        T->x = PK.x; T->c = PK.c; T->ctx = PK.ctx; T->c_ctx = PK.c_ctx; T->ada_w = PK.ada_w; T->ada_b = PK.ada_b; T->norm_g = PK.norm_g; T->w_in = PK.w_in;
        T->w_uq = PK.w_uq; T->w_ukv = PK.w_ukv; T->g_cq = PK.g_cq; T->g_ckv = PK.g_ckv; T->g_q = PK.g_q; T->g_k = PK.g_k; T->rpb = PK.rpb; T->ng_q = PK.ng_q; T->ng_k = PK.ng_k;
        T->lb_logits = PK.lb_logits; T->hg_g_o = PK.hg_g_o; T->gla_w2 = PK.gla_w2; T->gla_b2 = PK.gla_b2; T->gla_g_o = PK.gla_g_o; T->w_br = PK.w_br; T->w_merge = PK.w_merge;
        T->b_merge = PK.b_merge; T->w_out = PK.w_out; T->out = PK.out; T->ws = PK.ws; T->ph_lo = PK.ph_lo; T->ph_hi = PK.ph_hi;
    }
    unsigned char* wsb = PK.ws;
    const int ph_lo = PK.ph_lo, ph_hi = PK.ph_hi;
#ifdef PROBE_SUB
    __shared__ long long s_tacc, s_tprev; if (threadIdx.x == 0) { s_tacc = 0; s_tprev = 0; }
#endif
    for (int ph = ph_lo; ph < ph_hi; ++ph) {
#ifndef SPLIT_MIX
        if (ph > 8 && ((ph - 1) & 7) == 0) continue;
#endif
        if (ph > ph_lo) cg::this_grid().sync();
        const Params& P = PK;
#ifdef PROBE_SUB
        if (threadIdx.x == 0) { const long long t_now = wall_clock64();
#ifdef SPLIT_MIX
            const int prev_sub = (ph == 0) ? -1 : (ph == 1 ? 9 : ((ph - 2) % 9));
#else
            const int prev_sub = (ph == 0) ? -1 : (ph == 1 ? 8 : ((ph - 2) & 7));
#endif
            if (prev_sub == PROBE_SUB) s_tacc += t_now - s_tprev; s_tprev = t_now; }
#endif
#ifdef ONLYP
#define PH_ON(n) ((ONLYP >> (n)) & 1)
#else
#define PH_ON(n) true
#endif
        if (ph == 0) { if (PH_ON(8)) phase_prologue(PK, ph, smem); continue; }
#ifdef SPLIT_MIX
        const int q = ph - 1, pass = q / 9, sub9 = q % 9, l = pass >> 1, hf = pass & 1;
        if (sub9 == 4 || sub9 == 5) { phase_mixers(P, ph, l, smem, sub9 - 3); continue; }
        const int sub = sub9 < 4 ? sub9 : sub9 - 1;
        switch (sub) {
            case 0: phase_norm(P, ph, l, hf); break;
            case 1: phase_gemm1(P, ph, l, smem); break;
            case 2: phase_gemm2(P, ph, l, smem); break;
            case 3: phase_finalize(P, ph, l, smem); break;
            case 5: phase_scanfin(P, ph, l); break;
            case 6: phase_merge(P, ph, l, smem); break;
            default: phase_out(P, ph, l, hf, smem); break;
        }
#else
        const int q = ph - 1, pass = q >> 3, sub = q & 7, l = pass >> 1, hf = pass & 1;
        switch (sub) {
            case 0: if (PH_ON(0)) phase_norm(P, ph, l, hf); break;
            case 1: if (PH_ON(1)) phase_gemm1(P, ph, l, smem); break;
            case 2: if (PH_ON(2)) phase_gemm2(P, ph, l, smem); break;
            case 3: if (PH_ON(3)) phase_finalize(P, ph, l, smem); break;
            case 4: if (PH_ON(4)) phase_mixers(P, ph, l, smem); break;
            case 5: if (PH_ON(5)) phase_scanfin(P, ph, l); break;
            case 6: if (PH_ON(6)) phase_merge(P, ph, l, smem); break;
            default: if (PH_ON(7)) { phase_out(P, ph, l, hf, smem); if (pass < 3) phase_norm(P, ph + 40, (pass + 1) >> 1, (pass + 1) & 1); } break;
        }
#endif
    }
#ifdef PROBE_SUB
    cg::this_grid().sync();
    if (threadIdx.x == 0) { const long long t_now = wall_clock64(); if (7 == PROBE_SUB) s_tacc += t_now - s_tprev;
      if (blockIdx.x == 0) { const long long t_acc = s_tacc; const long long t0 = wall_clock64(); while (wall_clock64() - t0 < t_acc) { __builtin_amdgcn_s_sleep(10); } } }
#endif
}

extern "C" void kernel_launch(void* const* d_in, const int* in_sizes, int n_in, void* d_out, int out_size, void* d_ws, size_t ws_size, hipStream_t stream) {
    static int grid = 0;
    if (grid == 0) {
        if (ws_size < WS_END) { fprintf(stderr, "workspace too small: %zu < %zu\n", ws_size, (size_t)WS_END); grid = -1; return; }
        int dev = 0, cus = 0, per_cu = 0;
        hipGetDevice(&dev);
        hipDeviceGetAttribute(&cus, hipDeviceAttributeMultiprocessorCount, dev);
        hipFuncSetAttribute((const void*)mega, hipFuncAttributeMaxDynamicSharedMemorySize, LDS_BYTES);
        hipOccupancyMaxActiveBlocksPerMultiprocessor(&per_cu, (const void*)mega, 256, LDS_BYTES);
        if (per_cu < 1) per_cu = 1;
        if (per_cu > 2) per_cu = 2;
        grid = cus * per_cu;
        (void)hipGetLastError();
    }
    if (grid < 0) return;
    hipMemsetAsync((unsigned char*)d_ws + OFF_CTL, 0, 4096, stream);
    Params p{};
    const float** pp = (const float**)&p;
    for (int i = 0; i < 26; ++i) pp[i] = (const float*)d_in[i];
    p.out = (float*)d_out; p.ws = (unsigned char*)d_ws;
#if SINGLE_LAUNCH
    p.ph_lo = 0; p.ph_hi = NPHASE;
    void* args[] = {&p};
    hipError_t e = hipLaunchCooperativeKernel((const void*)mega, dim3(grid), dim3(256), args, LDS_BYTES, stream);
    if (e != hipSuccess) fprintf(stderr, "cooperative launch failed: %s (grid %d)\n", hipGetErrorString(e), grid);
#else
    for (int ph = 0; ph < NPHASE; ++ph) {
        p.ph_lo = ph; p.ph_hi = ph + 1;
        hipLaunchKernelGGL(mega, dim3(grid), dim3(256), LDS_BYTES, stream, p);
    }
#endif
}
```

```cpp
#include <hip/hip_runtime.h>
#include <hip/hip_cooperative_groups.h>
#include <stdint.h>
#include <stdio.h>
namespace cg = cooperative_groups;

typedef unsigned short bf16_t;
typedef short bf16x8 __attribute__((ext_vector_type(8)));
typedef short bf16x4 __attribute__((ext_vector_type(4)));
typedef float f32x16 __attribute__((ext_vector_type(16)));

#ifndef SINGLE_LAUNCH
#define SINGLE_LAUNCH 1
#endif

constexpr int D = 1024, SEQ = 8192, CTXL = 256, TB = SEQ + CTXL  , NTH = 2 * TB  ;
constexpr int INW = 7104, PW = 7104;
constexpr int C_CQ = 0, C_CKV = 256, C_KR = 384, C_NQ = 416, C_NK = 928, C_NV = 1440, C_HQ = 1952, C_HF = 2464, C_HI = 3488,
              C_GQ = 4000, C_GK = 4256, C_GV = 4512, C_GR = 5024, C_Z = 5056;
constexpr float EPS = 1e-6f;
constexpr float LOG2E = 1.4426950408889634f;
constexpr int LDS_BYTES = 73728;
#ifdef SPLIT_MIX
constexpr int NPHASE = 37;
#else
constexpr int NPHASE = 33;
#endif

constexpr size_t al256(size_t v) { return (v + 255) & ~(size_t)255; }
constexpr size_t OFF_CTL = 0;
constexpr size_t OFF_TAB = 1024;
constexpr size_t OFF_MOD = 4096;
constexpr size_t OFF_CX1 = al256(OFF_MOD + 2 * 5 * 3072 * 4);
constexpr size_t OFF_WIN = al256(OFF_CX1 + (size_t)4 * 256 * 1024 * 4);
constexpr size_t OFF_WM = al256(OFF_WIN + (size_t)2 * 7168 * 1024 * 2);
constexpr size_t OFF_WBR = al256(OFF_WM + (size_t)8 * 1024 * 1024 * 2);
constexpr size_t OFF_WO = al256(OFF_WBR + (size_t)8 * 1024 * 512 * 2);
constexpr size_t OFF_WUQ = al256(OFF_WO + (size_t)2 * 1024 * 1024 * 2);
constexpr size_t OFF_WUKV = al256(OFF_WUQ + (size_t)2 * 768 * 256 * 2);
constexpr size_t OFF_H = al256(OFF_WUKV + (size_t)2 * 1024 * 128 * 2);
constexpr size_t OFF_PB = al256(OFF_H + (size_t)NTH * 1024 * 2);
constexpr size_t OFF_QF = al256(OFF_PB + (size_t)NTH * PW * 2);
constexpr size_t OFF_KV = al256(OFF_QF + (size_t)NTH * 768 * 2);
constexpr size_t OFF_KF = al256(OFF_KV + (size_t)NTH * 1024 * 2);
constexpr size_t OFF_VTM = al256(OFF_KF + (size_t)NTH * 768 * 2);
constexpr size_t OFF_VTN = al256(OFF_VTM + (size_t)2 * 8 * 64 * TB * 2);
constexpr size_t OFF_OSG = al256(OFF_VTN + (size_t)2 * 8 * 64 * TB * 2);
constexpr size_t OFF_XH = al256(OFF_OSG + (size_t)2 * NTH * 512 * 2);
constexpr size_t OFF_XG = al256(OFF_XH + (size_t)NTH * 512 * 2);
constexpr size_t OFF_EBH = al256(OFF_XG + (size_t)NTH * 512 * 2);
constexpr size_t OFF_EBG = al256(OFF_EBH + (size_t)528 * 2 * 512 * 4);
constexpr size_t WS_END = al256(OFF_EBG + (size_t)528 * 2 * 256 * 4);

static_assert(WS_END <= (size_t)512 * 1024 * 1024, "workspace map exceeds 512 MiB");
struct Params {
    const float *x, *c, *ctx, *c_ctx, *ada_w, *ada_b, *norm_g, *w_in, *w_uq, *w_ukv, *g_cq, *g_ckv, *g_q, *g_k, *rpb, *ng_q, *ng_k,
        *lb_logits, *hg_g_o, *gla_w2, *gla_b2, *gla_g_o, *w_br, *w_merge, *b_merge, *w_out;
    float* out;
    unsigned char* ws;
    int ph_lo, ph_hi;
};

__device__ __forceinline__ float bf2f(bf16_t v) { return __uint_as_float(((unsigned)v) << 16); }
typedef float f32x2_t __attribute__((ext_vector_type(2)));
typedef __bf16 bf16x2_t __attribute__((ext_vector_type(2)));
__device__ __forceinline__ unsigned cvt_pk(float lo, float hi) { f32x2_t v = {lo, hi}; bf16x2_t b = __builtin_convertvector(v, bf16x2_t); return __builtin_bit_cast(unsigned, b); }
__device__ __forceinline__ unsigned cvt_pk_asm(float lo, float hi) { unsigned r; asm("s_nop 1\n\tv_cvt_pk_bf16_f32 %0, %1, %2" : "=v"(r) : "v"(lo), "v"(hi)); return r; }
__device__ __forceinline__ bf16_t f2bf(float f) { return (bf16_t)(cvt_pk(f, 0.f) & 0xffffu); }
__device__ __forceinline__ float lo16(unsigned u) { return __uint_as_float(u << 16); }
__device__ __forceinline__ float hi16(unsigned u) { return __uint_as_float(u & 0xffff0000u); }
__device__ __forceinline__ float sigmoidf_(float x) { return 1.f / (1.f + __expf(-x)); }
__device__ __forceinline__ float siluf_(float x) { return x / (1.f + __expf(-x)); }
__device__ __forceinline__ float wave_sum(float v) {
#pragma unroll
    for (int o = 32; o > 0; o >>= 1) v += __shfl_xor(v, o);
    return v;
}
__device__ __forceinline__ void unpack8(uint4 u, float* f) {
    f[0] = lo16(u.x); f[1] = hi16(u.x); f[2] = lo16(u.y); f[3] = hi16(u.y); f[4] = lo16(u.z); f[5] = hi16(u.z); f[6] = lo16(u.w); f[7] = hi16(u.w);
}
__device__ __forceinline__ uint4 pack8(const float* f) { uint4 u; u.x = cvt_pk(f[0], f[1]); u.y = cvt_pk(f[2], f[3]); u.z = cvt_pk(f[4], f[5]); u.w = cvt_pk(f[6], f[7]); return u; }

__device__ __forceinline__ int tid_opaque() { int t = threadIdx.x; asm volatile("" : "+v"(t)); return t; }
__shared__ int s_item;
__device__ __forceinline__ int next_item(const Params& P, int ph) {
    __syncthreads();
    if (threadIdx.x == 0) s_item = atomicAdd((int*)(P.ws + OFF_CTL) + ph, 1);
    __syncthreads();
    return s_item;
}

constexpr int GS = 72;
__device__ __forceinline__ void gemm_tile(f32x16 (&acc)[2][2], const bf16_t* __restrict__ A, int lda, const bf16_t* __restrict__ Bt, int ldb, int K, unsigned char* smem) {
    const int tid = tid_opaque(), lane = tid & 63, wave = tid >> 6, wr = wave >> 1, wc = wave & 1;
    bf16_t* sA = (bf16_t*)smem;
    bf16_t* sB = sA + 2 * 128 * GS;
    const int lrow = tid >> 3, lch = (tid & 7) * 8;
    uint4 ra[4], rb[4];
    const bf16_t* Ap = A + (size_t)lrow * lda + lch;
    const bf16_t* Bp = Bt + (size_t)lrow * ldb + lch;
#pragma unroll
    for (int i = 0; i < 4; ++i) { ra[i] = *(const uint4*)(Ap + (size_t)(32 * i) * lda); rb[i] = *(const uint4*)(Bp + (size_t)(32 * i) * ldb); }
#pragma unroll
    for (int i = 0; i < 4; ++i) { *(uint4*)(sA + (lrow + 32 * i) * GS + lch) = ra[i]; *(uint4*)(sB + (lrow + 32 * i) * GS + lch) = rb[i]; }
    __syncthreads();
    const int nk = K >> 6;
    const int aoff = (wr * 64 + (lane & 31)) * GS + (lane >> 5) * 8, boff = (wc * 64 + (lane & 31)) * GS + (lane >> 5) * 8;
    for (int kt = 0; kt < nk; ++kt) {
        const bool more = kt + 1 < nk;
        if (more) {
#pragma unroll
            for (int i = 0; i < 4; ++i) { ra[i] = *(const uint4*)(Ap + (size_t)(32 * i) * lda + (kt + 1) * 64); rb[i] = *(const uint4*)(Bp + (size_t)(32 * i) * ldb + (kt + 1) * 64); }
        }
        const bf16_t* a = sA + (kt & 1) * 128 * GS + aoff;
        const bf16_t* b = sB + (kt & 1) * 128 * GS + boff;
#pragma unroll
        for (int ks = 0; ks < 4; ++ks) {
            bf16x8 a0 = *(const bf16x8*)(a + ks * 16), a1 = *(const bf16x8*)(a + 32 * GS + ks * 16);
            bf16x8 b0 = *(const bf16x8*)(b + ks * 16), b1 = *(const bf16x8*)(b + 32 * GS + ks * 16);
            acc[0][0] = __builtin_amdgcn_mfma_f32_32x32x16_bf16(a0, b0, acc[0][0], 0, 0, 0);
            acc[0][1] = __builtin_amdgcn_mfma_f32_32x32x16_bf16(a0, b1, acc[0][1], 0, 0, 0);
            acc[1][0] = __builtin_amdgcn_mfma_f32_32x32x16_bf16(a1, b0, acc[1][0], 0, 0, 0);
            acc[1][1] = __builtin_amdgcn_mfma_f32_32x32x16_bf16(a1, b1, acc[1][1], 0, 0, 0);
        }
        if (more) {
            bf16_t* wa = sA + ((kt + 1) & 1) * 128 * GS;
            bf16_t* wb = sB + ((kt + 1) & 1) * 128 * GS;
#pragma unroll
            for (int i = 0; i < 4; ++i) { *(uint4*)(wa + (lrow + 32 * i) * GS + lch) = ra[i]; *(uint4*)(wb + (lrow + 32 * i) * GS + lch) = rb[i]; }
        }
        __syncthreads();
    }
}

__device__ __forceinline__ void gemm_tile_pf2(f32x16 (&acc)[2][2], const bf16_t* __restrict__ A, int lda, const bf16_t* __restrict__ Bt, int ldb, int K, unsigned char* smem) {
    const int tid = tid_opaque(), lane = tid & 63, wave = tid >> 6, wr = wave >> 1, wc = wave & 1;
    bf16_t* sA = (bf16_t*)smem;
    bf16_t* sB = sA + 2 * 128 * GS;
    const int lrow = tid >> 3, lch = (tid & 7) * 8;
    uint4 pa0, pa1, pa2, pa3, pb0, pb1, pb2, pb3, qa0, qa1, qa2, qa3, qb0, qb1, qb2, qb3;
    const bf16_t* Ap = A + (size_t)lrow * lda + lch;
    const bf16_t* Bp = Bt + (size_t)lrow * ldb + lch;
    const int nk = K >> 6;
#define PF2_LD1(RA, RB, kt_, i) { RA##i = *(const uint4*)(Ap + (size_t)(32 * i) * lda + (kt_) * 64); RB##i = *(const uint4*)(Bp + (size_t)(32 * i) * ldb + (kt_) * 64); }
#define PF2_LOAD(RA, RB, kt_) { PF2_LD1(RA, RB, kt_, 0) PF2_LD1(RA, RB, kt_, 1) PF2_LD1(RA, RB, kt_, 2) PF2_LD1(RA, RB, kt_, 3) }
#define PF2_WR1(RA, RB, i) { *(uint4*)(wa + (lrow + 32 * i) * GS + lch) = RA##i; *(uint4*)(wb + (lrow + 32 * i) * GS + lch) = RB##i; }
#define PF2_WRITE(RA, RB, buf_) { bf16_t* wa = sA + (buf_) * 128 * GS; bf16_t* wb = sB + (buf_) * 128 * GS; PF2_WR1(RA, RB, 0) PF2_WR1(RA, RB, 1) PF2_WR1(RA, RB, 2) PF2_WR1(RA, RB, 3) }
#define PF2_COMPUTE(buf_) { const bf16_t* a = sA + (buf_) * 128 * GS + aoff; const bf16_t* b = sB + (buf_) * 128 * GS + boff; _Pragma("unroll") for (int ks = 0; ks < 4; ++ks) { \
        bf16x8 a0 = *(const bf16x8*)(a + ks * 16), a1 = *(const bf16x8*)(a + 32 * GS + ks * 16); bf16x8 b0 = *(const bf16x8*)(b + ks * 16), b1 = *(const bf16x8*)(b + 32 * GS + ks * 16); \
        acc[0][0] = __builtin_amdgcn_mfma_f32_32x32x16_bf16(a0, b0, acc[0][0], 0, 0, 0); acc[0][1] = __builtin_amdgcn_mfma_f32_32x32x16_bf16(a0, b1, acc[0][1], 0, 0, 0); \
        acc[1][0] = __builtin_amdgcn_mfma_f32_32x32x16_bf16(a1, b0, acc[1][0], 0, 0, 0); acc[1][1] = __builtin_amdgcn_mfma_f32_32x32x16_bf16(a1, b1, acc[1][1], 0, 0, 0); } }
    const int aoff = (wr * 64 + (lane & 31)) * GS + (lane >> 5) * 8, boff = (wc * 64 + (lane & 31)) * GS + (lane >> 5) * 8;
    PF2_LOAD(pa, pb, 0);
    PF2_LOAD(qa, qb, 1);
    PF2_WRITE(pa, pb, 0);
    __syncthreads();
    for (int kt = 0; kt < nk; kt += 2) {
        if (kt + 2 < nk) PF2_LOAD(pa, pb, kt + 2);
        PF2_COMPUTE(0);
        PF2_WRITE(qa, qb, 1);
        __syncthreads();
        if (kt + 3 < nk) PF2_LOAD(qa, qb, kt + 3);
        PF2_COMPUTE(1);
        if (kt + 2 < nk) PF2_WRITE(pa, pb, 0);
        __syncthreads();
    }
#undef PF2_LOAD
#undef PF2_LD1
#undef PF2_WR1
#undef PF2_WRITE
#undef PF2_COMPUTE
}

__device__ __forceinline__ void gemm_tile_n64(f32x16 (&acc)[2], const bf16_t* __restrict__ A, int lda, const bf16_t* __restrict__ Bt, int ldb, int K, unsigned char* smem) {
    const int tid = tid_opaque(), lane = tid & 63, wave = tid >> 6, wr = wave >> 1, wc = wave & 1;
    bf16_t* sA = (bf16_t*)smem;
    bf16_t* sB = sA + 2 * 128 * GS;
    const int lrow = tid >> 3, lch = (tid & 7) * 8;
    uint4 pa0, pa1, pa2, pa3, pb0, pb1, qa0, qa1, qa2, qa3, qb0, qb1;
    const bf16_t* Ap = A + (size_t)lrow * lda + lch;
    const bf16_t* Bp = Bt + (size_t)lrow * ldb + lch;
    const int nk = K >> 6;
#define N64_LOAD(RA, RB, kt_) { RA##0 = *(const uint4*)(Ap + (kt_) * 64); RA##1 = *(const uint4*)(Ap + (size_t)32 * lda + (kt_) * 64); RA##2 = *(const uint4*)(Ap + (size_t)64 * lda + (kt_) * 64); RA##3 = *(const uint4*)(Ap + (size_t)96 * lda + (kt_) * 64); \
        RB##0 = *(const uint4*)(Bp + (kt_) * 64); RB##1 = *(const uint4*)(Bp + (size_t)32 * ldb + (kt_) * 64); }
#define N64_WRITE(RA, RB, buf_) { bf16_t* wa = sA + (buf_) * 128 * GS + lrow * GS + lch; bf16_t* wb = sB + (buf_) * 64 * GS + lrow * GS + lch; \
        *(uint4*)wa = RA##0; *(uint4*)(wa + 32 * GS) = RA##1; *(uint4*)(wa + 64 * GS) = RA##2; *(uint4*)(wa + 96 * GS) = RA##3; *(uint4*)wb = RB##0; *(uint4*)(wb + 32 * GS) = RB##1; }
#define N64_COMPUTE(buf_) { const bf16_t* a = sA + (buf_) * 128 * GS + aoff; const bf16_t* b = sB + (buf_) * 64 * GS + boff; _Pragma("unroll") for (int ks = 0; ks < 4; ++ks) { \
        bf16x8 a0 = *(const bf16x8*)(a + ks * 16), a1 = *(const bf16x8*)(a + 32 * GS + ks * 16); bf16x8 b0 = *(const bf16x8*)(b + ks * 16); \
        acc[0] = __builtin_amdgcn_mfma_f32_32x32x16_bf16(a0, b0, acc[0], 0, 0, 0); acc[1] = __builtin_amdgcn_mfma_f32_32x32x16_bf16(a1, b0, acc[1], 0, 0, 0); } }
    const int aoff = (wr * 64 + (lane & 31)) * GS + (lane >> 5) * 8, boff = (wc * 32 + (lane & 31)) * GS + (lane >> 5) * 8;
    N64_LOAD(pa, pb, 0);
    N64_LOAD(qa, qb, 1);
    N64_WRITE(pa, pb, 0);
    __syncthreads();
    for (int kt = 0; kt < nk; kt += 2) {
        if (kt + 2 < nk) N64_LOAD(pa, pb, kt + 2);
        N64_COMPUTE(0);
        N64_WRITE(qa, qb, 1);
        __syncthreads();
        if (kt + 3 < nk) N64_LOAD(qa, qb, kt + 3);
        N64_COMPUTE(1);
        if (kt + 2 < nk) N64_WRITE(pa, pb, 0);
        __syncthreads();
    }
#undef N64_LOAD
#undef N64_WRITE
#undef N64_COMPUTE
}
__device__ __forceinline__ void zero_acc(f32x16 (&acc)[2][2]) {
#pragma unroll
    for (int i = 0; i < 2; ++i)
#pragma unroll
        for (int j = 0; j < 2; ++j)
#pragma unroll
            for (int r = 0; r < 16; ++r) acc[i][j][r] = 0.f;
}
#define ACC_ROW(mi, r) (wr * 64 + (mi) * 32 + ((r) & 3) + 8 * ((r) >> 2) + 4 * (lane >> 5))
#define ACC_COL(ni) (wc * 64 + (ni) * 32 + (lane & 31))

__device__ void tr_tile(const float* __restrict__ src, int K, int N, int kt, int nt, bf16_t* __restrict__ dst, const float* __restrict__ scale, float* s) {
    const int tid = tid_opaque(), r = tid >> 4, c4 = (tid & 15) * 4;
#pragma unroll
    for (int i = 0; i < 4; ++i) {
        const int k = kt * 64 + r + 16 * i;
        float4 v = *(const float4*)(src + (size_t)k * N + nt * 64 + c4);
        const float sc = scale ? scale[k] : 1.f;
        float* d = s + (r + 16 * i) * 65 + c4;
        d[0] = v.x * sc; d[1] = v.y * sc; d[2] = v.z * sc; d[3] = v.w * sc;
    }
    __syncthreads();
    const int n = tid >> 2, k0 = (tid & 3) * 16;
    float f[16];
#pragma unroll
    for (int j = 0; j < 16; ++j) f[j] = s[(k0 + j) * 65 + n];
    bf16_t* o = dst + (size_t)(nt * 64 + n) * K + kt * 64 + k0;
    *(uint4*)o = pack8(f);
    *(uint4*)(o + 8) = pack8(f + 8);
    __syncthreads();
}
__device__ void phase_prologue(const Params& P, int ph, unsigned char* smem) {
    float* s = (float*)smem;
    const int NTR = 7296, NMOD = 96;
    for (;;) {
        const int u = next_item(P, ph);
        if (u >= NTR + NMOD) break;
        if (u < NMOD) {
            const int l = u / 48, cb = u % 48, tid = threadIdx.x, lane = tid & 63, wave = tid >> 6;
            float* sc = s;
            float* red = s + 5 * 1024;
            for (int i = tid; i < 5 * 1024; i += 256) { const int r = i >> 10, k = i & 1023; const float v = (r < 4) ? P.c[r * 1024 + k] : P.c_ctx[k]; sc[i] = siluf_(v); }
            __syncthreads();
            const int col = cb * 64 + lane;
            float acc[5] = {0.f, 0.f, 0.f, 0.f, 0.f};
            const float* w = P.ada_w + (size_t)l * 1024 * 3072 + col;
#pragma unroll 8
            for (int k = wave * 256; k < wave * 256 + 256; ++k) {
                const float wv = w[(size_t)k * 3072];
#pragma unroll
                for (int r = 0; r < 5; ++r) acc[r] += sc[r * 1024 + k] * wv;
            }
#pragma unroll
            for (int r = 0; r < 5; ++r) red[(wave * 5 + r) * 64 + lane] = acc[r];
            __syncthreads();
            if (wave == 0) {
                float* mod = (float*)(P.ws + OFF_MOD);
#pragma unroll
                for (int r = 0; r < 5; ++r) mod[(l * 5 + r) * 3072 + col] = red[r * 64 + lane] + red[(5 + r) * 64 + lane] + red[(10 + r) * 64 + lane] + red[(15 + r) * 64 + lane] + P.ada_b[l * 3072 + col];
            }
            continue;
        }
        const int v = u - NMOD, l = v / 3648, r = v % 3648;
        if (r < 1776) tr_tile(P.w_in + (size_t)l * 1024 * INW, 1024, INW, r / 111, r % 111, (bf16_t*)(P.ws + OFF_WIN) + (size_t)l * 7168 * 1024, nullptr, s);
        else if (r < 2800) { const int r2 = r - 1776, br = r2 >> 8, t = r2 & 255; tr_tile(P.w_merge + (size_t)(l * 4 + br) * 1024 * 1024, 1024, 1024, t >> 4, t & 15, (bf16_t*)(P.ws + OFF_WM) + (size_t)(l * 4 + br) * 1024 * 1024, nullptr, s); }
        else if (r < 3312) { const int r2 = r - 2800, br = r2 >> 7, t = r2 & 127; tr_tile(P.w_br + (size_t)(l * 4 + br) * 512 * 1024, 512, 1024, t >> 4, t & 15, (bf16_t*)(P.ws + OFF_WBR) + (size_t)(l * 4 + br) * 1024 * 512, nullptr, s); }
        else if (r < 3568) { const int t = r - 3312; tr_tile(P.w_out + (size_t)l * 1024 * 1024, 1024, 1024, t >> 4, t & 15, (bf16_t*)(P.ws + OFF_WO) + (size_t)l * 1024 * 1024, nullptr, s); }
        else if (r < 3616) { const int t = r - 3568; tr_tile(P.w_uq + (size_t)l * 256 * 768, 256, 768, t / 12, t % 12, (bf16_t*)(P.ws + OFF_WUQ) + (size_t)l * 768 * 256, P.g_cq + l * 256, s); }
        else { const int t = r - 3616; tr_tile(P.w_ukv + (size_t)l * 128 * 1024, 128, 1024, t >> 4, t & 15, (bf16_t*)(P.ws + OFF_WUKV) + (size_t)l * 1024 * 128, P.g_ckv + l * 128, s); }
    }
}

__device__ void phase_norm(const Params& P, int ph, int l, int hf) {
    const int tid = tid_opaque(), lane = tid & 63, wave = tid >> 6;
    const float* mod = (const float*)(P.ws + OFF_MOD);
    bf16_t* H = (bf16_t*)(P.ws + OFF_H);
    for (;;) {
        const int u = next_item(P, ph);
        if (u >= NTH / 8) break;
        for (int rr = 0; rr < 2; ++rr) {
            const int t = u * 8 + wave * 2 + rr, bl = t / TB, p = t % TB, b = hf * 2 + bl;
            const float* src; int mr;
            if (p < CTXL) { src = (l == 0 ? P.ctx : (const float*)(P.ws + OFF_CX1)) + ((size_t)b * CTXL + p) * D; mr = 4; }
            else { src = (l == 0 ? P.x : (const float*)P.out) + ((size_t)b * SEQ + (p - CTXL)) * D; mr = b; }
            float4 v[4]; float ss = 0.f;
#pragma unroll
            for (int i = 0; i < 4; ++i) { v[i] = *(const float4*)(src + lane * 4 + 256 * i); ss += v[i].x * v[i].x + v[i].y * v[i].y + v[i].z * v[i].z + v[i].w * v[i].w; }
            ss = wave_sum(ss);
            const float rstd = rsqrtf(ss * (1.f / D) + EPS);
            const float* sh = mod + (l * 5 + mr) * 3072; const float* sc = sh + 1024; const float* g = P.norm_g + l * D;
#pragma unroll
            for (int i = 0; i < 4; ++i) {
                const int c = lane * 4 + 256 * i;
                const float4 gv = *(const float4*)(g + c), s1 = *(const float4*)(sc + c), s0 = *(const float4*)(sh + c);
                uint2 o;
                o.x = cvt_pk(v[i].x * rstd * gv.x * (1.f + s1.x) + s0.x, v[i].y * rstd * gv.y * (1.f + s1.y) + s0.y);
                o.y = cvt_pk(v[i].z * rstd * gv.z * (1.f + s1.z) + s0.z, v[i].w * rstd * gv.w * (1.f + s1.w) + s0.w);
                *(uint2*)(H + (size_t)t * D + c) = o;
            }
        }
    }
}

__device__ void phase_gemm1(const Params& P, int ph, int l, unsigned char* smem) {
    const int tid_ = tid_opaque(), lane = tid_ & 63, wave = tid_ >> 6, wr = wave >> 1, wc = wave & 1;
    const bf16_t* H = (const bf16_t*)(P.ws + OFF_H);
    const bf16_t* W = (const bf16_t*)(P.ws + OFF_WIN) + (size_t)l * 7168 * 1024;
    bf16_t* PB = (bf16_t*)(P.ws + OFF_PB);
    for (;;) {
        const int u = next_item(P, ph);
        if (u >= 132 * 56) break;
        const int mt = u / 56, nt = u % 56;
        f32x16 acc[2][2]; zero_acc(acc);
        gemm_tile_pf2(acc, H + (size_t)mt * 128 * D, D, W + (size_t)nt * 128 * D, D, D, smem);
#pragma unroll
        for (int mi = 0; mi < 2; ++mi)
#pragma unroll
            for (int ni = 0; ni < 2; ++ni) {
                const int col = nt * 128 + ACC_COL(ni);
                if (col < PW) {
#pragma unroll
                    for (int r = 0; r < 16; ++r) PB[(size_t)(mt * 128 + ACC_ROW(mi, r)) * PW + col] = f2bf(acc[mi][ni][r]);
                }
            }
    }
}

__device__ void phase_gemm2(const Params& P, int ph, int l, unsigned char* smem) {
    const int tid_ = tid_opaque(), lane = tid_ & 63, wave = tid_ >> 6, wr = wave >> 1, wc = wave & 1;
    const bf16_t* PB = (const bf16_t*)(P.ws + OFF_PB);
    for (;;) {
        const int u = next_item(P, ph);
        if (u >= 132 * 14) break;
        const int mt = u / 14, n14 = u % 14;
        f32x16 acc[2][2]; zero_acc(acc);
        bf16_t* O; int ldo, nt;
        if (n14 < 6) { nt = n14; O = (bf16_t*)(P.ws + OFF_QF); ldo = 768;
            gemm_tile_pf2(acc, PB + (size_t)mt * 128 * PW + C_CQ, PW, (const bf16_t*)(P.ws + OFF_WUQ) + (size_t)l * 768 * 256 + (size_t)nt * 128 * 256, 256, 256, smem); }
        else { nt = n14 - 6; O = (bf16_t*)(P.ws + OFF_KV); ldo = 1024;
            gemm_tile_pf2(acc, PB + (size_t)mt * 128 * PW + C_CKV, PW, (const bf16_t*)(P.ws + OFF_WUKV) + (size_t)l * 1024 * 128 + (size_t)nt * 128 * 128, 128, 128, smem); }
#pragma unroll
        for (int mi = 0; mi < 2; ++mi)
#pragma unroll
            for (int ni = 0; ni < 2; ++ni)
#pragma unroll
                for (int r = 0; r < 16; ++r) O[(size_t)(mt * 128 + ACC_ROW(mi, r)) * ldo + nt * 128 + ACC_COL(ni)] = f2bf(acc[mi][ni][r]);
    }
}

__device__ void phase_finalize(const Params& P, int ph, int l, unsigned char* smem) {
    const int tid = tid_opaque(), lane = tid & 63, wave = tid >> 6;
    bf16_t* PB = (bf16_t*)(P.ws + OFF_PB);
    bf16_t* QF = (bf16_t*)(P.ws + OFF_QF);
    const bf16_t* KV = (const bf16_t*)(P.ws + OFF_KV);
    bf16_t* KF = (bf16_t*)(P.ws + OFF_KF);
    bf16_t* VTM = (bf16_t*)(P.ws + OFF_VTM);
    bf16_t* VTN = (bf16_t*)(P.ws + OFF_VTN);
    float* rs = (float*)smem;
    const int hd = lane >> 3, j = lane & 7;
    const float invf = __powf(10000.f, -(float)j * 0.125f);
    for (;;) {
        const int u7 = next_item(P, ph);
        if (u7 >= (NTH / 32) * 11) break;
        const int u = u7 / 11, sub = u7 % 11;
        const int t0 = u * 32, bl = t0 / TB, p0 = t0 % TB;
        if (sub >= 1 && sub <= 4) {
        for (int rr = 0; rr < 2; ++rr) {
            const int tl = (sub - 1) * 8 + wave * 2 + rr, t = t0 + tl, p = p0 + tl;
            bf16_t* prow = PB + (size_t)t * PW;
            float s1 = 0.f, s2 = 0.f;
            { const uint2 a = *(const uint2*)(prow + C_CQ + lane * 4); const float f0 = lo16(a.x), f1 = hi16(a.x), f2 = lo16(a.y), f3 = hi16(a.y); s1 = f0 * f0 + f1 * f1 + f2 * f2 + f3 * f3;
              const unsigned b = *(const unsigned*)(prow + C_CKV + lane * 2); const float g0 = lo16(b), g1 = hi16(b); s2 = g0 * g0 + g1 * g1; }
            s1 = wave_sum(s1); s2 = wave_sum(s2);
            const float rcq = rsqrtf(s1 * (1.f / 256.f) + EPS), rckv = rsqrtf(s2 * (1.f / 128.f) + EPS);
            if (lane == 0) rs[tl] = rckv;
            {
                bf16_t* q = QF + (size_t)t * 768 + hd * 96;
                float v[12], ss = 0.f;
#pragma unroll
                for (int m = 0; m < 12; ++m) { v[m] = bf2f(q[j + 8 * m]) * rcq; ss += v[m] * v[m]; }
                ss += __shfl_xor(ss, 1); ss += __shfl_xor(ss, 2); ss += __shfl_xor(ss, 4);
                const float rn = rsqrtf(ss * (1.f / 96.f) + EPS);
#pragma unroll
                for (int m = 0; m < 12; ++m) q[j + 8 * m] = f2bf(v[m] * rn * P.g_q[l * 96 + j + 8 * m]);
            }
            {
                const bf16_t* kvr = KV + (size_t)t * 1024 + hd * 128;
                float v[12], ss = 0.f;
#pragma unroll
                for (int m = 0; m < 8; ++m) { v[m] = bf2f(kvr[j + 8 * m]) * rckv; ss += v[m] * v[m]; }
#pragma unroll
                for (int m = 8; m < 12; ++m) { v[m] = bf2f(prow[C_KR + j + 8 * (m - 8)]); ss += v[m] * v[m]; }
                ss += __shfl_xor(ss, 1); ss += __shfl_xor(ss, 2); ss += __shfl_xor(ss, 4);
                const float rn = rsqrtf(ss * (1.f / 96.f) + EPS);
#pragma unroll
                for (int m = 0; m < 12; ++m) v[m] = v[m] * rn * P.g_k[l * 96 + j + 8 * m];
                if (p >= CTXL) {
                    const int pos = p - CTXL;
                    const float ar = (float)(pos >> 6) * invf, ac = (float)(pos & 63) * invf;
                    double fr = (double)ar * 0.15915494309189535; fr -= rint(fr);
                    double fc = (double)ac * 0.15915494309189535; fc -= rint(fc);
                    const float sr = __builtin_amdgcn_sinf((float)fr), cr = __builtin_amdgcn_cosf((float)fr);
                    const float sc = __builtin_amdgcn_sinf((float)fc), cc = __builtin_amdgcn_cosf((float)fc);
                    const float x1a = v[8], x2a = v[10], x1b = v[9], x2b = v[11];
                    v[8] = x1a * cr - x2a * sr; v[10] = x1a * sr + x2a * cr;
                    v[9] = x1b * cc - x2b * sc; v[11] = x1b * sc + x2b * cc;
                }
                bf16_t* ko = KF + ((size_t)t * 8 + hd) * 96;
#pragma unroll
                for (int m = 0; m < 12; ++m) ko[j + 8 * m] = f2bf(v[m]);
            }
#pragma unroll
            for (int w = 0; w < 2; ++w) {
                bf16_t* q = prow + (w ? C_NK : C_NQ) + hd * 64 + j * 8;
                const float* g = (w ? P.ng_k : P.ng_q) + l * 64 + j * 8;
                float v[8], ss = 0.f;
                unpack8(*(const uint4*)q, v);
#pragma unroll
                for (int m = 0; m < 8; ++m) ss += v[m] * v[m];
                ss += __shfl_xor(ss, 1); ss += __shfl_xor(ss, 2); ss += __shfl_xor(ss, 4);
                const float rn = rsqrtf(ss * (1.f / 64.f) + EPS);
#pragma unroll
                for (int m = 0; m < 8; ++m) v[m] = v[m] * rn * g[m];
                *(uint4*)q = pack8(v);
            }
        }
        } else if (sub == 0) {
        {
            for (int rr = 0; rr < 8; ++rr) {
                const int tl = wave * 8 + rr;
                const unsigned bq = *(const unsigned*)(PB + (size_t)(t0 + tl) * PW + C_CKV + lane * 2);
                const float g0 = lo16(bq), g1 = hi16(bq);
                const float s2 = wave_sum(g0 * g0 + g1 * g1);
                if (lane == 0) rs[tl] = rsqrtf(s2 * (1.f / 128.f) + EPS);
            }
            __syncthreads();
            bf16_t* tile = (bf16_t*)(smem + 8192);
#pragma unroll
            for (int which = 0; which < 2; ++which) {
#pragma unroll
                for (int k8 = 0; k8 < 8; ++k8) {
                    const int id = tid + 256 * k8, i = id >> 6, c8 = id & 63;
                    const bf16_t* src = which ? PB + (size_t)(t0 + i) * PW + C_NV + c8 * 8
                                              : KV + (size_t)(t0 + i) * 1024 + (c8 >> 3) * 128 + 64 + (c8 & 7) * 8;
                    *(uint4*)(tile + i * 512 + c8 * 8) = *(const uint4*)src;
                }
                __syncthreads();
                bf16_t* VT = which ? VTN : VTM;
#pragma unroll
                for (int k8 = 0; k8 < 8; ++k8) {
                    const int id = tid + 256 * k8, r = id >> 2, g = id & 3;
                    float fv[8];
#pragma unroll
                    for (int i = 0; i < 8; ++i) fv[i] = bf2f(tile[(g * 8 + i) * 512 + r]) * (which ? 1.f : rs[g * 8 + i]);
                    *(uint4*)(VT + ((size_t)(bl * 8 + (r >> 6)) * 64 + (r & 63)) * TB + p0 + g * 8) = pack8(fv);
                }
                __syncthreads();
            }
        }
        } else
        {
            const int chunk = t0 >> 5;
            bf16_t* XH = (bf16_t*)(P.ws + OFF_XH);
            bf16_t* XG = (bf16_t*)(P.ws + OFF_XG);
            float* EBH = (float*)(P.ws + OFF_EBH);
            float* EBG = (float*)(P.ws + OFF_EBG);
            bf16_t* base = PB + (size_t)t0 * PW;
            float* rsh = (float*)smem + 256;
            bf16_t* inA = (bf16_t*)(smem + 8192);
            bf16_t* inB = inA + 32 * 128;
            bf16_t* inC = inB + 32 * 128;
            bf16_t* outT = inC + 32 * 128;
#pragma unroll
            for (int k4 = 0; k4 < 4; ++k4) { const int id = tid + 256 * k4, i = id >> 5, jx = id & 31; rsh[id] = bf2f(base[(size_t)i * PW + C_GR + jx]); }
            const int d = tid & 127, dr = tid >> 7;
            { const int grp = sub - 5;
                const bool isg = grp >= 4;
                const int gcol = isg ? (grp - 4) * 128 : grp * 128;
                const int cA = isg ? C_GQ + gcol : C_HQ + gcol, cB = isg ? C_GK + gcol : C_HF + gcol, cC = C_HF + 512 + gcol;
#pragma unroll
                for (int k2 = 0; k2 < 2; ++k2) {
                    const int id = tid + 256 * k2, i = id >> 4, ch = id & 15;
                    const bf16_t* row = base + (size_t)i * PW;
                    *(uint4*)(inA + i * 128 + ch * 8) = *(const uint4*)(row + cA + ch * 8);
                    *(uint4*)(inB + i * 128 + ch * 8) = *(const uint4*)(row + cB + ch * 8);
                    if (!isg) *(uint4*)(inC + i * 128 + ch * 8) = *(const uint4*)(row + cC + ch * 8);
                }
                __syncthreads();
                {
                    const int col = gcol + d;
                    float lb = 0.f, b2 = 0.f, w2[16];
#pragma unroll
                    for (int jx = 0; jx < 16; ++jx) w2[jx] = 0.f;
                    if (isg) {
#pragma unroll
                        for (int jx = 0; jx < 16; ++jx) w2[jx] = P.gla_w2[((size_t)(l * 2 + dr) * 16 + jx) * 256 + col];
                        b2 = P.gla_b2[(l * 2 + dr) * 256 + col];
                    } else if (l != 0) lb = sigmoidf_(P.lb_logits[1024 + dr * 512 + col] - P.lb_logits[dr * 512 + col]);
                    const bf16_t* fsrc = (dr && !isg) ? inC : inB;
                    bf16_t* oq = outT + (dr ? 2 : 0) * 32 * 128;
                    bf16_t* ok = oq + 32 * 128;
                    float cum = 0.f;
#pragma unroll 4
                    for (int sx = 0; sx < 32; ++sx) {
                        const int i = dr ? 31 - sx : sx;
                        const float qv = bf2f(inA[i * 128 + d]), fv = bf2f(fsrc[i * 128 + d]);
                        float qq, kk, la;
                        if (isg) {
                            float g = b2;
#pragma unroll
                            for (int jx = 0; jx < 16; ++jx) g = fmaf(rsh[i * 32 + dr * 16 + jx], w2[jx], g);
                            la = (fminf(g, 0.f) - __logf(1.f + __expf(-fabsf(g)))) * 0.0625f;
                            qq = qv * 0.125f; kk = fv;
                        } else {
                            const float av = lb + (1.f - lb) * sigmoidf_(fv);
                            la = __logf(av); kk = 1.f - av;
                            qq = siluf_(qv) * 0.08838834764831845f;
                        }
                        cum += la;
                        oq[i * 128 + d] = f2bf(qq * __expf(cum));
                        ok[i * 128 + d] = f2bf(kk * __expf(-cum));
                    }
                    if (isg) EBG[(size_t)(chunk * 2 + dr) * 256 + col] = __expf(cum);
                    else EBH[(size_t)(chunk * 2 + dr) * 512 + col] = __expf(cum);
                }
                __syncthreads();
#pragma unroll
                for (int k2 = 0; k2 < 2; ++k2) {
                    const int id = tid + 256 * k2, i = id >> 4, ch = id & 15;
                    bf16_t* row = base + (size_t)i * PW;
                    const uint4 v0 = *(const uint4*)(outT + (0 * 32 + i) * 128 + ch * 8), v1 = *(const uint4*)(outT + (1 * 32 + i) * 128 + ch * 8);
                    const uint4 v2 = *(const uint4*)(outT + (2 * 32 + i) * 128 + ch * 8), v3 = *(const uint4*)(outT + (3 * 32 + i) * 128 + ch * 8);
                    *(uint4*)(row + cA + ch * 8) = v0;
                    *(uint4*)(row + cB + ch * 8) = v1;
                    if (isg) { bf16_t* xr = XG + (size_t)(t0 + i) * 512 + gcol + ch * 8; *(uint4*)xr = v2; *(uint4*)(xr + 256) = v3; }
                    else { *(uint4*)(XH + (size_t)(t0 + i) * 512 + gcol + ch * 8) = v2; *(uint4*)(row + cC + ch * 8) = v3; }
                }
                __syncthreads();
            }
        }
    }
}

template <int DQK, bool NAT>
__device__ void attn_item(const Params& P, int l, int bl, int head, int qb, unsigned char* smem) {
    constexpr int NKS = DQK / 16, KSTR = DQK + 8, VSTR = 68, KCH = DQK / 8, KLD = (DQK * 64 / 8) / 256;
    const int tid = tid_opaque(), lane = tid & 63, wave = tid >> 6, hh = lane >> 5, r32 = lane & 31;
    bf16_t* Ks = (bf16_t*)smem;
    bf16_t* Vs = Ks + 2 * 64 * KSTR;
    float* rpb_s = (float*)(Vs + 2 * 64 * VSTR);
    bf16_t* PB = (bf16_t*)(P.ws + OFF_PB);
    const int rowbase = bl * TB, q_p0 = qb * 128, ql = wave * 32 + r32;
    const bool q_ctx = qb < 2;
    int lt0 = 0, lt1 = 0;
    int qr = 0, qc = 0, r0w = 0, c0 = 0;
    if (!q_ctx) {
        if (NAT) { const int rp = qb - 2, ra = 2 * rp, rb = ra + 1; lt0 = min(max(ra - 4, 0), 120); lt1 = min(max(rb - 4, 0), 120) + 8;
            qr = ra + (wave >> 1); qc = (wave & 1) * 32 + r32; r0w = min(max(qr - 4, 0), 120); c0 = min(max(qc - 8, 0), 48); }
        else { lt0 = 0; lt1 = 128; }
    }
    const int ntiles = 4 + (lt1 - lt0);
    const bf16_t* Kbase; const bf16_t* VT; const bf16_t* qptr; int k_ld;
    if (NAT) { Kbase = PB + (size_t)rowbase * PW + C_NK + head * 64; k_ld = PW; VT = (const bf16_t*)(P.ws + OFF_VTN) + (size_t)(bl * 8 + head) * 64 * TB;
        qptr = PB + (size_t)(rowbase + q_p0 + ql) * PW + C_NQ + head * 64; }
    else { Kbase = (const bf16_t*)(P.ws + OFF_KF) + (size_t)rowbase * 768 + head * 96; k_ld = 768; VT = (const bf16_t*)(P.ws + OFF_VTM) + (size_t)(bl * 8 + head) * 64 * TB;
        qptr = (const bf16_t*)(P.ws + OFF_QF) + (size_t)(rowbase + q_p0 + ql) * 768 + head * 96; }
    if (NAT) { for (int i = tid; i < 465; i += 256) rpb_s[i] = P.rpb[(size_t)(l * 8 + head) * 465 + i] * LOG2E; }
    bf16x8 qf[NKS];
#pragma unroll
    for (int ks = 0; ks < NKS; ++ks) qf[ks] = *(const bf16x8*)(qptr + ks * 16 + hh * 8);
    bf16x8 qrot4 = qf[NKS - 2], qrot5 = qf[NKS - 1];
    if (!NAT && !q_ctx) {
        const int pos = q_p0 - CTXL + ql;
        const float base = hh ? (float)(pos & 63) : (float)(pos >> 6);
#pragma unroll
        for (int jj = 0; jj < 8; ++jj) {
            const float invf = __powf(10000.f, -(float)jj * 0.125f);
            const float ang = base * invf;
            double fr = (double)ang * 0.15915494309189535; fr -= rint(fr);
            const float sn = __builtin_amdgcn_sinf((float)fr), cs = __builtin_amdgcn_cosf((float)fr);
            const float x1 = bf2f((bf16_t)qf[4][jj]), x2 = bf2f((bf16_t)qf[5][jj]);
            qrot4[jj] = (short)f2bf(x1 * cs - x2 * sn);
            qrot5[jj] = (short)f2bf(x1 * sn + x2 * cs);
        }
    }
    const float sc2 = (NAT ? 0.125f : 0.10206207261596575f) * LOG2E;
    float m_run = -1e30f, lsum = 0.f;
    f32x16 oacc[2];
#pragma unroll
    for (int r = 0; r < 16; ++r) { oacc[0][r] = 0.f; oacc[1][r] = 0.f; }
    uint4 kreg0, kreg1, kreg2, vreg0, vreg1;
    kreg2 = make_uint4(0, 0, 0, 0);
    const int kid0 = tid, kid1 = tid + 256, kid2 = tid + 512;
    const int krow0 = kid0 / KCH, kch0 = kid0 % KCH, krow1 = kid1 / KCH, kch1 = kid1 % KCH, krow2 = kid2 / KCH, kch2 = kid2 % KCH;
    const int vrow0 = tid >> 3, vch = tid & 7, vrow1 = vrow0 + 32;
#define TILE_P(ti) ((ti) < 4 ? (ti) * 64 : CTXL + (lt0 + (ti) - 4) * 64)
#define GLOAD(ti) { const int p_ = TILE_P(ti); \
        kreg0 = *(const uint4*)(Kbase + (size_t)(p_ + krow0) * k_ld + kch0 * 8); \
        kreg1 = *(const uint4*)(Kbase + (size_t)(p_ + krow1) * k_ld + kch1 * 8); \
        if (KLD > 2) kreg2 = *(const uint4*)(Kbase + (size_t)(p_ + krow2) * k_ld + kch2 * 8); \
        vreg0 = *(const uint4*)(VT + (size_t)vrow0 * TB + p_ + vch * 8); \
        vreg1 = *(const uint4*)(VT + (size_t)vrow1 * TB + p_ + vch * 8); }
#define SWRITE(buf_) { bf16_t* kd_ = Ks + (buf_) * 64 * KSTR; \
        *(uint4*)(kd_ + krow0 * KSTR + kch0 * 8) = kreg0; *(uint4*)(kd_ + krow1 * KSTR + kch1 * 8) = kreg1; \
        if (KLD > 2) *(uint4*)(kd_ + krow2 * KSTR + kch2 * 8) = kreg2; \
        bf16_t* vd_ = Vs + (buf_) * 64 * VSTR + vch * 8; \
        *(uint2*)(vd_ + vrow0 * VSTR) = make_uint2(vreg0.x, vreg0.y); *(uint2*)(vd_ + vrow0 * VSTR + 4) = make_uint2(vreg0.z, vreg0.w); \
        *(uint2*)(vd_ + vrow1 * VSTR) = make_uint2(vreg1.x, vreg1.y); *(uint2*)(vd_ + vrow1 * VSTR + 4) = make_uint2(vreg1.z, vreg1.w); }
    GLOAD(0); SWRITE(0);
    __syncthreads();
    for (int ti = 0; ti < ntiles; ++ti) {
        const int buf = ti & 1;
        const bool more = ti + 1 < ntiles;
        if (more) GLOAD(ti + 1);
        if (!NAT && ti == 4) { qf[NKS - 2] = qrot4; qf[NKS - 1] = qrot5; }
        const int kr = lt0 + ti - 4;
        const bool active = !NAT || ti < 4 || (kr >= r0w && kr < r0w + 8);
        if (active) {
            const bf16_t* kb = Ks + buf * 64 * KSTR + r32 * KSTR + hh * 8;
            f32x16 st0, st1;
#pragma unroll
            for (int r = 0; r < 16; ++r) { st0[r] = 0.f; st1[r] = 0.f; }
            bf16x8 kf0[NKS], kf1[NKS];
#pragma unroll
            for (int ks = 0; ks < NKS; ++ks) { kf0[ks] = *(const bf16x8*)(kb + ks * 16); kf1[ks] = *(const bf16x8*)(kb + 32 * KSTR + ks * 16); }
            asm volatile("s_waitcnt lgkmcnt(0)" ::: "memory");
#pragma unroll
            for (int ks = 0; ks < NKS; ++ks) {
                st0 = __builtin_amdgcn_mfma_f32_32x32x16_bf16(kf0[ks], qf[ks], st0, 0, 0, 0);
                st1 = __builtin_amdgcn_mfma_f32_32x32x16_bf16(kf1[ks], qf[ks], st1, 0, 0, 0);
            }
            const bf16_t* vb = Vs + buf * 64 * VSTR + r32 * VSTR + 4 * hh;
            uint2 vfr[2][2][2][2];
#pragma unroll
            for (int uu = 0; uu < 2; ++uu)
#pragma unroll
                for (int t = 0; t < 2; ++t)
#pragma unroll
                    for (int s2 = 0; s2 < 2; ++s2) {
                        const bf16_t* a = vb + uu * 32 * VSTR + t * 32 + s2 * 16;
                        vfr[uu][t][s2][0] = *(const uint2*)a; vfr[uu][t][s2][1] = *(const uint2*)(a + 8);
                    }
            float x[32];
#pragma unroll
            for (int r = 0; r < 16; ++r) { x[r] = st0[r] * sc2; x[16 + r] = st1[r] * sc2; }
            if (NAT && ti >= 4) {
                const int dr = kr - qr + 7;
#pragma unroll
                for (int e = 0; e < 32; ++e) {
                    const int r = e & 15, kc = (e >> 4) * 32 + (r & 3) + 8 * (r >> 2) + 4 * hh;
                    const int dc = min(max(kc - qc, -15), 15) + 15;
                    const bool ok = (kc >= c0) && (kc < c0 + 16);
                    x[e] = ok ? x[e] + rpb_s[dr * 31 + dc] : -1e30f;
                }
            }
            float mx = x[0];
#pragma unroll
            for (int e = 1; e < 32; ++e) mx = fmaxf(mx, x[e]);
            mx = fmaxf(mx, __shfl_xor(mx, 32));
            const float m_new = fmaxf(m_run, mx);
            const float alpha = __builtin_amdgcn_exp2f(m_run - m_new);
            m_run = m_new;
            float ps = 0.f;
#pragma unroll
            for (int e = 0; e < 32; ++e) { x[e] = __builtin_amdgcn_exp2f(x[e] - m_new); ps += x[e]; }
            lsum = lsum * alpha + ps;
#pragma unroll
            for (int r = 0; r < 16; ++r) { oacc[0][r] *= alpha; oacc[1][r] *= alpha; }
            bf16x8 pf[2][2];
#pragma unroll
            for (int t = 0; t < 2; ++t)
#pragma unroll
                for (int s = 0; s < 2; ++s) {
                    union { bf16x8 v; unsigned u[4]; } cv;
#pragma unroll
                    for (int q = 0; q < 4; ++q) cv.u[q] = cvt_pk(x[16 * t + 8 * s + 2 * q], x[16 * t + 8 * s + 2 * q + 1]);
                    pf[t][s] = cv.v;
                }
#pragma unroll
            for (int uu = 0; uu < 2; ++uu)
#pragma unroll
                for (int t = 0; t < 2; ++t)
#pragma unroll
                    for (int s = 0; s < 2; ++s) {
                        union { bf16x8 v; uint2 h[2]; } cv;
                        cv.h[0] = vfr[uu][t][s][0]; cv.h[1] = vfr[uu][t][s][1];
                        oacc[uu] = __builtin_amdgcn_mfma_f32_32x32x16_bf16(cv.v, pf[t][s], oacc[uu], 0, 0, 0);
                    }
        }
        if (more) SWRITE((ti + 1) & 1);
        __syncthreads();
    }
#undef TILE_P
#undef GLOAD
#undef SWRITE
    lsum += __shfl_xor(lsum, 32);
    const float inv = 1.f / lsum;
    bf16_t* zrow = PB + (size_t)(rowbase + q_p0 + ql) * PW + C_Z + (NAT ? 512 : 0) + head * 64;
#pragma unroll
    for (int uu = 0; uu < 2; ++uu)
#pragma unroll
        for (int g = 0; g < 4; ++g) {
            bf16_t* zp = zrow + uu * 32 + 8 * g + 4 * hh;
            const uint2 z = *(const uint2*)zp;
            uint2 o;
            o.x = cvt_pk(oacc[uu][4 * g + 0] * inv * siluf_(lo16(z.x)), oacc[uu][4 * g + 1] * inv * siluf_(hi16(z.x)));
            o.y = cvt_pk(oacc[uu][4 * g + 2] * inv * siluf_(lo16(z.y)), oacc[uu][4 * g + 3] * inv * siluf_(hi16(z.y)));
            *(uint2*)zp = o;
        }
}

__device__ void scan_hg_item(const Params& P, int l, int item, unsigned char* smem) {
    const int tid = tid_opaque(), lane = tid & 63, wave = tid >> 6;
    const int slice = item & 7, dir = (item >> 3) & 1, head = (item >> 4) & 3, bl = item >> 6;
    float* a_s = (float*)smem;
    float* q_s = a_s + 64 * 128;
    float* v_s = q_s + 64 * 128;
    float* o_s = v_s + 64 * 16;
    const bf16_t* PB = (const bf16_t*)(P.ws + OFF_PB) + (size_t)bl * TB * PW;
    bf16_t* OS = (bf16_t*)(P.ws + OFF_KV) + ((size_t)dir * NTH + (size_t)bl * TB) * 512 + head * 128 + slice * 16;
    const int prow = tid >> 4, pd = (tid & 15) * 8;
    float lb[8];
#pragma unroll
    for (int e = 0; e < 8; ++e) {
        const int cidx = dir * 512 + head * 128 + pd + e;
        lb[e] = (l == 0) ? 0.f : sigmoidf_(P.lb_logits[1024 + cidx] - P.lb_logits[cidx]);
    }
    const int fcol = (dir ? C_HF + 512 : C_HF) + head * 128 + pd, qcol = C_HQ + head * 128 + pd, vcol = C_HI + head * 128 + slice * 16 + (tid & 1) * 8;
    uint4 rq[4], rf[4], rv;
    auto chunk_p = [&](int c) { const int ci = dir ? (c < 4 ? 3 - c : 135 - c) : c; return ci * 64; };
    auto gload = [&](int c) {
        const int p = chunk_p(c);
#pragma unroll
        for (int r = 0; r < 4; ++r) { const bf16_t* row = PB + (size_t)(p + prow + 16 * r) * PW; rq[r] = *(const uint4*)(row + qcol); rf[r] = *(const uint4*)(row + fcol); }
        if (tid < 128) rv = *(const uint4*)(PB + (size_t)(p + (tid >> 1)) * PW + vcol);
    };
    const int dg = lane & 15, col = wave * 4 + (lane >> 4);
    float S[8];
#pragma unroll
    for (int e = 0; e < 8; ++e) S[e] = 0.f;
    gload(0);
    for (int c = 0; c < 132; ++c) {
        __syncthreads();
#pragma unroll
        for (int r = 0; r < 4; ++r) {
            float fq[8], ff[8];
            unpack8(rq[r], fq); unpack8(rf[r], ff);
            float* ad = a_s + (prow + 16 * r) * 128 + pd; float* qd = q_s + (prow + 16 * r) * 128 + pd;
#pragma unroll
            for (int e = 0; e < 8; ++e) { ad[e] = lb[e] + (1.f - lb[e]) * sigmoidf_(ff[e]); qd[e] = siluf_(fq[e]) * 0.08838834764831845f; }
        }
        if (tid < 128) { float fv[8]; unpack8(rv, fv); float* vd = v_s + (tid >> 1) * 16 + (tid & 1) * 8;
#pragma unroll
            for (int e = 0; e < 8; ++e) vd[e] = fv[e]; }
        __syncthreads();
        if (c + 1 < 132) gload(c + 1);
        for (int tt = 0; tt < 64; tt += 8) {
            float op[8];
#pragma unroll
            for (int u = 0; u < 8; ++u) {
                const int i = dir ? 63 - (tt + u) : tt + u;
                const float4 a0 = *(const float4*)(a_s + i * 128 + dg * 8), a1 = *(const float4*)(a_s + i * 128 + dg * 8 + 4);
                const float4 q0 = *(const float4*)(q_s + i * 128 + dg * 8), q1 = *(const float4*)(q_s + i * 128 + dg * 8 + 4);
                const float v = v_s[i * 16 + col];
                float o;
                S[0] = fmaf(a0.x, S[0] - v, v); o = q0.x * S[0];
                S[1] = fmaf(a0.y, S[1] - v, v); o = fmaf(q0.y, S[1], o);
                S[2] = fmaf(a0.z, S[2] - v, v); o = fmaf(q0.z, S[2], o);
                S[3] = fmaf(a0.w, S[3] - v, v); o = fmaf(q0.w, S[3], o);
                S[4] = fmaf(a1.x, S[4] - v, v); o = fmaf(q1.x, S[4], o);
                S[5] = fmaf(a1.y, S[5] - v, v); o = fmaf(q1.y, S[5], o);
                S[6] = fmaf(a1.z, S[6] - v, v); o = fmaf(q1.z, S[6], o);
                S[7] = fmaf(a1.w, S[7] - v, v); o = fmaf(q1.w, S[7], o);
                op[u] = o;
            }
            float r4[4], r2[2];
            const bool b8 = dg & 8, b4 = dg & 4, b2 = dg & 2;
#pragma unroll
            for (int k = 0; k < 4; ++k) { const float snd = b8 ? op[k] : op[k + 4], kp = b8 ? op[k + 4] : op[k]; r4[k] = kp + __shfl_xor(snd, 8); }
#pragma unroll
            for (int k = 0; k < 2; ++k) { const float snd = b4 ? r4[k] : r4[k + 2], kp = b4 ? r4[k + 2] : r4[k]; r2[k] = kp + __shfl_xor(snd, 4); }
            float r1; { const float snd = b2 ? r2[0] : r2[1], kp = b2 ? r2[1] : r2[0]; r1 = kp + __shfl_xor(snd, 2); }
            r1 += __shfl_xor(r1, 1);
            if ((dg & 1) == 0) { const int tok = tt + (b8 ? 4 : 0) + (b4 ? 2 : 0) + (b2 ? 1 : 0); const int i = dir ? 63 - tok : tok; o_s[i * 16 + col] = r1; }
        }
        __syncthreads();
        if (tid < 128) {
            const int p = chunk_p(c) + (tid >> 1);
            *(uint4*)(OS + (size_t)p * 512 + (tid & 1) * 8) = pack8(o_s + (tid >> 1) * 16 + (tid & 1) * 8);
        }
    }
}

__device__ void scan_gla_item(const Params& P, int l, int item, unsigned char* smem) {
    const int tid = tid_opaque(), lane = tid & 63, wave = tid >> 6;
    const int slice = item & 3, dir = (item >> 2) & 1, head = (item >> 3) & 3, bl = item >> 5;
    float* a_s = (float*)smem;
    float* q_s = a_s + 64 * 64;
    float* k_s = q_s + 64 * 64;
    float* v_s = k_s + 64 * 64;
    float* o_s = v_s + 64 * 32;
    float* r_s = o_s + 64 * 32;
    const bf16_t* PB = (const bf16_t*)(P.ws + OFF_PB) + (size_t)bl * TB * PW;
    bf16_t* OS = (bf16_t*)(P.ws + OFF_OSG) + ((size_t)dir * NTH + (size_t)bl * TB) * 512 + head * 128 + slice * 32;
    const int gd = tid & 63, gt0 = tid >> 6;
    float w2[16];
#pragma unroll
    for (int jx = 0; jx < 16; ++jx) w2[jx] = P.gla_w2[((size_t)(l * 2 + dir) * 16 + jx) * 256 + head * 64 + gd];
    const float b2 = P.gla_b2[(l * 2 + dir) * 256 + head * 64 + gd];
    uint4 rq[2], rk[2], rv, rr;
    auto chunk_p = [&](int c) { const int ci = dir ? (c < 4 ? 3 - c : 135 - c) : c; return ci * 64; };
    auto gload = [&](int c) {
        const int p = chunk_p(c);
#pragma unroll
        for (int i = 0; i < 2; ++i) { const int id = tid + 256 * i, row = id >> 3, ch = id & 7; const bf16_t* rp = PB + (size_t)(p + row) * PW;
            rq[i] = *(const uint4*)(rp + C_GQ + head * 64 + ch * 8); rk[i] = *(const uint4*)(rp + C_GK + head * 64 + ch * 8); }
        { const int row = tid >> 2, ch = tid & 3; rv = *(const uint4*)(PB + (size_t)(p + row) * PW + C_GV + head * 128 + slice * 32 + ch * 8); }
        if (tid < 128) { const int row = tid >> 1, ch = tid & 1; rr = *(const uint4*)(PB + (size_t)(p + row) * PW + C_GR + dir * 16 + ch * 8); }
    };
    const int dg = lane & 7, col = wave * 8 + (lane >> 3);
    float S[8];
#pragma unroll
    for (int e = 0; e < 8; ++e) S[e] = 0.f;
    gload(0);
    for (int c = 0; c < 132; ++c) {
        __syncthreads();
#pragma unroll
        for (int i = 0; i < 2; ++i) { const int id = tid + 256 * i, row = id >> 3, ch = id & 7; float fq[8], fk[8]; unpack8(rq[i], fq); unpack8(rk[i], fk);
#pragma unroll
            for (int e = 0; e < 8; ++e) { q_s[row * 64 + ch * 8 + e] = fq[e] * 0.125f; k_s[row * 64 + ch * 8 + e] = fk[e]; } }
        { const int row = tid >> 2, ch = tid & 3; float fv[8]; unpack8(rv, fv);
#pragma unroll
            for (int e = 0; e < 8; ++e) v_s[row * 32 + ch * 8 + e] = fv[e]; }
        if (tid < 128) { const int row = tid >> 1, ch = tid & 1; float fr[8]; unpack8(rr, fr);
#pragma unroll
            for (int e = 0; e < 8; ++e) r_s[row * 16 + ch * 8 + e] = fr[e]; }
        __syncthreads();
        if (c + 1 < 132) gload(c + 1);
#pragma unroll 4
        for (int m = 0; m < 16; ++m) {
            const int i = gt0 + 4 * m;
            float g = b2;
#pragma unroll
            for (int jx = 0; jx < 16; ++jx) g = fmaf(r_s[i * 16 + jx], w2[jx], g);
            const float ls = fminf(g, 0.f) - __logf(1.f + __expf(-fabsf(g)));
            a_s[i * 64 + gd] = __expf(ls * 0.0625f);
        }
        __syncthreads();
        for (int tt = 0; tt < 64; tt += 8) {
            float op[8];
#pragma unroll
            for (int u = 0; u < 8; ++u) {
                const int i = dir ? 63 - (tt + u) : tt + u;
                const float4 a0 = *(const float4*)(a_s + i * 64 + dg * 8), a1 = *(const float4*)(a_s + i * 64 + dg * 8 + 4);
                const float4 q0 = *(const float4*)(q_s + i * 64 + dg * 8), q1 = *(const float4*)(q_s + i * 64 + dg * 8 + 4);
                const float4 k0 = *(const float4*)(k_s + i * 64 + dg * 8), k1 = *(const float4*)(k_s + i * 64 + dg * 8 + 4);
                const float v = v_s[i * 32 + col];
                float o;
                S[0] = fmaf(a0.x, S[0], k0.x * v); o = q0.x * S[0];
                S[1] = fmaf(a0.y, S[1], k0.y * v); o = fmaf(q0.y, S[1], o);
                S[2] = fmaf(a0.z, S[2], k0.z * v); o = fmaf(q0.z, S[2], o);
                S[3] = fmaf(a0.w, S[3], k0.w * v); o = fmaf(q0.w, S[3], o);
                S[4] = fmaf(a1.x, S[4], k1.x * v); o = fmaf(q1.x, S[4], o);
                S[5] = fmaf(a1.y, S[5], k1.y * v); o = fmaf(q1.y, S[5], o);
                S[6] = fmaf(a1.z, S[6], k1.z * v); o = fmaf(q1.z, S[6], o);
                S[7] = fmaf(a1.w, S[7], k1.w * v); o = fmaf(q1.w, S[7], o);
                op[u] = o;
            }
            float r4[4], r2[2];
            const bool b4 = dg & 4, b2 = dg & 2, b1 = dg & 1;
#pragma unroll
            for (int k = 0; k < 4; ++k) { const float snd = b4 ? op[k] : op[k + 4], kp = b4 ? op[k + 4] : op[k]; r4[k] = kp + __shfl_xor(snd, 4); }
#pragma unroll
            for (int k = 0; k < 2; ++k) { const float snd = b2 ? r4[k] : r4[k + 2], kp = b2 ? r4[k + 2] : r4[k]; r2[k] = kp + __shfl_xor(snd, 2); }
            float r1; { const float snd = b1 ? r2[0] : r2[1], kp = b1 ? r2[1] : r2[0]; r1 = kp + __shfl_xor(snd, 1); }
            { const int tok = tt + (b4 ? 4 : 0) + (b2 ? 2 : 0) + (b1 ? 1 : 0); const int i = dir ? 63 - tok : tok; o_s[i * 32 + col] = r1; }
        }
        __syncthreads();
        { const int row = tid >> 2, ch = tid & 3; const int p = chunk_p(c) + row;
          *(uint4*)(OS + (size_t)p * 512 + ch * 8) = pack8(o_s + row * 32 + ch * 8); }
    }
}


template <bool GLA>
__device__ void scan2_item(const Params& P, int l, int item, unsigned char* smem) {
    constexpr int DK = GLA ? 64 : 128, NT = DK / 32, QS = DK + 8, TS = 40, NSEG = GLA ? 4 : 2, TPS = 32 / NSEG, QCH = DK / 8;
    const int tid = tid_opaque(), lane = tid & 63, wave = tid >> 6, r32 = lane & 31, hh = lane >> 5;
    const int dir = item & 1, head = (item >> 1) & 3, bl = item >> 3;
    bf16_t* Qh = (bf16_t*)smem;
    bf16_t* Kh = Qh + 32 * QS;
    bf16_t* Kt = Kh + 32 * QS;
    bf16_t* Vt = Kt + DK * TS;
    float* eb = (float*)(Vt + 128 * TS);
    float* tot = eb + DK;
    bf16_t* qraw = (bf16_t*)(tot + 4 * DK);
    bf16_t* fraw = qraw + 32 * DK;
    bf16_t* vraw = fraw + 32 * DK;
    bf16_t* rraw = vraw + 32 * 128;
    const bf16_t* PB = (const bf16_t*)(P.ws + OFF_PB) + (size_t)bl * TB * PW;
    bf16_t* OS = (bf16_t*)(P.ws + (GLA ? OFF_OSG : OFF_KV)) + ((size_t)dir * NTH + (size_t)bl * TB) * 512 + head * 128 + wave * 32;
    const int qcol = (GLA ? C_GQ : C_HQ) + head * DK, fcol = GLA ? (C_GK + head * 64) : ((dir ? C_HF + 512 : C_HF) + head * 128),
              vcol = (GLA ? C_GV : C_HI) + head * 128, rcol = C_GR + dir * 16;
    const int pd = tid & (DK - 1), seg = tid / DK;
    float lbv = 0.f, b2 = 0.f, w2[16];
#pragma unroll
    for (int jx = 0; jx < 16; ++jx) w2[jx] = 0.f;
    if (GLA) {
#pragma unroll
        for (int jx = 0; jx < 16; ++jx) w2[jx] = P.gla_w2[((size_t)(l * 2 + dir) * 16 + jx) * 256 + head * 64 + pd];
        b2 = P.gla_b2[(l * 2 + dir) * 256 + head * 64 + pd];
    } else if (l != 0) { const int cidx = dir * 512 + head * 128 + pd; lbv = sigmoidf_(P.lb_logits[1024 + cidx] - P.lb_logits[cidx]); }
    uint4 pq0, pq1, pf0, pf1, pv0, pv1, pr;
    pq1 = pf1 = pr = make_uint4(0, 0, 0, 0);
#define CH_P0(c) (dir ? ((c) < 8 ? (7 - (c)) * 32 : CTXL + (263 - (c)) * 32) : (c) * 32)
#define ROWP(p0_, i_) ((p0_) + (dir ? 31 - (i_) : (i_)))
#define SC_GLOAD(c) { const int p0_ = CH_P0(c); \
        { const int id = tid, i = id / QCH, ch = id % QCH; const bf16_t* rp = PB + (size_t)ROWP(p0_, i) * PW; pq0 = *(const uint4*)(rp + qcol + ch * 8); pf0 = *(const uint4*)(rp + fcol + ch * 8); } \
        if (!GLA) { const int id = tid + 256, i = id / QCH, ch = id % QCH; const bf16_t* rp = PB + (size_t)ROWP(p0_, i) * PW; pq1 = *(const uint4*)(rp + qcol + ch * 8); pf1 = *(const uint4*)(rp + fcol + ch * 8); } \
        { const int i = tid >> 4, ch = tid & 15; pv0 = *(const uint4*)(PB + (size_t)ROWP(p0_, i) * PW + vcol + ch * 8); pv1 = *(const uint4*)(PB + (size_t)ROWP(p0_, i + 16) * PW + vcol + ch * 8); } \
        if (GLA && tid < 64) { const int i = tid >> 1, ch = tid & 1; pr = *(const uint4*)(PB + (size_t)ROWP(p0_, i) * PW + rcol + ch * 8); } }
    f32x16 ST[NT];
#pragma unroll
    for (int T = 0; T < NT; ++T)
#pragma unroll
        for (int r = 0; r < 16; ++r) ST[T][r] = 0.f;
    SC_GLOAD(0);
    for (int c = 0; c < 264; ++c) {
        __syncthreads();
        { const int id = tid, i = id / QCH, ch = id % QCH; *(uint4*)(qraw + i * DK + ch * 8) = pq0; *(uint4*)(fraw + i * DK + ch * 8) = pf0; }
        if (!GLA) { const int id = tid + 256, i = id / QCH, ch = id % QCH; *(uint4*)(qraw + i * DK + ch * 8) = pq1; *(uint4*)(fraw + i * DK + ch * 8) = pf1; }
        { const int i = tid >> 4, ch = tid & 15; *(uint4*)(vraw + i * 128 + ch * 8) = pv0; *(uint4*)(vraw + (i + 16) * 128 + ch * 8) = pv1; }
        if (GLA && tid < 64) { const int i = tid >> 1, ch = tid & 1; *(uint4*)(rraw + i * 16 + ch * 8) = pr; }
        __syncthreads();
        if (c + 1 < 264) SC_GLOAD(c + 1);
        float bl_[TPS], kk[TPS], qq[TPS];
        float cum = 0.f;
#pragma unroll
        for (int tt = 0; tt < TPS; ++tt) {
            const int i = seg * TPS + tt;
            float la;
            if (GLA) {
                float g = b2;
#pragma unroll
                for (int jx = 0; jx < 16; ++jx) g = fmaf(bf2f(rraw[i * 16 + jx]), w2[jx], g);
                la = (fminf(g, 0.f) - __logf(1.f + __expf(-fabsf(g)))) * 0.0625f;
                kk[tt] = bf2f(fraw[i * DK + pd]);
                qq[tt] = bf2f(qraw[i * DK + pd]) * 0.125f;
            } else {
                const float f = bf2f(fraw[i * DK + pd]);
                const float a = lbv + (1.f - lbv) * sigmoidf_(f);
                la = __logf(a);
                kk[tt] = 1.f - a;
                qq[tt] = siluf_(bf2f(qraw[i * DK + pd])) * 0.08838834764831845f;
            }
            cum += la;
            bl_[tt] = cum;
        }
        tot[seg * DK + pd] = cum;
        __syncthreads();
        {
            float off = 0.f, bend = 0.f;
#pragma unroll
            for (int sg = 0; sg < NSEG; ++sg) { const float tv = tot[sg * DK + pd]; bend += tv; if (sg < seg) off += tv; }
            const float eend = __expf(bend);
            if (seg == 0) eb[pd] = eend;
            float kt[TPS];
#pragma unroll
            for (int tt = 0; tt < TPS; ++tt) {
                const int i = seg * TPS + tt;
                const float b = bl_[tt] + off;
                const float e1 = __expf(b), e2 = __expf(-b);
                const float kh = kk[tt] * e2;
                Qh[i * QS + pd] = f2bf(qq[tt] * e1);
                Kh[i * QS + pd] = f2bf(kh);
                kt[tt] = kh * eend;
            }
#pragma unroll
            for (int g8 = 0; g8 < TPS / 8; ++g8) *(uint4*)(Kt + pd * TS + seg * TPS + g8 * 8) = pack8(kt + g8 * 8);
            const int vc = tid & 127, vs = tid >> 7;
            float vv[16];
#pragma unroll
            for (int tt = 0; tt < 16; ++tt) vv[tt] = bf2f(vraw[(vs * 16 + tt) * 128 + vc]);
            *(uint4*)(Vt + vc * TS + vs * 16) = pack8(vv);
            *(uint4*)(Vt + vc * TS + vs * 16 + 8) = pack8(vv + 8);
        }
        __syncthreads();
        f32x16 st;
#pragma unroll
        for (int r = 0; r < 16; ++r) st[r] = 0.f;
#pragma unroll
        for (int ks = 0; ks < DK / 16; ++ks) {
            const bf16x8 ka = *(const bf16x8*)(Kh + r32 * QS + ks * 16 + hh * 8);
            const bf16x8 qb = *(const bf16x8*)(Qh + r32 * QS + ks * 16 + hh * 8);
            st = __builtin_amdgcn_mfma_f32_32x32x16_bf16(ka, qb, st, 0, 0, 0);
        }
        bf16x8 pfr[2];
#pragma unroll
        for (int sI = 0; sI < 2; ++sI) {
            union { bf16x8 v; unsigned u[4]; } cv;
#pragma unroll
            for (int q = 0; q < 4; ++q) {
                const int ra = 8 * sI + 2 * q, rb = ra + 1;
                const int ja = (ra & 3) + 8 * (ra >> 2) + 4 * hh, jb = (rb & 3) + 8 * (rb >> 2) + 4 * hh;
                cv.u[q] = cvt_pk(ja <= r32 ? st[ra] : 0.f, jb <= r32 ? st[rb] : 0.f);
            }
            pfr[sI] = cv.v;
        }
        f32x16 oT;
#pragma unroll
        for (int r = 0; r < 16; ++r) oT[r] = 0.f;
#pragma unroll
        for (int sI = 0; sI < 2; ++sI) {
            const bf16_t* a = Vt + (wave * 32 + r32) * TS + sI * 16 + 4 * hh;
            union { bf16x8 v; uint2 h[2]; } cv;
            cv.h[0] = *(const uint2*)a; cv.h[1] = *(const uint2*)(a + 8);
            oT = __builtin_amdgcn_mfma_f32_32x32x16_bf16(cv.v, pfr[sI], oT, 0, 0, 0);
        }
#pragma unroll
        for (int T = 0; T < NT; ++T)
#pragma unroll
            for (int sI = 0; sI < 2; ++sI) {
                union { bf16x8 v; unsigned u[4]; } ca;
#pragma unroll
                for (int q = 0; q < 4; ++q) ca.u[q] = cvt_pk(ST[T][8 * sI + 2 * q], ST[T][8 * sI + 2 * q + 1]);
                const bf16_t* b = Qh + r32 * QS + T * 32 + sI * 16 + 4 * hh;
                union { bf16x8 v; uint2 h[2]; } cb;
                cb.h[0] = *(const uint2*)b; cb.h[1] = *(const uint2*)(b + 8);
                oT = __builtin_amdgcn_mfma_f32_32x32x16_bf16(ca.v, cb.v, oT, 0, 0, 0);
            }
#pragma unroll
        for (int T = 0; T < NT; ++T) {
#pragma unroll
            for (int g = 0; g < 4; ++g) {
                const float4 e4 = *(const float4*)(eb + T * 32 + 8 * g + 4 * hh);
                ST[T][4 * g + 0] *= e4.x; ST[T][4 * g + 1] *= e4.y; ST[T][4 * g + 2] *= e4.z; ST[T][4 * g + 3] *= e4.w;
            }
#pragma unroll
            for (int ks = 0; ks < 2; ++ks) {
                const bf16x8 ka = *(const bf16x8*)(Kt + (T * 32 + r32) * TS + ks * 16 + hh * 8);
                const bf16x8 vb = *(const bf16x8*)(Vt + (wave * 32 + r32) * TS + ks * 16 + hh * 8);
                ST[T] = __builtin_amdgcn_mfma_f32_32x32x16_bf16(ka, vb, ST[T], 0, 0, 0);
            }
        }
        {
            const int p = ROWP(CH_P0(c), r32);
            bf16_t* op = OS + (size_t)p * 512 + 4 * hh;
#pragma unroll
            for (int g = 0; g < 4; ++g) { uint2 o; o.x = cvt_pk(oT[4 * g], oT[4 * g + 1]); o.y = cvt_pk(oT[4 * g + 2], oT[4 * g + 3]); *(uint2*)(op + 8 * g) = o; }
        }
    }
#undef CH_P0
#undef ROWP
#undef SC_GLOAD
}


template <bool GLA>
__device__ void scan3_item(const Params& P, int l, int item, unsigned char* smem) {
    constexpr int DK = GLA ? 64 : 128, NT = DK / 32, QS = DK + 8, TS = 40, NSEG = GLA ? 4 : 2, TPS = 32 / NSEG, QCH = DK / 8;
    const int tid = tid_opaque(), lane = tid & 63, wave = tid >> 6, r32 = lane & 31, hh = lane >> 5;
    const int dir = item & 1, head = (item >> 1) & 3, bl = item >> 3;
    __builtin_amdgcn_s_setprio(3);
    bf16_t* Qh = (bf16_t*)smem;
    bf16_t* Kh = Qh + 32 * QS;
    bf16_t* Kt = Kh + 32 * QS;
    bf16_t* Vt = Kt + DK * TS;
    float* eb = (float*)(Vt + 128 * TS);
    bf16_t* vraw = (bf16_t*)(eb + DK);
    const bf16_t* PB = (const bf16_t*)(P.ws + OFF_PB) + (size_t)bl * TB * PW;
    bf16_t* OS = (bf16_t*)(P.ws + (GLA ? OFF_OSG : OFF_KV)) + ((size_t)dir * NTH + (size_t)bl * TB) * 512 + head * 128 + wave * 32;
    const bf16_t* qsrc; const bf16_t* ksrc; int qld, kld;
    if (GLA) {
        if (dir == 0) { qsrc = PB + C_GQ + head * 64; qld = PW; ksrc = PB + C_GK + head * 64; kld = PW; }
        else { const bf16_t* X = (const bf16_t*)(P.ws + OFF_XG) + (size_t)bl * TB * 512; qsrc = X + head * 64; qld = 512; ksrc = X + 256 + head * 64; kld = 512; }
    } else {
        if (dir == 0) { qsrc = PB + C_HQ + head * 128; qld = PW; ksrc = PB + C_HF + head * 128; kld = PW; }
        else { qsrc = (const bf16_t*)(P.ws + OFF_XH) + (size_t)bl * TB * 512 + head * 128; qld = 512; ksrc = PB + C_HF + 512 + head * 128; kld = PW; }
    }
    const float* ebsrc = (const float*)(P.ws + (GLA ? OFF_EBG : OFF_EBH)) + ((size_t)(bl * 264) * 2 + dir) * (4 * DK) + head * DK;
    const int vcol = (GLA ? C_GV : C_HI) + head * 128;
    const int pd = tid & (DK - 1), seg = tid / DK;
    uint4 pq0, pq1, pk0, pk1, pv0, pv1; float pe = 0.f;
    pq1 = pk1 = make_uint4(0, 0, 0, 0);
#define CH_P0(c) (dir ? ((c) < 8 ? (7 - (c)) * 32 : CTXL + (263 - (c)) * 32) : (c) * 32)
#define ROWP(p0_, i_) ((p0_) + (dir ? 31 - (i_) : (i_)))
#define SC_GLOAD(c) { const int p0_ = CH_P0(c); \
        { const int id = tid, i = id / QCH, ch = id % QCH; const size_t rr_ = (size_t)ROWP(p0_, i); pq0 = *(const uint4*)(qsrc + rr_ * qld + ch * 8); pk0 = *(const uint4*)(ksrc + rr_ * kld + ch * 8); } \
        if (!GLA) { const int id = tid + 256, i = id / QCH, ch = id % QCH; const size_t rr_ = (size_t)ROWP(p0_, i); pq1 = *(const uint4*)(qsrc + rr_ * qld + ch * 8); pk1 = *(const uint4*)(ksrc + rr_ * kld + ch * 8); } \
        { const int i = tid >> 4, ch = tid & 15; pv0 = *(const uint4*)(PB + (size_t)ROWP(p0_, i) * PW + vcol + ch * 8); pv1 = *(const uint4*)(PB + (size_t)ROWP(p0_, i + 16) * PW + vcol + ch * 8); } \
        if (tid < DK) pe = ebsrc[(size_t)(p0_ >> 5) * 2 * (4 * DK) + tid]; }
    f32x16 ST[NT];
#pragma unroll
    for (int T = 0; T < NT; ++T)
#pragma unroll
        for (int r = 0; r < 16; ++r) ST[T][r] = 0.f;
    SC_GLOAD(0);
    for (int c = 0; c < 264; ++c) {
        __syncthreads();
        { const int id = tid, i = id / QCH, ch = id % QCH; *(uint4*)(Qh + i * QS + ch * 8) = pq0; *(uint4*)(Kh + i * QS + ch * 8) = pk0; }
        if (!GLA) { const int id = tid + 256, i = id / QCH, ch = id % QCH; *(uint4*)(Qh + i * QS + ch * 8) = pq1; *(uint4*)(Kh + i * QS + ch * 8) = pk1; }
        { const int i = tid >> 4, ch = tid & 15; *(uint4*)(vraw + i * 128 + ch * 8) = pv0; *(uint4*)(vraw + (i + 16) * 128 + ch * 8) = pv1; }
        if (tid < DK) eb[tid] = pe;
        __syncthreads();
        if (c + 1 < 264) SC_GLOAD(c + 1);
        {
            const float eend = eb[pd];
            float kt[TPS];
#pragma unroll
            for (int tt = 0; tt < TPS; ++tt) kt[tt] = bf2f(Kh[(seg * TPS + tt) * QS + pd]) * eend;
#pragma unroll
            for (int g8 = 0; g8 < TPS / 8; ++g8) *(uint4*)(Kt + pd * TS + seg * TPS + g8 * 8) = pack8(kt + g8 * 8);
            const int vc = tid & 127, vs = tid >> 7;
            float vv[16];
#pragma unroll
            for (int tt = 0; tt < 16; ++tt) vv[tt] = bf2f(vraw[(vs * 16 + tt) * 128 + vc]);
            *(uint4*)(Vt + vc * TS + vs * 16) = pack8(vv);
            *(uint4*)(Vt + vc * TS + vs * 16 + 8) = pack8(vv + 8);
        }
        __syncthreads();
        f32x16 st;
#pragma unroll
        for (int r = 0; r < 16; ++r) st[r] = 0.f;
#pragma unroll
        for (int ks = 0; ks < DK / 16; ++ks) {
            const bf16x8 ka = *(const bf16x8*)(Kh + r32 * QS + ks * 16 + hh * 8);
            const bf16x8 qb = *(const bf16x8*)(Qh + r32 * QS + ks * 16 + hh * 8);
            st = __builtin_amdgcn_mfma_f32_32x32x16_bf16(ka, qb, st, 0, 0, 0);
        }
        bf16x8 pfr[2];
#pragma unroll
        for (int sI = 0; sI < 2; ++sI) {
            union { bf16x8 v; unsigned u[4]; } cv;
#pragma unroll
            for (int q = 0; q < 4; ++q) {
                const int ra = 8 * sI + 2 * q, rb = ra + 1;
                const int ja = (ra & 3) + 8 * (ra >> 2) + 4 * hh, jb = (rb & 3) + 8 * (rb >> 2) + 4 * hh;
                cv.u[q] = cvt_pk(ja <= r32 ? st[ra] : 0.f, jb <= r32 ? st[rb] : 0.f);
            }
            pfr[sI] = cv.v;
        }
        f32x16 oT;
#pragma unroll
        for (int r = 0; r < 16; ++r) oT[r] = 0.f;
#pragma unroll
        for (int sI = 0; sI < 2; ++sI) {
            const bf16_t* a = Vt + (wave * 32 + r32) * TS + sI * 16 + 4 * hh;
            union { bf16x8 v; uint2 h[2]; } cv;
            cv.h[0] = *(const uint2*)a; cv.h[1] = *(const uint2*)(a + 8);
            oT = __builtin_amdgcn_mfma_f32_32x32x16_bf16(cv.v, pfr[sI], oT, 0, 0, 0);
        }
#pragma unroll
        for (int T = 0; T < NT; ++T)
#pragma unroll
            for (int sI = 0; sI < 2; ++sI) {
                union { bf16x8 v; unsigned u[4]; } ca;
#pragma unroll
                for (int q = 0; q < 4; ++q) ca.u[q] = cvt_pk(ST[T][8 * sI + 2 * q], ST[T][8 * sI + 2 * q + 1]);
                const bf16_t* b = Qh + r32 * QS + T * 32 + sI * 16 + 4 * hh;
                union { bf16x8 v; uint2 h[2]; } cb;
                cb.h[0] = *(const uint2*)b; cb.h[1] = *(const uint2*)(b + 8);
                oT = __builtin_amdgcn_mfma_f32_32x32x16_bf16(ca.v, cb.v, oT, 0, 0, 0);
            }
#pragma unroll
        for (int T = 0; T < NT; ++T) {
#pragma unroll
            for (int g = 0; g < 4; ++g) {
                const float4 e4 = *(const float4*)(eb + T * 32 + 8 * g + 4 * hh);
                ST[T][4 * g + 0] *= e4.x; ST[T][4 * g + 1] *= e4.y; ST[T][4 * g + 2] *= e4.z; ST[T][4 * g + 3] *= e4.w;
            }
#pragma unroll
            for (int ks = 0; ks < 2; ++ks) {
                const bf16x8 ka = *(const bf16x8*)(Kt + (T * 32 + r32) * TS + ks * 16 + hh * 8);
                const bf16x8 vb = *(const bf16x8*)(Vt + (wave * 32 + r32) * TS + ks * 16 + hh * 8);
                ST[T] = __builtin_amdgcn_mfma_f32_32x32x16_bf16(ka, vb, ST[T], 0, 0, 0);
            }
        }
        {
            const int p = ROWP(CH_P0(c), r32);
            bf16_t* op = OS + (size_t)p * 512 + 4 * hh;
#pragma unroll
            for (int g = 0; g < 4; ++g) { uint2 o; o.x = cvt_pk(oT[4 * g], oT[4 * g + 1]); o.y = cvt_pk(oT[4 * g + 2], oT[4 * g + 3]); *(uint2*)(op + 8 * g) = o; }
        }
    }
#undef CH_P0
#undef ROWP
#undef SC_GLOAD
    __builtin_amdgcn_s_setprio(0);
}

#ifdef ONLYI
#define IT_ON(n) (ONLYI == (n))
#else
#define IT_ON(n) true
#endif
__device__ void phase_mixers(const Params& P, int ph, int l, unsigned char* smem, int mode = 0) {
    constexpr int N_HG = 16, N_GLA = 16, N_ATT = 2 * 8 * 66;
    const int bx = blockIdx.x;
    int my_scan = -1;
    if (mode != 2 && bx < 256 && (bx & 7) == ((bx >> 3) & 7)) my_scan = bx >> 3;
    if (mode == 0 && bx >= 256 && ((bx - 256) & 7) == (((bx - 256) >> 3) & 7)) return;
    for (;;) {
        int it;
        if (my_scan >= 0) { it = my_scan; my_scan = -1; }
        else {
            if (mode == 1) break;
            it = next_item(P, ph) + N_HG + N_GLA;
        }
        if (it >= N_HG + N_GLA + 2 * N_ATT) break;
        if (it < N_HG) { if (IT_ON(0)) scan3_item<false>(P, l, it, smem); continue; }
        it -= N_HG;
        if (it < N_GLA) { if (IT_ON(1)) scan3_item<true>(P, l, it, smem); continue; }
        it -= N_GLA;
        if (it < N_ATT) { const int bl = it / 528, rem = it % 528; if (IT_ON(2)) attn_item<96, false>(P, l, bl, rem / 66, rem % 66, smem); continue; }
        it -= N_ATT;
        { const int bl = it / 528, rem = it % 528; if (IT_ON(3)) attn_item<64, true>(P, l, bl, rem / 66, rem % 66, smem); }
    }
}

__device__ void phase_scanfin(const Params& P, int ph, int l) {
    const int tid = tid_opaque(), lane = tid & 63, wave = tid >> 6;
    bf16_t* PB = (bf16_t*)(P.ws + OFF_PB);
    const bf16_t* OSH = (const bf16_t*)(P.ws + OFF_KV);
    const bf16_t* OSGp = (const bf16_t*)(P.ws + OFF_OSG);
    float gh[8], gg[8];
#pragma unroll
    for (int e = 0; e < 8; ++e) { gh[e] = P.hg_g_o[l * 128 + (lane & 15) * 8 + e]; gg[e] = P.gla_g_o[l * 128 + (lane & 15) * 8 + e]; }
    for (;;) {
        const int u = next_item(P, ph);
        if (u >= NTH / 16) break;
        uint4 ra[8], rb[8], rz[8];
#pragma unroll
        for (int k = 0; k < 8; ++k) {
            const int t = u * 16 + wave * 4 + (k >> 1), mx = k & 1;
            const bf16_t* OS = mx ? OSGp : OSH;
            ra[k] = *(const uint4*)(OS + (size_t)t * 512 + lane * 8);
            rb[k] = *(const uint4*)(OS + ((size_t)NTH + t) * 512 + lane * 8);
            rz[k] = *(const uint4*)(PB + (size_t)t * PW + C_Z + (2 + mx) * 512 + lane * 8);
        }
#pragma unroll
        for (int k = 0; k < 8; ++k) {
            const int t = u * 16 + wave * 4 + (k >> 1), mx = k & 1;
            float a[8], b[8], z[8];
            unpack8(ra[k], a); unpack8(rb[k], b); unpack8(rz[k], z);
            float ss = 0.f;
#pragma unroll
            for (int e = 0; e < 8; ++e) { a[e] += b[e]; ss += a[e] * a[e]; }
            ss += __shfl_xor(ss, 1); ss += __shfl_xor(ss, 2); ss += __shfl_xor(ss, 4); ss += __shfl_xor(ss, 8);
            const float rn = rsqrtf(ss * (1.f / 128.f) + EPS);
#pragma unroll
            for (int e = 0; e < 8; ++e) a[e] = a[e] * rn * (mx ? gg[e] : gh[e]) * siluf_(z[e]);
            *(uint4*)(PB + (size_t)t * PW + C_Z + (2 + mx) * 512 + lane * 8) = pack8(a);
        }
    }
}

__device__ void phase_merge(const Params& P, int ph, int l, unsigned char* smem) {
    const int tid_ = tid_opaque(), lane = tid_ & 63, wave = tid_ >> 6, wr = wave >> 1, wc = wave & 1;
    const bf16_t* H = (const bf16_t*)(P.ws + OFF_H);
    const bf16_t* PB = (const bf16_t*)(P.ws + OFF_PB);
    bf16_t* ACC = (bf16_t*)(P.ws + OFF_KV);
    for (;;) {
        const int u = next_item(P, ph);
        if (u >= 132 * 16) break;
        const int mt = u >> 4, nt = u & 15;
        const int col = nt * 64 + wc * 32 + (lane & 31);
        f32x16 tot[2];
#pragma unroll
        for (int r = 0; r < 16; ++r) { tot[0][r] = 0.f; tot[1][r] = 0.f; }
        for (int br = 0; br < 4; ++br) {
            unsigned gate[2][8];
            {
                f32x16 g[2];
#pragma unroll
                for (int r = 0; r < 16; ++r) { g[0][r] = 0.f; g[1][r] = 0.f; }
                gemm_tile_n64(g, H + (size_t)mt * 128 * D, D, (const bf16_t*)(P.ws + OFF_WM) + ((size_t)(l * 4 + br) * 1024 + nt * 64) * 1024, 1024, 1024, smem);
                const float bm = P.b_merge[(l * 4 + br) * 1024 + col];
#pragma unroll
                for (int mi = 0; mi < 2; ++mi)
#pragma unroll
                    for (int r = 0; r < 8; ++r) gate[mi][r] = cvt_pk_asm(sigmoidf_(g[mi][2 * r] + bm), sigmoidf_(g[mi][2 * r + 1] + bm));
            }
            f32x16 pa[2];
#pragma unroll
            for (int r = 0; r < 16; ++r) { pa[0][r] = 0.f; pa[1][r] = 0.f; }
            gemm_tile_n64(pa, PB + (size_t)mt * 128 * PW + C_Z + br * 512, PW, (const bf16_t*)(P.ws + OFF_WBR) + ((size_t)(l * 4 + br) * 1024 + nt * 64) * 512, 512, 512, smem);
#pragma unroll
            for (int mi = 0; mi < 2; ++mi)
#pragma unroll
                for (int r = 0; r < 8; ++r) {
                    tot[mi][2 * r] = fmaf(lo16(gate[mi][r]), pa[mi][2 * r], tot[mi][2 * r]);
                    tot[mi][2 * r + 1] = fmaf(hi16(gate[mi][r]), pa[mi][2 * r + 1], tot[mi][2 * r + 1]);
                }
        }
#pragma unroll
        for (int mi = 0; mi < 2; ++mi)
#pragma unroll
            for (int r = 0; r < 16; ++r) ACC[(size_t)(mt * 128 + ACC_ROW(mi, r)) * 1024 + col] = f2bf(tot[mi][r]);
    }
}

__device__ void phase_out(const Params& P, int ph, int l, int hf, unsigned char* smem) {
    const int tid_ = tid_opaque(), lane = tid_ & 63, wave = tid_ >> 6, wr = wave >> 1, wc = wave & 1;
    const bf16_t* ACC = (const bf16_t*)(P.ws + OFF_KV);
    const float* mod = (const float*)(P.ws + OFF_MOD);
    for (;;) {
        const int u = next_item(P, ph);
        if (u >= 132 * 8) break;
        const int mt = u >> 3, nt = u & 7;
        const int t0 = mt * 128, bl = t0 / TB, p0 = t0 % TB, b = hf * 2 + bl;
        const bool isctx = p0 < CTXL;
        if (isctx && l == 1) continue;
        f32x16 acc[2][2]; zero_acc(acc);
        gemm_tile_pf2(acc, ACC + (size_t)mt * 128 * 1024, 1024, (const bf16_t*)(P.ws + OFF_WO) + ((size_t)l * 1024 + nt * 128) * 1024, 1024, 1024, smem);
        const float* gt = mod + (l * 5 + (isctx ? 4 : b)) * 3072 + 2048 + nt * 128;
        const float* src; float* dst;
        if (isctx) { src = P.ctx + ((size_t)b * CTXL + p0) * D; dst = (float*)(P.ws + OFF_CX1) + ((size_t)b * CTXL + p0) * D; }
        else { const size_t o = ((size_t)b * SEQ + (p0 - CTXL)) * D; src = (l == 0 ? P.x : (const float*)P.out) + o; dst = P.out + o; }
#pragma unroll
        for (int mi = 0; mi < 2; ++mi)
#pragma unroll
            for (int ni = 0; ni < 2; ++ni) {
                const int cl = ACC_COL(ni);
                const float g = gt[cl];
#pragma unroll
                for (int r = 0; r < 16; ++r) { const size_t o = (size_t)ACC_ROW(mi, r) * D + nt * 128 + cl; dst[o] = src[o] + g * acc[mi][ni][r]; }
            }
    }
}

__global__ void __launch_bounds__(256, 2) mega(Params PK) {
    extern __shared__ __attribute__((aligned(16))) unsigned char smem[];
    if (blockIdx.x == 0 && threadIdx.x == 0) {
        Params* T = (Params*)(PK.ws + OFF_TAB);
        T->x = PK.x; T->c = PK.c; T->ctx = PK.ctx; T->c_ctx = PK.c_ctx; T->ada_w = PK.ada_w; T->ada_b = PK.ada_b; T->norm_g = PK.norm_g; T->w_in = PK.w_in;
        T->w_uq = PK.w_uq; T->w_ukv = PK.w_ukv; T->g_cq = PK.g_cq; T->g_ckv = PK.g_ckv; T->g_q = PK.g_q; T->g_k = PK.g_k; T->rpb = PK.rpb; T->ng_q = PK.ng_q; T->ng_k = PK.ng_k;
        T->lb_logits = PK.lb_logits; T->hg_g_o = PK.hg_g_o; T->gla_w2 = PK.gla_w2; T->gla_b2 = PK.gla_b2; T->gla_g_o = PK.gla_g_o; T->w_br = PK.w_br; T->w_merge = PK.w_merge;
        T->b_merge = PK.b_merge; T->w_out = PK.w_out; T->out = PK.out; T->ws = PK.ws; T->ph_lo = PK.ph_lo; T->ph_hi = PK.ph_hi;
    }
    unsigned char* wsb = PK.ws;
    const int ph_lo = PK.ph_lo, ph_hi = PK.ph_hi;
#ifdef PROBE_SUB
    __shared__ long long s_tacc, s_tprev; if (threadIdx.x == 0) { s_tacc = 0; s_tprev = 0; }
#endif
    for (int ph = ph_lo; ph < ph_hi; ++ph) {
#ifndef SPLIT_MIX
        if (ph > 8 && ((ph - 1) & 7) == 0) continue;
#endif
        if (ph > ph_lo) cg::this_grid().sync();
        const Params& P = PK;
#ifdef PROBE_SUB
        if (threadIdx.x == 0) { const long long t_now = wall_clock64();
#ifdef SPLIT_MIX
            const int prev_sub = (ph == 0) ? -1 : (ph == 1 ? 9 : ((ph - 2) % 9));
#else
            const int prev_sub = (ph == 0) ? -1 : (ph == 1 ? 8 : ((ph - 2) & 7));
#endif
            if (prev_sub == PROBE_SUB) s_tacc += t_now - s_tprev; s_tprev = t_now; }
#endif
#ifdef ONLYP
#define PH_ON(n) ((ONLYP >> (n)) & 1)
#else
#define PH_ON(n) true
#endif
        if (ph == 0) { if (PH_ON(8)) phase_prologue(PK, ph, smem); continue; }
#ifdef SPLIT_MIX
        const int q = ph - 1, pass = q / 9, sub9 = q % 9, l = pass >> 1, hf = pass & 1;
        if (sub9 == 4 || sub9 == 5) { phase_mixers(P, ph, l, smem, sub9 - 3); continue; }
        const int sub = sub9 < 4 ? sub9 : sub9 - 1;
        switch (sub) {
            case 0: phase_norm(P, ph, l, hf); break;
            case 1: phase_gemm1(P, ph, l, smem); break;
            case 2: phase_gemm2(P, ph, l, smem); break;
            case 3: phase_finalize(P, ph, l, smem); break;
            case 5: phase_scanfin(P, ph, l); break;
            case 6: phase_merge(P, ph, l, smem); break;
            default: phase_out(P, ph, l, hf, smem); break;
        }
#else
        const int q = ph - 1, pass = q >> 3, sub = q & 7, l = pass >> 1, hf = pass & 1;
        switch (sub) {
            case 0: if (PH_ON(0)) phase_norm(P, ph, l, hf); break;
            case 1: if (PH_ON(1)) phase_gemm1(P, ph, l, smem); break;
            case 2: if (PH_ON(2)) phase_gemm2(P, ph, l, smem); break;
            case 3: if (PH_ON(3)) phase_finalize(P, ph, l, smem); break;
            case 4: if (PH_ON(4)) phase_mixers(P, ph, l, smem); break;
            case 5: if (PH_ON(5)) phase_scanfin(P, ph, l); break;
            case 6: if (PH_ON(6)) phase_merge(P, ph, l, smem); break;
            default: if (PH_ON(7)) { phase_out(P, ph, l, hf, smem); if (pass < 3) phase_norm(P, ph + 40, (pass + 1) >> 1, (pass + 1) & 1); } break;
        }
#endif
    }
#ifdef PROBE_SUB
    cg::this_grid().sync();
    if (threadIdx.x == 0) { const long long t_now = wall_clock64(); if (7 == PROBE_SUB) s_tacc += t_now - s_tprev;
      if (blockIdx.x == 0) { const long long t_acc = s_tacc; const long long t0 = wall_clock64(); while (wall_clock64() - t0 < t_acc) { __builtin_amdgcn_s_sleep(10); } } }
#endif
}

extern "C" void kernel_launch(void* const* d_in, const int* in_sizes, int n_in, void* d_out, int out_size, void* d_ws, size_t ws_size, hipStream_t stream) {
    static int grid = 0;
    if (grid == 0) {
        if (ws_size < WS_END) { fprintf(stderr, "workspace too small: %zu < %zu\n", ws_size, (size_t)WS_END); grid = -1; return; }
        int dev = 0, cus = 0, per_cu = 0;
        hipGetDevice(&dev);
        hipDeviceGetAttribute(&cus, hipDeviceAttributeMultiprocessorCount, dev);
        hipFuncSetAttribute((const void*)mega, hipFuncAttributeMaxDynamicSharedMemorySize, LDS_BYTES);
        hipOccupancyMaxActiveBlocksPerMultiprocessor(&per_cu, (const void*)mega, 256, LDS_BYTES);
        if (per_cu < 1) per_cu = 1;
        if (per_cu > 2) per_cu = 2;
        grid = cus * per_cu;
        (void)hipGetLastError();
    }
    if (grid < 0) return;
    hipMemsetAsync((unsigned char*)d_ws + OFF_CTL, 0, 4096, stream);
    Params p{};
    const float** pp = (const float**)&p;
    for (int i = 0; i < 26; ++i) pp[i] = (const float*)d_in[i];
    p.out = (float*)d_out; p.ws = (unsigned char*)d_ws;
#if SINGLE_LAUNCH
    p.ph_lo = 0; p.ph_hi = NPHASE;
    void* args[] = {&p};
    hipError_t e = hipLaunchCooperativeKernel((const void*)mega, dim3(grid), dim3(256), args, LDS_BYTES, stream);
    if (e != hipSuccess) fprintf(stderr, "cooperative launch failed: %s (grid %d)\n", hipGetErrorString(e), grid);
#else
    for (int ph = 0; ph < NPHASE; ++ph) {
        p.ph_lo = ph; p.ph_hi = ph + 1;
        hipLaunchKernelGGL(mega, dim3(grid), dim3(256), LDS_BYTES, stream, p);
    }
#endif
}
```

```cpp
#include <hip/hip_runtime.h>
#include <hip/hip_cooperative_groups.h>
#include <stdint.h>
#include <stdio.h>
namespace cg = cooperative_groups;

typedef unsigned short bf16_t;
typedef short bf16x8 __attribute__((ext_vector_type(8)));
typedef short bf16x4 __attribute__((ext_vector_type(4)));
typedef float f32x16 __attribute__((ext_vector_type(16)));

#ifndef SINGLE_LAUNCH
#define SINGLE_LAUNCH 1
#endif

constexpr int D = 1024, SEQ = 8192, CTXL = 256, TB = SEQ + CTXL  , NTH = 2 * TB  ;
constexpr int INW = 7104, PW = 7104;
constexpr int C_CQ = 0, C_CKV = 256, C_KR = 384, C_NQ = 416, C_NK = 928, C_NV = 1440, C_HQ = 1952, C_HF = 2464, C_HI = 3488,
              C_GQ = 4000, C_GK = 4256, C_GV = 4512, C_GR = 5024, C_Z = 5056;
constexpr float EPS = 1e-6f;
constexpr float LOG2E = 1.4426950408889634f;
constexpr int LDS_BYTES = 73728;
#ifdef SPLIT_MIX
constexpr int NPHASE = 37;
#else
constexpr int NPHASE = 33;
#endif

constexpr size_t al256(size_t v) { return (v + 255) & ~(size_t)255; }
constexpr size_t OFF_CTL = 0;
constexpr size_t OFF_TAB = 1024;
constexpr size_t OFF_MOD = 4096;
constexpr size_t OFF_CX1 = al256(OFF_MOD + 2 * 5 * 3072 * 4);
constexpr size_t OFF_WIN = al256(OFF_CX1 + (size_t)4 * 256 * 1024 * 4);
constexpr size_t OFF_WM = al256(OFF_WIN + (size_t)2 * 7168 * 1024 * 2);
constexpr size_t OFF_WBR = al256(OFF_WM + (size_t)8 * 1024 * 1024 * 2);
constexpr size_t OFF_WO = al256(OFF_WBR + (size_t)8 * 1024 * 512 * 2);
constexpr size_t OFF_WUQ = al256(OFF_WO + (size_t)2 * 1024 * 1024 * 2);
constexpr size_t OFF_WUKV = al256(OFF_WUQ + (size_t)2 * 768 * 256 * 2);
constexpr size_t OFF_H = al256(OFF_WUKV + (size_t)2 * 1024 * 128 * 2);
constexpr size_t OFF_PB = al256(OFF_H + (size_t)NTH * 1024 * 2);
constexpr size_t OFF_QF = al256(OFF_PB + (size_t)NTH * PW * 2);
constexpr size_t OFF_KV = al256(OFF_QF + (size_t)NTH * 768 * 2);
constexpr size_t OFF_KF = al256(OFF_KV + (size_t)NTH * 1024 * 2);
constexpr size_t OFF_VTM = al256(OFF_KF + (size_t)NTH * 768 * 2);
constexpr size_t OFF_VTN = al256(OFF_VTM + (size_t)2 * 8 * 64 * TB * 2);
constexpr size_t OFF_OSG = al256(OFF_VTN + (size_t)2 * 8 * 64 * TB * 2);
constexpr size_t OFF_XH = al256(OFF_OSG + (size_t)2 * NTH * 512 * 2);
constexpr size_t OFF_XG = al256(OFF_XH + (size_t)NTH * 512 * 2);
constexpr size_t OFF_EBH = al256(OFF_XG + (size_t)NTH * 512 * 2);
constexpr size_t OFF_EBG = al256(OFF_EBH + (size_t)528 * 2 * 512 * 4);
constexpr size_t WS_END = al256(OFF_EBG + (size_t)528 * 2 * 256 * 4);

static_assert(WS_END <= (size_t)512 * 1024 * 1024, "workspace map exceeds 512 MiB");
struct Params {
    const float *x, *c, *ctx, *c_ctx, *ada_w, *ada_b, *norm_g, *w_in, *w_uq, *w_ukv, *g_cq, *g_ckv, *g_q, *g_k, *rpb, *ng_q, *ng_k,
        *lb_logits, *hg_g_o, *gla_w2, *gla_b2, *gla_g_o, *w_br, *w_merge, *b_merge, *w_out;
    float* out;
    unsigned char* ws;
    int ph_lo, ph_hi;
};

__device__ __forceinline__ float bf2f(bf16_t v) { return __uint_as_float(((unsigned)v) << 16); }
typedef float f32x2_t __attribute__((ext_vector_type(2)));
typedef __bf16 bf16x2_t __attribute__((ext_vector_type(2)));
__device__ __forceinline__ unsigned cvt_pk(float lo, float hi) { f32x2_t v = {lo, hi}; bf16x2_t b = __builtin_convertvector(v, bf16x2_t); return __builtin_bit_cast(unsigned, b); }
__device__ __forceinline__ unsigned cvt_pk_asm(float lo, float hi) { unsigned r; asm("s_nop 1\n\tv_cvt_pk_bf16_f32 %0, %1, %2" : "=v"(r) : "v"(lo), "v"(hi)); return r; }
__device__ __forceinline__ bf16_t f2bf(float f) { return (bf16_t)(cvt_pk(f, 0.f) & 0xffffu); }
__device__ __forceinline__ float lo16(unsigned u) { return __uint_as_float(u << 16); }
__device__ __forceinline__ float hi16(unsigned u) { return __uint_as_float(u & 0xffff0000u); }
__device__ __forceinline__ float sigmoidf_(float x) { return 1.f / (1.f + __expf(-x)); }
__device__ __forceinline__ float siluf_(float x) { return x / (1.f + __expf(-x)); }
__device__ __forceinline__ float wave_sum(float v) {
#pragma unroll
    for (int o = 32; o > 0; o >>= 1) v += __shfl_xor(v, o);
    return v;
}
__device__ __forceinline__ void unpack8(uint4 u, float* f) {
    f[0] = lo16(u.x); f[1] = hi16(u.x); f[2] = lo16(u.y); f[3] = hi16(u.y); f[4] = lo16(u.z); f[5] = hi16(u.z); f[6] = lo16(u.w); f[7] = hi16(u.w);
}
__device__ __forceinline__ uint4 pack8(const float* f) { uint4 u; u.x = cvt_pk(f[0], f[1]); u.y = cvt_pk(f[2], f[3]); u.z = cvt_pk(f[4], f[5]); u.w = cvt_pk(f[6], f[7]); return u; }

__device__ __forceinline__ int tid_opaque() { int t = threadIdx.x; asm volatile("" : "+v"(t)); return t; }
__shared__ int s_item;
__device__ __forceinline__ int next_item(const Params& P, int ph) {
    __syncthreads();
    if (threadIdx.x == 0) s_item = atomicAdd((int*)(P.ws + OFF_CTL) + ph, 1);
    __syncthreads();
    return s_item;
}

constexpr int GS = 72;
__device__ __forceinline__ void gemm_tile(f32x16 (&acc)[2][2], const bf16_t* __restrict__ A, int lda, const bf16_t* __restrict__ Bt, int ldb, int K, unsigned char* smem) {
    const int tid = tid_opaque(), lane = tid & 63, wave = tid >> 6, wr = wave >> 1, wc = wave & 1;
    bf16_t* sA = (bf16_t*)smem;
    bf16_t* sB = sA + 2 * 128 * GS;
    const int lrow = tid >> 3, lch = (tid & 7) * 8;
    uint4 ra[4], rb[4];
    const bf16_t* Ap = A + (size_t)lrow * lda + lch;
    const bf16_t* Bp = Bt + (size_t)lrow * ldb + lch;
#pragma unroll
    for (int i = 0; i < 4; ++i) { ra[i] = *(const uint4*)(Ap + (size_t)(32 * i) * lda); rb[i] = *(const uint4*)(Bp + (size_t)(32 * i) * ldb); }
#pragma unroll
    for (int i = 0; i < 4; ++i) { *(uint4*)(sA + (lrow + 32 * i) * GS + lch) = ra[i]; *(uint4*)(sB + (lrow + 32 * i) * GS + lch) = rb[i]; }
    __syncthreads();
    const int nk = K >> 6;
    const int aoff = (wr * 64 + (lane & 31)) * GS + (lane >> 5) * 8, boff = (wc * 64 + (lane & 31)) * GS + (lane >> 5) * 8;
    for (int kt = 0; kt < nk; ++kt) {
        const bool more = kt + 1 < nk;
        if (more) {
#pragma unroll
            for (int i = 0; i < 4; ++i) { ra[i] = *(const uint4*)(Ap + (size_t)(32 * i) * lda + (kt + 1) * 64); rb[i] = *(const uint4*)(Bp + (size_t)(32 * i) * ldb + (kt + 1) * 64); }
        }
        const bf16_t* a = sA + (kt & 1) * 128 * GS + aoff;
        const bf16_t* b = sB + (kt & 1) * 128 * GS + boff;
#pragma unroll
        for (int ks = 0; ks < 4; ++ks) {
            bf16x8 a0 = *(const bf16x8*)(a + ks * 16), a1 = *(const bf16x8*)(a + 32 * GS + ks * 16);
            bf16x8 b0 = *(const bf16x8*)(b + ks * 16), b1 = *(const bf16x8*)(b + 32 * GS + ks * 16);
            acc[0][0] = __builtin_amdgcn_mfma_f32_32x32x16_bf16(a0, b0, acc[0][0], 0, 0, 0);
            acc[0][1] = __builtin_amdgcn_mfma_f32_32x32x16_bf16(a0, b1, acc[0][1], 0, 0, 0);
            acc[1][0] = __builtin_amdgcn_mfma_f32_32x32x16_bf16(a1, b0, acc[1][0], 0, 0, 0);
            acc[1][1] = __builtin_amdgcn_mfma_f32_32x32x16_bf16(a1, b1, acc[1][1], 0, 0, 0);
        }
        if (more) {
            bf16_t* wa = sA + ((kt + 1) & 1) * 128 * GS;
            bf16_t* wb = sB + ((kt + 1) & 1) * 128 * GS;
#pragma unroll
            for (int i = 0; i < 4; ++i) { *(uint4*)(wa + (lrow + 32 * i) * GS + lch) = ra[i]; *(uint4*)(wb + (lrow + 32 * i) * GS + lch) = rb[i]; }
        }
        __syncthreads();
    }
}

__device__ __forceinline__ void gemm_tile_pf2(f32x16 (&acc)[2][2], const bf16_t* __restrict__ A, int lda, const bf16_t* __restrict__ Bt, int ldb, int K, unsigned char* smem) {
    const int tid = tid_opaque(), lane = tid & 63, wave = tid >> 6, wr = wave >> 1, wc = wave & 1;
    bf16_t* sA = (bf16_t*)smem;
    bf16_t* sB = sA + 2 * 128 * GS;
    const int lrow = tid >> 3, lch = (tid & 7) * 8;
    uint4 pa0, pa1, pa2, pa3, pb0, pb1, pb2, pb3, qa0, qa1, qa2, qa3, qb0, qb1, qb2, qb3;
    const bf16_t* Ap = A + (size_t)lrow * lda + lch;
    const bf16_t* Bp = Bt + (size_t)lrow * ldb + lch;
    const int nk = K >> 6;
#define PF2_LD1(RA, RB, kt_, i) { RA##i = *(const uint4*)(Ap + (size_t)(32 * i) * lda + (kt_) * 64); RB##i = *(const uint4*)(Bp + (size_t)(32 * i) * ldb + (kt_) * 64); }
#define PF2_LOAD(RA, RB, kt_) { PF2_LD1(RA, RB, kt_, 0) PF2_LD1(RA, RB, kt_, 1) PF2_LD1(RA, RB, kt_, 2) PF2_LD1(RA, RB, kt_, 3) }
#define PF2_WR1(RA, RB, i) { *(uint4*)(wa + (lrow + 32 * i) * GS + lch) = RA##i; *(uint4*)(wb + (lrow + 32 * i) * GS + lch) = RB##i; }
#define PF2_WRITE(RA, RB, buf_) { bf16_t* wa = sA + (buf_) * 128 * GS; bf16_t* wb = sB + (buf_) * 128 * GS; PF2_WR1(RA, RB, 0) PF2_WR1(RA, RB, 1) PF2_WR1(RA, RB, 2) PF2_WR1(RA, RB, 3) }
#define PF2_COMPUTE(buf_) { const bf16_t* a = sA + (buf_) * 128 * GS + aoff; const bf16_t* b = sB + (buf_) * 128 * GS + boff; _Pragma("unroll") for (int ks = 0; ks < 4; ++ks) { \
        bf16x8 a0 = *(const bf16x8*)(a + ks * 16), a1 = *(const bf16x8*)(a + 32 * GS + ks * 16); bf16x8 b0 = *(const bf16x8*)(b + ks * 16), b1 = *(const bf16x8*)(b + 32 * GS + ks * 16); \
        acc[0][0] = __builtin_amdgcn_mfma_f32_32x32x16_bf16(a0, b0, acc[0][0], 0, 0, 0); acc[0][1] = __builtin_amdgcn_mfma_f32_32x32x16_bf16(a0, b1, acc[0][1], 0, 0, 0); \
        acc[1][0] = __builtin_amdgcn_mfma_f32_32x32x16_bf16(a1, b0, acc[1][0], 0, 0, 0); acc[1][1] = __builtin_amdgcn_mfma_f32_32x32x16_bf16(a1, b1, acc[1][1], 0, 0, 0); } }
    const int aoff = (wr * 64 + (lane & 31)) * GS + (lane >> 5) * 8, boff = (wc * 64 + (lane & 31)) * GS + (lane >> 5) * 8;
    PF2_LOAD(pa, pb, 0);
    PF2_LOAD(qa, qb, 1);
    PF2_WRITE(pa, pb, 0);
    __syncthreads();
    for (int kt = 0; kt < nk; kt += 2) {
        if (kt + 2 < nk) PF2_LOAD(pa, pb, kt + 2);
        PF2_COMPUTE(0);
        PF2_WRITE(qa, qb, 1);
        __syncthreads();
        if (kt + 3 < nk) PF2_LOAD(qa, qb, kt + 3);
        PF2_COMPUTE(1);
        if (kt + 2 < nk) PF2_WRITE(pa, pb, 0);
        __syncthreads();
    }
#undef PF2_LOAD
#undef PF2_LD1
#undef PF2_WR1
#undef PF2_WRITE
#undef PF2_COMPUTE
}

__device__ __forceinline__ void gemm_tile_n64(f32x16 (&acc)[2], const bf16_t* __restrict__ A, int lda, const bf16_t* __restrict__ Bt, int ldb, int K, unsigned char* smem) {
    const int tid = tid_opaque(), lane = tid & 63, wave = tid >> 6, wr = wave >> 1, wc = wave & 1;
    bf16_t* sA = (bf16_t*)smem;
    bf16_t* sB = sA + 2 * 128 * GS;
    const int lrow = tid >> 3, lch = (tid & 7) * 8;
    uint4 pa0, pa1, pa2, pa3, pb0, pb1, qa0, qa1, qa2, qa3, qb0, qb1;
    const bf16_t* Ap = A + (size_t)lrow * lda + lch;
    const bf16_t* Bp = Bt + (size_t)lrow * ldb + lch;
    const int nk = K >> 6;
#define N64_LOAD(RA, RB, kt_) { RA##0 = *(const uint4*)(Ap + (kt_) * 64); RA##1 = *(const uint4*)(Ap + (size_t)32 * lda + (kt_) * 64); RA##2 = *(const uint4*)(Ap + (size_t)64 * lda + (kt_) * 64); RA##3 = *(const uint4*)(Ap + (size_t)96 * lda + (kt_) * 64); \
        RB##0 = *(const uint4*)(Bp + (kt_) * 64); RB##1 = *(const uint4*)(Bp + (size_t)32 * ldb + (kt_) * 64); }
#define N64_WRITE(RA, RB, buf_) { bf16_t* wa = sA + (buf_) * 128 * GS + lrow * GS + lch; bf16_t* wb = sB + (buf_) * 64 * GS + lrow * GS + lch; \
        *(uint4*)wa = RA##0; *(uint4*)(wa + 32 * GS) = RA##1; *(uint4*)(wa + 64 * GS) = RA##2; *(uint4*)(wa + 96 * GS) = RA##3; *(uint4*)wb = RB##0; *(uint4*)(wb + 32 * GS) = RB##1; }
#define N64_COMPUTE(buf_) { const bf16_t* a = sA + (buf_) * 128 * GS + aoff; const bf16_t* b = sB + (buf_) * 64 * GS + boff; _Pragma("unroll") for (int ks = 0; ks < 4; ++ks) { \
        bf16x8 a0 = *(const bf16x8*)(a + ks * 16), a1 = *(const bf16x8*)(a + 32 * GS + ks * 16); bf16x8 b0 = *(const bf16x8*)(b + ks * 16); \
        acc[0] = __builtin_amdgcn_mfma_f32_32x32x16_bf16(a0, b0, acc[0], 0, 0, 0); acc[1] = __builtin_amdgcn_mfma_f32_32x32x16_bf16(a1, b0, acc[1], 0, 0, 0); } }
    const int aoff = (wr * 64 + (lane & 31)) * GS + (lane >> 5) * 8, boff = (wc * 32 + (lane & 31)) * GS + (lane >> 5) * 8;
    N64_LOAD(pa, pb, 0);
    N64_LOAD(qa, qb, 1);
    N64_WRITE(pa, pb, 0);
    __syncthreads();
    for (int kt = 0; kt < nk; kt += 2) {
        if (kt + 2 < nk) N64_LOAD(pa, pb, kt + 2);
        N64_COMPUTE(0);
        N64_WRITE(qa, qb, 1);
        __syncthreads();
        if (kt + 3 < nk) N64_LOAD(qa, qb, kt + 3);
        N64_COMPUTE(1);
        if (kt + 2 < nk) N64_WRITE(pa, pb, 0);
        __syncthreads();
    }
#undef N64_LOAD
#undef N64_WRITE
#undef N64_COMPUTE
}
__device__ __forceinline__ void zero_acc(f32x16 (&acc)[2][2]) {
#pragma unroll
    for (int i = 0; i < 2; ++i)
#pragma unroll
        for (int j = 0; j < 2; ++j)
#pragma unroll
            for (int r = 0; r < 16; ++r) acc[i][j][r] = 0.f;
}
#define ACC_ROW(mi, r) (wr * 64 + (mi) * 32 + ((r) & 3) + 8 * ((r) >> 2) + 4 * (lane >> 5))
#define ACC_COL(ni) (wc * 64 + (ni) * 32 + (lane & 31))

__device__ void tr_tile(const float* __restrict__ src, int K, int N, int kt, int nt, bf16_t* __restrict__ dst, const float* __restrict__ scale, float* s) {
    const int tid = tid_opaque(), r = tid >> 4, c4 = (tid & 15) * 4;
#pragma unroll
    for (int i = 0; i < 4; ++i) {
        const int k = kt * 64 + r + 16 * i;
        float4 v = *(const float4*)(src + (size_t)k * N + nt * 64 + c4);
        const float sc = scale ? scale[k] : 1.f;
        float* d = s + (r + 16 * i) * 65 + c4;
        d[0] = v.x * sc; d[1] = v.y * sc; d[2] = v.z * sc; d[3] = v.w * sc;
    }
    __syncthreads();
    const int n = tid >> 2, k0 = (tid & 3) * 16;
    float f[16];
#pragma unroll
    for (int j = 0; j < 16; ++j) f[j] = s[(k0 + j) * 65 + n];
    bf16_t* o = dst + (size_t)(nt * 64 + n) * K + kt * 64 + k0;
    *(uint4*)o = pack8(f);
    *(uint4*)(o + 8) = pack8(f + 8);
    __syncthreads();
}
__device__ void phase_prologue(const Params& P, int ph, unsigned char* smem) {
    float* s = (float*)smem;
    const int NTR = 7296, NMOD = 96;
    for (;;) {
        const int u = next_item(P, ph);
        if (u >= NTR + NMOD) break;
        if (u < NMOD) {
            const int l = u / 48, cb = u % 48, tid = threadIdx.x, lane = tid & 63, wave = tid >> 6;
            float* sc = s;
            float* red = s + 5 * 1024;
            for (int i = tid; i < 5 * 1024; i += 256) { const int r = i >> 10, k = i & 1023; const float v = (r < 4) ? P.c[r * 1024 + k] : P.c_ctx[k]; sc[i] = siluf_(v); }
            __syncthreads();
            const int col = cb * 64 + lane;
            float acc[5] = {0.f, 0.f, 0.f, 0.f, 0.f};
            const float* w = P.ada_w + (size_t)l * 1024 * 3072 + col;
#pragma unroll 8
            for (int k = wave * 256; k < wave * 256 + 256; ++k) {
                const float wv = w[(size_t)k * 3072];
#pragma unroll
                for (int r = 0; r < 5; ++r) acc[r] += sc[r * 1024 + k] * wv;
            }
#pragma unroll
            for (int r = 0; r < 5; ++r) red[(wave * 5 + r) * 64 + lane] = acc[r];
            __syncthreads();
            if (wave == 0) {
                float* mod = (float*)(P.ws + OFF_MOD);
#pragma unroll
                for (int r = 0; r < 5; ++r) mod[(l * 5 + r) * 3072 + col] = red[r * 64 + lane] + red[(5 + r) * 64 + lane] + red[(10 + r) * 64 + lane] + red[(15 + r) * 64 + lane] + P.ada_b[l * 3072 + col];
            }
            continue;
        }
        const int v = u - NMOD, l = v / 3648, r = v % 3648;
        if (r < 1776) tr_tile(P.w_in + (size_t)l * 1024 * INW, 1024, INW, r / 111, r % 111, (bf16_t*)(P.ws + OFF_WIN) + (size_t)l * 7168 * 1024, nullptr, s);
        else if (r < 2800) { const int r2 = r - 1776, br = r2 >> 8, t = r2 & 255; tr_tile(P.w_merge + (size_t)(l * 4 + br) * 1024 * 1024, 1024, 1024, t >> 4, t & 15, (bf16_t*)(P.ws + OFF_WM) + (size_t)(l * 4 + br) * 1024 * 1024, nullptr, s); }
        else if (r < 3312) { const int r2 = r - 2800, br = r2 >> 7, t = r2 & 127; tr_tile(P.w_br + (size_t)(l * 4 + br) * 512 * 1024, 512, 1024, t >> 4, t & 15, (bf16_t*)(P.ws + OFF_WBR) + (size_t)(l * 4 + br) * 1024 * 512, nullptr, s); }
        else if (r < 3568) { const int t = r - 3312; tr_tile(P.w_out + (size_t)l * 1024 * 1024, 1024, 1024, t >> 4, t & 15, (bf16_t*)(P.ws + OFF_WO) + (size_t)l * 1024 * 1024, nullptr, s); }
        else if (r < 3616) { const int t = r - 3568; tr_tile(P.w_uq + (size_t)l * 256 * 768, 256, 768, t / 12, t % 12, (bf16_t*)(P.ws + OFF_WUQ) + (size_t)l * 768 * 256, P.g_cq + l * 256, s); }
        else { const int t = r - 3616; tr_tile(P.w_ukv + (size_t)l * 128 * 1024, 128, 1024, t >> 4, t & 15, (bf16_t*)(P.ws + OFF_WUKV) + (size_t)l * 1024 * 128, P.g_ckv + l * 128, s); }
    }
}

__device__ void phase_norm(const Params& P, int ph, int l, int hf) {
    const int tid = tid_opaque(), lane = tid & 63, wave = tid >> 6;
    const float* mod = (const float*)(P.ws + OFF_MOD);
    bf16_t* H = (bf16_t*)(P.ws + OFF_H);
    for (;;) {
        const int u = next_item(P, ph);
        if (u >= NTH / 8) break;
        for (int rr = 0; rr < 2; ++rr) {
            const int t = u * 8 + wave * 2 + rr, bl = t / TB, p = t % TB, b = hf * 2 + bl;
            const float* src; int mr;
            if (p < CTXL) { src = (l == 0 ? P.ctx : (const float*)(P.ws + OFF_CX1)) + ((size_t)b * CTXL + p) * D; mr = 4; }
            else { src = (l == 0 ? P.x : (const float*)P.out) + ((size_t)b * SEQ + (p - CTXL)) * D; mr = b; }
            float4 v[4]; float ss = 0.f;
#pragma unroll
            for (int i = 0; i < 4; ++i) { v[i] = *(const float4*)(src + lane * 4 + 256 * i); ss += v[i].x * v[i].x + v[i].y * v[i].y + v[i].z * v[i].z + v[i].w * v[i].w; }
            ss = wave_sum(ss);
            const float rstd = rsqrtf(ss * (1.f / D) + EPS);
            const float* sh = mod + (l * 5 + mr) * 3072; const float* sc = sh + 1024; const float* g = P.norm_g + l * D;
#pragma unroll
            for (int i = 0; i < 4; ++i) {
                const int c = lane * 4 + 256 * i;
                const float4 gv = *(const float4*)(g + c), s1 = *(const float4*)(sc + c), s0 = *(const float4*)(sh + c);
                uint2 o;
                o.x = cvt_pk(v[i].x * rstd * gv.x * (1.f + s1.x) + s0.x, v[i].y * rstd * gv.y * (1.f + s1.y) + s0.y);
                o.y = cvt_pk(v[i].z * rstd * gv.z * (1.f + s1.z) + s0.z, v[i].w * rstd * gv.w * (1.f + s1.w) + s0.w);
                *(uint2*)(H + (size_t)t * D + c) = o;
            }
        }
    }
}

__device__ void phase_gemm1(const Params& P, int ph, int l, unsigned char* smem) {
    const int tid_ = tid_opaque(), lane = tid_ & 63, wave = tid_ >> 6, wr = wave >> 1, wc = wave & 1;
    const bf16_t* H = (const bf16_t*)(P.ws + OFF_H);
    const bf16_t* W = (const bf16_t*)(P.ws + OFF_WIN) + (size_t)l * 7168 * 1024;
    bf16_t* PB = (bf16_t*)(P.ws + OFF_PB);
    for (;;) {
        const int u = next_item(P, ph);
        if (u >= 132 * 56) break;
        const int mt = u / 56, nt = u % 56;
        f32x16 acc[2][2]; zero_acc(acc);
        gemm_tile_pf2(acc, H + (size_t)mt * 128 * D, D, W + (size_t)nt * 128 * D, D, D, smem);
#pragma unroll
        for (int mi = 0; mi < 2; ++mi)
#pragma unroll
            for (int ni = 0; ni < 2; ++ni) {
                const int col = nt * 128 + ACC_COL(ni);
                if (col < PW) {
#pragma unroll
                    for (int r = 0; r < 16; ++r) PB[(size_t)(mt * 128 + ACC_ROW(mi, r)) * PW + col] = f2bf(acc[mi][ni][r]);
                }
            }
    }
}

__device__ void phase_gemm2(const Params& P, int ph, int l, unsigned char* smem) {
    const int tid_ = tid_opaque(), lane = tid_ & 63, wave = tid_ >> 6, wr = wave >> 1, wc = wave & 1;
    const bf16_t* PB = (const bf16_t*)(P.ws + OFF_PB);
    for (;;) {
        const int u = next_item(P, ph);
        if (u >= 132 * 14) break;
        const int mt = u / 14, n14 = u % 14;
        f32x16 acc[2][2]; zero_acc(acc);
        bf16_t* O; int ldo, nt;
        if (n14 < 6) { nt = n14; O = (bf16_t*)(P.ws + OFF_QF); ldo = 768;
            gemm_tile_pf2(acc, PB + (size_t)mt * 128 * PW + C_CQ, PW, (const bf16_t*)(P.ws + OFF_WUQ) + (size_t)l * 768 * 256 + (size_t)nt * 128 * 256, 256, 256, smem); }
        else { nt = n14 - 6; O = (bf16_t*)(P.ws + OFF_KV); ldo = 1024;
            gemm_tile_pf2(acc, PB + (size_t)mt * 128 * PW + C_CKV, PW, (const bf16_t*)(P.ws + OFF_WUKV) + (size_t)l * 1024 * 128 + (size_t)nt * 128 * 128, 128, 128, smem); }
#pragma unroll
        for (int mi = 0; mi < 2; ++mi)
#pragma unroll
            for (int ni = 0; ni < 2; ++ni)
#pragma unroll
                for (int r = 0; r < 16; ++r) O[(size_t)(mt * 128 + ACC_ROW(mi, r)) * ldo + nt * 128 + ACC_COL(ni)] = f2bf(acc[mi][ni][r]);
    }
}

__device__ void phase_finalize(const Params& P, int ph, int l, unsigned char* smem) {
    const int tid = tid_opaque(), lane = tid & 63, wave = tid >> 6;
    bf16_t* PB = (bf16_t*)(P.ws + OFF_PB);
    bf16_t* QF = (bf16_t*)(P.ws + OFF_QF);
    const bf16_t* KV = (const bf16_t*)(P.ws + OFF_KV);
    bf16_t* KF = (bf16_t*)(P.ws + OFF_KF);
    bf16_t* VTM = (bf16_t*)(P.ws + OFF_VTM);
    bf16_t* VTN = (bf16_t*)(P.ws + OFF_VTN);
    float* rs = (float*)smem;
    const int hd = lane >> 3, j = lane & 7;
    const float invf = __powf(10000.f, -(float)j * 0.125f);
    for (;;) {
        const int u7 = next_item(P, ph);
        if (u7 >= (NTH / 32) * 11) break;
        const int u = u7 / 11, sub = u7 % 11;
        const int t0 = u * 32, bl = t0 / TB, p0 = t0 % TB;
        if (sub >= 1 && sub <= 4) {
        uint2 in_cq[2]; unsigned in_ckv[2]; bf16_t in_q[2][12], in_kv[2][8], in_kr[2][4]; uint4 in_nq[2], in_nk[2];
#pragma unroll
        for (int rr = 0; rr < 2; ++rr) {
            const int tl = (sub - 1) * 8 + wave * 2 + rr, t = t0 + tl;
            const bf16_t* prow = PB + (size_t)t * PW;
            in_cq[rr] = *(const uint2*)(prow + C_CQ + lane * 4);
            in_ckv[rr] = *(const unsigned*)(prow + C_CKV + lane * 2);
            const bf16_t* q = QF + (size_t)t * 768 + hd * 96;
            const bf16_t* kvr = KV + (size_t)t * 1024 + hd * 128;
#pragma unroll
            for (int m = 0; m < 12; ++m) in_q[rr][m] = q[j + 8 * m];
#pragma unroll
            for (int m = 0; m < 8; ++m) in_kv[rr][m] = kvr[j + 8 * m];
#pragma unroll
            for (int m = 0; m < 4; ++m) in_kr[rr][m] = prow[C_KR + j + 8 * m];
            in_nq[rr] = *(const uint4*)(prow + C_NQ + hd * 64 + j * 8);
            in_nk[rr] = *(const uint4*)(prow + C_NK + hd * 64 + j * 8);
        }
#pragma unroll
        for (int rr = 0; rr < 2; ++rr) {
            const int tl = (sub - 1) * 8 + wave * 2 + rr, t = t0 + tl, p = p0 + tl;
            bf16_t* prow = PB + (size_t)t * PW;
            float s1, s2;
            { const uint2 a = in_cq[rr]; const float f0 = lo16(a.x), f1 = hi16(a.x), f2 = lo16(a.y), f3 = hi16(a.y); s1 = f0 * f0 + f1 * f1 + f2 * f2 + f3 * f3;
              const unsigned b = in_ckv[rr]; const float g0 = lo16(b), g1 = hi16(b); s2 = g0 * g0 + g1 * g1; }
            s1 = wave_sum(s1); s2 = wave_sum(s2);
            const float rcq = rsqrtf(s1 * (1.f / 256.f) + EPS), rckv = rsqrtf(s2 * (1.f / 128.f) + EPS);
            {
                bf16_t* q = QF + (size_t)t * 768 + hd * 96;
                float v[12], ss = 0.f;
#pragma unroll
                for (int m = 0; m < 12; ++m) { v[m] = bf2f(in_q[rr][m]) * rcq; ss += v[m] * v[m]; }
                ss += __shfl_xor(ss, 1); ss += __shfl_xor(ss, 2); ss += __shfl_xor(ss, 4);
                const float rn = rsqrtf(ss * (1.f / 96.f) + EPS);
#pragma unroll
                for (int m = 0; m < 12; ++m) q[j + 8 * m] = f2bf(v[m] * rn * P.g_q[l * 96 + j + 8 * m]);
            }
            {
                float v[12], ss = 0.f;
#pragma unroll
                for (int m = 0; m < 8; ++m) { v[m] = bf2f(in_kv[rr][m]) * rckv; ss += v[m] * v[m]; }
#pragma unroll
                for (int m = 8; m < 12; ++m) { v[m] = bf2f(in_kr[rr][m - 8]); ss += v[m] * v[m]; }
                ss += __shfl_xor(ss, 1); ss += __shfl_xor(ss, 2); ss += __shfl_xor(ss, 4);
                const float rn = rsqrtf(ss * (1.f / 96.f) + EPS);
#pragma unroll
                for (int m = 0; m < 12; ++m) v[m] = v[m] * rn * P.g_k[l * 96 + j + 8 * m];
                if (p >= CTXL) {
                    const int pos = p - CTXL;
                    const float ar = (float)(pos >> 6) * invf, ac = (float)(pos & 63) * invf;
                    double fr = (double)ar * 0.15915494309189535; fr -= rint(fr);
                    double fc = (double)ac * 0.15915494309189535; fc -= rint(fc);
                    const float sr = __builtin_amdgcn_sinf((float)fr), cr = __builtin_amdgcn_cosf((float)fr);
                    const float sc = __builtin_amdgcn_sinf((float)fc), cc = __builtin_amdgcn_cosf((float)fc);
                    const float x1a = v[8], x2a = v[10], x1b = v[9], x2b = v[11];
                    v[8] = x1a * cr - x2a * sr; v[10] = x1a * sr + x2a * cr;
                    v[9] = x1b * cc - x2b * sc; v[11] = x1b * sc + x2b * cc;
                }
                bf16_t* ko = KF + ((size_t)t * 8 + hd) * 96;
#pragma unroll
                for (int m = 0; m < 12; ++m) ko[j + 8 * m] = f2bf(v[m]);
            }
#pragma unroll
            for (int w = 0; w < 2; ++w) {
                bf16_t* q = prow + (w ? C_NK : C_NQ) + hd * 64 + j * 8;
                const float* g = (w ? P.ng_k : P.ng_q) + l * 64 + j * 8;
                float v[8], ss = 0.f;
                unpack8(w ? in_nk[rr] : in_nq[rr], v);
#pragma unroll
                for (int m = 0; m < 8; ++m) ss += v[m] * v[m];
                ss += __shfl_xor(ss, 1); ss += __shfl_xor(ss, 2); ss += __shfl_xor(ss, 4);
                const float rn = rsqrtf(ss * (1.f / 64.f) + EPS);
#pragma unroll
                for (int m = 0; m < 8; ++m) v[m] = v[m] * rn * g[m];
                *(uint4*)q = pack8(v);
            }
        }
        } else if (sub == 0) {
        {
            for (int rr = 0; rr < 8; ++rr) {
                const int tl = wave * 8 + rr;
                const unsigned bq = *(const unsigned*)(PB + (size_t)(t0 + tl) * PW + C_CKV + lane * 2);
                const float g0 = lo16(bq), g1 = hi16(bq);
                const float s2 = wave_sum(g0 * g0 + g1 * g1);
                if (lane == 0) rs[tl] = rsqrtf(s2 * (1.f / 128.f) + EPS);
            }
            __syncthreads();
            bf16_t* tile = (bf16_t*)(smem + 8192);
#pragma unroll
            for (int which = 0; which < 2; ++which) {
#pragma unroll
                for (int k8 = 0; k8 < 8; ++k8) {
                    const int id = tid + 256 * k8, i = id >> 6, c8 = id & 63;
                    const bf16_t* src = which ? PB + (size_t)(t0 + i) * PW + C_NV + c8 * 8
                                              : KV + (size_t)(t0 + i) * 1024 + (c8 >> 3) * 128 + 64 + (c8 & 7) * 8;
                    *(uint4*)(tile + i * 512 + c8 * 8) = *(const uint4*)src;
                }
                __syncthreads();
                bf16_t* VT = which ? VTN : VTM;
#pragma unroll
                for (int k8 = 0; k8 < 8; ++k8) {
                    const int id = tid + 256 * k8, r = id >> 2, g = id & 3;
                    float fv[8];
#pragma unroll
                    for (int i = 0; i < 8; ++i) fv[i] = bf2f(tile[(g * 8 + i) * 512 + r]) * (which ? 1.f : rs[g * 8 + i]);
                    *(uint4*)(VT + ((size_t)(bl * 8 + (r >> 6)) * 64 + (r & 63)) * TB + p0 + g * 8) = pack8(fv);
                }
                __syncthreads();
            }
        }
        } else
        {
            const int chunk = t0 >> 5;
            bf16_t* XH = (bf16_t*)(P.ws + OFF_XH);
            bf16_t* XG = (bf16_t*)(P.ws + OFF_XG);
            float* EBH = (float*)(P.ws + OFF_EBH);
            float* EBG = (float*)(P.ws + OFF_EBG);
            bf16_t* base = PB + (size_t)t0 * PW;
            float* rsh = (float*)smem + 256;
            bf16_t* inA = (bf16_t*)(smem + 8192);
            bf16_t* inB = inA + 32 * 128;
            bf16_t* inC = inB + 32 * 128;
            bf16_t* outT = inC + 32 * 128;
#pragma unroll
            for (int k4 = 0; k4 < 4; ++k4) { const int id = tid + 256 * k4, i = id >> 5, jx = id & 31; rsh[id] = bf2f(base[(size_t)i * PW + C_GR + jx]); }
            const int d = tid & 127, dr = tid >> 7;
            { const int grp = sub - 5;
                const bool isg = grp >= 4;
                const int gcol = isg ? (grp - 4) * 128 : grp * 128;
                const int cA = isg ? C_GQ + gcol : C_HQ + gcol, cB = isg ? C_GK + gcol : C_HF + gcol, cC = C_HF + 512 + gcol;
#pragma unroll
                for (int k2 = 0; k2 < 2; ++k2) {
                    const int id = tid + 256 * k2, i = id >> 4, ch = id & 15;
                    const bf16_t* row = base + (size_t)i * PW;
                    *(uint4*)(inA + i * 128 + ch * 8) = *(const uint4*)(row + cA + ch * 8);
                    *(uint4*)(inB + i * 128 + ch * 8) = *(const uint4*)(row + cB + ch * 8);
                    if (!isg) *(uint4*)(inC + i * 128 + ch * 8) = *(const uint4*)(row + cC + ch * 8);
                }
                __syncthreads();
                {
                    const int col = gcol + d;
                    float lb = 0.f, b2 = 0.f, w2[16];
#pragma unroll
                    for (int jx = 0; jx < 16; ++jx) w2[jx] = 0.f;
                    if (isg) {
#pragma unroll
                        for (int jx = 0; jx < 16; ++jx) w2[jx] = P.gla_w2[((size_t)(l * 2 + dr) * 16 + jx) * 256 + col];
                        b2 = P.gla_b2[(l * 2 + dr) * 256 + col];
                    } else if (l != 0) lb = sigmoidf_(P.lb_logits[1024 + dr * 512 + col] - P.lb_logits[dr * 512 + col]);
                    const bf16_t* fsrc = (dr && !isg) ? inC : inB;
                    bf16_t* oq = outT + (dr ? 2 : 0) * 32 * 128;
                    bf16_t* ok = oq + 32 * 128;
                    float cum = 0.f;
#pragma unroll 4
                    for (int sx = 0; sx < 32; ++sx) {
                        const int i = dr ? 31 - sx : sx;
                        const float qv = bf2f(inA[i * 128 + d]), fv = bf2f(fsrc[i * 128 + d]);
                        float qq, kk, la;
                        if (isg) {
                            float g = b2;
#pragma unroll
                            for (int jx = 0; jx < 16; ++jx) g = fmaf(rsh[i * 32 + dr * 16 + jx], w2[jx], g);
                            la = (fminf(g, 0.f) - __logf(1.f + __expf(-fabsf(g)))) * 0.0625f;
                            qq = qv * 0.125f; kk = fv;
                        } else {
                            const float av = lb + (1.f - lb) * sigmoidf_(fv);
                            la = __logf(av); kk = 1.f - av;
                            qq = siluf_(qv) * 0.08838834764831845f;
                        }
                        cum += la;
                        oq[i * 128 + d] = f2bf(qq * __expf(cum));
                        ok[i * 128 + d] = f2bf(kk * __expf(-cum));
                    }
                    if (isg) EBG[(size_t)(chunk * 2 + dr) * 256 + col] = __expf(cum);
                    else EBH[(size_t)(chunk * 2 + dr) * 512 + col] = __expf(cum);
                }
                __syncthreads();
#pragma unroll
                for (int k2 = 0; k2 < 2; ++k2) {
                    const int id = tid + 256 * k2, i = id >> 4, ch = id & 15;
                    bf16_t* row = base + (size_t)i * PW;
                    const uint4 v0 = *(const uint4*)(outT + (0 * 32 + i) * 128 + ch * 8), v1 = *(const uint4*)(outT + (1 * 32 + i) * 128 + ch * 8);
                    const uint4 v2 = *(const uint4*)(outT + (2 * 32 + i) * 128 + ch * 8), v3 = *(const uint4*)(outT + (3 * 32 + i) * 128 + ch * 8);
                    *(uint4*)(row + cA + ch * 8) = v0;
                    *(uint4*)(row + cB + ch * 8) = v1;
                    if (isg) { bf16_t* xr = XG + (size_t)(t0 + i) * 512 + gcol + ch * 8; *(uint4*)xr = v2; *(uint4*)(xr + 256) = v3; }
                    else { *(uint4*)(XH + (size_t)(t0 + i) * 512 + gcol + ch * 8) = v2; *(uint4*)(row + cC + ch * 8) = v3; }
                }
                __syncthreads();
            }
        }
    }
}

template <int DQK, bool NAT>
__device__ void attn_item(const Params& P, int l, int bl, int head, int qb, unsigned char* smem) {
    constexpr int NKS = DQK / 16, KSTR = DQK + 8, VSTR = 68, KCH = DQK / 8, KLD = (DQK * 64 / 8) / 256;
    const int tid = tid_opaque(), lane = tid & 63, wave = tid >> 6, hh = lane >> 5, r32 = lane & 31;
    bf16_t* Ks = (bf16_t*)smem;
    bf16_t* Vs = Ks + 2 * 64 * KSTR;
    float* rpb_s = (float*)(Vs + 2 * 64 * VSTR);
    bf16_t* PB = (bf16_t*)(P.ws + OFF_PB);
    const int rowbase = bl * TB, q_p0 = qb * 128, ql = wave * 32 + r32;
    const bool q_ctx = qb < 2;
    int lt0 = 0, lt1 = 0;
    int qr = 0, qc = 0, r0w = 0, c0 = 0;
    if (!q_ctx) {
        if (NAT) { const int rp = qb - 2, ra = 2 * rp, rb = ra + 1; lt0 = min(max(ra - 4, 0), 120); lt1 = min(max(rb - 4, 0), 120) + 8;
            qr = ra + (wave >> 1); qc = (wave & 1) * 32 + r32; r0w = min(max(qr - 4, 0), 120); c0 = min(max(qc - 8, 0), 48); }
        else { lt0 = 0; lt1 = 128; }
    }
    const int ntiles = 4 + (lt1 - lt0);
    const bf16_t* Kbase; const bf16_t* VT; const bf16_t* qptr; int k_ld;
    if (NAT) { Kbase = PB + (size_t)rowbase * PW + C_NK + head * 64; k_ld = PW; VT = (const bf16_t*)(P.ws + OFF_VTN) + (size_t)(bl * 8 + head) * 64 * TB;
        qptr = PB + (size_t)(rowbase + q_p0 + ql) * PW + C_NQ + head * 64; }
    else { Kbase = (const bf16_t*)(P.ws + OFF_KF) + (size_t)rowbase * 768 + head * 96; k_ld = 768; VT = (const bf16_t*)(P.ws + OFF_VTM) + (size_t)(bl * 8 + head) * 64 * TB;
        qptr = (const bf16_t*)(P.ws + OFF_QF) + (size_t)(rowbase + q_p0 + ql) * 768 + head * 96; }
    if (NAT) { for (int i = tid; i < 465; i += 256) rpb_s[i] = P.rpb[(size_t)(l * 8 + head) * 465 + i] * LOG2E; }
    bf16x8 qf[NKS];
#pragma unroll
    for (int ks = 0; ks < NKS; ++ks) qf[ks] = *(const bf16x8*)(qptr + ks * 16 + hh * 8);
    bf16x8 qrot4 = qf[NKS - 2], qrot5 = qf[NKS - 1];
    if (!NAT && !q_ctx) {
        const int pos = q_p0 - CTXL + ql;
        const float base = hh ? (float)(pos & 63) : (float)(pos >> 6);
#pragma unroll
        for (int jj = 0; jj < 8; ++jj) {
            const float invf = __powf(10000.f, -(float)jj * 0.125f);
            const float ang = base * invf;
            double fr = (double)ang * 0.15915494309189535; fr -= rint(fr);
            const float sn = __builtin_amdgcn_sinf((float)fr), cs = __builtin_amdgcn_cosf((float)fr);
            const float x1 = bf2f((bf16_t)qf[4][jj]), x2 = bf2f((bf16_t)qf[5][jj]);
            qrot4[jj] = (short)f2bf(x1 * cs - x2 * sn);
            qrot5[jj] = (short)f2bf(x1 * sn + x2 * cs);
        }
    }
    const float sc2 = (NAT ? 0.125f : 0.10206207261596575f) * LOG2E;
    float m_run = -1e30f, lsum = 0.f;
    f32x16 oacc[2];
#pragma unroll
    for (int r = 0; r < 16; ++r) { oacc[0][r] = 0.f; oacc[1][r] = 0.f; }
    uint4 kreg0, kreg1, kreg2, vreg0, vreg1;
    kreg2 = make_uint4(0, 0, 0, 0);
    const int kid0 = tid, kid1 = tid + 256, kid2 = tid + 512;
    const int krow0 = kid0 / KCH, kch0 = kid0 % KCH, krow1 = kid1 / KCH, kch1 = kid1 % KCH, krow2 = kid2 / KCH, kch2 = kid2 % KCH;
    const int vrow0 = tid >> 3, vch = tid & 7, vrow1 = vrow0 + 32;
#define TILE_P(ti) ((ti) < 4 ? (ti) * 64 : CTXL + (lt0 + (ti) - 4) * 64)
#define GLOAD(ti) { const int p_ = TILE_P(ti); \
        kreg0 = *(const uint4*)(Kbase + (size_t)(p_ + krow0) * k_ld + kch0 * 8); \
        kreg1 = *(const uint4*)(Kbase + (size_t)(p_ + krow1) * k_ld + kch1 * 8); \
        if (KLD > 2) kreg2 = *(const uint4*)(Kbase + (size_t)(p_ + krow2) * k_ld + kch2 * 8); \
        vreg0 = *(const uint4*)(VT + (size_t)vrow0 * TB + p_ + vch * 8); \
        vreg1 = *(const uint4*)(VT + (size_t)vrow1 * TB + p_ + vch * 8); }
#define SWRITE(buf_) { bf16_t* kd_ = Ks + (buf_) * 64 * KSTR; \
        *(uint4*)(kd_ + krow0 * KSTR + kch0 * 8) = kreg0; *(uint4*)(kd_ + krow1 * KSTR + kch1 * 8) = kreg1; \
        if (KLD > 2) *(uint4*)(kd_ + krow2 * KSTR + kch2 * 8) = kreg2; \
        bf16_t* vd_ = Vs + (buf_) * 64 * VSTR + vch * 8; \
        *(uint2*)(vd_ + vrow0 * VSTR) = make_uint2(vreg0.x, vreg0.y); *(uint2*)(vd_ + vrow0 * VSTR + 4) = make_uint2(vreg0.z, vreg0.w); \
        *(uint2*)(vd_ + vrow1 * VSTR) = make_uint2(vreg1.x, vreg1.y); *(uint2*)(vd_ + vrow1 * VSTR + 4) = make_uint2(vreg1.z, vreg1.w); }
    GLOAD(0); SWRITE(0);
    __syncthreads();
    for (int ti = 0; ti < ntiles; ++ti) {
        const int buf = ti & 1;
        const bool more = ti + 1 < ntiles;
        if (more) GLOAD(ti + 1);
        if (!NAT && ti == 4) { qf[NKS - 2] = qrot4; qf[NKS - 1] = qrot5; }
        const int kr = lt0 + ti - 4;
        const bool active = !NAT || ti < 4 || (kr >= r0w && kr < r0w + 8);
        if (active) {
            const bf16_t* kb = Ks + buf * 64 * KSTR + r32 * KSTR + hh * 8;
            f32x16 st0, st1;
#pragma unroll
            for (int r = 0; r < 16; ++r) { st0[r] = 0.f; st1[r] = 0.f; }
            bf16x8 kf0[NKS], kf1[NKS];
#pragma unroll
            for (int ks = 0; ks < NKS; ++ks) { kf0[ks] = *(const bf16x8*)(kb + ks * 16); kf1[ks] = *(const bf16x8*)(kb + 32 * KSTR + ks * 16); }
            asm volatile("s_waitcnt lgkmcnt(0)" ::: "memory");
#pragma unroll
            for (int ks = 0; ks < NKS; ++ks) {
                st0 = __builtin_amdgcn_mfma_f32_32x32x16_bf16(kf0[ks], qf[ks], st0, 0, 0, 0);
                st1 = __builtin_amdgcn_mfma_f32_32x32x16_bf16(kf1[ks], qf[ks], st1, 0, 0, 0);
            }
            const bf16_t* vb = Vs + buf * 64 * VSTR + r32 * VSTR + 4 * hh;
            uint2 vfr[2][2][2][2];
#pragma unroll
            for (int uu = 0; uu < 2; ++uu)
#pragma unroll
                for (int t = 0; t < 2; ++t)
#pragma unroll
                    for (int s2 = 0; s2 < 2; ++s2) {
                        const bf16_t* a = vb + uu * 32 * VSTR + t * 32 + s2 * 16;
                        vfr[uu][t][s2][0] = *(const uint2*)a; vfr[uu][t][s2][1] = *(const uint2*)(a + 8);
                    }
            float x[32];
#pragma unroll
            for (int r = 0; r < 16; ++r) { x[r] = st0[r] * sc2; x[16 + r] = st1[r] * sc2; }
            if (NAT && ti >= 4) {
                const int dr = kr - qr + 7;
#pragma unroll
                for (int e = 0; e < 32; ++e) {
                    const int r = e & 15, kc = (e >> 4) * 32 + (r & 3) + 8 * (r >> 2) + 4 * hh;
                    const int dc = min(max(kc - qc, -15), 15) + 15;
                    const bool ok = (kc >= c0) && (kc < c0 + 16);
                    x[e] = ok ? x[e] + rpb_s[dr * 31 + dc] : -1e30f;
                }
            }
            float mx = x[0];
#pragma unroll
            for (int e = 1; e < 32; ++e) mx = fmaxf(mx, x[e]);
            mx = fmaxf(mx, __shfl_xor(mx, 32));
            const float m_new = fmaxf(m_run, mx);
            const float alpha = __builtin_amdgcn_exp2f(m_run - m_new);
            m_run = m_new;
            float ps = 0.f;
#pragma unroll
            for (int e = 0; e < 32; ++e) { x[e] = __builtin_amdgcn_exp2f(x[e] - m_new); ps += x[e]; }
            lsum = lsum * alpha + ps;
#pragma unroll
            for (int r = 0; r < 16; ++r) { oacc[0][r] *= alpha; oacc[1][r] *= alpha; }
            bf16x8 pf[2][2];
#pragma unroll
            for (int t = 0; t < 2; ++t)
#pragma unroll
                for (int s = 0; s < 2; ++s) {
                    union { bf16x8 v; unsigned u[4]; } cv;
#pragma unroll
                    for (int q = 0; q < 4; ++q) cv.u[q] = cvt_pk(x[16 * t + 8 * s + 2 * q], x[16 * t + 8 * s + 2 * q + 1]);
                    pf[t][s] = cv.v;
                }
#pragma unroll
            for (int uu = 0; uu < 2; ++uu)
#pragma unroll
                for (int t = 0; t < 2; ++t)
#pragma unroll
                    for (int s = 0; s < 2; ++s) {
                        union { bf16x8 v; uint2 h[2]; } cv;
                        cv.h[0] = vfr[uu][t][s][0]; cv.h[1] = vfr[uu][t][s][1];
                        oacc[uu] = __builtin_amdgcn_mfma_f32_32x32x16_bf16(cv.v, pf[t][s], oacc[uu], 0, 0, 0);
                    }
        }
        if (more) SWRITE((ti + 1) & 1);
        __syncthreads();
    }
#undef TILE_P
#undef GLOAD
#undef SWRITE
    lsum += __shfl_xor(lsum, 32);
    const float inv = 1.f / lsum;
    bf16_t* zrow = PB + (size_t)(rowbase + q_p0 + ql) * PW + C_Z + (NAT ? 512 : 0) + head * 64;
#pragma unroll
    for (int uu = 0; uu < 2; ++uu)
#pragma unroll
        for (int g = 0; g < 4; ++g) {
            bf16_t* zp = zrow + uu * 32 + 8 * g + 4 * hh;
            const uint2 z = *(const uint2*)zp;
            uint2 o;
            o.x = cvt_pk(oacc[uu][4 * g + 0] * inv * siluf_(lo16(z.x)), oacc[uu][4 * g + 1] * inv * siluf_(hi16(z.x)));
            o.y = cvt_pk(oacc[uu][4 * g + 2] * inv * siluf_(lo16(z.y)), oacc[uu][4 * g + 3] * inv * siluf_(hi16(z.y)));
            *(uint2*)zp = o;
        }
}

__device__ void scan_hg_item(const Params& P, int l, int item, unsigned char* smem) {
    const int tid = tid_opaque(), lane = tid & 63, wave = tid >> 6;
    const int slice = item & 7, dir = (item >> 3) & 1, head = (item >> 4) & 3, bl = item >> 6;
    float* a_s = (float*)smem;
    float* q_s = a_s + 64 * 128;
    float* v_s = q_s + 64 * 128;
    float* o_s = v_s + 64 * 16;
    const bf16_t* PB = (const bf16_t*)(P.ws + OFF_PB) + (size_t)bl * TB * PW;
    bf16_t* OS = (bf16_t*)(P.ws + OFF_KV) + ((size_t)dir * NTH + (size_t)bl * TB) * 512 + head * 128 + slice * 16;
    const int prow = tid >> 4, pd = (tid & 15) * 8;
    float lb[8];
#pragma unroll
    for (int e = 0; e < 8; ++e) {
        const int cidx = dir * 512 + head * 128 + pd + e;
        lb[e] = (l == 0) ? 0.f : sigmoidf_(P.lb_logits[1024 + cidx] - P.lb_logits[cidx]);
    }
    const int fcol = (dir ? C_HF + 512 : C_HF) + head * 128 + pd, qcol = C_HQ + head * 128 + pd, vcol = C_HI + head * 128 + slice * 16 + (tid & 1) * 8;
    uint4 rq[4], rf[4], rv;
    auto chunk_p = [&](int c) { const int ci = dir ? (c < 4 ? 3 - c : 135 - c) : c; return ci * 64; };
    auto gload = [&](int c) {
        const int p = chunk_p(c);
#pragma unroll
        for (int r = 0; r < 4; ++r) { const bf16_t* row = PB + (size_t)(p + prow + 16 * r) * PW; rq[r] = *(const uint4*)(row + qcol); rf[r] = *(const uint4*)(row + fcol); }
        if (tid < 128) rv = *(const uint4*)(PB + (size_t)(p + (tid >> 1)) * PW + vcol);
    };
    const int dg = lane & 15, col = wave * 4 + (lane >> 4);
    float S[8];
#pragma unroll
    for (int e = 0; e < 8; ++e) S[e] = 0.f;
    gload(0);
    for (int c = 0; c < 132; ++c) {
        __syncthreads();
#pragma unroll
        for (int r = 0; r < 4; ++r) {
            float fq[8], ff[8];
            unpack8(rq[r], fq); unpack8(rf[r], ff);
            float* ad = a_s + (prow + 16 * r) * 128 + pd; float* qd = q_s + (prow + 16 * r) * 128 + pd;
#pragma unroll
            for (int e = 0; e < 8; ++e) { ad[e] = lb[e] + (1.f - lb[e]) * sigmoidf_(ff[e]); qd[e] = siluf_(fq[e]) * 0.08838834764831845f; }
        }
        if (tid < 128) { float fv[8]; unpack8(rv, fv); float* vd = v_s + (tid >> 1) * 16 + (tid & 1) * 8;
#pragma unroll
            for (int e = 0; e < 8; ++e) vd[e] = fv[e]; }
        __syncthreads();
        if (c + 1 < 132) gload(c + 1);
        for (int tt = 0; tt < 64; tt += 8) {
            float op[8];
#pragma unroll
            for (int u = 0; u < 8; ++u) {
                const int i = dir ? 63 - (tt + u) : tt + u;
                const float4 a0 = *(const float4*)(a_s + i * 128 + dg * 8), a1 = *(const float4*)(a_s + i * 128 + dg * 8 + 4);
                const float4 q0 = *(const float4*)(q_s + i * 128 + dg * 8), q1 = *(const float4*)(q_s + i * 128 + dg * 8 + 4);
                const float v = v_s[i * 16 + col];
                float o;
                S[0] = fmaf(a0.x, S[0] - v, v); o = q0.x * S[0];
                S[1] = fmaf(a0.y, S[1] - v, v); o = fmaf(q0.y, S[1], o);
                S[2] = fmaf(a0.z, S[2] - v, v); o = fmaf(q0.z, S[2], o);
                S[3] = fmaf(a0.w, S[3] - v, v); o = fmaf(q0.w, S[3], o);
                S[4] = fmaf(a1.x, S[4] - v, v); o = fmaf(q1.x, S[4], o);
                S[5] = fmaf(a1.y, S[5] - v, v); o = fmaf(q1.y, S[5], o);
                S[6] = fmaf(a1.z, S[6] - v, v); o = fmaf(q1.z, S[6], o);
                S[7] = fmaf(a1.w, S[7] - v, v); o = fmaf(q1.w, S[7], o);
                op[u] = o;
            }
            float r4[4], r2[2];
            const bool b8 = dg & 8, b4 = dg & 4, b2 = dg & 2;
#pragma unroll
            for (int k = 0; k < 4; ++k) { const float snd = b8 ? op[k] : op[k + 4], kp = b8 ? op[k + 4] : op[k]; r4[k] = kp + __shfl_xor(snd, 8); }
#pragma unroll
            for (int k = 0; k < 2; ++k) { const float snd = b4 ? r4[k] : r4[k + 2], kp = b4 ? r4[k + 2] : r4[k]; r2[k] = kp + __shfl_xor(snd, 4); }
            float r1; { const float snd = b2 ? r2[0] : r2[1], kp = b2 ? r2[1] : r2[0]; r1 = kp + __shfl_xor(snd, 2); }
            r1 += __shfl_xor(r1, 1);
            if ((dg & 1) == 0) { const int tok = tt + (b8 ? 4 : 0) + (b4 ? 2 : 0) + (b2 ? 1 : 0); const int i = dir ? 63 - tok : tok; o_s[i * 16 + col] = r1; }
        }
        __syncthreads();
        if (tid < 128) {
            const int p = chunk_p(c) + (tid >> 1);
            *(uint4*)(OS + (size_t)p * 512 + (tid & 1) * 8) = pack8(o_s + (tid >> 1) * 16 + (tid & 1) * 8);
        }
    }
}

__device__ void scan_gla_item(const Params& P, int l, int item, unsigned char* smem) {
    const int tid = tid_opaque(), lane = tid & 63, wave = tid >> 6;
    const int slice = item & 3, dir = (item >> 2) & 1, head = (item >> 3) & 3, bl = item >> 5;
    float* a_s = (float*)smem;
    float* q_s = a_s + 64 * 64;
    float* k_s = q_s + 64 * 64;
    float* v_s = k_s + 64 * 64;
    float* o_s = v_s + 64 * 32;
    float* r_s = o_s + 64 * 32;
    const bf16_t* PB = (const bf16_t*)(P.ws + OFF_PB) + (size_t)bl * TB * PW;
    bf16_t* OS = (bf16_t*)(P.ws + OFF_OSG) + ((size_t)dir * NTH + (size_t)bl * TB) * 512 + head * 128 + slice * 32;
    const int gd = tid & 63, gt0 = tid >> 6;
    float w2[16];
#pragma unroll
    for (int jx = 0; jx < 16; ++jx) w2[jx] = P.gla_w2[((size_t)(l * 2 + dir) * 16 + jx) * 256 + head * 64 + gd];
    const float b2 = P.gla_b2[(l * 2 + dir) * 256 + head * 64 + gd];
    uint4 rq[2], rk[2], rv, rr;
    auto chunk_p = [&](int c) { const int ci = dir ? (c < 4 ? 3 - c : 135 - c) : c; return ci * 64; };
    auto gload = [&](int c) {
        const int p = chunk_p(c);
#pragma unroll
        for (int i = 0; i < 2; ++i) { const int id = tid + 256 * i, row = id >> 3, ch = id & 7; const bf16_t* rp = PB + (size_t)(p + row) * PW;
            rq[i] = *(const uint4*)(rp + C_GQ + head * 64 + ch * 8); rk[i] = *(const uint4*)(rp + C_GK + head * 64 + ch * 8); }
        { const int row = tid >> 2, ch = tid & 3; rv = *(const uint4*)(PB + (size_t)(p + row) * PW + C_GV + head * 128 + slice * 32 + ch * 8); }
        if (tid < 128) { const int row = tid >> 1, ch = tid & 1; rr = *(const uint4*)(PB + (size_t)(p + row) * PW + C_GR + dir * 16 + ch * 8); }
    };
    const int dg = lane & 7, col = wave * 8 + (lane >> 3);
    float S[8];
#pragma unroll
    for (int e = 0; e < 8; ++e) S[e] = 0.f;
    gload(0);
    for (int c = 0; c < 132; ++c) {
        __syncthreads();
#pragma unroll
        for (int i = 0; i < 2; ++i) { const int id = tid + 256 * i, row = id >> 3, ch = id & 7; float fq[8], fk[8]; unpack8(rq[i], fq); unpack8(rk[i], fk);
#pragma unroll
            for (int e = 0; e < 8; ++e) { q_s[row * 64 + ch * 8 + e] = fq[e] * 0.125f; k_s[row * 64 + ch * 8 + e] = fk[e]; } }
        { const int row = tid >> 2, ch = tid & 3; float fv[8]; unpack8(rv, fv);
#pragma unroll
            for (int e = 0; e < 8; ++e) v_s[row * 32 + ch * 8 + e] = fv[e]; }
        if (tid < 128) { const int row = tid >> 1, ch = tid & 1; float fr[8]; unpack8(rr, fr);
#pragma unroll
            for (int e = 0; e < 8; ++e) r_s[row * 16 + ch * 8 + e] = fr[e]; }
        __syncthreads();
        if (c + 1 < 132) gload(c + 1);
#pragma unroll 4
        for (int m = 0; m < 16; ++m) {
            const int i = gt0 + 4 * m;
            float g = b2;
#pragma unroll
            for (int jx = 0; jx < 16; ++jx) g = fmaf(r_s[i * 16 + jx], w2[jx], g);
            const float ls = fminf(g, 0.f) - __logf(1.f + __expf(-fabsf(g)));
            a_s[i * 64 + gd] = __expf(ls * 0.0625f);
        }
        __syncthreads();
        for (int tt = 0; tt < 64; tt += 8) {
            float op[8];
#pragma unroll
            for (int u = 0; u < 8; ++u) {
                const int i = dir ? 63 - (tt + u) : tt + u;
                const float4 a0 = *(const float4*)(a_s + i * 64 + dg * 8), a1 = *(const float4*)(a_s + i * 64 + dg * 8 + 4);
                const float4 q0 = *(const float4*)(q_s + i * 64 + dg * 8), q1 = *(const float4*)(q_s + i * 64 + dg * 8 + 4);
                const float4 k0 = *(const float4*)(k_s + i * 64 + dg * 8), k1 = *(const float4*)(k_s + i * 64 + dg * 8 + 4);
                const float v = v_s[i * 32 + col];
                float o;
                S[0] = fmaf(a0.x, S[0], k0.x * v); o = q0.x * S[0];
                S[1] = fmaf(a0.y, S[1], k0.y * v); o = fmaf(q0.y, S[1], o);
                S[2] = fmaf(a0.z, S[2], k0.z * v); o = fmaf(q0.z, S[2], o);
                S[3] = fmaf(a0.w, S[3], k0.w * v); o = fmaf(q0.w, S[3], o);
                S[4] = fmaf(a1.x, S[4], k1.x * v); o = fmaf(q1.x, S[4], o);
                S[5] = fmaf(a1.y, S[5], k1.y * v); o = fmaf(q1.y, S[5], o);
                S[6] = fmaf(a1.z, S[6], k1.z * v); o = fmaf(q1.z, S[6], o);
                S[7] = fmaf(a1.w, S[7], k1.w * v); o = fmaf(q1.w, S[7], o);
                op[u] = o;
            }
            float r4[4], r2[2];
            const bool b4 = dg & 4, b2 = dg & 2, b1 = dg & 1;
#pragma unroll
            for (int k = 0; k < 4; ++k) { const float snd = b4 ? op[k] : op[k + 4], kp = b4 ? op[k + 4] : op[k]; r4[k] = kp + __shfl_xor(snd, 4); }
#pragma unroll
            for (int k = 0; k < 2; ++k) { const float snd = b2 ? r4[k] : r4[k + 2], kp = b2 ? r4[k + 2] : r4[k]; r2[k] = kp + __shfl_xor(snd, 2); }
            float r1; { const float snd = b1 ? r2[0] : r2[1], kp = b1 ? r2[1] : r2[0]; r1 = kp + __shfl_xor(snd, 1); }
            { const int tok = tt + (b4 ? 4 : 0) + (b2 ? 2 : 0) + (b1 ? 1 : 0); const int i = dir ? 63 - tok : tok; o_s[i * 32 + col] = r1; }
        }
        __syncthreads();
        { const int row = tid >> 2, ch = tid & 3; const int p = chunk_p(c) + row;
          *(uint4*)(OS + (size_t)p * 512 + ch * 8) = pack8(o_s + row * 32 + ch * 8); }
    }
}


template <bool GLA>
__device__ void scan2_item(const Params& P, int l, int item, unsigned char* smem) {
    constexpr int DK = GLA ? 64 : 128, NT = DK / 32, QS = DK + 8, TS = 40, NSEG = GLA ? 4 : 2, TPS = 32 / NSEG, QCH = DK / 8;
    const int tid = tid_opaque(), lane = tid & 63, wave = tid >> 6, r32 = lane & 31, hh = lane >> 5;
    const int dir = item & 1, head = (item >> 1) & 3, bl = item >> 3;
    bf16_t* Qh = (bf16_t*)smem;
    bf16_t* Kh = Qh + 32 * QS;
    bf16_t* Kt = Kh + 32 * QS;
    bf16_t* Vt = Kt + DK * TS;
    float* eb = (float*)(Vt + 128 * TS);
    float* tot = eb + DK;
    bf16_t* qraw = (bf16_t*)(tot + 4 * DK);
    bf16_t* fraw = qraw + 32 * DK;
    bf16_t* vraw = fraw + 32 * DK;
    bf16_t* rraw = vraw + 32 * 128;
    const bf16_t* PB = (const bf16_t*)(P.ws + OFF_PB) + (size_t)bl * TB * PW;
    bf16_t* OS = (bf16_t*)(P.ws + (GLA ? OFF_OSG : OFF_KV)) + ((size_t)dir * NTH + (size_t)bl * TB) * 512 + head * 128 + wave * 32;
    const int qcol = (GLA ? C_GQ : C_HQ) + head * DK, fcol = GLA ? (C_GK + head * 64) : ((dir ? C_HF + 512 : C_HF) + head * 128),
              vcol = (GLA ? C_GV : C_HI) + head * 128, rcol = C_GR + dir * 16;
    const int pd = tid & (DK - 1), seg = tid / DK;
    float lbv = 0.f, b2 = 0.f, w2[16];
#pragma unroll
    for (int jx = 0; jx < 16; ++jx) w2[jx] = 0.f;
    if (GLA) {
#pragma unroll
        for (int jx = 0; jx < 16; ++jx) w2[jx] = P.gla_w2[((size_t)(l * 2 + dir) * 16 + jx) * 256 + head * 64 + pd];
        b2 = P.gla_b2[(l * 2 + dir) * 256 + head * 64 + pd];
    } else if (l != 0) { const int cidx = dir * 512 + head * 128 + pd; lbv = sigmoidf_(P.lb_logits[1024 + cidx] - P.lb_logits[cidx]); }
    uint4 pq0, pq1, pf0, pf1, pv0, pv1, pr;
    pq1 = pf1 = pr = make_uint4(0, 0, 0, 0);
#define CH_P0(c) (dir ? ((c) < 8 ? (7 - (c)) * 32 : CTXL + (263 - (c)) * 32) : (c) * 32)
#define ROWP(p0_, i_) ((p0_) + (dir ? 31 - (i_) : (i_)))
#define SC_GLOAD(c) { const int p0_ = CH_P0(c); \
        { const int id = tid, i = id / QCH, ch = id % QCH; const bf16_t* rp = PB + (size_t)ROWP(p0_, i) * PW; pq0 = *(const uint4*)(rp + qcol + ch * 8); pf0 = *(const uint4*)(rp + fcol + ch * 8); } \
        if (!GLA) { const int id = tid + 256, i = id / QCH, ch = id % QCH; const bf16_t* rp = PB + (size_t)ROWP(p0_, i) * PW; pq1 = *(const uint4*)(rp + qcol + ch * 8); pf1 = *(const uint4*)(rp + fcol + ch * 8); } \
        { const int i = tid >> 4, ch = tid & 15; pv0 = *(const uint4*)(PB + (size_t)ROWP(p0_, i) * PW + vcol + ch * 8); pv1 = *(const uint4*)(PB + (size_t)ROWP(p0_, i + 16) * PW + vcol + ch * 8); } \
        if (GLA && tid < 64) { const int i = tid >> 1, ch = tid & 1; pr = *(const uint4*)(PB + (size_t)ROWP(p0_, i) * PW + rcol + ch * 8); } }
    f32x16 ST[NT];
#pragma unroll
    for (int T = 0; T < NT; ++T)
#pragma unroll
        for (int r = 0; r < 16; ++r) ST[T][r] = 0.f;
    SC_GLOAD(0);
    for (int c = 0; c < 264; ++c) {
        __syncthreads();
        { const int id = tid, i = id / QCH, ch = id % QCH; *(uint4*)(qraw + i * DK + ch * 8) = pq0; *(uint4*)(fraw + i * DK + ch * 8) = pf0; }
        if (!GLA) { const int id = tid + 256, i = id / QCH, ch = id % QCH; *(uint4*)(qraw + i * DK + ch * 8) = pq1; *(uint4*)(fraw + i * DK + ch * 8) = pf1; }
        { const int i = tid >> 4, ch = tid & 15; *(uint4*)(vraw + i * 128 + ch * 8) = pv0; *(uint4*)(vraw + (i + 16) * 128 + ch * 8) = pv1; }
        if (GLA && tid < 64) { const int i = tid >> 1, ch = tid & 1; *(uint4*)(rraw + i * 16 + ch * 8) = pr; }
        __syncthreads();
        if (c + 1 < 264) SC_GLOAD(c + 1);
        float bl_[TPS], kk[TPS], qq[TPS];
        float cum = 0.f;
#pragma unroll
        for (int tt = 0; tt < TPS; ++tt) {
            const int i = seg * TPS + tt;
            float la;
            if (GLA) {
                float g = b2;
#pragma unroll
                for (int jx = 0; jx < 16; ++jx) g = fmaf(bf2f(rraw[i * 16 + jx]), w2[jx], g);
                la = (fminf(g, 0.f) - __logf(1.f + __expf(-fabsf(g)))) * 0.0625f;
                kk[tt] = bf2f(fraw[i * DK + pd]);
                qq[tt] = bf2f(qraw[i * DK + pd]) * 0.125f;
            } else {
                const float f = bf2f(fraw[i * DK + pd]);
                const float a = lbv + (1.f - lbv) * sigmoidf_(f);
                la = __logf(a);
                kk[tt] = 1.f - a;
                qq[tt] = siluf_(bf2f(qraw[i * DK + pd])) * 0.08838834764831845f;
            }
            cum += la;
            bl_[tt] = cum;
        }
        tot[seg * DK + pd] = cum;
        __syncthreads();
        {
            float off = 0.f, bend = 0.f;
#pragma unroll
            for (int sg = 0; sg < NSEG; ++sg) { const float tv = tot[sg * DK + pd]; bend += tv; if (sg < seg) off += tv; }
            const float eend = __expf(bend);
            if (seg == 0) eb[pd] = eend;
            float kt[TPS];
#pragma unroll
            for (int tt = 0; tt < TPS; ++tt) {
                const int i = seg * TPS + tt;
                const float b = bl_[tt] + off;
                const float e1 = __expf(b), e2 = __expf(-b);
                const float kh = kk[tt] * e2;
                Qh[i * QS + pd] = f2bf(qq[tt] * e1);
                Kh[i * QS + pd] = f2bf(kh);
                kt[tt] = kh * eend;
            }
#pragma unroll
            for (int g8 = 0; g8 < TPS / 8; ++g8) *(uint4*)(Kt + pd * TS + seg * TPS + g8 * 8) = pack8(kt + g8 * 8);
            const int vc = tid & 127, vs = tid >> 7;
            float vv[16];
#pragma unroll
            for (int tt = 0; tt < 16; ++tt) vv[tt] = bf2f(vraw[(vs * 16 + tt) * 128 + vc]);
            *(uint4*)(Vt + vc * TS + vs * 16) = pack8(vv);
            *(uint4*)(Vt + vc * TS + vs * 16 + 8) = pack8(vv + 8);
        }
        __syncthreads();
        f32x16 st;
#pragma unroll
        for (int r = 0; r < 16; ++r) st[r] = 0.f;
#pragma unroll
        for (int ks = 0; ks < DK / 16; ++ks) {
            const bf16x8 ka = *(const bf16x8*)(Kh + r32 * QS + ks * 16 + hh * 8);
            const bf16x8 qb = *(const bf16x8*)(Qh + r32 * QS + ks * 16 + hh * 8);
            st = __builtin_amdgcn_mfma_f32_32x32x16_bf16(ka, qb, st, 0, 0, 0);
        }
        bf16x8 pfr[2];
#pragma unroll
        for (int sI = 0; sI < 2; ++sI) {
            union { bf16x8 v; unsigned u[4]; } cv;
#pragma unroll
            for (int q = 0; q < 4; ++q) {
                const int ra = 8 * sI + 2 * q, rb = ra + 1;
                const int ja = (ra & 3) + 8 * (ra >> 2) + 4 * hh, jb = (rb & 3) + 8 * (rb >> 2) + 4 * hh;
                cv.u[q] = cvt_pk(ja <= r32 ? st[ra] : 0.f, jb <= r32 ? st[rb] : 0.f);
            }
            pfr[sI] = cv.v;
        }
        f32x16 oT;
#pragma unroll
        for (int r = 0; r < 16; ++r) oT[r] = 0.f;
#pragma unroll
        for (int sI = 0; sI < 2; ++sI) {
            const bf16_t* a = Vt + (wave * 32 + r32) * TS + sI * 16 + 4 * hh;
            union { bf16x8 v; uint2 h[2]; } cv;
            cv.h[0] = *(const uint2*)a; cv.h[1] = *(const uint2*)(a + 8);
            oT = __builtin_amdgcn_mfma_f32_32x32x16_bf16(cv.v, pfr[sI], oT, 0, 0, 0);
        }
#pragma unroll
        for (int T = 0; T < NT; ++T)
#pragma unroll
            for (int sI = 0; sI < 2; ++sI) {
                union { bf16x8 v; unsigned u[4]; } ca;
#pragma unroll
                for (int q = 0; q < 4; ++q) ca.u[q] = cvt_pk(ST[T][8 * sI + 2 * q], ST[T][8 * sI + 2 * q + 1]);
                const bf16_t* b = Qh + r32 * QS + T * 32 + sI * 16 + 4 * hh;
                union { bf16x8 v; uint2 h[2]; } cb;
                cb.h[0] = *(const uint2*)b; cb.h[1] = *(const uint2*)(b + 8);
                oT = __builtin_amdgcn_mfma_f32_32x32x16_bf16(ca.v, cb.v, oT, 0, 0, 0);
            }
#pragma unroll
        for (int T = 0; T < NT; ++T) {
#pragma unroll
            for (int g = 0; g < 4; ++g) {
                const float4 e4 = *(const float4*)(eb + T * 32 + 8 * g + 4 * hh);
                ST[T][4 * g + 0] *= e4.x; ST[T][4 * g + 1] *= e4.y; ST[T][4 * g + 2] *= e4.z; ST[T][4 * g + 3] *= e4.w;
            }
#pragma unroll
            for (int ks = 0; ks < 2; ++ks) {
                const bf16x8 ka = *(const bf16x8*)(Kt + (T * 32 + r32) * TS + ks * 16 + hh * 8);
                const bf16x8 vb = *(const bf16x8*)(Vt + (wave * 32 + r32) * TS + ks * 16 + hh * 8);
                ST[T] = __builtin_amdgcn_mfma_f32_32x32x16_bf16(ka, vb, ST[T], 0, 0, 0);
            }
        }
        {
            const int p = ROWP(CH_P0(c), r32);
            bf16_t* op = OS + (size_t)p * 512 + 4 * hh;
#pragma unroll
            for (int g = 0; g < 4; ++g) { uint2 o; o.x = cvt_pk(oT[4 * g], oT[4 * g + 1]); o.y = cvt_pk(oT[4 * g + 2], oT[4 * g + 3]); *(uint2*)(op + 8 * g) = o; }
        }
    }
#undef CH_P0
#undef ROWP
#undef SC_GLOAD
}


template <bool GLA>
__device__ void scan3_item(const Params& P, int l, int item, unsigned char* smem) {
    constexpr int DK = GLA ? 64 : 128, NT = DK / 32, QS = DK + 8, TS = 40, NSEG = GLA ? 4 : 2, TPS = 32 / NSEG, QCH = DK / 8;
    const int tid = tid_opaque(), lane = tid & 63, wave = tid >> 6, r32 = lane & 31, hh = lane >> 5;
    const int dir = item & 1, head = (item >> 1) & 3, bl = item >> 3;
    __builtin_amdgcn_s_setprio(3);
    bf16_t* Qh = (bf16_t*)smem;
    bf16_t* Kh = Qh + 32 * QS;
    bf16_t* Kt = Kh + 32 * QS;
    bf16_t* Vt = Kt + DK * TS;
    float* eb = (float*)(Vt + 128 * TS);
    bf16_t* vraw = (bf16_t*)(eb + DK);
    const bf16_t* PB = (const bf16_t*)(P.ws + OFF_PB) + (size_t)bl * TB * PW;
    bf16_t* OS = (bf16_t*)(P.ws + (GLA ? OFF_OSG : OFF_KV)) + ((size_t)dir * NTH + (size_t)bl * TB) * 512 + head * 128 + wave * 32;
    const bf16_t* qsrc; const bf16_t* ksrc; int qld, kld;
    if (GLA) {
        if (dir == 0) { qsrc = PB + C_GQ + head * 64; qld = PW; ksrc = PB + C_GK + head * 64; kld = PW; }
        else { const bf16_t* X = (const bf16_t*)(P.ws + OFF_XG) + (size_t)bl * TB * 512; qsrc = X + head * 64; qld = 512; ksrc = X + 256 + head * 64; kld = 512; }
    } else {
        if (dir == 0) { qsrc = PB + C_HQ + head * 128; qld = PW; ksrc = PB + C_HF + head * 128; kld = PW; }
        else { qsrc = (const bf16_t*)(P.ws + OFF_XH) + (size_t)bl * TB * 512 + head * 128; qld = 512; ksrc = PB + C_HF + 512 + head * 128; kld = PW; }
    }
    const float* ebsrc = (const float*)(P.ws + (GLA ? OFF_EBG : OFF_EBH)) + ((size_t)(bl * 264) * 2 + dir) * (4 * DK) + head * DK;
    const int vcol = (GLA ? C_GV : C_HI) + head * 128;
    const int pd = tid & (DK - 1), seg = tid / DK;
    uint4 pq0, pq1, pk0, pk1, pv0, pv1; float pe = 0.f;
    pq1 = pk1 = make_uint4(0, 0, 0, 0);
#define CH_P0(c) (dir ? ((c) < 8 ? (7 - (c)) * 32 : CTXL + (263 - (c)) * 32) : (c) * 32)
#define ROWP(p0_, i_) ((p0_) + (dir ? 31 - (i_) : (i_)))
#define SC_GLOAD(c) { const int p0_ = CH_P0(c); \
        { const int id = tid, i = id / QCH, ch = id % QCH; const size_t rr_ = (size_t)ROWP(p0_, i); pq0 = *(const uint4*)(qsrc + rr_ * qld + ch * 8); pk0 = *(const uint4*)(ksrc + rr_ * kld + ch * 8); } \
        if (!GLA) { const int id = tid + 256, i = id / QCH, ch = id % QCH; const size_t rr_ = (size_t)ROWP(p0_, i); pq1 = *(const uint4*)(qsrc + rr_ * qld + ch * 8); pk1 = *(const uint4*)(ksrc + rr_ * kld + ch * 8); } \
        { const int i = tid >> 4, ch = tid & 15; pv0 = *(const uint4*)(PB + (size_t)ROWP(p0_, i) * PW + vcol + ch * 8); pv1 = *(const uint4*)(PB + (size_t)ROWP(p0_, i + 16) * PW + vcol + ch * 8); } \
        if (tid < DK) pe = ebsrc[(size_t)(p0_ >> 5) * 2 * (4 * DK) + tid]; }
    f32x16 ST[NT];
#pragma unroll
    for (int T = 0; T < NT; ++T)
#pragma unroll
        for (int r = 0; r < 16; ++r) ST[T][r] = 0.f;
    SC_GLOAD(0);
    for (int c = 0; c < 264; ++c) {
        __syncthreads();
        { const int id = tid, i = id / QCH, ch = id % QCH; *(uint4*)(Qh + i * QS + ch * 8) = pq0; *(uint4*)(Kh + i * QS + ch * 8) = pk0; }
        if (!GLA) { const int id = tid + 256, i = id / QCH, ch = id % QCH; *(uint4*)(Qh + i * QS + ch * 8) = pq1; *(uint4*)(Kh + i * QS + ch * 8) = pk1; }
        { const int i = tid >> 4, ch = tid & 15; *(uint4*)(vraw + i * 128 + ch * 8) = pv0; *(uint4*)(vraw + (i + 16) * 128 + ch * 8) = pv1; }
        if (tid < DK) eb[tid] = pe;
        __syncthreads();
        if (c + 1 < 264) SC_GLOAD(c + 1);
        {
            const float eend = eb[pd];
            float kt[TPS];
#pragma unroll
            for (int tt = 0; tt < TPS; ++tt) kt[tt] = bf2f(Kh[(seg * TPS + tt) * QS + pd]) * eend;
#pragma unroll
            for (int g8 = 0; g8 < TPS / 8; ++g8) *(uint4*)(Kt + pd * TS + seg * TPS + g8 * 8) = pack8(kt + g8 * 8);
            const int vc = tid & 127, vs = tid >> 7;
            float vv[16];
#pragma unroll
            for (int tt = 0; tt < 16; ++tt) vv[tt] = bf2f(vraw[(vs * 16 + tt) * 128 + vc]);
            *(uint4*)(Vt + vc * TS + vs * 16) = pack8(vv);
            *(uint4*)(Vt + vc * TS + vs * 16 + 8) = pack8(vv + 8);
        }
        __syncthreads();
        f32x16 st, stb;
#pragma unroll
        for (int r = 0; r < 16; ++r) { st[r] = 0.f; stb[r] = 0.f; }
        {
            bf16x8 ka[DK / 16], qb[DK / 16];
#pragma unroll
            for (int ks = 0; ks < DK / 16; ++ks) { ka[ks] = *(const bf16x8*)(Kh + r32 * QS + ks * 16 + hh * 8); qb[ks] = *(const bf16x8*)(Qh + r32 * QS + ks * 16 + hh * 8); }
            asm volatile("s_waitcnt lgkmcnt(0)" ::: "memory");
#pragma unroll
            for (int ks = 0; ks < DK / 16; ks += 2) {
                st = __builtin_amdgcn_mfma_f32_32x32x16_bf16(ka[ks], qb[ks], st, 0, 0, 0);
                stb = __builtin_amdgcn_mfma_f32_32x32x16_bf16(ka[ks + 1], qb[ks + 1], stb, 0, 0, 0);
            }
        }
        uint2 vp[2][2], qp[NT][2][2];
#pragma unroll
        for (int sI = 0; sI < 2; ++sI) { const bf16_t* av = Vt + (wave * 32 + r32) * TS + sI * 16 + 4 * hh; vp[sI][0] = *(const uint2*)av; vp[sI][1] = *(const uint2*)(av + 8); }
#pragma unroll
        for (int T = 0; T < NT; ++T)
#pragma unroll
            for (int sI = 0; sI < 2; ++sI) { const bf16_t* bq = Qh + r32 * QS + T * 32 + sI * 16 + 4 * hh; qp[T][sI][0] = *(const uint2*)bq; qp[T][sI][1] = *(const uint2*)(bq + 8); }
#pragma unroll
        for (int r = 0; r < 16; ++r) st[r] += stb[r];
        bf16x8 pfr[2];
#pragma unroll
        for (int sI = 0; sI < 2; ++sI) {
            union { bf16x8 v; unsigned u[4]; } cv;
#pragma unroll
            for (int q = 0; q < 4; ++q) {
                const int ra = 8 * sI + 2 * q, rb = ra + 1;
                const int ja = (ra & 3) + 8 * (ra >> 2) + 4 * hh, jb = (rb & 3) + 8 * (rb >> 2) + 4 * hh;
                cv.u[q] = cvt_pk(ja <= r32 ? st[ra] : 0.f, jb <= r32 ? st[rb] : 0.f);
            }
            pfr[sI] = cv.v;
        }
        asm volatile("s_waitcnt lgkmcnt(0)" ::: "memory");
        f32x16 oT, oTb;
#pragma unroll
        for (int r = 0; r < 16; ++r) { oT[r] = 0.f; oTb[r] = 0.f; }
#pragma unroll
        for (int sI = 0; sI < 2; ++sI) {
            union { bf16x8 v; uint2 h[2]; } cv;
            cv.h[0] = vp[sI][0]; cv.h[1] = vp[sI][1];
            oT = __builtin_amdgcn_mfma_f32_32x32x16_bf16(cv.v, pfr[sI], oT, 0, 0, 0);
        }
#pragma unroll
        for (int T = 0; T < NT; ++T)
#pragma unroll
            for (int sI = 0; sI < 2; ++sI) {
                union { bf16x8 v; unsigned u[4]; } ca;
#pragma unroll
                for (int q = 0; q < 4; ++q) ca.u[q] = cvt_pk(ST[T][8 * sI + 2 * q], ST[T][8 * sI + 2 * q + 1]);
                union { bf16x8 v; uint2 h[2]; } cb;
                cb.h[0] = qp[T][sI][0]; cb.h[1] = qp[T][sI][1];
                if (T & 1) oTb = __builtin_amdgcn_mfma_f32_32x32x16_bf16(ca.v, cb.v, oTb, 0, 0, 0);
                else oT = __builtin_amdgcn_mfma_f32_32x32x16_bf16(ca.v, cb.v, oT, 0, 0, 0);
            }
        {
            bf16x8 kt2[NT][2], vb2[2];
            float4 e4v[NT][4];
#pragma unroll
            for (int ks = 0; ks < 2; ++ks) vb2[ks] = *(const bf16x8*)(Vt + (wave * 32 + r32) * TS + ks * 16 + hh * 8);
#pragma unroll
            for (int T = 0; T < NT; ++T) {
#pragma unroll
                for (int ks = 0; ks < 2; ++ks) kt2[T][ks] = *(const bf16x8*)(Kt + (T * 32 + r32) * TS + ks * 16 + hh * 8);
#pragma unroll
                for (int g = 0; g < 4; ++g) e4v[T][g] = *(const float4*)(eb + T * 32 + 8 * g + 4 * hh);
            }
            asm volatile("s_waitcnt lgkmcnt(0)" ::: "memory");
#pragma unroll
            for (int T = 0; T < NT; ++T) {
#pragma unroll
                for (int g = 0; g < 4; ++g) { ST[T][4 * g + 0] *= e4v[T][g].x; ST[T][4 * g + 1] *= e4v[T][g].y; ST[T][4 * g + 2] *= e4v[T][g].z; ST[T][4 * g + 3] *= e4v[T][g].w; }
#pragma unroll
                for (int ks = 0; ks < 2; ++ks) ST[T] = __builtin_amdgcn_mfma_f32_32x32x16_bf16(kt2[T][ks], vb2[ks], ST[T], 0, 0, 0);
            }
        }
#pragma unroll
        for (int r = 0; r < 16; ++r) oT[r] += oTb[r];
        {
            const int p = ROWP(CH_P0(c), r32);
            bf16_t* op = OS + (size_t)p * 512 + 4 * hh;
#pragma unroll
            for (int g = 0; g < 4; ++g) { uint2 o; o.x = cvt_pk(oT[4 * g], oT[4 * g + 1]); o.y = cvt_pk(oT[4 * g + 2], oT[4 * g + 3]); *(uint2*)(op + 8 * g) = o; }
        }
    }
#undef CH_P0
#undef ROWP
#undef SC_GLOAD
    __builtin_amdgcn_s_setprio(0);
}

#ifdef ONLYI
#define IT_ON(n) (ONLYI == (n))
#else
#define IT_ON(n) true
#endif
__device__ void phase_mixers(const Params& P, int ph, int l, unsigned char* smem, int mode = 0) {
    constexpr int N_HG = 16, N_GLA = 16, N_ATT = 2 * 8 * 66;
    const int bx = blockIdx.x;
    int my_scan = -1;
    if (mode != 2 && bx < 256 && (bx & 7) == ((bx >> 3) & 7)) my_scan = bx >> 3;
    if (mode == 0 && bx >= 256 && ((bx - 256) & 7) == (((bx - 256) >> 3) & 7)) return;
    for (;;) {
        int it;
        if (my_scan >= 0) { it = my_scan; my_scan = -1; }
        else {
            if (mode == 1) break;
            it = next_item(P, ph) + N_HG + N_GLA;
        }
        if (it >= N_HG + N_GLA + 2 * N_ATT) break;
        if (it < N_HG) { if (IT_ON(0)) scan3_item<false>(P, l, it, smem); continue; }
        it -= N_HG;
        if (it < N_GLA) { if (IT_ON(1)) scan3_item<true>(P, l, it, smem); continue; }
        it -= N_GLA;
        if (it < N_ATT) { const int bl = it / 528, rem = it % 528; if (IT_ON(2)) attn_item<96, false>(P, l, bl, rem / 66, rem % 66, smem); continue; }
        it -= N_ATT;
        { const int bl = it / 528, rem = it % 528; if (IT_ON(3)) attn_item<64, true>(P, l, bl, rem / 66, rem % 66, smem); }
    }
}

__device__ void phase_scanfin(const Params& P, int ph, int l) {
    const int tid = tid_opaque(), lane = tid & 63, wave = tid >> 6;
    bf16_t* PB = (bf16_t*)(P.ws + OFF_PB);
    const bf16_t* OSH = (const bf16_t*)(P.ws + OFF_KV);
    const bf16_t* OSGp = (const bf16_t*)(P.ws + OFF_OSG);
    float gh[8], gg[8];
#pragma unroll
    for (int e = 0; e < 8; ++e) { gh[e] = P.hg_g_o[l * 128 + (lane & 15) * 8 + e]; gg[e] = P.gla_g_o[l * 128 + (lane & 15) * 8 + e]; }
    for (;;) {
        const int u = next_item(P, ph);
        if (u >= NTH / 16) break;
        uint4 ra[8], rb[8], rz[8];
#pragma unroll
        for (int k = 0; k < 8; ++k) {
            const int t = u * 16 + wave * 4 + (k >> 1), mx = k & 1;
            const bf16_t* OS = mx ? OSGp : OSH;
            ra[k] = *(const uint4*)(OS + (size_t)t * 512 + lane * 8);
            rb[k] = *(const uint4*)(OS + ((size_t)NTH + t) * 512 + lane * 8);
            rz[k] = *(const uint4*)(PB + (size_t)t * PW + C_Z + (2 + mx) * 512 + lane * 8);
        }
#pragma unroll
        for (int k = 0; k < 8; ++k) {
            const int t = u * 16 + wave * 4 + (k >> 1), mx = k & 1;
            float a[8], b[8], z[8];
            unpack8(ra[k], a); unpack8(rb[k], b); unpack8(rz[k], z);
            float ss = 0.f;
#pragma unroll
            for (int e = 0; e < 8; ++e) { a[e] += b[e]; ss += a[e] * a[e]; }
            ss += __shfl_xor(ss, 1); ss += __shfl_xor(ss, 2); ss += __shfl_xor(ss, 4); ss += __shfl_xor(ss, 8);
            const float rn = rsqrtf(ss * (1.f / 128.f) + EPS);
#pragma unroll
            for (int e = 0; e < 8; ++e) a[e] = a[e] * rn * (mx ? gg[e] : gh[e]) * siluf_(z[e]);
            *(uint4*)(PB + (size_t)t * PW + C_Z + (2 + mx) * 512 + lane * 8) = pack8(a);
        }
    }
}

__device__ void phase_merge(const Params& P, int ph, int l, unsigned char* smem) {
    const int tid_ = tid_opaque(), lane = tid_ & 63, wave = tid_ >> 6, wr = wave >> 1, wc = wave & 1;
    const bf16_t* H = (const bf16_t*)(P.ws + OFF_H);
    const bf16_t* PB = (const bf16_t*)(P.ws + OFF_PB);
    bf16_t* ACC = (bf16_t*)(P.ws + OFF_KV);
    for (;;) {
        const int u = next_item(P, ph);
        if (u >= 132 * 16) break;
        const int mt = u >> 4, nt = u & 15;
        const int col = nt * 64 + wc * 32 + (lane & 31);
        f32x16 tot[2];
#pragma unroll
        for (int r = 0; r < 16; ++r) { tot[0][r] = 0.f; tot[1][r] = 0.f; }
        for (int br = 0; br < 4; ++br) {
            unsigned gate[2][8];
            {
                f32x16 g[2];
#pragma unroll
                for (int r = 0; r < 16; ++r) { g[0][r] = 0.f; g[1][r] = 0.f; }
                gemm_tile_n64(g, H + (size_t)mt * 128 * D, D, (const bf16_t*)(P.ws + OFF_WM) + ((size_t)(l * 4 + br) * 1024 + nt * 64) * 1024, 1024, 1024, smem);
                const float bm = P.b_merge[(l * 4 + br) * 1024 + col];
#pragma unroll
                for (int mi = 0; mi < 2; ++mi)
#pragma unroll
                    for (int r = 0; r < 8; ++r) gate[mi][r] = cvt_pk_asm(sigmoidf_(g[mi][2 * r] + bm), sigmoidf_(g[mi][2 * r + 1] + bm));
            }
            f32x16 pa[2];
#pragma unroll
            for (int r = 0; r < 16; ++r) { pa[0][r] = 0.f; pa[1][r] = 0.f; }
            gemm_tile_n64(pa, PB + (size_t)mt * 128 * PW + C_Z + br * 512, PW, (const bf16_t*)(P.ws + OFF_WBR) + ((size_t)(l * 4 + br) * 1024 + nt * 64) * 512, 512, 512, smem);
#pragma unroll
            for (int mi = 0; mi < 2; ++mi)
#pragma unroll
                for (int r = 0; r < 8; ++r) {
                    tot[mi][2 * r] = fmaf(lo16(gate[mi][r]), pa[mi][2 * r], tot[mi][2 * r]);
                    tot[mi][2 * r + 1] = fmaf(hi16(gate[mi][r]), pa[mi][2 * r + 1], tot[mi][2 * r + 1]);
                }
        }
#pragma unroll
        for (int mi = 0; mi < 2; ++mi)
#pragma unroll
            for (int r = 0; r < 16; ++r) ACC[(size_t)(mt * 128 + ACC_ROW(mi, r)) * 1024 + col] = f2bf(tot[mi][r]);
    }
}

__device__ void phase_out(const Params& P, int ph, int l, int hf, unsigned char* smem) {
    const int tid_ = tid_opaque(), lane = tid_ & 63, wave = tid_ >> 6, wr = wave >> 1, wc = wave & 1;
    const bf16_t* ACC = (const bf16_t*)(P.ws + OFF_KV);
    const float* mod = (const float*)(P.ws + OFF_MOD);
    for (;;) {
        const int u = next_item(P, ph);
        if (u >= 132 * 8) break;
        const int mt = u >> 3, nt = u & 7;
        const int t0 = mt * 128, bl = t0 / TB, p0 = t0 % TB, b = hf * 2 + bl;
        const bool isctx = p0 < CTXL;
        if (isctx && l == 1) continue;
        f32x16 acc[2][2]; zero_acc(acc);
        gemm_tile_pf2(acc, ACC + (size_t)mt * 128 * 1024, 1024, (const bf16_t*)(P.ws + OFF_WO) + ((size_t)l * 1024 + nt * 128) * 1024, 1024, 1024, smem);
        const float* gt = mod + (l * 5 + (isctx ? 4 : b)) * 3072 + 2048 + nt * 128;
        const float* src; float* dst;
        if (isctx) { src = P.ctx + ((size_t)b * CTXL + p0) * D; dst = (float*)(P.ws + OFF_CX1) + ((size_t)b * CTXL + p0) * D; }
        else { const size_t o = ((size_t)b * SEQ + (p0 - CTXL)) * D; src = (l == 0 ? P.x : (const float*)P.out) + o; dst = P.out + o; }
#pragma unroll
        for (int mi = 0; mi < 2; ++mi)
#pragma unroll
            for (int ni = 0; ni < 2; ++ni) {
                const int cl = ACC_COL(ni);
                const float g = gt[cl];
#pragma unroll
                for (int r = 0; r < 16; ++r) { const size_t o = (size_t)ACC_ROW(mi, r) * D + nt * 128 + cl; dst[o] = src[o] + g * acc[mi][ni][r]; }
            }
    }
}

__global__ void __launch_bounds__(256, 2) mega(Params PK) {
    extern __shared__ __attribute__((aligned(16))) unsigned char smem[];
    if (blockIdx.x == 0 && threadIdx.x == 0) {
        Params* T = (Params*)(PK.ws + OFF_TAB);
        T->x = PK.x; T->c = PK.c; T->ctx = PK.ctx; T->c_ctx = PK.c_ctx; T->ada_w = PK.ada_w; T->ada_b = PK.ada_b; T->norm_g = PK.norm_g; T->w_in = PK.w_in;
        T->w_uq = PK.w_uq; T->w_ukv = PK.w_ukv; T->g_cq = PK.g_cq; T->g_ckv = PK.g_ckv; T->g_q = PK.g_q; T->g_k = PK.g_k; T->rpb = PK.rpb; T->ng_q = PK.ng_q; T->ng_k = PK.ng_k;
        T->lb_logits = PK.lb_logits; T->hg_g_o = PK.hg_g_o; T->gla_w2 = PK.gla_w2; T->gla_b2 = PK.gla_b2; T->gla_g_o = PK.gla_g_o; T->w_br = PK.w_br; T->w_merge = PK.w_merge;
        T->b_merge = PK.b_merge; T->w_out = PK.w_out; T->out = PK.out; T->ws = PK.ws; T->ph_lo = PK.ph_lo; T->ph_hi = PK.ph_hi;
    }
    unsigned char* wsb = PK.ws;
    const int ph_lo = PK.ph_lo, ph_hi = PK.ph_hi;
#ifdef PROBE_SUB
    __shared__ long long s_tacc, s_tprev; if (threadIdx.x == 0) { s_tacc = 0; s_tprev = 0; }
#endif
    for (int ph = ph_lo; ph < ph_hi; ++ph) {
#ifndef SPLIT_MIX
        if (ph > 8 && ((ph - 1) & 7) == 0) continue;
#endif
        if (ph > ph_lo) cg::this_grid().sync();
        const Params& P = PK;
#ifdef PROBE_SUB
        if (threadIdx.x == 0) { const long long t_now = wall_clock64();
#ifdef SPLIT_MIX
            const int prev_sub = (ph == 0) ? -1 : (ph == 1 ? 9 : ((ph - 2) % 9));
#else
            const int prev_sub = (ph == 0) ? -1 : (ph == 1 ? 8 : ((ph - 2) & 7));
#endif
            if (prev_sub == PROBE_SUB) s_tacc += t_now - s_tprev; s_tprev = t_now; }
#endif
#ifdef ONLYP
#define PH_ON(n) ((ONLYP >> (n)) & 1)
#else
#define PH_ON(n) true
#endif
        if (ph == 0) { if (PH_ON(8)) phase_prologue(PK, ph, smem); continue; }
#ifdef SPLIT_MIX
        const int q = ph - 1, pass = q / 9, sub9 = q % 9, l = pass >> 1, hf = pass & 1;
        if (sub9 == 4 || sub9 == 5) { phase_mixers(P, ph, l, smem, sub9 - 3); continue; }
        const int sub = sub9 < 4 ? sub9 : sub9 - 1;
        switch (sub) {
            case 0: phase_norm(P, ph, l, hf); break;
            case 1: phase_gemm1(P, ph, l, smem); break;
            case 2: phase_gemm2(P, ph, l, smem); break;
            case 3: phase_finalize(P, ph, l, smem); break;
            case 5: phase_scanfin(P, ph, l); break;
            case 6: phase_merge(P, ph, l, smem); break;
            default: phase_out(P, ph, l, hf, smem); break;
        }
#else
        const int q = ph - 1, pass = q >> 3, sub = q & 7, l = pass >> 1, hf = pass & 1;
        switch (sub) {
            case 0: if (PH_ON(0)) phase_norm(P, ph, l, hf); break;
            case 1: if (PH_ON(1)) phase_gemm1(P, ph, l, smem); break;
            case 2: if (PH_ON(2)) phase_gemm2(P, ph, l, smem); break;
            case 3: if (PH_ON(3)) phase_finalize(P, ph, l, smem); break;
            case 4: if (PH_ON(4)) phase_mixers(P, ph, l, smem); break;
            case 5: if (PH_ON(5)) phase_scanfin(P, ph, l); break;
            case 6: if (PH_ON(6)) phase_merge(P, ph, l, smem); break;
            default: if (PH_ON(7)) { phase_out(P, ph, l, hf, smem); if (pass < 3) phase_norm(P, ph + 40, (pass + 1) >> 1, (pass + 1) & 1); } break;
        }
#endif
    }
#ifdef PROBE_SUB
    cg::this_grid().sync();
    if (threadIdx.x == 0) { const long long t_now = wall_clock64(); if (7 == PROBE_SUB) s_tacc += t_now - s_tprev;
      if (blockIdx.x == 0) { const long long t_acc = s_tacc; const long long t0 = wall_clock64(); while (wall_clock64() - t0 < t_acc) { __builtin_amdgcn_s_sleep(10); } } }
#endif
}

extern "C" void kernel_launch(void* const* d_in, const int* in_sizes, int n_in, void* d_out, int out_size, void* d_ws, size_t ws_size, hipStream_t stream) {
    static int grid = 0;
    if (grid == 0) {
        if (ws_size < WS_END) { fprintf(stderr, "workspace too small: %zu < %zu\n", ws_size, (size_t)WS_END); grid = -1; return; }
        int dev = 0, cus = 0, per_cu = 0;
        hipGetDevice(&dev);
        hipDeviceGetAttribute(&cus, hipDeviceAttributeMultiprocessorCount, dev);
        hipFuncSetAttribute((const void*)mega, hipFuncAttributeMaxDynamicSharedMemorySize, LDS_BYTES);
        hipOccupancyMaxActiveBlocksPerMultiprocessor(&per_cu, (const void*)mega, 256, LDS_BYTES);
        if (per_cu < 1) per_cu = 1;
        if (per_cu > 2) per_cu = 2;
        grid = cus * per_cu;
        (void)hipGetLastError();
    }
    if (grid < 0) return;
    hipMemsetAsync((unsigned char*)d_ws + OFF_CTL, 0, 4096, stream);
    Params p{};
    const float** pp = (const float**)&p;
    for (int i = 0; i < 26; ++i) pp[i] = (const float*)d_in[i];
    p.out = (float*)d_out; p.ws = (unsigned char*)d_ws;
#if SINGLE_LAUNCH
    p.ph_lo = 0; p.ph_hi = NPHASE;
    void* args[] = {&p};
    hipError_t e = hipLaunchCooperativeKernel((const void*)mega, dim3(grid), dim3(256), args, LDS_BYTES, stream);
    if (e != hipSuccess) fprintf(stderr, "cooperative launch failed: %s (grid %d)\n", hipGetErrorString(e), grid);
#else
    for (int ph = 0; ph < NPHASE; ++ph) {
        p.ph_lo = ph; p.ph_hi = ph + 1;
        hipLaunchKernelGGL(mega, dim3(grid), dim3(256), LDS_BYTES, stream, p);
    }
#endif
}
```

```cpp
#include <hip/hip_runtime.h>
#include <hip/hip_cooperative_groups.h>
#include <stdint.h>
#include <stdio.h>
namespace cg = cooperative_groups;

typedef unsigned short bf16_t;
typedef short bf16x8 __attribute__((ext_vector_type(8)));
typedef short bf16x4 __attribute__((ext_vector_type(4)));
typedef float f32x16 __attribute__((ext_vector_type(16)));

#ifndef SINGLE_LAUNCH
#define SINGLE_LAUNCH 1
#endif

constexpr int D = 1024, SEQ = 8192, CTXL = 256, TB = SEQ + CTXL  , NTH = 2 * TB  ;
constexpr int INW = 7104, PW = 7104;
constexpr int C_CQ = 0, C_CKV = 256, C_KR = 384, C_NQ = 416, C_NK = 928, C_NV = 1440, C_HQ = 1952, C_HF = 2464, C_HI = 3488,
              C_GQ = 4000, C_GK = 4256, C_GV = 4512, C_GR = 5024, C_Z = 5056;
constexpr float EPS = 1e-6f;
constexpr float LOG2E = 1.4426950408889634f;
constexpr int LDS_BYTES = 73728;
#ifdef SPLIT_MIX
constexpr int NPHASE = 37;
#else
constexpr int NPHASE = 33;
#endif

constexpr size_t al256(size_t v) { return (v + 255) & ~(size_t)255; }
constexpr size_t OFF_CTL = 0;
constexpr size_t OFF_TAB = 1024;
constexpr size_t OFF_MOD = 4096;
constexpr size_t OFF_CX1 = al256(OFF_MOD + 2 * 5 * 3072 * 4);
constexpr size_t OFF_WIN = al256(OFF_CX1 + (size_t)4 * 256 * 1024 * 4);
constexpr size_t OFF_WM = al256(OFF_WIN + (size_t)2 * 7168 * 1024 * 2);
constexpr size_t OFF_WBR = al256(OFF_WM + (size_t)8 * 1024 * 1024 * 2);
constexpr size_t OFF_WO = al256(OFF_WBR + (size_t)8 * 1024 * 512 * 2);
constexpr size_t OFF_WUQ = al256(OFF_WO + (size_t)2 * 1024 * 1024 * 2);
constexpr size_t OFF_WUKV = al256(OFF_WUQ + (size_t)2 * 768 * 256 * 2);
constexpr size_t OFF_H = al256(OFF_WUKV + (size_t)2 * 1024 * 128 * 2);
constexpr size_t OFF_PB = al256(OFF_H + (size_t)NTH * 1024 * 2);
constexpr size_t OFF_QF = al256(OFF_PB + (size_t)NTH * PW * 2);
constexpr size_t OFF_KV = al256(OFF_QF + (size_t)NTH * 768 * 2);
constexpr size_t OFF_KF = al256(OFF_KV + (size_t)NTH * 1024 * 2);
constexpr size_t OFF_VTM = al256(OFF_KF + (size_t)NTH * 768 * 2);
constexpr size_t OFF_VTN = al256(OFF_VTM + (size_t)2 * 8 * 64 * TB * 2);
constexpr size_t OFF_OSG = al256(OFF_VTN + (size_t)2 * 8 * 64 * TB * 2);
constexpr size_t OFF_XH = al256(OFF_OSG + (size_t)2 * NTH * 512 * 2);
constexpr size_t OFF_XG = al256(OFF_XH + (size_t)NTH * 512 * 2);
constexpr size_t OFF_EBH = al256(OFF_XG + (size_t)NTH * 512 * 2);
constexpr size_t OFF_EBG = al256(OFF_EBH + (size_t)528 * 2 * 512 * 4);
constexpr size_t WS_END = al256(OFF_EBG + (size_t)528 * 2 * 256 * 4);

static_assert(WS_END <= (size_t)512 * 1024 * 1024, "workspace map exceeds 512 MiB");
struct Params {
    const float *x, *c, *ctx, *c_ctx, *ada_w, *ada_b, *norm_g, *w_in, *w_uq, *w_ukv, *g_cq, *g_ckv, *g_q, *g_k, *rpb, *ng_q, *ng_k,
        *lb_logits, *hg_g_o, *gla_w2, *gla_b2, *gla_g_o, *w_br, *w_merge, *b_merge, *w_out;
    float* out;
    unsigned char* ws;
    int ph_lo, ph_hi;
};

__device__ __forceinline__ float bf2f(bf16_t v) { return __uint_as_float(((unsigned)v) << 16); }
typedef float f32x2_t __attribute__((ext_vector_type(2)));
typedef __bf16 bf16x2_t __attribute__((ext_vector_type(2)));
__device__ __forceinline__ unsigned cvt_pk(float lo, float hi) { f32x2_t v = {lo, hi}; bf16x2_t b = __builtin_convertvector(v, bf16x2_t); return __builtin_bit_cast(unsigned, b); }
__device__ __forceinline__ unsigned cvt_pk_asm(float lo, float hi) { unsigned r; asm("s_nop 1\n\tv_cvt_pk_bf16_f32 %0, %1, %2" : "=v"(r) : "v"(lo), "v"(hi)); return r; }
__device__ __forceinline__ bf16_t f2bf(float f) { return (bf16_t)(cvt_pk(f, 0.f) & 0xffffu); }
__device__ __forceinline__ float lo16(unsigned u) { return __uint_as_float(u << 16); }
__device__ __forceinline__ float hi16(unsigned u) { return __uint_as_float(u & 0xffff0000u); }
__device__ __forceinline__ float sigmoidf_(float x) { return 1.f / (1.f + __expf(-x)); }
__device__ __forceinline__ float siluf_(float x) { return x / (1.f + __expf(-x)); }
__device__ __forceinline__ float wave_sum(float v) {
#pragma unroll
    for (int o = 32; o > 0; o >>= 1) v += __shfl_xor(v, o);
    return v;
}
__device__ __forceinline__ void unpack8(uint4 u, float* f) {
    f[0] = lo16(u.x); f[1] = hi16(u.x); f[2] = lo16(u.y); f[3] = hi16(u.y); f[4] = lo16(u.z); f[5] = hi16(u.z); f[6] = lo16(u.w); f[7] = hi16(u.w);
}
__device__ __forceinline__ uint4 pack8(const float* f) { uint4 u; u.x = cvt_pk(f[0], f[1]); u.y = cvt_pk(f[2], f[3]); u.z = cvt_pk(f[4], f[5]); u.w = cvt_pk(f[6], f[7]); return u; }

__device__ __forceinline__ int tid_opaque() { int t = threadIdx.x; asm volatile("" : "+v"(t)); return t; }
__shared__ int s_item;
__device__ __forceinline__ int next_item(const Params& P, int ph) {
    __syncthreads();
    if (threadIdx.x == 0) s_item = atomicAdd((int*)(P.ws + OFF_CTL) + ph, 1);
    __syncthreads();
    return s_item;
}

constexpr int GS = 72;
__device__ __forceinline__ void gemm_tile(f32x16 (&acc)[2][2], const bf16_t* __restrict__ A, int lda, const bf16_t* __restrict__ Bt, int ldb, int K, unsigned char* smem) {
    const int tid = tid_opaque(), lane = tid & 63, wave = tid >> 6, wr = wave >> 1, wc = wave & 1;
    bf16_t* sA = (bf16_t*)smem;
    bf16_t* sB = sA + 2 * 128 * GS;
    const int lrow = tid >> 3, lch = (tid & 7) * 8;
    uint4 ra[4], rb[4];
    const bf16_t* Ap = A + (size_t)lrow * lda + lch;
    const bf16_t* Bp = Bt + (size_t)lrow * ldb + lch;
#pragma unroll
    for (int i = 0; i < 4; ++i) { ra[i] = *(const uint4*)(Ap + (size_t)(32 * i) * lda); rb[i] = *(const uint4*)(Bp + (size_t)(32 * i) * ldb); }
#pragma unroll
    for (int i = 0; i < 4; ++i) { *(uint4*)(sA + (lrow + 32 * i) * GS + lch) = ra[i]; *(uint4*)(sB + (lrow + 32 * i) * GS + lch) = rb[i]; }
    __syncthreads();
    const int nk = K >> 6;
    const int aoff = (wr * 64 + (lane & 31)) * GS + (lane >> 5) * 8, boff = (wc * 64 + (lane & 31)) * GS + (lane >> 5) * 8;
    for (int kt = 0; kt < nk; ++kt) {
        const bool more = kt + 1 < nk;
        if (more) {
#pragma unroll
            for (int i = 0; i < 4; ++i) { ra[i] = *(const uint4*)(Ap + (size_t)(32 * i) * lda + (kt + 1) * 64); rb[i] = *(const uint4*)(Bp + (size_t)(32 * i) * ldb + (kt + 1) * 64); }
        }
        const bf16_t* a = sA + (kt & 1) * 128 * GS + aoff;
        const bf16_t* b = sB + (kt & 1) * 128 * GS + boff;
#pragma unroll
        for (int ks = 0; ks < 4; ++ks) {
            bf16x8 a0 = *(const bf16x8*)(a + ks * 16), a1 = *(const bf16x8*)(a + 32 * GS + ks * 16);
            bf16x8 b0 = *(const bf16x8*)(b + ks * 16), b1 = *(const bf16x8*)(b + 32 * GS + ks * 16);
            acc[0][0] = __builtin_amdgcn_mfma_f32_32x32x16_bf16(a0, b0, acc[0][0], 0, 0, 0);
            acc[0][1] = __builtin_amdgcn_mfma_f32_32x32x16_bf16(a0, b1, acc[0][1], 0, 0, 0);
            acc[1][0] = __builtin_amdgcn_mfma_f32_32x32x16_bf16(a1, b0, acc[1][0], 0, 0, 0);
            acc[1][1] = __builtin_amdgcn_mfma_f32_32x32x16_bf16(a1, b1, acc[1][1], 0, 0, 0);
        }
        if (more) {
            bf16_t* wa = sA + ((kt + 1) & 1) * 128 * GS;
            bf16_t* wb = sB + ((kt + 1) & 1) * 128 * GS;
#pragma unroll
            for (int i = 0; i < 4; ++i) { *(uint4*)(wa + (lrow + 32 * i) * GS + lch) = ra[i]; *(uint4*)(wb + (lrow + 32 * i) * GS + lch) = rb[i]; }
        }
        __syncthreads();
    }
}

__device__ __forceinline__ void gemm_tile_pf2(f32x16 (&acc)[2][2], const bf16_t* __restrict__ A, int lda, const bf16_t* __restrict__ Bt, int ldb, int K, unsigned char* smem) {
    const int tid = tid_opaque(), lane = tid & 63, wave = tid >> 6, wr = wave >> 1, wc = wave & 1;
    bf16_t* sA = (bf16_t*)smem;
    bf16_t* sB = sA + 2 * 128 * GS;
    const int lrow = tid >> 3, lch = (tid & 7) * 8;
    uint4 pa0, pa1, pa2, pa3, pb0, pb1, pb2, pb3, qa0, qa1, qa2, qa3, qb0, qb1, qb2, qb3;
    const bf16_t* Ap = A + (size_t)lrow * lda + lch;
    const bf16_t* Bp = Bt + (size_t)lrow * ldb + lch;
    const int nk = K >> 6;
#define PF2_LD1(RA, RB, kt_, i) { RA##i = *(const uint4*)(Ap + (size_t)(32 * i) * lda + (kt_) * 64); RB##i = *(const uint4*)(Bp + (size_t)(32 * i) * ldb + (kt_) * 64); }
#define PF2_LOAD(RA, RB, kt_) { PF2_LD1(RA, RB, kt_, 0) PF2_LD1(RA, RB, kt_, 1) PF2_LD1(RA, RB, kt_, 2) PF2_LD1(RA, RB, kt_, 3) }
#define PF2_WR1(RA, RB, i) { *(uint4*)(wa + (lrow + 32 * i) * GS + lch) = RA##i; *(uint4*)(wb + (lrow + 32 * i) * GS + lch) = RB##i; }
#define PF2_WRITE(RA, RB, buf_) { bf16_t* wa = sA + (buf_) * 128 * GS; bf16_t* wb = sB + (buf_) * 128 * GS; PF2_WR1(RA, RB, 0) PF2_WR1(RA, RB, 1) PF2_WR1(RA, RB, 2) PF2_WR1(RA, RB, 3) }
#define PF2_COMPUTE(buf_) { const bf16_t* a = sA + (buf_) * 128 * GS + aoff; const bf16_t* b = sB + (buf_) * 128 * GS + boff; _Pragma("unroll") for (int ks = 0; ks < 4; ++ks) { \
        bf16x8 a0 = *(const bf16x8*)(a + ks * 16), a1 = *(const bf16x8*)(a + 32 * GS + ks * 16); bf16x8 b0 = *(const bf16x8*)(b + ks * 16), b1 = *(const bf16x8*)(b + 32 * GS + ks * 16); \
        acc[0][0] = __builtin_amdgcn_mfma_f32_32x32x16_bf16(a0, b0, acc[0][0], 0, 0, 0); acc[0][1] = __builtin_amdgcn_mfma_f32_32x32x16_bf16(a0, b1, acc[0][1], 0, 0, 0); \
        acc[1][0] = __builtin_amdgcn_mfma_f32_32x32x16_bf16(a1, b0, acc[1][0], 0, 0, 0); acc[1][1] = __builtin_amdgcn_mfma_f32_32x32x16_bf16(a1, b1, acc[1][1], 0, 0, 0); } }
    const int aoff = (wr * 64 + (lane & 31)) * GS + (lane >> 5) * 8, boff = (wc * 64 + (lane & 31)) * GS + (lane >> 5) * 8;
    PF2_LOAD(pa, pb, 0);
    PF2_LOAD(qa, qb, 1);
    PF2_WRITE(pa, pb, 0);
    __syncthreads();
    for (int kt = 0; kt < nk; kt += 2) {
        if (kt + 2 < nk) PF2_LOAD(pa, pb, kt + 2);
        PF2_COMPUTE(0);
        PF2_WRITE(qa, qb, 1);
        __syncthreads();
        if (kt + 3 < nk) PF2_LOAD(qa, qb, kt + 3);
        PF2_COMPUTE(1);
        if (kt + 2 < nk) PF2_WRITE(pa, pb, 0);
        __syncthreads();
    }
#undef PF2_LOAD
#undef PF2_LD1
#undef PF2_WR1
#undef PF2_WRITE
#undef PF2_COMPUTE
}

__device__ __forceinline__ void gemm_tile_n64(f32x16 (&acc)[2], const bf16_t* __restrict__ A, int lda, const bf16_t* __restrict__ Bt, int ldb, int K, unsigned char* smem) {
    const int tid = tid_opaque(), lane = tid & 63, wave = tid >> 6, wr = wave >> 1, wc = wave & 1;
    bf16_t* sA = (bf16_t*)smem;
    bf16_t* sB = sA + 2 * 128 * GS;
    const int lrow = tid >> 3, lch = (tid & 7) * 8;
    uint4 pa0, pa1, pa2, pa3, pb0, pb1, qa0, qa1, qa2, qa3, qb0, qb1;
    const bf16_t* Ap = A + (size_t)lrow * lda + lch;
    const bf16_t* Bp = Bt + (size_t)lrow * ldb + lch;
    const int nk = K >> 6;
#define N64_LOAD(RA, RB, kt_) { RA##0 = *(const uint4*)(Ap + (kt_) * 64); RA##1 = *(const uint4*)(Ap + (size_t)32 * lda + (kt_) * 64); RA##2 = *(const uint4*)(Ap + (size_t)64 * lda + (kt_) * 64); RA##3 = *(const uint4*)(Ap + (size_t)96 * lda + (kt_) * 64); \
        RB##0 = *(const uint4*)(Bp + (kt_) * 64); RB##1 = *(const uint4*)(Bp + (size_t)32 * ldb + (kt_) * 64); }
#define N64_WRITE(RA, RB, buf_) { bf16_t* wa = sA + (buf_) * 128 * GS + lrow * GS + lch; bf16_t* wb = sB + (buf_) * 64 * GS + lrow * GS + lch; \
        *(uint4*)wa = RA##0; *(uint4*)(wa + 32 * GS) = RA##1; *(uint4*)(wa + 64 * GS) = RA##2; *(uint4*)(wa + 96 * GS) = RA##3; *(uint4*)wb = RB##0; *(uint4*)(wb + 32 * GS) = RB##1; }
#define N64_COMPUTE(buf_) { const bf16_t* a = sA + (buf_) * 128 * GS + aoff; const bf16_t* b = sB + (buf_) * 64 * GS + boff; _Pragma("unroll") for (int ks = 0; ks < 4; ++ks) { \
        bf16x8 a0 = *(const bf16x8*)(a + ks * 16), a1 = *(const bf16x8*)(a + 32 * GS + ks * 16); bf16x8 b0 = *(const bf16x8*)(b + ks * 16); \
        acc[0] = __builtin_amdgcn_mfma_f32_32x32x16_bf16(a0, b0, acc[0], 0, 0, 0); acc[1] = __builtin_amdgcn_mfma_f32_32x32x16_bf16(a1, b0, acc[1], 0, 0, 0); } }
    const int aoff = (wr * 64 + (lane & 31)) * GS + (lane >> 5) * 8, boff = (wc * 32 + (lane & 31)) * GS + (lane >> 5) * 8;
    N64_LOAD(pa, pb, 0);
    N64_LOAD(qa, qb, 1);
    N64_WRITE(pa, pb, 0);
    __syncthreads();
    for (int kt = 0; kt < nk; kt += 2) {
        if (kt + 2 < nk) N64_LOAD(pa, pb, kt + 2);
        N64_COMPUTE(0);
        N64_WRITE(qa, qb, 1);
        __syncthreads();
        if (kt + 3 < nk) N64_LOAD(qa, qb, kt + 3);
        N64_COMPUTE(1);
        if (kt + 2 < nk) N64_WRITE(pa, pb, 0);
        __syncthreads();
    }
#undef N64_LOAD
#undef N64_WRITE
#undef N64_COMPUTE
}
__device__ __forceinline__ void zero_acc(f32x16 (&acc)[2][2]) {
#pragma unroll
    for (int i = 0; i < 2; ++i)
#pragma unroll
        for (int j = 0; j < 2; ++j)
#pragma unroll
            for (int r = 0; r < 16; ++r) acc[i][j][r] = 0.f;
}
#define ACC_ROW(mi, r) (wr * 64 + (mi) * 32 + ((r) & 3) + 8 * ((r) >> 2) + 4 * (lane >> 5))
#define ACC_COL(ni) (wc * 64 + (ni) * 32 + (lane & 31))

__device__ void tr_tile(const float* __restrict__ src, int K, int N, int kt, int nt, bf16_t* __restrict__ dst, const float* __restrict__ scale, float* s) {
    const int tid = tid_opaque(), r = tid >> 4, c4 = (tid & 15) * 4;
#pragma unroll
    for (int i = 0; i < 4; ++i) {
        const int k = kt * 64 + r + 16 * i;
        float4 v = *(const float4*)(src + (size_t)k * N + nt * 64 + c4);
        const float sc = scale ? scale[k] : 1.f;
        float* d = s + (r + 16 * i) * 65 + c4;
        d[0] = v.x * sc; d[1] = v.y * sc; d[2] = v.z * sc; d[3] = v.w * sc;
    }
    __syncthreads();
    const int n = tid >> 2, k0 = (tid & 3) * 16;
    float f[16];
#pragma unroll
    for (int j = 0; j < 16; ++j) f[j] = s[(k0 + j) * 65 + n];
    bf16_t* o = dst + (size_t)(nt * 64 + n) * K + kt * 64 + k0;
    *(uint4*)o = pack8(f);
    *(uint4*)(o + 8) = pack8(f + 8);
    __syncthreads();
}
__device__ void phase_prologue(const Params& P, int ph, unsigned char* smem) {
    float* s = (float*)smem;
    const int NTR = 7296, NMOD = 96;
    for (;;) {
        const int u = next_item(P, ph);
        if (u >= NTR + NMOD) break;
        if (u < NMOD) {
            const int l = u / 48, cb = u % 48, tid = threadIdx.x, lane = tid & 63, wave = tid >> 6;
            float* sc = s;
            float* red = s + 5 * 1024;
            for (int i = tid; i < 5 * 1024; i += 256) { const int r = i >> 10, k = i & 1023; const float v = (r < 4) ? P.c[r * 1024 + k] : P.c_ctx[k]; sc[i] = siluf_(v); }
            __syncthreads();
            const int col = cb * 64 + lane;
            float acc[5] = {0.f, 0.f, 0.f, 0.f, 0.f};
            const float* w = P.ada_w + (size_t)l * 1024 * 3072 + col;
#pragma unroll 8
            for (int k = wave * 256; k < wave * 256 + 256; ++k) {
                const float wv = w[(size_t)k * 3072];
#pragma unroll
                for (int r = 0; r < 5; ++r) acc[r] += sc[r * 1024 + k] * wv;
            }
#pragma unroll
            for (int r = 0; r < 5; ++r) red[(wave * 5 + r) * 64 + lane] = acc[r];
            __syncthreads();
            if (wave == 0) {
                float* mod = (float*)(P.ws + OFF_MOD);
#pragma unroll
                for (int r = 0; r < 5; ++r) mod[(l * 5 + r) * 3072 + col] = red[r * 64 + lane] + red[(5 + r) * 64 + lane] + red[(10 + r) * 64 + lane] + red[(15 + r) * 64 + lane] + P.ada_b[l * 3072 + col];
            }
            continue;
        }
        const int v = u - NMOD, l = v / 3648, r = v % 3648;
        if (r < 1776) tr_tile(P.w_in + (size_t)l * 1024 * INW, 1024, INW, r / 111, r % 111, (bf16_t*)(P.ws + OFF_WIN) + (size_t)l * 7168 * 1024, nullptr, s);
        else if (r < 2800) { const int r2 = r - 1776, br = r2 >> 8, t = r2 & 255; tr_tile(P.w_merge + (size_t)(l * 4 + br) * 1024 * 1024, 1024, 1024, t >> 4, t & 15, (bf16_t*)(P.ws + OFF_WM) + (size_t)(l * 4 + br) * 1024 * 1024, nullptr, s); }
        else if (r < 3312) { const int r2 = r - 2800, br = r2 >> 7, t = r2 & 127; tr_tile(P.w_br + (size_t)(l * 4 + br) * 512 * 1024, 512, 1024, t >> 4, t & 15, (bf16_t*)(P.ws + OFF_WBR) + (size_t)(l * 4 + br) * 1024 * 512, nullptr, s); }
        else if (r < 3568) { const int t = r - 3312; tr_tile(P.w_out + (size_t)l * 1024 * 1024, 1024, 1024, t >> 4, t & 15, (bf16_t*)(P.ws + OFF_WO) + (size_t)l * 1024 * 1024, nullptr, s); }
        else if (r < 3616) { const int t = r - 3568; tr_tile(P.w_uq + (size_t)l * 256 * 768, 256, 768, t / 12, t % 12, (bf16_t*)(P.ws + OFF_WUQ) + (size_t)l * 768 * 256, P.g_cq + l * 256, s); }
        else { const int t = r - 3616; tr_tile(P.w_ukv + (size_t)l * 128 * 1024, 128, 1024, t >> 4, t & 15, (bf16_t*)(P.ws + OFF_WUKV) + (size_t)l * 1024 * 128, P.g_ckv + l * 128, s); }
    }
}

__device__ void phase_norm(const Params& P, int ph, int l, int hf) {
    const int tid = tid_opaque(), lane = tid & 63, wave = tid >> 6;
    const float* mod = (const float*)(P.ws + OFF_MOD);
    bf16_t* H = (bf16_t*)(P.ws + OFF_H);
    for (;;) {
        const int u = next_item(P, ph);
        if (u >= NTH / 8) break;
        float4 v[2][4]; int mrr[2];
#pragma unroll
        for (int rr = 0; rr < 2; ++rr) {
            const int t = u * 8 + wave * 2 + rr, bl = t / TB, p = t % TB, b = hf * 2 + bl;
            const float* src;
            if (p < CTXL) { src = (l == 0 ? P.ctx : (const float*)(P.ws + OFF_CX1)) + ((size_t)b * CTXL + p) * D; mrr[rr] = 4; }
            else { src = (l == 0 ? P.x : (const float*)P.out) + ((size_t)b * SEQ + (p - CTXL)) * D; mrr[rr] = b; }
#pragma unroll
            for (int i = 0; i < 4; ++i) v[rr][i] = *(const float4*)(src + lane * 4 + 256 * i);
        }
#pragma unroll
        for (int rr = 0; rr < 2; ++rr) {
            const int t = u * 8 + wave * 2 + rr;
            float ss = 0.f;
#pragma unroll
            for (int i = 0; i < 4; ++i) ss += v[rr][i].x * v[rr][i].x + v[rr][i].y * v[rr][i].y + v[rr][i].z * v[rr][i].z + v[rr][i].w * v[rr][i].w;
            ss = wave_sum(ss);
            const float rstd = rsqrtf(ss * (1.f / D) + EPS);
            const float* sh = mod + (l * 5 + mrr[rr]) * 3072; const float* sc = sh + 1024; const float* g = P.norm_g + l * D;
#pragma unroll
            for (int i = 0; i < 4; ++i) {
                const int c = lane * 4 + 256 * i;
                const float4 gv = *(const float4*)(g + c), s1 = *(const float4*)(sc + c), s0 = *(const float4*)(sh + c);
                uint2 o;
                o.x = cvt_pk(v[rr][i].x * rstd * gv.x * (1.f + s1.x) + s0.x, v[rr][i].y * rstd * gv.y * (1.f + s1.y) + s0.y);
                o.y = cvt_pk(v[rr][i].z * rstd * gv.z * (1.f + s1.z) + s0.z, v[rr][i].w * rstd * gv.w * (1.f + s1.w) + s0.w);
                *(uint2*)(H + (size_t)t * D + c) = o;
            }
        }
    }
}

__device__ void phase_gemm1(const Params& P, int ph, int l, unsigned char* smem) {
    const int tid_ = tid_opaque(), lane = tid_ & 63, wave = tid_ >> 6, wr = wave >> 1, wc = wave & 1;
    const bf16_t* H = (const bf16_t*)(P.ws + OFF_H);
    const bf16_t* W = (const bf16_t*)(P.ws + OFF_WIN) + (size_t)l * 7168 * 1024;
    bf16_t* PB = (bf16_t*)(P.ws + OFF_PB);
    for (;;) {
        const int u = next_item(P, ph);
        if (u >= 132 * 56) break;
        const int mt = u / 56, nt = u % 56;
        f32x16 acc[2][2]; zero_acc(acc);
        gemm_tile_pf2(acc, H + (size_t)mt * 128 * D, D, W + (size_t)nt * 128 * D, D, D, smem);
#pragma unroll
        for (int mi = 0; mi < 2; ++mi)
#pragma unroll
            for (int ni = 0; ni < 2; ++ni) {
                const int col = nt * 128 + ACC_COL(ni);
                if (col < PW) {
#pragma unroll
                    for (int r = 0; r < 16; ++r) PB[(size_t)(mt * 128 + ACC_ROW(mi, r)) * PW + col] = f2bf(acc[mi][ni][r]);
                }
            }
    }
}

__device__ void phase_gemm2(const Params& P, int ph, int l, unsigned char* smem) {
    const int tid_ = tid_opaque(), lane = tid_ & 63, wave = tid_ >> 6, wr = wave >> 1, wc = wave & 1;
    const bf16_t* PB = (const bf16_t*)(P.ws + OFF_PB);
    for (;;) {
        const int u = next_item(P, ph);
        if (u >= 132 * 14) break;
        const int mt = u / 14, n14 = u % 14;
        f32x16 acc[2][2]; zero_acc(acc);
        bf16_t* O; int ldo, nt;
        if (n14 < 6) { nt = n14; O = (bf16_t*)(P.ws + OFF_QF); ldo = 768;
            gemm_tile_pf2(acc, PB + (size_t)mt * 128 * PW + C_CQ, PW, (const bf16_t*)(P.ws + OFF_WUQ) + (size_t)l * 768 * 256 + (size_t)nt * 128 * 256, 256, 256, smem); }
        else { nt = n14 - 6; O = (bf16_t*)(P.ws + OFF_KV); ldo = 1024;
            gemm_tile_pf2(acc, PB + (size_t)mt * 128 * PW + C_CKV, PW, (const bf16_t*)(P.ws + OFF_WUKV) + (size_t)l * 1024 * 128 + (size_t)nt * 128 * 128, 128, 128, smem); }
#pragma unroll
        for (int mi = 0; mi < 2; ++mi)
#pragma unroll
            for (int ni = 0; ni < 2; ++ni)
#pragma unroll
                for (int r = 0; r < 16; ++r) O[(size_t)(mt * 128 + ACC_ROW(mi, r)) * ldo + nt * 128 + ACC_COL(ni)] = f2bf(acc[mi][ni][r]);
    }
}

__device__ void phase_finalize(const Params& P, int ph, int l, unsigned char* smem) {
    const int tid = tid_opaque(), lane = tid & 63, wave = tid >> 6;
    bf16_t* PB = (bf16_t*)(P.ws + OFF_PB);
    bf16_t* QF = (bf16_t*)(P.ws + OFF_QF);
    const bf16_t* KV = (const bf16_t*)(P.ws + OFF_KV);
    bf16_t* KF = (bf16_t*)(P.ws + OFF_KF);
    bf16_t* VTM = (bf16_t*)(P.ws + OFF_VTM);
    bf16_t* VTN = (bf16_t*)(P.ws + OFF_VTN);
    float* rs = (float*)smem;
    const int hd = lane >> 3, j = lane & 7;
    const float invf = __powf(10000.f, -(float)j * 0.125f);
    for (;;) {
        const int u7 = next_item(P, ph);
        if (u7 >= (NTH / 32) * 11) break;
        const int u = u7 / 11, sub = u7 % 11;
        const int t0 = u * 32, bl = t0 / TB, p0 = t0 % TB;
        if (sub >= 1 && sub <= 4) {
        uint2 in_cq[2]; unsigned in_ckv[2]; bf16_t in_q[2][12], in_kv[2][8], in_kr[2][4]; uint4 in_nq[2], in_nk[2];
#pragma unroll
        for (int rr = 0; rr < 2; ++rr) {
            const int tl = (sub - 1) * 8 + wave * 2 + rr, t = t0 + tl;
            const bf16_t* prow = PB + (size_t)t * PW;
            in_cq[rr] = *(const uint2*)(prow + C_CQ + lane * 4);
            in_ckv[rr] = *(const unsigned*)(prow + C_CKV + lane * 2);
            const bf16_t* q = QF + (size_t)t * 768 + hd * 96;
            const bf16_t* kvr = KV + (size_t)t * 1024 + hd * 128;
#pragma unroll
            for (int m = 0; m < 12; ++m) in_q[rr][m] = q[j + 8 * m];
#pragma unroll
            for (int m = 0; m < 8; ++m) in_kv[rr][m] = kvr[j + 8 * m];
#pragma unroll
            for (int m = 0; m < 4; ++m) in_kr[rr][m] = prow[C_KR + j + 8 * m];
            in_nq[rr] = *(const uint4*)(prow + C_NQ + hd * 64 + j * 8);
            in_nk[rr] = *(const uint4*)(prow + C_NK + hd * 64 + j * 8);
        }
#pragma unroll
        for (int rr = 0; rr < 2; ++rr) {
            const int tl = (sub - 1) * 8 + wave * 2 + rr, t = t0 + tl, p = p0 + tl;
            bf16_t* prow = PB + (size_t)t * PW;
            float s1, s2;
            { const uint2 a = in_cq[rr]; const float f0 = lo16(a.x), f1 = hi16(a.x), f2 = lo16(a.y), f3 = hi16(a.y); s1 = f0 * f0 + f1 * f1 + f2 * f2 + f3 * f3;
              const unsigned b = in_ckv[rr]; const float g0 = lo16(b), g1 = hi16(b); s2 = g0 * g0 + g1 * g1; }
            s1 = wave_sum(s1); s2 = wave_sum(s2);
            const float rcq = rsqrtf(s1 * (1.f / 256.f) + EPS), rckv = rsqrtf(s2 * (1.f / 128.f) + EPS);
            {
                bf16_t* q = QF + (size_t)t * 768 + hd * 96;
                float v[12], ss = 0.f;
#pragma unroll
                for (int m = 0; m < 12; ++m) { v[m] = bf2f(in_q[rr][m]) * rcq; ss += v[m] * v[m]; }
                ss += __shfl_xor(ss, 1); ss += __shfl_xor(ss, 2); ss += __shfl_xor(ss, 4);
                const float rn = rsqrtf(ss * (1.f / 96.f) + EPS);
#pragma unroll
                for (int m = 0; m < 12; ++m) q[j + 8 * m] = f2bf(v[m] * rn * P.g_q[l * 96 + j + 8 * m] * (0.10206207261596575f * LOG2E));
            }
            {
                float v[12], ss = 0.f;
#pragma unroll
                for (int m = 0; m < 8; ++m) { v[m] = bf2f(in_kv[rr][m]) * rckv; ss += v[m] * v[m]; }
#pragma unroll
                for (int m = 8; m < 12; ++m) { v[m] = bf2f(in_kr[rr][m - 8]); ss += v[m] * v[m]; }
                ss += __shfl_xor(ss, 1); ss += __shfl_xor(ss, 2); ss += __shfl_xor(ss, 4);
                const float rn = rsqrtf(ss * (1.f / 96.f) + EPS);
#pragma unroll
                for (int m = 0; m < 12; ++m) v[m] = v[m] * rn * P.g_k[l * 96 + j + 8 * m];
                if (p >= CTXL) {
                    const int pos = p - CTXL;
                    const float ar = (float)(pos >> 6) * invf, ac = (float)(pos & 63) * invf;
                    double fr = (double)ar * 0.15915494309189535; fr -= rint(fr);
                    double fc = (double)ac * 0.15915494309189535; fc -= rint(fc);
                    const float sr = __builtin_amdgcn_sinf((float)fr), cr = __builtin_amdgcn_cosf((float)fr);
                    const float sc = __builtin_amdgcn_sinf((float)fc), cc = __builtin_amdgcn_cosf((float)fc);
                    const float x1a = v[8], x2a = v[10], x1b = v[9], x2b = v[11];
                    v[8] = x1a * cr - x2a * sr; v[10] = x1a * sr + x2a * cr;
                    v[9] = x1b * cc - x2b * sc; v[11] = x1b * sc + x2b * cc;
                }
                bf16_t* ko = KF + ((size_t)t * 8 + hd) * 96;
#pragma unroll
                for (int m = 0; m < 12; ++m) ko[j + 8 * m] = f2bf(v[m]);
            }
#pragma unroll
            for (int w = 0; w < 2; ++w) {
                bf16_t* q = prow + (w ? C_NK : C_NQ) + hd * 64 + j * 8;
                const float* g = (w ? P.ng_k : P.ng_q) + l * 64 + j * 8;
                float v[8], ss = 0.f;
                unpack8(w ? in_nk[rr] : in_nq[rr], v);
#pragma unroll
                for (int m = 0; m < 8; ++m) ss += v[m] * v[m];
                ss += __shfl_xor(ss, 1); ss += __shfl_xor(ss, 2); ss += __shfl_xor(ss, 4);
                const float rn = rsqrtf(ss * (1.f / 64.f) + EPS);
#pragma unroll
                for (int m = 0; m < 8; ++m) v[m] = v[m] * rn * g[m] * (w ? 1.f : 0.125f * LOG2E);
                *(uint4*)q = pack8(v);
            }
        }
        } else if (sub == 0) {
        {
            for (int rr = 0; rr < 8; ++rr) {
                const int tl = wave * 8 + rr;
                const unsigned bq = *(const unsigned*)(PB + (size_t)(t0 + tl) * PW + C_CKV + lane * 2);
                const float g0 = lo16(bq), g1 = hi16(bq);
                const float s2 = wave_sum(g0 * g0 + g1 * g1);
                if (lane == 0) rs[tl] = rsqrtf(s2 * (1.f / 128.f) + EPS);
            }
            __syncthreads();
            bf16_t* tile = (bf16_t*)(smem + 8192);
#pragma unroll
            for (int which = 0; which < 2; ++which) {
#pragma unroll
                for (int k8 = 0; k8 < 8; ++k8) {
                    const int id = tid + 256 * k8, i = id >> 6, c8 = id & 63;
                    const bf16_t* src = which ? PB + (size_t)(t0 + i) * PW + C_NV + c8 * 8
                                              : KV + (size_t)(t0 + i) * 1024 + (c8 >> 3) * 128 + 64 + (c8 & 7) * 8;
                    *(uint4*)(tile + i * 512 + c8 * 8) = *(const uint4*)src;
                }
                __syncthreads();
                bf16_t* VT = which ? VTN : VTM;
#pragma unroll
                for (int k8 = 0; k8 < 8; ++k8) {
                    const int id = tid + 256 * k8, r = id >> 2, g = id & 3;
                    float fv[8];
#pragma unroll
                    for (int i = 0; i < 8; ++i) fv[i] = bf2f(tile[(g * 8 + i) * 512 + r]) * (which ? 1.f : rs[g * 8 + i]);
                    *(uint4*)(VT + ((size_t)(bl * 8 + (r >> 6)) * 64 + (r & 63)) * TB + p0 + g * 8) = pack8(fv);
                }
                __syncthreads();
            }
        }
        } else
        {
            const int chunk = t0 >> 5;
            bf16_t* XH = (bf16_t*)(P.ws + OFF_XH);
            bf16_t* XG = (bf16_t*)(P.ws + OFF_XG);
            float* EBH = (float*)(P.ws + OFF_EBH);
            float* EBG = (float*)(P.ws + OFF_EBG);
            bf16_t* base = PB + (size_t)t0 * PW;
            float* rsh = (float*)smem + 256;
            bf16_t* inA = (bf16_t*)(smem + 8192);
            bf16_t* inB = inA + 32 * 128;
            bf16_t* inC = inB + 32 * 128;
            bf16_t* outT = inC + 32 * 128;
#pragma unroll
            for (int k4 = 0; k4 < 4; ++k4) { const int id = tid + 256 * k4, i = id >> 5, jx = id & 31; rsh[id] = bf2f(base[(size_t)i * PW + C_GR + jx]); }
            const int d = tid & 127, dr = tid >> 7;
            { const int grp = sub - 5;
                const bool isg = grp >= 4;
                const int gcol = isg ? (grp - 4) * 128 : grp * 128;
                const int cA = isg ? C_GQ + gcol : C_HQ + gcol, cB = isg ? C_GK + gcol : C_HF + gcol, cC = C_HF + 512 + gcol;
#pragma unroll
                for (int k2 = 0; k2 < 2; ++k2) {
                    const int id = tid + 256 * k2, i = id >> 4, ch = id & 15;
                    const bf16_t* row = base + (size_t)i * PW;
                    *(uint4*)(inA + i * 128 + ch * 8) = *(const uint4*)(row + cA + ch * 8);
                    *(uint4*)(inB + i * 128 + ch * 8) = *(const uint4*)(row + cB + ch * 8);
                    if (!isg) *(uint4*)(inC + i * 128 + ch * 8) = *(const uint4*)(row + cC + ch * 8);
                }
                __syncthreads();
                {
                    const int col = gcol + d;
                    float lb = 0.f, b2 = 0.f, w2[16];
#pragma unroll
                    for (int jx = 0; jx < 16; ++jx) w2[jx] = 0.f;
                    if (isg) {
#pragma unroll
                        for (int jx = 0; jx < 16; ++jx) w2[jx] = P.gla_w2[((size_t)(l * 2 + dr) * 16 + jx) * 256 + col];
                        b2 = P.gla_b2[(l * 2 + dr) * 256 + col];
                    } else if (l != 0) lb = sigmoidf_(P.lb_logits[1024 + dr * 512 + col] - P.lb_logits[dr * 512 + col]);
                    const bf16_t* fsrc = (dr && !isg) ? inC : inB;
                    bf16_t* oq = outT + (dr ? 2 : 0) * 32 * 128;
                    bf16_t* ok = oq + 32 * 128;
                    float cum = 0.f;
#pragma unroll 4
                    for (int sx = 0; sx < 32; ++sx) {
                        const int i = dr ? 31 - sx : sx;
                        const float qv = bf2f(inA[i * 128 + d]), fv = bf2f(fsrc[i * 128 + d]);
                        float qq, kk, la;
                        if (isg) {
                            float g = b2;
#pragma unroll
                            for (int jx = 0; jx < 16; ++jx) g = fmaf(rsh[i * 32 + dr * 16 + jx], w2[jx], g);
                            la = (fminf(g, 0.f) - __logf(1.f + __expf(-fabsf(g)))) * 0.0625f;
                            qq = qv * 0.125f; kk = fv;
                        } else {
                            const float av = lb + (1.f - lb) * sigmoidf_(fv);
                            la = __logf(av); kk = 1.f - av;
                            qq = siluf_(qv) * 0.08838834764831845f;
                        }
                        cum += la;
                        oq[i * 128 + d] = f2bf(qq * __expf(cum));
                        ok[i * 128 + d] = f2bf(kk * __expf(-cum));
                    }
                    if (isg) EBG[(size_t)(chunk * 2 + dr) * 256 + col] = __expf(cum);
                    else EBH[(size_t)(chunk * 2 + dr) * 512 + col] = __expf(cum);
                }
                __syncthreads();
#pragma unroll
                for (int k2 = 0; k2 < 2; ++k2) {
                    const int id = tid + 256 * k2, i = id >> 4, ch = id & 15;
                    bf16_t* row = base + (size_t)i * PW;
                    const uint4 v0 = *(const uint4*)(outT + (0 * 32 + i) * 128 + ch * 8), v1 = *(const uint4*)(outT + (1 * 32 + i) * 128 + ch * 8);
                    const uint4 v2 = *(const uint4*)(outT + (2 * 32 + i) * 128 + ch * 8), v3 = *(const uint4*)(outT + (3 * 32 + i) * 128 + ch * 8);
                    *(uint4*)(row + cA + ch * 8) = v0;
                    *(uint4*)(row + cB + ch * 8) = v1;
                    if (isg) { bf16_t* xr = XG + (size_t)(t0 + i) * 512 + gcol + ch * 8; *(uint4*)xr = v2; *(uint4*)(xr + 256) = v3; }
                    else { *(uint4*)(XH + (size_t)(t0 + i) * 512 + gcol + ch * 8) = v2; *(uint4*)(row + cC + ch * 8) = v3; }
                }
                __syncthreads();
            }
        }
    }
}

template <int DQK, bool NAT>
__device__ void attn_item(const Params& P, int l, int bl, int head, int qb, unsigned char* smem) {
    constexpr int NKS = DQK / 16, KSTR = DQK + 8, VSTR = 68, KCH = DQK / 8, KLD = (DQK * 64 / 8) / 256;
    const int tid = tid_opaque(), lane = tid & 63, wave = tid >> 6, hh = lane >> 5, r32 = lane & 31;
    bf16_t* Ks = (bf16_t*)smem;
    bf16_t* Vs = Ks + 2 * 64 * KSTR;
    float* rpb_s = (float*)(Vs + 2 * 64 * VSTR);
    bf16_t* PB = (bf16_t*)(P.ws + OFF_PB);
    const int rowbase = bl * TB, q_p0 = qb * 128, ql = wave * 32 + r32;
    const bool q_ctx = qb < 2;
    int lt0 = 0, lt1 = 0;
    int qr = 0, qc = 0, r0w = 0, c0 = 0;
    if (!q_ctx) {
        if (NAT) { const int rp = qb - 2, ra = 2 * rp, rb = ra + 1; lt0 = min(max(ra - 4, 0), 120); lt1 = min(max(rb - 4, 0), 120) + 8;
            qr = ra + (wave >> 1); qc = (wave & 1) * 32 + r32; r0w = min(max(qr - 4, 0), 120); c0 = min(max(qc - 8, 0), 48); }
        else { lt0 = 0; lt1 = 128; }
    }
    const int ntiles = 4 + (lt1 - lt0);
    const bf16_t* Kbase; const bf16_t* VT; const bf16_t* qptr; int k_ld;
    if (NAT) { Kbase = PB + (size_t)rowbase * PW + C_NK + head * 64; k_ld = PW; VT = (const bf16_t*)(P.ws + OFF_VTN) + (size_t)(bl * 8 + head) * 64 * TB;
        qptr = PB + (size_t)(rowbase + q_p0 + ql) * PW + C_NQ + head * 64; }
    else { Kbase = (const bf16_t*)(P.ws + OFF_KF) + (size_t)rowbase * 768 + head * 96; k_ld = 768; VT = (const bf16_t*)(P.ws + OFF_VTM) + (size_t)(bl * 8 + head) * 64 * TB;
        qptr = (const bf16_t*)(P.ws + OFF_QF) + (size_t)(rowbase + q_p0 + ql) * 768 + head * 96; }
    if (NAT) { for (int i = tid; i < 465; i += 256) rpb_s[i] = P.rpb[(size_t)(l * 8 + head) * 465 + i] * LOG2E; }
    bf16x8 qf[NKS];
#pragma unroll
    for (int ks = 0; ks < NKS; ++ks) qf[ks] = *(const bf16x8*)(qptr + ks * 16 + hh * 8);
    bf16x8 qrot4 = qf[NKS - 2], qrot5 = qf[NKS - 1];
    if (!NAT && !q_ctx) {
        const int pos = q_p0 - CTXL + ql;
        const float base = hh ? (float)(pos & 63) : (float)(pos >> 6);
#pragma unroll
        for (int jj = 0; jj < 8; ++jj) {
            const float invf = __powf(10000.f, -(float)jj * 0.125f);
            const float ang = base * invf;
            double fr = (double)ang * 0.15915494309189535; fr -= rint(fr);
            const float sn = __builtin_amdgcn_sinf((float)fr), cs = __builtin_amdgcn_cosf((float)fr);
            const float x1 = bf2f((bf16_t)qf[4][jj]), x2 = bf2f((bf16_t)qf[5][jj]);
            qrot4[jj] = (short)f2bf(x1 * cs - x2 * sn);
            qrot5[jj] = (short)f2bf(x1 * sn + x2 * cs);
        }
    }
    float m_run = -1e30f, lsum = 0.f;
    f32x16 oacc[2];
#pragma unroll
    for (int r = 0; r < 16; ++r) { oacc[0][r] = 0.f; oacc[1][r] = 0.f; }
    uint4 kreg0, kreg1, kreg2, vreg0, vreg1;
    kreg2 = make_uint4(0, 0, 0, 0);
    const int kid0 = tid, kid1 = tid + 256, kid2 = tid + 512;
    const int krow0 = kid0 / KCH, kch0 = kid0 % KCH, krow1 = kid1 / KCH, kch1 = kid1 % KCH, krow2 = kid2 / KCH, kch2 = kid2 % KCH;
    const int vrow0 = tid >> 3, vch = tid & 7, vrow1 = vrow0 + 32;
#define TILE_P(ti) ((ti) < 4 ? (ti) * 64 : CTXL + (lt0 + (ti) - 4) * 64)
#define GLOAD(ti) { const int p_ = TILE_P(ti); \
        kreg0 = *(const uint4*)(Kbase + (size_t)(p_ + krow0) * k_ld + kch0 * 8); \
        kreg1 = *(const uint4*)(Kbase + (size_t)(p_ + krow1) * k_ld + kch1 * 8); \
        if (KLD > 2) kreg2 = *(const uint4*)(Kbase + (size_t)(p_ + krow2) * k_ld + kch2 * 8); \
        vreg0 = *(const uint4*)(VT + (size_t)vrow0 * TB + p_ + vch * 8); \
        vreg1 = *(const uint4*)(VT + (size_t)vrow1 * TB + p_ + vch * 8); }
#define SWRITE(buf_) { bf16_t* kd_ = Ks + (buf_) * 64 * KSTR; \
        *(uint4*)(kd_ + krow0 * KSTR + kch0 * 8) = kreg0; *(uint4*)(kd_ + krow1 * KSTR + kch1 * 8) = kreg1; \
        if (KLD > 2) *(uint4*)(kd_ + krow2 * KSTR + kch2 * 8) = kreg2; \
        bf16_t* vd_ = Vs + (buf_) * 64 * VSTR + vch * 8; \
        *(uint2*)(vd_ + vrow0 * VSTR) = make_uint2(vreg0.x, vreg0.y); *(uint2*)(vd_ + vrow0 * VSTR + 4) = make_uint2(vreg0.z, vreg0.w); \
        *(uint2*)(vd_ + vrow1 * VSTR) = make_uint2(vreg1.x, vreg1.y); *(uint2*)(vd_ + vrow1 * VSTR + 4) = make_uint2(vreg1.z, vreg1.w); }
    GLOAD(0); SWRITE(0);
    __syncthreads();
    for (int ti = 0; ti < ntiles; ++ti) {
        const int buf = ti & 1;
        const bool more = ti + 1 < ntiles;
        if (more) GLOAD(ti + 1);
        if (!NAT && ti == 4) { qf[NKS - 2] = qrot4; qf[NKS - 1] = qrot5; }
        const int kr = lt0 + ti - 4;
        const bool active = !NAT || ti < 4 || (kr >= r0w && kr < r0w + 8);
        if (active) {
            const bf16_t* kb = Ks + buf * 64 * KSTR + r32 * KSTR + hh * 8;
            f32x16 st0, st1;
#pragma unroll
            for (int r = 0; r < 16; ++r) { st0[r] = 0.f; st1[r] = 0.f; }
            bf16x8 kf0[NKS], kf1[NKS];
#pragma unroll
            for (int ks = 0; ks < NKS; ++ks) { kf0[ks] = *(const bf16x8*)(kb + ks * 16); kf1[ks] = *(const bf16x8*)(kb + 32 * KSTR + ks * 16); }
            asm volatile("s_waitcnt lgkmcnt(0)" ::: "memory");
#pragma unroll
            for (int ks = 0; ks < NKS; ++ks) {
                st0 = __builtin_amdgcn_mfma_f32_32x32x16_bf16(kf0[ks], qf[ks], st0, 0, 0, 0);
                st1 = __builtin_amdgcn_mfma_f32_32x32x16_bf16(kf1[ks], qf[ks], st1, 0, 0, 0);
            }
            const bf16_t* vb = Vs + buf * 64 * VSTR + r32 * VSTR + 4 * hh;
            uint2 vfr[2][2][2][2];
#pragma unroll
            for (int uu = 0; uu < 2; ++uu)
#pragma unroll
                for (int t = 0; t < 2; ++t)
#pragma unroll
                    for (int s2 = 0; s2 < 2; ++s2) {
                        const bf16_t* a = vb + uu * 32 * VSTR + t * 32 + s2 * 16;
                        vfr[uu][t][s2][0] = *(const uint2*)a; vfr[uu][t][s2][1] = *(const uint2*)(a + 8);
                    }
            float x[32];
#pragma unroll
            for (int r = 0; r < 16; ++r) { x[r] = st0[r]; x[16 + r] = st1[r]; }
            if (NAT && ti >= 4) {
                const int dr = kr - qr + 7;
#pragma unroll
                for (int e = 0; e < 32; ++e) {
                    const int r = e & 15, kc = (e >> 4) * 32 + (r & 3) + 8 * (r >> 2) + 4 * hh;
                    const int dc = min(max(kc - qc, -15), 15) + 15;
                    const bool ok = (kc >= c0) && (kc < c0 + 16);
                    x[e] = ok ? x[e] + rpb_s[dr * 31 + dc] : -1e30f;
                }
            }
            float mx = x[0];
#pragma unroll
            for (int e = 1; e < 32; ++e) mx = fmaxf(mx, x[e]);
            mx = fmaxf(mx, __shfl_xor(mx, 32));
            const float m_new = fmaxf(m_run, mx);
            const bool resc = __ballot(m_new > m_run) != 0ull;
            const float alpha = __builtin_amdgcn_exp2f(m_run - m_new);
            m_run = m_new;
            float ps = 0.f;
#pragma unroll
            for (int e = 0; e < 32; ++e) { x[e] = __builtin_amdgcn_exp2f(x[e] - m_new); ps += x[e]; }
            lsum = lsum * alpha + ps;
            if (resc) {
#pragma unroll
                for (int r = 0; r < 16; ++r) { oacc[0][r] *= alpha; oacc[1][r] *= alpha; }
            }
            bf16x8 pf[2][2];
#pragma unroll
            for (int t = 0; t < 2; ++t)
#pragma unroll
                for (int s = 0; s < 2; ++s) {
                    union { bf16x8 v; unsigned u[4]; } cv;
#pragma unroll
                    for (int q = 0; q < 4; ++q) cv.u[q] = cvt_pk(x[16 * t + 8 * s + 2 * q], x[16 * t + 8 * s + 2 * q + 1]);
                    pf[t][s] = cv.v;
                }
#pragma unroll
            for (int uu = 0; uu < 2; ++uu)
#pragma unroll
                for (int t = 0; t < 2; ++t)
#pragma unroll
                    for (int s = 0; s < 2; ++s) {
                        union { bf16x8 v; uint2 h[2]; } cv;
                        cv.h[0] = vfr[uu][t][s][0]; cv.h[1] = vfr[uu][t][s][1];
                        oacc[uu] = __builtin_amdgcn_mfma_f32_32x32x16_bf16(cv.v, pf[t][s], oacc[uu], 0, 0, 0);
                    }
        }
        if (more) SWRITE((ti + 1) & 1);
        __syncthreads();
    }
#undef TILE_P
#undef GLOAD
#undef SWRITE
    lsum += __shfl_xor(lsum, 32);
    const float inv = 1.f / lsum;
    bf16_t* zrow = PB + (size_t)(rowbase + q_p0 + ql) * PW + C_Z + (NAT ? 512 : 0) + head * 64;
#pragma unroll
    for (int uu = 0; uu < 2; ++uu)
#pragma unroll
        for (int g = 0; g < 4; ++g) {
            bf16_t* zp = zrow + uu * 32 + 8 * g + 4 * hh;
            const uint2 z = *(const uint2*)zp;
            uint2 o;
            o.x = cvt_pk(oacc[uu][4 * g + 0] * inv * siluf_(lo16(z.x)), oacc[uu][4 * g + 1] * inv * siluf_(hi16(z.x)));
            o.y = cvt_pk(oacc[uu][4 * g + 2] * inv * siluf_(lo16(z.y)), oacc[uu][4 * g + 3] * inv * siluf_(hi16(z.y)));
            *(uint2*)zp = o;
        }
}

__device__ void scan_hg_item(const Params& P, int l, int item, unsigned char* smem) {
    const int tid = tid_opaque(), lane = tid & 63, wave = tid >> 6;
    const int slice = item & 7, dir = (item >> 3) & 1, head = (item >> 4) & 3, bl = item >> 6;
    float* a_s = (float*)smem;
    float* q_s = a_s + 64 * 128;
    float* v_s = q_s + 64 * 128;
    float* o_s = v_s + 64 * 16;
    const bf16_t* PB = (const bf16_t*)(P.ws + OFF_PB) + (size_t)bl * TB * PW;
    bf16_t* OS = (bf16_t*)(P.ws + OFF_KV) + ((size_t)dir * NTH + (size_t)bl * TB) * 512 + head * 128 + slice * 16;
    const int prow = tid >> 4, pd = (tid & 15) * 8;
    float lb[8];
#pragma unroll
    for (int e = 0; e < 8; ++e) {
        const int cidx = dir * 512 + head * 128 + pd + e;
        lb[e] = (l == 0) ? 0.f : sigmoidf_(P.lb_logits[1024 + cidx] - P.lb_logits[cidx]);
    }
    const int fcol = (dir ? C_HF + 512 : C_HF) + head * 128 + pd, qcol = C_HQ + head * 128 + pd, vcol = C_HI + head * 128 + slice * 16 + (tid & 1) * 8;
    uint4 rq[4], rf[4], rv;
    auto chunk_p = [&](int c) { const int ci = dir ? (c < 4 ? 3 - c : 135 - c) : c; return ci * 64; };
    auto gload = [&](int c) {
        const int p = chunk_p(c);
#pragma unroll
        for (int r = 0; r < 4; ++r) { const bf16_t* row = PB + (size_t)(p + prow + 16 * r) * PW; rq[r] = *(const uint4*)(row + qcol); rf[r] = *(const uint4*)(row + fcol); }
        if (tid < 128) rv = *(const uint4*)(PB + (size_t)(p + (tid >> 1)) * PW + vcol);
    };
    const int dg = lane & 15, col = wave * 4 + (lane >> 4);
    float S[8];
#pragma unroll
    for (int e = 0; e < 8; ++e) S[e] = 0.f;
    gload(0);
    for (int c = 0; c < 132; ++c) {
        __syncthreads();
#pragma unroll
        for (int r = 0; r < 4; ++r) {
            float fq[8], ff[8];
            unpack8(rq[r], fq); unpack8(rf[r], ff);
            float* ad = a_s + (prow + 16 * r) * 128 + pd; float* qd = q_s + (prow + 16 * r) * 128 + pd;
#pragma unroll
            for (int e = 0; e < 8; ++e) { ad[e] = lb[e] + (1.f - lb[e]) * sigmoidf_(ff[e]); qd[e] = siluf_(fq[e]) * 0.08838834764831845f; }
        }
        if (tid < 128) { float fv[8]; unpack8(rv, fv); float* vd = v_s + (tid >> 1) * 16 + (tid & 1) * 8;
#pragma unroll
            for (int e = 0; e < 8; ++e) vd[e] = fv[e]; }
        __syncthreads();
        if (c + 1 < 132) gload(c + 1);
        for (int tt = 0; tt < 64; tt += 8) {
            float op[8];
#pragma unroll
            for (int u = 0; u < 8; ++u) {
                const int i = dir ? 63 - (tt + u) : tt + u;
                const float4 a0 = *(const float4*)(a_s + i * 128 + dg * 8), a1 = *(const float4*)(a_s + i * 128 + dg * 8 + 4);
                const float4 q0 = *(const float4*)(q_s + i * 128 + dg * 8), q1 = *(const float4*)(q_s + i * 128 + dg * 8 + 4);
                const float v = v_s[i * 16 + col];
                float o;
                S[0] = fmaf(a0.x, S[0] - v, v); o = q0.x * S[0];
                S[1] = fmaf(a0.y, S[1] - v, v); o = fmaf(q0.y, S[1], o);
                S[2] = fmaf(a0.z, S[2] - v, v); o = fmaf(q0.z, S[2], o);
                S[3] = fmaf(a0.w, S[3] - v, v); o = fmaf(q0.w, S[3], o);
                S[4] = fmaf(a1.x, S[4] - v, v); o = fmaf(q1.x, S[4], o);
                S[5] = fmaf(a1.y, S[5] - v, v); o = fmaf(q1.y, S[5], o);
                S[6] = fmaf(a1.z, S[6] - v, v); o = fmaf(q1.z, S[6], o);
                S[7] = fmaf(a1.w, S[7] - v, v); o = fmaf(q1.w, S[7], o);
                op[u] = o;
            }
            float r4[4], r2[2];
            const bool b8 = dg & 8, b4 = dg & 4, b2 = dg & 2;
#pragma unroll
            for (int k = 0; k < 4; ++k) { const float snd = b8 ? op[k] : op[k + 4], kp = b8 ? op[k + 4] : op[k]; r4[k] = kp + __shfl_xor(snd, 8); }
#pragma unroll
            for (int k = 0; k < 2; ++k) { const float snd = b4 ? r4[k] : r4[k + 2], kp = b4 ? r4[k + 2] : r4[k]; r2[k] = kp + __shfl_xor(snd, 4); }
            float r1; { const float snd = b2 ? r2[0] : r2[1], kp = b2 ? r2[1] : r2[0]; r1 = kp + __shfl_xor(snd, 2); }
            r1 += __shfl_xor(r1, 1);
            if ((dg & 1) == 0) { const int tok = tt + (b8 ? 4 : 0) + (b4 ? 2 : 0) + (b2 ? 1 : 0); const int i = dir ? 63 - tok : tok; o_s[i * 16 + col] = r1; }
        }
        __syncthreads();
        if (tid < 128) {
            const int p = chunk_p(c) + (tid >> 1);
            *(uint4*)(OS + (size_t)p * 512 + (tid & 1) * 8) = pack8(o_s + (tid >> 1) * 16 + (tid & 1) * 8);
        }
    }
}

__device__ void scan_gla_item(const Params& P, int l, int item, unsigned char* smem) {
    const int tid = tid_opaque(), lane = tid & 63, wave = tid >> 6;
    const int slice = item & 3, dir = (item >> 2) & 1, head = (item >> 3) & 3, bl = item >> 5;
    float* a_s = (float*)smem;
    float* q_s = a_s + 64 * 64;
    float* k_s = q_s + 64 * 64;
    float* v_s = k_s + 64 * 64;
    float* o_s = v_s + 64 * 32;
    float* r_s = o_s + 64 * 32;
    const bf16_t* PB = (const bf16_t*)(P.ws + OFF_PB) + (size_t)bl * TB * PW;
    bf16_t* OS = (bf16_t*)(P.ws + OFF_OSG) + ((size_t)dir * NTH + (size_t)bl * TB) * 512 + head * 128 + slice * 32;
    const int gd = tid & 63, gt0 = tid >> 6;
    float w2[16];
#pragma unroll
    for (int jx = 0; jx < 16; ++jx) w2[jx] = P.gla_w2[((size_t)(l * 2 + dir) * 16 + jx) * 256 + head * 64 + gd];
    const float b2 = P.gla_b2[(l * 2 + dir) * 256 + head * 64 + gd];
    uint4 rq[2], rk[2], rv, rr;
    auto chunk_p = [&](int c) { const int ci = dir ? (c < 4 ? 3 - c : 135 - c) : c; return ci * 64; };
    auto gload = [&](int c) {
        const int p = chunk_p(c);
#pragma unroll
        for (int i = 0; i < 2; ++i) { const int id = tid + 256 * i, row = id >> 3, ch = id & 7; const bf16_t* rp = PB + (size_t)(p + row) * PW;
            rq[i] = *(const uint4*)(rp + C_GQ + head * 64 + ch * 8); rk[i] = *(const uint4*)(rp + C_GK + head * 64 + ch * 8); }
        { const int row = tid >> 2, ch = tid & 3; rv = *(const uint4*)(PB + (size_t)(p + row) * PW + C_GV + head * 128 + slice * 32 + ch * 8); }
        if (tid < 128) { const int row = tid >> 1, ch = tid & 1; rr = *(const uint4*)(PB + (size_t)(p + row) * PW + C_GR + dir * 16 + ch * 8); }
    };
    const int dg = lane & 7, col = wave * 8 + (lane >> 3);
    float S[8];
#pragma unroll
    for (int e = 0; e < 8; ++e) S[e] = 0.f;
    gload(0);
    for (int c = 0; c < 132; ++c) {
        __syncthreads();
#pragma unroll
        for (int i = 0; i < 2; ++i) { const int id = tid + 256 * i, row = id >> 3, ch = id & 7; float fq[8], fk[8]; unpack8(rq[i], fq); unpack8(rk[i], fk);
#pragma unroll
            for (int e = 0; e < 8; ++e) { q_s[row * 64 + ch * 8 + e] = fq[e] * 0.125f; k_s[row * 64 + ch * 8 + e] = fk[e]; } }
        { const int row = tid >> 2, ch = tid & 3; float fv[8]; unpack8(rv, fv);
#pragma unroll
            for (int e = 0; e < 8; ++e) v_s[row * 32 + ch * 8 + e] = fv[e]; }
        if (tid < 128) { const int row = tid >> 1, ch = tid & 1; float fr[8]; unpack8(rr, fr);
#pragma unroll
            for (int e = 0; e < 8; ++e) r_s[row * 16 + ch * 8 + e] = fr[e]; }
        __syncthreads();
        if (c + 1 < 132) gload(c + 1);
#pragma unroll 4
        for (int m = 0; m < 16; ++m) {
            const int i = gt0 + 4 * m;
            float g = b2;
#pragma unroll
            for (int jx = 0; jx < 16; ++jx) g = fmaf(r_s[i * 16 + jx], w2[jx], g);
            const float ls = fminf(g, 0.f) - __logf(1.f + __expf(-fabsf(g)));
            a_s[i * 64 + gd] = __expf(ls * 0.0625f);
        }
        __syncthreads();
        for (int tt = 0; tt < 64; tt += 8) {
            float op[8];
#pragma unroll
            for (int u = 0; u < 8; ++u) {
                const int i = dir ? 63 - (tt + u) : tt + u;
                const float4 a0 = *(const float4*)(a_s + i * 64 + dg * 8), a1 = *(const float4*)(a_s + i * 64 + dg * 8 + 4);
                const float4 q0 = *(const float4*)(q_s + i * 64 + dg * 8), q1 = *(const float4*)(q_s + i * 64 + dg * 8 + 4);
                const float4 k0 = *(const float4*)(k_s + i * 64 + dg * 8), k1 = *(const float4*)(k_s + i * 64 + dg * 8 + 4);
                const float v = v_s[i * 32 + col];
                float o;
                S[0] = fmaf(a0.x, S[0], k0.x * v); o = q0.x * S[0];
                S[1] = fmaf(a0.y, S[1], k0.y * v); o = fmaf(q0.y, S[1], o);
                S[2] = fmaf(a0.z, S[2], k0.z * v); o = fmaf(q0.z, S[2], o);
                S[3] = fmaf(a0.w, S[3], k0.w * v); o = fmaf(q0.w, S[3], o);
                S[4] = fmaf(a1.x, S[4], k1.x * v); o = fmaf(q1.x, S[4], o);
                S[5] = fmaf(a1.y, S[5], k1.y * v); o = fmaf(q1.y, S[5], o);
                S[6] = fmaf(a1.z, S[6], k1.z * v); o = fmaf(q1.z, S[6], o);
                S[7] = fmaf(a1.w, S[7], k1.w * v); o = fmaf(q1.w, S[7], o);
                op[u] = o;
            }
            float r4[4], r2[2];
            const bool b4 = dg & 4, b2 = dg & 2, b1 = dg & 1;
#pragma unroll
            for (int k = 0; k < 4; ++k) { const float snd = b4 ? op[k] : op[k + 4], kp = b4 ? op[k + 4] : op[k]; r4[k] = kp + __shfl_xor(snd, 4); }
#pragma unroll
            for (int k = 0; k < 2; ++k) { const float snd = b2 ? r4[k] : r4[k + 2], kp = b2 ? r4[k + 2] : r4[k]; r2[k] = kp + __shfl_xor(snd, 2); }
            float r1; { const float snd = b1 ? r2[0] : r2[1], kp = b1 ? r2[1] : r2[0]; r1 = kp + __shfl_xor(snd, 1); }
            { const int tok = tt + (b4 ? 4 : 0) + (b2 ? 2 : 0) + (b1 ? 1 : 0); const int i = dir ? 63 - tok : tok; o_s[i * 32 + col] = r1; }
        }
        __syncthreads();
        { const int row = tid >> 2, ch = tid & 3; const int p = chunk_p(c) + row;
          *(uint4*)(OS + (size_t)p * 512 + ch * 8) = pack8(o_s + row * 32 + ch * 8); }
    }
}


template <bool GLA>
__device__ void scan2_item(const Params& P, int l, int item, unsigned char* smem) {
    constexpr int DK = GLA ? 64 : 128, NT = DK / 32, QS = DK + 8, TS = 40, NSEG = GLA ? 4 : 2, TPS = 32 / NSEG, QCH = DK / 8;
    const int tid = tid_opaque(), lane = tid & 63, wave = tid >> 6, r32 = lane & 31, hh = lane >> 5;
    const int dir = item & 1, head = (item >> 1) & 3, bl = item >> 3;
    bf16_t* Qh = (bf16_t*)smem;
    bf16_t* Kh = Qh + 32 * QS;
    bf16_t* Kt = Kh + 32 * QS;
    bf16_t* Vt = Kt + DK * TS;
    float* eb = (float*)(Vt + 128 * TS);
    float* tot = eb + DK;
    bf16_t* qraw = (bf16_t*)(tot + 4 * DK);
    bf16_t* fraw = qraw + 32 * DK;
    bf16_t* vraw = fraw + 32 * DK;
    bf16_t* rraw = vraw + 32 * 128;
    const bf16_t* PB = (const bf16_t*)(P.ws + OFF_PB) + (size_t)bl * TB * PW;
    bf16_t* OS = (bf16_t*)(P.ws + (GLA ? OFF_OSG : OFF_KV)) + ((size_t)dir * NTH + (size_t)bl * TB) * 512 + head * 128 + wave * 32;
    const int qcol = (GLA ? C_GQ : C_HQ) + head * DK, fcol = GLA ? (C_GK + head * 64) : ((dir ? C_HF + 512 : C_HF) + head * 128),
              vcol = (GLA ? C_GV : C_HI) + head * 128, rcol = C_GR + dir * 16;
    const int pd = tid & (DK - 1), seg = tid / DK;
    float lbv = 0.f, b2 = 0.f, w2[16];
#pragma unroll
    for (int jx = 0; jx < 16; ++jx) w2[jx] = 0.f;
    if (GLA) {
#pragma unroll
        for (int jx = 0; jx < 16; ++jx) w2[jx] = P.gla_w2[((size_t)(l * 2 + dir) * 16 + jx) * 256 + head * 64 + pd];
        b2 = P.gla_b2[(l * 2 + dir) * 256 + head * 64 + pd];
    } else if (l != 0) { const int cidx = dir * 512 + head * 128 + pd; lbv = sigmoidf_(P.lb_logits[1024 + cidx] - P.lb_logits[cidx]); }
    uint4 pq0, pq1, pf0, pf1, pv0, pv1, pr;
    pq1 = pf1 = pr = make_uint4(0, 0, 0, 0);
#define CH_P0(c) (dir ? ((c) < 8 ? (7 - (c)) * 32 : CTXL + (263 - (c)) * 32) : (c) * 32)
#define ROWP(p0_, i_) ((p0_) + (dir ? 31 - (i_) : (i_)))
#define SC_GLOAD(c) { const int p0_ = CH_P0(c); \
        { const int id = tid, i = id / QCH, ch = id % QCH; const bf16_t* rp = PB + (size_t)ROWP(p0_, i) * PW; pq0 = *(const uint4*)(rp + qcol + ch * 8); pf0 = *(const uint4*)(rp + fcol + ch * 8); } \
        if (!GLA) { const int id = tid + 256, i = id / QCH, ch = id % QCH; const bf16_t* rp = PB + (size_t)ROWP(p0_, i) * PW; pq1 = *(const uint4*)(rp + qcol + ch * 8); pf1 = *(const uint4*)(rp + fcol + ch * 8); } \
        { const int i = tid >> 4, ch = tid & 15; pv0 = *(const uint4*)(PB + (size_t)ROWP(p0_, i) * PW + vcol + ch * 8); pv1 = *(const uint4*)(PB + (size_t)ROWP(p0_, i + 16) * PW + vcol + ch * 8); } \
        if (GLA && tid < 64) { const int i = tid >> 1, ch = tid & 1; pr = *(const uint4*)(PB + (size_t)ROWP(p0_, i) * PW + rcol + ch * 8); } }
    f32x16 ST[NT];
#pragma unroll
    for (int T = 0; T < NT; ++T)
#pragma unroll
        for (int r = 0; r < 16; ++r) ST[T][r] = 0.f;
    SC_GLOAD(0);
    for (int c = 0; c < 264; ++c) {
        __syncthreads();
        { const int id = tid, i = id / QCH, ch = id % QCH; *(uint4*)(qraw + i * DK + ch * 8) = pq0; *(uint4*)(fraw + i * DK + ch * 8) = pf0; }
        if (!GLA) { const int id = tid + 256, i = id / QCH, ch = id % QCH; *(uint4*)(qraw + i * DK + ch * 8) = pq1; *(uint4*)(fraw + i * DK + ch * 8) = pf1; }
        { const int i = tid >> 4, ch = tid & 15; *(uint4*)(vraw + i * 128 + ch * 8) = pv0; *(uint4*)(vraw + (i + 16) * 128 + ch * 8) = pv1; }
        if (GLA && tid < 64) { const int i = tid >> 1, ch = tid & 1; *(uint4*)(rraw + i * 16 + ch * 8) = pr; }
        __syncthreads();
        if (c + 1 < 264) SC_GLOAD(c + 1);
        float bl_[TPS], kk[TPS], qq[TPS];
        float cum = 0.f;
#pragma unroll
        for (int tt = 0; tt < TPS; ++tt) {
            const int i = seg * TPS + tt;
            float la;
            if (GLA) {
                float g = b2;
#pragma unroll
                for (int jx = 0; jx < 16; ++jx) g = fmaf(bf2f(rraw[i * 16 + jx]), w2[jx], g);
                la = (fminf(g, 0.f) - __logf(1.f + __expf(-fabsf(g)))) * 0.0625f;
                kk[tt] = bf2f(fraw[i * DK + pd]);
                qq[tt] = bf2f(qraw[i * DK + pd]) * 0.125f;
            } else {
                const float f = bf2f(fraw[i * DK + pd]);
                const float a = lbv + (1.f - lbv) * sigmoidf_(f);
                la = __logf(a);
                kk[tt] = 1.f - a;
                qq[tt] = siluf_(bf2f(qraw[i * DK + pd])) * 0.08838834764831845f;
            }
            cum += la;
            bl_[tt] = cum;
        }
        tot[seg * DK + pd] = cum;
        __syncthreads();
        {
            float off = 0.f, bend = 0.f;
#pragma unroll
            for (int sg = 0; sg < NSEG; ++sg) { const float tv = tot[sg * DK + pd]; bend += tv; if (sg < seg) off += tv; }
            const float eend = __expf(bend);
            if (seg == 0) eb[pd] = eend;
            float kt[TPS];
#pragma unroll
            for (int tt = 0; tt < TPS; ++tt) {
                const int i = seg * TPS + tt;
                const float b = bl_[tt] + off;
                const float e1 = __expf(b), e2 = __expf(-b);
                const float kh = kk[tt] * e2;
                Qh[i * QS + pd] = f2bf(qq[tt] * e1);
                Kh[i * QS + pd] = f2bf(kh);
                kt[tt] = kh * eend;
            }
#pragma unroll
            for (int g8 = 0; g8 < TPS / 8; ++g8) *(uint4*)(Kt + pd * TS + seg * TPS + g8 * 8) = pack8(kt + g8 * 8);
            const int vc = tid & 127, vs = tid >> 7;
            float vv[16];
#pragma unroll
            for (int tt = 0; tt < 16; ++tt) vv[tt] = bf2f(vraw[(vs * 16 + tt) * 128 + vc]);
            *(uint4*)(Vt + vc * TS + vs * 16) = pack8(vv);
            *(uint4*)(Vt + vc * TS + vs * 16 + 8) = pack8(vv + 8);
        }
        __syncthreads();
        f32x16 st;
#pragma unroll
        for (int r = 0; r < 16; ++r) st[r] = 0.f;
#pragma unroll
        for (int ks = 0; ks < DK / 16; ++ks) {
            const bf16x8 ka = *(const bf16x8*)(Kh + r32 * QS + ks * 16 + hh * 8);
            const bf16x8 qb = *(const bf16x8*)(Qh + r32 * QS + ks * 16 + hh * 8);
            st = __builtin_amdgcn_mfma_f32_32x32x16_bf16(ka, qb, st, 0, 0, 0);
        }
        bf16x8 pfr[2];
#pragma unroll
        for (int sI = 0; sI < 2; ++sI) {
            union { bf16x8 v; unsigned u[4]; } cv;
#pragma unroll
            for (int q = 0; q < 4; ++q) {
                const int ra = 8 * sI + 2 * q, rb = ra + 1;
                const int ja = (ra & 3) + 8 * (ra >> 2) + 4 * hh, jb = (rb & 3) + 8 * (rb >> 2) + 4 * hh;
                cv.u[q] = cvt_pk(ja <= r32 ? st[ra] : 0.f, jb <= r32 ? st[rb] : 0.f);
            }
            pfr[sI] = cv.v;
        }
        f32x16 oT;
#pragma unroll
        for (int r = 0; r < 16; ++r) oT[r] = 0.f;
#pragma unroll
        for (int sI = 0; sI < 2; ++sI) {
            const bf16_t* a = Vt + (wave * 32 + r32) * TS + sI * 16 + 4 * hh;
            union { bf16x8 v; uint2 h[2]; } cv;
            cv.h[0] = *(const uint2*)a; cv.h[1] = *(const uint2*)(a + 8);
            oT = __builtin_amdgcn_mfma_f32_32x32x16_bf16(cv.v, pfr[sI], oT, 0, 0, 0);
        }
#pragma unroll
        for (int T = 0; T < NT; ++T)
#pragma unroll
            for (int sI = 0; sI < 2; ++sI) {
                union { bf16x8 v; unsigned u[4]; } ca;
#pragma unroll
                for (int q = 0; q < 4; ++q) ca.u[q] = cvt_pk(ST[T][8 * sI + 2 * q], ST[T][8 * sI + 2 * q + 1]);
                const bf16_t* b = Qh + r32 * QS + T * 32 + sI * 16 + 4 * hh;
                union { bf16x8 v; uint2 h[2]; } cb;
                cb.h[0] = *(const uint2*)b; cb.h[1] = *(const uint2*)(b + 8);
                oT = __builtin_amdgcn_mfma_f32_32x32x16_bf16(ca.v, cb.v, oT, 0, 0, 0);
            }
#pragma unroll
        for (int T = 0; T < NT; ++T) {
#pragma unroll
            for (int g = 0; g < 4; ++g) {
                const float4 e4 = *(const float4*)(eb + T * 32 + 8 * g + 4 * hh);
                ST[T][4 * g + 0] *= e4.x; ST[T][4 * g + 1] *= e4.y; ST[T][4 * g + 2] *= e4.z; ST[T][4 * g + 3] *= e4.w;
            }
#pragma unroll
            for (int ks = 0; ks < 2; ++ks) {
                const bf16x8 ka = *(const bf16x8*)(Kt + (T * 32 + r32) * TS + ks * 16 + hh * 8);
                const bf16x8 vb = *(const bf16x8*)(Vt + (wave * 32 + r32) * TS + ks * 16 + hh * 8);
                ST[T] = __builtin_amdgcn_mfma_f32_32x32x16_bf16(ka, vb, ST[T], 0, 0, 0);
            }
        }
        {
            const int p = ROWP(CH_P0(c), r32);
            bf16_t* op = OS + (size_t)p * 512 + 4 * hh;
#pragma unroll
            for (int g = 0; g < 4; ++g) { uint2 o; o.x = cvt_pk(oT[4 * g], oT[4 * g + 1]); o.y = cvt_pk(oT[4 * g + 2], oT[4 * g + 3]); *(uint2*)(op + 8 * g) = o; }
        }
    }
#undef CH_P0
#undef ROWP
#undef SC_GLOAD
}


template <bool GLA>
__device__ void scan3_item(const Params& P, int l, int item, unsigned char* smem) {
    constexpr int DK = GLA ? 64 : 128, NT = DK / 32, QS = DK + 8, TS = 40, NSEG = GLA ? 4 : 2, TPS = 32 / NSEG, QCH = DK / 8;
    const int tid = tid_opaque(), lane = tid & 63, wave = tid >> 6, r32 = lane & 31, hh = lane >> 5;
    const int dir = item & 1, head = (item >> 1) & 3, bl = item >> 3;
    __builtin_amdgcn_s_setprio(3);
    bf16_t* Qh = (bf16_t*)smem;
    bf16_t* Kh = Qh + 32 * QS;
    bf16_t* Kt = Kh + 32 * QS;
    bf16_t* Vt = Kt + DK * TS;
    float* eb = (float*)(Vt + 128 * TS);
    bf16_t* vraw = (bf16_t*)(eb + DK);
    const bf16_t* PB = (const bf16_t*)(P.ws + OFF_PB) + (size_t)bl * TB * PW;
    bf16_t* OS = (bf16_t*)(P.ws + (GLA ? OFF_OSG : OFF_KV)) + ((size_t)dir * NTH + (size_t)bl * TB) * 512 + head * 128 + wave * 32;
    const bf16_t* qsrc; const bf16_t* ksrc; int qld, kld;
    if (GLA) {
        if (dir == 0) { qsrc = PB + C_GQ + head * 64; qld = PW; ksrc = PB + C_GK + head * 64; kld = PW; }
        else { const bf16_t* X = (const bf16_t*)(P.ws + OFF_XG) + (size_t)bl * TB * 512; qsrc = X + head * 64; qld = 512; ksrc = X + 256 + head * 64; kld = 512; }
    } else {
        if (dir == 0) { qsrc = PB + C_HQ + head * 128; qld = PW; ksrc = PB + C_HF + head * 128; kld = PW; }
        else { qsrc = (const bf16_t*)(P.ws + OFF_XH) + (size_t)bl * TB * 512 + head * 128; qld = 512; ksrc = PB + C_HF + 512 + head * 128; kld = PW; }
    }
    const float* ebsrc = (const float*)(P.ws + (GLA ? OFF_EBG : OFF_EBH)) + ((size_t)(bl * 264) * 2 + dir) * (4 * DK) + head * DK;
    const int vcol = (GLA ? C_GV : C_HI) + head * 128;
    const int pd = tid & (DK - 1), seg = tid / DK;
    uint4 pq0, pq1, pk0, pk1, pv0, pv1; float pe = 0.f;
    pq1 = pk1 = make_uint4(0, 0, 0, 0);
#define CH_P0(c) (dir ? ((c) < 8 ? (7 - (c)) * 32 : CTXL + (263 - (c)) * 32) : (c) * 32)
#define ROWP(p0_, i_) ((p0_) + (dir ? 31 - (i_) : (i_)))
#define SC_GLOAD(c) { const int p0_ = CH_P0(c); \
        { const int id = tid, i = id / QCH, ch = id % QCH; const size_t rr_ = (size_t)ROWP(p0_, i); pq0 = *(const uint4*)(qsrc + rr_ * qld + ch * 8); pk0 = *(const uint4*)(ksrc + rr_ * kld + ch * 8); } \
        if (!GLA) { const int id = tid + 256, i = id / QCH, ch = id % QCH; const size_t rr_ = (size_t)ROWP(p0_, i); pq1 = *(const uint4*)(qsrc + rr_ * qld + ch * 8); pk1 = *(const uint4*)(ksrc + rr_ * kld + ch * 8); } \
        { const int i = tid >> 4, ch = tid & 15; pv0 = *(const uint4*)(PB + (size_t)ROWP(p0_, i) * PW + vcol + ch * 8); pv1 = *(const uint4*)(PB + (size_t)ROWP(p0_, i + 16) * PW + vcol + ch * 8); } \
        if (tid < DK) pe = ebsrc[(size_t)(p0_ >> 5) * 2 * (4 * DK) + tid]; }
    f32x16 ST[NT];
#pragma unroll
    for (int T = 0; T < NT; ++T)
#pragma unroll
        for (int r = 0; r < 16; ++r) ST[T][r] = 0.f;
    SC_GLOAD(0);
    for (int c = 0; c < 264; ++c) {
        __syncthreads();
        { const int id = tid, i = id / QCH, ch = id % QCH; *(uint4*)(Qh + i * QS + ch * 8) = pq0; *(uint4*)(Kh + i * QS + ch * 8) = pk0; }
        if (!GLA) { const int id = tid + 256, i = id / QCH, ch = id % QCH; *(uint4*)(Qh + i * QS + ch * 8) = pq1; *(uint4*)(Kh + i * QS + ch * 8) = pk1; }
        { const int i = tid >> 4, ch = tid & 15; *(uint4*)(vraw + i * 128 + ch * 8) = pv0; *(uint4*)(vraw + (i + 16) * 128 + ch * 8) = pv1; }
        if (tid < DK) eb[tid] = pe;
        __syncthreads();
        if (c + 1 < 264) SC_GLOAD(c + 1);
        {
            const float eend = eb[pd];
            float kt[TPS];
#pragma unroll
            for (int tt = 0; tt < TPS; ++tt) kt[tt] = bf2f(Kh[(seg * TPS + tt) * QS + pd]) * eend;
#pragma unroll
            for (int g8 = 0; g8 < TPS / 8; ++g8) *(uint4*)(Kt + pd * TS + seg * TPS + g8 * 8) = pack8(kt + g8 * 8);
            const int vc = tid & 127, vs = tid >> 7;
            float vv[16];
#pragma unroll
            for (int tt = 0; tt < 16; ++tt) vv[tt] = bf2f(vraw[(vs * 16 + tt) * 128 + vc]);
            *(uint4*)(Vt + vc * TS + vs * 16) = pack8(vv);
            *(uint4*)(Vt + vc * TS + vs * 16 + 8) = pack8(vv + 8);
        }
        __syncthreads();
        f32x16 st, stb;
#pragma unroll
        for (int r = 0; r < 16; ++r) { st[r] = 0.f; stb[r] = 0.f; }
        {
            bf16x8 ka[DK / 16], qb[DK / 16];
#pragma unroll
            for (int ks = 0; ks < DK / 16; ++ks) { ka[ks] = *(const bf16x8*)(Kh + r32 * QS + ks * 16 + hh * 8); qb[ks] = *(const bf16x8*)(Qh + r32 * QS + ks * 16 + hh * 8); }
            asm volatile("s_waitcnt lgkmcnt(0)" ::: "memory");
#pragma unroll
            for (int ks = 0; ks < DK / 16; ks += 2) {
                st = __builtin_amdgcn_mfma_f32_32x32x16_bf16(ka[ks], qb[ks], st, 0, 0, 0);
                stb = __builtin_amdgcn_mfma_f32_32x32x16_bf16(ka[ks + 1], qb[ks + 1], stb, 0, 0, 0);
            }
        }
        uint2 vp[2][2], qp[NT][2][2];
#pragma unroll
        for (int sI = 0; sI < 2; ++sI) { const bf16_t* av = Vt + (wave * 32 + r32) * TS + sI * 16 + 4 * hh; vp[sI][0] = *(const uint2*)av; vp[sI][1] = *(const uint2*)(av + 8); }
#pragma unroll
        for (int T = 0; T < NT; ++T)
#pragma unroll
            for (int sI = 0; sI < 2; ++sI) { const bf16_t* bq = Qh + r32 * QS + T * 32 + sI * 16 + 4 * hh; qp[T][sI][0] = *(const uint2*)bq; qp[T][sI][1] = *(const uint2*)(bq + 8); }
#pragma unroll
        for (int r = 0; r < 16; ++r) st[r] += stb[r];
        bf16x8 pfr[2];
#pragma unroll
        for (int sI = 0; sI < 2; ++sI) {
            union { bf16x8 v; unsigned u[4]; } cv;
#pragma unroll
            for (int q = 0; q < 4; ++q) {
                const int ra = 8 * sI + 2 * q, rb = ra + 1;
                const int ja = (ra & 3) + 8 * (ra >> 2) + 4 * hh, jb = (rb & 3) + 8 * (rb >> 2) + 4 * hh;
                cv.u[q] = cvt_pk(ja <= r32 ? st[ra] : 0.f, jb <= r32 ? st[rb] : 0.f);
            }
            pfr[sI] = cv.v;
        }
        asm volatile("s_waitcnt lgkmcnt(0)" ::: "memory");
        f32x16 oT, oTb;
#pragma unroll
        for (int r = 0; r < 16; ++r) { oT[r] = 0.f; oTb[r] = 0.f; }
#pragma unroll
        for (int sI = 0; sI < 2; ++sI) {
            union { bf16x8 v; uint2 h[2]; } cv;
            cv.h[0] = vp[sI][0]; cv.h[1] = vp[sI][1];
            oT = __builtin_amdgcn_mfma_f32_32x32x16_bf16(cv.v, pfr[sI], oT, 0, 0, 0);
        }
#pragma unroll
        for (int T = 0; T < NT; ++T)
#pragma unroll
            for (int sI = 0; sI < 2; ++sI) {
                union { bf16x8 v; unsigned u[4]; } ca;
#pragma unroll
                for (int q = 0; q < 4; ++q) ca.u[q] = cvt_pk(ST[T][8 * sI + 2 * q], ST[T][8 * sI + 2 * q + 1]);
                union { bf16x8 v; uint2 h[2]; } cb;
                cb.h[0] = qp[T][sI][0]; cb.h[1] = qp[T][sI][1];
                if (T & 1) oTb = __builtin_amdgcn_mfma_f32_32x32x16_bf16(ca.v, cb.v, oTb, 0, 0, 0);
                else oT = __builtin_amdgcn_mfma_f32_32x32x16_bf16(ca.v, cb.v, oT, 0, 0, 0);
            }
        {
            bf16x8 kt2[NT][2], vb2[2];
            float4 e4v[NT][4];
#pragma unroll
            for (int ks = 0; ks < 2; ++ks) vb2[ks] = *(const bf16x8*)(Vt + (wave * 32 + r32) * TS + ks * 16 + hh * 8);
#pragma unroll
            for (int T = 0; T < NT; ++T) {
#pragma unroll
                for (int ks = 0; ks < 2; ++ks) kt2[T][ks] = *(const bf16x8*)(Kt + (T * 32 + r32) * TS + ks * 16 + hh * 8);
#pragma unroll
                for (int g = 0; g < 4; ++g) e4v[T][g] = *(const float4*)(eb + T * 32 + 8 * g + 4 * hh);
            }
            asm volatile("s_waitcnt lgkmcnt(0)" ::: "memory");
#pragma unroll
            for (int T = 0; T < NT; ++T) {
#pragma unroll
                for (int g = 0; g < 4; ++g) { ST[T][4 * g + 0] *= e4v[T][g].x; ST[T][4 * g + 1] *= e4v[T][g].y; ST[T][4 * g + 2] *= e4v[T][g].z; ST[T][4 * g + 3] *= e4v[T][g].w; }
#pragma unroll
                for (int ks = 0; ks < 2; ++ks) ST[T] = __builtin_amdgcn_mfma_f32_32x32x16_bf16(kt2[T][ks], vb2[ks], ST[T], 0, 0, 0);
            }
        }
#pragma unroll
        for (int r = 0; r < 16; ++r) oT[r] += oTb[r];
        {
            const int p = ROWP(CH_P0(c), r32);
            bf16_t* op = OS + (size_t)p * 512 + 4 * hh;
#pragma unroll
            for (int g = 0; g < 4; ++g) { uint2 o; o.x = cvt_pk(oT[4 * g], oT[4 * g + 1]); o.y = cvt_pk(oT[4 * g + 2], oT[4 * g + 3]); *(uint2*)(op + 8 * g) = o; }
        }
    }
#undef CH_P0
#undef ROWP
#undef SC_GLOAD
    __builtin_amdgcn_s_setprio(0);
}

#ifdef ONLYI
#define IT_ON(n) (ONLYI == (n))
#else
#define IT_ON(n) true
#endif
__device__ void phase_mixers(const Params& P, int ph, int l, unsigned char* smem, int mode = 0) {
    constexpr int N_HG = 16, N_GLA = 16, N_ATT = 2 * 8 * 66;
    const int bx = blockIdx.x;
    int my_scan = -1;
    if (mode != 2 && bx < 256 && (bx & 7) == ((bx >> 3) & 7)) my_scan = bx >> 3;
    if (mode == 0 && bx >= 256 && ((bx - 256) & 7) == (((bx - 256) >> 3) & 7)) return;
    for (;;) {
        int it;
        if (my_scan >= 0) { it = my_scan; my_scan = -1; }
        else {
            if (mode == 1) break;
            it = next_item(P, ph) + N_HG + N_GLA;
        }
        if (it >= N_HG + N_GLA + 2 * N_ATT) break;
        if (it < N_HG) { if (IT_ON(0)) scan3_item<false>(P, l, it, smem); continue; }
        it -= N_HG;
        if (it < N_GLA) { if (IT_ON(1)) scan3_item<true>(P, l, it, smem); continue; }
        it -= N_GLA;
        if (it < N_ATT) { const int bl = it / 528, rem = it % 528; if (IT_ON(2)) attn_item<96, false>(P, l, bl, rem / 66, rem % 66, smem); continue; }
        it -= N_ATT;
        { const int bl = it / 528, rem = it % 528; if (IT_ON(3)) attn_item<64, true>(P, l, bl, rem / 66, rem % 66, smem); }
    }
}

__device__ void phase_scanfin(const Params& P, int ph, int l) {
    const int tid = tid_opaque(), lane = tid & 63, wave = tid >> 6;
    bf16_t* PB = (bf16_t*)(P.ws + OFF_PB);
    const bf16_t* OSH = (const bf16_t*)(P.ws + OFF_KV);
    const bf16_t* OSGp = (const bf16_t*)(P.ws + OFF_OSG);
    float gh[8], gg[8];
#pragma unroll
    for (int e = 0; e < 8; ++e) { gh[e] = P.hg_g_o[l * 128 + (lane & 15) * 8 + e]; gg[e] = P.gla_g_o[l * 128 + (lane & 15) * 8 + e]; }
    for (;;) {
        const int u = next_item(P, ph);
        if (u >= NTH / 16) break;
        uint4 ra[8], rb[8], rz[8];
#pragma unroll
        for (int k = 0; k < 8; ++k) {
            const int t = u * 16 + wave * 4 + (k >> 1), mx = k & 1;
            const bf16_t* OS = mx ? OSGp : OSH;
            ra[k] = *(const uint4*)(OS + (size_t)t * 512 + lane * 8);
            rb[k] = *(const uint4*)(OS + ((size_t)NTH + t) * 512 + lane * 8);
            rz[k] = *(const uint4*)(PB + (size_t)t * PW + C_Z + (2 + mx) * 512 + lane * 8);
        }
#pragma unroll
        for (int k = 0; k < 8; ++k) {
            const int t = u * 16 + wave * 4 + (k >> 1), mx = k & 1;
            float a[8], b[8], z[8];
            unpack8(ra[k], a); unpack8(rb[k], b); unpack8(rz[k], z);
            float ss = 0.f;
#pragma unroll
            for (int e = 0; e < 8; ++e) { a[e] += b[e]; ss += a[e] * a[e]; }
            ss += __shfl_xor(ss, 1); ss += __shfl_xor(ss, 2); ss += __shfl_xor(ss, 4); ss += __shfl_xor(ss, 8);
            const float rn = rsqrtf(ss * (1.f / 128.f) + EPS);
#pragma unroll
            for (int e = 0; e < 8; ++e) a[e] = a[e] * rn * (mx ? gg[e] : gh[e]) * siluf_(z[e]);
            *(uint4*)(PB + (size_t)t * PW + C_Z + (2 + mx) * 512 + lane * 8) = pack8(a);
        }
    }
}

__device__ void phase_merge(const Params& P, int ph, int l, unsigned char* smem) {
    const int tid_ = tid_opaque(), lane = tid_ & 63, wave = tid_ >> 6, wr = wave >> 1, wc = wave & 1;
    const bf16_t* H = (const bf16_t*)(P.ws + OFF_H);
    const bf16_t* PB = (const bf16_t*)(P.ws + OFF_PB);
    bf16_t* ACC = (bf16_t*)(P.ws + OFF_KV);
    for (;;) {
        const int u = next_item(P, ph);
        if (u >= 132 * 16) break;
        const int mt = u >> 4, nt = u & 15;
        const int col = nt * 64 + wc * 32 + (lane & 31);
        f32x16 tot[2];
#pragma unroll
        for (int r = 0; r < 16; ++r) { tot[0][r] = 0.f; tot[1][r] = 0.f; }
        for (int br = 0; br < 4; ++br) {
            unsigned gate[2][8];
            {
                f32x16 g[2];
#pragma unroll
                for (int r = 0; r < 16; ++r) { g[0][r] = 0.f; g[1][r] = 0.f; }
                gemm_tile_n64(g, H + (size_t)mt * 128 * D, D, (const bf16_t*)(P.ws + OFF_WM) + ((size_t)(l * 4 + br) * 1024 + nt * 64) * 1024, 1024, 1024, smem);
                const float bm = P.b_merge[(l * 4 + br) * 1024 + col];
#pragma unroll
                for (int mi = 0; mi < 2; ++mi)
#pragma unroll
                    for (int r = 0; r < 8; ++r) gate[mi][r] = cvt_pk_asm(sigmoidf_(g[mi][2 * r] + bm), sigmoidf_(g[mi][2 * r + 1] + bm));
            }
            f32x16 pa[2];
#pragma unroll
            for (int r = 0; r < 16; ++r) { pa[0][r] = 0.f; pa[1][r] = 0.f; }
            gemm_tile_n64(pa, PB + (size_t)mt * 128 * PW + C_Z + br * 512, PW, (const bf16_t*)(P.ws + OFF_WBR) + ((size_t)(l * 4 + br) * 1024 + nt * 64) * 512, 512, 512, smem);
#pragma unroll
            for (int mi = 0; mi < 2; ++mi)
#pragma unroll
                for (int r = 0; r < 8; ++r) {
                    tot[mi][2 * r] = fmaf(lo16(gate[mi][r]), pa[mi][2 * r], tot[mi][2 * r]);
                    tot[mi][2 * r + 1] = fmaf(hi16(gate[mi][r]), pa[mi][2 * r + 1], tot[mi][2 * r + 1]);
                }
        }
#pragma unroll
        for (int mi = 0; mi < 2; ++mi)
#pragma unroll
            for (int r = 0; r < 16; ++r) ACC[(size_t)(mt * 128 + ACC_ROW(mi, r)) * 1024 + col] = f2bf(tot[mi][r]);
    }
}

__device__ void phase_out(const Params& P, int ph, int l, int hf, unsigned char* smem) {
    const int tid_ = tid_opaque(), lane = tid_ & 63, wave = tid_ >> 6, wr = wave >> 1, wc = wave & 1;
    const bf16_t* ACC = (const bf16_t*)(P.ws + OFF_KV);
    const float* mod = (const float*)(P.ws + OFF_MOD);
    for (;;) {
        const int u = next_item(P, ph);
        if (u >= 132 * 8) break;
        const int mt = u >> 3, nt = u & 7;
        const int t0 = mt * 128, bl = t0 / TB, p0 = t0 % TB, b = hf * 2 + bl;
        const bool isctx = p0 < CTXL;
        if (isctx && l == 1) continue;
        f32x16 acc[2][2]; zero_acc(acc);
        gemm_tile_pf2(acc, ACC + (size_t)mt * 128 * 1024, 1024, (const bf16_t*)(P.ws + OFF_WO) + ((size_t)l * 1024 + nt * 128) * 1024, 1024, 1024, smem);
        const float* gt = mod + (l * 5 + (isctx ? 4 : b)) * 3072 + 2048 + nt * 128;
        const float* src; float* dst;
        if (isctx) { src = P.ctx + ((size_t)b * CTXL + p0) * D; dst = (float*)(P.ws + OFF_CX1) + ((size_t)b * CTXL + p0) * D; }
        else { const size_t o = ((size_t)b * SEQ + (p0 - CTXL)) * D; src = (l == 0 ? P.x : (const float*)P.out) + o; dst = P.out + o; }
        float rv[2][2][16];
#pragma unroll
        for (int mi = 0; mi < 2; ++mi)
#pragma unroll
            for (int ni = 0; ni < 2; ++ni)
#pragma unroll
                for (int r = 0; r < 16; ++r) rv[mi][ni][r] = src[(size_t)ACC_ROW(mi, r) * D + nt * 128 + ACC_COL(ni)];
#pragma unroll
        for (int mi = 0; mi < 2; ++mi)
#pragma unroll
            for (int ni = 0; ni < 2; ++ni) {
                const int cl = ACC_COL(ni);
                const float g = gt[cl];
#pragma unroll
                for (int r = 0; r < 16; ++r) { const size_t o = (size_t)ACC_ROW(mi, r) * D + nt * 128 + cl; dst[o] = rv[mi][ni][r] + g * acc[mi][ni][r]; }
            }
    }
}

__global__ void __launch_bounds__(256, 2) mega(Params PK) {
    extern __shared__ __attribute__((aligned(16))) unsigned char smem[];
    if (blockIdx.x == 0 && threadIdx.x == 0) {
        Params* T = (Params*)(PK.ws + OFF_TAB);
        T->x = PK.x; T->c = PK.c; T->ctx = PK.ctx; T->c_ctx = PK.c_ctx; T->ada_w = PK.ada_w; T->ada_b = PK.ada_b; T->norm_g = PK.norm_g; T->w_in = PK.w_in;
        T->w_uq = PK.w_uq; T->w_ukv = PK.w_ukv; T->g_cq = PK.g_cq; T->g_ckv = PK.g_ckv; T->g_q = PK.g_q; T->g_k = PK.g_k; T->rpb = PK.rpb; T->ng_q = PK.ng_q; T->ng_k = PK.ng_k;
        T->lb_logits = PK.lb_logits; T->hg_g_o = PK.hg_g_o; T->gla_w2 = PK.gla_w2; T->gla_b2 = PK.gla_b2; T->gla_g_o = PK.gla_g_o; T->w_br = PK.w_br; T->w_merge = PK.w_merge;
        T->b_merge = PK.b_merge; T->w_out = PK.w_out; T->out = PK.out; T->ws = PK.ws; T->ph_lo = PK.ph_lo; T->ph_hi = PK.ph_hi;
    }
    unsigned char* wsb = PK.ws;
    const int ph_lo = PK.ph_lo, ph_hi = PK.ph_hi;
#ifdef PROBE_SUB
    __shared__ long long s_tacc, s_tprev; if (threadIdx.x == 0) { s_tacc = 0; s_tprev = 0; }
#endif
    for (int ph = ph_lo; ph < ph_hi; ++ph) {
#ifndef SPLIT_MIX
        if (ph > 8 && ((ph - 1) & 7) == 0) continue;
#endif
        if (ph > ph_lo) cg::this_grid().sync();
        const Params& P = PK;
#ifdef PROBE_SUB
        if (threadIdx.x == 0) { const long long t_now = wall_clock64();
#ifdef SPLIT_MIX
            const int prev_sub = (ph == 0) ? -1 : (ph == 1 ? 9 : ((ph - 2) % 9));
#else
            const int prev_sub = (ph == 0) ? -1 : (ph == 1 ? 8 : ((ph - 2) & 7));
#endif
            if (prev_sub == PROBE_SUB) s_tacc += t_now - s_tprev; s_tprev = t_now; }
#endif
#ifdef ONLYP
#define PH_ON(n) ((ONLYP >> (n)) & 1)
#else
#define PH_ON(n) true
#endif
        if (ph == 0) { if (PH_ON(8)) phase_prologue(PK, ph, smem); continue; }
#ifdef SPLIT_MIX
        const int q = ph - 1, pass = q / 9, sub9 = q % 9, l = pass >> 1, hf = pass & 1;
        if (sub9 == 4 || sub9 == 5) { phase_mixers(P, ph, l, smem, sub9 - 3); continue; }
        const int sub = sub9 < 4 ? sub9 : sub9 - 1;
        switch (sub) {
            case 0: phase_norm(P, ph, l, hf); break;
            case 1: phase_gemm1(P, ph, l, smem); break;
            case 2: phase_gemm2(P, ph, l, smem); break;
            case 3: phase_finalize(P, ph, l, smem); break;
            case 5: phase_scanfin(P, ph, l); break;
            case 6: phase_merge(P, ph, l, smem); break;
            default: phase_out(P, ph, l, hf, smem); break;
        }
#else
        const int q = ph - 1, pass = q >> 3, sub = q & 7, l = pass >> 1, hf = pass & 1;
        switch (sub) {
            case 0: if (PH_ON(0)) phase_norm(P, ph, l, hf); break;
            case 1: if (PH_ON(1)) phase_gemm1(P, ph, l, smem); break;
            case 2: if (PH_ON(2)) phase_gemm2(P, ph, l, smem); break;
            case 3: if (PH_ON(3)) phase_finalize(P, ph, l, smem); break;
            case 4: if (PH_ON(4)) phase_mixers(P, ph, l, smem); break;
            case 5: if (PH_ON(5)) phase_scanfin(P, ph, l); break;
            case 6: if (PH_ON(6)) phase_merge(P, ph, l, smem); break;
            default: if (PH_ON(7)) { phase_out(P, ph, l, hf, smem); if (pass < 3) phase_norm(P, ph + 40, (pass + 1) >> 1, (pass + 1) & 1); } break;
        }
#endif
    }
#ifdef PROBE_SUB
    cg::this_grid().sync();
    if (threadIdx.x == 0) { const long long t_now = wall_clock64(); if (7 == PROBE_SUB) s_tacc += t_now - s_tprev;
      if (blockIdx.x == 0) { const long long t_acc = s_tacc; const long long t0 = wall_clock64(); while (wall_clock64() - t0 < t_acc) { __builtin_amdgcn_s_sleep(10); } } }
#endif
}

extern "C" void kernel_launch(void* const* d_in, const int* in_sizes, int n_in, void* d_out, int out_size, void* d_ws, size_t ws_size, hipStream_t stream) {
    static int grid = 0;
    if (grid == 0) {
        if (ws_size < WS_END) { fprintf(stderr, "workspace too small: %zu < %zu\n", ws_size, (size_t)WS_END); grid = -1; return; }
        int dev = 0, cus = 0, per_cu = 0;
        hipGetDevice(&dev);
        hipDeviceGetAttribute(&cus, hipDeviceAttributeMultiprocessorCount, dev);
        hipFuncSetAttribute((const void*)mega, hipFuncAttributeMaxDynamicSharedMemorySize, LDS_BYTES);
        hipOccupancyMaxActiveBlocksPerMultiprocessor(&per_cu, (const void*)mega, 256, LDS_BYTES);
        if (per_cu < 1) per_cu = 1;
        if (per_cu > 2) per_cu = 2;
        grid = cus * per_cu;
        (void)hipGetLastError();
    }
    if (grid < 0) return;
    hipMemsetAsync((unsigned char*)d_ws + OFF_CTL, 0, 4096, stream);
    Params p{};
    const float** pp = (const float**)&p;
    for (int i = 0; i < 26; ++i) pp[i] = (const float*)d_in[i];
    p.out = (float*)d_out; p.ws = (unsigned char*)d_ws;
#if SINGLE_LAUNCH
    p.ph_lo = 0; p.ph_hi = NPHASE;
    void* args[] = {&p};
    hipError_t e = hipLaunchCooperativeKernel((const void*)mega, dim3(grid), dim3(256), args, LDS_BYTES, stream);
    if (e != hipSuccess) fprintf(stderr, "cooperative launch failed: %s (grid %d)\n", hipGetErrorString(e), grid);
#else
    for (int ph = 0; ph < NPHASE; ++ph) {
        p.ph_lo = ph; p.ph_hi = ph + 1;
        hipLaunchKernelGGL(mega, dim3(grid), dim3(256), LDS_BYTES, stream, p);
    }
#endif
}
```

```cpp
#include <hip/hip_runtime.h>
#include <hip/hip_cooperative_groups.h>
#include <stdint.h>
#include <stdio.h>
namespace cg = cooperative_groups;

typedef unsigned short bf16_t;
typedef short bf16x8 __attribute__((ext_vector_type(8)));
typedef short bf16x4 __attribute__((ext_vector_type(4)));
typedef float f32x16 __attribute__((ext_vector_type(16)));

#ifndef SINGLE_LAUNCH
#define SINGLE_LAUNCH 1
#endif

constexpr int D = 1024, SEQ = 8192, CTXL = 256, TB = SEQ + CTXL  , NTH = 2 * TB  ;
constexpr int INW = 7104, PW = 7104;
constexpr int C_CQ = 0, C_CKV = 256, C_KR = 384, C_NQ = 416, C_NK = 928, C_NV = 1440, C_HQ = 1952, C_HF = 2464, C_HI = 3488,
              C_GQ = 4000, C_GK = 4256, C_GV = 4512, C_GR = 5024, C_Z = 5056;
constexpr float EPS = 1e-6f;
constexpr float LOG2E = 1.4426950408889634f;
constexpr int LDS_BYTES = 73728;
#ifdef SPLIT_MIX
constexpr int NPHASE = 37;
#else
constexpr int NPHASE = 33;
#endif

constexpr size_t al256(size_t v) { return (v + 255) & ~(size_t)255; }
constexpr size_t OFF_CTL = 0;
constexpr size_t OFF_TAB = 1024;
constexpr size_t OFF_MOD = 4096;
constexpr size_t OFF_CX1 = al256(OFF_MOD + 2 * 5 * 3072 * 4);
constexpr size_t OFF_WIN = al256(OFF_CX1 + (size_t)4 * 256 * 1024 * 4);
constexpr size_t OFF_WM = al256(OFF_WIN + (size_t)2 * 7168 * 1024 * 2);
constexpr size_t OFF_WBR = al256(OFF_WM + (size_t)8 * 1024 * 1024 * 2);
constexpr size_t OFF_WO = al256(OFF_WBR + (size_t)8 * 1024 * 512 * 2);
constexpr size_t OFF_WUQ = al256(OFF_WO + (size_t)2 * 1024 * 1024 * 2);
constexpr size_t OFF_WUKV = al256(OFF_WUQ + (size_t)2 * 768 * 256 * 2);
constexpr size_t OFF_H = al256(OFF_WUKV + (size_t)2 * 1024 * 128 * 2);
constexpr size_t OFF_PB = al256(OFF_H + (size_t)NTH * 1024 * 2);
constexpr size_t OFF_QF = al256(OFF_PB + (size_t)NTH * PW * 2);
constexpr size_t OFF_KV = al256(OFF_QF + (size_t)NTH * 768 * 2);
constexpr size_t OFF_KF = al256(OFF_KV + (size_t)NTH * 1024 * 2);
constexpr size_t OFF_VTM = al256(OFF_KF + (size_t)NTH * 768 * 2);
constexpr size_t OFF_VTN = al256(OFF_VTM + (size_t)2 * 8 * 64 * TB * 2);
constexpr size_t OFF_OSG = al256(OFF_VTN + (size_t)2 * 8 * 64 * TB * 2);
constexpr size_t OFF_XH = al256(OFF_OSG + (size_t)2 * NTH * 512 * 2);
constexpr size_t OFF_XG = al256(OFF_XH + (size_t)NTH * 512 * 2);
constexpr size_t OFF_EBH = al256(OFF_XG + (size_t)NTH * 512 * 2);
constexpr size_t OFF_EBG = al256(OFF_EBH + (size_t)528 * 2 * 512 * 4);
constexpr size_t WS_END = al256(OFF_EBG + (size_t)528 * 2 * 256 * 4);

static_assert(WS_END <= (size_t)512 * 1024 * 1024, "workspace map exceeds 512 MiB");
struct Params {
    const float *x, *c, *ctx, *c_ctx, *ada_w, *ada_b, *norm_g, *w_in, *w_uq, *w_ukv, *g_cq, *g_ckv, *g_q, *g_k, *rpb, *ng_q, *ng_k,
        *lb_logits, *hg_g_o, *gla_w2, *gla_b2, *gla_g_o, *w_br, *w_merge, *b_merge, *w_out;
    float* out;
    unsigned char* ws;
    int ph_lo, ph_hi;
};

__device__ __forceinline__ float bf2f(bf16_t v) { return __uint_as_float(((unsigned)v) << 16); }
typedef float f32x2_t __attribute__((ext_vector_type(2)));
typedef __bf16 bf16x2_t __attribute__((ext_vector_type(2)));
__device__ __forceinline__ unsigned cvt_pk(float lo, float hi) { f32x2_t v = {lo, hi}; bf16x2_t b = __builtin_convertvector(v, bf16x2_t); return __builtin_bit_cast(unsigned, b); }
__device__ __forceinline__ unsigned cvt_pk_asm(float lo, float hi) { unsigned r; asm("s_nop 1\n\tv_cvt_pk_bf16_f32 %0, %1, %2" : "=v"(r) : "v"(lo), "v"(hi)); return r; }
__device__ __forceinline__ bf16_t f2bf(float f) { return (bf16_t)(cvt_pk(f, 0.f) & 0xffffu); }
__device__ __forceinline__ float lo16(unsigned u) { return __uint_as_float(u << 16); }
__device__ __forceinline__ float hi16(unsigned u) { return __uint_as_float(u & 0xffff0000u); }
__device__ __forceinline__ float sigmoidf_(float x) { return 1.f / (1.f + __expf(-x)); }
__device__ __forceinline__ float siluf_(float x) { return x / (1.f + __expf(-x)); }
__device__ __forceinline__ float wave_sum(float v) {
#pragma unroll
    for (int o = 32; o > 0; o >>= 1) v += __shfl_xor(v, o);
    return v;
}
__device__ __forceinline__ void unpack8(uint4 u, float* f) {
    f[0] = lo16(u.x); f[1] = hi16(u.x); f[2] = lo16(u.y); f[3] = hi16(u.y); f[4] = lo16(u.z); f[5] = hi16(u.z); f[6] = lo16(u.w); f[7] = hi16(u.w);
}
__device__ __forceinline__ uint4 pack8(const float* f) { uint4 u; u.x = cvt_pk(f[0], f[1]); u.y = cvt_pk(f[2], f[3]); u.z = cvt_pk(f[4], f[5]); u.w = cvt_pk(f[6], f[7]); return u; }

__device__ __forceinline__ int tid_opaque() { int t = threadIdx.x; asm volatile("" : "+v"(t)); return t; }
__shared__ int s_item;
__device__ __forceinline__ int next_item(const Params& P, int ph) {
    __syncthreads();
    if (threadIdx.x == 0) s_item = atomicAdd((int*)(P.ws + OFF_CTL) + ph, 1);
    __syncthreads();
    return s_item;
}

constexpr int GS = 72;
__device__ __forceinline__ void gemm_tile(f32x16 (&acc)[2][2], const bf16_t* __restrict__ A, int lda, const bf16_t* __restrict__ Bt, int ldb, int K, unsigned char* smem) {
    const int tid = tid_opaque(), lane = tid & 63, wave = tid >> 6, wr = wave >> 1, wc = wave & 1;
    bf16_t* sA = (bf16_t*)smem;
    bf16_t* sB = sA + 2 * 128 * GS;
    const int lrow = tid >> 3, lch = (tid & 7) * 8;
    uint4 ra[4], rb[4];
    const bf16_t* Ap = A + (size_t)lrow * lda + lch;
    const bf16_t* Bp = Bt + (size_t)lrow * ldb + lch;
#pragma unroll
    for (int i = 0; i < 4; ++i) { ra[i] = *(const uint4*)(Ap + (size_t)(32 * i) * lda); rb[i] = *(const uint4*)(Bp + (size_t)(32 * i) * ldb); }
#pragma unroll
    for (int i = 0; i < 4; ++i) { *(uint4*)(sA + (lrow + 32 * i) * GS + lch) = ra[i]; *(uint4*)(sB + (lrow + 32 * i) * GS + lch) = rb[i]; }
    __syncthreads();
    const int nk = K >> 6;
    const int aoff = (wr * 64 + (lane & 31)) * GS + (lane >> 5) * 8, boff = (wc * 64 + (lane & 31)) * GS + (lane >> 5) * 8;
    for (int kt = 0; kt < nk; ++kt) {
        const bool more = kt + 1 < nk;
        if (more) {
#pragma unroll
            for (int i = 0; i < 4; ++i) { ra[i] = *(const uint4*)(Ap + (size_t)(32 * i) * lda + (kt + 1) * 64); rb[i] = *(const uint4*)(Bp + (size_t)(32 * i) * ldb + (kt + 1) * 64); }
        }
        const bf16_t* a = sA + (kt & 1) * 128 * GS + aoff;
        const bf16_t* b = sB + (kt & 1) * 128 * GS + boff;
#pragma unroll
        for (int ks = 0; ks < 4; ++ks) {
            bf16x8 a0 = *(const bf16x8*)(a + ks * 16), a1 = *(const bf16x8*)(a + 32 * GS + ks * 16);
            bf16x8 b0 = *(const bf16x8*)(b + ks * 16), b1 = *(const bf16x8*)(b + 32 * GS + ks * 16);
            acc[0][0] = __builtin_amdgcn_mfma_f32_32x32x16_bf16(a0, b0, acc[0][0], 0, 0, 0);
            acc[0][1] = __builtin_amdgcn_mfma_f32_32x32x16_bf16(a0, b1, acc[0][1], 0, 0, 0);
            acc[1][0] = __builtin_amdgcn_mfma_f32_32x32x16_bf16(a1, b0, acc[1][0], 0, 0, 0);
            acc[1][1] = __builtin_amdgcn_mfma_f32_32x32x16_bf16(a1, b1, acc[1][1], 0, 0, 0);
        }
        if (more) {
            bf16_t* wa = sA + ((kt + 1) & 1) * 128 * GS;
            bf16_t* wb = sB + ((kt + 1) & 1) * 128 * GS;
#pragma unroll
            for (int i = 0; i < 4; ++i) { *(uint4*)(wa + (lrow + 32 * i) * GS + lch) = ra[i]; *(uint4*)(wb + (lrow + 32 * i) * GS + lch) = rb[i]; }
        }
        __syncthreads();
    }
}

__device__ __forceinline__ void gemm_tile_pf2(f32x16 (&acc)[2][2], const bf16_t* __restrict__ A, int lda, const bf16_t* __restrict__ Bt, int ldb, int K, unsigned char* smem) {
    const int tid = tid_opaque(), lane = tid & 63, wave = tid >> 6, wr = wave >> 1, wc = wave & 1;
    bf16_t* sA = (bf16_t*)smem;
    bf16_t* sB = sA + 2 * 128 * GS;
    const int lrow = tid >> 3, lch = (tid & 7) * 8;
    uint4 pa0, pa1, pa2, pa3, pb0, pb1, pb2, pb3, qa0, qa1, qa2, qa3, qb0, qb1, qb2, qb3;
    const bf16_t* Ap = A + (size_t)lrow * lda + lch;
    const bf16_t* Bp = Bt + (size_t)lrow * ldb + lch;
    const int nk = K >> 6;
#define PF2_LD1(RA, RB, kt_, i) { RA##i = *(const uint4*)(Ap + (size_t)(32 * i) * lda + (kt_) * 64); RB##i = *(const uint4*)(Bp + (size_t)(32 * i) * ldb + (kt_) * 64); }
#define PF2_LOAD(RA, RB, kt_) { PF2_LD1(RA, RB, kt_, 0) PF2_LD1(RA, RB, kt_, 1) PF2_LD1(RA, RB, kt_, 2) PF2_LD1(RA, RB, kt_, 3) }
#define PF2_WR1(RA, RB, i) { *(uint4*)(wa + (lrow + 32 * i) * GS + lch) = RA##i; *(uint4*)(wb + (lrow + 32 * i) * GS + lch) = RB##i; }
#define PF2_WRITE(RA, RB, buf_) { bf16_t* wa = sA + (buf_) * 128 * GS; bf16_t* wb = sB + (buf_) * 128 * GS; PF2_WR1(RA, RB, 0) PF2_WR1(RA, RB, 1) PF2_WR1(RA, RB, 2) PF2_WR1(RA, RB, 3) }
#define PF2_COMPUTE(buf_) { const bf16_t* a = sA + (buf_) * 128 * GS + aoff; const bf16_t* b = sB + (buf_) * 128 * GS + boff; _Pragma("unroll") for (int ks = 0; ks < 4; ++ks) { \
        bf16x8 a0 = *(const bf16x8*)(a + ks * 16), a1 = *(const bf16x8*)(a + 32 * GS + ks * 16); bf16x8 b0 = *(const bf16x8*)(b + ks * 16), b1 = *(const bf16x8*)(b + 32 * GS + ks * 16); \
        acc[0][0] = __builtin_amdgcn_mfma_f32_32x32x16_bf16(a0, b0, acc[0][0], 0, 0, 0); acc[0][1] = __builtin_amdgcn_mfma_f32_32x32x16_bf16(a0, b1, acc[0][1], 0, 0, 0); \
        acc[1][0] = __builtin_amdgcn_mfma_f32_32x32x16_bf16(a1, b0, acc[1][0], 0, 0, 0); acc[1][1] = __builtin_amdgcn_mfma_f32_32x32x16_bf16(a1, b1, acc[1][1], 0, 0, 0); } }
    const int aoff = (wr * 64 + (lane & 31)) * GS + (lane >> 5) * 8, boff = (wc * 64 + (lane & 31)) * GS + (lane >> 5) * 8;
    PF2_LOAD(pa, pb, 0);
    PF2_LOAD(qa, qb, 1);
    PF2_WRITE(pa, pb, 0);
    __syncthreads();
    for (int kt = 0; kt < nk; kt += 2) {
        if (kt + 2 < nk) PF2_LOAD(pa, pb, kt + 2);
        PF2_COMPUTE(0);
        PF2_WRITE(qa, qb, 1);
        __syncthreads();
        if (kt + 3 < nk) PF2_LOAD(qa, qb, kt + 3);
        PF2_COMPUTE(1);
        if (kt + 2 < nk) PF2_WRITE(pa, pb, 0);
        __syncthreads();
    }
#undef PF2_LOAD
#undef PF2_LD1
#undef PF2_WR1
#undef PF2_WRITE
#undef PF2_COMPUTE
}

__device__ __forceinline__ void gemm_tile_n64(f32x16 (&acc)[2], const bf16_t* __restrict__ A, int lda, const bf16_t* __restrict__ Bt, int ldb, int K, unsigned char* smem) {
    const int tid = tid_opaque(), lane = tid & 63, wave = tid >> 6, wr = wave >> 1, wc = wave & 1;
    bf16_t* sA = (bf16_t*)smem;
    bf16_t* sB = sA + 2 * 128 * GS;
    const int lrow = tid >> 3, lch = (tid & 7) * 8;
    uint4 pa0, pa1, pa2, pa3, pb0, pb1, qa0, qa1, qa2, qa3, qb0, qb1;
    const bf16_t* Ap = A + (size_t)lrow * lda + lch;
    const bf16_t* Bp = Bt + (size_t)lrow * ldb + lch;
    const int nk = K >> 6;
#define N64_LOAD(RA, RB, kt_) { RA##0 = *(const uint4*)(Ap + (kt_) * 64); RA##1 = *(const uint4*)(Ap + (size_t)32 * lda + (kt_) * 64); RA##2 = *(const uint4*)(Ap + (size_t)64 * lda + (kt_) * 64); RA##3 = *(const uint4*)(Ap + (size_t)96 * lda + (kt_) * 64); \
        RB##0 = *(const uint4*)(Bp + (kt_) * 64); RB##1 = *(const uint4*)(Bp + (size_t)32 * ldb + (kt_) * 64); }
#define N64_WRITE(RA, RB, buf_) { bf16_t* wa = sA + (buf_) * 128 * GS + lrow * GS + lch; bf16_t* wb = sB + (buf_) * 64 * GS + lrow * GS + lch; \
        *(uint4*)wa = RA##0; *(uint4*)(wa + 32 * GS) = RA##1; *(uint4*)(wa + 64 * GS) = RA##2; *(uint4*)(wa + 96 * GS) = RA##3; *(uint4*)wb = RB##0; *(uint4*)(wb + 32 * GS) = RB##1; }
#define N64_COMPUTE(buf_) { const bf16_t* a = sA + (buf_) * 128 * GS + aoff; const bf16_t* b = sB + (buf_) * 64 * GS + boff; _Pragma("unroll") for (int ks = 0; ks < 4; ++ks) { \
        bf16x8 a0 = *(const bf16x8*)(a + ks * 16), a1 = *(const bf16x8*)(a + 32 * GS + ks * 16); bf16x8 b0 = *(const bf16x8*)(b + ks * 16); \
        acc[0] = __builtin_amdgcn_mfma_f32_32x32x16_bf16(a0, b0, acc[0], 0, 0, 0); acc[1] = __builtin_amdgcn_mfma_f32_32x32x16_bf16(a1, b0, acc[1], 0, 0, 0); } }
    const int aoff = (wr * 64 + (lane & 31)) * GS + (lane >> 5) * 8, boff = (wc * 32 + (lane & 31)) * GS + (lane >> 5) * 8;
    N64_LOAD(pa, pb, 0);
    N64_LOAD(qa, qb, 1);
    N64_WRITE(pa, pb, 0);
    __syncthreads();
    for (int kt = 0; kt < nk; kt += 2) {
        if (kt + 2 < nk) N64_LOAD(pa, pb, kt + 2);
        N64_COMPUTE(0);
        N64_WRITE(qa, qb, 1);
        __syncthreads();
        if (kt + 3 < nk) N64_LOAD(qa, qb, kt + 3);
        N64_COMPUTE(1);
        if (kt + 2 < nk) N64_WRITE(pa, pb, 0);
        __syncthreads();
    }
#undef N64_LOAD
#undef N64_WRITE
#undef N64_COMPUTE
}

__device__ __forceinline__ void gemm_pair_n64(f32x16 (&acc1)[2], f32x16 (&acc2)[2], const bf16_t* __restrict__ A1, int lda1, const bf16_t* __restrict__ B1, int ldb1, int K1,
                                              const bf16_t* __restrict__ A2, int lda2, const bf16_t* __restrict__ B2, int ldb2, int K2, unsigned char* smem) {
    const int tid = tid_opaque(), lane = tid & 63, wave = tid >> 6, wr = wave >> 1, wc = wave & 1;
    bf16_t* sA = (bf16_t*)smem;
    bf16_t* sB = sA + 2 * 128 * GS;
    const int lrow = tid >> 3, lch = (tid & 7) * 8;
    uint4 pa0, pa1, pa2, pa3, pb0, pb1, qa0, qa1, qa2, qa3, qb0, qb1;
    const bf16_t* Ap1 = A1 + (size_t)lrow * lda1 + lch; const bf16_t* Bp1 = B1 + (size_t)lrow * ldb1 + lch;
    const bf16_t* Ap2 = A2 + (size_t)lrow * lda2 + lch; const bf16_t* Bp2 = B2 + (size_t)lrow * ldb2 + lch;
    const int nk1 = K1 >> 6, nk = nk1 + (K2 >> 6);
#define P64_LOAD(RA, RB, kt_) { const bool s2_ = (kt_) >= nk1; const bf16_t* ap_ = s2_ ? Ap2 + ((kt_) - nk1) * 64 : Ap1 + (kt_) * 64; const bf16_t* bp_ = s2_ ? Bp2 + ((kt_) - nk1) * 64 : Bp1 + (kt_) * 64; \
        const size_t la_ = s2_ ? lda2 : lda1, lb_ = s2_ ? ldb2 : ldb1; \
        RA##0 = *(const uint4*)(ap_); RA##1 = *(const uint4*)(ap_ + 32 * la_); RA##2 = *(const uint4*)(ap_ + 64 * la_); RA##3 = *(const uint4*)(ap_ + 96 * la_); \
        RB##0 = *(const uint4*)(bp_); RB##1 = *(const uint4*)(bp_ + 32 * lb_); }
#define P64_WRITE(RA, RB, buf_) { bf16_t* wa = sA + (buf_) * 128 * GS + lrow * GS + lch; bf16_t* wb = sB + (buf_) * 64 * GS + lrow * GS + lch; \
        *(uint4*)wa = RA##0; *(uint4*)(wa + 32 * GS) = RA##1; *(uint4*)(wa + 64 * GS) = RA##2; *(uint4*)(wa + 96 * GS) = RA##3; *(uint4*)wb = RB##0; *(uint4*)(wb + 32 * GS) = RB##1; }
#define P64_COMPUTE(ACC, buf_) { const bf16_t* a = sA + (buf_) * 128 * GS + aoff; const bf16_t* b = sB + (buf_) * 64 * GS + boff; _Pragma("unroll") for (int ks = 0; ks < 4; ++ks) { \
        bf16x8 a0 = *(const bf16x8*)(a + ks * 16), a1 = *(const bf16x8*)(a + 32 * GS + ks * 16); bf16x8 b0 = *(const bf16x8*)(b + ks * 16); \
        ACC[0] = __builtin_amdgcn_mfma_f32_32x32x16_bf16(a0, b0, ACC[0], 0, 0, 0); ACC[1] = __builtin_amdgcn_mfma_f32_32x32x16_bf16(a1, b0, ACC[1], 0, 0, 0); } }
    const int aoff = (wr * 64 + (lane & 31)) * GS + (lane >> 5) * 8, boff = (wc * 32 + (lane & 31)) * GS + (lane >> 5) * 8;
    P64_LOAD(pa, pb, 0);
    P64_LOAD(qa, qb, 1);
    P64_WRITE(pa, pb, 0);
    __syncthreads();
    for (int kt = 0; kt < nk; kt += 2) {
        if (kt + 2 < nk) P64_LOAD(pa, pb, kt + 2);
        if (kt < nk1) P64_COMPUTE(acc1, 0) else P64_COMPUTE(acc2, 0)
        P64_WRITE(qa, qb, 1);
        __syncthreads();
        if (kt + 3 < nk) P64_LOAD(qa, qb, kt + 3);
        if (kt + 1 < nk1) P64_COMPUTE(acc1, 1) else P64_COMPUTE(acc2, 1)
        if (kt + 2 < nk) P64_WRITE(pa, pb, 0);
        __syncthreads();
    }
#undef P64_LOAD
#undef P64_WRITE
#undef P64_COMPUTE
}
__device__ __forceinline__ void zero_acc(f32x16 (&acc)[2][2]) {
#pragma unroll
    for (int i = 0; i < 2; ++i)
#pragma unroll
        for (int j = 0; j < 2; ++j)
#pragma unroll
            for (int r = 0; r < 16; ++r) acc[i][j][r] = 0.f;
}
#define ACC_ROW(mi, r) (wr * 64 + (mi) * 32 + ((r) & 3) + 8 * ((r) >> 2) + 4 * (lane >> 5))
#define ACC_COL(ni) (wc * 64 + (ni) * 32 + (lane & 31))

__device__ void tr_tile(const float* __restrict__ src, int K, int N, int kt, int nt, bf16_t* __restrict__ dst, const float* __restrict__ scale, float* s) {
    const int tid = tid_opaque(), r = tid >> 4, c4 = (tid & 15) * 4;
#pragma unroll
    for (int i = 0; i < 4; ++i) {
        const int k = kt * 64 + r + 16 * i;
        float4 v = *(const float4*)(src + (size_t)k * N + nt * 64 + c4);
        const float sc = scale ? scale[k] : 1.f;
        float* d = s + (r + 16 * i) * 65 + c4;
        d[0] = v.x * sc; d[1] = v.y * sc; d[2] = v.z * sc; d[3] = v.w * sc;
    }
    __syncthreads();
    const int n = tid >> 2, k0 = (tid & 3) * 16;
    float f[16];
#pragma unroll
    for (int j = 0; j < 16; ++j) f[j] = s[(k0 + j) * 65 + n];
    bf16_t* o = dst + (size_t)(nt * 64 + n) * K + kt * 64 + k0;
    *(uint4*)o = pack8(f);
    *(uint4*)(o + 8) = pack8(f + 8);
    __syncthreads();
}
__device__ void phase_prologue(const Params& P, int ph, unsigned char* smem) {
    float* s = (float*)smem;
    const int NTR = 7296, NMOD = 96;
    for (;;) {
        const int u = next_item(P, ph);
        if (u >= NTR + NMOD) break;
        if (u < NMOD) {
            const int l = u / 48, cb = u % 48, tid = threadIdx.x, lane = tid & 63, wave = tid >> 6;
            float* sc = s;
            float* red = s + 5 * 1024;
            for (int i = tid; i < 5 * 1024; i += 256) { const int r = i >> 10, k = i & 1023; const float v = (r < 4) ? P.c[r * 1024 + k] : P.c_ctx[k]; sc[i] = siluf_(v); }
            __syncthreads();
            const int col = cb * 64 + lane;
            float acc[5] = {0.f, 0.f, 0.f, 0.f, 0.f};
            const float* w = P.ada_w + (size_t)l * 1024 * 3072 + col;
#pragma unroll 8
            for (int k = wave * 256; k < wave * 256 + 256; ++k) {
                const float wv = w[(size_t)k * 3072];
#pragma unroll
                for (int r = 0; r < 5; ++r) acc[r] += sc[r * 1024 + k] * wv;
            }
#pragma unroll
            for (int r = 0; r < 5; ++r) red[(wave * 5 + r) * 64 + lane] = acc[r];
            __syncthreads();
            if (wave == 0) {
                float* mod = (float*)(P.ws + OFF_MOD);
#pragma unroll
                for (int r = 0; r < 5; ++r) mod[(l * 5 + r) * 3072 + col] = red[r * 64 + lane] + red[(5 + r) * 64 + lane] + red[(10 + r) * 64 + lane] + red[(15 + r) * 64 + lane] + P.ada_b[l * 3072 + col];
            }
            continue;
        }
        const int v = u - NMOD, l = v / 3648, r = v % 3648;
        if (r < 1776) tr_tile(P.w_in + (size_t)l * 1024 * INW, 1024, INW, r / 111, r % 111, (bf16_t*)(P.ws + OFF_WIN) + (size_t)l * 7168 * 1024, nullptr, s);
        else if (r < 2800) { const int r2 = r - 1776, br = r2 >> 8, t = r2 & 255; tr_tile(P.w_merge + (size_t)(l * 4 + br) * 1024 * 1024, 1024, 1024, t >> 4, t & 15, (bf16_t*)(P.ws + OFF_WM) + (size_t)(l * 4 + br) * 1024 * 1024, nullptr, s); }
        else if (r < 3312) { const int r2 = r - 2800, br = r2 >> 7, t = r2 & 127; tr_tile(P.w_br + (size_t)(l * 4 + br) * 512 * 1024, 512, 1024, t >> 4, t & 15, (bf16_t*)(P.ws + OFF_WBR) + (size_t)(l * 4 + br) * 1024 * 512, nullptr, s); }
        else if (r < 3568) { const int t = r - 3312; tr_tile(P.w_out + (size_t)l * 1024 * 1024, 1024, 1024, t >> 4, t & 15, (bf16_t*)(P.ws + OFF_WO) + (size_t)l * 1024 * 1024, nullptr, s); }
        else if (r < 3616) { const int t = r - 3568; tr_tile(P.w_uq + (size_t)l * 256 * 768, 256, 768, t / 12, t % 12, (bf16_t*)(P.ws + OFF_WUQ) + (size_t)l * 768 * 256, P.g_cq + l * 256, s); }
        else { const int t = r - 3616; tr_tile(P.w_ukv + (size_t)l * 128 * 1024, 128, 1024, t >> 4, t & 15, (bf16_t*)(P.ws + OFF_WUKV) + (size_t)l * 1024 * 128, P.g_ckv + l * 128, s); }
    }
}

__device__ void phase_norm(const Params& P, int ph, int l, int hf) {
    const int tid = tid_opaque(), lane = tid & 63, wave = tid >> 6;
    const float* mod = (const float*)(P.ws + OFF_MOD);
    bf16_t* H = (bf16_t*)(P.ws + OFF_H);
    for (;;) {
        const int u = next_item(P, ph);
        if (u >= NTH / 8) break;
        float4 v[2][4]; int mrr[2];
#pragma unroll
        for (int rr = 0; rr < 2; ++rr) {
            const int t = u * 8 + wave * 2 + rr, bl = t / TB, p = t % TB, b = hf * 2 + bl;
            const float* src;
            if (p < CTXL) { src = (l == 0 ? P.ctx : (const float*)(P.ws + OFF_CX1)) + ((size_t)b * CTXL + p) * D; mrr[rr] = 4; }
            else { src = (l == 0 ? P.x : (const float*)P.out) + ((size_t)b * SEQ + (p - CTXL)) * D; mrr[rr] = b; }
#pragma unroll
            for (int i = 0; i < 4; ++i) v[rr][i] = *(const float4*)(src + lane * 4 + 256 * i);
        }
#pragma unroll
        for (int rr = 0; rr < 2; ++rr) {
            const int t = u * 8 + wave * 2 + rr;
            float ss = 0.f;
#pragma unroll
            for (int i = 0; i < 4; ++i) ss += v[rr][i].x * v[rr][i].x + v[rr][i].y * v[rr][i].y + v[rr][i].z * v[rr][i].z + v[rr][i].w * v[rr][i].w;
            ss = wave_sum(ss);
            const float rstd = rsqrtf(ss * (1.f / D) + EPS);
            const float* sh = mod + (l * 5 + mrr[rr]) * 3072; const float* sc = sh + 1024; const float* g = P.norm_g + l * D;
#pragma unroll
            for (int i = 0; i < 4; ++i) {
                const int c = lane * 4 + 256 * i;
                const float4 gv = *(const float4*)(g + c), s1 = *(const float4*)(sc + c), s0 = *(const float4*)(sh + c);
                uint2 o;
                o.x = cvt_pk(v[rr][i].x * rstd * gv.x * (1.f + s1.x) + s0.x, v[rr][i].y * rstd * gv.y * (1.f + s1.y) + s0.y);
                o.y = cvt_pk(v[rr][i].z * rstd * gv.z * (1.f + s1.z) + s0.z, v[rr][i].w * rstd * gv.w * (1.f + s1.w) + s0.w);
                *(uint2*)(H + (size_t)t * D + c) = o;
            }
        }
    }
}

__device__ void phase_gemm1(const Params& P, int ph, int l, unsigned char* smem) {
    const int tid_ = tid_opaque(), lane = tid_ & 63, wave = tid_ >> 6, wr = wave >> 1, wc = wave & 1;
    const bf16_t* H = (const bf16_t*)(P.ws + OFF_H);
    const bf16_t* W = (const bf16_t*)(P.ws + OFF_WIN) + (size_t)l * 7168 * 1024;
    bf16_t* PB = (bf16_t*)(P.ws + OFF_PB);
    for (;;) {
        const int u = next_item(P, ph);
        if (u >= 132 * 56) break;
        const int mt = u / 56, nt = u % 56;
        f32x16 acc[2][2]; zero_acc(acc);
        gemm_tile_pf2(acc, H + (size_t)mt * 128 * D, D, W + (size_t)nt * 128 * D, D, D, smem);
#pragma unroll
        for (int mi = 0; mi < 2; ++mi)
#pragma unroll
            for (int ni = 0; ni < 2; ++ni) {
                const int col = nt * 128 + ACC_COL(ni);
                if (col < PW) {
#pragma unroll
                    for (int r = 0; r < 16; ++r) PB[(size_t)(mt * 128 + ACC_ROW(mi, r)) * PW + col] = f2bf(acc[mi][ni][r]);
                }
            }
    }
}

__device__ void phase_gemm2(const Params& P, int ph, int l, unsigned char* smem) {
    const int tid_ = tid_opaque(), lane = tid_ & 63, wave = tid_ >> 6, wr = wave >> 1, wc = wave & 1;
    const bf16_t* PB = (const bf16_t*)(P.ws + OFF_PB);
    for (;;) {
        const int u = next_item(P, ph);
        if (u >= 132 * 14) break;
        const int mt = u / 14, n14 = u % 14;
        f32x16 acc[2][2]; zero_acc(acc);
        bf16_t* O; int ldo, nt;
        if (n14 < 6) { nt = n14; O = (bf16_t*)(P.ws + OFF_QF); ldo = 768;
            gemm_tile_pf2(acc, PB + (size_t)mt * 128 * PW + C_CQ, PW, (const bf16_t*)(P.ws + OFF_WUQ) + (size_t)l * 768 * 256 + (size_t)nt * 128 * 256, 256, 256, smem); }
        else { nt = n14 - 6; O = (bf16_t*)(P.ws + OFF_KV); ldo = 1024;
            gemm_tile_pf2(acc, PB + (size_t)mt * 128 * PW + C_CKV, PW, (const bf16_t*)(P.ws + OFF_WUKV) + (size_t)l * 1024 * 128 + (size_t)nt * 128 * 128, 128, 128, smem); }
#pragma unroll
        for (int mi = 0; mi < 2; ++mi)
#pragma unroll
            for (int ni = 0; ni < 2; ++ni)
#pragma unroll
                for (int r = 0; r < 16; ++r) O[(size_t)(mt * 128 + ACC_ROW(mi, r)) * ldo + nt * 128 + ACC_COL(ni)] = f2bf(acc[mi][ni][r]);
    }
}

__device__ void phase_finalize(const Params& P, int ph, int l, unsigned char* smem) {
    const int tid = tid_opaque(), lane = tid & 63, wave = tid >> 6;
    bf16_t* PB = (bf16_t*)(P.ws + OFF_PB);
    bf16_t* QF = (bf16_t*)(P.ws + OFF_QF);
    const bf16_t* KV = (const bf16_t*)(P.ws + OFF_KV);
    bf16_t* KF = (bf16_t*)(P.ws + OFF_KF);
    bf16_t* VTM = (bf16_t*)(P.ws + OFF_VTM);
    bf16_t* VTN = (bf16_t*)(P.ws + OFF_VTN);
    float* rs = (float*)smem;
    const int hd = lane >> 3, j = lane & 7;
    const float invf = __powf(10000.f, -(float)j * 0.125f);
    for (;;) {
        const int u7 = next_item(P, ph);
        if (u7 >= (NTH / 32) * 11) break;
        const int u = u7 / 11, sub = u7 % 11;
        const int t0 = u * 32, bl = t0 / TB, p0 = t0 % TB;
        if (sub >= 1 && sub <= 4) {
        uint2 in_cq[2]; unsigned in_ckv[2]; bf16_t in_q[2][12], in_kv[2][8], in_kr[2][4]; uint4 in_nq[2], in_nk[2];
#pragma unroll
        for (int rr = 0; rr < 2; ++rr) {
            const int tl = (sub - 1) * 8 + wave * 2 + rr, t = t0 + tl;
            const bf16_t* prow = PB + (size_t)t * PW;
            in_cq[rr] = *(const uint2*)(prow + C_CQ + lane * 4);
            in_ckv[rr] = *(const unsigned*)(prow + C_CKV + lane * 2);
            const bf16_t* q = QF + (size_t)t * 768 + hd * 96;
            const bf16_t* kvr = KV + (size_t)t * 1024 + hd * 128;
#pragma unroll
            for (int m = 0; m < 12; ++m) in_q[rr][m] = q[j + 8 * m];
#pragma unroll
            for (int m = 0; m < 8; ++m) in_kv[rr][m] = kvr[j + 8 * m];
#pragma unroll
            for (int m = 0; m < 4; ++m) in_kr[rr][m] = prow[C_KR + j + 8 * m];
            in_nq[rr] = *(const uint4*)(prow + C_NQ + hd * 64 + j * 8);
            in_nk[rr] = *(const uint4*)(prow + C_NK + hd * 64 + j * 8);
        }
#pragma unroll
        for (int rr = 0; rr < 2; ++rr) {
            const int tl = (sub - 1) * 8 + wave * 2 + rr, t = t0 + tl, p = p0 + tl;
            bf16_t* prow = PB + (size_t)t * PW;
            float s1, s2;
            { const uint2 a = in_cq[rr]; const float f0 = lo16(a.x), f1 = hi16(a.x), f2 = lo16(a.y), f3 = hi16(a.y); s1 = f0 * f0 + f1 * f1 + f2 * f2 + f3 * f3;
              const unsigned b = in_ckv[rr]; const float g0 = lo16(b), g1 = hi16(b); s2 = g0 * g0 + g1 * g1; }
            s1 = wave_sum(s1); s2 = wave_sum(s2);
            const float rcq = rsqrtf(s1 * (1.f / 256.f) + EPS), rckv = rsqrtf(s2 * (1.f / 128.f) + EPS);
            {
                bf16_t* q = QF + (size_t)t * 768 + hd * 96;
                float v[12], ss = 0.f;
#pragma unroll
                for (int m = 0; m < 12; ++m) { v[m] = bf2f(in_q[rr][m]) * rcq; ss += v[m] * v[m]; }
                ss += __shfl_xor(ss, 1); ss += __shfl_xor(ss, 2); ss += __shfl_xor(ss, 4);
                const float rn = rsqrtf(ss * (1.f / 96.f) + EPS);
#pragma unroll
                for (int m = 0; m < 12; ++m) q[j + 8 * m] = f2bf(v[m] * rn * P.g_q[l * 96 + j + 8 * m] * (0.10206207261596575f * LOG2E));
            }
            {
                float v[12], ss = 0.f;
#pragma unroll
                for (int m = 0; m < 8; ++m) { v[m] = bf2f(in_kv[rr][m]) * rckv; ss += v[m] * v[m]; }
#pragma unroll
                for (int m = 8; m < 12; ++m) { v[m] = bf2f(in_kr[rr][m - 8]); ss += v[m] * v[m]; }
                ss += __shfl_xor(ss, 1); ss += __shfl_xor(ss, 2); ss += __shfl_xor(ss, 4);
                const float rn = rsqrtf(ss * (1.f / 96.f) + EPS);
#pragma unroll
                for (int m = 0; m < 12; ++m) v[m] = v[m] * rn * P.g_k[l * 96 + j + 8 * m];
                if (p >= CTXL) {
                    const int pos = p - CTXL;
                    const float ar = (float)(pos >> 6) * invf, ac = (float)(pos & 63) * invf;
                    double fr = (double)ar * 0.15915494309189535; fr -= rint(fr);
                    double fc = (double)ac * 0.15915494309189535; fc -= rint(fc);
                    const float sr = __builtin_amdgcn_sinf((float)fr), cr = __builtin_amdgcn_cosf((float)fr);
                    const float sc = __builtin_amdgcn_sinf((float)fc), cc = __builtin_amdgcn_cosf((float)fc);
                    const float x1a = v[8], x2a = v[10], x1b = v[9], x2b = v[11];
                    v[8] = x1a * cr - x2a * sr; v[10] = x1a * sr + x2a * cr;
                    v[9] = x1b * cc - x2b * sc; v[11] = x1b * sc + x2b * cc;
                }
                bf16_t* ko = KF + ((size_t)t * 8 + hd) * 96;
#pragma unroll
                for (int m = 0; m < 12; ++m) ko[j + 8 * m] = f2bf(v[m]);
            }
#pragma unroll
            for (int w = 0; w < 2; ++w) {
                bf16_t* q = prow + (w ? C_NK : C_NQ) + hd * 64 + j * 8;
                const float* g = (w ? P.ng_k : P.ng_q) + l * 64 + j * 8;
                float v[8], ss = 0.f;
                unpack8(w ? in_nk[rr] : in_nq[rr], v);
#pragma unroll
                for (int m = 0; m < 8; ++m) ss += v[m] * v[m];
                ss += __shfl_xor(ss, 1); ss += __shfl_xor(ss, 2); ss += __shfl_xor(ss, 4);
                const float rn = rsqrtf(ss * (1.f / 64.f) + EPS);
#pragma unroll
                for (int m = 0; m < 8; ++m) v[m] = v[m] * rn * g[m] * (w ? 1.f : 0.125f * LOG2E);
                *(uint4*)q = pack8(v);
            }
        }
        } else if (sub == 0) {
        {
            for (int rr = 0; rr < 8; ++rr) {
                const int tl = wave * 8 + rr;
                const unsigned bq = *(const unsigned*)(PB + (size_t)(t0 + tl) * PW + C_CKV + lane * 2);
                const float g0 = lo16(bq), g1 = hi16(bq);
                const float s2 = wave_sum(g0 * g0 + g1 * g1);
                if (lane == 0) rs[tl] = rsqrtf(s2 * (1.f / 128.f) + EPS);
            }
            __syncthreads();
            bf16_t* tile = (bf16_t*)(smem + 8192);
#pragma unroll
            for (int which = 0; which < 2; ++which) {
#pragma unroll
                for (int k8 = 0; k8 < 8; ++k8) {
                    const int id = tid + 256 * k8, i = id >> 6, c8 = id & 63;
                    const bf16_t* src = which ? PB + (size_t)(t0 + i) * PW + C_NV + c8 * 8
                                              : KV + (size_t)(t0 + i) * 1024 + (c8 >> 3) * 128 + 64 + (c8 & 7) * 8;
                    *(uint4*)(tile + i * 512 + c8 * 8) = *(const uint4*)src;
                }
                __syncthreads();
                bf16_t* VT = which ? VTN : VTM;
#pragma unroll
                for (int k8 = 0; k8 < 8; ++k8) {
                    const int id = tid + 256 * k8, r = id >> 2, g = id & 3;
                    float fv[8];
#pragma unroll
                    for (int i = 0; i < 8; ++i) fv[i] = bf2f(tile[(g * 8 + i) * 512 + r]) * (which ? 1.f : rs[g * 8 + i]);
                    *(uint4*)(VT + ((size_t)(bl * 8 + (r >> 6)) * 64 + (r & 63)) * TB + p0 + g * 8) = pack8(fv);
                }
                __syncthreads();
            }
        }
        } else
        {
            const int chunk = t0 >> 5;
            bf16_t* XH = (bf16_t*)(P.ws + OFF_XH);
            bf16_t* XG = (bf16_t*)(P.ws + OFF_XG);
            float* EBH = (float*)(P.ws + OFF_EBH);
            float* EBG = (float*)(P.ws + OFF_EBG);
            bf16_t* base = PB + (size_t)t0 * PW;
            float* rsh = (float*)smem + 256;
            bf16_t* inA = (bf16_t*)(smem + 8192);
            bf16_t* inB = inA + 32 * 128;
            bf16_t* inC = inB + 32 * 128;
            bf16_t* outT = inC + 32 * 128;
#pragma unroll
            for (int k4 = 0; k4 < 4; ++k4) { const int id = tid + 256 * k4, i = id >> 5, jx = id & 31; rsh[id] = bf2f(base[(size_t)i * PW + C_GR + jx]); }
            const int d = tid & 127, dr = tid >> 7;
            { const int grp = sub - 5;
                const bool isg = grp >= 4;
                const int gcol = isg ? (grp - 4) * 128 : grp * 128;
                const int cA = isg ? C_GQ + gcol : C_HQ + gcol, cB = isg ? C_GK + gcol : C_HF + gcol, cC = C_HF + 512 + gcol;
#pragma unroll
                for (int k2 = 0; k2 < 2; ++k2) {
                    const int id = tid + 256 * k2, i = id >> 4, ch = id & 15;
                    const bf16_t* row = base + (size_t)i * PW;
                    *(uint4*)(inA + i * 128 + ch * 8) = *(const uint4*)(row + cA + ch * 8);
                    *(uint4*)(inB + i * 128 + ch * 8) = *(const uint4*)(row + cB + ch * 8);
                    if (!isg) *(uint4*)(inC + i * 128 + ch * 8) = *(const uint4*)(row + cC + ch * 8);
                }
                __syncthreads();
                {
                    const int col = gcol + d;
                    float lb = 0.f, b2 = 0.f, w2[16];
#pragma unroll
                    for (int jx = 0; jx < 16; ++jx) w2[jx] = 0.f;
                    if (isg) {
#pragma unroll
                        for (int jx = 0; jx < 16; ++jx) w2[jx] = P.gla_w2[((size_t)(l * 2 + dr) * 16 + jx) * 256 + col];
                        b2 = P.gla_b2[(l * 2 + dr) * 256 + col];
                    } else if (l != 0) lb = sigmoidf_(P.lb_logits[1024 + dr * 512 + col] - P.lb_logits[dr * 512 + col]);
                    const bf16_t* fsrc = (dr && !isg) ? inC : inB;
                    bf16_t* oq = outT + (dr ? 2 : 0) * 32 * 128;
                    bf16_t* ok = oq + 32 * 128;
                    float cum = 0.f;
#pragma unroll 4
                    for (int sx = 0; sx < 32; ++sx) {
                        const int i = dr ? 31 - sx : sx;
                        const float qv = bf2f(inA[i * 128 + d]), fv = bf2f(fsrc[i * 128 + d]);
                        float qq, kk, la;
                        if (isg) {
                            float g = b2;
#pragma unroll
                            for (int jx = 0; jx < 16; ++jx) g = fmaf(rsh[i * 32 + dr * 16 + jx], w2[jx], g);
                            la = (fminf(g, 0.f) - __logf(1.f + __expf(-fabsf(g)))) * 0.0625f;
                            qq = qv * 0.125f; kk = fv;
                        } else {
                            const float av = lb + (1.f - lb) * sigmoidf_(fv);
                            la = __logf(av); kk = 1.f - av;
                            qq = siluf_(qv) * 0.08838834764831845f;
                        }
                        cum += la;
                        oq[i * 128 + d] = f2bf(qq * __expf(cum));
                        ok[i * 128 + d] = f2bf(kk * __expf(-cum));
                    }
                    if (isg) EBG[(size_t)(chunk * 2 + dr) * 256 + col] = __expf(cum);
                    else EBH[(size_t)(chunk * 2 + dr) * 512 + col] = __expf(cum);
                }
                __syncthreads();
#pragma unroll
                for (int k2 = 0; k2 < 2; ++k2) {
                    const int id = tid + 256 * k2, i = id >> 4, ch = id & 15;
                    bf16_t* row = base + (size_t)i * PW;
                    const uint4 v0 = *(const uint4*)(outT + (0 * 32 + i) * 128 + ch * 8), v1 = *(const uint4*)(outT + (1 * 32 + i) * 128 + ch * 8);
                    const uint4 v2 = *(const uint4*)(outT + (2 * 32 + i) * 128 + ch * 8), v3 = *(const uint4*)(outT + (3 * 32 + i) * 128 + ch * 8);
                    *(uint4*)(row + cA + ch * 8) = v0;
                    *(uint4*)(row + cB + ch * 8) = v1;
                    if (isg) { bf16_t* xr = XG + (size_t)(t0 + i) * 512 + gcol + ch * 8; *(uint4*)xr = v2; *(uint4*)(xr + 256) = v3; }
                    else { *(uint4*)(XH + (size_t)(t0 + i) * 512 + gcol + ch * 8) = v2; *(uint4*)(row + cC + ch * 8) = v3; }
                }
                __syncthreads();
            }
        }
    }
}

template <int DQK, bool NAT>
__device__ void attn_item(const Params& P, int l, int bl, int head, int qb, unsigned char* smem) {
    constexpr int NKS = DQK / 16, KSTR = DQK + 8, VSTR = 68, KCH = DQK / 8, KLD = (DQK * 64 / 8) / 256;
    const int tid = tid_opaque(), lane = tid & 63, wave = tid >> 6, hh = lane >> 5, r32 = lane & 31;
    bf16_t* Ks = (bf16_t*)smem;
    bf16_t* Vs = Ks + 2 * 64 * KSTR;
    float* rpb_s = (float*)(Vs + 2 * 64 * VSTR);
    bf16_t* PB = (bf16_t*)(P.ws + OFF_PB);
    const int rowbase = bl * TB, q_p0 = qb * 128, ql = wave * 32 + r32;
    const bool q_ctx = qb < 2;
    int lt0 = 0, lt1 = 0;
    int qr = 0, qc = 0, r0w = 0, c0 = 0;
    if (!q_ctx) {
        if (NAT) { const int rp = qb - 2, ra = 2 * rp, rb = ra + 1; lt0 = min(max(ra - 4, 0), 120); lt1 = min(max(rb - 4, 0), 120) + 8;
            qr = ra + (wave >> 1); qc = (wave & 1) * 32 + r32; r0w = min(max(qr - 4, 0), 120); c0 = min(max(qc - 8, 0), 48); }
        else { lt0 = 0; lt1 = 128; }
    }
    const int ntiles = 4 + (lt1 - lt0);
    const bf16_t* Kbase; const bf16_t* VT; const bf16_t* qptr; int k_ld;
    if (NAT) { Kbase = PB + (size_t)rowbase * PW + C_NK + head * 64; k_ld = PW; VT = (const bf16_t*)(P.ws + OFF_VTN) + (size_t)(bl * 8 + head) * 64 * TB;
        qptr = PB + (size_t)(rowbase + q_p0 + ql) * PW + C_NQ + head * 64; }
    else { Kbase = (const bf16_t*)(P.ws + OFF_KF) + (size_t)rowbase * 768 + head * 96; k_ld = 768; VT = (const bf16_t*)(P.ws + OFF_VTM) + (size_t)(bl * 8 + head) * 64 * TB;
        qptr = (const bf16_t*)(P.ws + OFF_QF) + (size_t)(rowbase + q_p0 + ql) * 768 + head * 96; }
    if (NAT) { for (int i = tid; i < 465; i += 256) rpb_s[i] = P.rpb[(size_t)(l * 8 + head) * 465 + i] * LOG2E; }
    bf16x8 qf[NKS];
#pragma unroll
    for (int ks = 0; ks < NKS; ++ks) qf[ks] = *(const bf16x8*)(qptr + ks * 16 + hh * 8);
    bf16x8 qrot4 = qf[NKS - 2], qrot5 = qf[NKS - 1];
    if (!NAT && !q_ctx) {
        const int pos = q_p0 - CTXL + ql;
        const float base = hh ? (float)(pos & 63) : (float)(pos >> 6);
#pragma unroll
        for (int jj = 0; jj < 8; ++jj) {
            const float invf = __powf(10000.f, -(float)jj * 0.125f);
            const float ang = base * invf;
            double fr = (double)ang * 0.15915494309189535; fr -= rint(fr);
            const float sn = __builtin_amdgcn_sinf((float)fr), cs = __builtin_amdgcn_cosf((float)fr);
            const float x1 = bf2f((bf16_t)qf[4][jj]), x2 = bf2f((bf16_t)qf[5][jj]);
            qrot4[jj] = (short)f2bf(x1 * cs - x2 * sn);
            qrot5[jj] = (short)f2bf(x1 * sn + x2 * cs);
        }
    }
    float m_run = -1e30f, lsum = 0.f;
    f32x16 oacc[2];
#pragma unroll
    for (int r = 0; r < 16; ++r) { oacc[0][r] = 0.f; oacc[1][r] = 0.f; }
    uint4 kreg0, kreg1, kreg2, vreg0, vreg1;
    kreg2 = make_uint4(0, 0, 0, 0);
    const int kid0 = tid, kid1 = tid + 256, kid2 = tid + 512;
    const int krow0 = kid0 / KCH, kch0 = kid0 % KCH, krow1 = kid1 / KCH, kch1 = kid1 % KCH, krow2 = kid2 / KCH, kch2 = kid2 % KCH;
    const int vrow0 = tid >> 3, vch = tid & 7, vrow1 = vrow0 + 32;
#define TILE_P(ti) ((ti) < 4 ? (ti) * 64 : CTXL + (lt0 + (ti) - 4) * 64)
#define GLOAD(ti) { const int p_ = TILE_P(ti); \
        kreg0 = *(const uint4*)(Kbase + (size_t)(p_ + krow0) * k_ld + kch0 * 8); \
        kreg1 = *(const uint4*)(Kbase + (size_t)(p_ + krow1) * k_ld + kch1 * 8); \
        if (KLD > 2) kreg2 = *(const uint4*)(Kbase + (size_t)(p_ + krow2) * k_ld + kch2 * 8); \
        vreg0 = *(const uint4*)(VT + (size_t)vrow0 * TB + p_ + vch * 8); \
        vreg1 = *(const uint4*)(VT + (size_t)vrow1 * TB + p_ + vch * 8); }
#define SWRITE(buf_) { bf16_t* kd_ = Ks + (buf_) * 64 * KSTR; \
        *(uint4*)(kd_ + krow0 * KSTR + kch0 * 8) = kreg0; *(uint4*)(kd_ + krow1 * KSTR + kch1 * 8) = kreg1; \
        if (KLD > 2) *(uint4*)(kd_ + krow2 * KSTR + kch2 * 8) = kreg2; \
        bf16_t* vd_ = Vs + (buf_) * 64 * VSTR + vch * 8; \
        *(uint2*)(vd_ + vrow0 * VSTR) = make_uint2(vreg0.x, vreg0.y); *(uint2*)(vd_ + vrow0 * VSTR + 4) = make_uint2(vreg0.z, vreg0.w); \
        *(uint2*)(vd_ + vrow1 * VSTR) = make_uint2(vreg1.x, vreg1.y); *(uint2*)(vd_ + vrow1 * VSTR + 4) = make_uint2(vreg1.z, vreg1.w); }
    GLOAD(0); SWRITE(0);
    __syncthreads();
    for (int ti = 0; ti < ntiles; ++ti) {
        const int buf = ti & 1;
        const bool more = ti + 1 < ntiles;
        if (more) GLOAD(ti + 1);
        if (!NAT && ti == 4) { qf[NKS - 2] = qrot4; qf[NKS - 1] = qrot5; }
        const int kr = lt0 + ti - 4;
        const bool active = !NAT || ti < 4 || (kr >= r0w && kr < r0w + 8);
        if (active) {
            const bf16_t* kb = Ks + buf * 64 * KSTR + r32 * KSTR + hh * 8;
            f32x16 st0, st1;
#pragma unroll
            for (int r = 0; r < 16; ++r) { st0[r] = 0.f; st1[r] = 0.f; }
            bf16x8 kf0[NKS], kf1[NKS];
#pragma unroll
            for (int ks = 0; ks < NKS; ++ks) { kf0[ks] = *(const bf16x8*)(kb + ks * 16); kf1[ks] = *(const bf16x8*)(kb + 32 * KSTR + ks * 16); }
            asm volatile("s_waitcnt lgkmcnt(0)" ::: "memory");
#pragma unroll
            for (int ks = 0; ks < NKS; ++ks) {
                st0 = __builtin_amdgcn_mfma_f32_32x32x16_bf16(kf0[ks], qf[ks], st0, 0, 0, 0);
                st1 = __builtin_amdgcn_mfma_f32_32x32x16_bf16(kf1[ks], qf[ks], st1, 0, 0, 0);
            }
            const bf16_t* vb = Vs + buf * 64 * VSTR + r32 * VSTR + 4 * hh;
            uint2 vfr[2][2][2][2];
#pragma unroll
            for (int uu = 0; uu < 2; ++uu)
#pragma unroll
                for (int t = 0; t < 2; ++t)
#pragma unroll
                    for (int s2 = 0; s2 < 2; ++s2) {
                        const bf16_t* a = vb + uu * 32 * VSTR + t * 32 + s2 * 16;
                        vfr[uu][t][s2][0] = *(const uint2*)a; vfr[uu][t][s2][1] = *(const uint2*)(a + 8);
                    }
            float x[32];
#pragma unroll
            for (int r = 0; r < 16; ++r) { x[r] = st0[r]; x[16 + r] = st1[r]; }
            if (NAT && ti >= 4) {
                const int dr = kr - qr + 7;
#pragma unroll
                for (int e = 0; e < 32; ++e) {
                    const int r = e & 15, kc = (e >> 4) * 32 + (r & 3) + 8 * (r >> 2) + 4 * hh;
                    const int dc = min(max(kc - qc, -15), 15) + 15;
                    const bool ok = (kc >= c0) && (kc < c0 + 16);
                    x[e] = ok ? x[e] + rpb_s[dr * 31 + dc] : -1e30f;
                }
            }
            float mx = x[0];
#pragma unroll
            for (int e = 1; e < 32; ++e) mx = fmaxf(mx, x[e]);
            mx = fmaxf(mx, __shfl_xor(mx, 32));
            const float m_new = fmaxf(m_run, mx);
            const bool resc = __ballot(m_new > m_run) != 0ull;
            const float alpha = __builtin_amdgcn_exp2f(m_run - m_new);
            m_run = m_new;
            float ps = 0.f;
#pragma unroll
            for (int e = 0; e < 32; ++e) { x[e] = __builtin_amdgcn_exp2f(x[e] - m_new); ps += x[e]; }
            lsum = lsum * alpha + ps;
            if (resc) {
#pragma unroll
                for (int r = 0; r < 16; ++r) { oacc[0][r] *= alpha; oacc[1][r] *= alpha; }
            }
            bf16x8 pf[2][2];
#pragma unroll
            for (int t = 0; t < 2; ++t)
#pragma unroll
                for (int s = 0; s < 2; ++s) {
                    union { bf16x8 v; unsigned u[4]; } cv;
#pragma unroll
                    for (int q = 0; q < 4; ++q) cv.u[q] = cvt_pk(x[16 * t + 8 * s + 2 * q], x[16 * t + 8 * s + 2 * q + 1]);
                    pf[t][s] = cv.v;
                }
#pragma unroll
            for (int uu = 0; uu < 2; ++uu)
#pragma unroll
                for (int t = 0; t < 2; ++t)
#pragma unroll
                    for (int s = 0; s < 2; ++s) {
                        union { bf16x8 v; uint2 h[2]; } cv;
                        cv.h[0] = vfr[uu][t][s][0]; cv.h[1] = vfr[uu][t][s][1];
                        oacc[uu] = __builtin_amdgcn_mfma_f32_32x32x16_bf16(cv.v, pf[t][s], oacc[uu], 0, 0, 0);
                    }
        }
        if (more) SWRITE((ti + 1) & 1);
        __syncthreads();
    }
#undef TILE_P
#undef GLOAD
#undef SWRITE
    lsum += __shfl_xor(lsum, 32);
    const float inv = 1.f / lsum;
    bf16_t* zrow = PB + (size_t)(rowbase + q_p0 + ql) * PW + C_Z + (NAT ? 512 : 0) + head * 64;
#pragma unroll
    for (int uu = 0; uu < 2; ++uu)
#pragma unroll
        for (int g = 0; g < 4; ++g) {
            bf16_t* zp = zrow + uu * 32 + 8 * g + 4 * hh;
            const uint2 z = *(const uint2*)zp;
            uint2 o;
            o.x = cvt_pk(oacc[uu][4 * g + 0] * inv * siluf_(lo16(z.x)), oacc[uu][4 * g + 1] * inv * siluf_(hi16(z.x)));
            o.y = cvt_pk(oacc[uu][4 * g + 2] * inv * siluf_(lo16(z.y)), oacc[uu][4 * g + 3] * inv * siluf_(hi16(z.y)));
            *(uint2*)zp = o;
        }
}

__device__ void scan_hg_item(const Params& P, int l, int item, unsigned char* smem) {
    const int tid = tid_opaque(), lane = tid & 63, wave = tid >> 6;
    const int slice = item & 7, dir = (item >> 3) & 1, head = (item >> 4) & 3, bl = item >> 6;
    float* a_s = (float*)smem;
    float* q_s = a_s + 64 * 128;
    float* v_s = q_s + 64 * 128;
    float* o_s = v_s + 64 * 16;
    const bf16_t* PB = (const bf16_t*)(P.ws + OFF_PB) + (size_t)bl * TB * PW;
    bf16_t* OS = (bf16_t*)(P.ws + OFF_KV) + ((size_t)dir * NTH + (size_t)bl * TB) * 512 + head * 128 + slice * 16;
    const int prow = tid >> 4, pd = (tid & 15) * 8;
    float lb[8];
#pragma unroll
    for (int e = 0; e < 8; ++e) {
        const int cidx = dir * 512 + head * 128 + pd + e;
        lb[e] = (l == 0) ? 0.f : sigmoidf_(P.lb_logits[1024 + cidx] - P.lb_logits[cidx]);
    }
    const int fcol = (dir ? C_HF + 512 : C_HF) + head * 128 + pd, qcol = C_HQ + head * 128 + pd, vcol = C_HI + head * 128 + slice * 16 + (tid & 1) * 8;
    uint4 rq[4], rf[4], rv;
    auto chunk_p = [&](int c) { const int ci = dir ? (c < 4 ? 3 - c : 135 - c) : c; return ci * 64; };
    auto gload = [&](int c) {
        const int p = chunk_p(c);
#pragma unroll
        for (int r = 0; r < 4; ++r) { const bf16_t* row = PB + (size_t)(p + prow + 16 * r) * PW; rq[r] = *(const uint4*)(row + qcol); rf[r] = *(const uint4*)(row + fcol); }
        if (tid < 128) rv = *(const uint4*)(PB + (size_t)(p + (tid >> 1)) * PW + vcol);
    };
    const int dg = lane & 15, col = wave * 4 + (lane >> 4);
    float S[8];
#pragma unroll
    for (int e = 0; e < 8; ++e) S[e] = 0.f;
    gload(0);
    for (int c = 0; c < 132; ++c) {
        __syncthreads();
#pragma unroll
        for (int r = 0; r < 4; ++r) {
            float fq[8], ff[8];
            unpack8(rq[r], fq); unpack8(rf[r], ff);
            float* ad = a_s + (prow + 16 * r) * 128 + pd; float* qd = q_s + (prow + 16 * r) * 128 + pd;
#pragma unroll
            for (int e = 0; e < 8; ++e) { ad[e] = lb[e] + (1.f - lb[e]) * sigmoidf_(ff[e]); qd[e] = siluf_(fq[e]) * 0.08838834764831845f; }
        }
        if (tid < 128) { float fv[8]; unpack8(rv, fv); float* vd = v_s + (tid >> 1) * 16 + (tid & 1) * 8;
#pragma unroll
            for (int e = 0; e < 8; ++e) vd[e] = fv[e]; }
        __syncthreads();
        if (c + 1 < 132) gload(c + 1);
        for (int tt = 0; tt < 64; tt += 8) {
            float op[8];
#pragma unroll
            for (int u = 0; u < 8; ++u) {
                const int i = dir ? 63 - (tt + u) : tt + u;
                const float4 a0 = *(const float4*)(a_s + i * 128 + dg * 8), a1 = *(const float4*)(a_s + i * 128 + dg * 8 + 4);
                const float4 q0 = *(const float4*)(q_s + i * 128 + dg * 8), q1 = *(const float4*)(q_s + i * 128 + dg * 8 + 4);
                const float v = v_s[i * 16 + col];
                float o;
                S[0] = fmaf(a0.x, S[0] - v, v); o = q0.x * S[0];
                S[1] = fmaf(a0.y, S[1] - v, v); o = fmaf(q0.y, S[1], o);
                S[2] = fmaf(a0.z, S[2] - v, v); o = fmaf(q0.z, S[2], o);
                S[3] = fmaf(a0.w, S[3] - v, v); o = fmaf(q0.w, S[3], o);
                S[4] = fmaf(a1.x, S[4] - v, v); o = fmaf(q1.x, S[4], o);
                S[5] = fmaf(a1.y, S[5] - v, v); o = fmaf(q1.y, S[5], o);
                S[6] = fmaf(a1.z, S[6] - v, v); o = fmaf(q1.z, S[6], o);
                S[7] = fmaf(a1.w, S[7] - v, v); o = fmaf(q1.w, S[7], o);
                op[u] = o;
            }
            float r4[4], r2[2];
            const bool b8 = dg & 8, b4 = dg & 4, b2 = dg & 2;
#pragma unroll
            for (int k = 0; k < 4; ++k) { const float snd = b8 ? op[k] : op[k + 4], kp = b8 ? op[k + 4] : op[k]; r4[k] = kp + __shfl_xor(snd, 8); }
#pragma unroll
            for (int k = 0; k < 2; ++k) { const float snd = b4 ? r4[k] : r4[k + 2], kp = b4 ? r4[k + 2] : r4[k]; r2[k] = kp + __shfl_xor(snd, 4); }
            float r1; { const float snd = b2 ? r2[0] : r2[1], kp = b2 ? r2[1] : r2[0]; r1 = kp + __shfl_xor(snd, 2); }
            r1 += __shfl_xor(r1, 1);
            if ((dg & 1) == 0) { const int tok = tt + (b8 ? 4 : 0) + (b4 ? 2 : 0) + (b2 ? 1 : 0); const int i = dir ? 63 - tok : tok; o_s[i * 16 + col] = r1; }
        }
        __syncthreads();
        if (tid < 128) {
            const int p = chunk_p(c) + (tid >> 1);
            *(uint4*)(OS + (size_t)p * 512 + (tid & 1) * 8) = pack8(o_s + (tid >> 1) * 16 + (tid & 1) * 8);
        }
    }
}

__device__ void scan_gla_item(const Params& P, int l, int item, unsigned char* smem) {
    const int tid = tid_opaque(), lane = tid & 63, wave = tid >> 6;
    const int slice = item & 3, dir = (item >> 2) & 1, head = (item >> 3) & 3, bl = item >> 5;
    float* a_s = (float*)smem;
    float* q_s = a_s + 64 * 64;
    float* k_s = q_s + 64 * 64;
    float* v_s = k_s + 64 * 64;
    float* o_s = v_s + 64 * 32;
    float* r_s = o_s + 64 * 32;
    const bf16_t* PB = (const bf16_t*)(P.ws + OFF_PB) + (size_t)bl * TB * PW;
    bf16_t* OS = (bf16_t*)(P.ws + OFF_OSG) + ((size_t)dir * NTH + (size_t)bl * TB) * 512 + head * 128 + slice * 32;
    const int gd = tid & 63, gt0 = tid >> 6;
    float w2[16];
#pragma unroll
    for (int jx = 0; jx < 16; ++jx) w2[jx] = P.gla_w2[((size_t)(l * 2 + dir) * 16 + jx) * 256 + head * 64 + gd];
    const float b2 = P.gla_b2[(l * 2 + dir) * 256 + head * 64 + gd];
    uint4 rq[2], rk[2], rv, rr;
    auto chunk_p = [&](int c) { const int ci = dir ? (c < 4 ? 3 - c : 135 - c) : c; return ci * 64; };
    auto gload = [&](int c) {
        const int p = chunk_p(c);
#pragma unroll
        for (int i = 0; i < 2; ++i) { const int id = tid + 256 * i, row = id >> 3, ch = id & 7; const bf16_t* rp = PB + (size_t)(p + row) * PW;
            rq[i] = *(const uint4*)(rp + C_GQ + head * 64 + ch * 8); rk[i] = *(const uint4*)(rp + C_GK + head * 64 + ch * 8); }
        { const int row = tid >> 2, ch = tid & 3; rv = *(const uint4*)(PB + (size_t)(p + row) * PW + C_GV + head * 128 + slice * 32 + ch * 8); }
        if (tid < 128) { const int row = tid >> 1, ch = tid & 1; rr = *(const uint4*)(PB + (size_t)(p + row) * PW + C_GR + dir * 16 + ch * 8); }
    };
    const int dg = lane & 7, col = wave * 8 + (lane >> 3);
    float S[8];
#pragma unroll
    for (int e = 0; e < 8; ++e) S[e] = 0.f;
    gload(0);
    for (int c = 0; c < 132; ++c) {
        __syncthreads();
#pragma unroll
        for (int i = 0; i < 2; ++i) { const int id = tid + 256 * i, row = id >> 3, ch = id & 7; float fq[8], fk[8]; unpack8(rq[i], fq); unpack8(rk[i], fk);
#pragma unroll
            for (int e = 0; e < 8; ++e) { q_s[row * 64 + ch * 8 + e] = fq[e] * 0.125f; k_s[row * 64 + ch * 8 + e] = fk[e]; } }
        { const int row = tid >> 2, ch = tid & 3; float fv[8]; unpack8(rv, fv);
#pragma unroll
            for (int e = 0; e < 8; ++e) v_s[row * 32 + ch * 8 + e] = fv[e]; }
        if (tid < 128) { const int row = tid >> 1, ch = tid & 1; float fr[8]; unpack8(rr, fr);
#pragma unroll
            for (int e = 0; e < 8; ++e) r_s[row * 16 + ch * 8 + e] = fr[e]; }
        __syncthreads();
        if (c + 1 < 132) gload(c + 1);
#pragma unroll 4
        for (int m = 0; m < 16; ++m) {
            const int i = gt0 + 4 * m;
            float g = b2;
#pragma unroll
            for (int jx = 0; jx < 16; ++jx) g = fmaf(r_s[i * 16 + jx], w2[jx], g);
            const float ls = fminf(g, 0.f) - __logf(1.f + __expf(-fabsf(g)));
            a_s[i * 64 + gd] = __expf(ls * 0.0625f);
        }
        __syncthreads();
        for (int tt = 0; tt < 64; tt += 8) {
            float op[8];
#pragma unroll
            for (int u = 0; u < 8; ++u) {
                const int i = dir ? 63 - (tt + u) : tt + u;
                const float4 a0 = *(const float4*)(a_s + i * 64 + dg * 8), a1 = *(const float4*)(a_s + i * 64 + dg * 8 + 4);
                const float4 q0 = *(const float4*)(q_s + i * 64 + dg * 8), q1 = *(const float4*)(q_s + i * 64 + dg * 8 + 4);
                const float4 k0 = *(const float4*)(k_s + i * 64 + dg * 8), k1 = *(const float4*)(k_s + i * 64 + dg * 8 + 4);
                const float v = v_s[i * 32 + col];
                float o;
                S[0] = fmaf(a0.x, S[0], k0.x * v); o = q0.x * S[0];
                S[1] = fmaf(a0.y, S[1], k0.y * v); o = fmaf(q0.y, S[1], o);
                S[2] = fmaf(a0.z, S[2], k0.z * v); o = fmaf(q0.z, S[2], o);
                S[3] = fmaf(a0.w, S[3], k0.w * v); o = fmaf(q0.w, S[3], o);
                S[4] = fmaf(a1.x, S[4], k1.x * v); o = fmaf(q1.x, S[4], o);
                S[5] = fmaf(a1.y, S[5], k1.y * v); o = fmaf(q1.y, S[5], o);
                S[6] = fmaf(a1.z, S[6], k1.z * v); o = fmaf(q1.z, S[6], o);
                S[7] = fmaf(a1.w, S[7], k1.w * v); o = fmaf(q1.w, S[7], o);
                op[u] = o;
            }
            float r4[4], r2[2];
            const bool b4 = dg & 4, b2 = dg & 2, b1 = dg & 1;
#pragma unroll
            for (int k = 0; k < 4; ++k) { const float snd = b4 ? op[k] : op[k + 4], kp = b4 ? op[k + 4] : op[k]; r4[k] = kp + __shfl_xor(snd, 4); }
#pragma unroll
            for (int k = 0; k < 2; ++k) { const float snd = b2 ? r4[k] : r4[k + 2], kp = b2 ? r4[k + 2] : r4[k]; r2[k] = kp + __shfl_xor(snd, 2); }
            float r1; { const float snd = b1 ? r2[0] : r2[1], kp = b1 ? r2[1] : r2[0]; r1 = kp + __shfl_xor(snd, 1); }
            { const int tok = tt + (b4 ? 4 : 0) + (b2 ? 2 : 0) + (b1 ? 1 : 0); const int i = dir ? 63 - tok : tok; o_s[i * 32 + col] = r1; }
        }
        __syncthreads();
        { const int row = tid >> 2, ch = tid & 3; const int p = chunk_p(c) + row;
          *(uint4*)(OS + (size_t)p * 512 + ch * 8) = pack8(o_s + row * 32 + ch * 8); }
    }
}


template <bool GLA>
__device__ void scan2_item(const Params& P, int l, int item, unsigned char* smem) {
    constexpr int DK = GLA ? 64 : 128, NT = DK / 32, QS = DK + 8, TS = 40, NSEG = GLA ? 4 : 2, TPS = 32 / NSEG, QCH = DK / 8;
    const int tid = tid_opaque(), lane = tid & 63, wave = tid >> 6, r32 = lane & 31, hh = lane >> 5;
    const int dir = item & 1, head = (item >> 1) & 3, bl = item >> 3;
    bf16_t* Qh = (bf16_t*)smem;
    bf16_t* Kh = Qh + 32 * QS;
    bf16_t* Kt = Kh + 32 * QS;
    bf16_t* Vt = Kt + DK * TS;
    float* eb = (float*)(Vt + 128 * TS);
    float* tot = eb + DK;
    bf16_t* qraw = (bf16_t*)(tot + 4 * DK);
    bf16_t* fraw = qraw + 32 * DK;
    bf16_t* vraw = fraw + 32 * DK;
    bf16_t* rraw = vraw + 32 * 128;
    const bf16_t* PB = (const bf16_t*)(P.ws + OFF_PB) + (size_t)bl * TB * PW;
    bf16_t* OS = (bf16_t*)(P.ws + (GLA ? OFF_OSG : OFF_KV)) + ((size_t)dir * NTH + (size_t)bl * TB) * 512 + head * 128 + wave * 32;
    const int qcol = (GLA ? C_GQ : C_HQ) + head * DK, fcol = GLA ? (C_GK + head * 64) : ((dir ? C_HF + 512 : C_HF) + head * 128),
              vcol = (GLA ? C_GV : C_HI) + head * 128, rcol = C_GR + dir * 16;
    const int pd = tid & (DK - 1), seg = tid / DK;
    float lbv = 0.f, b2 = 0.f, w2[16];
#pragma unroll
    for (int jx = 0; jx < 16; ++jx) w2[jx] = 0.f;
    if (GLA) {
#pragma unroll
        for (int jx = 0; jx < 16; ++jx) w2[jx] = P.gla_w2[((size_t)(l * 2 + dir) * 16 + jx) * 256 + head * 64 + pd];
        b2 = P.gla_b2[(l * 2 + dir) * 256 + head * 64 + pd];
    } else if (l != 0) { const int cidx = dir * 512 + head * 128 + pd; lbv = sigmoidf_(P.lb_logits[1024 + cidx] - P.lb_logits[cidx]); }
    uint4 pq0, pq1, pf0, pf1, pv0, pv1, pr;
    pq1 = pf1 = pr = make_uint4(0, 0, 0, 0);
#define CH_P0(c) (dir ? ((c) < 8 ? (7 - (c)) * 32 : CTXL + (263 - (c)) * 32) : (c) * 32)
#define ROWP(p0_, i_) ((p0_) + (dir ? 31 - (i_) : (i_)))
#define SC_GLOAD(c) { const int p0_ = CH_P0(c); \
        { const int id = tid, i = id / QCH, ch = id % QCH; const bf16_t* rp = PB + (size_t)ROWP(p0_, i) * PW; pq0 = *(const uint4*)(rp + qcol + ch * 8); pf0 = *(const uint4*)(rp + fcol + ch * 8); } \
        if (!GLA) { const int id = tid + 256, i = id / QCH, ch = id % QCH; const bf16_t* rp = PB + (size_t)ROWP(p0_, i) * PW; pq1 = *(const uint4*)(rp + qcol + ch * 8); pf1 = *(const uint4*)(rp + fcol + ch * 8); } \
        { const int i = tid >> 4, ch = tid & 15; pv0 = *(const uint4*)(PB + (size_t)ROWP(p0_, i) * PW + vcol + ch * 8); pv1 = *(const uint4*)(PB + (size_t)ROWP(p0_, i + 16) * PW + vcol + ch * 8); } \
        if (GLA && tid < 64) { const int i = tid >> 1, ch = tid & 1; pr = *(const uint4*)(PB + (size_t)ROWP(p0_, i) * PW + rcol + ch * 8); } }
    f32x16 ST[NT];
#pragma unroll
    for (int T = 0; T < NT; ++T)
#pragma unroll
        for (int r = 0; r < 16; ++r) ST[T][r] = 0.f;
    SC_GLOAD(0);
    for (int c = 0; c < 264; ++c) {
        __syncthreads();
        { const int id = tid, i = id / QCH, ch = id % QCH; *(uint4*)(qraw + i * DK + ch * 8) = pq0; *(uint4*)(fraw + i * DK + ch * 8) = pf0; }
        if (!GLA) { const int id = tid + 256, i = id / QCH, ch = id % QCH; *(uint4*)(qraw + i * DK + ch * 8) = pq1; *(uint4*)(fraw + i * DK + ch * 8) = pf1; }
        { const int i = tid >> 4, ch = tid & 15; *(uint4*)(vraw + i * 128 + ch * 8) = pv0; *(uint4*)(vraw + (i + 16) * 128 + ch * 8) = pv1; }
        if (GLA && tid < 64) { const int i = tid >> 1, ch = tid & 1; *(uint4*)(rraw + i * 16 + ch * 8) = pr; }
        __syncthreads();
        if (c + 1 < 264) SC_GLOAD(c + 1);
        float bl_[TPS], kk[TPS], qq[TPS];
        float cum = 0.f;
#pragma unroll
        for (int tt = 0; tt < TPS; ++tt) {
            const int i = seg * TPS + tt;
            float la;
            if (GLA) {
                float g = b2;
#pragma unroll
                for (int jx = 0; jx < 16; ++jx) g = fmaf(bf2f(rraw[i * 16 + jx]), w2[jx], g);
                la = (fminf(g, 0.f) - __logf(1.f + __expf(-fabsf(g)))) * 0.0625f;
                kk[tt] = bf2f(fraw[i * DK + pd]);
                qq[tt] = bf2f(qraw[i * DK + pd]) * 0.125f;
            } else {
                const float f = bf2f(fraw[i * DK + pd]);
                const float a = lbv + (1.f - lbv) * sigmoidf_(f);
                la = __logf(a);
                kk[tt] = 1.f - a;
                qq[tt] = siluf_(bf2f(qraw[i * DK + pd])) * 0.08838834764831845f;
            }
            cum += la;
            bl_[tt] = cum;
        }
        tot[seg * DK + pd] = cum;
        __syncthreads();
        {
            float off = 0.f, bend = 0.f;
#pragma unroll
            for (int sg = 0; sg < NSEG; ++sg) { const float tv = tot[sg * DK + pd]; bend += tv; if (sg < seg) off += tv; }
            const float eend = __expf(bend);
            if (seg == 0) eb[pd] = eend;
            float kt[TPS];
#pragma unroll
            for (int tt = 0; tt < TPS; ++tt) {
                const int i = seg * TPS + tt;
                const float b = bl_[tt] + off;
                const float e1 = __expf(b), e2 = __expf(-b);
                const float kh = kk[tt] * e2;
                Qh[i * QS + pd] = f2bf(qq[tt] * e1);
                Kh[i * QS + pd] = f2bf(kh);
                kt[tt] = kh * eend;
            }
#pragma unroll
            for (int g8 = 0; g8 < TPS / 8; ++g8) *(uint4*)(Kt + pd * TS + seg * TPS + g8 * 8) = pack8(kt + g8 * 8);
            const int vc = tid & 127, vs = tid >> 7;
            float vv[16];
#pragma unroll
            for (int tt = 0; tt < 16; ++tt) vv[tt] = bf2f(vraw[(vs * 16 + tt) * 128 + vc]);
            *(uint4*)(Vt + vc * TS + vs * 16) = pack8(vv);
            *(uint4*)(Vt + vc * TS + vs * 16 + 8) = pack8(vv + 8);
        }
        __syncthreads();
        f32x16 st;
#pragma unroll
        for (int r = 0; r < 16; ++r) st[r] = 0.f;
#pragma unroll
        for (int ks = 0; ks < DK / 16; ++ks) {
            const bf16x8 ka = *(const bf16x8*)(Kh + r32 * QS + ks * 16 + hh * 8);
            const bf16x8 qb = *(const bf16x8*)(Qh + r32 * QS + ks * 16 + hh * 8);
            st = __builtin_amdgcn_mfma_f32_32x32x16_bf16(ka, qb, st, 0, 0, 0);
        }
        bf16x8 pfr[2];
#pragma unroll
        for (int sI = 0; sI < 2; ++sI) {
            union { bf16x8 v; unsigned u[4]; } cv;
#pragma unroll
            for (int q = 0; q < 4; ++q) {
                const int ra = 8 * sI + 2 * q, rb = ra + 1;
                const int ja = (ra & 3) + 8 * (ra >> 2) + 4 * hh, jb = (rb & 3) + 8 * (rb >> 2) + 4 * hh;
                cv.u[q] = cvt_pk(ja <= r32 ? st[ra] : 0.f, jb <= r32 ? st[rb] : 0.f);
            }
            pfr[sI] = cv.v;
        }
        f32x16 oT;
#pragma unroll
        for (int r = 0; r < 16; ++r) oT[r] = 0.f;
#pragma unroll
        for (int sI = 0; sI < 2; ++sI) {
            const bf16_t* a = Vt + (wave * 32 + r32) * TS + sI * 16 + 4 * hh;
            union { bf16x8 v; uint2 h[2]; } cv;
            cv.h[0] = *(const uint2*)a; cv.h[1] = *(const uint2*)(a + 8);
            oT = __builtin_amdgcn_mfma_f32_32x32x16_bf16(cv.v, pfr[sI], oT, 0, 0, 0);
        }
#pragma unroll
        for (int T = 0; T < NT; ++T)
#pragma unroll
            for (int sI = 0; sI < 2; ++sI) {
                union { bf16x8 v; unsigned u[4]; } ca;
#pragma unroll
                for (int q = 0; q < 4; ++q) ca.u[q] = cvt_pk(ST[T][8 * sI + 2 * q], ST[T][8 * sI + 2 * q + 1]);
                const bf16_t* b = Qh + r32 * QS + T * 32 + sI * 16 + 4 * hh;
                union { bf16x8 v; uint2 h[2]; } cb;
                cb.h[0] = *(const uint2*)b; cb.h[1] = *(const uint2*)(b + 8);
                oT = __builtin_amdgcn_mfma_f32_32x32x16_bf16(ca.v, cb.v, oT, 0, 0, 0);
            }
#pragma unroll
        for (int T = 0; T < NT; ++T) {
#pragma unroll
            for (int g = 0; g < 4; ++g) {
                const float4 e4 = *(const float4*)(eb + T * 32 + 8 * g + 4 * hh);
                ST[T][4 * g + 0] *= e4.x; ST[T][4 * g + 1] *= e4.y; ST[T][4 * g + 2] *= e4.z; ST[T][4 * g + 3] *= e4.w;
            }
#pragma unroll
            for (int ks = 0; ks < 2; ++ks) {
                const bf16x8 ka = *(const bf16x8*)(Kt + (T * 32 + r32) * TS + ks * 16 + hh * 8);
                const bf16x8 vb = *(const bf16x8*)(Vt + (wave * 32 + r32) * TS + ks * 16 + hh * 8);
                ST[T] = __builtin_amdgcn_mfma_f32_32x32x16_bf16(ka, vb, ST[T], 0, 0, 0);
            }
        }
        {
            const int p = ROWP(CH_P0(c), r32);
            bf16_t* op = OS + (size_t)p * 512 + 4 * hh;
#pragma unroll
            for (int g = 0; g < 4; ++g) { uint2 o; o.x = cvt_pk(oT[4 * g], oT[4 * g + 1]); o.y = cvt_pk(oT[4 * g + 2], oT[4 * g + 3]); *(uint2*)(op + 8 * g) = o; }
        }
    }
#undef CH_P0
#undef ROWP
#undef SC_GLOAD
}


template <bool GLA>
__device__ void scan3_item(const Params& P, int l, int item, unsigned char* smem) {
    constexpr int DK = GLA ? 64 : 128, NT = DK / 32, QS = DK + 8, TS = 40, NSEG = GLA ? 4 : 2, TPS = 32 / NSEG, QCH = DK / 8;
    const int tid = tid_opaque(), lane = tid & 63, wave = tid >> 6, r32 = lane & 31, hh = lane >> 5;
    const int dir = item & 1, head = (item >> 1) & 3, bl = item >> 3;
    __builtin_amdgcn_s_setprio(3);
    bf16_t* Qh = (bf16_t*)smem;
    bf16_t* Kh = Qh + 32 * QS;
    bf16_t* Kt = Kh + 32 * QS;
    bf16_t* Vt = Kt + DK * TS;
    float* eb = (float*)(Vt + 128 * TS);
    bf16_t* vraw = (bf16_t*)(eb + DK);
    const bf16_t* PB = (const bf16_t*)(P.ws + OFF_PB) + (size_t)bl * TB * PW;
    bf16_t* OS = (bf16_t*)(P.ws + (GLA ? OFF_OSG : OFF_KV)) + ((size_t)dir * NTH + (size_t)bl * TB) * 512 + head * 128 + wave * 32;
    const bf16_t* qsrc; const bf16_t* ksrc; int qld, kld;
    if (GLA) {
        if (dir == 0) { qsrc = PB + C_GQ + head * 64; qld = PW; ksrc = PB + C_GK + head * 64; kld = PW; }
        else { const bf16_t* X = (const bf16_t*)(P.ws + OFF_XG) + (size_t)bl * TB * 512; qsrc = X + head * 64; qld = 512; ksrc = X + 256 + head * 64; kld = 512; }
    } else {
        if (dir == 0) { qsrc = PB + C_HQ + head * 128; qld = PW; ksrc = PB + C_HF + head * 128; kld = PW; }
        else { qsrc = (const bf16_t*)(P.ws + OFF_XH) + (size_t)bl * TB * 512 + head * 128; qld = 512; ksrc = PB + C_HF + 512 + head * 128; kld = PW; }
    }
    const float* ebsrc = (const float*)(P.ws + (GLA ? OFF_EBG : OFF_EBH)) + ((size_t)(bl * 264) * 2 + dir) * (4 * DK) + head * DK;
    const int vcol = (GLA ? C_GV : C_HI) + head * 128;
    const int pd = tid & (DK - 1), seg = tid / DK;
    uint4 pq0, pq1, pk0, pk1, pv0, pv1; float pe = 0.f;
    pq1 = pk1 = make_uint4(0, 0, 0, 0);
#define CH_P0(c) (dir ? ((c) < 8 ? (7 - (c)) * 32 : CTXL + (263 - (c)) * 32) : (c) * 32)
#define ROWP(p0_, i_) ((p0_) + (dir ? 31 - (i_) : (i_)))
#define SC_GLOAD(c) { const int p0_ = CH_P0(c); \
        { const int id = tid, i = id / QCH, ch = id % QCH; const size_t rr_ = (size_t)ROWP(p0_, i); pq0 = *(const uint4*)(qsrc + rr_ * qld + ch * 8); pk0 = *(const uint4*)(ksrc + rr_ * kld + ch * 8); } \
        if (!GLA) { const int id = tid + 256, i = id / QCH, ch = id % QCH; const size_t rr_ = (size_t)ROWP(p0_, i); pq1 = *(const uint4*)(qsrc + rr_ * qld + ch * 8); pk1 = *(const uint4*)(ksrc + rr_ * kld + ch * 8); } \
        { const int i = tid >> 4, ch = tid & 15; pv0 = *(const uint4*)(PB + (size_t)ROWP(p0_, i) * PW + vcol + ch * 8); pv1 = *(const uint4*)(PB + (size_t)ROWP(p0_, i + 16) * PW + vcol + ch * 8); } \
        if (tid < DK) pe = ebsrc[(size_t)(p0_ >> 5) * 2 * (4 * DK) + tid]; }
    f32x16 ST[NT];
#pragma unroll
    for (int T = 0; T < NT; ++T)
#pragma unroll
        for (int r = 0; r < 16; ++r) ST[T][r] = 0.f;
    SC_GLOAD(0);
    for (int c = 0; c < 264; ++c) {
        __syncthreads();
        { const int id = tid, i = id / QCH, ch = id % QCH; *(uint4*)(Qh + i * QS + ch * 8) = pq0; *(uint4*)(Kh + i * QS + ch * 8) = pk0; }
        if (!GLA) { const int id = tid + 256, i = id / QCH, ch = id % QCH; *(uint4*)(Qh + i * QS + ch * 8) = pq1; *(uint4*)(Kh + i * QS + ch * 8) = pk1; }
        { const int i = tid >> 4, ch = tid & 15; *(uint4*)(vraw + i * 128 + ch * 8) = pv0; *(uint4*)(vraw + (i + 16) * 128 + ch * 8) = pv1; }
        if (tid < DK) eb[tid] = pe;
        __syncthreads();
        if (c + 1 < 264) SC_GLOAD(c + 1);
        {
            const float eend = eb[pd];
            float kt[TPS];
#pragma unroll
            for (int tt = 0; tt < TPS; ++tt) kt[tt] = bf2f(Kh[(seg * TPS + tt) * QS + pd]) * eend;
#pragma unroll
            for (int g8 = 0; g8 < TPS / 8; ++g8) *(uint4*)(Kt + pd * TS + seg * TPS + g8 * 8) = pack8(kt + g8 * 8);
            const int vc = tid & 127, vs = tid >> 7;
            float vv[16];
#pragma unroll
            for (int tt = 0; tt < 16; ++tt) vv[tt] = bf2f(vraw[(vs * 16 + tt) * 128 + vc]);
            *(uint4*)(Vt + vc * TS + vs * 16) = pack8(vv);
            *(uint4*)(Vt + vc * TS + vs * 16 + 8) = pack8(vv + 8);
        }
        __syncthreads();
        f32x16 st, stb;
#pragma unroll
        for (int r = 0; r < 16; ++r) { st[r] = 0.f; stb[r] = 0.f; }
        {
            bf16x8 ka[DK / 16], qb[DK / 16];
#pragma unroll
            for (int ks = 0; ks < DK / 16; ++ks) { ka[ks] = *(const bf16x8*)(Kh + r32 * QS + ks * 16 + hh * 8); qb[ks] = *(const bf16x8*)(Qh + r32 * QS + ks * 16 + hh * 8); }
            asm volatile("s_waitcnt lgkmcnt(0)" ::: "memory");
#pragma unroll
            for (int ks = 0; ks < DK / 16; ks += 2) {
                st = __builtin_amdgcn_mfma_f32_32x32x16_bf16(ka[ks], qb[ks], st, 0, 0, 0);
                stb = __builtin_amdgcn_mfma_f32_32x32x16_bf16(ka[ks + 1], qb[ks + 1], stb, 0, 0, 0);
            }
        }
        uint2 vp[2][2], qp[NT][2][2];
#pragma unroll
        for (int sI = 0; sI < 2; ++sI) { const bf16_t* av = Vt + (wave * 32 + r32) * TS + sI * 16 + 4 * hh; vp[sI][0] = *(const uint2*)av; vp[sI][1] = *(const uint2*)(av + 8); }
#pragma unroll
        for (int T = 0; T < NT; ++T)
#pragma unroll
            for (int sI = 0; sI < 2; ++sI) { const bf16_t* bq = Qh + r32 * QS + T * 32 + sI * 16 + 4 * hh; qp[T][sI][0] = *(const uint2*)bq; qp[T][sI][1] = *(const uint2*)(bq + 8); }
#pragma unroll
        for (int r = 0; r < 16; ++r) st[r] += stb[r];
        bf16x8 pfr[2];
#pragma unroll
        for (int sI = 0; sI < 2; ++sI) {
            union { bf16x8 v; unsigned u[4]; } cv;
#pragma unroll
            for (int q = 0; q < 4; ++q) {
                const int ra = 8 * sI + 2 * q, rb = ra + 1;
                const int ja = (ra & 3) + 8 * (ra >> 2) + 4 * hh, jb = (rb & 3) + 8 * (rb >> 2) + 4 * hh;
                cv.u[q] = cvt_pk(ja <= r32 ? st[ra] : 0.f, jb <= r32 ? st[rb] : 0.f);
            }
            pfr[sI] = cv.v;
        }
        asm volatile("s_waitcnt lgkmcnt(0)" ::: "memory");
        f32x16 oT, oTb;
#pragma unroll
        for (int r = 0; r < 16; ++r) { oT[r] = 0.f; oTb[r] = 0.f; }
#pragma unroll
        for (int sI = 0; sI < 2; ++sI) {
            union { bf16x8 v; uint2 h[2]; } cv;
            cv.h[0] = vp[sI][0]; cv.h[1] = vp[sI][1];
            oT = __builtin_amdgcn_mfma_f32_32x32x16_bf16(cv.v, pfr[sI], oT, 0, 0, 0);
        }
#pragma unroll
        for (int T = 0; T < NT; ++T)
#pragma unroll
            for (int sI = 0; sI < 2; ++sI) {
                union { bf16x8 v; unsigned u[4]; } ca;
#pragma unroll
                for (int q = 0; q < 4; ++q) ca.u[q] = cvt_pk(ST[T][8 * sI + 2 * q], ST[T][8 * sI + 2 * q + 1]);
                union { bf16x8 v; uint2 h[2]; } cb;
                cb.h[0] = qp[T][sI][0]; cb.h[1] = qp[T][sI][1];
                if (T & 1) oTb = __builtin_amdgcn_mfma_f32_32x32x16_bf16(ca.v, cb.v, oTb, 0, 0, 0);
                else oT = __builtin_amdgcn_mfma_f32_32x32x16_bf16(ca.v, cb.v, oT, 0, 0, 0);
            }
        {
            bf16x8 kt2[NT][2], vb2[2];
            float4 e4v[NT][4];
#pragma unroll
            for (int ks = 0; ks < 2; ++ks) vb2[ks] = *(const bf16x8*)(Vt + (wave * 32 + r32) * TS + ks * 16 + hh * 8);
#pragma unroll
            for (int T = 0; T < NT; ++T) {
#pragma unroll
                for (int ks = 0; ks < 2; ++ks) kt2[T][ks] = *(const bf16x8*)(Kt + (T * 32 + r32) * TS + ks * 16 + hh * 8);
#pragma unroll
                for (int g = 0; g < 4; ++g) e4v[T][g] = *(const float4*)(eb + T * 32 + 8 * g + 4 * hh);
            }
            asm volatile("s_waitcnt lgkmcnt(0)" ::: "memory");
#pragma unroll
            for (int T = 0; T < NT; ++T) {
#pragma unroll
                for (int g = 0; g < 4; ++g) { ST[T][4 * g + 0] *= e4v[T][g].x; ST[T][4 * g + 1] *= e4v[T][g].y; ST[T][4 * g + 2] *= e4v[T][g].z; ST[T][4 * g + 3] *= e4v[T][g].w; }
#pragma unroll
                for (int ks = 0; ks < 2; ++ks) ST[T] = __builtin_amdgcn_mfma_f32_32x32x16_bf16(kt2[T][ks], vb2[ks], ST[T], 0, 0, 0);
            }
        }
#pragma unroll
        for (int r = 0; r < 16; ++r) oT[r] += oTb[r];
        {
            const int p = ROWP(CH_P0(c), r32);
            bf16_t* op = OS + (size_t)p * 512 + 4 * hh;
#pragma unroll
            for (int g = 0; g < 4; ++g) { uint2 o; o.x = cvt_pk(oT[4 * g], oT[4 * g + 1]); o.y = cvt_pk(oT[4 * g + 2], oT[4 * g + 3]); *(uint2*)(op + 8 * g) = o; }
        }
    }
#undef CH_P0
#undef ROWP
#undef SC_GLOAD
    __builtin_amdgcn_s_setprio(0);
}

#ifdef ONLYI
#define IT_ON(n) (ONLYI == (n))
#else
#define IT_ON(n) true
#endif
__device__ void phase_mixers(const Params& P, int ph, int l, unsigned char* smem, int mode = 0) {
    constexpr int N_HG = 16, N_GLA = 16, N_ATT = 2 * 8 * 66;
    const int bx = blockIdx.x;
    int my_scan = -1;
    if (mode != 2 && bx < 256 && (bx & 7) == ((bx >> 3) & 7)) my_scan = bx >> 3;
    if (mode == 0 && bx >= 256 && ((bx - 256) & 7) == (((bx - 256) >> 3) & 7)) return;
    for (;;) {
        int it;
        if (my_scan >= 0) { it = my_scan; my_scan = -1; }
        else {
            if (mode == 1) break;
            it = next_item(P, ph) + N_HG + N_GLA;
        }
        if (it >= N_HG + N_GLA + 2 * N_ATT) break;
        if (it < N_HG) { if (IT_ON(0)) scan3_item<false>(P, l, it, smem); continue; }
        it -= N_HG;
        if (it < N_GLA) { if (IT_ON(1)) scan3_item<true>(P, l, it, smem); continue; }
        it -= N_GLA;
        if (it < N_ATT) { const int bl = it / 528, rem = it % 528; if (IT_ON(2)) attn_item<96, false>(P, l, bl, rem / 66, rem % 66, smem); continue; }
        it -= N_ATT;
        { const int bl = it / 528, rem = it % 528; if (IT_ON(3)) attn_item<64, true>(P, l, bl, rem / 66, rem % 66, smem); }
    }
}

__device__ void phase_scanfin(const Params& P, int ph, int l) {
    const int tid = tid_opaque(), lane = tid & 63, wave = tid >> 6;
    bf16_t* PB = (bf16_t*)(P.ws + OFF_PB);
    const bf16_t* OSH = (const bf16_t*)(P.ws + OFF_KV);
    const bf16_t* OSGp = (const bf16_t*)(P.ws + OFF_OSG);
    float gh[8], gg[8];
#pragma unroll
    for (int e = 0; e < 8; ++e) { gh[e] = P.hg_g_o[l * 128 + (lane & 15) * 8 + e]; gg[e] = P.gla_g_o[l * 128 + (lane & 15) * 8 + e]; }
    for (;;) {
        const int u = next_item(P, ph);
        if (u >= NTH / 16) break;
        uint4 ra[8], rb[8], rz[8];
#pragma unroll
        for (int k = 0; k < 8; ++k) {
            const int t = u * 16 + wave * 4 + (k >> 1), mx = k & 1;
            const bf16_t* OS = mx ? OSGp : OSH;
            ra[k] = *(const uint4*)(OS + (size_t)t * 512 + lane * 8);
            rb[k] = *(const uint4*)(OS + ((size_t)NTH + t) * 512 + lane * 8);
            rz[k] = *(const uint4*)(PB + (size_t)t * PW + C_Z + (2 + mx) * 512 + lane * 8);
        }
#pragma unroll
        for (int k = 0; k < 8; ++k) {
            const int t = u * 16 + wave * 4 + (k >> 1), mx = k & 1;
            float a[8], b[8], z[8];
            unpack8(ra[k], a); unpack8(rb[k], b); unpack8(rz[k], z);
            float ss = 0.f;
#pragma unroll
            for (int e = 0; e < 8; ++e) { a[e] += b[e]; ss += a[e] * a[e]; }
            ss += __shfl_xor(ss, 1); ss += __shfl_xor(ss, 2); ss += __shfl_xor(ss, 4); ss += __shfl_xor(ss, 8);
            const float rn = rsqrtf(ss * (1.f / 128.f) + EPS);
#pragma unroll
            for (int e = 0; e < 8; ++e) a[e] = a[e] * rn * (mx ? gg[e] : gh[e]) * siluf_(z[e]);
            *(uint4*)(PB + (size_t)t * PW + C_Z + (2 + mx) * 512 + lane * 8) = pack8(a);
        }
    }
}

__device__ void phase_merge(const Params& P, int ph, int l, unsigned char* smem) {
    const int tid_ = tid_opaque(), lane = tid_ & 63, wave = tid_ >> 6, wr = wave >> 1, wc = wave & 1;
    const bf16_t* H = (const bf16_t*)(P.ws + OFF_H);
    const bf16_t* PB = (const bf16_t*)(P.ws + OFF_PB);
    bf16_t* ACC = (bf16_t*)(P.ws + OFF_KV);
    for (;;) {
        const int u = next_item(P, ph);
        if (u >= 132 * 16) break;
        const int mt = u >> 4, nt = u & 15;
        const int col = nt * 64 + wc * 32 + (lane & 31);
        f32x16 tot[2];
#pragma unroll
        for (int r = 0; r < 16; ++r) { tot[0][r] = 0.f; tot[1][r] = 0.f; }
        for (int br = 0; br < 4; ++br) {
            unsigned gate[2][8];
            f32x16 g[2], pa[2];
#pragma unroll
            for (int r = 0; r < 16; ++r) { g[0][r] = 0.f; g[1][r] = 0.f; pa[0][r] = 0.f; pa[1][r] = 0.f; }
            gemm_pair_n64(g, pa, H + (size_t)mt * 128 * D, D, (const bf16_t*)(P.ws + OFF_WM) + ((size_t)(l * 4 + br) * 1024 + nt * 64) * 1024, 1024, 1024,
                          PB + (size_t)mt * 128 * PW + C_Z + br * 512, PW, (const bf16_t*)(P.ws + OFF_WBR) + ((size_t)(l * 4 + br) * 1024 + nt * 64) * 512, 512, 512, smem);
            {
                const float bm = P.b_merge[(l * 4 + br) * 1024 + col];
#pragma unroll
                for (int mi = 0; mi < 2; ++mi)
#pragma unroll
                    for (int r = 0; r < 8; ++r) gate[mi][r] = cvt_pk_asm(sigmoidf_(g[mi][2 * r] + bm), sigmoidf_(g[mi][2 * r + 1] + bm));
            }
#pragma unroll
            for (int mi = 0; mi < 2; ++mi)
#pragma unroll
                for (int r = 0; r < 8; ++r) {
                    tot[mi][2 * r] = fmaf(lo16(gate[mi][r]), pa[mi][2 * r], tot[mi][2 * r]);
                    tot[mi][2 * r + 1] = fmaf(hi16(gate[mi][r]), pa[mi][2 * r + 1], tot[mi][2 * r + 1]);
                }
        }
#pragma unroll
        for (int mi = 0; mi < 2; ++mi)
#pragma unroll
            for (int r = 0; r < 16; ++r) ACC[(size_t)(mt * 128 + ACC_ROW(mi, r)) * 1024 + col] = f2bf(tot[mi][r]);
    }
}

__device__ void phase_out(const Params& P, int ph, int l, int hf, unsigned char* smem) {
    const int tid_ = tid_opaque(), lane = tid_ & 63, wave = tid_ >> 6, wr = wave >> 1, wc = wave & 1;
    const bf16_t* ACC = (const bf16_t*)(P.ws + OFF_KV);
    const float* mod = (const float*)(P.ws + OFF_MOD);
    for (;;) {
        const int u = next_item(P, ph);
        if (u >= 132 * 8) break;
        const int mt = u >> 3, nt = u & 7;
        const int t0 = mt * 128, bl = t0 / TB, p0 = t0 % TB, b = hf * 2 + bl;
        const bool isctx = p0 < CTXL;
        if (isctx && l == 1) continue;
        f32x16 acc[2][2]; zero_acc(acc);
        gemm_tile_pf2(acc, ACC + (size_t)mt * 128 * 1024, 1024, (const bf16_t*)(P.ws + OFF_WO) + ((size_t)l * 1024 + nt * 128) * 1024, 1024, 1024, smem);
        const float* gt = mod + (l * 5 + (isctx ? 4 : b)) * 3072 + 2048 + nt * 128;
        const float* src; float* dst;
        if (isctx) { src = P.ctx + ((size_t)b * CTXL + p0) * D; dst = (float*)(P.ws + OFF_CX1) + ((size_t)b * CTXL + p0) * D; }
        else { const size_t o = ((size_t)b * SEQ + (p0 - CTXL)) * D; src = (l == 0 ? P.x : (const float*)P.out) + o; dst = P.out + o; }
        float rv[2][2][16];
#pragma unroll
        for (int mi = 0; mi < 2; ++mi)
#pragma unroll
            for (int ni = 0; ni < 2; ++ni)
#pragma unroll
                for (int r = 0; r < 16; ++r) rv[mi][ni][r] = src[(size_t)ACC_ROW(mi, r) * D + nt * 128 + ACC_COL(ni)];
#pragma unroll
        for (int mi = 0; mi < 2; ++mi)
#pragma unroll
            for (int ni = 0; ni < 2; ++ni) {
                const int cl = ACC_COL(ni);
                const float g = gt[cl];
#pragma unroll
                for (int r = 0; r < 16; ++r) { const size_t o = (size_t)ACC_ROW(mi, r) * D + nt * 128 + cl; dst[o] = rv[mi][ni][r] + g * acc[mi][ni][r]; }
            }
    }
}

__global__ void __launch_bounds__(256, 2) mega(Params PK) {
    extern __shared__ __attribute__((aligned(16))) unsigned char smem[];
    if (blockIdx.x == 0 && threadIdx.x == 0) {
        Params* T = (Params*)(PK.ws + OFF_TAB);
        T->x = PK.x; T->c = PK.c; T->ctx = PK.ctx; T->c_ctx = PK.c_ctx; T->ada_w = PK.ada_w; T->ada_b = PK.ada_b; T->norm_g = PK.norm_g; T->w_in = PK.w_in;
        T->w_uq = PK.w_uq; T->w_ukv = PK.w_ukv; T->g_cq = PK.g_cq; T->g_ckv = PK.g_ckv; T->g_q = PK.g_q; T->g_k = PK.g_k; T->rpb = PK.rpb; T->ng_q = PK.ng_q; T->ng_k = PK.ng_k;
        T->lb_logits = PK.lb_logits; T->hg_g_o = PK.hg_g_o; T->gla_w2 = PK.gla_w2; T->gla_b2 = PK.gla_b2; T->gla_g_o = PK.gla_g_o; T->w_br = PK.w_br; T->w_merge = PK.w_merge;
        T->b_merge = PK.b_merge; T->w_out = PK.w_out; T->out = PK.out; T->ws = PK.ws; T->ph_lo = PK.ph_lo; T->ph_hi = PK.ph_hi;
    }
    unsigned char* wsb = PK.ws;
    const int ph_lo = PK.ph_lo, ph_hi = PK.ph_hi;
#ifdef PROBE_SUB
    __shared__ long long s_tacc, s_tprev; if (threadIdx.x == 0) { s_tacc = 0; s_tprev = 0; }
#endif
    for (int ph = ph_lo; ph < ph_hi; ++ph) {
#ifndef SPLIT_MIX
        if (ph > 8 && ((ph - 1) & 7) == 0) continue;
#endif
        if (ph > ph_lo) cg::this_grid().sync();
        const Params& P = PK;
#ifdef PROBE_SUB
        if (threadIdx.x == 0) { const long long t_now = wall_clock64();
#ifdef SPLIT_MIX
            const int prev_sub = (ph == 0) ? -1 : (ph == 1 ? 9 : ((ph - 2) % 9));
#else
            const int prev_sub = (ph == 0) ? -1 : (ph == 1 ? 8 : ((ph - 2) & 7));
#endif
            if (prev_sub == PROBE_SUB) s_tacc += t_now - s_tprev; s_tprev = t_now; }
#endif
#ifdef ONLYP
#define PH_ON(n) ((ONLYP >> (n)) & 1)
#else
#define PH_ON(n) true
#endif
        if (ph == 0) { if (PH_ON(8)) phase_prologue(PK, ph, smem); continue; }
#ifdef SPLIT_MIX
        const int q = ph - 1, pass = q / 9, sub9 = q % 9, l = pass >> 1, hf = pass & 1;
        if (sub9 == 4 || sub9 == 5) { phase_mixers(P, ph, l, smem, sub9 - 3); continue; }
        const int sub = sub9 < 4 ? sub9 : sub9 - 1;
        switch (sub) {
            case 0: phase_norm(P, ph, l, hf); break;
            case 1: phase_gemm1(P, ph, l, smem); break;
            case 2: phase_gemm2(P, ph, l, smem); break;
            case 3: phase_finalize(P, ph, l, smem); break;
            case 5: phase_scanfin(P, ph, l); break;
            case 6: phase_merge(P, ph, l, smem); break;
            default: phase_out(P, ph, l, hf, smem); break;
        }
#else
        const int q = ph - 1, pass = q >> 3, sub = q & 7, l = pass >> 1, hf = pass & 1;
        switch (sub) {
            case 0: if (PH_ON(0)) phase_norm(P, ph, l, hf); break;
            case 1: if (PH_ON(1)) phase_gemm1(P, ph, l, smem); break;
            case 2: if (PH_ON(2)) phase_gemm2(P, ph, l, smem); break;
            case 3: if (PH_ON(3)) phase_finalize(P, ph, l, smem); break;
            case 4: if (PH_ON(4)) phase_mixers(P, ph, l, smem); break;
            case 5: if (PH_ON(5)) phase_scanfin(P, ph, l); break;
            case 6: if (PH_ON(6)) phase_merge(P, ph, l, smem); break;
            default: if (PH_ON(7)) { phase_out(P, ph, l, hf, smem); if (pass < 3) phase_norm(P, ph + 40, (pass + 1) >> 1, (pass + 1) & 1); } break;
        }
#endif
    }
#ifdef PROBE_SUB
    cg::this_grid().sync();
    if (threadIdx.x == 0) { const long long t_now = wall_clock64(); if (7 == PROBE_SUB) s_tacc += t_now - s_tprev;
      if (blockIdx.x == 0) { const long long t_acc = s_tacc; const long long t0 = wall_clock64(); while (wall_clock64() - t0 < t_acc) { __builtin_amdgcn_s_sleep(10); } } }
#endif
}

extern "C" void kernel_launch(void* const* d_in, const int* in_sizes, int n_in, void* d_out, int out_size, void* d_ws, size_t ws_size, hipStream_t stream) {
    static int grid = 0;
    if (grid == 0) {
        if (ws_size < WS_END) { fprintf(stderr, "workspace too small: %zu < %zu\n", ws_size, (size_t)WS_END); grid = -1; return; }
        int dev = 0, cus = 0, per_cu = 0;
        hipGetDevice(&dev);
        hipDeviceGetAttribute(&cus, hipDeviceAttributeMultiprocessorCount, dev);
        hipFuncSetAttribute((const void*)mega, hipFuncAttributeMaxDynamicSharedMemorySize, LDS_BYTES);
        hipOccupancyMaxActiveBlocksPerMultiprocessor(&per_cu, (const void*)mega, 256, LDS_BYTES);
        if (per_cu < 1) per_cu = 1;
        if (per_cu > 2) per_cu = 2;
        grid = cus * per_cu;
        (void)hipGetLastError();
    }
    if (grid < 0) return;
    hipMemsetAsync((unsigned char*)d_ws + OFF_CTL, 0, 4096, stream);
    Params p{};
    const float** pp = (const float**)&p;
    for (int i = 0; i < 26; ++i) pp[i] = (const float*)d_in[i];
    p.out = (float*)d_out; p.ws = (unsigned char*)d_ws;
#if SINGLE_LAUNCH
    p.ph_lo = 0; p.ph_hi = NPHASE;
    void* args[] = {&p};
    hipError_t e = hipLaunchCooperativeKernel((const void*)mega, dim3(grid), dim3(256), args, LDS_BYTES, stream);
    if (e != hipSuccess) fprintf(stderr, "cooperative launch failed: %s (grid %d)\n", hipGetErrorString(e), grid);
#else
    for (int ph = 0; ph < NPHASE; ++ph) {
        p.ph_lo = ph; p.ph_hi = ph + 1;
        hipLaunchKernelGGL(mega, dim3(grid), dim3(256), LDS_BYTES, stream, p);
    }
#endif
}
```

```cpp
#include <hip/hip_runtime.h>
#include <hip/hip_cooperative_groups.h>
#include <stdint.h>
#include <stdio.h>
namespace cg = cooperative_groups;

typedef unsigned short bf16_t;
typedef short bf16x8 __attribute__((ext_vector_type(8)));
typedef short bf16x4 __attribute__((ext_vector_type(4)));
typedef float f32x16 __attribute__((ext_vector_type(16)));

#ifndef SINGLE_LAUNCH
#define SINGLE_LAUNCH 1
#endif

constexpr int D = 1024, SEQ = 8192, CTXL = 256, TB = SEQ + CTXL  , NTH = 2 * TB  ;
constexpr int INW = 7104, PW = 7104;
constexpr int C_CQ = 0, C_CKV = 256, C_KR = 384, C_NQ = 416, C_NK = 928, C_NV = 1440, C_HQ = 1952, C_HF = 2464, C_HI = 3488,
              C_GQ = 4000, C_GK = 4256, C_GV = 4512, C_GR = 5024, C_Z = 5056;
constexpr float EPS = 1e-6f;
constexpr float LOG2E = 1.4426950408889634f;
constexpr int LDS_BYTES = 73728;
#ifdef SPLIT_MIX
constexpr int NPHASE = 37;
#else
constexpr int NPHASE = 33;
#endif

constexpr size_t al256(size_t v) { return (v + 255) & ~(size_t)255; }
constexpr size_t OFF_CTL = 0;
constexpr size_t OFF_TAB = 1024;
constexpr size_t OFF_MOD = 4096;
constexpr size_t OFF_CX1 = al256(OFF_MOD + 2 * 5 * 3072 * 4);
constexpr size_t OFF_WIN = al256(OFF_CX1 + (size_t)4 * 256 * 1024 * 4);
constexpr size_t OFF_WM = al256(OFF_WIN + (size_t)2 * 7168 * 1024 * 2);
constexpr size_t OFF_WBR = al256(OFF_WM + (size_t)8 * 1024 * 1024 * 2);
constexpr size_t OFF_WO = al256(OFF_WBR + (size_t)8 * 1024 * 512 * 2);
constexpr size_t OFF_WUQ = al256(OFF_WO + (size_t)2 * 1024 * 1024 * 2);
constexpr size_t OFF_WUKV = al256(OFF_WUQ + (size_t)2 * 768 * 256 * 2);
constexpr size_t OFF_H = al256(OFF_WUKV + (size_t)2 * 1024 * 128 * 2);
constexpr size_t OFF_PB = al256(OFF_H + (size_t)NTH * 1024 * 2);
constexpr size_t OFF_QF = al256(OFF_PB + (size_t)NTH * PW * 2);
constexpr size_t OFF_KV = al256(OFF_QF + (size_t)NTH * 768 * 2);
constexpr size_t OFF_KF = al256(OFF_KV + (size_t)NTH * 1024 * 2);
constexpr size_t OFF_VTM = al256(OFF_KF + (size_t)NTH * 768 * 2);
constexpr size_t OFF_VTN = al256(OFF_VTM + (size_t)2 * 8 * 64 * TB * 2);
constexpr size_t OFF_OSG = al256(OFF_VTN + (size_t)2 * 8 * 64 * TB * 2);
constexpr size_t OFF_XH = al256(OFF_OSG + (size_t)2 * NTH * 512 * 2);
constexpr size_t OFF_XG = al256(OFF_XH + (size_t)NTH * 512 * 2);
constexpr size_t OFF_EBH = al256(OFF_XG + (size_t)NTH * 512 * 2);
constexpr size_t OFF_EBG = al256(OFF_EBH + (size_t)528 * 2 * 512 * 4);
constexpr size_t WS_END = al256(OFF_EBG + (size_t)528 * 2 * 256 * 4);

static_assert(WS_END <= (size_t)512 * 1024 * 1024, "workspace map exceeds 512 MiB");
struct Params {
    const float *x, *c, *ctx, *c_ctx, *ada_w, *ada_b, *norm_g, *w_in, *w_uq, *w_ukv, *g_cq, *g_ckv, *g_q, *g_k, *rpb, *ng_q, *ng_k,
        *lb_logits, *hg_g_o, *gla_w2, *gla_b2, *gla_g_o, *w_br, *w_merge, *b_merge, *w_out;
    float* out;
    unsigned char* ws;
    int ph_lo, ph_hi;
};

__device__ __forceinline__ float bf2f(bf16_t v) { return __uint_as_float(((unsigned)v) << 16); }
typedef float f32x2_t __attribute__((ext_vector_type(2)));
typedef __bf16 bf16x2_t __attribute__((ext_vector_type(2)));
__device__ __forceinline__ unsigned cvt_pk(float lo, float hi) { f32x2_t v = {lo, hi}; bf16x2_t b = __builtin_convertvector(v, bf16x2_t); return __builtin_bit_cast(unsigned, b); }
__device__ __forceinline__ unsigned cvt_pk_asm(float lo, float hi) { unsigned r; asm("s_nop 1\n\tv_cvt_pk_bf16_f32 %0, %1, %2" : "=v"(r) : "v"(lo), "v"(hi)); return r; }
__device__ __forceinline__ bf16_t f2bf(float f) { return (bf16_t)(cvt_pk(f, 0.f) & 0xffffu); }
__device__ __forceinline__ float lo16(unsigned u) { return __uint_as_float(u << 16); }
__device__ __forceinline__ float hi16(unsigned u) { return __uint_as_float(u & 0xffff0000u); }
__device__ __forceinline__ float sigmoidf_(float x) { return 1.f / (1.f + __expf(-x)); }
__device__ __forceinline__ float siluf_(float x) { return x / (1.f + __expf(-x)); }
__device__ __forceinline__ float wave_sum(float v) {
#pragma unroll
    for (int o = 32; o > 0; o >>= 1) v += __shfl_xor(v, o);
    return v;
}
__device__ __forceinline__ void unpack8(uint4 u, float* f) {
    f[0] = lo16(u.x); f[1] = hi16(u.x); f[2] = lo16(u.y); f[3] = hi16(u.y); f[4] = lo16(u.z); f[5] = hi16(u.z); f[6] = lo16(u.w); f[7] = hi16(u.w);
}
__device__ __forceinline__ uint4 pack8(const float* f) { uint4 u; u.x = cvt_pk(f[0], f[1]); u.y = cvt_pk(f[2], f[3]); u.z = cvt_pk(f[4], f[5]); u.w = cvt_pk(f[6], f[7]); return u; }

__device__ __forceinline__ int tid_opaque() { int t = threadIdx.x; asm volatile("" : "+v"(t)); return t; }
__shared__ int s_item;
__device__ __forceinline__ int next_item(const Params& P, int ph) {
    __syncthreads();
    if (threadIdx.x == 0) s_item = atomicAdd((int*)(P.ws + OFF_CTL) + ph, 1);
    __syncthreads();
    return s_item;
}

constexpr int GS = 72;
__device__ __forceinline__ void gemm_tile(f32x16 (&acc)[2][2], const bf16_t* __restrict__ A, int lda, const bf16_t* __restrict__ Bt, int ldb, int K, unsigned char* smem) {
    const int tid = tid_opaque(), lane = tid & 63, wave = tid >> 6, wr = wave >> 1, wc = wave & 1;
    bf16_t* sA = (bf16_t*)smem;
    bf16_t* sB = sA + 2 * 128 * GS;
    const int lrow = tid >> 3, lch = (tid & 7) * 8;
    uint4 ra[4], rb[4];
    const bf16_t* Ap = A + (size_t)lrow * lda + lch;
    const bf16_t* Bp = Bt + (size_t)lrow * ldb + lch;
#pragma unroll
    for (int i = 0; i < 4; ++i) { ra[i] = *(const uint4*)(Ap + (size_t)(32 * i) * lda); rb[i] = *(const uint4*)(Bp + (size_t)(32 * i) * ldb); }
#pragma unroll
    for (int i = 0; i < 4; ++i) { *(uint4*)(sA + (lrow + 32 * i) * GS + lch) = ra[i]; *(uint4*)(sB + (lrow + 32 * i) * GS + lch) = rb[i]; }
    __syncthreads();
    const int nk = K >> 6;
    const int aoff = (wr * 64 + (lane & 31)) * GS + (lane >> 5) * 8, boff = (wc * 64 + (lane & 31)) * GS + (lane >> 5) * 8;
    for (int kt = 0; kt < nk; ++kt) {
        const bool more = kt + 1 < nk;
        if (more) {
#pragma unroll
            for (int i = 0; i < 4; ++i) { ra[i] = *(const uint4*)(Ap + (size_t)(32 * i) * lda + (kt + 1) * 64); rb[i] = *(const uint4*)(Bp + (size_t)(32 * i) * ldb + (kt + 1) * 64); }
        }
        const bf16_t* a = sA + (kt & 1) * 128 * GS + aoff;
        const bf16_t* b = sB + (kt & 1) * 128 * GS + boff;
#pragma unroll
        for (int ks = 0; ks < 4; ++ks) {
            bf16x8 a0 = *(const bf16x8*)(a + ks * 16), a1 = *(const bf16x8*)(a + 32 * GS + ks * 16);
            bf16x8 b0 = *(const bf16x8*)(b + ks * 16), b1 = *(const bf16x8*)(b + 32 * GS + ks * 16);
            acc[0][0] = __builtin_amdgcn_mfma_f32_32x32x16_bf16(a0, b0, acc[0][0], 0, 0, 0);
            acc[0][1] = __builtin_amdgcn_mfma_f32_32x32x16_bf16(a0, b1, acc[0][1], 0, 0, 0);
            acc[1][0] = __builtin_amdgcn_mfma_f32_32x32x16_bf16(a1, b0, acc[1][0], 0, 0, 0);
            acc[1][1] = __builtin_amdgcn_mfma_f32_32x32x16_bf16(a1, b1, acc[1][1], 0, 0, 0);
        }
        if (more) {
            bf16_t* wa = sA + ((kt + 1) & 1) * 128 * GS;
            bf16_t* wb = sB + ((kt + 1) & 1) * 128 * GS;
#pragma unroll
            for (int i = 0; i < 4; ++i) { *(uint4*)(wa + (lrow + 32 * i) * GS + lch) = ra[i]; *(uint4*)(wb + (lrow + 32 * i) * GS + lch) = rb[i]; }
        }
        __syncthreads();
    }
}

__device__ __forceinline__ void gemm_tile_pf2(f32x16 (&acc)[2][2], const bf16_t* __restrict__ A, int lda, const bf16_t* __restrict__ Bt, int ldb, int K, unsigned char* smem) {
    const int tid = tid_opaque(), lane = tid & 63, wave = tid >> 6, wr = wave >> 1, wc = wave & 1;
    bf16_t* sA = (bf16_t*)smem;
    bf16_t* sB = sA + 2 * 128 * GS;
    const int lrow = tid >> 3, lch = (tid & 7) * 8;
    uint4 pa0, pa1, pa2, pa3, pb0, pb1, pb2, pb3, qa0, qa1, qa2, qa3, qb0, qb1, qb2, qb3;
    const bf16_t* Ap = A + (size_t)lrow * lda + lch;
    const bf16_t* Bp = Bt + (size_t)lrow * ldb + lch;
    const int nk = K >> 6;
#define PF2_LD1(RA, RB, kt_, i) { RA##i = *(const uint4*)(Ap + (size_t)(32 * i) * lda + (kt_) * 64); RB##i = *(const uint4*)(Bp + (size_t)(32 * i) * ldb + (kt_) * 64); }
#define PF2_LOAD(RA, RB, kt_) { PF2_LD1(RA, RB, kt_, 0) PF2_LD1(RA, RB, kt_, 1) PF2_LD1(RA, RB, kt_, 2) PF2_LD1(RA, RB, kt_, 3) }
#define PF2_WR1(RA, RB, i) { *(uint4*)(wa + (lrow + 32 * i) * GS + lch) = RA##i; *(uint4*)(wb + (lrow + 32 * i) * GS + lch) = RB##i; }
#define PF2_WRITE(RA, RB, buf_) { bf16_t* wa = sA + (buf_) * 128 * GS; bf16_t* wb = sB + (buf_) * 128 * GS; PF2_WR1(RA, RB, 0) PF2_WR1(RA, RB, 1) PF2_WR1(RA, RB, 2) PF2_WR1(RA, RB, 3) }
#define PF2_COMPUTE(buf_) { const bf16_t* a = sA + (buf_) * 128 * GS + aoff; const bf16_t* b = sB + (buf_) * 128 * GS + boff; _Pragma("unroll") for (int ks = 0; ks < 4; ++ks) { \
        bf16x8 a0 = *(const bf16x8*)(a + ks * 16), a1 = *(const bf16x8*)(a + 32 * GS + ks * 16); bf16x8 b0 = *(const bf16x8*)(b + ks * 16), b1 = *(const bf16x8*)(b + 32 * GS + ks * 16); \
        acc[0][0] = __builtin_amdgcn_mfma_f32_32x32x16_bf16(a0, b0, acc[0][0], 0, 0, 0); acc[0][1] = __builtin_amdgcn_mfma_f32_32x32x16_bf16(a0, b1, acc[0][1], 0, 0, 0); \
        acc[1][0] = __builtin_amdgcn_mfma_f32_32x32x16_bf16(a1, b0, acc[1][0], 0, 0, 0); acc[1][1] = __builtin_amdgcn_mfma_f32_32x32x16_bf16(a1, b1, acc[1][1], 0, 0, 0); } }
    const int aoff = (wr * 64 + (lane & 31)) * GS + (lane >> 5) * 8, boff = (wc * 64 + (lane & 31)) * GS + (lane >> 5) * 8;
    PF2_LOAD(pa, pb, 0);
    PF2_LOAD(qa, qb, 1);
    PF2_WRITE(pa, pb, 0);
    __syncthreads();
    for (int kt = 0; kt < nk; kt += 2) {
        if (kt + 2 < nk) PF2_LOAD(pa, pb, kt + 2);
        PF2_COMPUTE(0);
        PF2_WRITE(qa, qb, 1);
        __syncthreads();
        if (kt + 3 < nk) PF2_LOAD(qa, qb, kt + 3);
        PF2_COMPUTE(1);
        if (kt + 2 < nk) PF2_WRITE(pa, pb, 0);
        __syncthreads();
    }
#undef PF2_LOAD
#undef PF2_LD1
#undef PF2_WR1
#undef PF2_WRITE
#undef PF2_COMPUTE
}

__device__ __forceinline__ void gemm_tile_n64(f32x16 (&acc)[2], const bf16_t* __restrict__ A, int lda, const bf16_t* __restrict__ Bt, int ldb, int K, unsigned char* smem) {
    const int tid = tid_opaque(), lane = tid & 63, wave = tid >> 6, wr = wave >> 1, wc = wave & 1;
    bf16_t* sA = (bf16_t*)smem;
    bf16_t* sB = sA + 2 * 128 * GS;
    const int lrow = tid >> 3, lch = (tid & 7) * 8;
    uint4 pa0, pa1, pa2, pa3, pb0, pb1, qa0, qa1, qa2, qa3, qb0, qb1;
    const bf16_t* Ap = A + (size_t)lrow * lda + lch;
    const bf16_t* Bp = Bt + (size_t)lrow * ldb + lch;
    const int nk = K >> 6;
#define N64_LOAD(RA, RB, kt_) { RA##0 = *(const uint4*)(Ap + (kt_) * 64); RA##1 = *(const uint4*)(Ap + (size_t)32 * lda + (kt_) * 64); RA##2 = *(const uint4*)(Ap + (size_t)64 * lda + (kt_) * 64); RA##3 = *(const uint4*)(Ap + (size_t)96 * lda + (kt_) * 64); \
        RB##0 = *(const uint4*)(Bp + (kt_) * 64); RB##1 = *(const uint4*)(Bp + (size_t)32 * ldb + (kt_) * 64); }
#define N64_WRITE(RA, RB, buf_) { bf16_t* wa = sA + (buf_) * 128 * GS + lrow * GS + lch; bf16_t* wb = sB + (buf_) * 64 * GS + lrow * GS + lch; \
        *(uint4*)wa = RA##0; *(uint4*)(wa + 32 * GS) = RA##1; *(uint4*)(wa + 64 * GS) = RA##2; *(uint4*)(wa + 96 * GS) = RA##3; *(uint4*)wb = RB##0; *(uint4*)(wb + 32 * GS) = RB##1; }
#define N64_COMPUTE(buf_) { const bf16_t* a = sA + (buf_) * 128 * GS + aoff; const bf16_t* b = sB + (buf_) * 64 * GS + boff; _Pragma("unroll") for (int ks = 0; ks < 4; ++ks) { \
        bf16x8 a0 = *(const bf16x8*)(a + ks * 16), a1 = *(const bf16x8*)(a + 32 * GS + ks * 16); bf16x8 b0 = *(const bf16x8*)(b + ks * 16); \
        acc[0] = __builtin_amdgcn_mfma_f32_32x32x16_bf16(a0, b0, acc[0], 0, 0, 0); acc[1] = __builtin_amdgcn_mfma_f32_32x32x16_bf16(a1, b0, acc[1], 0, 0, 0); } }
    const int aoff = (wr * 64 + (lane & 31)) * GS + (lane >> 5) * 8, boff = (wc * 32 + (lane & 31)) * GS + (lane >> 5) * 8;
    N64_LOAD(pa, pb, 0);
    N64_LOAD(qa, qb, 1);
    N64_WRITE(pa, pb, 0);
    __syncthreads();
    for (int kt = 0; kt < nk; kt += 2) {
        if (kt + 2 < nk) N64_LOAD(pa, pb, kt + 2);
        N64_COMPUTE(0);
        N64_WRITE(qa, qb, 1);
        __syncthreads();
        if (kt + 3 < nk) N64_LOAD(qa, qb, kt + 3);
        N64_COMPUTE(1);
        if (kt + 2 < nk) N64_WRITE(pa, pb, 0);
        __syncthreads();
    }
#undef N64_LOAD
#undef N64_WRITE
#undef N64_COMPUTE
}

__device__ __forceinline__ void gemm_pair_n64(f32x16 (&acc1)[2], f32x16 (&acc2)[2], const bf16_t* __restrict__ A1, int lda1, const bf16_t* __restrict__ B1, int ldb1, int K1,
                                              const bf16_t* __restrict__ A2, int lda2, const bf16_t* __restrict__ B2, int ldb2, int K2, unsigned char* smem) {
    const int tid = tid_opaque(), lane = tid & 63, wave = tid >> 6, wr = wave >> 1, wc = wave & 1;
    bf16_t* sA = (bf16_t*)smem;
    bf16_t* sB = sA + 2 * 128 * GS;
    const int lrow = tid >> 3, lch = (tid & 7) * 8;
    uint4 pa0, pa1, pa2, pa3, pb0, pb1, qa0, qa1, qa2, qa3, qb0, qb1;
    const bf16_t* Ap1 = A1 + (size_t)lrow * lda1 + lch; const bf16_t* Bp1 = B1 + (size_t)lrow * ldb1 + lch;
    const bf16_t* Ap2 = A2 + (size_t)lrow * lda2 + lch; const bf16_t* Bp2 = B2 + (size_t)lrow * ldb2 + lch;
    const int nk1 = K1 >> 6, nk = nk1 + (K2 >> 6);
#define P64_LOAD(RA, RB, kt_) { const bool s2_ = (kt_) >= nk1; const bf16_t* ap_ = s2_ ? Ap2 + ((kt_) - nk1) * 64 : Ap1 + (kt_) * 64; const bf16_t* bp_ = s2_ ? Bp2 + ((kt_) - nk1) * 64 : Bp1 + (kt_) * 64; \
        const size_t la_ = s2_ ? lda2 : lda1, lb_ = s2_ ? ldb2 : ldb1; \
        RA##0 = *(const uint4*)(ap_); RA##1 = *(const uint4*)(ap_ + 32 * la_); RA##2 = *(const uint4*)(ap_ + 64 * la_); RA##3 = *(const uint4*)(ap_ + 96 * la_); \
        RB##0 = *(const uint4*)(bp_); RB##1 = *(const uint4*)(bp_ + 32 * lb_); }
#define P64_WRITE(RA, RB, buf_) { bf16_t* wa = sA + (buf_) * 128 * GS + lrow * GS + lch; bf16_t* wb = sB + (buf_) * 64 * GS + lrow * GS + lch; \
        *(uint4*)wa = RA##0; *(uint4*)(wa + 32 * GS) = RA##1; *(uint4*)(wa + 64 * GS) = RA##2; *(uint4*)(wa + 96 * GS) = RA##3; *(uint4*)wb = RB##0; *(uint4*)(wb + 32 * GS) = RB##1; }
#define P64_COMPUTE(ACC, buf_) { const bf16_t* a = sA + (buf_) * 128 * GS + aoff; const bf16_t* b = sB + (buf_) * 64 * GS + boff; _Pragma("unroll") for (int ks = 0; ks < 4; ++ks) { \
        bf16x8 a0 = *(const bf16x8*)(a + ks * 16), a1 = *(const bf16x8*)(a + 32 * GS + ks * 16); bf16x8 b0 = *(const bf16x8*)(b + ks * 16); \
        ACC[0] = __builtin_amdgcn_mfma_f32_32x32x16_bf16(a0, b0, ACC[0], 0, 0, 0); ACC[1] = __builtin_amdgcn_mfma_f32_32x32x16_bf16(a1, b0, ACC[1], 0, 0, 0); } }
    const int aoff = (wr * 64 + (lane & 31)) * GS + (lane >> 5) * 8, boff = (wc * 32 + (lane & 31)) * GS + (lane >> 5) * 8;
    P64_LOAD(pa, pb, 0);
    P64_LOAD(qa, qb, 1);
    P64_WRITE(pa, pb, 0);
    __syncthreads();
    for (int kt = 0; kt < nk; kt += 2) {
        if (kt + 2 < nk) P64_LOAD(pa, pb, kt + 2);
        if (kt < nk1) P64_COMPUTE(acc1, 0) else P64_COMPUTE(acc2, 0)
        P64_WRITE(qa, qb, 1);
        __syncthreads();
        if (kt + 3 < nk) P64_LOAD(qa, qb, kt + 3);
        if (kt + 1 < nk1) P64_COMPUTE(acc1, 1) else P64_COMPUTE(acc2, 1)
        if (kt + 2 < nk) P64_WRITE(pa, pb, 0);
        __syncthreads();
    }
#undef P64_LOAD
#undef P64_WRITE
#undef P64_COMPUTE
}
__device__ __forceinline__ void zero_acc(f32x16 (&acc)[2][2]) {
#pragma unroll
    for (int i = 0; i < 2; ++i)
#pragma unroll
        for (int j = 0; j < 2; ++j)
#pragma unroll
            for (int r = 0; r < 16; ++r) acc[i][j][r] = 0.f;
}
#define ACC_ROW(mi, r) (wr * 64 + (mi) * 32 + ((r) & 3) + 8 * ((r) >> 2) + 4 * (lane >> 5))
#define ACC_COL(ni) (wc * 64 + (ni) * 32 + (lane & 31))

__device__ void tr_tile(const float* __restrict__ src, int K, int N, int kt, int nt, bf16_t* __restrict__ dst, const float* __restrict__ scale, float* s) {
    const int tid = tid_opaque(), r = tid >> 4, c4 = (tid & 15) * 4;
#pragma unroll
    for (int i = 0; i < 4; ++i) {
        const int k = kt * 64 + r + 16 * i;
        float4 v = *(const float4*)(src + (size_t)k * N + nt * 64 + c4);
        const float sc = scale ? scale[k] : 1.f;
        float* d = s + (r + 16 * i) * 65 + c4;
        d[0] = v.x * sc; d[1] = v.y * sc; d[2] = v.z * sc; d[3] = v.w * sc;
    }
    __syncthreads();
    const int n = tid >> 2, k0 = (tid & 3) * 16;
    float f[16];
#pragma unroll
    for (int j = 0; j < 16; ++j) f[j] = s[(k0 + j) * 65 + n];
    bf16_t* o = dst + (size_t)(nt * 64 + n) * K + kt * 64 + k0;
    *(uint4*)o = pack8(f);
    *(uint4*)(o + 8) = pack8(f + 8);
    __syncthreads();
}
__device__ void phase_prologue(const Params& P, int ph, unsigned char* smem) {
    float* s = (float*)smem;
    const int NTR = 7296, NMOD = 96;
    for (;;) {
        const int u = next_item(P, ph);
        if (u >= NTR + NMOD) break;
        if (u < NMOD) {
            const int l = u / 48, cb = u % 48, tid = threadIdx.x, lane = tid & 63, wave = tid >> 6;
            float* sc = s;
            float* red = s + 5 * 1024;
            for (int i = tid; i < 5 * 1024; i += 256) { const int r = i >> 10, k = i & 1023; const float v = (r < 4) ? P.c[r * 1024 + k] : P.c_ctx[k]; sc[i] = siluf_(v); }
            __syncthreads();
            const int col = cb * 64 + lane;
            float acc[5] = {0.f, 0.f, 0.f, 0.f, 0.f};
            const float* w = P.ada_w + (size_t)l * 1024 * 3072 + col;
#pragma unroll 8
            for (int k = wave * 256; k < wave * 256 + 256; ++k) {
                const float wv = w[(size_t)k * 3072];
#pragma unroll
                for (int r = 0; r < 5; ++r) acc[r] += sc[r * 1024 + k] * wv;
            }
#pragma unroll
            for (int r = 0; r < 5; ++r) red[(wave * 5 + r) * 64 + lane] = acc[r];
            __syncthreads();
            if (wave == 0) {
                float* mod = (float*)(P.ws + OFF_MOD);
#pragma unroll
                for (int r = 0; r < 5; ++r) mod[(l * 5 + r) * 3072 + col] = red[r * 64 + lane] + red[(5 + r) * 64 + lane] + red[(10 + r) * 64 + lane] + red[(15 + r) * 64 + lane] + P.ada_b[l * 3072 + col];
            }
            continue;
        }
        const int v = u - NMOD, l = v / 3648, r = v % 3648;
        if (r < 1776) tr_tile(P.w_in + (size_t)l * 1024 * INW, 1024, INW, r / 111, r % 111, (bf16_t*)(P.ws + OFF_WIN) + (size_t)l * 7168 * 1024, nullptr, s);
        else if (r < 2800) { const int r2 = r - 1776, br = r2 >> 8, t = r2 & 255; tr_tile(P.w_merge + (size_t)(l * 4 + br) * 1024 * 1024, 1024, 1024, t >> 4, t & 15, (bf16_t*)(P.ws + OFF_WM) + (size_t)(l * 4 + br) * 1024 * 1024, nullptr, s); }
        else if (r < 3312) { const int r2 = r - 2800, br = r2 >> 7, t = r2 & 127; tr_tile(P.w_br + (size_t)(l * 4 + br) * 512 * 1024, 512, 1024, t >> 4, t & 15, (bf16_t*)(P.ws + OFF_WBR) + (size_t)(l * 4 + br) * 1024 * 512, nullptr, s); }
        else if (r < 3568) { const int t = r - 3312; tr_tile(P.w_out + (size_t)l * 1024 * 1024, 1024, 1024, t >> 4, t & 15, (bf16_t*)(P.ws + OFF_WO) + (size_t)l * 1024 * 1024, nullptr, s); }
        else if (r < 3616) { const int t = r - 3568; tr_tile(P.w_uq + (size_t)l * 256 * 768, 256, 768, t / 12, t % 12, (bf16_t*)(P.ws + OFF_WUQ) + (size_t)l * 768 * 256, P.g_cq + l * 256, s); }
        else { const int t = r - 3616; tr_tile(P.w_ukv + (size_t)l * 128 * 1024, 128, 1024, t >> 4, t & 15, (bf16_t*)(P.ws + OFF_WUKV) + (size_t)l * 1024 * 128, P.g_ckv + l * 128, s); }
    }
}

__device__ void phase_norm(const Params& P, int ph, int l, int hf) {
    const int tid = tid_opaque(), lane = tid & 63, wave = tid >> 6;
    const float* mod = (const float*)(P.ws + OFF_MOD);
    bf16_t* H = (bf16_t*)(P.ws + OFF_H);
    for (;;) {
        const int u = next_item(P, ph);
        if (u >= NTH / 8) break;
        float4 v[2][4]; int mrr[2];
#pragma unroll
        for (int rr = 0; rr < 2; ++rr) {
            const int t = u * 8 + wave * 2 + rr, bl = t / TB, p = t % TB, b = hf * 2 + bl;
            const float* src;
            if (p < CTXL) { src = (l == 0 ? P.ctx : (const float*)(P.ws + OFF_CX1)) + ((size_t)b * CTXL + p) * D; mrr[rr] = 4; }
            else { src = (l == 0 ? P.x : (const float*)P.out) + ((size_t)b * SEQ + (p - CTXL)) * D; mrr[rr] = b; }
#pragma unroll
            for (int i = 0; i < 4; ++i) v[rr][i] = *(const float4*)(src + lane * 4 + 256 * i);
        }
#pragma unroll
        for (int rr = 0; rr < 2; ++rr) {
            const int t = u * 8 + wave * 2 + rr;
            float ss = 0.f;
#pragma unroll
            for (int i = 0; i < 4; ++i) ss += v[rr][i].x * v[rr][i].x + v[rr][i].y * v[rr][i].y + v[rr][i].z * v[rr][i].z + v[rr][i].w * v[rr][i].w;
            ss = wave_sum(ss);
            const float rstd = rsqrtf(ss * (1.f / D) + EPS);
            const float* sh = mod + (l * 5 + mrr[rr]) * 3072; const float* sc = sh + 1024; const float* g = P.norm_g + l * D;
#pragma unroll
            for (int i = 0; i < 4; ++i) {
                const int c = lane * 4 + 256 * i;
                const float4 gv = *(const float4*)(g + c), s1 = *(const float4*)(sc + c), s0 = *(const float4*)(sh + c);
                uint2 o;
                o.x = cvt_pk(v[rr][i].x * rstd * gv.x * (1.f + s1.x) + s0.x, v[rr][i].y * rstd * gv.y * (1.f + s1.y) + s0.y);
                o.y = cvt_pk(v[rr][i].z * rstd * gv.z * (1.f + s1.z) + s0.z, v[rr][i].w * rstd * gv.w * (1.f + s1.w) + s0.w);
                *(uint2*)(H + (size_t)t * D + c) = o;
            }
        }
    }
}

__device__ void phase_gemm1(const Params& P, int ph, int l, unsigned char* smem) {
    const int tid_ = tid_opaque(), lane = tid_ & 63, wave = tid_ >> 6, wr = wave >> 1, wc = wave & 1;
    const bf16_t* H = (const bf16_t*)(P.ws + OFF_H);
    const bf16_t* W = (const bf16_t*)(P.ws + OFF_WIN) + (size_t)l * 7168 * 1024;
    bf16_t* PB = (bf16_t*)(P.ws + OFF_PB);
    for (;;) {
        const int u = next_item(P, ph);
        if (u >= 132 * 56) break;
        const int mt = u / 56, nt = u % 56;
        f32x16 acc[2][2]; zero_acc(acc);
        gemm_tile_pf2(acc, H + (size_t)mt * 128 * D, D, W + (size_t)nt * 128 * D, D, D, smem);
#pragma unroll
        for (int mi = 0; mi < 2; ++mi)
#pragma unroll
            for (int ni = 0; ni < 2; ++ni) {
                const int col = nt * 128 + ACC_COL(ni);
                if (col < PW) {
#pragma unroll
                    for (int r = 0; r < 16; ++r) PB[(size_t)(mt * 128 + ACC_ROW(mi, r)) * PW + col] = f2bf(acc[mi][ni][r]);
                }
            }
    }
}

__device__ void phase_gemm2(const Params& P, int ph, int l, unsigned char* smem) {
    const int tid_ = tid_opaque(), lane = tid_ & 63, wave = tid_ >> 6, wr = wave >> 1, wc = wave & 1;
    const bf16_t* PB = (const bf16_t*)(P.ws + OFF_PB);
    for (;;) {
        const int u = next_item(P, ph);
        if (u >= 132 * 14) break;
        const int mt = u / 14, n14 = u % 14;
        f32x16 acc[2][2]; zero_acc(acc);
        bf16_t* O; int ldo, nt;
        if (n14 < 6) { nt = n14; O = (bf16_t*)(P.ws + OFF_QF); ldo = 768;
            gemm_tile_pf2(acc, PB + (size_t)mt * 128 * PW + C_CQ, PW, (const bf16_t*)(P.ws + OFF_WUQ) + (size_t)l * 768 * 256 + (size_t)nt * 128 * 256, 256, 256, smem); }
        else { nt = n14 - 6; O = (bf16_t*)(P.ws + OFF_KV); ldo = 1024;
            gemm_tile_pf2(acc, PB + (size_t)mt * 128 * PW + C_CKV, PW, (const bf16_t*)(P.ws + OFF_WUKV) + (size_t)l * 1024 * 128 + (size_t)nt * 128 * 128, 128, 128, smem); }
#pragma unroll
        for (int mi = 0; mi < 2; ++mi)
#pragma unroll
            for (int ni = 0; ni < 2; ++ni)
#pragma unroll
                for (int r = 0; r < 16; ++r) O[(size_t)(mt * 128 + ACC_ROW(mi, r)) * ldo + nt * 128 + ACC_COL(ni)] = f2bf(acc[mi][ni][r]);
    }
}

__device__ void phase_finalize(const Params& P, int ph, int l, unsigned char* smem) {
    const int tid = tid_opaque(), lane = tid & 63, wave = tid >> 6;
    bf16_t* PB = (bf16_t*)(P.ws + OFF_PB);
    bf16_t* QF = (bf16_t*)(P.ws + OFF_QF);
    const bf16_t* KV = (const bf16_t*)(P.ws + OFF_KV);
    bf16_t* KF = (bf16_t*)(P.ws + OFF_KF);
    bf16_t* VTM = (bf16_t*)(P.ws + OFF_VTM);
    bf16_t* VTN = (bf16_t*)(P.ws + OFF_VTN);
    float* rs = (float*)smem;
    const int hd = lane >> 3, j = lane & 7;
    const float invf = __powf(10000.f, -(float)j * 0.125f);
    for (;;) {
        const int u7 = next_item(P, ph);
        if (u7 >= (NTH / 32) * 11) break;
        const int u = u7 / 11, sub = u7 % 11;
        const int t0 = u * 32, bl = t0 / TB, p0 = t0 % TB;
        if (sub >= 1 && sub <= 4) {
        uint2 in_cq[2]; unsigned in_ckv[2]; bf16_t in_q[2][12], in_kv[2][8], in_kr[2][4]; uint4 in_nq[2], in_nk[2];
#pragma unroll
        for (int rr = 0; rr < 2; ++rr) {
            const int tl = (sub - 1) * 8 + wave * 2 + rr, t = t0 + tl;
            const bf16_t* prow = PB + (size_t)t * PW;
            in_cq[rr] = *(const uint2*)(prow + C_CQ + lane * 4);
            in_ckv[rr] = *(const unsigned*)(prow + C_CKV + lane * 2);
            const bf16_t* q = QF + (size_t)t * 768 + hd * 96;
            const bf16_t* kvr = KV + (size_t)t * 1024 + hd * 128;
#pragma unroll
            for (int m = 0; m < 12; ++m) in_q[rr][m] = q[j + 8 * m];
#pragma unroll
            for (int m = 0; m < 8; ++m) in_kv[rr][m] = kvr[j + 8 * m];
#pragma unroll
            for (int m = 0; m < 4; ++m) in_kr[rr][m] = prow[C_KR + j + 8 * m];
            in_nq[rr] = *(const uint4*)(prow + C_NQ + hd * 64 + j * 8);
            in_nk[rr] = *(const uint4*)(prow + C_NK + hd * 64 + j * 8);
        }
#pragma unroll
        for (int rr = 0; rr < 2; ++rr) {
            const int tl = (sub - 1) * 8 + wave * 2 + rr, t = t0 + tl, p = p0 + tl;
            bf16_t* prow = PB + (size_t)t * PW;
            float s1, s2;
            { const uint2 a = in_cq[rr]; const float f0 = lo16(a.x), f1 = hi16(a.x), f2 = lo16(a.y), f3 = hi16(a.y); s1 = f0 * f0 + f1 * f1 + f2 * f2 + f3 * f3;
              const unsigned b = in_ckv[rr]; const float g0 = lo16(b), g1 = hi16(b); s2 = g0 * g0 + g1 * g1; }
            s1 = wave_sum(s1); s2 = wave_sum(s2);
            const float rcq = rsqrtf(s1 * (1.f / 256.f) + EPS), rckv = rsqrtf(s2 * (1.f / 128.f) + EPS);
            {
                bf16_t* q = QF + (size_t)t * 768 + hd * 96;
                float v[12], ss = 0.f;
#pragma unroll
                for (int m = 0; m < 12; ++m) { v[m] = bf2f(in_q[rr][m]) * rcq; ss += v[m] * v[m]; }
                ss += __shfl_xor(ss, 1); ss += __shfl_xor(ss, 2); ss += __shfl_xor(ss, 4);
                const float rn = rsqrtf(ss * (1.f / 96.f) + EPS);
#pragma unroll
                for (int m = 0; m < 12; ++m) q[j + 8 * m] = f2bf(v[m] * rn * P.g_q[l * 96 + j + 8 * m] * (0.10206207261596575f * LOG2E));
            }
            {
                float v[12], ss = 0.f;
#pragma unroll
                for (int m = 0; m < 8; ++m) { v[m] = bf2f(in_kv[rr][m]) * rckv; ss += v[m] * v[m]; }
#pragma unroll
                for (int m = 8; m < 12; ++m) { v[m] = bf2f(in_kr[rr][m - 8]); ss += v[m] * v[m]; }
                ss += __shfl_xor(ss, 1); ss += __shfl_xor(ss, 2); ss += __shfl_xor(ss, 4);
                const float rn = rsqrtf(ss * (1.f / 96.f) + EPS);
#pragma unroll
                for (int m = 0; m < 12; ++m) v[m] = v[m] * rn * P.g_k[l * 96 + j + 8 * m];
                if (p >= CTXL) {
                    const int pos = p - CTXL;
                    const float ar = (float)(pos >> 6) * invf, ac = (float)(pos & 63) * invf;
                    double fr = (double)ar * 0.15915494309189535; fr -= rint(fr);
                    double fc = (double)ac * 0.15915494309189535; fc -= rint(fc);
                    const float sr = __builtin_amdgcn_sinf((float)fr), cr = __builtin_amdgcn_cosf((float)fr);
                    const float sc = __builtin_amdgcn_sinf((float)fc), cc = __builtin_amdgcn_cosf((float)fc);
                    const float x1a = v[8], x2a = v[10], x1b = v[9], x2b = v[11];
                    v[8] = x1a * cr - x2a * sr; v[10] = x1a * sr + x2a * cr;
                    v[9] = x1b * cc - x2b * sc; v[11] = x1b * sc + x2b * cc;
                }
                bf16_t* ko = KF + ((size_t)t * 8 + hd) * 96;
#pragma unroll
                for (int m = 0; m < 12; ++m) ko[j + 8 * m] = f2bf(v[m]);
            }
#pragma unroll
            for (int w = 0; w < 2; ++w) {
                bf16_t* q = prow + (w ? C_NK : C_NQ) + hd * 64 + j * 8;
                const float* g = (w ? P.ng_k : P.ng_q) + l * 64 + j * 8;
                float v[8], ss = 0.f;
                unpack8(w ? in_nk[rr] : in_nq[rr], v);
#pragma unroll
                for (int m = 0; m < 8; ++m) ss += v[m] * v[m];
                ss += __shfl_xor(ss, 1); ss += __shfl_xor(ss, 2); ss += __shfl_xor(ss, 4);
                const float rn = rsqrtf(ss * (1.f / 64.f) + EPS);
#pragma unroll
                for (int m = 0; m < 8; ++m) v[m] = v[m] * rn * g[m] * (w ? 1.f : 0.125f * LOG2E);
                *(uint4*)q = pack8(v);
            }
        }
        } else if (sub == 0) {
        {
            for (int rr = 0; rr < 8; ++rr) {
                const int tl = wave * 8 + rr;
                const unsigned bq = *(const unsigned*)(PB + (size_t)(t0 + tl) * PW + C_CKV + lane * 2);
                const float g0 = lo16(bq), g1 = hi16(bq);
                const float s2 = wave_sum(g0 * g0 + g1 * g1);
                if (lane == 0) rs[tl] = rsqrtf(s2 * (1.f / 128.f) + EPS);
            }
            __syncthreads();
            bf16_t* tile = (bf16_t*)(smem + 8192);
#pragma unroll
            for (int which = 0; which < 2; ++which) {
#pragma unroll
                for (int k8 = 0; k8 < 8; ++k8) {
                    const int id = tid + 256 * k8, i = id >> 6, c8 = id & 63;
                    const bf16_t* src = which ? PB + (size_t)(t0 + i) * PW + C_NV + c8 * 8
                                              : KV + (size_t)(t0 + i) * 1024 + (c8 >> 3) * 128 + 64 + (c8 & 7) * 8;
                    *(uint4*)(tile + i * 512 + c8 * 8) = *(const uint4*)src;
                }
                __syncthreads();
                bf16_t* VT = which ? VTN : VTM;
#pragma unroll
                for (int k8 = 0; k8 < 8; ++k8) {
                    const int id = tid + 256 * k8, r = id >> 2, g = id & 3;
                    float fv[8];
#pragma unroll
                    for (int i = 0; i < 8; ++i) fv[i] = bf2f(tile[(g * 8 + i) * 512 + r]) * (which ? 1.f : rs[g * 8 + i]);
                    *(uint4*)(VT + ((size_t)(bl * 8 + (r >> 6)) * 64 + (r & 63)) * TB + p0 + g * 8) = pack8(fv);
                }
                __syncthreads();
            }
        }
        } else
        {
            const int chunk = t0 >> 5;
            bf16_t* XH = (bf16_t*)(P.ws + OFF_XH);
            bf16_t* XG = (bf16_t*)(P.ws + OFF_XG);
            float* EBH = (float*)(P.ws + OFF_EBH);
            float* EBG = (float*)(P.ws + OFF_EBG);
            bf16_t* base = PB + (size_t)t0 * PW;
            float* rsh = (float*)smem + 256;
            bf16_t* inA = (bf16_t*)(smem + 8192);
            bf16_t* inB = inA + 32 * 128;
            bf16_t* inC = inB + 32 * 128;
            bf16_t* outT = inC + 32 * 128;
#pragma unroll
            for (int k4 = 0; k4 < 4; ++k4) { const int id = tid + 256 * k4, i = id >> 5, jx = id & 31; rsh[id] = bf2f(base[(size_t)i * PW + C_GR + jx]); }
            const int d = tid & 127, dr = tid >> 7;
            { const int grp = sub - 5;
                const bool isg = grp >= 4;
                const int gcol = isg ? (grp - 4) * 128 : grp * 128;
                const int cA = isg ? C_GQ + gcol : C_HQ + gcol, cB = isg ? C_GK + gcol : C_HF + gcol, cC = C_HF + 512 + gcol;
#pragma unroll
                for (int k2 = 0; k2 < 2; ++k2) {
                    const int id = tid + 256 * k2, i = id >> 4, ch = id & 15;
                    const bf16_t* row = base + (size_t)i * PW;
                    *(uint4*)(inA + i * 128 + ch * 8) = *(const uint4*)(row + cA + ch * 8);
                    *(uint4*)(inB + i * 128 + ch * 8) = *(const uint4*)(row + cB + ch * 8);
                    if (!isg) *(uint4*)(inC + i * 128 + ch * 8) = *(const uint4*)(row + cC + ch * 8);
                }
                __syncthreads();
                {
                    const int col = gcol + d;
                    float lb = 0.f, b2 = 0.f, w2[16];
#pragma unroll
                    for (int jx = 0; jx < 16; ++jx) w2[jx] = 0.f;
                    if (isg) {
#pragma unroll
                        for (int jx = 0; jx < 16; ++jx) w2[jx] = P.gla_w2[((size_t)(l * 2 + dr) * 16 + jx) * 256 + col];
                        b2 = P.gla_b2[(l * 2 + dr) * 256 + col];
                    } else if (l != 0) lb = sigmoidf_(P.lb_logits[1024 + dr * 512 + col] - P.lb_logits[dr * 512 + col]);
                    const bf16_t* fsrc = (dr && !isg) ? inC : inB;
                    bf16_t* oq = outT + (dr ? 2 : 0) * 32 * 128;
                    bf16_t* ok = oq + 32 * 128;
                    float cum = 0.f;
#pragma unroll 4
                    for (int sx = 0; sx < 32; ++sx) {
                        const int i = dr ? 31 - sx : sx;
                        const float qv = bf2f(inA[i * 128 + d]), fv = bf2f(fsrc[i * 128 + d]);
                        float qq, kk, la;
                        if (isg) {
                            float g = b2;
#pragma unroll
                            for (int jx = 0; jx < 16; ++jx) g = fmaf(rsh[i * 32 + dr * 16 + jx], w2[jx], g);
                            la = (fminf(g, 0.f) - __logf(1.f + __expf(-fabsf(g)))) * 0.0625f;
                            qq = qv * 0.125f; kk = fv;
                        } else {
                            const float av = lb + (1.f - lb) * sigmoidf_(fv);
                            la = __logf(av); kk = 1.f - av;
                            qq = siluf_(qv) * 0.08838834764831845f;
                        }
                        cum += la;
                        oq[i * 128 + d] = f2bf(qq * __expf(cum));
                        ok[i * 128 + d] = f2bf(kk * __expf(-cum));
                    }
                    if (isg) EBG[(size_t)(chunk * 2 + dr) * 256 + col] = __expf(cum);
                    else EBH[(size_t)(chunk * 2 + dr) * 512 + col] = __expf(cum);
                }
                __syncthreads();
#pragma unroll
                for (int k2 = 0; k2 < 2; ++k2) {
                    const int id = tid + 256 * k2, i = id >> 4, ch = id & 15;
                    bf16_t* row = base + (size_t)i * PW;
                    const uint4 v0 = *(const uint4*)(outT + (0 * 32 + i) * 128 + ch * 8), v1 = *(const uint4*)(outT + (1 * 32 + i) * 128 + ch * 8);
                    const uint4 v2 = *(const uint4*)(outT + (2 * 32 + i) * 128 + ch * 8), v3 = *(const uint4*)(outT + (3 * 32 + i) * 128 + ch * 8);
                    *(uint4*)(row + cA + ch * 8) = v0;
                    *(uint4*)(row + cB + ch * 8) = v1;
                    if (isg) { bf16_t* xr = XG + (size_t)(t0 + i) * 512 + gcol + ch * 8; *(uint4*)xr = v2; *(uint4*)(xr + 256) = v3; }
                    else { *(uint4*)(XH + (size_t)(t0 + i) * 512 + gcol + ch * 8) = v2; *(uint4*)(row + cC + ch * 8) = v3; }
                }
                __syncthreads();
            }
        }
    }
}

template <int DQK, bool NAT>
__device__ void attn_item(const Params& P, int l, int bl, int head, int qb, unsigned char* smem) {
    constexpr int NKS = DQK / 16, KSTR = DQK + 8, VSTR = 68, KCH = DQK / 8, KLD = (DQK * 64 / 8) / 256;
    const int tid = tid_opaque(), lane = tid & 63, wave = tid >> 6, hh = lane >> 5, r32 = lane & 31;
    bf16_t* Ks = (bf16_t*)smem;
    bf16_t* Vs = Ks + 2 * 64 * KSTR;
    float* rpb_s = (float*)(Vs + 2 * 64 * VSTR);
    bf16_t* PB = (bf16_t*)(P.ws + OFF_PB);
    const int rowbase = bl * TB, q_p0 = qb * 128, ql = wave * 32 + r32;
    const bool q_ctx = qb < 2;
    int lt0 = 0, lt1 = 0;
    int qr = 0, qc = 0, r0w = 0, c0 = 0;
    if (!q_ctx) {
        if (NAT) { const int rp = qb - 2, ra = 2 * rp, rb = ra + 1; lt0 = min(max(ra - 4, 0), 120); lt1 = min(max(rb - 4, 0), 120) + 8;
            qr = ra + (wave >> 1); qc = (wave & 1) * 32 + r32; r0w = min(max(qr - 4, 0), 120); c0 = min(max(qc - 8, 0), 48); }
        else { lt0 = 0; lt1 = 128; }
    }
    const int ntiles = 4 + (lt1 - lt0);
    const bf16_t* Kbase; const bf16_t* VT; const bf16_t* qptr; int k_ld;
    if (NAT) { Kbase = PB + (size_t)rowbase * PW + C_NK + head * 64; k_ld = PW; VT = (const bf16_t*)(P.ws + OFF_VTN) + (size_t)(bl * 8 + head) * 64 * TB;
        qptr = PB + (size_t)(rowbase + q_p0 + ql) * PW + C_NQ + head * 64; }
    else { Kbase = (const bf16_t*)(P.ws + OFF_KF) + (size_t)rowbase * 768 + head * 96; k_ld = 768; VT = (const bf16_t*)(P.ws + OFF_VTM) + (size_t)(bl * 8 + head) * 64 * TB;
        qptr = (const bf16_t*)(P.ws + OFF_QF) + (size_t)(rowbase + q_p0 + ql) * 768 + head * 96; }
    if (NAT) { for (int i = tid; i < 465; i += 256) rpb_s[i] = P.rpb[(size_t)(l * 8 + head) * 465 + i] * LOG2E; }
    bf16x8 qf[NKS];
#pragma unroll
    for (int ks = 0; ks < NKS; ++ks) qf[ks] = *(const bf16x8*)(qptr + ks * 16 + hh * 8);
    bf16x8 qrot4 = qf[NKS - 2], qrot5 = qf[NKS - 1];
    if (!NAT && !q_ctx) {
        const int pos = q_p0 - CTXL + ql;
        const float base = hh ? (float)(pos & 63) : (float)(pos >> 6);
#pragma unroll
        for (int jj = 0; jj < 8; ++jj) {
            const float invf = __powf(10000.f, -(float)jj * 0.125f);
            const float ang = base * invf;
            double fr = (double)ang * 0.15915494309189535; fr -= rint(fr);
            const float sn = __builtin_amdgcn_sinf((float)fr), cs = __builtin_amdgcn_cosf((float)fr);
            const float x1 = bf2f((bf16_t)qf[4][jj]), x2 = bf2f((bf16_t)qf[5][jj]);
            qrot4[jj] = (short)f2bf(x1 * cs - x2 * sn);
            qrot5[jj] = (short)f2bf(x1 * sn + x2 * cs);
        }
    }
    float m_run = -1e30f, lsum = 0.f;
    f32x16 oacc[2];
#pragma unroll
    for (int r = 0; r < 16; ++r) { oacc[0][r] = 0.f; oacc[1][r] = 0.f; }
    uint4 kreg0, kreg1, kreg2, vreg0, vreg1;
    kreg2 = make_uint4(0, 0, 0, 0);
    const int kid0 = tid, kid1 = tid + 256, kid2 = tid + 512;
    const int krow0 = kid0 / KCH, kch0 = kid0 % KCH, krow1 = kid1 / KCH, kch1 = kid1 % KCH, krow2 = kid2 / KCH, kch2 = kid2 % KCH;
    const int vrow0 = tid >> 3, vch = tid & 7, vrow1 = vrow0 + 32;
#define TILE_P(ti) ((ti) < 4 ? (ti) * 64 : CTXL + (lt0 + (ti) - 4) * 64)
#define GLOAD(ti) { const int p_ = TILE_P(ti); \
        kreg0 = *(const uint4*)(Kbase + (size_t)(p_ + krow0) * k_ld + kch0 * 8); \
        kreg1 = *(const uint4*)(Kbase + (size_t)(p_ + krow1) * k_ld + kch1 * 8); \
        if (KLD > 2) kreg2 = *(const uint4*)(Kbase + (size_t)(p_ + krow2) * k_ld + kch2 * 8); \
        vreg0 = *(const uint4*)(VT + (size_t)vrow0 * TB + p_ + vch * 8); \
        vreg1 = *(const uint4*)(VT + (size_t)vrow1 * TB + p_ + vch * 8); }
#define SWRITE(buf_) { bf16_t* kd_ = Ks + (buf_) * 64 * KSTR; \
        *(uint4*)(kd_ + krow0 * KSTR + kch0 * 8) = kreg0; *(uint4*)(kd_ + krow1 * KSTR + kch1 * 8) = kreg1; \
        if (KLD > 2) *(uint4*)(kd_ + krow2 * KSTR + kch2 * 8) = kreg2; \
        bf16_t* vd_ = Vs + (buf_) * 64 * VSTR + vch * 8; \
        *(uint2*)(vd_ + vrow0 * VSTR) = make_uint2(vreg0.x, vreg0.y); *(uint2*)(vd_ + vrow0 * VSTR + 4) = make_uint2(vreg0.z, vreg0.w); \
        *(uint2*)(vd_ + vrow1 * VSTR) = make_uint2(vreg1.x, vreg1.y); *(uint2*)(vd_ + vrow1 * VSTR + 4) = make_uint2(vreg1.z, vreg1.w); }
    GLOAD(0); SWRITE(0);
    __syncthreads();
    for (int ti = 0; ti < ntiles; ++ti) {
        const int buf = ti & 1;
        const bool more = ti + 1 < ntiles;
        if (more) GLOAD(ti + 1);
        if (!NAT && ti == 4) { qf[NKS - 2] = qrot4; qf[NKS - 1] = qrot5; }
        const int kr = lt0 + ti - 4;
        const bool active = !NAT || ti < 4 || (kr >= r0w && kr < r0w + 8);
        if (active) {
            const bf16_t* kb = Ks + buf * 64 * KSTR + r32 * KSTR + hh * 8;
            f32x16 st0, st1;
#pragma unroll
            for (int r = 0; r < 16; ++r) { st0[r] = 0.f; st1[r] = 0.f; }
            bf16x8 kf0[NKS], kf1[NKS];
#pragma unroll
            for (int ks = 0; ks < NKS; ++ks) { kf0[ks] = *(const bf16x8*)(kb + ks * 16); kf1[ks] = *(const bf16x8*)(kb + 32 * KSTR + ks * 16); }
            asm volatile("s_waitcnt lgkmcnt(0)" ::: "memory");
#pragma unroll
            for (int ks = 0; ks < NKS; ++ks) {
                st0 = __builtin_amdgcn_mfma_f32_32x32x16_bf16(kf0[ks], qf[ks], st0, 0, 0, 0);
                st1 = __builtin_amdgcn_mfma_f32_32x32x16_bf16(kf1[ks], qf[ks], st1, 0, 0, 0);
            }
            const bf16_t* vb = Vs + buf * 64 * VSTR + r32 * VSTR + 4 * hh;
            uint2 vfr[2][2][2][2];
#pragma unroll
            for (int uu = 0; uu < 2; ++uu)
#pragma unroll
                for (int t = 0; t < 2; ++t)
#pragma unroll
                    for (int s2 = 0; s2 < 2; ++s2) {
                        const bf16_t* a = vb + uu * 32 * VSTR + t * 32 + s2 * 16;
                        vfr[uu][t][s2][0] = *(const uint2*)a; vfr[uu][t][s2][1] = *(const uint2*)(a + 8);
                    }
            float x[32];
#pragma unroll
            for (int r = 0; r < 16; ++r) { x[r] = st0[r]; x[16 + r] = st1[r]; }
            if (NAT && ti >= 4) {
                const int dr = kr - qr + 7;
#pragma unroll
                for (int e = 0; e < 32; ++e) {
                    const int r = e & 15, kc = (e >> 4) * 32 + (r & 3) + 8 * (r >> 2) + 4 * hh;
                    const int dc = min(max(kc - qc, -15), 15) + 15;
                    const bool ok = (kc >= c0) && (kc < c0 + 16);
                    x[e] = ok ? x[e] + rpb_s[dr * 31 + dc] : -1e30f;
                }
            }
            float mx = x[0];
#pragma unroll
            for (int e = 1; e < 32; ++e) mx = fmaxf(mx, x[e]);
            mx = fmaxf(mx, __shfl_xor(mx, 32));
            const float m_new = fmaxf(m_run, mx);
            const bool resc = __ballot(m_new > m_run) != 0ull;
            const float alpha = __builtin_amdgcn_exp2f(m_run - m_new);
            m_run = m_new;
            float ps = 0.f;
#pragma unroll
            for (int e = 0; e < 32; ++e) { x[e] = __builtin_amdgcn_exp2f(x[e] - m_new); ps += x[e]; }
            lsum = lsum * alpha + ps;
            if (resc) {
#pragma unroll
                for (int r = 0; r < 16; ++r) { oacc[0][r] *= alpha; oacc[1][r] *= alpha; }
            }
            bf16x8 pf[2][2];
#pragma unroll
            for (int t = 0; t < 2; ++t)
#pragma unroll
                for (int s = 0; s < 2; ++s) {
                    union { bf16x8 v; unsigned u[4]; } cv;
#pragma unroll
                    for (int q = 0; q < 4; ++q) cv.u[q] = cvt_pk(x[16 * t + 8 * s + 2 * q], x[16 * t + 8 * s + 2 * q + 1]);
                    pf[t][s] = cv.v;
                }
#pragma unroll
            for (int uu = 0; uu < 2; ++uu)
#pragma unroll
                for (int t = 0; t < 2; ++t)
#pragma unroll
                    for (int s = 0; s < 2; ++s) {
                        union { bf16x8 v; uint2 h[2]; } cv;
                        cv.h[0] = vfr[uu][t][s][0]; cv.h[1] = vfr[uu][t][s][1];
                        oacc[uu] = __builtin_amdgcn_mfma_f32_32x32x16_bf16(cv.v, pf[t][s], oacc[uu], 0, 0, 0);
                    }
        }
        if (more) SWRITE((ti + 1) & 1);
        __syncthreads();
    }
#undef TILE_P
#undef GLOAD
#undef SWRITE
    lsum += __shfl_xor(lsum, 32);
    const float inv = 1.f / lsum;
    bf16_t* zrow = PB + (size_t)(rowbase + q_p0 + ql) * PW + C_Z + (NAT ? 512 : 0) + head * 64;
#pragma unroll
    for (int uu = 0; uu < 2; ++uu)
#pragma unroll
        for (int g = 0; g < 4; ++g) {
            bf16_t* zp = zrow + uu * 32 + 8 * g + 4 * hh;
            const uint2 z = *(const uint2*)zp;
            uint2 o;
            o.x = cvt_pk(oacc[uu][4 * g + 0] * inv * siluf_(lo16(z.x)), oacc[uu][4 * g + 1] * inv * siluf_(hi16(z.x)));
            o.y = cvt_pk(oacc[uu][4 * g + 2] * inv * siluf_(lo16(z.y)), oacc[uu][4 * g + 3] * inv * siluf_(hi16(z.y)));
            *(uint2*)zp = o;
        }
}

__device__ void scan_hg_item(const Params& P, int l, int item, unsigned char* smem) {
    const int tid = tid_opaque(), lane = tid & 63, wave = tid >> 6;
    const int slice = item & 7, dir = (item >> 3) & 1, head = (item >> 4) & 3, bl = item >> 6;
    float* a_s = (float*)smem;
    float* q_s = a_s + 64 * 128;
    float* v_s = q_s + 64 * 128;
    float* o_s = v_s + 64 * 16;
    const bf16_t* PB = (const bf16_t*)(P.ws + OFF_PB) + (size_t)bl * TB * PW;
    bf16_t* OS = (bf16_t*)(P.ws + OFF_KV) + ((size_t)dir * NTH + (size_t)bl * TB) * 512 + head * 128 + slice * 16;
    const int prow = tid >> 4, pd = (tid & 15) * 8;
    float lb[8];
#pragma unroll
    for (int e = 0; e < 8; ++e) {
        const int cidx = dir * 512 + head * 128 + pd + e;
        lb[e] = (l == 0) ? 0.f : sigmoidf_(P.lb_logits[1024 + cidx] - P.lb_logits[cidx]);
    }
    const int fcol = (dir ? C_HF + 512 : C_HF) + head * 128 + pd, qcol = C_HQ + head * 128 + pd, vcol = C_HI + head * 128 + slice * 16 + (tid & 1) * 8;
    uint4 rq[4], rf[4], rv;
    auto chunk_p = [&](int c) { const int ci = dir ? (c < 4 ? 3 - c : 135 - c) : c; return ci * 64; };
    auto gload = [&](int c) {
        const int p = chunk_p(c);
#pragma unroll
        for (int r = 0; r < 4; ++r) { const bf16_t* row = PB + (size_t)(p + prow + 16 * r) * PW; rq[r] = *(const uint4*)(row + qcol); rf[r] = *(const uint4*)(row + fcol); }
        if (tid < 128) rv = *(const uint4*)(PB + (size_t)(p + (tid >> 1)) * PW + vcol);
    };
    const int dg = lane & 15, col = wave * 4 + (lane >> 4);
    float S[8];
#pragma unroll
    for (int e = 0; e < 8; ++e) S[e] = 0.f;
    gload(0);
    for (int c = 0; c < 132; ++c) {
        __syncthreads();
#pragma unroll
        for (int r = 0; r < 4; ++r) {
            float fq[8], ff[8];
            unpack8(rq[r], fq); unpack8(rf[r], ff);
            float* ad = a_s + (prow + 16 * r) * 128 + pd; float* qd = q_s + (prow + 16 * r) * 128 + pd;
#pragma unroll
            for (int e = 0; e < 8; ++e) { ad[e] = lb[e] + (1.f - lb[e]) * sigmoidf_(ff[e]); qd[e] = siluf_(fq[e]) * 0.08838834764831845f; }
        }
        if (tid < 128) { float fv[8]; unpack8(rv, fv); float* vd = v_s + (tid >> 1) * 16 + (tid & 1) * 8;
#pragma unroll
            for (int e = 0; e < 8; ++e) vd[e] = fv[e]; }
        __syncthreads();
        if (c + 1 < 132) gload(c + 1);
        for (int tt = 0; tt < 64; tt += 8) {
            float op[8];
#pragma unroll
            for (int u = 0; u < 8; ++u) {
                const int i = dir ? 63 - (tt + u) : tt + u;
                const float4 a0 = *(const float4*)(a_s + i * 128 + dg * 8), a1 = *(const float4*)(a_s + i * 128 + dg * 8 + 4);
                const float4 q0 = *(const float4*)(q_s + i * 128 + dg * 8), q1 = *(const float4*)(q_s + i * 128 + dg * 8 + 4);
                const float v = v_s[i * 16 + col];
                float o;
                S[0] = fmaf(a0.x, S[0] - v, v); o = q0.x * S[0];
                S[1] = fmaf(a0.y, S[1] - v, v); o = fmaf(q0.y, S[1], o);
                S[2] = fmaf(a0.z, S[2] - v, v); o = fmaf(q0.z, S[2], o);
                S[3] = fmaf(a0.w, S[3] - v, v); o = fmaf(q0.w, S[3], o);
                S[4] = fmaf(a1.x, S[4] - v, v); o = fmaf(q1.x, S[4], o);
                S[5] = fmaf(a1.y, S[5] - v, v); o = fmaf(q1.y, S[5], o);
                S[6] = fmaf(a1.z, S[6] - v, v); o = fmaf(q1.z, S[6], o);
                S[7] = fmaf(a1.w, S[7] - v, v); o = fmaf(q1.w, S[7], o);
                op[u] = o;
            }
            float r4[4], r2[2];
            const bool b8 = dg & 8, b4 = dg & 4, b2 = dg & 2;
#pragma unroll
            for (int k = 0; k < 4; ++k) { const float snd = b8 ? op[k] : op[k + 4], kp = b8 ? op[k + 4] : op[k]; r4[k] = kp + __shfl_xor(snd, 8); }
#pragma unroll
            for (int k = 0; k < 2; ++k) { const float snd = b4 ? r4[k] : r4[k + 2], kp = b4 ? r4[k + 2] : r4[k]; r2[k] = kp + __shfl_xor(snd, 4); }
            float r1; { const float snd = b2 ? r2[0] : r2[1], kp = b2 ? r2[1] : r2[0]; r1 = kp + __shfl_xor(snd, 2); }
            r1 += __shfl_xor(r1, 1);
            if ((dg & 1) == 0) { const int tok = tt + (b8 ? 4 : 0) + (b4 ? 2 : 0) + (b2 ? 1 : 0); const int i = dir ? 63 - tok : tok; o_s[i * 16 + col] = r1; }
        }
        __syncthreads();
        if (tid < 128) {
            const int p = chunk_p(c) + (tid >> 1);
            *(uint4*)(OS + (size_t)p * 512 + (tid & 1) * 8) = pack8(o_s + (tid >> 1) * 16 + (tid & 1) * 8);
        }
    }
}

__device__ void scan_gla_item(const Params& P, int l, int item, unsigned char* smem) {
    const int tid = tid_opaque(), lane = tid & 63, wave = tid >> 6;
    const int slice = item & 3, dir = (item >> 2) & 1, head = (item >> 3) & 3, bl = item >> 5;
    float* a_s = (float*)smem;
    float* q_s = a_s + 64 * 64;
    float* k_s = q_s + 64 * 64;
    float* v_s = k_s + 64 * 64;
    float* o_s = v_s + 64 * 32;
    float* r_s = o_s + 64 * 32;
    const bf16_t* PB = (const bf16_t*)(P.ws + OFF_PB) + (size_t)bl * TB * PW;
    bf16_t* OS = (bf16_t*)(P.ws + OFF_OSG) + ((size_t)dir * NTH + (size_t)bl * TB) * 512 + head * 128 + slice * 32;
    const int gd = tid & 63, gt0 = tid >> 6;
    float w2[16];
#pragma unroll
    for (int jx = 0; jx < 16; ++jx) w2[jx] = P.gla_w2[((size_t)(l * 2 + dir) * 16 + jx) * 256 + head * 64 + gd];
    const float b2 = P.gla_b2[(l * 2 + dir) * 256 + head * 64 + gd];
    uint4 rq[2], rk[2], rv, rr;
    auto chunk_p = [&](int c) { const int ci = dir ? (c < 4 ? 3 - c : 135 - c) : c; return ci * 64; };
    auto gload = [&](int c) {
        const int p = chunk_p(c);
#pragma unroll
        for (int i = 0; i < 2; ++i) { const int id = tid + 256 * i, row = id >> 3, ch = id & 7; const bf16_t* rp = PB + (size_t)(p + row) * PW;
            rq[i] = *(const uint4*)(rp + C_GQ + head * 64 + ch * 8); rk[i] = *(const uint4*)(rp + C_GK + head * 64 + ch * 8); }
        { const int row = tid >> 2, ch = tid & 3; rv = *(const uint4*)(PB + (size_t)(p + row) * PW + C_GV + head * 128 + slice * 32 + ch * 8); }
        if (tid < 128) { const int row = tid >> 1, ch = tid & 1; rr = *(const uint4*)(PB + (size_t)(p + row) * PW + C_GR + dir * 16 + ch * 8); }
    };
    const int dg = lane & 7, col = wave * 8 + (lane >> 3);
    float S[8];
#pragma unroll
    for (int e = 0; e < 8; ++e) S[e] = 0.f;
    gload(0);
    for (int c = 0; c < 132; ++c) {
        __syncthreads();
#pragma unroll
        for (int i = 0; i < 2; ++i) { const int id = tid + 256 * i, row = id >> 3, ch = id & 7; float fq[8], fk[8]; unpack8(rq[i], fq); unpack8(rk[i], fk);
#pragma unroll
            for (int e = 0; e < 8; ++e) { q_s[row * 64 + ch * 8 + e] = fq[e] * 0.125f; k_s[row * 64 + ch * 8 + e] = fk[e]; } }
        { const int row = tid >> 2, ch = tid & 3; float fv[8]; unpack8(rv, fv);
#pragma unroll
            for (int e = 0; e < 8; ++e) v_s[row * 32 + ch * 8 + e] = fv[e]; }
        if (tid < 128) { const int row = tid >> 1, ch = tid & 1; float fr[8]; unpack8(rr, fr);
#pragma unroll
            for (int e = 0; e < 8; ++e) r_s[row * 16 + ch * 8 + e] = fr[e]; }
        __syncthreads();
        if (c + 1 < 132) gload(c + 1);
#pragma unroll 4
        for (int m = 0; m < 16; ++m) {
            const int i = gt0 + 4 * m;
            float g = b2;
#pragma unroll
            for (int jx = 0; jx < 16; ++jx) g = fmaf(r_s[i * 16 + jx], w2[jx], g);
            const float ls = fminf(g, 0.f) - __logf(1.f + __expf(-fabsf(g)));
            a_s[i * 64 + gd] = __expf(ls * 0.0625f);
        }
        __syncthreads();
        for (int tt = 0; tt < 64; tt += 8) {
            float op[8];
#pragma unroll
            for (int u = 0; u < 8; ++u) {
                const int i = dir ? 63 - (tt + u) : tt + u;
                const float4 a0 = *(const float4*)(a_s + i * 64 + dg * 8), a1 = *(const float4*)(a_s + i * 64 + dg * 8 + 4);
                const float4 q0 = *(const float4*)(q_s + i * 64 + dg * 8), q1 = *(const float4*)(q_s + i * 64 + dg * 8 + 4);
                const float4 k0 = *(const float4*)(k_s + i * 64 + dg * 8), k1 = *(const float4*)(k_s + i * 64 + dg * 8 + 4);
                const float v = v_s[i * 32 + col];
                float o;
                S[0] = fmaf(a0.x, S[0], k0.x * v); o = q0.x * S[0];
                S[1] = fmaf(a0.y, S[1], k0.y * v); o = fmaf(q0.y, S[1], o);
                S[2] = fmaf(a0.z, S[2], k0.z * v); o = fmaf(q0.z, S[2], o);
                S[3] = fmaf(a0.w, S[3], k0.w * v); o = fmaf(q0.w, S[3], o);
                S[4] = fmaf(a1.x, S[4], k1.x * v); o = fmaf(q1.x, S[4], o);
                S[5] = fmaf(a1.y, S[5], k1.y * v); o = fmaf(q1.y, S[5], o);
                S[6] = fmaf(a1.z, S[6], k1.z * v); o = fmaf(q1.z, S[6], o);
                S[7] = fmaf(a1.w, S[7], k1.w * v); o = fmaf(q1.w, S[7], o);
                op[u] = o;
            }
            float r4[4], r2[2];
            const bool b4 = dg & 4, b2 = dg & 2, b1 = dg & 1;
#pragma unroll
            for (int k = 0; k < 4; ++k) { const float snd = b4 ? op[k] : op[k + 4], kp = b4 ? op[k + 4] : op[k]; r4[k] = kp + __shfl_xor(snd, 4); }
#pragma unroll
            for (int k = 0; k < 2; ++k) { const float snd = b2 ? r4[k] : r4[k + 2], kp = b2 ? r4[k + 2] : r4[k]; r2[k] = kp + __shfl_xor(snd, 2); }
            float r1; { const float snd = b1 ? r2[0] : r2[1], kp = b1 ? r2[1] : r2[0]; r1 = kp + __shfl_xor(snd, 1); }
            { const int tok = tt + (b4 ? 4 : 0) + (b2 ? 2 : 0) + (b1 ? 1 : 0); const int i = dir ? 63 - tok : tok; o_s[i * 32 + col] = r1; }
        }
        __syncthreads();
        { const int row = tid >> 2, ch = tid & 3; const int p = chunk_p(c) + row;
          *(uint4*)(OS + (size_t)p * 512 + ch * 8) = pack8(o_s + row * 32 + ch * 8); }
    }
}


template <bool GLA>
__device__ void scan2_item(const Params& P, int l, int item, unsigned char* smem) {
    constexpr int DK = GLA ? 64 : 128, NT = DK / 32, QS = DK + 8, TS = 40, NSEG = GLA ? 4 : 2, TPS = 32 / NSEG, QCH = DK / 8;
    const int tid = tid_opaque(), lane = tid & 63, wave = tid >> 6, r32 = lane & 31, hh = lane >> 5;
    const int dir = item & 1, head = (item >> 1) & 3, bl = item >> 3;
    bf16_t* Qh = (bf16_t*)smem;
    bf16_t* Kh = Qh + 32 * QS;
    bf16_t* Kt = Kh + 32 * QS;
    bf16_t* Vt = Kt + DK * TS;
    float* eb = (float*)(Vt + 128 * TS);
    float* tot = eb + DK;
    bf16_t* qraw = (bf16_t*)(tot + 4 * DK);
    bf16_t* fraw = qraw + 32 * DK;
    bf16_t* vraw = fraw + 32 * DK;
    bf16_t* rraw = vraw + 32 * 128;
    const bf16_t* PB = (const bf16_t*)(P.ws + OFF_PB) + (size_t)bl * TB * PW;
    bf16_t* OS = (bf16_t*)(P.ws + (GLA ? OFF_OSG : OFF_KV)) + ((size_t)dir * NTH + (size_t)bl * TB) * 512 + head * 128 + wave * 32;
    const int qcol = (GLA ? C_GQ : C_HQ) + head * DK, fcol = GLA ? (C_GK + head * 64) : ((dir ? C_HF + 512 : C_HF) + head * 128),
              vcol = (GLA ? C_GV : C_HI) + head * 128, rcol = C_GR + dir * 16;
    const int pd = tid & (DK - 1), seg = tid / DK;
    float lbv = 0.f, b2 = 0.f, w2[16];
#pragma unroll
    for (int jx = 0; jx < 16; ++jx) w2[jx] = 0.f;
    if (GLA) {
#pragma unroll
        for (int jx = 0; jx < 16; ++jx) w2[jx] = P.gla_w2[((size_t)(l * 2 + dir) * 16 + jx) * 256 + head * 64 + pd];
        b2 = P.gla_b2[(l * 2 + dir) * 256 + head * 64 + pd];
    } else if (l != 0) { const int cidx = dir * 512 + head * 128 + pd; lbv = sigmoidf_(P.lb_logits[1024 + cidx] - P.lb_logits[cidx]); }
    uint4 pq0, pq1, pf0, pf1, pv0, pv1, pr;
    pq1 = pf1 = pr = make_uint4(0, 0, 0, 0);
#define CH_P0(c) (dir ? ((c) < 8 ? (7 - (c)) * 32 : CTXL + (263 - (c)) * 32) : (c) * 32)
#define ROWP(p0_, i_) ((p0_) + (dir ? 31 - (i_) : (i_)))
#define SC_GLOAD(c) { const int p0_ = CH_P0(c); \
        { const int id = tid, i = id / QCH, ch = id % QCH; const bf16_t* rp = PB + (size_t)ROWP(p0_, i) * PW; pq0 = *(const uint4*)(rp + qcol + ch * 8); pf0 = *(const uint4*)(rp + fcol + ch * 8); } \
        if (!GLA) { const int id = tid + 256, i = id / QCH, ch = id % QCH; const bf16_t* rp = PB + (size_t)ROWP(p0_, i) * PW; pq1 = *(const uint4*)(rp + qcol + ch * 8); pf1 = *(const uint4*)(rp + fcol + ch * 8); } \
        { const int i = tid >> 4, ch = tid & 15; pv0 = *(const uint4*)(PB + (size_t)ROWP(p0_, i) * PW + vcol + ch * 8); pv1 = *(const uint4*)(PB + (size_t)ROWP(p0_, i + 16) * PW + vcol + ch * 8); } \
        if (GLA && tid < 64) { const int i = tid >> 1, ch = tid & 1; pr = *(const uint4*)(PB + (size_t)ROWP(p0_, i) * PW + rcol + ch * 8); } }
    f32x16 ST[NT];
#pragma unroll
    for (int T = 0; T < NT; ++T)
#pragma unroll
        for (int r = 0; r < 16; ++r) ST[T][r] = 0.f;
    SC_GLOAD(0);
    for (int c = 0; c < 264; ++c) {
        __syncthreads();
        { const int id = tid, i = id / QCH, ch = id % QCH; *(uint4*)(qraw + i * DK + ch * 8) = pq0; *(uint4*)(fraw + i * DK + ch * 8) = pf0; }
        if (!GLA) { const int id = tid + 256, i = id / QCH, ch = id % QCH; *(uint4*)(qraw + i * DK + ch * 8) = pq1; *(uint4*)(fraw + i * DK + ch * 8) = pf1; }
        { const int i = tid >> 4, ch = tid & 15; *(uint4*)(vraw + i * 128 + ch * 8) = pv0; *(uint4*)(vraw + (i + 16) * 128 + ch * 8) = pv1; }
        if (GLA && tid < 64) { const int i = tid >> 1, ch = tid & 1; *(uint4*)(rraw + i * 16 + ch * 8) = pr; }
        __syncthreads();
        if (c + 1 < 264) SC_GLOAD(c + 1);
        float bl_[TPS], kk[TPS], qq[TPS];
        float cum = 0.f;
#pragma unroll
        for (int tt = 0; tt < TPS; ++tt) {
            const int i = seg * TPS + tt;
            float la;
            if (GLA) {
                float g = b2;
#pragma unroll
                for (int jx = 0; jx < 16; ++jx) g = fmaf(bf2f(rraw[i * 16 + jx]), w2[jx], g);
                la = (fminf(g, 0.f) - __logf(1.f + __expf(-fabsf(g)))) * 0.0625f;
                kk[tt] = bf2f(fraw[i * DK + pd]);
                qq[tt] = bf2f(qraw[i * DK + pd]) * 0.125f;
            } else {
                const float f = bf2f(fraw[i * DK + pd]);
                const float a = lbv + (1.f - lbv) * sigmoidf_(f);
                la = __logf(a);
                kk[tt] = 1.f - a;
                qq[tt] = siluf_(bf2f(qraw[i * DK + pd])) * 0.08838834764831845f;
            }
            cum += la;
            bl_[tt] = cum;
        }
        tot[seg * DK + pd] = cum;
        __syncthreads();
        {
            float off = 0.f, bend = 0.f;
#pragma unroll
            for (int sg = 0; sg < NSEG; ++sg) { const float tv = tot[sg * DK + pd]; bend += tv; if (sg < seg) off += tv; }
            const float eend = __expf(bend);
            if (seg == 0) eb[pd] = eend;
            float kt[TPS];
#pragma unroll
            for (int tt = 0; tt < TPS; ++tt) {
                const int i = seg * TPS + tt;
                const float b = bl_[tt] + off;
                const float e1 = __expf(b), e2 = __expf(-b);
                const float kh = kk[tt] * e2;
                Qh[i * QS + pd] = f2bf(qq[tt] * e1);
                Kh[i * QS + pd] = f2bf(kh);
                kt[tt] = kh * eend;
            }
#pragma unroll
            for (int g8 = 0; g8 < TPS / 8; ++g8) *(uint4*)(Kt + pd * TS + seg * TPS + g8 * 8) = pack8(kt + g8 * 8);
            const int vc = tid & 127, vs = tid >> 7;
            float vv[16];
#pragma unroll
            for (int tt = 0; tt < 16; ++tt) vv[tt] = bf2f(vraw[(vs * 16 + tt) * 128 + vc]);
            *(uint4*)(Vt + vc * TS + vs * 16) = pack8(vv);
            *(uint4*)(Vt + vc * TS + vs * 16 + 8) = pack8(vv + 8);
        }
        __syncthreads();
        f32x16 st;
#pragma unroll
        for (int r = 0; r < 16; ++r) st[r] = 0.f;
#pragma unroll
        for (int ks = 0; ks < DK / 16; ++ks) {
            const bf16x8 ka = *(const bf16x8*)(Kh + r32 * QS + ks * 16 + hh * 8);
            const bf16x8 qb = *(const bf16x8*)(Qh + r32 * QS + ks * 16 + hh * 8);
            st = __builtin_amdgcn_mfma_f32_32x32x16_bf16(ka, qb, st, 0, 0, 0);
        }
        bf16x8 pfr[2];
#pragma unroll
        for (int sI = 0; sI < 2; ++sI) {
            union { bf16x8 v; unsigned u[4]; } cv;
#pragma unroll
            for (int q = 0; q < 4; ++q) {
                const int ra = 8 * sI + 2 * q, rb = ra + 1;
                const int ja = (ra & 3) + 8 * (ra >> 2) + 4 * hh, jb = (rb & 3) + 8 * (rb >> 2) + 4 * hh;
                cv.u[q] = cvt_pk(ja <= r32 ? st[ra] : 0.f, jb <= r32 ? st[rb] : 0.f);
            }
            pfr[sI] = cv.v;
        }
        f32x16 oT;
#pragma unroll
        for (int r = 0; r < 16; ++r) oT[r] = 0.f;
#pragma unroll
        for (int sI = 0; sI < 2; ++sI) {
            const bf16_t* a = Vt + (wave * 32 + r32) * TS + sI * 16 + 4 * hh;
            union { bf16x8 v; uint2 h[2]; } cv;
            cv.h[0] = *(const uint2*)a; cv.h[1] = *(const uint2*)(a + 8);
            oT = __builtin_amdgcn_mfma_f32_32x32x16_bf16(cv.v, pfr[sI], oT, 0, 0, 0);
        }
#pragma unroll
        for (int T = 0; T < NT; ++T)
#pragma unroll
            for (int sI = 0; sI < 2; ++sI) {
                union { bf16x8 v; unsigned u[4]; } ca;
#pragma unroll
                for (int q = 0; q < 4; ++q) ca.u[q] = cvt_pk(ST[T][8 * sI + 2 * q], ST[T][8 * sI + 2 * q + 1]);
                const bf16_t* b = Qh + r32 * QS + T * 32 + sI * 16 + 4 * hh;
                union { bf16x8 v; uint2 h[2]; } cb;
                cb.h[0] = *(const uint2*)b; cb.h[1] = *(const uint2*)(b + 8);
                oT = __builtin_amdgcn_mfma_f32_32x32x16_bf16(ca.v, cb.v, oT, 0, 0, 0);
            }
#pragma unroll
        for (int T = 0; T < NT; ++T) {
#pragma unroll
            for (int g = 0; g < 4; ++g) {
                const float4 e4 = *(const float4*)(eb + T * 32 + 8 * g + 4 * hh);
                ST[T][4 * g + 0] *= e4.x; ST[T][4 * g + 1] *= e4.y; ST[T][4 * g + 2] *= e4.z; ST[T][4 * g + 3] *= e4.w;
            }
#pragma unroll
            for (int ks = 0; ks < 2; ++ks) {
                const bf16x8 ka = *(const bf16x8*)(Kt + (T * 32 + r32) * TS + ks * 16 + hh * 8);
                const bf16x8 vb = *(const bf16x8*)(Vt + (wave * 32 + r32) * TS + ks * 16 + hh * 8);
                ST[T] = __builtin_amdgcn_mfma_f32_32x32x16_bf16(ka, vb, ST[T], 0, 0, 0);
            }
        }
        {
            const int p = ROWP(CH_P0(c), r32);
            bf16_t* op = OS + (size_t)p * 512 + 4 * hh;
#pragma unroll
            for (int g = 0; g < 4; ++g) { uint2 o; o.x = cvt_pk(oT[4 * g], oT[4 * g + 1]); o.y = cvt_pk(oT[4 * g + 2], oT[4 * g + 3]); *(uint2*)(op + 8 * g) = o; }
        }
    }
#undef CH_P0
#undef ROWP
#undef SC_GLOAD
}


template <bool GLA>
__device__ __forceinline__ void scan3_rest(f32x16 (&ST)[GLA ? 2 : 4], bf16_t* Qh, bf16_t* Kh, bf16_t* Kt, bf16_t* Vt, float* eb, bf16_t* vraw, bf16_t* OS,
                                           int tid, int wave, int r32, int hh, int pd, int seg, int c, int dir) {
    constexpr int DK = GLA ? 64 : 128, NT = DK / 32, QS = DK + 8, TS = 40, NSEG = GLA ? 4 : 2, TPS = 32 / NSEG;
#define CH_P0(c) (dir ? ((c) < 8 ? (7 - (c)) * 32 : CTXL + (263 - (c)) * 32) : (c) * 32)
#define ROWP(p0_, i_) ((p0_) + (dir ? 31 - (i_) : (i_)))
        {
            const float eend = eb[pd];
            float kt[TPS];
#pragma unroll
            for (int tt = 0; tt < TPS; ++tt) kt[tt] = bf2f(Kh[(seg * TPS + tt) * QS + pd]) * eend;
#pragma unroll
            for (int g8 = 0; g8 < TPS / 8; ++g8) *(uint4*)(Kt + pd * TS + seg * TPS + g8 * 8) = pack8(kt + g8 * 8);
            const int vc = tid & 127, vs = tid >> 7;
            float vv[16];
#pragma unroll
            for (int tt = 0; tt < 16; ++tt) vv[tt] = bf2f(vraw[(vs * 16 + tt) * 128 + vc]);
            *(uint4*)(Vt + vc * TS + vs * 16) = pack8(vv);
            *(uint4*)(Vt + vc * TS + vs * 16 + 8) = pack8(vv + 8);
        }
        __syncthreads();
        f32x16 st, stb;
#pragma unroll
        for (int r = 0; r < 16; ++r) { st[r] = 0.f; stb[r] = 0.f; }
        {
            bf16x8 ka[DK / 16], qb[DK / 16];
#pragma unroll
            for (int ks = 0; ks < DK / 16; ++ks) { ka[ks] = *(const bf16x8*)(Kh + r32 * QS + ks * 16 + hh * 8); qb[ks] = *(const bf16x8*)(Qh + r32 * QS + ks * 16 + hh * 8); }
            asm volatile("s_waitcnt lgkmcnt(0)" ::: "memory");
#pragma unroll
            for (int ks = 0; ks < DK / 16; ks += 2) {
                st = __builtin_amdgcn_mfma_f32_32x32x16_bf16(ka[ks], qb[ks], st, 0, 0, 0);
                stb = __builtin_amdgcn_mfma_f32_32x32x16_bf16(ka[ks + 1], qb[ks + 1], stb, 0, 0, 0);
            }
        }
        uint2 vp[2][2], qp[NT][2][2];
#pragma unroll
        for (int sI = 0; sI < 2; ++sI) { const bf16_t* av = Vt + (wave * 32 + r32) * TS + sI * 16 + 4 * hh; vp[sI][0] = *(const uint2*)av; vp[sI][1] = *(const uint2*)(av + 8); }
#pragma unroll
        for (int T = 0; T < NT; ++T)
#pragma unroll
            for (int sI = 0; sI < 2; ++sI) { const bf16_t* bq = Qh + r32 * QS + T * 32 + sI * 16 + 4 * hh; qp[T][sI][0] = *(const uint2*)bq; qp[T][sI][1] = *(const uint2*)(bq + 8); }
#pragma unroll
        for (int r = 0; r < 16; ++r) st[r] += stb[r];
        bf16x8 pfr[2];
#pragma unroll
        for (int sI = 0; sI < 2; ++sI) {
            union { bf16x8 v; unsigned u[4]; } cv;
#pragma unroll
            for (int q = 0; q < 4; ++q) {
                const int ra = 8 * sI + 2 * q, rb = ra + 1;
                const int ja = (ra & 3) + 8 * (ra >> 2) + 4 * hh, jb = (rb & 3) + 8 * (rb >> 2) + 4 * hh;
                cv.u[q] = cvt_pk(ja <= r32 ? st[ra] : 0.f, jb <= r32 ? st[rb] : 0.f);
            }
            pfr[sI] = cv.v;
        }
        asm volatile("s_waitcnt lgkmcnt(0)" ::: "memory");
        f32x16 oT, oTb;
#pragma unroll
        for (int r = 0; r < 16; ++r) { oT[r] = 0.f; oTb[r] = 0.f; }
#pragma unroll
        for (int sI = 0; sI < 2; ++sI) {
            union { bf16x8 v; uint2 h[2]; } cv;
            cv.h[0] = vp[sI][0]; cv.h[1] = vp[sI][1];
            oT = __builtin_amdgcn_mfma_f32_32x32x16_bf16(cv.v, pfr[sI], oT, 0, 0, 0);
        }
#pragma unroll
        for (int T = 0; T < NT; ++T)
#pragma unroll
            for (int sI = 0; sI < 2; ++sI) {
                union { bf16x8 v; unsigned u[4]; } ca;
#pragma unroll
                for (int q = 0; q < 4; ++q) ca.u[q] = cvt_pk(ST[T][8 * sI + 2 * q], ST[T][8 * sI + 2 * q + 1]);
                union { bf16x8 v; uint2 h[2]; } cb;
                cb.h[0] = qp[T][sI][0]; cb.h[1] = qp[T][sI][1];
                if (T & 1) oTb = __builtin_amdgcn_mfma_f32_32x32x16_bf16(ca.v, cb.v, oTb, 0, 0, 0);
                else oT = __builtin_amdgcn_mfma_f32_32x32x16_bf16(ca.v, cb.v, oT, 0, 0, 0);
            }
        {
            bf16x8 kt2[NT][2], vb2[2];
            float4 e4v[NT][4];
#pragma unroll
            for (int ks = 0; ks < 2; ++ks) vb2[ks] = *(const bf16x8*)(Vt + (wave * 32 + r32) * TS + ks * 16 + hh * 8);
#pragma unroll
            for (int T = 0; T < NT; ++T) {
#pragma unroll
                for (int ks = 0; ks < 2; ++ks) kt2[T][ks] = *(const bf16x8*)(Kt + (T * 32 + r32) * TS + ks * 16 + hh * 8);
#pragma unroll
                for (int g = 0; g < 4; ++g) e4v[T][g] = *(const float4*)(eb + T * 32 + 8 * g + 4 * hh);
            }
            asm volatile("s_waitcnt lgkmcnt(0)" ::: "memory");
#pragma unroll
            for (int T = 0; T < NT; ++T) {
#pragma unroll
                for (int g = 0; g < 4; ++g) { ST[T][4 * g + 0] *= e4v[T][g].x; ST[T][4 * g + 1] *= e4v[T][g].y; ST[T][4 * g + 2] *= e4v[T][g].z; ST[T][4 * g + 3] *= e4v[T][g].w; }
#pragma unroll
                for (int ks = 0; ks < 2; ++ks) ST[T] = __builtin_amdgcn_mfma_f32_32x32x16_bf16(kt2[T][ks], vb2[ks], ST[T], 0, 0, 0);
            }
        }
#pragma unroll
        for (int r = 0; r < 16; ++r) oT[r] += oTb[r];
        {
            const int p = ROWP(CH_P0(c), r32);
            bf16_t* op = OS + (size_t)p * 512 + 4 * hh;
#pragma unroll
            for (int g = 0; g < 4; ++g) { uint2 o; o.x = cvt_pk(oT[4 * g], oT[4 * g + 1]); o.y = cvt_pk(oT[4 * g + 2], oT[4 * g + 3]); *(uint2*)(op + 8 * g) = o; }
        }
#undef CH_P0
#undef ROWP
}

template <bool GLA>
__device__ void scan3_item(const Params& P, int l, int item, unsigned char* smem) {
    constexpr int DK = GLA ? 64 : 128, NT = DK / 32, QS = DK + 8, TS = 40, NSEG = GLA ? 4 : 2, TPS = 32 / NSEG, QCH = DK / 8;
    const int tid = tid_opaque(), lane = tid & 63, wave = tid >> 6, r32 = lane & 31, hh = lane >> 5;
    const int dir = item & 1, head = (item >> 1) & 3, bl = item >> 3;
    __builtin_amdgcn_s_setprio(3);
    bf16_t* Qh = (bf16_t*)smem;
    bf16_t* Kh = Qh + 32 * QS;
    bf16_t* Kt = Kh + 32 * QS;
    bf16_t* Vt = Kt + DK * TS;
    float* eb = (float*)(Vt + 128 * TS);
    bf16_t* vraw = (bf16_t*)(eb + DK);
    const bf16_t* PB = (const bf16_t*)(P.ws + OFF_PB) + (size_t)bl * TB * PW;
    bf16_t* OS = (bf16_t*)(P.ws + (GLA ? OFF_OSG : OFF_KV)) + ((size_t)dir * NTH + (size_t)bl * TB) * 512 + head * 128 + wave * 32;
    const bf16_t* qsrc; const bf16_t* ksrc; int qld, kld;
    if (GLA) {
        if (dir == 0) { qsrc = PB + C_GQ + head * 64; qld = PW; ksrc = PB + C_GK + head * 64; kld = PW; }
        else { const bf16_t* X = (const bf16_t*)(P.ws + OFF_XG) + (size_t)bl * TB * 512; qsrc = X + head * 64; qld = 512; ksrc = X + 256 + head * 64; kld = 512; }
    } else {
        if (dir == 0) { qsrc = PB + C_HQ + head * 128; qld = PW; ksrc = PB + C_HF + head * 128; kld = PW; }
        else { qsrc = (const bf16_t*)(P.ws + OFF_XH) + (size_t)bl * TB * 512 + head * 128; qld = 512; ksrc = PB + C_HF + 512 + head * 128; kld = PW; }
    }
    const float* ebsrc = (const float*)(P.ws + (GLA ? OFF_EBG : OFF_EBH)) + ((size_t)(bl * 264) * 2 + dir) * (4 * DK) + head * DK;
    const int vcol = (GLA ? C_GV : C_HI) + head * 128;
    const int pd = tid & (DK - 1), seg = tid / DK;
    uint4 pq0A, pq1A, pk0A, pk1A, pv0A, pv1A, pq0B, pq1B, pk0B, pk1B, pv0B, pv1B; float peA = 0.f, peB = 0.f;
    pq1A = pk1A = pq1B = pk1B = make_uint4(0, 0, 0, 0);
#define CH_P0(c) (dir ? ((c) < 8 ? (7 - (c)) * 32 : CTXL + (263 - (c)) * 32) : (c) * 32)
#define ROWP(p0_, i_) ((p0_) + (dir ? 31 - (i_) : (i_)))
#define SC_GLOAD(c, S) { const int p0_ = CH_P0(c); \
        { const int id = tid, i = id / QCH, ch = id % QCH; const size_t rr_ = (size_t)ROWP(p0_, i); pq0##S = *(const uint4*)(qsrc + rr_ * qld + ch * 8); pk0##S = *(const uint4*)(ksrc + rr_ * kld + ch * 8); } \
        if (!GLA) { const int id = tid + 256, i = id / QCH, ch = id % QCH; const size_t rr_ = (size_t)ROWP(p0_, i); pq1##S = *(const uint4*)(qsrc + rr_ * qld + ch * 8); pk1##S = *(const uint4*)(ksrc + rr_ * kld + ch * 8); } \
        { const int i = tid >> 4, ch = tid & 15; pv0##S = *(const uint4*)(PB + (size_t)ROWP(p0_, i) * PW + vcol + ch * 8); pv1##S = *(const uint4*)(PB + (size_t)ROWP(p0_, i + 16) * PW + vcol + ch * 8); } \
        if (tid < DK) pe##S = ebsrc[(size_t)(p0_ >> 5) * 2 * (4 * DK) + tid]; }
    f32x16 ST[NT];
#pragma unroll
    for (int T = 0; T < NT; ++T)
#pragma unroll
        for (int r = 0; r < 16; ++r) ST[T][r] = 0.f;
#define SC_COPY(S) { \
        { const int id = tid, i = id / QCH, ch = id % QCH; *(uint4*)(Qh + i * QS + ch * 8) = pq0##S; *(uint4*)(Kh + i * QS + ch * 8) = pk0##S; } \
        if (!GLA) { const int id = tid + 256, i = id / QCH, ch = id % QCH; *(uint4*)(Qh + i * QS + ch * 8) = pq1##S; *(uint4*)(Kh + i * QS + ch * 8) = pk1##S; } \
        { const int i = tid >> 4, ch = tid & 15; *(uint4*)(vraw + i * 128 + ch * 8) = pv0##S; *(uint4*)(vraw + (i + 16) * 128 + ch * 8) = pv1##S; } \
        if (tid < DK) eb[tid] = pe##S; }
    SC_GLOAD(0, A);
    SC_GLOAD(1, B);
    for (int c = 0; c < 264; c += 2) {
        __syncthreads();
        SC_COPY(A);
        __syncthreads();
        { const int cl_ = c + 2 < 264 ? c + 2 : 263; SC_GLOAD(cl_, A); asm volatile("" ::: "memory"); }
        scan3_rest<GLA>(ST, Qh, Kh, Kt, Vt, eb, vraw, OS, tid, wave, r32, hh, pd, seg, c, dir);
        __syncthreads();
        SC_COPY(B);
        __syncthreads();
        { const int cl_ = c + 3 < 264 ? c + 3 : 263; SC_GLOAD(cl_, B); asm volatile("" ::: "memory"); }
        scan3_rest<GLA>(ST, Qh, Kh, Kt, Vt, eb, vraw, OS, tid, wave, r32, hh, pd, seg, c + 1, dir);
    }
#undef SC_COPY
#undef CH_P0
#undef ROWP
#undef SC_GLOAD
    __builtin_amdgcn_s_setprio(0);
}

#ifdef ONLYI
#define IT_ON(n) (ONLYI == (n))
#else
#define IT_ON(n) true
#endif
__device__ void phase_mixers(const Params& P, int ph, int l, unsigned char* smem, int mode = 0) {
    constexpr int N_HG = 16, N_GLA = 16, N_ATT = 2 * 8 * 66;
    const int bx = blockIdx.x;
    int my_scan = -1;
    if (mode != 2 && bx < 256 && (bx & 7) == ((bx >> 3) & 7)) my_scan = bx >> 3;
    if (mode == 0 && bx >= 256 && ((bx - 256) & 7) == (((bx - 256) >> 3) & 7)) return;
    for (;;) {
        int it;
        if (my_scan >= 0) { it = my_scan; my_scan = -1; }
        else {
            if (mode == 1) break;
            it = next_item(P, ph) + N_HG + N_GLA;
        }
        if (it >= N_HG + N_GLA + 2 * N_ATT) break;
        if (it < N_HG) { if (IT_ON(0)) scan3_item<false>(P, l, it, smem); continue; }
        it -= N_HG;
        if (it < N_GLA) { if (IT_ON(1)) scan3_item<true>(P, l, it, smem); continue; }
        it -= N_GLA;
        if (it < N_ATT) { const int bl = it / 528, rem = it % 528; if (IT_ON(2)) attn_item<96, false>(P, l, bl, rem / 66, rem % 66, smem); continue; }
        it -= N_ATT;
        { const int bl = it / 528, rem = it % 528; if (IT_ON(3)) attn_item<64, true>(P, l, bl, rem / 66, rem % 66, smem); }
    }
}

__device__ void phase_scanfin(const Params& P, int ph, int l) {
    const int tid = tid_opaque(), lane = tid & 63, wave = tid >> 6;
    bf16_t* PB = (bf16_t*)(P.ws + OFF_PB);
    const bf16_t* OSH = (const bf16_t*)(P.ws + OFF_KV);
    const bf16_t* OSGp = (const bf16_t*)(P.ws + OFF_OSG);
    float gh[8], gg[8];
#pragma unroll
    for (int e = 0; e < 8; ++e) { gh[e] = P.hg_g_o[l * 128 + (lane & 15) * 8 + e]; gg[e] = P.gla_g_o[l * 128 + (lane & 15) * 8 + e]; }
    for (;;) {
        const int u = next_item(P, ph);
        if (u >= NTH / 16) break;
        uint4 ra[8], rb[8], rz[8];
#pragma unroll
        for (int k = 0; k < 8; ++k) {
            const int t = u * 16 + wave * 4 + (k >> 1), mx = k & 1;
            const bf16_t* OS = mx ? OSGp : OSH;
            ra[k] = *(const uint4*)(OS + (size_t)t * 512 + lane * 8);
            rb[k] = *(const uint4*)(OS + ((size_t)NTH + t) * 512 + lane * 8);
            rz[k] = *(const uint4*)(PB + (size_t)t * PW + C_Z + (2 + mx) * 512 + lane * 8);
        }
#pragma unroll
        for (int k = 0; k < 8; ++k) {
            const int t = u * 16 + wave * 4 + (k >> 1), mx = k & 1;
            float a[8], b[8], z[8];
            unpack8(ra[k], a); unpack8(rb[k], b); unpack8(rz[k], z);
            float ss = 0.f;
#pragma unroll
            for (int e = 0; e < 8; ++e) { a[e] += b[e]; ss += a[e] * a[e]; }
            ss += __shfl_xor(ss, 1); ss += __shfl_xor(ss, 2); ss += __shfl_xor(ss, 4); ss += __shfl_xor(ss, 8);
            const float rn = rsqrtf(ss * (1.f / 128.f) + EPS);
#pragma unroll
            for (int e = 0; e < 8; ++e) a[e] = a[e] * rn * (mx ? gg[e] : gh[e]) * siluf_(z[e]);
            *(uint4*)(PB + (size_t)t * PW + C_Z + (2 + mx) * 512 + lane * 8) = pack8(a);
        }
    }
}

__device__ void phase_merge(const Params& P, int ph, int l, unsigned char* smem) {
    const int tid_ = tid_opaque(), lane = tid_ & 63, wave = tid_ >> 6, wr = wave >> 1, wc = wave & 1;
    const bf16_t* H = (const bf16_t*)(P.ws + OFF_H);
    const bf16_t* PB = (const bf16_t*)(P.ws + OFF_PB);
    bf16_t* ACC = (bf16_t*)(P.ws + OFF_KV);
    for (;;) {
        const int u = next_item(P, ph);
        if (u >= 132 * 16) break;
        const int mt = u >> 4, nt = u & 15;
        const int col = nt * 64 + wc * 32 + (lane & 31);
        f32x16 tot[2];
#pragma unroll
        for (int r = 0; r < 16; ++r) { tot[0][r] = 0.f; tot[1][r] = 0.f; }
        for (int br = 0; br < 4; ++br) {
            unsigned gate[2][8];
            f32x16 g[2], pa[2];
#pragma unroll
            for (int r = 0; r < 16; ++r) { g[0][r] = 0.f; g[1][r] = 0.f; pa[0][r] = 0.f; pa[1][r] = 0.f; }
            gemm_pair_n64(g, pa, H + (size_t)mt * 128 * D, D, (const bf16_t*)(P.ws + OFF_WM) + ((size_t)(l * 4 + br) * 1024 + nt * 64) * 1024, 1024, 1024,
                          PB + (size_t)mt * 128 * PW + C_Z + br * 512, PW, (const bf16_t*)(P.ws + OFF_WBR) + ((size_t)(l * 4 + br) * 1024 + nt * 64) * 512, 512, 512, smem);
            {
                const float bm = P.b_merge[(l * 4 + br) * 1024 + col];
#pragma unroll
                for (int mi = 0; mi < 2; ++mi)
#pragma unroll
                    for (int r = 0; r < 8; ++r) gate[mi][r] = cvt_pk_asm(sigmoidf_(g[mi][2 * r] + bm), sigmoidf_(g[mi][2 * r + 1] + bm));
            }
#pragma unroll
            for (int mi = 0; mi < 2; ++mi)
#pragma unroll
                for (int r = 0; r < 8; ++r) {
                    tot[mi][2 * r] = fmaf(lo16(gate[mi][r]), pa[mi][2 * r], tot[mi][2 * r]);
                    tot[mi][2 * r + 1] = fmaf(hi16(gate[mi][r]), pa[mi][2 * r + 1], tot[mi][2 * r + 1]);
                }
        }
#pragma unroll
        for (int mi = 0; mi < 2; ++mi)
#pragma unroll
            for (int r = 0; r < 16; ++r) ACC[(size_t)(mt * 128 + ACC_ROW(mi, r)) * 1024 + col] = f2bf(tot[mi][r]);
    }
}

__device__ void phase_out(const Params& P, int ph, int l, int hf, unsigned char* smem) {
    const int tid_ = tid_opaque(), lane = tid_ & 63, wave = tid_ >> 6, wr = wave >> 1, wc = wave & 1;
    const bf16_t* ACC = (const bf16_t*)(P.ws + OFF_KV);
    const float* mod = (const float*)(P.ws + OFF_MOD);
    for (;;) {
        const int u = next_item(P, ph);
        if (u >= 132 * 8) break;
        const int mt = u >> 3, nt = u & 7;
        const int t0 = mt * 128, bl = t0 / TB, p0 = t0 % TB, b = hf * 2 + bl;
        const bool isctx = p0 < CTXL;
        if (isctx && l == 1) continue;
        f32x16 acc[2][2]; zero_acc(acc);
        gemm_tile_pf2(acc, ACC + (size_t)mt * 128 * 1024, 1024, (const bf16_t*)(P.ws + OFF_WO) + ((size_t)l * 1024 + nt * 128) * 1024, 1024, 1024, smem);
        const float* gt = mod + (l * 5 + (isctx ? 4 : b)) * 3072 + 2048 + nt * 128;
        const float* src; float* dst;
        if (isctx) { src = P.ctx + ((size_t)b * CTXL + p0) * D; dst = (float*)(P.ws + OFF_CX1) + ((size_t)b * CTXL + p0) * D; }
        else { const size_t o = ((size_t)b * SEQ + (p0 - CTXL)) * D; src = (l == 0 ? P.x : (const float*)P.out) + o; dst = P.out + o; }
        float rv[2][2][16];
#pragma unroll
        for (int mi = 0; mi < 2; ++mi)
#pragma unroll
            for (int ni = 0; ni < 2; ++ni)
#pragma unroll
                for (int r = 0; r < 16; ++r) rv[mi][ni][r] = src[(size_t)ACC_ROW(mi, r) * D + nt * 128 + ACC_COL(ni)];
#pragma unroll
        for (int mi = 0; mi < 2; ++mi)
#pragma unroll
            for (int ni = 0; ni < 2; ++ni) {
                const int cl = ACC_COL(ni);
                const float g = gt[cl];
#pragma unroll
                for (int r = 0; r < 16; ++r) { const size_t o = (size_t)ACC_ROW(mi, r) * D + nt * 128 + cl; dst[o] = rv[mi][ni][r] + g * acc[mi][ni][r]; }
            }
    }
}

__global__ void __launch_bounds__(256, 2) mega(Params PK) {
    extern __shared__ __attribute__((aligned(16))) unsigned char smem[];
    if (blockIdx.x == 0 && threadIdx.x == 0) {
        Params* T = (Params*)(PK.ws + OFF_TAB);
        T->x = PK.x; T->c = PK.c; T->ctx = PK.ctx; T->c_ctx = PK.c_ctx; T->ada_w = PK.ada_w; T->ada_b = PK.ada_b; T->norm_g = PK.norm_g; T->w_in = PK.w_in;
        T->w_uq = PK.w_uq; T->w_ukv = PK.w_ukv; T->g_cq = PK.g_cq; T->g_ckv = PK.g_ckv; T->g_q = PK.g_q; T->g_k = PK.g_k; T->rpb = PK.rpb; T->ng_q = PK.ng_q; T->ng_k = PK.ng_k;
        T->lb_logits = PK.lb_logits; T->hg_g_o = PK.hg_g_o; T->gla_w2 = PK.gla_w2; T->gla_b2 = PK.gla_b2; T->gla_g_o = PK.gla_g_o; T->w_br = PK.w_br; T->w_merge = PK.w_merge;
        T->b_merge = PK.b_merge; T->w_out = PK.w_out; T->out = PK.out; T->ws = PK.ws; T->ph_lo = PK.ph_lo; T->ph_hi = PK.ph_hi;
    }
    unsigned char* wsb = PK.ws;
    const int ph_lo = PK.ph_lo, ph_hi = PK.ph_hi;
#ifdef PROBE_SUB
    __shared__ long long s_tacc, s_tprev; if (threadIdx.x == 0) { s_tacc = 0; s_tprev = 0; }
#endif
    for (int ph = ph_lo; ph < ph_hi; ++ph) {
#ifndef SPLIT_MIX
        if (ph > 8 && ((ph - 1) & 7) == 0) continue;
#endif
        if (ph > ph_lo) cg::this_grid().sync();
        const Params& P = PK;
#ifdef PROBE_SUB
        if (threadIdx.x == 0) { const long long t_now = wall_clock64();
#ifdef SPLIT_MIX
            const int prev_sub = (ph == 0) ? -1 : (ph == 1 ? 9 : ((ph - 2) % 9));
#else
            const int prev_sub = (ph == 0) ? -1 : (ph == 1 ? 8 : ((ph - 2) & 7));
#endif
            if (prev_sub == PROBE_SUB) s_tacc += t_now - s_tprev; s_tprev = t_now; }
#endif
#ifdef ONLYP
#define PH_ON(n) ((ONLYP >> (n)) & 1)
#else
#define PH_ON(n) true
#endif
        if (ph == 0) { if (PH_ON(8)) phase_prologue(PK, ph, smem); continue; }
#ifdef SPLIT_MIX
        const int q = ph - 1, pass = q / 9, sub9 = q % 9, l = pass >> 1, hf = pass & 1;
        if (sub9 == 4 || sub9 == 5) { phase_mixers(P, ph, l, smem, sub9 - 3); continue; }
        const int sub = sub9 < 4 ? sub9 : sub9 - 1;
        switch (sub) {
            case 0: phase_norm(P, ph, l, hf); break;
            case 1: phase_gemm1(P, ph, l, smem); break;
            case 2: phase_gemm2(P, ph, l, smem); break;
            case 3: phase_finalize(P, ph, l, smem); break;
            case 5: phase_scanfin(P, ph, l); break;
            case 6: phase_merge(P, ph, l, smem); break;
            default: phase_out(P, ph, l, hf, smem); break;
        }
#else
        const int q = ph - 1, pass = q >> 3, sub = q & 7, l = pass >> 1, hf = pass & 1;
        switch (sub) {
            case 0: if (PH_ON(0)) phase_norm(P, ph, l, hf); break;
            case 1: if (PH_ON(1)) phase_gemm1(P, ph, l, smem); break;
            case 2: if (PH_ON(2)) phase_gemm2(P, ph, l, smem); break;
            case 3: if (PH_ON(3)) phase_finalize(P, ph, l, smem); break;
            case 4: if (PH_ON(4)) phase_mixers(P, ph, l, smem); break;
            case 5: if (PH_ON(5)) phase_scanfin(P, ph, l); break;
            case 6: if (PH_ON(6)) phase_merge(P, ph, l, smem); break;
            default: if (PH_ON(7)) { phase_out(P, ph, l, hf, smem); if (pass < 3) phase_norm(P, ph + 40, (pass + 1) >> 1, (pass + 1) & 1); } break;
        }
#endif
    }
#ifdef PROBE_SUB
    cg::this_grid().sync();
    if (threadIdx.x == 0) { const long long t_now = wall_clock64(); if (7 == PROBE_SUB) s_tacc += t_now - s_tprev;
      if (blockIdx.x == 0) { const long long t_acc = s_tacc; const long long t0 = wall_clock64(); while (wall_clock64() - t0 < t_acc) { __builtin_amdgcn_s_sleep(10); } } }
#endif
}

extern "C" void kernel_launch(void* const* d_in, const int* in_sizes, int n_in, void* d_out, int out_size, void* d_ws, size_t ws_size, hipStream_t stream) {
    static int grid = 0;
    if (grid == 0) {
        if (ws_size < WS_END) { fprintf(stderr, "workspace too small: %zu < %zu\n", ws_size, (size_t)WS_END); grid = -1; return; }
        int dev = 0, cus = 0, per_cu = 0;
        hipGetDevice(&dev);
        hipDeviceGetAttribute(&cus, hipDeviceAttributeMultiprocessorCount, dev);
        hipFuncSetAttribute((const void*)mega, hipFuncAttributeMaxDynamicSharedMemorySize, LDS_BYTES);
        hipOccupancyMaxActiveBlocksPerMultiprocessor(&per_cu, (const void*)mega, 256, LDS_BYTES);
        if (per_cu < 1) per_cu = 1;
        if (per_cu > 2) per_cu = 2;
        grid = cus * per_cu;
        (void)hipGetLastError();
    }
    if (grid < 0) return;
    hipMemsetAsync((unsigned char*)d_ws + OFF_CTL, 0, 4096, stream);
    Params p{};
    const float** pp = (const float**)&p;
    for (int i = 0; i < 26; ++i) pp[i] = (const float*)d_in[i];
    p.out = (float*)d_out; p.ws = (unsigned char*)d_ws;
#if SINGLE_LAUNCH
    p.ph_lo = 0; p.ph_hi = NPHASE;
    void* args[] = {&p};
    hipError_t e = hipLaunchCooperativeKernel((const void*)mega, dim3(grid), dim3(256), args, LDS_BYTES, stream);
    if (e != hipSuccess) fprintf(stderr, "cooperative launch failed: %s (grid %d)\n", hipGetErrorString(e), grid);
#else
    for (int ph = 0; ph < NPHASE; ++ph) {
        p.ph_lo = ph; p.ph_hi = ph + 1;
        hipLaunchKernelGGL(mega, dim3(grid), dim3(256), LDS_BYTES, stream, p);
    }
#endif
}
```

```cpp
#include <hip/hip_runtime.h>
#include <hip/hip_cooperative_groups.h>
#include <stdint.h>
#include <stdio.h>
namespace cg = cooperative_groups;

typedef unsigned short bf16_t;
typedef short bf16x8 __attribute__((ext_vector_type(8)));
typedef short bf16x4 __attribute__((ext_vector_type(4)));
typedef float f32x16 __attribute__((ext_vector_type(16)));

#ifndef SINGLE_LAUNCH
#define SINGLE_LAUNCH 1
#endif

constexpr int D = 1024, SEQ = 8192, CTXL = 256, TB = SEQ + CTXL  , NTH = 2 * TB  ;
constexpr int INW = 7104, PW = 7104;
constexpr int C_CQ = 0, C_CKV = 256, C_KR = 384, C_NQ = 416, C_NK = 928, C_NV = 1440, C_HQ = 1952, C_HF = 2464, C_HI = 3488,
              C_GQ = 4000, C_GK = 4256, C_GV = 4512, C_GR = 5024, C_Z = 5056;
constexpr float EPS = 1e-6f;
constexpr float LOG2E = 1.4426950408889634f;
constexpr int LDS_BYTES = 73728;
#ifdef SPLIT_MIX
constexpr int NPHASE = 37;
#else
constexpr int NPHASE = 33;
#endif

constexpr size_t al256(size_t v) { return (v + 255) & ~(size_t)255; }
constexpr size_t OFF_CTL = 0;
constexpr size_t OFF_TAB = 1024;
constexpr size_t OFF_MOD = 4096;
constexpr size_t OFF_CX1 = al256(OFF_MOD + 2 * 5 * 3072 * 4);
constexpr size_t OFF_WIN = al256(OFF_CX1 + (size_t)4 * 256 * 1024 * 4);
constexpr size_t OFF_WM = al256(OFF_WIN + (size_t)2 * 7168 * 1024 * 2);
constexpr size_t OFF_WBR = al256(OFF_WM + (size_t)8 * 1024 * 1024 * 2);
constexpr size_t OFF_WO = al256(OFF_WBR + (size_t)8 * 1024 * 512 * 2);
constexpr size_t OFF_WUQ = al256(OFF_WO + (size_t)2 * 1024 * 1024 * 2);
constexpr size_t OFF_WUKV = al256(OFF_WUQ + (size_t)2 * 768 * 256 * 2);
constexpr size_t OFF_H = al256(OFF_WUKV + (size_t)2 * 1024 * 128 * 2);
constexpr size_t OFF_PB = al256(OFF_H + (size_t)NTH * 1024 * 2);
constexpr size_t OFF_QF = al256(OFF_PB + (size_t)NTH * PW * 2);
constexpr size_t OFF_KV = al256(OFF_QF + (size_t)NTH * 768 * 2);
constexpr size_t OFF_KF = al256(OFF_KV + (size_t)NTH * 1024 * 2);
constexpr size_t OFF_VTM = al256(OFF_KF + (size_t)NTH * 768 * 2);
constexpr size_t OFF_VTN = al256(OFF_VTM + (size_t)2 * 8 * 64 * TB * 2);
constexpr size_t OFF_OSG = al256(OFF_VTN + (size_t)2 * 8 * 64 * TB * 2);
constexpr size_t OFF_XH = al256(OFF_OSG + (size_t)2 * NTH * 512 * 2);
constexpr size_t OFF_XG = al256(OFF_XH + (size_t)NTH * 512 * 2);
constexpr size_t OFF_EBH = al256(OFF_XG + (size_t)NTH * 512 * 2);
constexpr size_t OFF_EBG = al256(OFF_EBH + (size_t)528 * 2 * 512 * 4);
constexpr size_t WS_END = al256(OFF_EBG + (size_t)528 * 2 * 256 * 4);

static_assert(WS_END <= (size_t)512 * 1024 * 1024, "workspace map exceeds 512 MiB");
struct Params {
    const float *x, *c, *ctx, *c_ctx, *ada_w, *ada_b, *norm_g, *w_in, *w_uq, *w_ukv, *g_cq, *g_ckv, *g_q, *g_k, *rpb, *ng_q, *ng_k,
        *lb_logits, *hg_g_o, *gla_w2, *gla_b2, *gla_g_o, *w_br, *w_merge, *b_merge, *w_out;
    float* out;
    unsigned char* ws;
    int ph_lo, ph_hi;
};

__device__ __forceinline__ float bf2f(bf16_t v) { return __uint_as_float(((unsigned)v) << 16); }
typedef float f32x2_t __attribute__((ext_vector_type(2)));
typedef __bf16 bf16x2_t __attribute__((ext_vector_type(2)));
__device__ __forceinline__ unsigned cvt_pk(float lo, float hi) { f32x2_t v = {lo, hi}; bf16x2_t b = __builtin_convertvector(v, bf16x2_t); return __builtin_bit_cast(unsigned, b); }
__device__ __forceinline__ unsigned cvt_pk_asm(float lo, float hi) { unsigned r; asm("s_nop 1\n\tv_cvt_pk_bf16_f32 %0, %1, %2" : "=v"(r) : "v"(lo), "v"(hi)); return r; }
__device__ __forceinline__ bf16_t f2bf(float f) { return (bf16_t)(cvt_pk(f, 0.f) & 0xffffu); }
__device__ __forceinline__ float lo16(unsigned u) { return __uint_as_float(u << 16); }
__device__ __forceinline__ float hi16(unsigned u) { return __uint_as_float(u & 0xffff0000u); }
__device__ __forceinline__ float sigmoidf_(float x) { return 1.f / (1.f + __expf(-x)); }
__device__ __forceinline__ float siluf_(float x) { return x / (1.f + __expf(-x)); }
__device__ __forceinline__ float wave_sum(float v) {
#pragma unroll
    for (int o = 32; o > 0; o >>= 1) v += __shfl_xor(v, o);
    return v;
}
__device__ __forceinline__ void unpack8(uint4 u, float* f) {
    f[0] = lo16(u.x); f[1] = hi16(u.x); f[2] = lo16(u.y); f[3] = hi16(u.y); f[4] = lo16(u.z); f[5] = hi16(u.z); f[6] = lo16(u.w); f[7] = hi16(u.w);
}
__device__ __forceinline__ uint4 pack8(const float* f) { uint4 u; u.x = cvt_pk(f[0], f[1]); u.y = cvt_pk(f[2], f[3]); u.z = cvt_pk(f[4], f[5]); u.w = cvt_pk(f[6], f[7]); return u; }

__device__ __forceinline__ int tid_opaque() { int t = threadIdx.x; asm volatile("" : "+v"(t)); return t; }
__shared__ int s_item;
__device__ __forceinline__ int next_item(const Params& P, int ph) {
    __syncthreads();
    if (threadIdx.x == 0) s_item = atomicAdd((int*)(P.ws + OFF_CTL) + ph, 1);
    __syncthreads();
    return s_item;
}

constexpr int GS = 72;
__device__ __forceinline__ void gemm_tile(f32x16 (&acc)[2][2], const bf16_t* __restrict__ A, int lda, const bf16_t* __restrict__ Bt, int ldb, int K, unsigned char* smem) {
    const int tid = tid_opaque(), lane = tid & 63, wave = tid >> 6, wr = wave >> 1, wc = wave & 1;
    bf16_t* sA = (bf16_t*)smem;
    bf16_t* sB = sA + 2 * 128 * GS;
    const int lrow = tid >> 3, lch = (tid & 7) * 8;
    uint4 ra[4], rb[4];
    const bf16_t* Ap = A + (size_t)lrow * lda + lch;
    const bf16_t* Bp = Bt + (size_t)lrow * ldb + lch;
#pragma unroll
    for (int i = 0; i < 4; ++i) { ra[i] = *(const uint4*)(Ap + (size_t)(32 * i) * lda); rb[i] = *(const uint4*)(Bp + (size_t)(32 * i) * ldb); }
#pragma unroll
    for (int i = 0; i < 4; ++i) { *(uint4*)(sA + (lrow + 32 * i) * GS + lch) = ra[i]; *(uint4*)(sB + (lrow + 32 * i) * GS + lch) = rb[i]; }
    __syncthreads();
    const int nk = K >> 6;
    const int aoff = (wr * 64 + (lane & 31)) * GS + (lane >> 5) * 8, boff = (wc * 64 + (lane & 31)) * GS + (lane >> 5) * 8;
    for (int kt = 0; kt < nk; ++kt) {
        const bool more = kt + 1 < nk;
        if (more) {
#pragma unroll
            for (int i = 0; i < 4; ++i) { ra[i] = *(const uint4*)(Ap + (size_t)(32 * i) * lda + (kt + 1) * 64); rb[i] = *(const uint4*)(Bp + (size_t)(32 * i) * ldb + (kt + 1) * 64); }
        }
        const bf16_t* a = sA + (kt & 1) * 128 * GS + aoff;
        const bf16_t* b = sB + (kt & 1) * 128 * GS + boff;
#pragma unroll
        for (int ks = 0; ks < 4; ++ks) {
            bf16x8 a0 = *(const bf16x8*)(a + ks * 16), a1 = *(const bf16x8*)(a + 32 * GS + ks * 16);
            bf16x8 b0 = *(const bf16x8*)(b + ks * 16), b1 = *(const bf16x8*)(b + 32 * GS + ks * 16);
            acc[0][0] = __builtin_amdgcn_mfma_f32_32x32x16_bf16(a0, b0, acc[0][0], 0, 0, 0);
            acc[0][1] = __builtin_amdgcn_mfma_f32_32x32x16_bf16(a0, b1, acc[0][1], 0, 0, 0);
            acc[1][0] = __builtin_amdgcn_mfma_f32_32x32x16_bf16(a1, b0, acc[1][0], 0, 0, 0);
            acc[1][1] = __builtin_amdgcn_mfma_f32_32x32x16_bf16(a1, b1, acc[1][1], 0, 0, 0);
        }
        if (more) {
            bf16_t* wa = sA + ((kt + 1) & 1) * 128 * GS;
            bf16_t* wb = sB + ((kt + 1) & 1) * 128 * GS;
#pragma unroll
            for (int i = 0; i < 4; ++i) { *(uint4*)(wa + (lrow + 32 * i) * GS + lch) = ra[i]; *(uint4*)(wb + (lrow + 32 * i) * GS + lch) = rb[i]; }
        }
        __syncthreads();
    }
}

__device__ __forceinline__ void gemm_tile_pf2(f32x16 (&acc)[2][2], const bf16_t* __restrict__ A, int lda, const bf16_t* __restrict__ Bt, int ldb, int K, unsigned char* smem) {
    const int tid = tid_opaque(), lane = tid & 63, wave = tid >> 6, wr = wave >> 1, wc = wave & 1;
    bf16_t* sA = (bf16_t*)smem;
    bf16_t* sB = sA + 2 * 128 * GS;
    const int lrow = tid >> 3, lch = (tid & 7) * 8;
    uint4 pa0, pa1, pa2, pa3, pb0, pb1, pb2, pb3, qa0, qa1, qa2, qa3, qb0, qb1, qb2, qb3;
    const bf16_t* Ap = A + (size_t)lrow * lda + lch;
    const bf16_t* Bp = Bt + (size_t)lrow * ldb + lch;
    const int nk = K >> 6;
#define PF2_LD1(RA, RB, kt_, i) { RA##i = *(const uint4*)(Ap + (size_t)(32 * i) * lda + (kt_) * 64); RB##i = *(const uint4*)(Bp + (size_t)(32 * i) * ldb + (kt_) * 64); }
#define PF2_LOAD(RA, RB, kt_) { PF2_LD1(RA, RB, kt_, 0) PF2_LD1(RA, RB, kt_, 1) PF2_LD1(RA, RB, kt_, 2) PF2_LD1(RA, RB, kt_, 3) }
#define PF2_WR1(RA, RB, i) { *(uint4*)(wa + (lrow + 32 * i) * GS + lch) = RA##i; *(uint4*)(wb + (lrow + 32 * i) * GS + lch) = RB##i; }
#define PF2_WRITE(RA, RB, buf_) { bf16_t* wa = sA + (buf_) * 128 * GS; bf16_t* wb = sB + (buf_) * 128 * GS; PF2_WR1(RA, RB, 0) PF2_WR1(RA, RB, 1) PF2_WR1(RA, RB, 2) PF2_WR1(RA, RB, 3) }
#define PF2_COMPUTE(buf_) { const bf16_t* a = sA + (buf_) * 128 * GS + aoff; const bf16_t* b = sB + (buf_) * 128 * GS + boff; _Pragma("unroll") for (int ks = 0; ks < 4; ++ks) { \
        bf16x8 a0 = *(const bf16x8*)(a + ks * 16), a1 = *(const bf16x8*)(a + 32 * GS + ks * 16); bf16x8 b0 = *(const bf16x8*)(b + ks * 16), b1 = *(const bf16x8*)(b + 32 * GS + ks * 16); \
        acc[0][0] = __builtin_amdgcn_mfma_f32_32x32x16_bf16(a0, b0, acc[0][0], 0, 0, 0); acc[0][1] = __builtin_amdgcn_mfma_f32_32x32x16_bf16(a0, b1, acc[0][1], 0, 0, 0); \
        acc[1][0] = __builtin_amdgcn_mfma_f32_32x32x16_bf16(a1, b0, acc[1][0], 0, 0, 0); acc[1][1] = __builtin_amdgcn_mfma_f32_32x32x16_bf16(a1, b1, acc[1][1], 0, 0, 0); } }
    const int aoff = (wr * 64 + (lane & 31)) * GS + (lane >> 5) * 8, boff = (wc * 64 + (lane & 31)) * GS + (lane >> 5) * 8;
    PF2_LOAD(pa, pb, 0);
    PF2_LOAD(qa, qb, 1);
    PF2_WRITE(pa, pb, 0);
    __syncthreads();
    for (int kt = 0; kt < nk; kt += 2) {
        if (kt + 2 < nk) PF2_LOAD(pa, pb, kt + 2);
        PF2_COMPUTE(0);
        PF2_WRITE(qa, qb, 1);
        __syncthreads();
        if (kt + 3 < nk) PF2_LOAD(qa, qb, kt + 3);
        PF2_COMPUTE(1);
        if (kt + 2 < nk) PF2_WRITE(pa, pb, 0);
        __syncthreads();
    }
#undef PF2_LOAD
#undef PF2_LD1
#undef PF2_WR1
#undef PF2_WRITE
#undef PF2_COMPUTE
}

__device__ __forceinline__ void gemm_tile_n64(f32x16 (&acc)[2], const bf16_t* __restrict__ A, int lda, const bf16_t* __restrict__ Bt, int ldb, int K, unsigned char* smem) {
    const int tid = tid_opaque(), lane = tid & 63, wave = tid >> 6, wr = wave >> 1, wc = wave & 1;
    bf16_t* sA = (bf16_t*)smem;
    bf16_t* sB = sA + 2 * 128 * GS;
    const int lrow = tid >> 3, lch = (tid & 7) * 8;
    uint4 pa0, pa1, pa2, pa3, pb0, pb1, qa0, qa1, qa2, qa3, qb0, qb1;
    const bf16_t* Ap = A + (size_t)lrow * lda + lch;
    const bf16_t* Bp = Bt + (size_t)lrow * ldb + lch;
    const int nk = K >> 6;
#define N64_LOAD(RA, RB, kt_) { RA##0 = *(const uint4*)(Ap + (kt_) * 64); RA##1 = *(const uint4*)(Ap + (size_t)32 * lda + (kt_) * 64); RA##2 = *(const uint4*)(Ap + (size_t)64 * lda + (kt_) * 64); RA##3 = *(const uint4*)(Ap + (size_t)96 * lda + (kt_) * 64); \
        RB##0 = *(const uint4*)(Bp + (kt_) * 64); RB##1 = *(const uint4*)(Bp + (size_t)32 * ldb + (kt_) * 64); }
#define N64_WRITE(RA, RB, buf_) { bf16_t* wa = sA + (buf_) * 128 * GS + lrow * GS + lch; bf16_t* wb = sB + (buf_) * 64 * GS + lrow * GS + lch; \
        *(uint4*)wa = RA##0; *(uint4*)(wa + 32 * GS) = RA##1; *(uint4*)(wa + 64 * GS) = RA##2; *(uint4*)(wa + 96 * GS) = RA##3; *(uint4*)wb = RB##0; *(uint4*)(wb + 32 * GS) = RB##1; }
#define N64_COMPUTE(buf_) { const bf16_t* a = sA + (buf_) * 128 * GS + aoff; const bf16_t* b = sB + (buf_) * 64 * GS + boff; _Pragma("unroll") for (int ks = 0; ks < 4; ++ks) { \
        bf16x8 a0 = *(const bf16x8*)(a + ks * 16), a1 = *(const bf16x8*)(a + 32 * GS + ks * 16); bf16x8 b0 = *(const bf16x8*)(b + ks * 16); \
        acc[0] = __builtin_amdgcn_mfma_f32_32x32x16_bf16(a0, b0, acc[0], 0, 0, 0); acc[1] = __builtin_amdgcn_mfma_f32_32x32x16_bf16(a1, b0, acc[1], 0, 0, 0); } }
    const int aoff = (wr * 64 + (lane & 31)) * GS + (lane >> 5) * 8, boff = (wc * 32 + (lane & 31)) * GS + (lane >> 5) * 8;
    N64_LOAD(pa, pb, 0);
    N64_LOAD(qa, qb, 1);
    N64_WRITE(pa, pb, 0);
    __syncthreads();
    for (int kt = 0; kt < nk; kt += 2) {
        if (kt + 2 < nk) N64_LOAD(pa, pb, kt + 2);
        N64_COMPUTE(0);
        N64_WRITE(qa, qb, 1);
        __syncthreads();
        if (kt + 3 < nk) N64_LOAD(qa, qb, kt + 3);
        N64_COMPUTE(1);
        if (kt + 2 < nk) N64_WRITE(pa, pb, 0);
        __syncthreads();
    }
#undef N64_LOAD
#undef N64_WRITE
#undef N64_COMPUTE
}

__device__ __forceinline__ void gemm_pair_n64(f32x16 (&acc1)[2], f32x16 (&acc2)[2], const bf16_t* __restrict__ A1, int lda1, const bf16_t* __restrict__ B1, int ldb1, int K1,
                                              const bf16_t* __restrict__ A2, int lda2, const bf16_t* __restrict__ B2, int ldb2, int K2, unsigned char* smem) {
    const int tid = tid_opaque(), lane = tid & 63, wave = tid >> 6, wr = wave >> 1, wc = wave & 1;
    bf16_t* sA = (bf16_t*)smem;
    bf16_t* sB = sA + 2 * 128 * GS;
    const int lrow = tid >> 3, lch = (tid & 7) * 8;
    uint4 pa0, pa1, pa2, pa3, pb0, pb1, qa0, qa1, qa2, qa3, qb0, qb1;
    const bf16_t* Ap1 = A1 + (size_t)lrow * lda1 + lch; const bf16_t* Bp1 = B1 + (size_t)lrow * ldb1 + lch;
    const bf16_t* Ap2 = A2 + (size_t)lrow * lda2 + lch; const bf16_t* Bp2 = B2 + (size_t)lrow * ldb2 + lch;
    const int nk1 = K1 >> 6, nk = nk1 + (K2 >> 6);
#define P64_LOAD(RA, RB, kt_) { const bool s2_ = (kt_) >= nk1; const bf16_t* ap_ = s2_ ? Ap2 + ((kt_) - nk1) * 64 : Ap1 + (kt_) * 64; const bf16_t* bp_ = s2_ ? Bp2 + ((kt_) - nk1) * 64 : Bp1 + (kt_) * 64; \
        const size_t la_ = s2_ ? lda2 : lda1, lb_ = s2_ ? ldb2 : ldb1; \
        RA##0 = *(const uint4*)(ap_); RA##1 = *(const uint4*)(ap_ + 32 * la_); RA##2 = *(const uint4*)(ap_ + 64 * la_); RA##3 = *(const uint4*)(ap_ + 96 * la_); \
        RB##0 = *(const uint4*)(bp_); RB##1 = *(const uint4*)(bp_ + 32 * lb_); }
#define P64_WRITE(RA, RB, buf_) { bf16_t* wa = sA + (buf_) * 128 * GS + lrow * GS + lch; bf16_t* wb = sB + (buf_) * 64 * GS + lrow * GS + lch; \
        *(uint4*)wa = RA##0; *(uint4*)(wa + 32 * GS) = RA##1; *(uint4*)(wa + 64 * GS) = RA##2; *(uint4*)(wa + 96 * GS) = RA##3; *(uint4*)wb = RB##0; *(uint4*)(wb + 32 * GS) = RB##1; }
#define P64_COMPUTE(ACC, buf_) { const bf16_t* a = sA + (buf_) * 128 * GS + aoff; const bf16_t* b = sB + (buf_) * 64 * GS + boff; _Pragma("unroll") for (int ks = 0; ks < 4; ++ks) { \
        bf16x8 a0 = *(const bf16x8*)(a + ks * 16), a1 = *(const bf16x8*)(a + 32 * GS + ks * 16); bf16x8 b0 = *(const bf16x8*)(b + ks * 16); \
        ACC[0] = __builtin_amdgcn_mfma_f32_32x32x16_bf16(a0, b0, ACC[0], 0, 0, 0); ACC[1] = __builtin_amdgcn_mfma_f32_32x32x16_bf16(a1, b0, ACC[1], 0, 0, 0); } }
    const int aoff = (wr * 64 + (lane & 31)) * GS + (lane >> 5) * 8, boff = (wc * 32 + (lane & 31)) * GS + (lane >> 5) * 8;
    P64_LOAD(pa, pb, 0);
    P64_LOAD(qa, qb, 1);
    P64_WRITE(pa, pb, 0);
    __syncthreads();
    for (int kt = 0; kt < nk; kt += 2) {
        if (kt + 2 < nk) P64_LOAD(pa, pb, kt + 2);
        if (kt < nk1) P64_COMPUTE(acc1, 0) else P64_COMPUTE(acc2, 0)
        P64_WRITE(qa, qb, 1);
        __syncthreads();
        if (kt + 3 < nk) P64_LOAD(qa, qb, kt + 3);
        if (kt + 1 < nk1) P64_COMPUTE(acc1, 1) else P64_COMPUTE(acc2, 1)
        if (kt + 2 < nk) P64_WRITE(pa, pb, 0);
        __syncthreads();
    }
#undef P64_LOAD
#undef P64_WRITE
#undef P64_COMPUTE
}
__device__ __forceinline__ void zero_acc(f32x16 (&acc)[2][2]) {
#pragma unroll
    for (int i = 0; i < 2; ++i)
#pragma unroll
        for (int j = 0; j < 2; ++j)
#pragma unroll
            for (int r = 0; r < 16; ++r) acc[i][j][r] = 0.f;
}
#define ACC_ROW(mi, r) (wr * 64 + (mi) * 32 + ((r) & 3) + 8 * ((r) >> 2) + 4 * (lane >> 5))
#define ACC_COL(ni) (wc * 64 + (ni) * 32 + (lane & 31))

__device__ void tr_tile(const float* __restrict__ src, int K, int N, int kt, int nt, bf16_t* __restrict__ dst, const float* __restrict__ scale, float* s) {
    const int tid = tid_opaque(), r = tid >> 4, c4 = (tid & 15) * 4;
#pragma unroll
    for (int i = 0; i < 4; ++i) {
        const int k = kt * 64 + r + 16 * i;
        float4 v = *(const float4*)(src + (size_t)k * N + nt * 64 + c4);
        const float sc = scale ? scale[k] : 1.f;
        float* d = s + (r + 16 * i) * 65 + c4;
        d[0] = v.x * sc; d[1] = v.y * sc; d[2] = v.z * sc; d[3] = v.w * sc;
    }
    __syncthreads();
    const int n = tid >> 2, k0 = (tid & 3) * 16;
    float f[16];
#pragma unroll
    for (int j = 0; j < 16; ++j) f[j] = s[(k0 + j) * 65 + n];
    bf16_t* o = dst + (size_t)(nt * 64 + n) * K + kt * 64 + k0;
    *(uint4*)o = pack8(f);
    *(uint4*)(o + 8) = pack8(f + 8);
    __syncthreads();
}
__device__ void phase_prologue(const Params& P, int ph, unsigned char* smem) {
    float* s = (float*)smem;
    const int NTR = 7296, NMOD = 96;
    for (;;) {
        const int u = next_item(P, ph);
        if (u >= NTR + NMOD) break;
        if (u < NMOD) {
            const int l = u / 48, cb = u % 48, tid = threadIdx.x, lane = tid & 63, wave = tid >> 6;
            float* sc = s;
            float* red = s + 5 * 1024;
            for (int i = tid; i < 5 * 1024; i += 256) { const int r = i >> 10, k = i & 1023; const float v = (r < 4) ? P.c[r * 1024 + k] : P.c_ctx[k]; sc[i] = siluf_(v); }
            __syncthreads();
            const int col = cb * 64 + lane;
            float acc[5] = {0.f, 0.f, 0.f, 0.f, 0.f};
            const float* w = P.ada_w + (size_t)l * 1024 * 3072 + col;
#pragma unroll 8
            for (int k = wave * 256; k < wave * 256 + 256; ++k) {
                const float wv = w[(size_t)k * 3072];
#pragma unroll
                for (int r = 0; r < 5; ++r) acc[r] += sc[r * 1024 + k] * wv;
            }
#pragma unroll
            for (int r = 0; r < 5; ++r) red[(wave * 5 + r) * 64 + lane] = acc[r];
            __syncthreads();
            if (wave == 0) {
                float* mod = (float*)(P.ws + OFF_MOD);
#pragma unroll
                for (int r = 0; r < 5; ++r) mod[(l * 5 + r) * 3072 + col] = red[r * 64 + lane] + red[(5 + r) * 64 + lane] + red[(10 + r) * 64 + lane] + red[(15 + r) * 64 + lane] + P.ada_b[l * 3072 + col];
            }
            continue;
        }
        const int v = u - NMOD, l = v / 3648, r = v % 3648;
        if (r < 1776) tr_tile(P.w_in + (size_t)l * 1024 * INW, 1024, INW, r / 111, r % 111, (bf16_t*)(P.ws + OFF_WIN) + (size_t)l * 7168 * 1024, nullptr, s);
        else if (r < 2800) { const int r2 = r - 1776, br = r2 >> 8, t = r2 & 255; tr_tile(P.w_merge + (size_t)(l * 4 + br) * 1024 * 1024, 1024, 1024, t >> 4, t & 15, (bf16_t*)(P.ws + OFF_WM) + (size_t)(l * 4 + br) * 1024 * 1024, nullptr, s); }
        else if (r < 3312) { const int r2 = r - 2800, br = r2 >> 7, t = r2 & 127; tr_tile(P.w_br + (size_t)(l * 4 + br) * 512 * 1024, 512, 1024, t >> 4, t & 15, (bf16_t*)(P.ws + OFF_WBR) + (size_t)(l * 4 + br) * 1024 * 512, nullptr, s); }
        else if (r < 3568) { const int t = r - 3312; tr_tile(P.w_out + (size_t)l * 1024 * 1024, 1024, 1024, t >> 4, t & 15, (bf16_t*)(P.ws + OFF_WO) + (size_t)l * 1024 * 1024, nullptr, s); }
        else if (r < 3616) { const int t = r - 3568; tr_tile(P.w_uq + (size_t)l * 256 * 768, 256, 768, t / 12, t % 12, (bf16_t*)(P.ws + OFF_WUQ) + (size_t)l * 768 * 256, P.g_cq + l * 256, s); }
        else { const int t = r - 3616; tr_tile(P.w_ukv + (size_t)l * 128 * 1024, 128, 1024, t >> 4, t & 15, (bf16_t*)(P.ws + OFF_WUKV) + (size_t)l * 1024 * 128, P.g_ckv + l * 128, s); }
    }
}

__device__ void phase_norm(const Params& P, int ph, int l, int hf) {
    const int tid = tid_opaque(), lane = tid & 63, wave = tid >> 6;
    const float* mod = (const float*)(P.ws + OFF_MOD);
    bf16_t* H = (bf16_t*)(P.ws + OFF_H);
    for (;;) {
        const int u = next_item(P, ph);
        if (u >= NTH / 8) break;
        float4 v[2][4]; int mrr[2];
#pragma unroll
        for (int rr = 0; rr < 2; ++rr) {
            const int t = u * 8 + wave * 2 + rr, bl = t / TB, p = t % TB, b = hf * 2 + bl;
            const float* src;
            if (p < CTXL) { src = (l == 0 ? P.ctx : (const float*)(P.ws + OFF_CX1)) + ((size_t)b * CTXL + p) * D; mrr[rr] = 4; }
            else { src = (l == 0 ? P.x : (const float*)P.out) + ((size_t)b * SEQ + (p - CTXL)) * D; mrr[rr] = b; }
#pragma unroll
            for (int i = 0; i < 4; ++i) v[rr][i] = *(const float4*)(src + lane * 4 + 256 * i);
        }
#pragma unroll
        for (int rr = 0; rr < 2; ++rr) {
            const int t = u * 8 + wave * 2 + rr;
            float ss = 0.f;
#pragma unroll
            for (int i = 0; i < 4; ++i) ss += v[rr][i].x * v[rr][i].x + v[rr][i].y * v[rr][i].y + v[rr][i].z * v[rr][i].z + v[rr][i].w * v[rr][i].w;
            ss = wave_sum(ss);
            const float rstd = rsqrtf(ss * (1.f / D) + EPS);
            const float* sh = mod + (l * 5 + mrr[rr]) * 3072; const float* sc = sh + 1024; const float* g = P.norm_g + l * D;
#pragma unroll
            for (int i = 0; i < 4; ++i) {
                const int c = lane * 4 + 256 * i;
                const float4 gv = *(const float4*)(g + c), s1 = *(const float4*)(sc + c), s0 = *(const float4*)(sh + c);
                uint2 o;
                o.x = cvt_pk(v[rr][i].x * rstd * gv.x * (1.f + s1.x) + s0.x, v[rr][i].y * rstd * gv.y * (1.f + s1.y) + s0.y);
                o.y = cvt_pk(v[rr][i].z * rstd * gv.z * (1.f + s1.z) + s0.z, v[rr][i].w * rstd * gv.w * (1.f + s1.w) + s0.w);
                *(uint2*)(H + (size_t)t * D + c) = o;
            }
        }
    }
}

__device__ void phase_gemm1(const Params& P, int ph, int l, unsigned char* smem) {
    const int tid_ = tid_opaque(), lane = tid_ & 63, wave = tid_ >> 6, wr = wave >> 1, wc = wave & 1;
    const bf16_t* H = (const bf16_t*)(P.ws + OFF_H);
    const bf16_t* W = (const bf16_t*)(P.ws + OFF_WIN) + (size_t)l * 7168 * 1024;
    bf16_t* PB = (bf16_t*)(P.ws + OFF_PB);
    for (;;) {
        const int u = next_item(P, ph);
        if (u >= 132 * 56) break;
        const int mt = u / 56, nt = u % 56;
        f32x16 acc[2][2]; zero_acc(acc);
        gemm_tile_pf2(acc, H + (size_t)mt * 128 * D, D, W + (size_t)nt * 128 * D, D, D, smem);
#pragma unroll
        for (int mi = 0; mi < 2; ++mi)
#pragma unroll
            for (int ni = 0; ni < 2; ++ni) {
                const int col = nt * 128 + ACC_COL(ni);
                if (col < PW) {
#pragma unroll
                    for (int r = 0; r < 16; ++r) PB[(size_t)(mt * 128 + ACC_ROW(mi, r)) * PW + col] = f2bf(acc[mi][ni][r]);
                }
            }
    }
}

__device__ void phase_gemm2(const Params& P, int ph, int l, unsigned char* smem) {
    const int tid_ = tid_opaque(), lane = tid_ & 63, wave = tid_ >> 6, wr = wave >> 1, wc = wave & 1;
    const bf16_t* PB = (const bf16_t*)(P.ws + OFF_PB);
    for (;;) {
        const int u = next_item(P, ph);
        if (u >= 132 * 14) break;
        const int mt = u / 14, n14 = u % 14;
        f32x16 acc[2][2]; zero_acc(acc);
        bf16_t* O; int ldo, nt;
        if (n14 < 6) { nt = n14; O = (bf16_t*)(P.ws + OFF_QF); ldo = 768;
            gemm_tile_pf2(acc, PB + (size_t)mt * 128 * PW + C_CQ, PW, (const bf16_t*)(P.ws + OFF_WUQ) + (size_t)l * 768 * 256 + (size_t)nt * 128 * 256, 256, 256, smem); }
        else { nt = n14 - 6; O = (bf16_t*)(P.ws + OFF_KV); ldo = 1024;
            gemm_tile_pf2(acc, PB + (size_t)mt * 128 * PW + C_CKV, PW, (const bf16_t*)(P.ws + OFF_WUKV) + (size_t)l * 1024 * 128 + (size_t)nt * 128 * 128, 128, 128, smem); }
#pragma unroll
        for (int mi = 0; mi < 2; ++mi)
#pragma unroll
            for (int ni = 0; ni < 2; ++ni)
#pragma unroll
                for (int r = 0; r < 16; ++r) O[(size_t)(mt * 128 + ACC_ROW(mi, r)) * ldo + nt * 128 + ACC_COL(ni)] = f2bf(acc[mi][ni][r]);
    }
}

__device__ void phase_finalize(const Params& P, int ph, int l, unsigned char* smem) {
    const int tid = tid_opaque(), lane = tid & 63, wave = tid >> 6;
    bf16_t* PB = (bf16_t*)(P.ws + OFF_PB);
    bf16_t* QF = (bf16_t*)(P.ws + OFF_QF);
    const bf16_t* KV = (const bf16_t*)(P.ws + OFF_KV);
    bf16_t* KF = (bf16_t*)(P.ws + OFF_KF);
    bf16_t* VTM = (bf16_t*)(P.ws + OFF_VTM);
    bf16_t* VTN = (bf16_t*)(P.ws + OFF_VTN);
    float* rs = (float*)smem;
    const int hd = lane >> 3, j = lane & 7;
    const float invf = __powf(10000.f, -(float)j * 0.125f);
    for (;;) {
        const int u7 = next_item(P, ph);
        if (u7 >= (NTH / 32) * 11) break;
        const int u = u7 / 11, sub = u7 % 11;
        const int t0 = u * 32, bl = t0 / TB, p0 = t0 % TB;
        if (sub >= 1 && sub <= 4) {
        uint2 in_cq[2]; unsigned in_ckv[2]; bf16_t in_q[2][12], in_kv[2][8], in_kr[2][4]; uint4 in_nq[2], in_nk[2];
#pragma unroll
        for (int rr = 0; rr < 2; ++rr) {
            const int tl = (sub - 1) * 8 + wave * 2 + rr, t = t0 + tl;
            const bf16_t* prow = PB + (size_t)t * PW;
            in_cq[rr] = *(const uint2*)(prow + C_CQ + lane * 4);
            in_ckv[rr] = *(const unsigned*)(prow + C_CKV + lane * 2);
            const bf16_t* q = QF + (size_t)t * 768 + hd * 96;
            const bf16_t* kvr = KV + (size_t)t * 1024 + hd * 128;
#pragma unroll
            for (int m = 0; m < 12; ++m) in_q[rr][m] = q[j + 8 * m];
#pragma unroll
            for (int m = 0; m < 8; ++m) in_kv[rr][m] = kvr[j + 8 * m];
#pragma unroll
            for (int m = 0; m < 4; ++m) in_kr[rr][m] = prow[C_KR + j + 8 * m];
            in_nq[rr] = *(const uint4*)(prow + C_NQ + hd * 64 + j * 8);
            in_nk[rr] = *(const uint4*)(prow + C_NK + hd * 64 + j * 8);
        }
#pragma unroll
        for (int rr = 0; rr < 2; ++rr) {
            const int tl = (sub - 1) * 8 + wave * 2 + rr, t = t0 + tl, p = p0 + tl;
            bf16_t* prow = PB + (size_t)t * PW;
            float s1, s2;
            { const uint2 a = in_cq[rr]; const float f0 = lo16(a.x), f1 = hi16(a.x), f2 = lo16(a.y), f3 = hi16(a.y); s1 = f0 * f0 + f1 * f1 + f2 * f2 + f3 * f3;
              const unsigned b = in_ckv[rr]; const float g0 = lo16(b), g1 = hi16(b); s2 = g0 * g0 + g1 * g1; }
            s1 = wave_sum(s1); s2 = wave_sum(s2);
            const float rcq = rsqrtf(s1 * (1.f / 256.f) + EPS), rckv = rsqrtf(s2 * (1.f / 128.f) + EPS);
            {
                bf16_t* q = QF + (size_t)t * 768 + hd * 96;
                float v[12], ss = 0.f;
#pragma unroll
                for (int m = 0; m < 12; ++m) { v[m] = bf2f(in_q[rr][m]) * rcq; ss += v[m] * v[m]; }
                ss += __shfl_xor(ss, 1); ss += __shfl_xor(ss, 2); ss += __shfl_xor(ss, 4);
                const float rn = rsqrtf(ss * (1.f / 96.f) + EPS);
#pragma unroll
                for (int m = 0; m < 12; ++m) q[j + 8 * m] = f2bf(v[m] * rn * P.g_q[l * 96 + j + 8 * m] * (0.10206207261596575f * LOG2E));
            }
            {
                float v[12], ss = 0.f;
#pragma unroll
                for (int m = 0; m < 8; ++m) { v[m] = bf2f(in_kv[rr][m]) * rckv; ss += v[m] * v[m]; }
#pragma unroll
                for (int m = 8; m < 12; ++m) { v[m] = bf2f(in_kr[rr][m - 8]); ss += v[m] * v[m]; }
                ss += __shfl_xor(ss, 1); ss += __shfl_xor(ss, 2); ss += __shfl_xor(ss, 4);
                const float rn = rsqrtf(ss * (1.f / 96.f) + EPS);
#pragma unroll
                for (int m = 0; m < 12; ++m) v[m] = v[m] * rn * P.g_k[l * 96 + j + 8 * m];
                if (p >= CTXL) {
                    const int pos = p - CTXL;
                    const float ar = (float)(pos >> 6) * invf, ac = (float)(pos & 63) * invf;
                    double fr = (double)ar * 0.15915494309189535; fr -= rint(fr);
                    double fc = (double)ac * 0.15915494309189535; fc -= rint(fc);
                    const float sr = __builtin_amdgcn_sinf((float)fr), cr = __builtin_amdgcn_cosf((float)fr);
                    const float sc = __builtin_amdgcn_sinf((float)fc), cc = __builtin_amdgcn_cosf((float)fc);
                    const float x1a = v[8], x2a = v[10], x1b = v[9], x2b = v[11];
                    v[8] = x1a * cr - x2a * sr; v[10] = x1a * sr + x2a * cr;
                    v[9] = x1b * cc - x2b * sc; v[11] = x1b * sc + x2b * cc;
                }
                bf16_t* ko = KF + ((size_t)t * 8 + hd) * 96;
#pragma unroll
                for (int m = 0; m < 12; ++m) ko[j + 8 * m] = f2bf(v[m]);
            }
#pragma unroll
            for (int w = 0; w < 2; ++w) {
                bf16_t* q = prow + (w ? C_NK : C_NQ) + hd * 64 + j * 8;
                const float* g = (w ? P.ng_k : P.ng_q) + l * 64 + j * 8;
                float v[8], ss = 0.f;
                unpack8(w ? in_nk[rr] : in_nq[rr], v);
#pragma unroll
                for (int m = 0; m < 8; ++m) ss += v[m] * v[m];
                ss += __shfl_xor(ss, 1); ss += __shfl_xor(ss, 2); ss += __shfl_xor(ss, 4);
                const float rn = rsqrtf(ss * (1.f / 64.f) + EPS);
#pragma unroll
                for (int m = 0; m < 8; ++m) v[m] = v[m] * rn * g[m] * (w ? 1.f : 0.125f * LOG2E);
                *(uint4*)q = pack8(v);
            }
        }
        } else if (sub == 0) {
        {
            for (int rr = 0; rr < 8; ++rr) {
                const int tl = wave * 8 + rr;
                const unsigned bq = *(const unsigned*)(PB + (size_t)(t0 + tl) * PW + C_CKV + lane * 2);
                const float g0 = lo16(bq), g1 = hi16(bq);
                const float s2 = wave_sum(g0 * g0 + g1 * g1);
                if (lane == 0) rs[tl] = rsqrtf(s2 * (1.f / 128.f) + EPS);
            }
            __syncthreads();
            bf16_t* tile = (bf16_t*)(smem + 8192);
#pragma unroll
            for (int which = 0; which < 2; ++which) {
#pragma unroll
                for (int k8 = 0; k8 < 8; ++k8) {
                    const int id = tid + 256 * k8, i = id >> 6, c8 = id & 63;
                    const bf16_t* src = which ? PB + (size_t)(t0 + i) * PW + C_NV + c8 * 8
                                              : KV + (size_t)(t0 + i) * 1024 + (c8 >> 3) * 128 + 64 + (c8 & 7) * 8;
                    *(uint4*)(tile + i * 512 + c8 * 8) = *(const uint4*)src;
                }
                __syncthreads();
                bf16_t* VT = which ? VTN : VTM;
#pragma unroll
                for (int k8 = 0; k8 < 8; ++k8) {
                    const int id = tid + 256 * k8, r = id >> 2, g = id & 3;
                    float fv[8];
#pragma unroll
                    for (int i = 0; i < 8; ++i) fv[i] = bf2f(tile[(g * 8 + i) * 512 + r]) * (which ? 1.f : rs[g * 8 + i]);
                    *(uint4*)(VT + ((size_t)(bl * 8 + (r >> 6)) * 64 + (r & 63)) * TB + p0 + g * 8) = pack8(fv);
                }
                __syncthreads();
            }
        }
        } else
        {
            const int chunk = t0 >> 5;
            bf16_t* XH = (bf16_t*)(P.ws + OFF_XH);
            bf16_t* XG = (bf16_t*)(P.ws + OFF_XG);
            float* EBH = (float*)(P.ws + OFF_EBH);
            float* EBG = (float*)(P.ws + OFF_EBG);
            bf16_t* base = PB + (size_t)t0 * PW;
            float* rsh = (float*)smem + 256;
            bf16_t* inA = (bf16_t*)(smem + 8192);
            bf16_t* inB = inA + 32 * 128;
            bf16_t* inC = inB + 32 * 128;
            bf16_t* outT = inC + 32 * 128;
#pragma unroll
            for (int k4 = 0; k4 < 4; ++k4) { const int id = tid + 256 * k4, i = id >> 5, jx = id & 31; rsh[id] = bf2f(base[(size_t)i * PW + C_GR + jx]); }
            const int d = tid & 127, dr = tid >> 7;
            { const int grp = sub - 5;
                const bool isg = grp >= 4;
                const int gcol = isg ? (grp - 4) * 128 : grp * 128;
                const int cA = isg ? C_GQ + gcol : C_HQ + gcol, cB = isg ? C_GK + gcol : C_HF + gcol, cC = C_HF + 512 + gcol;
#pragma unroll
                for (int k2 = 0; k2 < 2; ++k2) {
                    const int id = tid + 256 * k2, i = id >> 4, ch = id & 15;
                    const bf16_t* row = base + (size_t)i * PW;
                    *(uint4*)(inA + i * 128 + ch * 8) = *(const uint4*)(row + cA + ch * 8);
                    *(uint4*)(inB + i * 128 + ch * 8) = *(const uint4*)(row + cB + ch * 8);
                    if (!isg) *(uint4*)(inC + i * 128 + ch * 8) = *(const uint4*)(row + cC + ch * 8);
                }
                __syncthreads();
                {
                    const int col = gcol + d;
                    float lb = 0.f, b2 = 0.f, w2[16];
#pragma unroll
                    for (int jx = 0; jx < 16; ++jx) w2[jx] = 0.f;
                    if (isg) {
#pragma unroll
                        for (int jx = 0; jx < 16; ++jx) w2[jx] = P.gla_w2[((size_t)(l * 2 + dr) * 16 + jx) * 256 + col];
                        b2 = P.gla_b2[(l * 2 + dr) * 256 + col];
                    } else if (l != 0) lb = sigmoidf_(P.lb_logits[1024 + dr * 512 + col] - P.lb_logits[dr * 512 + col]);
                    const bf16_t* fsrc = (dr && !isg) ? inC : inB;
                    bf16_t* oq = outT + (dr ? 2 : 0) * 32 * 128;
                    bf16_t* ok = oq + 32 * 128;
                    float cum = 0.f;
#pragma unroll 4
                    for (int sx = 0; sx < 32; ++sx) {
                        const int i = dr ? 31 - sx : sx;
                        const float qv = bf2f(inA[i * 128 + d]), fv = bf2f(fsrc[i * 128 + d]);
                        float qq, kk, la;
                        if (isg) {
                            float g = b2;
#pragma unroll
                            for (int jx = 0; jx < 16; ++jx) g = fmaf(rsh[i * 32 + dr * 16 + jx], w2[jx], g);
                            la = (fminf(g, 0.f) - __logf(1.f + __expf(-fabsf(g)))) * 0.0625f;
                            qq = qv * 0.125f; kk = fv;
                        } else {
                            const float av = lb + (1.f - lb) * sigmoidf_(fv);
                            la = __logf(av); kk = 1.f - av;
                            qq = siluf_(qv) * 0.08838834764831845f;
                        }
                        cum += la;
                        oq[i * 128 + d] = f2bf(qq * __expf(cum));
                        ok[i * 128 + d] = f2bf(kk * __expf(-cum));
                    }
                    if (isg) EBG[(size_t)(chunk * 2 + dr) * 256 + col] = __expf(cum);
                    else EBH[(size_t)(chunk * 2 + dr) * 512 + col] = __expf(cum);
                }
                __syncthreads();
#pragma unroll
                for (int k2 = 0; k2 < 2; ++k2) {
                    const int id = tid + 256 * k2, i = id >> 4, ch = id & 15;
                    bf16_t* row = base + (size_t)i * PW;
                    const uint4 v0 = *(const uint4*)(outT + (0 * 32 + i) * 128 + ch * 8), v1 = *(const uint4*)(outT + (1 * 32 + i) * 128 + ch * 8);
                    const uint4 v2 = *(const uint4*)(outT + (2 * 32 + i) * 128 + ch * 8), v3 = *(const uint4*)(outT + (3 * 32 + i) * 128 + ch * 8);
                    *(uint4*)(row + cA + ch * 8) = v0;
                    *(uint4*)(row + cB + ch * 8) = v1;
                    if (isg) { bf16_t* xr = XG + (size_t)(t0 + i) * 512 + gcol + ch * 8; *(uint4*)xr = v2; *(uint4*)(xr + 256) = v3; }
                    else { *(uint4*)(XH + (size_t)(t0 + i) * 512 + gcol + ch * 8) = v2; *(uint4*)(row + cC + ch * 8) = v3; }
                }
                __syncthreads();
            }
        }
    }
}

template <int DQK, bool NAT>
__device__ void attn_item(const Params& P, int l, int bl, int head, int qb, unsigned char* smem) {
    constexpr int NKS = DQK / 16, KSTR = DQK + 8, VSTR = 68, KCH = DQK / 8, KLD = (DQK * 64 / 8) / 256;
    const int tid = tid_opaque(), lane = tid & 63, wave = tid >> 6, hh = lane >> 5, r32 = lane & 31;
    bf16_t* Ks = (bf16_t*)smem;
    bf16_t* Vs = Ks + 2 * 64 * KSTR;
    float* rpb_s = (float*)(Vs + 2 * 64 * VSTR);
    bf16_t* PB = (bf16_t*)(P.ws + OFF_PB);
    const int rowbase = bl * TB, q_p0 = qb * 128, ql = wave * 32 + r32;
    const bool q_ctx = qb < 2;
    int lt0 = 0, lt1 = 0;
    int qr = 0, qc = 0, r0w = 0, c0 = 0;
    if (!q_ctx) {
        if (NAT) { const int rp = qb - 2, ra = 2 * rp, rb = ra + 1; lt0 = min(max(ra - 4, 0), 120); lt1 = min(max(rb - 4, 0), 120) + 8;
            qr = ra + (wave >> 1); qc = (wave & 1) * 32 + r32; r0w = min(max(qr - 4, 0), 120); c0 = min(max(qc - 8, 0), 48); }
        else { lt0 = 0; lt1 = 128; }
    }
    const int ntiles = 4 + (lt1 - lt0);
    const bf16_t* Kbase; const bf16_t* VT; const bf16_t* qptr; int k_ld;
    if (NAT) { Kbase = PB + (size_t)rowbase * PW + C_NK + head * 64; k_ld = PW; VT = (const bf16_t*)(P.ws + OFF_VTN) + (size_t)(bl * 8 + head) * 64 * TB;
        qptr = PB + (size_t)(rowbase + q_p0 + ql) * PW + C_NQ + head * 64; }
    else { Kbase = (const bf16_t*)(P.ws + OFF_KF) + (size_t)rowbase * 768 + head * 96; k_ld = 768; VT = (const bf16_t*)(P.ws + OFF_VTM) + (size_t)(bl * 8 + head) * 64 * TB;
        qptr = (const bf16_t*)(P.ws + OFF_QF) + (size_t)(rowbase + q_p0 + ql) * 768 + head * 96; }
    if (NAT) { for (int i = tid; i < 465; i += 256) rpb_s[i] = P.rpb[(size_t)(l * 8 + head) * 465 + i] * LOG2E; }
    bf16x8 qf[NKS];
#pragma unroll
    for (int ks = 0; ks < NKS; ++ks) qf[ks] = *(const bf16x8*)(qptr + ks * 16 + hh * 8);
    bf16x8 qrot4 = qf[NKS - 2], qrot5 = qf[NKS - 1];
    if (!NAT && !q_ctx) {
        const int pos = q_p0 - CTXL + ql;
        const float base = hh ? (float)(pos & 63) : (float)(pos >> 6);
#pragma unroll
        for (int jj = 0; jj < 8; ++jj) {
            const float invf = __powf(10000.f, -(float)jj * 0.125f);
            const float ang = base * invf;
            double fr = (double)ang * 0.15915494309189535; fr -= rint(fr);
            const float sn = __builtin_amdgcn_sinf((float)fr), cs = __builtin_amdgcn_cosf((float)fr);
            const float x1 = bf2f((bf16_t)qf[4][jj]), x2 = bf2f((bf16_t)qf[5][jj]);
            qrot4[jj] = (short)f2bf(x1 * cs - x2 * sn);
            qrot5[jj] = (short)f2bf(x1 * sn + x2 * cs);
        }
    }
    float m_run = -1e30f, lsum = 0.f;
    f32x16 oacc[2];
#pragma unroll
    for (int r = 0; r < 16; ++r) { oacc[0][r] = 0.f; oacc[1][r] = 0.f; }
    uint4 kreg0A, kreg1A, kreg2A, vreg0A, vreg1A, kreg0B, kreg1B, kreg2B, vreg0B, vreg1B;
    kreg2A = kreg2B = make_uint4(0, 0, 0, 0);
    const int kid0 = tid, kid1 = tid + 256, kid2 = tid + 512;
    const int krow0 = kid0 / KCH, kch0 = kid0 % KCH, krow1 = kid1 / KCH, kch1 = kid1 % KCH, krow2 = kid2 / KCH, kch2 = kid2 % KCH;
    const int vrow0 = tid >> 3, vch = tid & 7, vrow1 = vrow0 + 32;
#define TILE_P(ti) ((ti) < 4 ? (ti) * 64 : CTXL + (lt0 + (ti) - 4) * 64)
#define GLOAD(ti, S) { const int p_ = TILE_P(ti); \
        kreg0##S = *(const uint4*)(Kbase + (size_t)(p_ + krow0) * k_ld + kch0 * 8); \
        kreg1##S = *(const uint4*)(Kbase + (size_t)(p_ + krow1) * k_ld + kch1 * 8); \
        if (KLD > 2) kreg2##S = *(const uint4*)(Kbase + (size_t)(p_ + krow2) * k_ld + kch2 * 8); \
        vreg0##S = *(const uint4*)(VT + (size_t)vrow0 * TB + p_ + vch * 8); \
        vreg1##S = *(const uint4*)(VT + (size_t)vrow1 * TB + p_ + vch * 8); }
#define SWRITE(buf_, S) { bf16_t* kd_ = Ks + (buf_) * 64 * KSTR; \
        *(uint4*)(kd_ + krow0 * KSTR + kch0 * 8) = kreg0##S; *(uint4*)(kd_ + krow1 * KSTR + kch1 * 8) = kreg1##S; \
        if (KLD > 2) *(uint4*)(kd_ + krow2 * KSTR + kch2 * 8) = kreg2##S; \
        bf16_t* vd_ = Vs + (buf_) * 64 * VSTR + vch * 8; \
        *(uint2*)(vd_ + vrow0 * VSTR) = make_uint2(vreg0##S.x, vreg0##S.y); *(uint2*)(vd_ + vrow0 * VSTR + 4) = make_uint2(vreg0##S.z, vreg0##S.w); \
        *(uint2*)(vd_ + vrow1 * VSTR) = make_uint2(vreg1##S.x, vreg1##S.y); *(uint2*)(vd_ + vrow1 * VSTR + 4) = make_uint2(vreg1##S.z, vreg1##S.w); }
    GLOAD(0, A); SWRITE(0, A);
    { const int t1_ = 1 < ntiles ? 1 : ntiles - 1; GLOAD(t1_, B); }
    __syncthreads();
    for (int ti0 = 0; ti0 < ntiles; ti0 += 2) {
        { const int tl_ = ti0 + 2 < ntiles ? ti0 + 2 : ntiles - 1; GLOAD(tl_, A); asm volatile("" ::: "memory"); }
        { const int ti = ti0; const int buf = 0;
        if (!NAT && ti == 4) { qf[NKS - 2] = qrot4; qf[NKS - 1] = qrot5; }
        const int kr = lt0 + ti - 4;
        const bool active = !NAT || ti < 4 || (kr >= r0w && kr < r0w + 8);
        if (active) {
            const bf16_t* kb = Ks + buf * 64 * KSTR + r32 * KSTR + hh * 8;
            f32x16 st0, st1;
#pragma unroll
            for (int r = 0; r < 16; ++r) { st0[r] = 0.f; st1[r] = 0.f; }
            bf16x8 kf0[NKS], kf1[NKS];
#pragma unroll
            for (int ks = 0; ks < NKS; ++ks) { kf0[ks] = *(const bf16x8*)(kb + ks * 16); kf1[ks] = *(const bf16x8*)(kb + 32 * KSTR + ks * 16); }
            asm volatile("s_waitcnt lgkmcnt(0)" ::: "memory");
#pragma unroll
            for (int ks = 0; ks < NKS; ++ks) {
                st0 = __builtin_amdgcn_mfma_f32_32x32x16_bf16(kf0[ks], qf[ks], st0, 0, 0, 0);
                st1 = __builtin_amdgcn_mfma_f32_32x32x16_bf16(kf1[ks], qf[ks], st1, 0, 0, 0);
            }
            const bf16_t* vb = Vs + buf * 64 * VSTR + r32 * VSTR + 4 * hh;
            uint2 vfr[2][2][2][2];
#pragma unroll
            for (int uu = 0; uu < 2; ++uu)
#pragma unroll
                for (int t = 0; t < 2; ++t)
#pragma unroll
                    for (int s2 = 0; s2 < 2; ++s2) {
                        const bf16_t* a = vb + uu * 32 * VSTR + t * 32 + s2 * 16;
                        vfr[uu][t][s2][0] = *(const uint2*)a; vfr[uu][t][s2][1] = *(const uint2*)(a + 8);
                    }
            float x[32];
#pragma unroll
            for (int r = 0; r < 16; ++r) { x[r] = st0[r]; x[16 + r] = st1[r]; }
            if (NAT && ti >= 4) {
                const int dr = kr - qr + 7;
#pragma unroll
                for (int e = 0; e < 32; ++e) {
                    const int r = e & 15, kc = (e >> 4) * 32 + (r & 3) + 8 * (r >> 2) + 4 * hh;
                    const int dc = min(max(kc - qc, -15), 15) + 15;
                    const bool ok = (kc >= c0) && (kc < c0 + 16);
                    x[e] = ok ? x[e] + rpb_s[dr * 31 + dc] : -1e30f;
                }
            }
            float mx = x[0];
#pragma unroll
            for (int e = 1; e < 32; ++e) mx = fmaxf(mx, x[e]);
            mx = fmaxf(mx, __shfl_xor(mx, 32));
            const float m_new = fmaxf(m_run, mx);
            const bool resc = __ballot(m_new > m_run) != 0ull;
            const float alpha = __builtin_amdgcn_exp2f(m_run - m_new);
            m_run = m_new;
            float ps = 0.f;
#pragma unroll
            for (int e = 0; e < 32; ++e) { x[e] = __builtin_amdgcn_exp2f(x[e] - m_new); ps += x[e]; }
            lsum = lsum * alpha + ps;
            if (resc) {
#pragma unroll
                for (int r = 0; r < 16; ++r) { oacc[0][r] *= alpha; oacc[1][r] *= alpha; }
            }
            bf16x8 pf[2][2];
#pragma unroll
            for (int t = 0; t < 2; ++t)
#pragma unroll
                for (int s = 0; s < 2; ++s) {
                    union { bf16x8 v; unsigned u[4]; } cv;
#pragma unroll
                    for (int q = 0; q < 4; ++q) cv.u[q] = cvt_pk(x[16 * t + 8 * s + 2 * q], x[16 * t + 8 * s + 2 * q + 1]);
                    pf[t][s] = cv.v;
                }
#pragma unroll
            for (int uu = 0; uu < 2; ++uu)
#pragma unroll
                for (int t = 0; t < 2; ++t)
#pragma unroll
                    for (int s = 0; s < 2; ++s) {
                        union { bf16x8 v; uint2 h[2]; } cv;
                        cv.h[0] = vfr[uu][t][s][0]; cv.h[1] = vfr[uu][t][s][1];
                        oacc[uu] = __builtin_amdgcn_mfma_f32_32x32x16_bf16(cv.v, pf[t][s], oacc[uu], 0, 0, 0);
                    }
        }
        }
        SWRITE(1, B);
        __syncthreads();
        if (ti0 + 1 >= ntiles) break;
        { const int tl_ = ti0 + 3 < ntiles ? ti0 + 3 : ntiles - 1; GLOAD(tl_, B); asm volatile("" ::: "memory"); }
        { const int ti = ti0 + 1; const int buf = 1;
        if (!NAT && ti == 4) { qf[NKS - 2] = qrot4; qf[NKS - 1] = qrot5; }
        const int kr = lt0 + ti - 4;
        const bool active = !NAT || ti < 4 || (kr >= r0w && kr < r0w + 8);
        if (active) {
            const bf16_t* kb = Ks + buf * 64 * KSTR + r32 * KSTR + hh * 8;
            f32x16 st0, st1;
#pragma unroll
            for (int r = 0; r < 16; ++r) { st0[r] = 0.f; st1[r] = 0.f; }
            bf16x8 kf0[NKS], kf1[NKS];
#pragma unroll
            for (int ks = 0; ks < NKS; ++ks) { kf0[ks] = *(const bf16x8*)(kb + ks * 16); kf1[ks] = *(const bf16x8*)(kb + 32 * KSTR + ks * 16); }
            asm volatile("s_waitcnt lgkmcnt(0)" ::: "memory");
#pragma unroll
            for (int ks = 0; ks < NKS; ++ks) {
                st0 = __builtin_amdgcn_mfma_f32_32x32x16_bf16(kf0[ks], qf[ks], st0, 0, 0, 0);
                st1 = __builtin_amdgcn_mfma_f32_32x32x16_bf16(kf1[ks], qf[ks], st1, 0, 0, 0);
            }
            const bf16_t* vb = Vs + buf * 64 * VSTR + r32 * VSTR + 4 * hh;
            uint2 vfr[2][2][2][2];
#pragma unroll
            for (int uu = 0; uu < 2; ++uu)
#pragma unroll
                for (int t = 0; t < 2; ++t)
#pragma unroll
                    for (int s2 = 0; s2 < 2; ++s2) {
                        const bf16_t* a = vb + uu * 32 * VSTR + t * 32 + s2 * 16;
                        vfr[uu][t][s2][0] = *(const uint2*)a; vfr[uu][t][s2][1] = *(const uint2*)(a + 8);
                    }
            float x[32];
#pragma unroll
            for (int r = 0; r < 16; ++r) { x[r] = st0[r]; x[16 + r] = st1[r]; }
            if (NAT && ti >= 4) {
                const int dr = kr - qr + 7;
#pragma unroll
                for (int e = 0; e < 32; ++e) {
                    const int r = e & 15, kc = (e >> 4) * 32 + (r & 3) + 8 * (r >> 2) + 4 * hh;
                    const int dc = min(max(kc - qc, -15), 15) + 15;
                    const bool ok = (kc >= c0) && (kc < c0 + 16);
                    x[e] = ok ? x[e] + rpb_s[dr * 31 + dc] : -1e30f;
                }
            }
            float mx = x[0];
#pragma unroll
            for (int e = 1; e < 32; ++e) mx = fmaxf(mx, x[e]);
            mx = fmaxf(mx, __shfl_xor(mx, 32));
            const float m_new = fmaxf(m_run, mx);
            const bool resc = __ballot(m_new > m_run) != 0ull;
            const float alpha = __builtin_amdgcn_exp2f(m_run - m_new);
            m_run = m_new;
            float ps = 0.f;
#pragma unroll
            for (int e = 0; e < 32; ++e) { x[e] = __builtin_amdgcn_exp2f(x[e] - m_new); ps += x[e]; }
            lsum = lsum * alpha + ps;
            if (resc) {
#pragma unroll
                for (int r = 0; r < 16; ++r) { oacc[0][r] *= alpha; oacc[1][r] *= alpha; }
            }
            bf16x8 pf[2][2];
#pragma unroll
            for (int t = 0; t < 2; ++t)
#pragma unroll
                for (int s = 0; s < 2; ++s) {
                    union { bf16x8 v; unsigned u[4]; } cv;
#pragma unroll
                    for (int q = 0; q < 4; ++q) cv.u[q] = cvt_pk(x[16 * t + 8 * s + 2 * q], x[16 * t + 8 * s + 2 * q + 1]);
                    pf[t][s] = cv.v;
                }
#pragma unroll
            for (int uu = 0; uu < 2; ++uu)
#pragma unroll
                for (int t = 0; t < 2; ++t)
#pragma unroll
                    for (int s = 0; s < 2; ++s) {
                        union { bf16x8 v; uint2 h[2]; } cv;
                        cv.h[0] = vfr[uu][t][s][0]; cv.h[1] = vfr[uu][t][s][1];
                        oacc[uu] = __builtin_amdgcn_mfma_f32_32x32x16_bf16(cv.v, pf[t][s], oacc[uu], 0, 0, 0);
                    }
        }
        }
        SWRITE(0, A);
        __syncthreads();
    }
#undef TILE_P
#undef GLOAD
#undef SWRITE
    lsum += __shfl_xor(lsum, 32);
    const float inv = 1.f / lsum;
    bf16_t* zrow = PB + (size_t)(rowbase + q_p0 + ql) * PW + C_Z + (NAT ? 512 : 0) + head * 64;
#pragma unroll
    for (int uu = 0; uu < 2; ++uu)
#pragma unroll
        for (int g = 0; g < 4; ++g) {
            bf16_t* zp = zrow + uu * 32 + 8 * g + 4 * hh;
            const uint2 z = *(const uint2*)zp;
            uint2 o;
            o.x = cvt_pk(oacc[uu][4 * g + 0] * inv * siluf_(lo16(z.x)), oacc[uu][4 * g + 1] * inv * siluf_(hi16(z.x)));
            o.y = cvt_pk(oacc[uu][4 * g + 2] * inv * siluf_(lo16(z.y)), oacc[uu][4 * g + 3] * inv * siluf_(hi16(z.y)));
            *(uint2*)zp = o;
        }
}

__device__ void scan_hg_item(const Params& P, int l, int item, unsigned char* smem) {
    const int tid = tid_opaque(), lane = tid & 63, wave = tid >> 6;
    const int slice = item & 7, dir = (item >> 3) & 1, head = (item >> 4) & 3, bl = item >> 6;
    float* a_s = (float*)smem;
    float* q_s = a_s + 64 * 128;
    float* v_s = q_s + 64 * 128;
    float* o_s = v_s + 64 * 16;
    const bf16_t* PB = (const bf16_t*)(P.ws + OFF_PB) + (size_t)bl * TB * PW;
    bf16_t* OS = (bf16_t*)(P.ws + OFF_KV) + ((size_t)dir * NTH + (size_t)bl * TB) * 512 + head * 128 + slice * 16;
    const int prow = tid >> 4, pd = (tid & 15) * 8;
    float lb[8];
#pragma unroll
    for (int e = 0; e < 8; ++e) {
        const int cidx = dir * 512 + head * 128 + pd + e;
        lb[e] = (l == 0) ? 0.f : sigmoidf_(P.lb_logits[1024 + cidx] - P.lb_logits[cidx]);
    }
    const int fcol = (dir ? C_HF + 512 : C_HF) + head * 128 + pd, qcol = C_HQ + head * 128 + pd, vcol = C_HI + head * 128 + slice * 16 + (tid & 1) * 8;
    uint4 rq[4], rf[4], rv;
    auto chunk_p = [&](int c) { const int ci = dir ? (c < 4 ? 3 - c : 135 - c) : c; return ci * 64; };
    auto gload = [&](int c) {
        const int p = chunk_p(c);
#pragma unroll
        for (int r = 0; r < 4; ++r) { const bf16_t* row = PB + (size_t)(p + prow + 16 * r) * PW; rq[r] = *(const uint4*)(row + qcol); rf[r] = *(const uint4*)(row + fcol); }
        if (tid < 128) rv = *(const uint4*)(PB + (size_t)(p + (tid >> 1)) * PW + vcol);
    };
    const int dg = lane & 15, col = wave * 4 + (lane >> 4);
    float S[8];
#pragma unroll
    for (int e = 0; e < 8; ++e) S[e] = 0.f;
    gload(0);
    for (int c = 0; c < 132; ++c) {
        __syncthreads();
#pragma unroll
        for (int r = 0; r < 4; ++r) {
            float fq[8], ff[8];
            unpack8(rq[r], fq); unpack8(rf[r], ff);
            float* ad = a_s + (prow + 16 * r) * 128 + pd; float* qd = q_s + (prow + 16 * r) * 128 + pd;
#pragma unroll
            for (int e = 0; e < 8; ++e) { ad[e] = lb[e] + (1.f - lb[e]) * sigmoidf_(ff[e]); qd[e] = siluf_(fq[e]) * 0.08838834764831845f; }
        }
        if (tid < 128) { float fv[8]; unpack8(rv, fv); float* vd = v_s + (tid >> 1) * 16 + (tid & 1) * 8;
#pragma unroll
            for (int e = 0; e < 8; ++e) vd[e] = fv[e]; }
        __syncthreads();
        if (c + 1 < 132) gload(c + 1);
        for (int tt = 0; tt < 64; tt += 8) {
            float op[8];
#pragma unroll
            for (int u = 0; u < 8; ++u) {
                const int i = dir ? 63 - (tt + u) : tt + u;
                const float4 a0 = *(const float4*)(a_s + i * 128 + dg * 8), a1 = *(const float4*)(a_s + i * 128 + dg * 8 + 4);
                const float4 q0 = *(const float4*)(q_s + i * 128 + dg * 8), q1 = *(const float4*)(q_s + i * 128 + dg * 8 + 4);
                const float v = v_s[i * 16 + col];
                float o;
                S[0] = fmaf(a0.x, S[0] - v, v); o = q0.x * S[0];
                S[1] = fmaf(a0.y, S[1] - v, v); o = fmaf(q0.y, S[1], o);
                S[2] = fmaf(a0.z, S[2] - v, v); o = fmaf(q0.z, S[2], o);
                S[3] = fmaf(a0.w, S[3] - v, v); o = fmaf(q0.w, S[3], o);
                S[4] = fmaf(a1.x, S[4] - v, v); o = fmaf(q1.x, S[4], o);
                S[5] = fmaf(a1.y, S[5] - v, v); o = fmaf(q1.y, S[5], o);
                S[6] = fmaf(a1.z, S[6] - v, v); o = fmaf(q1.z, S[6], o);
                S[7] = fmaf(a1.w, S[7] - v, v); o = fmaf(q1.w, S[7], o);
                op[u] = o;
            }
            float r4[4], r2[2];
            const bool b8 = dg & 8, b4 = dg & 4, b2 = dg & 2;
#pragma unroll
            for (int k = 0; k < 4; ++k) { const float snd = b8 ? op[k] : op[k + 4], kp = b8 ? op[k + 4] : op[k]; r4[k] = kp + __shfl_xor(snd, 8); }
#pragma unroll
            for (int k = 0; k < 2; ++k) { const float snd = b4 ? r4[k] : r4[k + 2], kp = b4 ? r4[k + 2] : r4[k]; r2[k] = kp + __shfl_xor(snd, 4); }
            float r1; { const float snd = b2 ? r2[0] : r2[1], kp = b2 ? r2[1] : r2[0]; r1 = kp + __shfl_xor(snd, 2); }
            r1 += __shfl_xor(r1, 1);
            if ((dg & 1) == 0) { const int tok = tt + (b8 ? 4 : 0) + (b4 ? 2 : 0) + (b2 ? 1 : 0); const int i = dir ? 63 - tok : tok; o_s[i * 16 + col] = r1; }
        }
        __syncthreads();
        if (tid < 128) {
            const int p = chunk_p(c) + (tid >> 1);
            *(uint4*)(OS + (size_t)p * 512 + (tid & 1) * 8) = pack8(o_s + (tid >> 1) * 16 + (tid & 1) * 8);
        }
    }
}

__device__ void scan_gla_item(const Params& P, int l, int item, unsigned char* smem) {
    const int tid = tid_opaque(), lane = tid & 63, wave = tid >> 6;
    const int slice = item & 3, dir = (item >> 2) & 1, head = (item >> 3) & 3, bl = item >> 5;
    float* a_s = (float*)smem;
    float* q_s = a_s + 64 * 64;
    float* k_s = q_s + 64 * 64;
    float* v_s = k_s + 64 * 64;
    float* o_s = v_s + 64 * 32;
    float* r_s = o_s + 64 * 32;
    const bf16_t* PB = (const bf16_t*)(P.ws + OFF_PB) + (size_t)bl * TB * PW;
    bf16_t* OS = (bf16_t*)(P.ws + OFF_OSG) + ((size_t)dir * NTH + (size_t)bl * TB) * 512 + head * 128 + slice * 32;
    const int gd = tid & 63, gt0 = tid >> 6;
    float w2[16];
#pragma unroll
    for (int jx = 0; jx < 16; ++jx) w2[jx] = P.gla_w2[((size_t)(l * 2 + dir) * 16 + jx) * 256 + head * 64 + gd];
    const float b2 = P.gla_b2[(l * 2 + dir) * 256 + head * 64 + gd];
    uint4 rq[2], rk[2], rv, rr;
    auto chunk_p = [&](int c) { const int ci = dir ? (c < 4 ? 3 - c : 135 - c) : c; return ci * 64; };
    auto gload = [&](int c) {
        const int p = chunk_p(c);
#pragma unroll
        for (int i = 0; i < 2; ++i) { const int id = tid + 256 * i, row = id >> 3, ch = id & 7; const bf16_t* rp = PB + (size_t)(p + row) * PW;
            rq[i] = *(const uint4*)(rp + C_GQ + head * 64 + ch * 8); rk[i] = *(const uint4*)(rp + C_GK + head * 64 + ch * 8); }
        { const int row = tid >> 2, ch = tid & 3; rv = *(const uint4*)(PB + (size_t)(p + row) * PW + C_GV + head * 128 + slice * 32 + ch * 8); }
        if (tid < 128) { const int row = tid >> 1, ch = tid & 1; rr = *(const uint4*)(PB + (size_t)(p + row) * PW + C_GR + dir * 16 + ch * 8); }
    };
    const int dg = lane & 7, col = wave * 8 + (lane >> 3);
    float S[8];
#pragma unroll
    for (int e = 0; e < 8; ++e) S[e] = 0.f;
    gload(0);
    for (int c = 0; c < 132; ++c) {
        __syncthreads();
#pragma unroll
        for (int i = 0; i < 2; ++i) { const int id = tid + 256 * i, row = id >> 3, ch = id & 7; float fq[8], fk[8]; unpack8(rq[i], fq); unpack8(rk[i], fk);
#pragma unroll
            for (int e = 0; e < 8; ++e) { q_s[row * 64 + ch * 8 + e] = fq[e] * 0.125f; k_s[row * 64 + ch * 8 + e] = fk[e]; } }
        { const int row = tid >> 2, ch = tid & 3; float fv[8]; unpack8(rv, fv);
#pragma unroll
            for (int e = 0; e < 8; ++e) v_s[row * 32 + ch * 8 + e] = fv[e]; }
        if (tid < 128) { const int row = tid >> 1, ch = tid & 1; float fr[8]; unpack8(rr, fr);
#pragma unroll
            for (int e = 0; e < 8; ++e) r_s[row * 16 + ch * 8 + e] = fr[e]; }
        __syncthreads();
        if (c + 1 < 132) gload(c + 1);
#pragma unroll 4
        for (int m = 0; m < 16; ++m) {
            const int i = gt0 + 4 * m;
            float g = b2;
#pragma unroll
            for (int jx = 0; jx < 16; ++jx) g = fmaf(r_s[i * 16 + jx], w2[jx], g);
            const float ls = fminf(g, 0.f) - __logf(1.f + __expf(-fabsf(g)));
            a_s[i * 64 + gd] = __expf(ls * 0.0625f);
        }
        __syncthreads();
        for (int tt = 0; tt < 64; tt += 8) {
            float op[8];
#pragma unroll
            for (int u = 0; u < 8; ++u) {
                const int i = dir ? 63 - (tt + u) : tt + u;
                const float4 a0 = *(const float4*)(a_s + i * 64 + dg * 8), a1 = *(const float4*)(a_s + i * 64 + dg * 8 + 4);
                const float4 q0 = *(const float4*)(q_s + i * 64 + dg * 8), q1 = *(const float4*)(q_s + i * 64 + dg * 8 + 4);
                const float4 k0 = *(const float4*)(k_s + i * 64 + dg * 8), k1 = *(const float4*)(k_s + i * 64 + dg * 8 + 4);
                const float v = v_s[i * 32 + col];
                float o;
                S[0] = fmaf(a0.x, S[0], k0.x * v); o = q0.x * S[0];
                S[1] = fmaf(a0.y, S[1], k0.y * v); o = fmaf(q0.y, S[1], o);
                S[2] = fmaf(a0.z, S[2], k0.z * v); o = fmaf(q0.z, S[2], o);
                S[3] = fmaf(a0.w, S[3], k0.w * v); o = fmaf(q0.w, S[3], o);
                S[4] = fmaf(a1.x, S[4], k1.x * v); o = fmaf(q1.x, S[4], o);
                S[5] = fmaf(a1.y, S[5], k1.y * v); o = fmaf(q1.y, S[5], o);
                S[6] = fmaf(a1.z, S[6], k1.z * v); o = fmaf(q1.z, S[6], o);
                S[7] = fmaf(a1.w, S[7], k1.w * v); o = fmaf(q1.w, S[7], o);
                op[u] = o;
            }
            float r4[4], r2[2];
            const bool b4 = dg & 4, b2 = dg & 2, b1 = dg & 1;
#pragma unroll
            for (int k = 0; k < 4; ++k) { const float snd = b4 ? op[k] : op[k + 4], kp = b4 ? op[k + 4] : op[k]; r4[k] = kp + __shfl_xor(snd, 4); }
#pragma unroll
            for (int k = 0; k < 2; ++k) { const float snd = b2 ? r4[k] : r4[k + 2], kp = b2 ? r4[k + 2] : r4[k]; r2[k] = kp + __shfl_xor(snd, 2); }
            float r1; { const float snd = b1 ? r2[0] : r2[1], kp = b1 ? r2[1] : r2[0]; r1 = kp + __shfl_xor(snd, 1); }
            { const int tok = tt + (b4 ? 4 : 0) + (b2 ? 2 : 0) + (b1 ? 1 : 0); const int i = dir ? 63 - tok : tok; o_s[i * 32 + col] = r1; }
        }
        __syncthreads();
        { const int row = tid >> 2, ch = tid & 3; const int p = chunk_p(c) + row;
          *(uint4*)(OS + (size_t)p * 512 + ch * 8) = pack8(o_s + row * 32 + ch * 8); }
    }
}


template <bool GLA>
__device__ void scan2_item(const Params& P, int l, int item, unsigned char* smem) {
    constexpr int DK = GLA ? 64 : 128, NT = DK / 32, QS = DK + 8, TS = 40, NSEG = GLA ? 4 : 2, TPS = 32 / NSEG, QCH = DK / 8;
    const int tid = tid_opaque(), lane = tid & 63, wave = tid >> 6, r32 = lane & 31, hh = lane >> 5;
    const int dir = item & 1, head = (item >> 1) & 3, bl = item >> 3;
    bf16_t* Qh = (bf16_t*)smem;
    bf16_t* Kh = Qh + 32 * QS;
    bf16_t* Kt = Kh + 32 * QS;
    bf16_t* Vt = Kt + DK * TS;
    float* eb = (float*)(Vt + 128 * TS);
    float* tot = eb + DK;
    bf16_t* qraw = (bf16_t*)(tot + 4 * DK);
    bf16_t* fraw = qraw + 32 * DK;
    bf16_t* vraw = fraw + 32 * DK;
    bf16_t* rraw = vraw + 32 * 128;
    const bf16_t* PB = (const bf16_t*)(P.ws + OFF_PB) + (size_t)bl * TB * PW;
    bf16_t* OS = (bf16_t*)(P.ws + (GLA ? OFF_OSG : OFF_KV)) + ((size_t)dir * NTH + (size_t)bl * TB) * 512 + head * 128 + wave * 32;
    const int qcol = (GLA ? C_GQ : C_HQ) + head * DK, fcol = GLA ? (C_GK + head * 64) : ((dir ? C_HF + 512 : C_HF) + head * 128),
              vcol = (GLA ? C_GV : C_HI) + head * 128, rcol = C_GR + dir * 16;
    const int pd = tid & (DK - 1), seg = tid / DK;
    float lbv = 0.f, b2 = 0.f, w2[16];
#pragma unroll
    for (int jx = 0; jx < 16; ++jx) w2[jx] = 0.f;
    if (GLA) {
#pragma unroll
        for (int jx = 0; jx < 16; ++jx) w2[jx] = P.gla_w2[((size_t)(l * 2 + dir) * 16 + jx) * 256 + head * 64 + pd];
        b2 = P.gla_b2[(l * 2 + dir) * 256 + head * 64 + pd];
    } else if (l != 0) { const int cidx = dir * 512 + head * 128 + pd; lbv = sigmoidf_(P.lb_logits[1024 + cidx] - P.lb_logits[cidx]); }
    uint4 pq0, pq1, pf0, pf1, pv0, pv1, pr;
    pq1 = pf1 = pr = make_uint4(0, 0, 0, 0);
#define CH_P0(c) (dir ? ((c) < 8 ? (7 - (c)) * 32 : CTXL + (263 - (c)) * 32) : (c) * 32)
#define ROWP(p0_, i_) ((p0_) + (dir ? 31 - (i_) : (i_)))
#define SC_GLOAD(c) { const int p0_ = CH_P0(c); \
        { const int id = tid, i = id / QCH, ch = id % QCH; const bf16_t* rp = PB + (size_t)ROWP(p0_, i) * PW; pq0 = *(const uint4*)(rp + qcol + ch * 8); pf0 = *(const uint4*)(rp + fcol + ch * 8); } \
        if (!GLA) { const int id = tid + 256, i = id / QCH, ch = id % QCH; const bf16_t* rp = PB + (size_t)ROWP(p0_, i) * PW; pq1 = *(const uint4*)(rp + qcol + ch * 8); pf1 = *(const uint4*)(rp + fcol + ch * 8); } \
        { const int i = tid >> 4, ch = tid & 15; pv0 = *(const uint4*)(PB + (size_t)ROWP(p0_, i) * PW + vcol + ch * 8); pv1 = *(const uint4*)(PB + (size_t)ROWP(p0_, i + 16) * PW + vcol + ch * 8); } \
        if (GLA && tid < 64) { const int i = tid >> 1, ch = tid & 1; pr = *(const uint4*)(PB + (size_t)ROWP(p0_, i) * PW + rcol + ch * 8); } }
    f32x16 ST[NT];
#pragma unroll
    for (int T = 0; T < NT; ++T)
#pragma unroll
        for (int r = 0; r < 16; ++r) ST[T][r] = 0.f;
    SC_GLOAD(0);
    for (int c = 0; c < 264; ++c) {
        __syncthreads();
        { const int id = tid, i = id / QCH, ch = id % QCH; *(uint4*)(qraw + i * DK + ch * 8) = pq0; *(uint4*)(fraw + i * DK + ch * 8) = pf0; }
        if (!GLA) { const int id = tid + 256, i = id / QCH, ch = id % QCH; *(uint4*)(qraw + i * DK + ch * 8) = pq1; *(uint4*)(fraw + i * DK + ch * 8) = pf1; }
        { const int i = tid >> 4, ch = tid & 15; *(uint4*)(vraw + i * 128 + ch * 8) = pv0; *(uint4*)(vraw + (i + 16) * 128 + ch * 8) = pv1; }
        if (GLA && tid < 64) { const int i = tid >> 1, ch = tid & 1; *(uint4*)(rraw + i * 16 + ch * 8) = pr; }
        __syncthreads();
        if (c + 1 < 264) SC_GLOAD(c + 1);
        float bl_[TPS], kk[TPS], qq[TPS];
        float cum = 0.f;
#pragma unroll
        for (int tt = 0; tt < TPS; ++tt) {
            const int i = seg * TPS + tt;
            float la;
            if (GLA) {
                float g = b2;
#pragma unroll
                for (int jx = 0; jx < 16; ++jx) g = fmaf(bf2f(rraw[i * 16 + jx]), w2[jx], g);
                la = (fminf(g, 0.f) - __logf(1.f + __expf(-fabsf(g)))) * 0.0625f;
                kk[tt] = bf2f(fraw[i * DK + pd]);
                qq[tt] = bf2f(qraw[i * DK + pd]) * 0.125f;
            } else {
                const float f = bf2f(fraw[i * DK + pd]);
                const float a = lbv + (1.f - lbv) * sigmoidf_(f);
                la = __logf(a);
                kk[tt] = 1.f - a;
                qq[tt] = siluf_(bf2f(qraw[i * DK + pd])) * 0.08838834764831845f;
            }
            cum += la;
            bl_[tt] = cum;
        }
        tot[seg * DK + pd] = cum;
        __syncthreads();
        {
            float off = 0.f, bend = 0.f;
#pragma unroll
            for (int sg = 0; sg < NSEG; ++sg) { const float tv = tot[sg * DK + pd]; bend += tv; if (sg < seg) off += tv; }
            const float eend = __expf(bend);
            if (seg == 0) eb[pd] = eend;
            float kt[TPS];
#pragma unroll
            for (int tt = 0; tt < TPS; ++tt) {
                const int i = seg * TPS + tt;
                const float b = bl_[tt] + off;
                const float e1 = __expf(b), e2 = __expf(-b);
                const float kh = kk[tt] * e2;
                Qh[i * QS + pd] = f2bf(qq[tt] * e1);
                Kh[i * QS + pd] = f2bf(kh);
                kt[tt] = kh * eend;
            }
#pragma unroll
            for (int g8 = 0; g8 < TPS / 8; ++g8) *(uint4*)(Kt + pd * TS + seg * TPS + g8 * 8) = pack8(kt + g8 * 8);
            const int vc = tid & 127, vs = tid >> 7;
            float vv[16];
#pragma unroll
            for (int tt = 0; tt < 16; ++tt) vv[tt] = bf2f(vraw[(vs * 16 + tt) * 128 + vc]);
            *(uint4*)(Vt + vc * TS + vs * 16) = pack8(vv);
            *(uint4*)(Vt + vc * TS + vs * 16 + 8) = pack8(vv + 8);
        }
        __syncthreads();
        f32x16 st;
#pragma unroll
        for (int r = 0; r < 16; ++r) st[r] = 0.f;
#pragma unroll
        for (int ks = 0; ks < DK / 16; ++ks) {
            const bf16x8 ka = *(const bf16x8*)(Kh + r32 * QS + ks * 16 + hh * 8);
            const bf16x8 qb = *(const bf16x8*)(Qh + r32 * QS + ks * 16 + hh * 8);
            st = __builtin_amdgcn_mfma_f32_32x32x16_bf16(ka, qb, st, 0, 0, 0);
        }
        bf16x8 pfr[2];
#pragma unroll
        for (int sI = 0; sI < 2; ++sI) {
            union { bf16x8 v; unsigned u[4]; } cv;
#pragma unroll
            for (int q = 0; q < 4; ++q) {
                const int ra = 8 * sI + 2 * q, rb = ra + 1;
                const int ja = (ra & 3) + 8 * (ra >> 2) + 4 * hh, jb = (rb & 3) + 8 * (rb >> 2) + 4 * hh;
                cv.u[q] = cvt_pk(ja <= r32 ? st[ra] : 0.f, jb <= r32 ? st[rb] : 0.f);
            }
            pfr[sI] = cv.v;
        }
        f32x16 oT;
#pragma unroll
        for (int r = 0; r < 16; ++r) oT[r] = 0.f;
#pragma unroll
        for (int sI = 0; sI < 2; ++sI) {
            const bf16_t* a = Vt + (wave * 32 + r32) * TS + sI * 16 + 4 * hh;
            union { bf16x8 v; uint2 h[2]; } cv;
            cv.h[0] = *(const uint2*)a; cv.h[1] = *(const uint2*)(a + 8);
            oT = __builtin_amdgcn_mfma_f32_32x32x16_bf16(cv.v, pfr[sI], oT, 0, 0, 0);
        }
#pragma unroll
        for (int T = 0; T < NT; ++T)
#pragma unroll
            for (int sI = 0; sI < 2; ++sI) {
                union { bf16x8 v; unsigned u[4]; } ca;
#pragma unroll
                for (int q = 0; q < 4; ++q) ca.u[q] = cvt_pk(ST[T][8 * sI + 2 * q], ST[T][8 * sI + 2 * q + 1]);
                const bf16_t* b = Qh + r32 * QS + T * 32 + sI * 16 + 4 * hh;
                union { bf16x8 v; uint2 h[2]; } cb;
                cb.h[0] = *(const uint2*)b; cb.h[1] = *(const uint2*)(b + 8);
                oT = __builtin_amdgcn_mfma_f32_32x32x16_bf16(ca.v, cb.v, oT, 0, 0, 0);
            }
#pragma unroll
        for (int T = 0; T < NT; ++T) {
#pragma unroll
            for (int g = 0; g < 4; ++g) {
                const float4 e4 = *(const float4*)(eb + T * 32 + 8 * g + 4 * hh);
                ST[T][4 * g + 0] *= e4.x; ST[T][4 * g + 1] *= e4.y; ST[T][4 * g + 2] *= e4.z; ST[T][4 * g + 3] *= e4.w;
            }
#pragma unroll
            for (int ks = 0; ks < 2; ++ks) {
                const bf16x8 ka = *(const bf16x8*)(Kt + (T * 32 + r32) * TS + ks * 16 + hh * 8);
                const bf16x8 vb = *(const bf16x8*)(Vt + (wave * 32 + r32) * TS + ks * 16 + hh * 8);
                ST[T] = __builtin_amdgcn_mfma_f32_32x32x16_bf16(ka, vb, ST[T], 0, 0, 0);
            }
        }
        {
            const int p = ROWP(CH_P0(c), r32);
            bf16_t* op = OS + (size_t)p * 512 + 4 * hh;
#pragma unroll
            for (int g = 0; g < 4; ++g) { uint2 o; o.x = cvt_pk(oT[4 * g], oT[4 * g + 1]); o.y = cvt_pk(oT[4 * g + 2], oT[4 * g + 3]); *(uint2*)(op + 8 * g) = o; }
        }
    }
#undef CH_P0
#undef ROWP
#undef SC_GLOAD
}


template <bool GLA>
__device__ __forceinline__ void scan3_rest(f32x16 (&ST)[GLA ? 2 : 4], bf16_t* Qh, bf16_t* Kh, bf16_t* Kt, bf16_t* Vt, float* eb, bf16_t* vraw, bf16_t* OS,
                                           int tid, int wave, int r32, int hh, int pd, int seg, int c, int dir) {
    constexpr int DK = GLA ? 64 : 128, NT = DK / 32, QS = DK + 8, TS = 40, NSEG = GLA ? 4 : 2, TPS = 32 / NSEG;
#define CH_P0(c) (dir ? ((c) < 8 ? (7 - (c)) * 32 : CTXL + (263 - (c)) * 32) : (c) * 32)
#define ROWP(p0_, i_) ((p0_) + (dir ? 31 - (i_) : (i_)))
        {
            const float eend = eb[pd];
            float kt[TPS];
#pragma unroll
            for (int tt = 0; tt < TPS; ++tt) kt[tt] = bf2f(Kh[(seg * TPS + tt) * QS + pd]) * eend;
#pragma unroll
            for (int g8 = 0; g8 < TPS / 8; ++g8) *(uint4*)(Kt + pd * TS + seg * TPS + g8 * 8) = pack8(kt + g8 * 8);
            const int vc = tid & 127, vs = tid >> 7;
            float vv[16];
#pragma unroll
            for (int tt = 0; tt < 16; ++tt) vv[tt] = bf2f(vraw[(vs * 16 + tt) * 128 + vc]);
            *(uint4*)(Vt + vc * TS + vs * 16) = pack8(vv);
            *(uint4*)(Vt + vc * TS + vs * 16 + 8) = pack8(vv + 8);
        }
        __syncthreads();
        f32x16 st, stb;
#pragma unroll
        for (int r = 0; r < 16; ++r) { st[r] = 0.f; stb[r] = 0.f; }
        {
            bf16x8 ka[DK / 16], qb[DK / 16];
#pragma unroll
            for (int ks = 0; ks < DK / 16; ++ks) { ka[ks] = *(const bf16x8*)(Kh + r32 * QS + ks * 16 + hh * 8); qb[ks] = *(const bf16x8*)(Qh + r32 * QS + ks * 16 + hh * 8); }
            asm volatile("s_waitcnt lgkmcnt(0)" ::: "memory");
#pragma unroll
            for (int ks = 0; ks < DK / 16; ks += 2) {
                st = __builtin_amdgcn_mfma_f32_32x32x16_bf16(ka[ks], qb[ks], st, 0, 0, 0);
                stb = __builtin_amdgcn_mfma_f32_32x32x16_bf16(ka[ks + 1], qb[ks + 1], stb, 0, 0, 0);
            }
        }
        uint2 vp[2][2], qp[NT][2][2];
#pragma unroll
        for (int sI = 0; sI < 2; ++sI) { const bf16_t* av = Vt + (wave * 32 + r32) * TS + sI * 16 + 4 * hh; vp[sI][0] = *(const uint2*)av; vp[sI][1] = *(const uint2*)(av + 8); }
#pragma unroll
        for (int T = 0; T < NT; ++T)
#pragma unroll
            for (int sI = 0; sI < 2; ++sI) { const bf16_t* bq = Qh + r32 * QS + T * 32 + sI * 16 + 4 * hh; qp[T][sI][0] = *(const uint2*)bq; qp[T][sI][1] = *(const uint2*)(bq + 8); }
#pragma unroll
        for (int r = 0; r < 16; ++r) st[r] += stb[r];
        bf16x8 pfr[2];
#pragma unroll
        for (int sI = 0; sI < 2; ++sI) {
            union { bf16x8 v; unsigned u[4]; } cv;
#pragma unroll
            for (int q = 0; q < 4; ++q) {
                const int ra = 8 * sI + 2 * q, rb = ra + 1;
                const int ja = (ra & 3) + 8 * (ra >> 2) + 4 * hh, jb = (rb & 3) + 8 * (rb >> 2) + 4 * hh;
                cv.u[q] = cvt_pk(ja <= r32 ? st[ra] : 0.f, jb <= r32 ? st[rb] : 0.f);
            }
            pfr[sI] = cv.v;
        }
        asm volatile("s_waitcnt lgkmcnt(0)" ::: "memory");
        f32x16 oT, oTb;
#pragma unroll
        for (int r = 0; r < 16; ++r) { oT[r] = 0.f; oTb[r] = 0.f; }
#pragma unroll
        for (int sI = 0; sI < 2; ++sI) {
            union { bf16x8 v; uint2 h[2]; } cv;
            cv.h[0] = vp[sI][0]; cv.h[1] = vp[sI][1];
            oT = __builtin_amdgcn_mfma_f32_32x32x16_bf16(cv.v, pfr[sI], oT, 0, 0, 0);
        }
#pragma unroll
        for (int T = 0; T < NT; ++T)
#pragma unroll
            for (int sI = 0; sI < 2; ++sI) {
                union { bf16x8 v; unsigned u[4]; } ca;
#pragma unroll
                for (int q = 0; q < 4; ++q) ca.u[q] = cvt_pk(ST[T][8 * sI + 2 * q], ST[T][8 * sI + 2 * q + 1]);
                union { bf16x8 v; uint2 h[2]; } cb;
                cb.h[0] = qp[T][sI][0]; cb.h[1] = qp[T][sI][1];
                if (T & 1) oTb = __builtin_amdgcn_mfma_f32_32x32x16_bf16(ca.v, cb.v, oTb, 0, 0, 0);
                else oT = __builtin_amdgcn_mfma_f32_32x32x16_bf16(ca.v, cb.v, oT, 0, 0, 0);
            }
        {
            bf16x8 kt2[NT][2], vb2[2];
            float4 e4v[NT][4];
#pragma unroll
            for (int ks = 0; ks < 2; ++ks) vb2[ks] = *(const bf16x8*)(Vt + (wave * 32 + r32) * TS + ks * 16 + hh * 8);
#pragma unroll
            for (int T = 0; T < NT; ++T) {
#pragma unroll
                for (int ks = 0; ks < 2; ++ks) kt2[T][ks] = *(const bf16x8*)(Kt + (T * 32 + r32) * TS + ks * 16 + hh * 8);
#pragma unroll
                for (int g = 0; g < 4; ++g) e4v[T][g] = *(const float4*)(eb + T * 32 + 8 * g + 4 * hh);
            }
            asm volatile("s_waitcnt lgkmcnt(0)" ::: "memory");
#pragma unroll
            for (int T = 0; T < NT; ++T) {
#pragma unroll
                for (int g = 0; g < 4; ++g) { ST[T][4 * g + 0] *= e4v[T][g].x; ST[T][4 * g + 1] *= e4v[T][g].y; ST[T][4 * g + 2] *= e4v[T][g].z; ST[T][4 * g + 3] *= e4v[T][g].w; }
#pragma unroll
                for (int ks = 0; ks < 2; ++ks) ST[T] = __builtin_amdgcn_mfma_f32_32x32x16_bf16(kt2[T][ks], vb2[ks], ST[T], 0, 0, 0);
            }
        }
#pragma unroll
        for (int r = 0; r < 16; ++r) oT[r] += oTb[r];
        {
            const int p = ROWP(CH_P0(c), r32);
            bf16_t* op = OS + (size_t)p * 512 + 4 * hh;
#pragma unroll
            for (int g = 0; g < 4; ++g) { uint2 o; o.x = cvt_pk(oT[4 * g], oT[4 * g + 1]); o.y = cvt_pk(oT[4 * g + 2], oT[4 * g + 3]); *(uint2*)(op + 8 * g) = o; }
        }
#undef CH_P0
#undef ROWP
}

template <bool GLA>
__device__ void scan3_item(const Params& P, int l, int item, unsigned char* smem) {
    constexpr int DK = GLA ? 64 : 128, NT = DK / 32, QS = DK + 8, TS = 40, NSEG = GLA ? 4 : 2, TPS = 32 / NSEG, QCH = DK / 8;
    const int tid = tid_opaque(), lane = tid & 63, wave = tid >> 6, r32 = lane & 31, hh = lane >> 5;
    const int dir = item & 1, head = (item >> 1) & 3, bl = item >> 3;
    __builtin_amdgcn_s_setprio(3);
    bf16_t* Qh = (bf16_t*)smem;
    bf16_t* Kh = Qh + 32 * QS;
    bf16_t* Kt = Kh + 32 * QS;
    bf16_t* Vt = Kt + DK * TS;
    float* eb = (float*)(Vt + 128 * TS);
    bf16_t* vraw = (bf16_t*)(eb + DK);
    const bf16_t* PB = (const bf16_t*)(P.ws + OFF_PB) + (size_t)bl * TB * PW;
    bf16_t* OS = (bf16_t*)(P.ws + (GLA ? OFF_OSG : OFF_KV)) + ((size_t)dir * NTH + (size_t)bl * TB) * 512 + head * 128 + wave * 32;
    const bf16_t* qsrc; const bf16_t* ksrc; int qld, kld;
    if (GLA) {
        if (dir == 0) { qsrc = PB + C_GQ + head * 64; qld = PW; ksrc = PB + C_GK + head * 64; kld = PW; }
        else { const bf16_t* X = (const bf16_t*)(P.ws + OFF_XG) + (size_t)bl * TB * 512; qsrc = X + head * 64; qld = 512; ksrc = X + 256 + head * 64; kld = 512; }
    } else {
        if (dir == 0) { qsrc = PB + C_HQ + head * 128; qld = PW; ksrc = PB + C_HF + head * 128; kld = PW; }
        else { qsrc = (const bf16_t*)(P.ws + OFF_XH) + (size_t)bl * TB * 512 + head * 128; qld = 512; ksrc = PB + C_HF + 512 + head * 128; kld = PW; }
    }
    const float* ebsrc = (const float*)(P.ws + (GLA ? OFF_EBG : OFF_EBH)) + ((size_t)(bl * 264) * 2 + dir) * (4 * DK) + head * DK;
    const int vcol = (GLA ? C_GV : C_HI) + head * 128;
    const int pd = tid & (DK - 1), seg = tid / DK;
    uint4 pq0A, pq1A, pk0A, pk1A, pv0A, pv1A, pq0B, pq1B, pk0B, pk1B, pv0B, pv1B; float peA = 0.f, peB = 0.f;
    pq1A = pk1A = pq1B = pk1B = make_uint4(0, 0, 0, 0);
#define CH_P0(c) (dir ? ((c) < 8 ? (7 - (c)) * 32 : CTXL + (263 - (c)) * 32) : (c) * 32)
#define ROWP(p0_, i_) ((p0_) + (dir ? 31 - (i_) : (i_)))
#define SC_GLOAD(c, S) { const int p0_ = CH_P0(c); \
        { const int id = tid, i = id / QCH, ch = id % QCH; const size_t rr_ = (size_t)ROWP(p0_, i); pq0##S = *(const uint4*)(qsrc + rr_ * qld + ch * 8); pk0##S = *(const uint4*)(ksrc + rr_ * kld + ch * 8); } \
        if (!GLA) { const int id = tid + 256, i = id / QCH, ch = id % QCH; const size_t rr_ = (size_t)ROWP(p0_, i); pq1##S = *(const uint4*)(qsrc + rr_ * qld + ch * 8); pk1##S = *(const uint4*)(ksrc + rr_ * kld + ch * 8); } \
        { const int i = tid >> 4, ch = tid & 15; pv0##S = *(const uint4*)(PB + (size_t)ROWP(p0_, i) * PW + vcol + ch * 8); pv1##S = *(const uint4*)(PB + (size_t)ROWP(p0_, i + 16) * PW + vcol + ch * 8); } \
        if (tid < DK) pe##S = ebsrc[(size_t)(p0_ >> 5) * 2 * (4 * DK) + tid]; }
    f32x16 ST[NT];
#pragma unroll
    for (int T = 0; T < NT; ++T)
#pragma unroll
        for (int r = 0; r < 16; ++r) ST[T][r] = 0.f;
#define SC_COPY(S) { \
        { const int id = tid, i = id / QCH, ch = id % QCH; *(uint4*)(Qh + i * QS + ch * 8) = pq0##S; *(uint4*)(Kh + i * QS + ch * 8) = pk0##S; } \
        if (!GLA) { const int id = tid + 256, i = id / QCH, ch = id % QCH; *(uint4*)(Qh + i * QS + ch * 8) = pq1##S; *(uint4*)(Kh + i * QS + ch * 8) = pk1##S; } \
        { const int i = tid >> 4, ch = tid & 15; *(uint4*)(vraw + i * 128 + ch * 8) = pv0##S; *(uint4*)(vraw + (i + 16) * 128 + ch * 8) = pv1##S; } \
        if (tid < DK) eb[tid] = pe##S; }
    SC_GLOAD(0, A);
    SC_GLOAD(1, B);
    for (int c = 0; c < 264; c += 2) {
        __syncthreads();
        SC_COPY(A);
        __syncthreads();
        { const int cl_ = c + 2 < 264 ? c + 2 : 263; SC_GLOAD(cl_, A); asm volatile("" ::: "memory"); }
        scan3_rest<GLA>(ST, Qh, Kh, Kt, Vt, eb, vraw, OS, tid, wave, r32, hh, pd, seg, c, dir);
        __syncthreads();
        SC_COPY(B);
        __syncthreads();
        { const int cl_ = c + 3 < 264 ? c + 3 : 263; SC_GLOAD(cl_, B); asm volatile("" ::: "memory"); }
        scan3_rest<GLA>(ST, Qh, Kh, Kt, Vt, eb, vraw, OS, tid, wave, r32, hh, pd, seg, c + 1, dir);
    }
#undef SC_COPY
#undef CH_P0
#undef ROWP
#undef SC_GLOAD
    __builtin_amdgcn_s_setprio(0);
}

#ifdef ONLYI
#define IT_ON(n) (ONLYI == (n))
#else
#define IT_ON(n) true
#endif
__device__ void phase_mixers(const Params& P, int ph, int l, unsigned char* smem, int mode = 0) {
    constexpr int N_HG = 16, N_GLA = 16, N_ATT = 2 * 8 * 66;
    const int bx = blockIdx.x;
    int my_scan = -1;
    if (mode != 2 && bx < 256 && (bx & 7) == ((bx >> 3) & 7)) my_scan = bx >> 3;
    if (mode == 0 && bx >= 256 && ((bx - 256) & 7) == (((bx - 256) >> 3) & 7)) return;
    for (;;) {
        int it;
        if (my_scan >= 0) { it = my_scan; my_scan = -1; }
        else {
            if (mode == 1) break;
            it = next_item(P, ph) + N_HG + N_GLA;
        }
        if (it >= N_HG + N_GLA + 2 * N_ATT) break;
        if (it < N_HG) { if (IT_ON(0)) scan3_item<false>(P, l, it, smem); continue; }
        it -= N_HG;
        if (it < N_GLA) { if (IT_ON(1)) scan3_item<true>(P, l, it, smem); continue; }
        it -= N_GLA;
        if (it < N_ATT) { const int bl = it / 528, rem = it % 528; if (IT_ON(2)) attn_item<96, false>(P, l, bl, rem / 66, rem % 66, smem); continue; }
        it -= N_ATT;
        { const int bl = it / 528, rem = it % 528; if (IT_ON(3)) attn_item<64, true>(P, l, bl, rem / 66, rem % 66, smem); }
    }
}

__device__ void phase_scanfin(const Params& P, int ph, int l) {
    const int tid = tid_opaque(), lane = tid & 63, wave = tid >> 6;
    bf16_t* PB = (bf16_t*)(P.ws + OFF_PB);
    const bf16_t* OSH = (const bf16_t*)(P.ws + OFF_KV);
    const bf16_t* OSGp = (const bf16_t*)(P.ws + OFF_OSG);
    float gh[8], gg[8];
#pragma unroll
    for (int e = 0; e < 8; ++e) { gh[e] = P.hg_g_o[l * 128 + (lane & 15) * 8 + e]; gg[e] = P.gla_g_o[l * 128 + (lane & 15) * 8 + e]; }
    for (;;) {
        const int u = next_item(P, ph);
        if (u >= NTH / 16) break;
        uint4 ra[8], rb[8], rz[8];
#pragma unroll
        for (int k = 0; k < 8; ++k) {
            const int t = u * 16 + wave * 4 + (k >> 1), mx = k & 1;
            const bf16_t* OS = mx ? OSGp : OSH;
            ra[k] = *(const uint4*)(OS + (size_t)t * 512 + lane * 8);
            rb[k] = *(const uint4*)(OS + ((size_t)NTH + t) * 512 + lane * 8);
            rz[k] = *(const uint4*)(PB + (size_t)t * PW + C_Z + (2 + mx) * 512 + lane * 8);
        }
#pragma unroll
        for (int k = 0; k < 8; ++k) {
            const int t = u * 16 + wave * 4 + (k >> 1), mx = k & 1;
            float a[8], b[8], z[8];
            unpack8(ra[k], a); unpack8(rb[k], b); unpack8(rz[k], z);
            float ss = 0.f;
#pragma unroll
            for (int e = 0; e < 8; ++e) { a[e] += b[e]; ss += a[e] * a[e]; }
            ss += __shfl_xor(ss, 1); ss += __shfl_xor(ss, 2); ss += __shfl_xor(ss, 4); ss += __shfl_xor(ss, 8);
            const float rn = rsqrtf(ss * (1.f / 128.f) + EPS);
#pragma unroll
            for (int e = 0; e < 8; ++e) a[e] = a[e] * rn * (mx ? gg[e] : gh[e]) * siluf_(z[e]);
            *(uint4*)(PB + (size_t)t * PW + C_Z + (2 + mx) * 512 + lane * 8) = pack8(a);
        }
    }
}

__device__ void phase_merge(const Params& P, int ph, int l, unsigned char* smem) {
    const int tid_ = tid_opaque(), lane = tid_ & 63, wave = tid_ >> 6, wr = wave >> 1, wc = wave & 1;
    const bf16_t* H = (const bf16_t*)(P.ws + OFF_H);
    const bf16_t* PB = (const bf16_t*)(P.ws + OFF_PB);
    bf16_t* ACC = (bf16_t*)(P.ws + OFF_KV);
    for (;;) {
        const int u = next_item(P, ph);
        if (u >= 132 * 16) break;
        const int mt = u >> 4, nt = u & 15;
        const int col = nt * 64 + wc * 32 + (lane & 31);
        f32x16 tot[2];
#pragma unroll
        for (int r = 0; r < 16; ++r) { tot[0][r] = 0.f; tot[1][r] = 0.f; }
        for (int br = 0; br < 4; ++br) {
            unsigned gate[2][8];
            f32x16 g[2], pa[2];
#pragma unroll
            for (int r = 0; r < 16; ++r) { g[0][r] = 0.f; g[1][r] = 0.f; pa[0][r] = 0.f; pa[1][r] = 0.f; }
            gemm_pair_n64(g, pa, H + (size_t)mt * 128 * D, D, (const bf16_t*)(P.ws + OFF_WM) + ((size_t)(l * 4 + br) * 1024 + nt * 64) * 1024, 1024, 1024,
                          PB + (size_t)mt * 128 * PW + C_Z + br * 512, PW, (const bf16_t*)(P.ws + OFF_WBR) + ((size_t)(l * 4 + br) * 1024 + nt * 64) * 512, 512, 512, smem);
            {
                const float bm = P.b_merge[(l * 4 + br) * 1024 + col];
#pragma unroll
                for (int mi = 0; mi < 2; ++mi)
#pragma unroll
                    for (int r = 0; r < 8; ++r) gate[mi][r] = cvt_pk_asm(sigmoidf_(g[mi][2 * r] + bm), sigmoidf_(g[mi][2 * r + 1] + bm));
            }
#pragma unroll
            for (int mi = 0; mi < 2; ++mi)
#pragma unroll
                for (int r = 0; r < 8; ++r) {
                    tot[mi][2 * r] = fmaf(lo16(gate[mi][r]), pa[mi][2 * r], tot[mi][2 * r]);
                    tot[mi][2 * r + 1] = fmaf(hi16(gate[mi][r]), pa[mi][2 * r + 1], tot[mi][2 * r + 1]);
                }
        }
#pragma unroll
        for (int mi = 0; mi < 2; ++mi)
#pragma unroll
            for (int r = 0; r < 16; ++r) ACC[(size_t)(mt * 128 + ACC_ROW(mi, r)) * 1024 + col] = f2bf(tot[mi][r]);
    }
}

__device__ void phase_out(const Params& P, int ph, int l, int hf, unsigned char* smem) {
    const int tid_ = tid_opaque(), lane = tid_ & 63, wave = tid_ >> 6, wr = wave >> 1, wc = wave & 1;
    const bf16_t* ACC = (const bf16_t*)(P.ws + OFF_KV);
    const float* mod = (const float*)(P.ws + OFF_MOD);
    for (;;) {
        const int u = next_item(P, ph);
        if (u >= 132 * 8) break;
        const int mt = u >> 3, nt = u & 7;
        const int t0 = mt * 128, bl = t0 / TB, p0 = t0 % TB, b = hf * 2 + bl;
        const bool isctx = p0 < CTXL;
        if (isctx && l == 1) continue;
        f32x16 acc[2][2]; zero_acc(acc);
        gemm_tile_pf2(acc, ACC + (size_t)mt * 128 * 1024, 1024, (const bf16_t*)(P.ws + OFF_WO) + ((size_t)l * 1024 + nt * 128) * 1024, 1024, 1024, smem);
        const float* gt = mod + (l * 5 + (isctx ? 4 : b)) * 3072 + 2048 + nt * 128;
        const float* src; float* dst;
        if (isctx) { src = P.ctx + ((size_t)b * CTXL + p0) * D; dst = (float*)(P.ws + OFF_CX1) + ((size_t)b * CTXL + p0) * D; }
        else { const size_t o = ((size_t)b * SEQ + (p0 - CTXL)) * D; src = (l == 0 ? P.x : (const float*)P.out) + o; dst = P.out + o; }
        float rv[2][2][16];
#pragma unroll
        for (int mi = 0; mi < 2; ++mi)
#pragma unroll
            for (int ni = 0; ni < 2; ++ni)
#pragma unroll
                for (int r = 0; r < 16; ++r) rv[mi][ni][r] = src[(size_t)ACC_ROW(mi, r) * D + nt * 128 + ACC_COL(ni)];
#pragma unroll
        for (int mi = 0; mi < 2; ++mi)
#pragma unroll
            for (int ni = 0; ni < 2; ++ni) {
                const int cl = ACC_COL(ni);
                const float g = gt[cl];
#pragma unroll
                for (int r = 0; r < 16; ++r) { const size_t o = (size_t)ACC_ROW(mi, r) * D + nt * 128 + cl; dst[o] = rv[mi][ni][r] + g * acc[mi][ni][r]; }
            }
    }
}

__global__ void __launch_bounds__(256, 2) mega(Params PK) {
    extern __shared__ __attribute__((aligned(16))) unsigned char smem[];
    if (blockIdx.x == 0 && threadIdx.x == 0) {
        Params* T = (Params*)(PK.ws + OFF_TAB);
        T->x = PK.x; T->c = PK.c; T->ctx = PK.ctx; T->c_ctx = PK.c_ctx; T->ada_w = PK.ada_w; T->ada_b = PK.ada_b; T->norm_g = PK.norm_g; T->w_in = PK.w_in;
        T->w_uq = PK.w_uq; T->w_ukv = PK.w_ukv; T->g_cq = PK.g_cq; T->g_ckv = PK.g_ckv; T->g_q = PK.g_q; T->g_k = PK.g_k; T->rpb = PK.rpb; T->ng_q = PK.ng_q; T->ng_k = PK.ng_k;
        T->lb_logits = PK.lb_logits; T->hg_g_o = PK.hg_g_o; T->gla_w2 = PK.gla_w2; T->gla_b2 = PK.gla_b2; T->gla_g_o = PK.gla_g_o; T->w_br = PK.w_br; T->w_merge = PK.w_merge;
        T->b_merge = PK.b_merge; T->w_out = PK.w_out; T->out = PK.out; T->ws = PK.ws; T->ph_lo = PK.ph_lo; T->ph_hi = PK.ph_hi;
    }
    unsigned char* wsb = PK.ws;
    const int ph_lo = PK.ph_lo, ph_hi = PK.ph_hi;
#ifdef PROBE_SUB
    __shared__ long long s_tacc, s_tprev; if (threadIdx.x == 0) { s_tacc = 0; s_tprev = 0; }
#endif
    for (int ph = ph_lo; ph < ph_hi; ++ph) {
#ifndef SPLIT_MIX
        if (ph > 8 && ((ph - 1) & 7) == 0) continue;
#endif
        if (ph > ph_lo) cg::this_grid().sync();
        const Params& P = PK;
#ifdef PROBE_SUB
        if (threadIdx.x == 0) { const long long t_now = wall_clock64();
#ifdef SPLIT_MIX
            const int prev_sub = (ph == 0) ? -1 : (ph == 1 ? 9 : ((ph - 2) % 9));
#else
            const int prev_sub = (ph == 0) ? -1 : (ph == 1 ? 8 : ((ph - 2) & 7));
#endif
            if (prev_sub == PROBE_SUB) s_tacc += t_now - s_tprev; s_tprev = t_now; }
#endif
#ifdef ONLYP
#define PH_ON(n) ((ONLYP >> (n)) & 1)
#else
#define PH_ON(n) true
#endif
        if (ph == 0) { if (PH_ON(8)) phase_prologue(PK, ph, smem); continue; }
#ifdef SPLIT_MIX
        const int q = ph - 1, pass = q / 9, sub9 = q % 9, l = pass >> 1, hf = pass & 1;
        if (sub9 == 4 || sub9 == 5) { phase_mixers(P, ph, l, smem, sub9 - 3); continue; }
        const int sub = sub9 < 4 ? sub9 : sub9 - 1;
        switch (sub) {
            case 0: phase_norm(P, ph, l, hf); break;
            case 1: phase_gemm1(P, ph, l, smem); break;
            case 2: phase_gemm2(P, ph, l, smem); break;
            case 3: phase_finalize(P, ph, l, smem); break;
            case 5: phase_scanfin(P, ph, l); break;
            case 6: phase_merge(P, ph, l, smem); break;
            default: phase_out(P, ph, l, hf, smem); break;
        }
#else
        const int q = ph - 1, pass = q >> 3, sub = q & 7, l = pass >> 1, hf = pass & 1;
        switch (sub) {
            case 0: if (PH_ON(0)) phase_norm(P, ph, l, hf); break;
            case 1: if (PH_ON(1)) phase_gemm1(P, ph, l, smem); break;
            case 2: if (PH_ON(2)) phase_gemm2(P, ph, l, smem); break;
            case 3: if (PH_ON(3)) phase_finalize(P, ph, l, smem); break;
            case 4: if (PH_ON(4)) phase_mixers(P, ph, l, smem); break;
            case 5: if (PH_ON(5)) phase_scanfin(P, ph, l); break;
            case 6: if (PH_ON(6)) phase_merge(P, ph, l, smem); break;
            default: if (PH_ON(7)) { phase_out(P, ph, l, hf, smem); if (pass < 3) phase_norm(P, ph + 40, (pass + 1) >> 1, (pass + 1) & 1); } break;
        }
#endif
    }
#ifdef PROBE_SUB
    cg::this_grid().sync();
    if (threadIdx.x == 0) { const long long t_now = wall_clock64(); if (7 == PROBE_SUB) s_tacc += t_now - s_tprev;
      if (blockIdx.x == 0) { const long long t_acc = s_tacc; const long long t0 = wall_clock64(); while (wall_clock64() - t0 < t_acc) { __builtin_amdgcn_s_sleep(10); } } }
#endif
}

extern "C" void kernel_launch(void* const* d_in, const int* in_sizes, int n_in, void* d_out, int out_size, void* d_ws, size_t ws_size, hipStream_t stream) {
    static int grid = 0;
    if (grid == 0) {
        if (ws_size < WS_END) { fprintf(stderr, "workspace too small: %zu < %zu\n", ws_size, (size_t)WS_END); grid = -1; return; }
        int dev = 0, cus = 0, per_cu = 0;
        hipGetDevice(&dev);
        hipDeviceGetAttribute(&cus, hipDeviceAttributeMultiprocessorCount, dev);
        hipFuncSetAttribute((const void*)mega, hipFuncAttributeMaxDynamicSharedMemorySize, LDS_BYTES);
        hipOccupancyMaxActiveBlocksPerMultiprocessor(&per_cu, (const void*)mega, 256, LDS_BYTES);
        if (per_cu < 1) per_cu = 1;
        if (per_cu > 2) per_cu = 2;
        grid = cus * per_cu;
        (void)hipGetLastError();
    }
    if (grid < 0) return;
    hipMemsetAsync((unsigned char*)d_ws + OFF_CTL, 0, 4096, stream);
    Params p{};
    const float** pp = (const float**)&p;
    for (int i = 0; i < 26; ++i) pp[i] = (const float*)d_in[i];
    p.out = (float*)d_out; p.ws = (unsigned char*)d_ws;
#if SINGLE_LAUNCH
    p.ph_lo = 0; p.ph_hi = NPHASE;
    void* args[] = {&p};
    hipError_t e = hipLaunchCooperativeKernel((const void*)mega, dim3(grid), dim3(256), args, LDS_BYTES, stream);
    if (e != hipSuccess) fprintf(stderr, "cooperative launch failed: %s (grid %d)\n", hipGetErrorString(e), grid);
#else
    for (int ph = 0; ph < NPHASE; ++ph) {
        p.ph_lo = ph; p.ph_hi = ph + 1;
        hipLaunchKernelGGL(mega, dim3(grid), dim3(256), LDS_BYTES, stream, p);
    }
#endif
}
```

```cpp
#include <hip/hip_runtime.h>
#include <hip/hip_cooperative_groups.h>
#include <stdint.h>
#include <stdio.h>
namespace cg = cooperative_groups;

typedef unsigned short bf16_t;
typedef short bf16x8 __attribute__((ext_vector_type(8)));
typedef short bf16x4 __attribute__((ext_vector_type(4)));
typedef float f32x16 __attribute__((ext_vector_type(16)));

#ifndef SINGLE_LAUNCH
#define SINGLE_LAUNCH 1
#endif

constexpr int D = 1024, SEQ = 8192, CTXL = 256, TB = SEQ + CTXL  , NTH = 2 * TB  ;
constexpr int INW = 7104, PW = 7104;
constexpr int C_CQ = 0, C_CKV = 256, C_KR = 384, C_NQ = 416, C_NK = 928, C_NV = 1440, C_HQ = 1952, C_HF = 2464, C_HI = 3488,
              C_GQ = 4000, C_GK = 4256, C_GV = 4512, C_GR = 5024, C_Z = 5056;
constexpr float EPS = 1e-6f;
constexpr float LOG2E = 1.4426950408889634f;
constexpr int LDS_BYTES = 73728;
#ifdef SPLIT_MIX
constexpr int NPHASE = 37;
#else
constexpr int NPHASE = 33;
#endif

constexpr size_t al256(size_t v) { return (v + 255) & ~(size_t)255; }
constexpr size_t OFF_CTL = 0;
constexpr size_t OFF_TAB = 1024;
constexpr size_t OFF_MOD = 4096;
constexpr size_t OFF_CX1 = al256(OFF_MOD + 2 * 5 * 3072 * 4);
constexpr size_t OFF_WIN = al256(OFF_CX1 + (size_t)4 * 256 * 1024 * 4);
constexpr size_t OFF_WM = al256(OFF_WIN + (size_t)2 * 7168 * 1024 * 2);
constexpr size_t OFF_WBR = al256(OFF_WM + (size_t)8 * 1024 * 1024 * 2);
constexpr size_t OFF_WO = al256(OFF_WBR + (size_t)8 * 1024 * 512 * 2);
constexpr size_t OFF_WUQ = al256(OFF_WO + (size_t)2 * 1024 * 1024 * 2);
constexpr size_t OFF_WUKV = al256(OFF_WUQ + (size_t)2 * 768 * 256 * 2);
constexpr size_t OFF_H = al256(OFF_WUKV + (size_t)2 * 1024 * 128 * 2);
constexpr size_t OFF_PB = al256(OFF_H + (size_t)NTH * 1024 * 2);
constexpr size_t OFF_QF = al256(OFF_PB + (size_t)NTH * PW * 2);
constexpr size_t OFF_KV = al256(OFF_QF + (size_t)NTH * 768 * 2);
constexpr size_t OFF_KF = al256(OFF_KV + (size_t)NTH * 1024 * 2);
constexpr size_t OFF_VTM = al256(OFF_KF + (size_t)NTH * 768 * 2);
constexpr size_t OFF_VTN = al256(OFF_VTM + (size_t)2 * 8 * 64 * TB * 2);
constexpr size_t OFF_OSG = al256(OFF_VTN + (size_t)2 * 8 * 64 * TB * 2);
constexpr size_t OFF_XH = al256(OFF_OSG + (size_t)2 * NTH * 512 * 2);
constexpr size_t OFF_XG = al256(OFF_XH + (size_t)NTH * 512 * 2);
constexpr size_t OFF_EBH = al256(OFF_XG + (size_t)NTH * 512 * 2);
constexpr size_t OFF_EBG = al256(OFF_EBH + (size_t)528 * 2 * 512 * 4);
constexpr size_t WS_END = al256(OFF_EBG + (size_t)528 * 2 * 256 * 4);

static_assert(WS_END <= (size_t)512 * 1024 * 1024, "workspace map exceeds 512 MiB");
struct Params {
    const float *x, *c, *ctx, *c_ctx, *ada_w, *ada_b, *norm_g, *w_in, *w_uq, *w_ukv, *g_cq, *g_ckv, *g_q, *g_k, *rpb, *ng_q, *ng_k,
        *lb_logits, *hg_g_o, *gla_w2, *gla_b2, *gla_g_o, *w_br, *w_merge, *b_merge, *w_out;
    float* out;
    unsigned char* ws;
    int ph_lo, ph_hi;
};

__device__ __forceinline__ float bf2f(bf16_t v) { return __uint_as_float(((unsigned)v) << 16); }
typedef float f32x2_t __attribute__((ext_vector_type(2)));
typedef __bf16 bf16x2_t __attribute__((ext_vector_type(2)));
__device__ __forceinline__ unsigned cvt_pk(float lo, float hi) { f32x2_t v = {lo, hi}; bf16x2_t b = __builtin_convertvector(v, bf16x2_t); return __builtin_bit_cast(unsigned, b); }
__device__ __forceinline__ unsigned cvt_pk_asm(float lo, float hi) { unsigned r; asm("s_nop 1\n\tv_cvt_pk_bf16_f32 %0, %1, %2" : "=v"(r) : "v"(lo), "v"(hi)); return r; }
__device__ __forceinline__ bf16_t f2bf(float f) { return (bf16_t)(cvt_pk(f, 0.f) & 0xffffu); }
__device__ __forceinline__ float lo16(unsigned u) { return __uint_as_float(u << 16); }
__device__ __forceinline__ float hi16(unsigned u) { return __uint_as_float(u & 0xffff0000u); }
__device__ __forceinline__ float sigmoidf_(float x) { return 1.f / (1.f + __expf(-x)); }
__device__ __forceinline__ float siluf_(float x) { return x / (1.f + __expf(-x)); }
__device__ __forceinline__ float wave_sum(float v) {
#pragma unroll
    for (int o = 32; o > 0; o >>= 1) v += __shfl_xor(v, o);
    return v;
}
__device__ __forceinline__ void unpack8(uint4 u, float* f) {
    f[0] = lo16(u.x); f[1] = hi16(u.x); f[2] = lo16(u.y); f[3] = hi16(u.y); f[4] = lo16(u.z); f[5] = hi16(u.z); f[6] = lo16(u.w); f[7] = hi16(u.w);
}
__device__ __forceinline__ uint4 pack8(const float* f) { uint4 u; u.x = cvt_pk(f[0], f[1]); u.y = cvt_pk(f[2], f[3]); u.z = cvt_pk(f[4], f[5]); u.w = cvt_pk(f[6], f[7]); return u; }

__device__ __forceinline__ int tid_opaque() { int t = threadIdx.x; asm volatile("" : "+v"(t)); return t; }
__shared__ int s_item;
__device__ __forceinline__ int next_item(const Params& P, int ph) {
    __syncthreads();
    if (threadIdx.x == 0) s_item = atomicAdd((int*)(P.ws + OFF_CTL) + ph, 1);
    __syncthreads();
    return s_item;
}

constexpr int GS = 72;
__device__ __forceinline__ void gemm_tile(f32x16 (&acc)[2][2], const bf16_t* __restrict__ A, int lda, const bf16_t* __restrict__ Bt, int ldb, int K, unsigned char* smem) {
    const int tid = tid_opaque(), lane = tid & 63, wave = tid >> 6, wr = wave >> 1, wc = wave & 1;
    bf16_t* sA = (bf16_t*)smem;
    bf16_t* sB = sA + 2 * 128 * GS;
    const int lrow = tid >> 3, lch = (tid & 7) * 8;
    uint4 ra[4], rb[4];
    const bf16_t* Ap = A + (size_t)lrow * lda + lch;
    const bf16_t* Bp = Bt + (size_t)lrow * ldb + lch;
#pragma unroll
    for (int i = 0; i < 4; ++i) { ra[i] = *(const uint4*)(Ap + (size_t)(32 * i) * lda); rb[i] = *(const uint4*)(Bp + (size_t)(32 * i) * ldb); }
#pragma unroll
    for (int i = 0; i < 4; ++i) { *(uint4*)(sA + (lrow + 32 * i) * GS + lch) = ra[i]; *(uint4*)(sB + (lrow + 32 * i) * GS + lch) = rb[i]; }
    __syncthreads();
    const int nk = K >> 6;
    const int aoff = (wr * 64 + (lane & 31)) * GS + (lane >> 5) * 8, boff = (wc * 64 + (lane & 31)) * GS + (lane >> 5) * 8;
    for (int kt = 0; kt < nk; ++kt) {
        const bool more = kt + 1 < nk;
        if (more) {
#pragma unroll
            for (int i = 0; i < 4; ++i) { ra[i] = *(const uint4*)(Ap + (size_t)(32 * i) * lda + (kt + 1) * 64); rb[i] = *(const uint4*)(Bp + (size_t)(32 * i) * ldb + (kt + 1) * 64); }
        }
        const bf16_t* a = sA + (kt & 1) * 128 * GS + aoff;
        const bf16_t* b = sB + (kt & 1) * 128 * GS + boff;
#pragma unroll
        for (int ks = 0; ks < 4; ++ks) {
            bf16x8 a0 = *(const bf16x8*)(a + ks * 16), a1 = *(const bf16x8*)(a + 32 * GS + ks * 16);
            bf16x8 b0 = *(const bf16x8*)(b + ks * 16), b1 = *(const bf16x8*)(b + 32 * GS + ks * 16);
            acc[0][0] = __builtin_amdgcn_mfma_f32_32x32x16_bf16(a0, b0, acc[0][0], 0, 0, 0);
            acc[0][1] = __builtin_amdgcn_mfma_f32_32x32x16_bf16(a0, b1, acc[0][1], 0, 0, 0);
            acc[1][0] = __builtin_amdgcn_mfma_f32_32x32x16_bf16(a1, b0, acc[1][0], 0, 0, 0);
            acc[1][1] = __builtin_amdgcn_mfma_f32_32x32x16_bf16(a1, b1, acc[1][1], 0, 0, 0);
        }
        if (more) {
            bf16_t* wa = sA + ((kt + 1) & 1) * 128 * GS;
            bf16_t* wb = sB + ((kt + 1) & 1) * 128 * GS;
#pragma unroll
            for (int i = 0; i < 4; ++i) { *(uint4*)(wa + (lrow + 32 * i) * GS + lch) = ra[i]; *(uint4*)(wb + (lrow + 32 * i) * GS + lch) = rb[i]; }
        }
        __syncthreads();
    }
}

__device__ __forceinline__ void gemm_tile_pf2(f32x16 (&acc)[2][2], const bf16_t* __restrict__ A, int lda, const bf16_t* __restrict__ Bt, int ldb, int K, unsigned char* smem) {
    const int tid = tid_opaque(), lane = tid & 63, wave = tid >> 6, wr = wave >> 1, wc = wave & 1;
    bf16_t* sA = (bf16_t*)smem;
    bf16_t* sB = sA + 2 * 128 * GS;
    const int lrow = tid >> 3, lch = (tid & 7) * 8;
    uint4 pa0, pa1, pa2, pa3, pb0, pb1, pb2, pb3, qa0, qa1, qa2, qa3, qb0, qb1, qb2, qb3;
    const bf16_t* Ap = A + (size_t)lrow * lda + lch;
    const bf16_t* Bp = Bt + (size_t)lrow * ldb + lch;
    const int nk = K >> 6;
#define PF2_LD1(RA, RB, kt_, i) { RA##i = *(const uint4*)(Ap + (size_t)(32 * i) * lda + (kt_) * 64); RB##i = *(const uint4*)(Bp + (size_t)(32 * i) * ldb + (kt_) * 64); }
#define PF2_LOAD(RA, RB, kt_) { PF2_LD1(RA, RB, kt_, 0) PF2_LD1(RA, RB, kt_, 1) PF2_LD1(RA, RB, kt_, 2) PF2_LD1(RA, RB, kt_, 3) }
#define PF2_WR1(RA, RB, i) { *(uint4*)(wa + (lrow + 32 * i) * GS + lch) = RA##i; *(uint4*)(wb + (lrow + 32 * i) * GS + lch) = RB##i; }
#define PF2_WRITE(RA, RB, buf_) { bf16_t* wa = sA + (buf_) * 128 * GS; bf16_t* wb = sB + (buf_) * 128 * GS; PF2_WR1(RA, RB, 0) PF2_WR1(RA, RB, 1) PF2_WR1(RA, RB, 2) PF2_WR1(RA, RB, 3) }
#define PF2_COMPUTE(buf_) { const bf16_t* a = sA + (buf_) * 128 * GS + aoff; const bf16_t* b = sB + (buf_) * 128 * GS + boff; _Pragma("unroll") for (int ks = 0; ks < 4; ++ks) { \
        bf16x8 a0 = *(const bf16x8*)(a + ks * 16), a1 = *(const bf16x8*)(a + 32 * GS + ks * 16); bf16x8 b0 = *(const bf16x8*)(b + ks * 16), b1 = *(const bf16x8*)(b + 32 * GS + ks * 16); \
        acc[0][0] = __builtin_amdgcn_mfma_f32_32x32x16_bf16(a0, b0, acc[0][0], 0, 0, 0); acc[0][1] = __builtin_amdgcn_mfma_f32_32x32x16_bf16(a0, b1, acc[0][1], 0, 0, 0); \
        acc[1][0] = __builtin_amdgcn_mfma_f32_32x32x16_bf16(a1, b0, acc[1][0], 0, 0, 0); acc[1][1] = __builtin_amdgcn_mfma_f32_32x32x16_bf16(a1, b1, acc[1][1], 0, 0, 0); } }
    const int aoff = (wr * 64 + (lane & 31)) * GS + (lane >> 5) * 8, boff = (wc * 64 + (lane & 31)) * GS + (lane >> 5) * 8;
    PF2_LOAD(pa, pb, 0);
    PF2_LOAD(qa, qb, 1);
    PF2_WRITE(pa, pb, 0);
    __syncthreads();
    for (int kt = 0; kt < nk; kt += 2) {
        if (kt + 2 < nk) PF2_LOAD(pa, pb, kt + 2);
        PF2_COMPUTE(0);
        PF2_WRITE(qa, qb, 1);
        __syncthreads();
        if (kt + 3 < nk) PF2_LOAD(qa, qb, kt + 3);
        PF2_COMPUTE(1);
        if (kt + 2 < nk) PF2_WRITE(pa, pb, 0);
        __syncthreads();
    }
#undef PF2_LOAD
#undef PF2_LD1
#undef PF2_WR1
#undef PF2_WRITE
#undef PF2_COMPUTE
}

__device__ __forceinline__ void gemm_tile_n64(f32x16 (&acc)[2], const bf16_t* __restrict__ A, int lda, const bf16_t* __restrict__ Bt, int ldb, int K, unsigned char* smem) {
    const int tid = tid_opaque(), lane = tid & 63, wave = tid >> 6, wr = wave >> 1, wc = wave & 1;
    bf16_t* sA = (bf16_t*)smem;
    bf16_t* sB = sA + 2 * 128 * GS;
    const int lrow = tid >> 3, lch = (tid & 7) * 8;
    uint4 pa0, pa1, pa2, pa3, pb0, pb1, qa0, qa1, qa2, qa3, qb0, qb1;
    const bf16_t* Ap = A + (size_t)lrow * lda + lch;
    const bf16_t* Bp = Bt + (size_t)lrow * ldb + lch;
    const int nk = K >> 6;
#define N64_LOAD(RA, RB, kt_) { RA##0 = *(const uint4*)(Ap + (kt_) * 64); RA##1 = *(const uint4*)(Ap + (size_t)32 * lda + (kt_) * 64); RA##2 = *(const uint4*)(Ap + (size_t)64 * lda + (kt_) * 64); RA##3 = *(const uint4*)(Ap + (size_t)96 * lda + (kt_) * 64); \
        RB##0 = *(const uint4*)(Bp + (kt_) * 64); RB##1 = *(const uint4*)(Bp + (size_t)32 * ldb + (kt_) * 64); }
#define N64_WRITE(RA, RB, buf_) { bf16_t* wa = sA + (buf_) * 128 * GS + lrow * GS + lch; bf16_t* wb = sB + (buf_) * 64 * GS + lrow * GS + lch; \
        *(uint4*)wa = RA##0; *(uint4*)(wa + 32 * GS) = RA##1; *(uint4*)(wa + 64 * GS) = RA##2; *(uint4*)(wa + 96 * GS) = RA##3; *(uint4*)wb = RB##0; *(uint4*)(wb + 32 * GS) = RB##1; }
#define N64_COMPUTE(buf_) { const bf16_t* a = sA + (buf_) * 128 * GS + aoff; const bf16_t* b = sB + (buf_) * 64 * GS + boff; _Pragma("unroll") for (int ks = 0; ks < 4; ++ks) { \
        bf16x8 a0 = *(const bf16x8*)(a + ks * 16), a1 = *(const bf16x8*)(a + 32 * GS + ks * 16); bf16x8 b0 = *(const bf16x8*)(b + ks * 16); \
        acc[0] = __builtin_amdgcn_mfma_f32_32x32x16_bf16(a0, b0, acc[0], 0, 0, 0); acc[1] = __builtin_amdgcn_mfma_f32_32x32x16_bf16(a1, b0, acc[1], 0, 0, 0); } }
    const int aoff = (wr * 64 + (lane & 31)) * GS + (lane >> 5) * 8, boff = (wc * 32 + (lane & 31)) * GS + (lane >> 5) * 8;
    N64_LOAD(pa, pb, 0);
    N64_LOAD(qa, qb, 1);
    N64_WRITE(pa, pb, 0);
    __syncthreads();
    for (int kt = 0; kt < nk; kt += 2) {
        if (kt + 2 < nk) N64_LOAD(pa, pb, kt + 2);
        N64_COMPUTE(0);
        N64_WRITE(qa, qb, 1);
        __syncthreads();
        if (kt + 3 < nk) N64_LOAD(qa, qb, kt + 3);
        N64_COMPUTE(1);
        if (kt + 2 < nk) N64_WRITE(pa, pb, 0);
        __syncthreads();
    }
#undef N64_LOAD
#undef N64_WRITE
#undef N64_COMPUTE
}

__device__ __forceinline__ void gemm_pair_n64(f32x16 (&acc1)[2], f32x16 (&acc2)[2], const bf16_t* __restrict__ A1, int lda1, const bf16_t* __restrict__ B1, int ldb1, int K1,
                                              const bf16_t* __restrict__ A2, int lda2, const bf16_t* __restrict__ B2, int ldb2, int K2, unsigned char* smem) {
    const int tid = tid_opaque(), lane = tid & 63, wave = tid >> 6, wr = wave >> 1, wc = wave & 1;
    bf16_t* sA = (bf16_t*)smem;
    bf16_t* sB = sA + 2 * 128 * GS;
    const int lrow = tid >> 3, lch = (tid & 7) * 8;
    uint4 pa0, pa1, pa2, pa3, pb0, pb1, qa0, qa1, qa2, qa3, qb0, qb1;
    const bf16_t* Ap1 = A1 + (size_t)lrow * lda1 + lch; const bf16_t* Bp1 = B1 + (size_t)lrow * ldb1 + lch;
    const bf16_t* Ap2 = A2 + (size_t)lrow * lda2 + lch; const bf16_t* Bp2 = B2 + (size_t)lrow * ldb2 + lch;
    const int nk1 = K1 >> 6, nk = nk1 + (K2 >> 6);
#define P64_LOAD(RA, RB, kt_) { const bool s2_ = (kt_) >= nk1; const bf16_t* ap_ = s2_ ? Ap2 + ((kt_) - nk1) * 64 : Ap1 + (kt_) * 64; const bf16_t* bp_ = s2_ ? Bp2 + ((kt_) - nk1) * 64 : Bp1 + (kt_) * 64; \
        const size_t la_ = s2_ ? lda2 : lda1, lb_ = s2_ ? ldb2 : ldb1; \
        RA##0 = *(const uint4*)(ap_); RA##1 = *(const uint4*)(ap_ + 32 * la_); RA##2 = *(const uint4*)(ap_ + 64 * la_); RA##3 = *(const uint4*)(ap_ + 96 * la_); \
        RB##0 = *(const uint4*)(bp_); RB##1 = *(const uint4*)(bp_ + 32 * lb_); }
#define P64_WRITE(RA, RB, buf_) { bf16_t* wa = sA + (buf_) * 128 * GS + lrow * GS + lch; bf16_t* wb = sB + (buf_) * 64 * GS + lrow * GS + lch; \
        *(uint4*)wa = RA##0; *(uint4*)(wa + 32 * GS) = RA##1; *(uint4*)(wa + 64 * GS) = RA##2; *(uint4*)(wa + 96 * GS) = RA##3; *(uint4*)wb = RB##0; *(uint4*)(wb + 32 * GS) = RB##1; }
#define P64_COMPUTE(ACC, buf_) { const bf16_t* a = sA + (buf_) * 128 * GS + aoff; const bf16_t* b = sB + (buf_) * 64 * GS + boff; _Pragma("unroll") for (int ks = 0; ks < 4; ++ks) { \
        bf16x8 a0 = *(const bf16x8*)(a + ks * 16), a1 = *(const bf16x8*)(a + 32 * GS + ks * 16); bf16x8 b0 = *(const bf16x8*)(b + ks * 16); \
        ACC[0] = __builtin_amdgcn_mfma_f32_32x32x16_bf16(a0, b0, ACC[0], 0, 0, 0); ACC[1] = __builtin_amdgcn_mfma_f32_32x32x16_bf16(a1, b0, ACC[1], 0, 0, 0); } }
    const int aoff = (wr * 64 + (lane & 31)) * GS + (lane >> 5) * 8, boff = (wc * 32 + (lane & 31)) * GS + (lane >> 5) * 8;
    P64_LOAD(pa, pb, 0);
    P64_LOAD(qa, qb, 1);
    P64_WRITE(pa, pb, 0);
    __syncthreads();
    for (int kt = 0; kt < nk; kt += 2) {
        if (kt + 2 < nk) P64_LOAD(pa, pb, kt + 2);
        if (kt < nk1) P64_COMPUTE(acc1, 0) else P64_COMPUTE(acc2, 0)
        P64_WRITE(qa, qb, 1);
        __syncthreads();
        if (kt + 3 < nk) P64_LOAD(qa, qb, kt + 3);
        if (kt + 1 < nk1) P64_COMPUTE(acc1, 1) else P64_COMPUTE(acc2, 1)
        if (kt + 2 < nk) P64_WRITE(pa, pb, 0);
        __syncthreads();
    }
#undef P64_LOAD
#undef P64_WRITE
#undef P64_COMPUTE
}
__device__ __forceinline__ void zero_acc(f32x16 (&acc)[2][2]) {
#pragma unroll
    for (int i = 0; i < 2; ++i)
#pragma unroll
        for (int j = 0; j < 2; ++j)
#pragma unroll
            for (int r = 0; r < 16; ++r) acc[i][j][r] = 0.f;
}
#define ACC_ROW(mi, r) (wr * 64 + (mi) * 32 + ((r) & 3) + 8 * ((r) >> 2) + 4 * (lane >> 5))
#define ACC_COL(ni) (wc * 64 + (ni) * 32 + (lane & 31))

__device__ void tr_tile(const float* __restrict__ src, int K, int N, int kt, int nt, bf16_t* __restrict__ dst, const float* __restrict__ scale, float* s) {
    const int tid = tid_opaque(), r = tid >> 4, c4 = (tid & 15) * 4;
#pragma unroll
    for (int i = 0; i < 4; ++i) {
        const int k = kt * 64 + r + 16 * i;
        float4 v = *(const float4*)(src + (size_t)k * N + nt * 64 + c4);
        const float sc = scale ? scale[k] : 1.f;
        float* d = s + (r + 16 * i) * 65 + c4;
        d[0] = v.x * sc; d[1] = v.y * sc; d[2] = v.z * sc; d[3] = v.w * sc;
    }
    __syncthreads();
    const int n = tid >> 2, k0 = (tid & 3) * 16;
    float f[16];
#pragma unroll
    for (int j = 0; j < 16; ++j) f[j] = s[(k0 + j) * 65 + n];
    bf16_t* o = dst + (size_t)(nt * 64 + n) * K + kt * 64 + k0;
    *(uint4*)o = pack8(f);
    *(uint4*)(o + 8) = pack8(f + 8);
    __syncthreads();
}
__device__ void phase_prologue(const Params& P, int ph, unsigned char* smem) {
    float* s = (float*)smem;
    const int NTR = 7296, NMOD = 96;
    for (;;) {
        const int u = next_item(P, ph);
        if (u >= NTR + NMOD) break;
        if (u < NMOD) {
            const int l = u / 48, cb = u % 48, tid = threadIdx.x, lane = tid & 63, wave = tid >> 6;
            float* sc = s;
            float* red = s + 5 * 1024;
            for (int i = tid; i < 5 * 1024; i += 256) { const int r = i >> 10, k = i & 1023; const float v = (r < 4) ? P.c[r * 1024 + k] : P.c_ctx[k]; sc[i] = siluf_(v); }
            __syncthreads();
            const int col = cb * 64 + lane;
            float acc[5] = {0.f, 0.f, 0.f, 0.f, 0.f};
            const float* w = P.ada_w + (size_t)l * 1024 * 3072 + col;
#pragma unroll 8
            for (int k = wave * 256; k < wave * 256 + 256; ++k) {
                const float wv = w[(size_t)k * 3072];
#pragma unroll
                for (int r = 0; r < 5; ++r) acc[r] += sc[r * 1024 + k] * wv;
            }
#pragma unroll
            for (int r = 0; r < 5; ++r) red[(wave * 5 + r) * 64 + lane] = acc[r];
            __syncthreads();
            if (wave == 0) {
                float* mod = (float*)(P.ws + OFF_MOD);
#pragma unroll
                for (int r = 0; r < 5; ++r) mod[(l * 5 + r) * 3072 + col] = red[r * 64 + lane] + red[(5 + r) * 64 + lane] + red[(10 + r) * 64 + lane] + red[(15 + r) * 64 + lane] + P.ada_b[l * 3072 + col];
            }
            continue;
        }
        const int v = u - NMOD, l = v / 3648, r = v % 3648;
        if (r < 1776) tr_tile(P.w_in + (size_t)l * 1024 * INW, 1024, INW, r / 111, r % 111, (bf16_t*)(P.ws + OFF_WIN) + (size_t)l * 7168 * 1024, nullptr, s);
        else if (r < 2800) { const int r2 = r - 1776, br = r2 >> 8, t = r2 & 255; tr_tile(P.w_merge + (size_t)(l * 4 + br) * 1024 * 1024, 1024, 1024, t >> 4, t & 15, (bf16_t*)(P.ws + OFF_WM) + (size_t)(l * 4 + br) * 1024 * 1024, nullptr, s); }
        else if (r < 3312) { const int r2 = r - 2800, br = r2 >> 7, t = r2 & 127; tr_tile(P.w_br + (size_t)(l * 4 + br) * 512 * 1024, 512, 1024, t >> 4, t & 15, (bf16_t*)(P.ws + OFF_WBR) + (size_t)(l * 4 + br) * 1024 * 512, nullptr, s); }
        else if (r < 3568) { const int t = r - 3312; tr_tile(P.w_out + (size_t)l * 1024 * 1024, 1024, 1024, t >> 4, t & 15, (bf16_t*)(P.ws + OFF_WO) + (size_t)l * 1024 * 1024, nullptr, s); }
        else if (r < 3616) { const int t = r - 3568; tr_tile(P.w_uq + (size_t)l * 256 * 768, 256, 768, t / 12, t % 12, (bf16_t*)(P.ws + OFF_WUQ) + (size_t)l * 768 * 256, P.g_cq + l * 256, s); }
        else { const int t = r - 3616; tr_tile(P.w_ukv + (size_t)l * 128 * 1024, 128, 1024, t >> 4, t & 15, (bf16_t*)(P.ws + OFF_WUKV) + (size_t)l * 1024 * 128, P.g_ckv + l * 128, s); }
    }
}

__device__ void phase_norm(const Params& P, int ph, int l, int hf) {
    const int tid = tid_opaque(), lane = tid & 63, wave = tid >> 6;
    const float* mod = (const float*)(P.ws + OFF_MOD);
    bf16_t* H = (bf16_t*)(P.ws + OFF_H);
    for (;;) {
        const int u = next_item(P, ph);
        if (u >= NTH / 8) break;
        float4 v[2][4]; int mrr[2];
#pragma unroll
        for (int rr = 0; rr < 2; ++rr) {
            const int t = u * 8 + wave * 2 + rr, bl = t / TB, p = t % TB, b = hf * 2 + bl;
            const float* src;
            if (p < CTXL) { src = (l == 0 ? P.ctx : (const float*)(P.ws + OFF_CX1)) + ((size_t)b * CTXL + p) * D; mrr[rr] = 4; }
            else { src = (l == 0 ? P.x : (const float*)P.out) + ((size_t)b * SEQ + (p - CTXL)) * D; mrr[rr] = b; }
#pragma unroll
            for (int i = 0; i < 4; ++i) v[rr][i] = *(const float4*)(src + lane * 4 + 256 * i);
        }
#pragma unroll
        for (int rr = 0; rr < 2; ++rr) {
            const int t = u * 8 + wave * 2 + rr;
            float ss = 0.f;
#pragma unroll
            for (int i = 0; i < 4; ++i) ss += v[rr][i].x * v[rr][i].x + v[rr][i].y * v[rr][i].y + v[rr][i].z * v[rr][i].z + v[rr][i].w * v[rr][i].w;
            ss = wave_sum(ss);
            const float rstd = rsqrtf(ss * (1.f / D) + EPS);
            const float* sh = mod + (l * 5 + mrr[rr]) * 3072; const float* sc = sh + 1024; const float* g = P.norm_g + l * D;
#pragma unroll
            for (int i = 0; i < 4; ++i) {
                const int c = lane * 4 + 256 * i;
                const float4 gv = *(const float4*)(g + c), s1 = *(const float4*)(sc + c), s0 = *(const float4*)(sh + c);
                uint2 o;
                o.x = cvt_pk(v[rr][i].x * rstd * gv.x * (1.f + s1.x) + s0.x, v[rr][i].y * rstd * gv.y * (1.f + s1.y) + s0.y);
                o.y = cvt_pk(v[rr][i].z * rstd * gv.z * (1.f + s1.z) + s0.z, v[rr][i].w * rstd * gv.w * (1.f + s1.w) + s0.w);
                *(uint2*)(H + (size_t)t * D + c) = o;
            }
        }
    }
}

__device__ void phase_gemm1(const Params& P, int ph, int l, unsigned char* smem) {
    const int tid_ = tid_opaque(), lane = tid_ & 63, wave = tid_ >> 6, wr = wave >> 1, wc = wave & 1;
    const bf16_t* H = (const bf16_t*)(P.ws + OFF_H);
    const bf16_t* W = (const bf16_t*)(P.ws + OFF_WIN) + (size_t)l * 7168 * 1024;
    bf16_t* PB = (bf16_t*)(P.ws + OFF_PB);
    for (;;) {
        const int u = next_item(P, ph);
        if (u >= 132 * 56) break;
        const int mt = u / 56, nt = u % 56;
        f32x16 acc[2][2]; zero_acc(acc);
        gemm_tile_pf2(acc, H + (size_t)mt * 128 * D, D, W + (size_t)nt * 128 * D, D, D, smem);
#pragma unroll
        for (int mi = 0; mi < 2; ++mi)
#pragma unroll
            for (int ni = 0; ni < 2; ++ni) {
                const int col = nt * 128 + ACC_COL(ni);
                if (col < PW) {
#pragma unroll
                    for (int r = 0; r < 16; ++r) PB[(size_t)(mt * 128 + ACC_ROW(mi, r)) * PW + col] = f2bf(acc[mi][ni][r]);
                }
            }
    }
}

__device__ void phase_gemm2(const Params& P, int ph, int l, unsigned char* smem) {
    const int tid_ = tid_opaque(), lane = tid_ & 63, wave = tid_ >> 6, wr = wave >> 1, wc = wave & 1;
    const bf16_t* PB = (const bf16_t*)(P.ws + OFF_PB);
    for (;;) {
        const int u = next_item(P, ph);
        if (u >= 132 * 14) break;
        const int mt = u / 14, n14 = u % 14;
        f32x16 acc[2][2]; zero_acc(acc);
        bf16_t* O; int ldo, nt;
        if (n14 < 6) { nt = n14; O = (bf16_t*)(P.ws + OFF_QF); ldo = 768;
            gemm_tile_pf2(acc, PB + (size_t)mt * 128 * PW + C_CQ, PW, (const bf16_t*)(P.ws + OFF_WUQ) + (size_t)l * 768 * 256 + (size_t)nt * 128 * 256, 256, 256, smem); }
        else { nt = n14 - 6; O = (bf16_t*)(P.ws + OFF_KV); ldo = 1024;
            gemm_tile_pf2(acc, PB + (size_t)mt * 128 * PW + C_CKV, PW, (const bf16_t*)(P.ws + OFF_WUKV) + (size_t)l * 1024 * 128 + (size_t)nt * 128 * 128, 128, 128, smem); }
#pragma unroll
        for (int mi = 0; mi < 2; ++mi)
#pragma unroll
            for (int ni = 0; ni < 2; ++ni)
#pragma unroll
                for (int r = 0; r < 16; ++r) O[(size_t)(mt * 128 + ACC_ROW(mi, r)) * ldo + nt * 128 + ACC_COL(ni)] = f2bf(acc[mi][ni][r]);
    }
}

__device__ void phase_finalize(const Params& P, int ph, int l, unsigned char* smem) {
    const int tid = tid_opaque(), lane = tid & 63, wave = tid >> 6;
    bf16_t* PB = (bf16_t*)(P.ws + OFF_PB);
    bf16_t* QF = (bf16_t*)(P.ws + OFF_QF);
    const bf16_t* KV = (const bf16_t*)(P.ws + OFF_KV);
    bf16_t* KF = (bf16_t*)(P.ws + OFF_KF);
    bf16_t* VTM = (bf16_t*)(P.ws + OFF_VTM);
    bf16_t* VTN = (bf16_t*)(P.ws + OFF_VTN);
    float* rs = (float*)smem;
    const int hd = lane >> 3, j = lane & 7;
    const float invf = __powf(10000.f, -(float)j * 0.125f);
    for (;;) {
        const int u7 = next_item(P, ph);
        if (u7 >= (NTH / 32) * 11) break;
        const int u = u7 / 11, sub = u7 % 11;
        const int t0 = u * 32, bl = t0 / TB, p0 = t0 % TB;
        if (sub >= 1 && sub <= 4) {
        uint2 in_cq[2]; unsigned in_ckv[2]; bf16_t in_q[2][12], in_kv[2][8], in_kr[2][4]; uint4 in_nq[2], in_nk[2];
#pragma unroll
        for (int rr = 0; rr < 2; ++rr) {
            const int tl = (sub - 1) * 8 + wave * 2 + rr, t = t0 + tl;
            const bf16_t* prow = PB + (size_t)t * PW;
            in_cq[rr] = *(const uint2*)(prow + C_CQ + lane * 4);
            in_ckv[rr] = *(const unsigned*)(prow + C_CKV + lane * 2);
            const bf16_t* q = QF + (size_t)t * 768 + hd * 96;
            const bf16_t* kvr = KV + (size_t)t * 1024 + hd * 128;
#pragma unroll
            for (int m = 0; m < 12; ++m) in_q[rr][m] = q[j + 8 * m];
#pragma unroll
            for (int m = 0; m < 8; ++m) in_kv[rr][m] = kvr[j + 8 * m];
#pragma unroll
            for (int m = 0; m < 4; ++m) in_kr[rr][m] = prow[C_KR + j + 8 * m];
            in_nq[rr] = *(const uint4*)(prow + C_NQ + hd * 64 + j * 8);
            in_nk[rr] = *(const uint4*)(prow + C_NK + hd * 64 + j * 8);
        }
#pragma unroll
        for (int rr = 0; rr < 2; ++rr) {
            const int tl = (sub - 1) * 8 + wave * 2 + rr, t = t0 + tl, p = p0 + tl;
            bf16_t* prow = PB + (size_t)t * PW;
            float s1, s2;
            { const uint2 a = in_cq[rr]; const float f0 = lo16(a.x), f1 = hi16(a.x), f2 = lo16(a.y), f3 = hi16(a.y); s1 = f0 * f0 + f1 * f1 + f2 * f2 + f3 * f3;
              const unsigned b = in_ckv[rr]; const float g0 = lo16(b), g1 = hi16(b); s2 = g0 * g0 + g1 * g1; }
            s1 = wave_sum(s1); s2 = wave_sum(s2);
            const float rcq = rsqrtf(s1 * (1.f / 256.f) + EPS), rckv = rsqrtf(s2 * (1.f / 128.f) + EPS);
            {
                bf16_t* q = QF + (size_t)t * 768 + hd * 96;
                float v[12], ss = 0.f;
#pragma unroll
                for (int m = 0; m < 12; ++m) { v[m] = bf2f(in_q[rr][m]) * rcq; ss += v[m] * v[m]; }
                ss += __shfl_xor(ss, 1); ss += __shfl_xor(ss, 2); ss += __shfl_xor(ss, 4);
                const float rn = rsqrtf(ss * (1.f / 96.f) + EPS);
#pragma unroll
                for (int m = 0; m < 12; ++m) q[j + 8 * m] = f2bf(v[m] * rn * P.g_q[l * 96 + j + 8 * m] * (0.10206207261596575f * LOG2E));
            }
            {
                float v[12], ss = 0.f;
#pragma unroll
                for (int m = 0; m < 8; ++m) { v[m] = bf2f(in_kv[rr][m]) * rckv; ss += v[m] * v[m]; }
#pragma unroll
                for (int m = 8; m < 12; ++m) { v[m] = bf2f(in_kr[rr][m - 8]); ss += v[m] * v[m]; }
                ss += __shfl_xor(ss, 1); ss += __shfl_xor(ss, 2); ss += __shfl_xor(ss, 4);
                const float rn = rsqrtf(ss * (1.f / 96.f) + EPS);
#pragma unroll
                for (int m = 0; m < 12; ++m) v[m] = v[m] * rn * P.g_k[l * 96 + j + 8 * m];
                if (p >= CTXL) {
                    const int pos = p - CTXL;
                    const float ar = (float)(pos >> 6) * invf, ac = (float)(pos & 63) * invf;
                    double fr = (double)ar * 0.15915494309189535; fr -= rint(fr);
                    double fc = (double)ac * 0.15915494309189535; fc -= rint(fc);
                    const float sr = __builtin_amdgcn_sinf((float)fr), cr = __builtin_amdgcn_cosf((float)fr);
                    const float sc = __builtin_amdgcn_sinf((float)fc), cc = __builtin_amdgcn_cosf((float)fc);
                    const float x1a = v[8], x2a = v[10], x1b = v[9], x2b = v[11];
                    v[8] = x1a * cr - x2a * sr; v[10] = x1a * sr + x2a * cr;
                    v[9] = x1b * cc - x2b * sc; v[11] = x1b * sc + x2b * cc;
                }
                bf16_t* ko = KF + ((size_t)t * 8 + hd) * 96;
#pragma unroll
                for (int m = 0; m < 12; ++m) ko[j + 8 * m] = f2bf(v[m]);
            }
#pragma unroll
            for (int w = 0; w < 2; ++w) {
                bf16_t* q = prow + (w ? C_NK : C_NQ) + hd * 64 + j * 8;
                const float* g = (w ? P.ng_k : P.ng_q) + l * 64 + j * 8;
                float v[8], ss = 0.f;
                unpack8(w ? in_nk[rr] : in_nq[rr], v);
#pragma unroll
                for (int m = 0; m < 8; ++m) ss += v[m] * v[m];
                ss += __shfl_xor(ss, 1); ss += __shfl_xor(ss, 2); ss += __shfl_xor(ss, 4);
                const float rn = rsqrtf(ss * (1.f / 64.f) + EPS);
#pragma unroll
                for (int m = 0; m < 8; ++m) v[m] = v[m] * rn * g[m] * (w ? 1.f : 0.125f * LOG2E);
                *(uint4*)q = pack8(v);
            }
        }
        } else if (sub == 0) {
        {
            for (int rr = 0; rr < 8; ++rr) {
                const int tl = wave * 8 + rr;
                const unsigned bq = *(const unsigned*)(PB + (size_t)(t0 + tl) * PW + C_CKV + lane * 2);
                const float g0 = lo16(bq), g1 = hi16(bq);
                const float s2 = wave_sum(g0 * g0 + g1 * g1);
                if (lane == 0) rs[tl] = rsqrtf(s2 * (1.f / 128.f) + EPS);
            }
            __syncthreads();
            bf16_t* tile = (bf16_t*)(smem + 8192);
#pragma unroll
            for (int which = 0; which < 2; ++which) {
#pragma unroll
                for (int k8 = 0; k8 < 8; ++k8) {
                    const int id = tid + 256 * k8, i = id >> 6, c8 = id & 63;
                    const bf16_t* src = which ? PB + (size_t)(t0 + i) * PW + C_NV + c8 * 8
                                              : KV + (size_t)(t0 + i) * 1024 + (c8 >> 3) * 128 + 64 + (c8 & 7) * 8;
                    *(uint4*)(tile + i * 512 + c8 * 8) = *(const uint4*)src;
                }
                __syncthreads();
                bf16_t* VT = which ? VTN : VTM;
#pragma unroll
                for (int k8 = 0; k8 < 8; ++k8) {
                    const int id = tid + 256 * k8, r = id >> 2, g = id & 3;
                    float fv[8];
#pragma unroll
                    for (int i = 0; i < 8; ++i) fv[i] = bf2f(tile[(g * 8 + i) * 512 + r]) * (which ? 1.f : rs[g * 8 + i]);
                    *(uint4*)(VT + ((size_t)(bl * 8 + (r >> 6)) * 64 + (r & 63)) * TB + p0 + g * 8) = pack8(fv);
                }
                __syncthreads();
            }
        }
        } else
        {
            const int chunk = t0 >> 5;
            bf16_t* XH = (bf16_t*)(P.ws + OFF_XH);
            bf16_t* XG = (bf16_t*)(P.ws + OFF_XG);
            float* EBH = (float*)(P.ws + OFF_EBH);
            float* EBG = (float*)(P.ws + OFF_EBG);
            bf16_t* base = PB + (size_t)t0 * PW;
            float* rsh = (float*)smem + 256;
            bf16_t* inA = (bf16_t*)(smem + 8192);
            bf16_t* inB = inA + 32 * 128;
            bf16_t* inC = inB + 32 * 128;
            bf16_t* outT = inC + 32 * 128;
#pragma unroll
            for (int k4 = 0; k4 < 4; ++k4) { const int id = tid + 256 * k4, i = id >> 5, jx = id & 31; rsh[id] = bf2f(base[(size_t)i * PW + C_GR + jx]); }
            const int d = tid & 127, dr = tid >> 7;
            { const int grp = sub - 5;
                const bool isg = grp >= 4;
                const int gcol = isg ? (grp - 4) * 128 : grp * 128;
                const int cA = isg ? C_GQ + gcol : C_HQ + gcol, cB = isg ? C_GK + gcol : C_HF + gcol, cC = C_HF + 512 + gcol;
#pragma unroll
                for (int k2 = 0; k2 < 2; ++k2) {
                    const int id = tid + 256 * k2, i = id >> 4, ch = id & 15;
                    const bf16_t* row = base + (size_t)i * PW;
                    *(uint4*)(inA + i * 128 + ch * 8) = *(const uint4*)(row + cA + ch * 8);
                    *(uint4*)(inB + i * 128 + ch * 8) = *(const uint4*)(row + cB + ch * 8);
                    if (!isg) *(uint4*)(inC + i * 128 + ch * 8) = *(const uint4*)(row + cC + ch * 8);
                }
                __syncthreads();
                {
                    const int col = gcol + d;
                    float lb = 0.f, b2 = 0.f, w2[16];
#pragma unroll
                    for (int jx = 0; jx < 16; ++jx) w2[jx] = 0.f;
                    if (isg) {
#pragma unroll
                        for (int jx = 0; jx < 16; ++jx) w2[jx] = P.gla_w2[((size_t)(l * 2 + dr) * 16 + jx) * 256 + col];
                        b2 = P.gla_b2[(l * 2 + dr) * 256 + col];
                    } else if (l != 0) lb = sigmoidf_(P.lb_logits[1024 + dr * 512 + col] - P.lb_logits[dr * 512 + col]);
                    const bf16_t* fsrc = (dr && !isg) ? inC : inB;
                    bf16_t* oq = outT + (dr ? 2 : 0) * 32 * 128;
                    bf16_t* ok = oq + 32 * 128;
                    float cum = 0.f;
#pragma unroll 4
                    for (int sx = 0; sx < 32; ++sx) {
                        const int i = dr ? 31 - sx : sx;
                        const float qv = bf2f(inA[i * 128 + d]), fv = bf2f(fsrc[i * 128 + d]);
                        float qq, kk, la;
                        if (isg) {
                            float g = b2;
#pragma unroll
                            for (int jx = 0; jx < 16; ++jx) g = fmaf(rsh[i * 32 + dr * 16 + jx], w2[jx], g);
                            la = (fminf(g, 0.f) - __logf(1.f + __expf(-fabsf(g)))) * 0.0625f;
                            qq = qv * 0.125f; kk = fv;
                        } else {
                            const float av = lb + (1.f - lb) * sigmoidf_(fv);
                            la = __logf(av); kk = 1.f - av;
                            qq = siluf_(qv) * 0.08838834764831845f;
                        }
                        cum += la;
                        oq[i * 128 + d] = f2bf(qq * __expf(cum));
                        ok[i * 128 + d] = f2bf(kk * __expf(-cum));
                    }
                    if (isg) EBG[(size_t)(chunk * 2 + dr) * 256 + col] = __expf(cum);
                    else EBH[(size_t)(chunk * 2 + dr) * 512 + col] = __expf(cum);
                }
                __syncthreads();
#pragma unroll
                for (int k2 = 0; k2 < 2; ++k2) {
                    const int id = tid + 256 * k2, i = id >> 4, ch = id & 15;
                    bf16_t* row = base + (size_t)i * PW;
                    const uint4 v0 = *(const uint4*)(outT + (0 * 32 + i) * 128 + ch * 8), v1 = *(const uint4*)(outT + (1 * 32 + i) * 128 + ch * 8);
                    const uint4 v2 = *(const uint4*)(outT + (2 * 32 + i) * 128 + ch * 8), v3 = *(const uint4*)(outT + (3 * 32 + i) * 128 + ch * 8);
                    *(uint4*)(row + cA + ch * 8) = v0;
                    *(uint4*)(row + cB + ch * 8) = v1;
                    if (isg) { bf16_t* xr = XG + (size_t)(t0 + i) * 512 + gcol + ch * 8; *(uint4*)xr = v2; *(uint4*)(xr + 256) = v3; }
                    else { *(uint4*)(XH + (size_t)(t0 + i) * 512 + gcol + ch * 8) = v2; *(uint4*)(row + cC + ch * 8) = v3; }
                }
                __syncthreads();
            }
        }
    }
}

template <int DQK, bool NAT>
__device__ void attn_item(const Params& P, int l, int bl, int head, int qb, unsigned char* smem) {
    constexpr int NKS = DQK / 16, KSTR = DQK + 8, VSTR = 68, KCH = DQK / 8, KLD = (DQK * 64 / 8) / 256;
    const int tid = tid_opaque(), lane = tid & 63, wave = tid >> 6, hh = lane >> 5, r32 = lane & 31;
    bf16_t* Ks = (bf16_t*)smem;
    bf16_t* Vs = Ks + 2 * 64 * KSTR;
    float* rpb_s = (float*)(Vs + 2 * 64 * VSTR);
    bf16_t* PB = (bf16_t*)(P.ws + OFF_PB);
    const int rowbase = bl * TB, q_p0 = qb * 128, ql = wave * 32 + r32;
    const bool q_ctx = qb < 2;
    int lt0 = 0, lt1 = 0;
    int qr = 0, qc = 0, r0w = 0, c0 = 0;
    if (!q_ctx) {
        if (NAT) { const int rp = qb - 2, ra = 2 * rp, rb = ra + 1; lt0 = min(max(ra - 4, 0), 120); lt1 = min(max(rb - 4, 0), 120) + 8;
            qr = ra + (wave >> 1); qc = (wave & 1) * 32 + r32; r0w = min(max(qr - 4, 0), 120); c0 = min(max(qc - 8, 0), 48); }
        else { lt0 = 0; lt1 = 128; }
    }
    const int ntiles = 4 + (lt1 - lt0);
    const bf16_t* Kbase; const bf16_t* VT; const bf16_t* qptr; int k_ld;
    if (NAT) { Kbase = PB + (size_t)rowbase * PW + C_NK + head * 64; k_ld = PW; VT = (const bf16_t*)(P.ws + OFF_VTN) + (size_t)(bl * 8 + head) * 64 * TB;
        qptr = PB + (size_t)(rowbase + q_p0 + ql) * PW + C_NQ + head * 64; }
    else { Kbase = (const bf16_t*)(P.ws + OFF_KF) + (size_t)rowbase * 768 + head * 96; k_ld = 768; VT = (const bf16_t*)(P.ws + OFF_VTM) + (size_t)(bl * 8 + head) * 64 * TB;
        qptr = (const bf16_t*)(P.ws + OFF_QF) + (size_t)(rowbase + q_p0 + ql) * 768 + head * 96; }
    if (NAT) { for (int i = tid; i < 465; i += 256) rpb_s[i] = P.rpb[(size_t)(l * 8 + head) * 465 + i] * LOG2E; }
    bf16x8 qf[NKS];
#pragma unroll
    for (int ks = 0; ks < NKS; ++ks) qf[ks] = *(const bf16x8*)(qptr + ks * 16 + hh * 8);
    bf16x8 qrot4 = qf[NKS - 2], qrot5 = qf[NKS - 1];
    if (!NAT && !q_ctx) {
        const int pos = q_p0 - CTXL + ql;
        const float base = hh ? (float)(pos & 63) : (float)(pos >> 6);
#pragma unroll
        for (int jj = 0; jj < 8; ++jj) {
            const float invf = __powf(10000.f, -(float)jj * 0.125f);
            const float ang = base * invf;
            double fr = (double)ang * 0.15915494309189535; fr -= rint(fr);
            const float sn = __builtin_amdgcn_sinf((float)fr), cs = __builtin_amdgcn_cosf((float)fr);
            const float x1 = bf2f((bf16_t)qf[4][jj]), x2 = bf2f((bf16_t)qf[5][jj]);
            qrot4[jj] = (short)f2bf(x1 * cs - x2 * sn);
            qrot5[jj] = (short)f2bf(x1 * sn + x2 * cs);
        }
    }
    float m_run = -1e30f, lsum = 0.f;
    f32x16 oacc[2];
#pragma unroll
    for (int r = 0; r < 16; ++r) { oacc[0][r] = 0.f; oacc[1][r] = 0.f; }
    uint4 kreg0A, kreg1A, kreg2A, vreg0A, vreg1A, kreg0B, kreg1B, kreg2B, vreg0B, vreg1B;
    kreg2A = kreg2B = make_uint4(0, 0, 0, 0);
    const int kid0 = tid, kid1 = tid + 256, kid2 = tid + 512;
    const int krow0 = kid0 / KCH, kch0 = kid0 % KCH, krow1 = kid1 / KCH, kch1 = kid1 % KCH, krow2 = kid2 / KCH, kch2 = kid2 % KCH;
    const int vrow0 = tid >> 3, vch = tid & 7, vrow1 = vrow0 + 32;
#define TILE_P(ti) ((ti) < 4 ? (ti) * 64 : CTXL + (lt0 + (ti) - 4) * 64)
#define GLOAD(ti, S) { const int p_ = TILE_P(ti); \
        kreg0##S = *(const uint4*)(Kbase + (size_t)(p_ + krow0) * k_ld + kch0 * 8); \
        kreg1##S = *(const uint4*)(Kbase + (size_t)(p_ + krow1) * k_ld + kch1 * 8); \
        if (KLD > 2) kreg2##S = *(const uint4*)(Kbase + (size_t)(p_ + krow2) * k_ld + kch2 * 8); \
        vreg0##S = *(const uint4*)(VT + (size_t)vrow0 * TB + p_ + vch * 8); \
        vreg1##S = *(const uint4*)(VT + (size_t)vrow1 * TB + p_ + vch * 8); }
#define SWRITE(buf_, S) { bf16_t* kd_ = Ks + (buf_) * 64 * KSTR; \
        *(uint4*)(kd_ + krow0 * KSTR + kch0 * 8) = kreg0##S; *(uint4*)(kd_ + krow1 * KSTR + kch1 * 8) = kreg1##S; \
        if (KLD > 2) *(uint4*)(kd_ + krow2 * KSTR + kch2 * 8) = kreg2##S; \
        bf16_t* vd_ = Vs + (buf_) * 64 * VSTR + vch * 8; \
        *(uint2*)(vd_ + vrow0 * VSTR) = make_uint2(vreg0##S.x, vreg0##S.y); *(uint2*)(vd_ + vrow0 * VSTR + 4) = make_uint2(vreg0##S.z, vreg0##S.w); \
        *(uint2*)(vd_ + vrow1 * VSTR) = make_uint2(vreg1##S.x, vreg1##S.y); *(uint2*)(vd_ + vrow1 * VSTR + 4) = make_uint2(vreg1##S.z, vreg1##S.w); }
    GLOAD(0, A); SWRITE(0, A);
    { const int t1_ = 1 < ntiles ? 1 : ntiles - 1; GLOAD(t1_, B); }
    __syncthreads();
    for (int ti0 = 0; ti0 < ntiles; ti0 += 2) {
        { const int tl_ = ti0 + 2 < ntiles ? ti0 + 2 : ntiles - 1; GLOAD(tl_, A); asm volatile("" ::: "memory"); }
        { const int ti = ti0; const int buf = 0;
        if (!NAT && ti == 4) { qf[NKS - 2] = qrot4; qf[NKS - 1] = qrot5; }
        const int kr = lt0 + ti - 4;
        const bool active = !NAT || ti < 4 || (kr >= r0w && kr < r0w + 8);
        if (active) {
            const bf16_t* kb = Ks + buf * 64 * KSTR + r32 * KSTR + hh * 8;
            f32x16 st0, st1;
#pragma unroll
            for (int r = 0; r < 16; ++r) { st0[r] = 0.f; st1[r] = 0.f; }
            bf16x8 kf0[NKS], kf1[NKS];
#pragma unroll
            for (int ks = 0; ks < NKS; ++ks) { kf0[ks] = *(const bf16x8*)(kb + ks * 16); kf1[ks] = *(const bf16x8*)(kb + 32 * KSTR + ks * 16); }
            asm volatile("s_waitcnt lgkmcnt(0)" ::: "memory");
#pragma unroll
            for (int ks = 0; ks < NKS; ++ks) {
                st0 = __builtin_amdgcn_mfma_f32_32x32x16_bf16(kf0[ks], qf[ks], st0, 0, 0, 0);
                st1 = __builtin_amdgcn_mfma_f32_32x32x16_bf16(kf1[ks], qf[ks], st1, 0, 0, 0);
            }
            const bf16_t* vb = Vs + buf * 64 * VSTR + r32 * VSTR + 4 * hh;
            uint2 vfr[2][2][2][2];
#pragma unroll
            for (int uu = 0; uu < 2; ++uu)
#pragma unroll
                for (int t = 0; t < 2; ++t)
#pragma unroll
                    for (int s2 = 0; s2 < 2; ++s2) {
                        const bf16_t* a = vb + uu * 32 * VSTR + t * 32 + s2 * 16;
                        vfr[uu][t][s2][0] = *(const uint2*)a; vfr[uu][t][s2][1] = *(const uint2*)(a + 8);
                    }
            float x[32];
#pragma unroll
            for (int r = 0; r < 16; ++r) { x[r] = st0[r]; x[16 + r] = st1[r]; }
            if (NAT && ti >= 4) {
                const int dr = kr - qr + 7;
#pragma unroll
                for (int e = 0; e < 32; ++e) {
                    const int r = e & 15, kc = (e >> 4) * 32 + (r & 3) + 8 * (r >> 2) + 4 * hh;
                    const int dc = min(max(kc - qc, -15), 15) + 15;
                    const bool ok = (kc >= c0) && (kc < c0 + 16);
                    x[e] = ok ? x[e] + rpb_s[dr * 31 + dc] : -1e30f;
                }
            }
            float mx = x[0];
#pragma unroll
            for (int e = 1; e < 32; ++e) mx = fmaxf(mx, x[e]);
            mx = fmaxf(mx, __shfl_xor(mx, 32));
            const float m_new = fmaxf(m_run, mx);
            const bool resc = __ballot(m_new > m_run) != 0ull;
            const float alpha = __builtin_amdgcn_exp2f(m_run - m_new);
            m_run = m_new;
            float ps = 0.f;
#pragma unroll
            for (int e = 0; e < 32; ++e) { x[e] = __builtin_amdgcn_exp2f(x[e] - m_new); ps += x[e]; }
            lsum = lsum * alpha + ps;
            if (resc) {
#pragma unroll
                for (int r = 0; r < 16; ++r) { oacc[0][r] *= alpha; oacc[1][r] *= alpha; }
            }
            bf16x8 pf[2][2];
#pragma unroll
            for (int t = 0; t < 2; ++t)
#pragma unroll
                for (int s = 0; s < 2; ++s) {
                    union { bf16x8 v; unsigned u[4]; } cv;
#pragma unroll
                    for (int q = 0; q < 4; ++q) cv.u[q] = cvt_pk(x[16 * t + 8 * s + 2 * q], x[16 * t + 8 * s + 2 * q + 1]);
                    pf[t][s] = cv.v;
                }
#pragma unroll
            for (int uu = 0; uu < 2; ++uu)
#pragma unroll
                for (int t = 0; t < 2; ++t)
#pragma unroll
                    for (int s = 0; s < 2; ++s) {
                        union { bf16x8 v; uint2 h[2]; } cv;
                        cv.h[0] = vfr[uu][t][s][0]; cv.h[1] = vfr[uu][t][s][1];
                        oacc[uu] = __builtin_amdgcn_mfma_f32_32x32x16_bf16(cv.v, pf[t][s], oacc[uu], 0, 0, 0);
                    }
        }
        }
        SWRITE(1, B);
        __syncthreads();
        if (ti0 + 1 >= ntiles) break;
        { const int tl_ = ti0 + 3 < ntiles ? ti0 + 3 : ntiles - 1; GLOAD(tl_, B); asm volatile("" ::: "memory"); }
        { const int ti = ti0 + 1; const int buf = 1;
        if (!NAT && ti == 4) { qf[NKS - 2] = qrot4; qf[NKS - 1] = qrot5; }
        const int kr = lt0 + ti - 4;
        const bool active = !NAT || ti < 4 || (kr >= r0w && kr < r0w + 8);
        if (active) {
            const bf16_t* kb = Ks + buf * 64 * KSTR + r32 * KSTR + hh * 8;
            f32x16 st0, st1;
#pragma unroll
            for (int r = 0; r < 16; ++r) { st0[r] = 0.f; st1[r] = 0.f; }
            bf16x8 kf0[NKS], kf1[NKS];
#pragma unroll
            for (int ks = 0; ks < NKS; ++ks) { kf0[ks] = *(const bf16x8*)(kb + ks * 16); kf1[ks] = *(const bf16x8*)(kb + 32 * KSTR + ks * 16); }
            asm volatile("s_waitcnt lgkmcnt(0)" ::: "memory");
#pragma unroll
            for (int ks = 0; ks < NKS; ++ks) {
                st0 = __builtin_amdgcn_mfma_f32_32x32x16_bf16(kf0[ks], qf[ks], st0, 0, 0, 0);
                st1 = __builtin_amdgcn_mfma_f32_32x32x16_bf16(kf1[ks], qf[ks], st1, 0, 0, 0);
            }
            const bf16_t* vb = Vs + buf * 64 * VSTR + r32 * VSTR + 4 * hh;
            uint2 vfr[2][2][2][2];
#pragma unroll
            for (int uu = 0; uu < 2; ++uu)
#pragma unroll
                for (int t = 0; t < 2; ++t)
#pragma unroll
                    for (int s2 = 0; s2 < 2; ++s2) {
                        const bf16_t* a = vb + uu * 32 * VSTR + t * 32 + s2 * 16;
                        vfr[uu][t][s2][0] = *(const uint2*)a; vfr[uu][t][s2][1] = *(const uint2*)(a + 8);
                    }
            float x[32];
#pragma unroll
            for (int r = 0; r < 16; ++r) { x[r] = st0[r]; x[16 + r] = st1[r]; }
            if (NAT && ti >= 4) {
                const int dr = kr - qr + 7;
#pragma unroll
                for (int e = 0; e < 32; ++e) {
                    const int r = e & 15, kc = (e >> 4) * 32 + (r & 3) + 8 * (r >> 2) + 4 * hh;
                    const int dc = min(max(kc - qc, -15), 15) + 15;
                    const bool ok = (kc >= c0) && (kc < c0 + 16);
                    x[e] = ok ? x[e] + rpb_s[dr * 31 + dc] : -1e30f;
                }
            }
            float mx = x[0];
#pragma unroll
            for (int e = 1; e < 32; ++e) mx = fmaxf(mx, x[e]);
            mx = fmaxf(mx, __shfl_xor(mx, 32));
            const float m_new = fmaxf(m_run, mx);
            const bool resc = __ballot(m_new > m_run) != 0ull;
            const float alpha = __builtin_amdgcn_exp2f(m_run - m_new);
            m_run = m_new;
            float ps = 0.f;
#pragma unroll
            for (int e = 0; e < 32; ++e) { x[e] = __builtin_amdgcn_exp2f(x[e] - m_new); ps += x[e]; }
            lsum = lsum * alpha + ps;
            if (resc) {
#pragma unroll
                for (int r = 0; r < 16; ++r) { oacc[0][r] *= alpha; oacc[1][r] *= alpha; }
            }
            bf16x8 pf[2][2];
#pragma unroll
            for (int t = 0; t < 2; ++t)
#pragma unroll
                for (int s = 0; s < 2; ++s) {
                    union { bf16x8 v; unsigned u[4]; } cv;
#pragma unroll
                    for (int q = 0; q < 4; ++q) cv.u[q] = cvt_pk(x[16 * t + 8 * s + 2 * q], x[16 * t + 8 * s + 2 * q + 1]);
                    pf[t][s] = cv.v;
                }
#pragma unroll
            for (int uu = 0; uu < 2; ++uu)
#pragma unroll
                for (int t = 0; t < 2; ++t)
#pragma unroll
                    for (int s = 0; s < 2; ++s) {
                        union { bf16x8 v; uint2 h[2]; } cv;
                        cv.h[0] = vfr[uu][t][s][0]; cv.h[1] = vfr[uu][t][s][1];
                        oacc[uu] = __builtin_amdgcn_mfma_f32_32x32x16_bf16(cv.v, pf[t][s], oacc[uu], 0, 0, 0);
                    }
        }
        }
        SWRITE(0, A);
        __syncthreads();
    }
#undef TILE_P
#undef GLOAD
#undef SWRITE
    lsum += __shfl_xor(lsum, 32);
    const float inv = 1.f / lsum;
    bf16_t* zrow = PB + (size_t)(rowbase + q_p0 + ql) * PW + C_Z + (NAT ? 512 : 0) + head * 64;
#pragma unroll
    for (int uu = 0; uu < 2; ++uu)
#pragma unroll
        for (int g = 0; g < 4; ++g) {
            bf16_t* zp = zrow + uu * 32 + 8 * g + 4 * hh;
            const uint2 z = *(const uint2*)zp;
            uint2 o;
            o.x = cvt_pk(oacc[uu][4 * g + 0] * inv * siluf_(lo16(z.x)), oacc[uu][4 * g + 1] * inv * siluf_(hi16(z.x)));
            o.y = cvt_pk(oacc[uu][4 * g + 2] * inv * siluf_(lo16(z.y)), oacc[uu][4 * g + 3] * inv * siluf_(hi16(z.y)));
            *(uint2*)zp = o;
        }
}

__device__ void scan_hg_item(const Params& P, int l, int item, unsigned char* smem) {
    const int tid = tid_opaque(), lane = tid & 63, wave = tid >> 6;
    const int slice = item & 7, dir = (item >> 3) & 1, head = (item >> 4) & 3, bl = item >> 6;
    float* a_s = (float*)smem;
    float* q_s = a_s + 64 * 128;
    float* v_s = q_s + 64 * 128;
    float* o_s = v_s + 64 * 16;
    const bf16_t* PB = (const bf16_t*)(P.ws + OFF_PB) + (size_t)bl * TB * PW;
    bf16_t* OS = (bf16_t*)(P.ws + OFF_KV) + ((size_t)dir * NTH + (size_t)bl * TB) * 512 + head * 128 + slice * 16;
    const int prow = tid >> 4, pd = (tid & 15) * 8;
    float lb[8];
#pragma unroll
    for (int e = 0; e < 8; ++e) {
        const int cidx = dir * 512 + head * 128 + pd + e;
        lb[e] = (l == 0) ? 0.f : sigmoidf_(P.lb_logits[1024 + cidx] - P.lb_logits[cidx]);
    }
    const int fcol = (dir ? C_HF + 512 : C_HF) + head * 128 + pd, qcol = C_HQ + head * 128 + pd, vcol = C_HI + head * 128 + slice * 16 + (tid & 1) * 8;
    uint4 rq[4], rf[4], rv;
    auto chunk_p = [&](int c) { const int ci = dir ? (c < 4 ? 3 - c : 135 - c) : c; return ci * 64; };
    auto gload = [&](int c) {
        const int p = chunk_p(c);
#pragma unroll
        for (int r = 0; r < 4; ++r) { const bf16_t* row = PB + (size_t)(p + prow + 16 * r) * PW; rq[r] = *(const uint4*)(row + qcol); rf[r] = *(const uint4*)(row + fcol); }
        if (tid < 128) rv = *(const uint4*)(PB + (size_t)(p + (tid >> 1)) * PW + vcol);
    };
    const int dg = lane & 15, col = wave * 4 + (lane >> 4);
    float S[8];
#pragma unroll
    for (int e = 0; e < 8; ++e) S[e] = 0.f;
    gload(0);
    for (int c = 0; c < 132; ++c) {
        __syncthreads();
#pragma unroll
        for (int r = 0; r < 4; ++r) {
            float fq[8], ff[8];
            unpack8(rq[r], fq); unpack8(rf[r], ff);
            float* ad = a_s + (prow + 16 * r) * 128 + pd; float* qd = q_s + (prow + 16 * r) * 128 + pd;
#pragma unroll
            for (int e = 0; e < 8; ++e) { ad[e] = lb[e] + (1.f - lb[e]) * sigmoidf_(ff[e]); qd[e] = siluf_(fq[e]) * 0.08838834764831845f; }
        }
        if (tid < 128) { float fv[8]; unpack8(rv, fv); float* vd = v_s + (tid >> 1) * 16 + (tid & 1) * 8;
#pragma unroll
            for (int e = 0; e < 8; ++e) vd[e] = fv[e]; }
        __syncthreads();
        if (c + 1 < 132) gload(c + 1);
        for (int tt = 0; tt < 64; tt += 8) {
            float op[8];
#pragma unroll
            for (int u = 0; u < 8; ++u) {
                const int i = dir ? 63 - (tt + u) : tt + u;
                const float4 a0 = *(const float4*)(a_s + i * 128 + dg * 8), a1 = *(const float4*)(a_s + i * 128 + dg * 8 + 4);
                const float4 q0 = *(const float4*)(q_s + i * 128 + dg * 8), q1 = *(const float4*)(q_s + i * 128 + dg * 8 + 4);
                const float v = v_s[i * 16 + col];
                float o;
                S[0] = fmaf(a0.x, S[0] - v, v); o = q0.x * S[0];
                S[1] = fmaf(a0.y, S[1] - v, v); o = fmaf(q0.y, S[1], o);
                S[2] = fmaf(a0.z, S[2] - v, v); o = fmaf(q0.z, S[2], o);
                S[3] = fmaf(a0.w, S[3] - v, v); o = fmaf(q0.w, S[3], o);
                S[4] = fmaf(a1.x, S[4] - v, v); o = fmaf(q1.x, S[4], o);
                S[5] = fmaf(a1.y, S[5] - v, v); o = fmaf(q1.y, S[5], o);
                S[6] = fmaf(a1.z, S[6] - v, v); o = fmaf(q1.z, S[6], o);
                S[7] = fmaf(a1.w, S[7] - v, v); o = fmaf(q1.w, S[7], o);
                op[u] = o;
            }
            float r4[4], r2[2];
            const bool b8 = dg & 8, b4 = dg & 4, b2 = dg & 2;
#pragma unroll
            for (int k = 0; k < 4; ++k) { const float snd = b8 ? op[k] : op[k + 4], kp = b8 ? op[k + 4] : op[k]; r4[k] = kp + __shfl_xor(snd, 8); }
#pragma unroll
            for (int k = 0; k < 2; ++k) { const float snd = b4 ? r4[k] : r4[k + 2], kp = b4 ? r4[k + 2] : r4[k]; r2[k] = kp + __shfl_xor(snd, 4); }
            float r1; { const float snd = b2 ? r2[0] : r2[1], kp = b2 ? r2[1] : r2[0]; r1 = kp + __shfl_xor(snd, 2); }
            r1 += __shfl_xor(r1, 1);
            if ((dg & 1) == 0) { const int tok = tt + (b8 ? 4 : 0) + (b4 ? 2 : 0) + (b2 ? 1 : 0); const int i = dir ? 63 - tok : tok; o_s[i * 16 + col] = r1; }
        }
        __syncthreads();
        if (tid < 128) {
            const int p = chunk_p(c) + (tid >> 1);
            *(uint4*)(OS + (size_t)p * 512 + (tid & 1) * 8) = pack8(o_s + (tid >> 1) * 16 + (tid & 1) * 8);
        }
    }
}

__device__ void scan_gla_item(const Params& P, int l, int item, unsigned char* smem) {
    const int tid = tid_opaque(), lane = tid & 63, wave = tid >> 6;
    const int slice = item & 3, dir = (item >> 2) & 1, head = (item >> 3) & 3, bl = item >> 5;
    float* a_s = (float*)smem;
    float* q_s = a_s + 64 * 64;
    float* k_s = q_s + 64 * 64;
    float* v_s = k_s + 64 * 64;
    float* o_s = v_s + 64 * 32;
    float* r_s = o_s + 64 * 32;
    const bf16_t* PB = (const bf16_t*)(P.ws + OFF_PB) + (size_t)bl * TB * PW;
    bf16_t* OS = (bf16_t*)(P.ws + OFF_OSG) + ((size_t)dir * NTH + (size_t)bl * TB) * 512 + head * 128 + slice * 32;
    const int gd = tid & 63, gt0 = tid >> 6;
    float w2[16];
#pragma unroll
    for (int jx = 0; jx < 16; ++jx) w2[jx] = P.gla_w2[((size_t)(l * 2 + dir) * 16 + jx) * 256 + head * 64 + gd];
    const float b2 = P.gla_b2[(l * 2 + dir) * 256 + head * 64 + gd];
    uint4 rq[2], rk[2], rv, rr;
    auto chunk_p = [&](int c) { const int ci = dir ? (c < 4 ? 3 - c : 135 - c) : c; return ci * 64; };
    auto gload = [&](int c) {
        const int p = chunk_p(c);
#pragma unroll
        for (int i = 0; i < 2; ++i) { const int id = tid + 256 * i, row = id >> 3, ch = id & 7; const bf16_t* rp = PB + (size_t)(p + row) * PW;
            rq[i] = *(const uint4*)(rp + C_GQ + head * 64 + ch * 8); rk[i] = *(const uint4*)(rp + C_GK + head * 64 + ch * 8); }
        { const int row = tid >> 2, ch = tid & 3; rv = *(const uint4*)(PB + (size_t)(p + row) * PW + C_GV + head * 128 + slice * 32 + ch * 8); }
        if (tid < 128) { const int row = tid >> 1, ch = tid & 1; rr = *(const uint4*)(PB + (size_t)(p + row) * PW + C_GR + dir * 16 + ch * 8); }
    };
    const int dg = lane & 7, col = wave * 8 + (lane >> 3);
    float S[8];
#pragma unroll
    for (int e = 0; e < 8; ++e) S[e] = 0.f;
    gload(0);
    for (int c = 0; c < 132; ++c) {
        __syncthreads();
#pragma unroll
        for (int i = 0; i < 2; ++i) { const int id = tid + 256 * i, row = id >> 3, ch = id & 7; float fq[8], fk[8]; unpack8(rq[i], fq); unpack8(rk[i], fk);
#pragma unroll
            for (int e = 0; e < 8; ++e) { q_s[row * 64 + ch * 8 + e] = fq[e] * 0.125f; k_s[row * 64 + ch * 8 + e] = fk[e]; } }
        { const int row = tid >> 2, ch = tid & 3; float fv[8]; unpack8(rv, fv);
#pragma unroll
            for (int e = 0; e < 8; ++e) v_s[row * 32 + ch * 8 + e] = fv[e]; }
        if (tid < 128) { const int row = tid >> 1, ch = tid & 1; float fr[8]; unpack8(rr, fr);
#pragma unroll
            for (int e = 0; e < 8; ++e) r_s[row * 16 + ch * 8 + e] = fr[e]; }
        __syncthreads();
        if (c + 1 < 132) gload(c + 1);
#pragma unroll 4
        for (int m = 0; m < 16; ++m) {
            const int i = gt0 + 4 * m;
            float g = b2;
#pragma unroll
            for (int jx = 0; jx < 16; ++jx) g = fmaf(r_s[i * 16 + jx], w2[jx], g);
            const float ls = fminf(g, 0.f) - __logf(1.f + __expf(-fabsf(g)));
            a_s[i * 64 + gd] = __expf(ls * 0.0625f);
        }
        __syncthreads();
        for (int tt = 0; tt < 64; tt += 8) {
            float op[8];
#pragma unroll
            for (int u = 0; u < 8; ++u) {
                const int i = dir ? 63 - (tt + u) : tt + u;
                const float4 a0 = *(const float4*)(a_s + i * 64 + dg * 8), a1 = *(const float4*)(a_s + i * 64 + dg * 8 + 4);
                const float4 q0 = *(const float4*)(q_s + i * 64 + dg * 8), q1 = *(const float4*)(q_s + i * 64 + dg * 8 + 4);
                const float4 k0 = *(const float4*)(k_s + i * 64 + dg * 8), k1 = *(const float4*)(k_s + i * 64 + dg * 8 + 4);
                const float v = v_s[i * 32 + col];
                float o;
                S[0] = fmaf(a0.x, S[0], k0.x * v); o = q0.x * S[0];
                S[1] = fmaf(a0.y, S[1], k0.y * v); o = fmaf(q0.y, S[1], o);
                S[2] = fmaf(a0.z, S[2], k0.z * v); o = fmaf(q0.z, S[2], o);
                S[3] = fmaf(a0.w, S[3], k0.w * v); o = fmaf(q0.w, S[3], o);
                S[4] = fmaf(a1.x, S[4], k1.x * v); o = fmaf(q1.x, S[4], o);
                S[5] = fmaf(a1.y, S[5], k1.y * v); o = fmaf(q1.y, S[5], o);
                S[6] = fmaf(a1.z, S[6], k1.z * v); o = fmaf(q1.z, S[6], o);
                S[7] = fmaf(a1.w, S[7], k1.w * v); o = fmaf(q1.w, S[7], o);
                op[u] = o;
            }
            float r4[4], r2[2];
            const bool b4 = dg & 4, b2 = dg & 2, b1 = dg & 1;
#pragma unroll
            for (int k = 0; k < 4; ++k) { const float snd = b4 ? op[k] : op[k + 4], kp = b4 ? op[k + 4] : op[k]; r4[k] = kp + __shfl_xor(snd, 4); }
#pragma unroll
            for (int k = 0; k < 2; ++k) { const float snd = b2 ? r4[k] : r4[k + 2], kp = b2 ? r4[k + 2] : r4[k]; r2[k] = kp + __shfl_xor(snd, 2); }
            float r1; { const float snd = b1 ? r2[0] : r2[1], kp = b1 ? r2[1] : r2[0]; r1 = kp + __shfl_xor(snd, 1); }
            { const int tok = tt + (b4 ? 4 : 0) + (b2 ? 2 : 0) + (b1 ? 1 : 0); const int i = dir ? 63 - tok : tok; o_s[i * 32 + col] = r1; }
        }
        __syncthreads();
        { const int row = tid >> 2, ch = tid & 3; const int p = chunk_p(c) + row;
          *(uint4*)(OS + (size_t)p * 512 + ch * 8) = pack8(o_s + row * 32 + ch * 8); }
    }
}


template <bool GLA>
__device__ void scan2_item(const Params& P, int l, int item, unsigned char* smem) {
    constexpr int DK = GLA ? 64 : 128, NT = DK / 32, QS = DK + 8, TS = 40, NSEG = GLA ? 4 : 2, TPS = 32 / NSEG, QCH = DK / 8;
    const int tid = tid_opaque(), lane = tid & 63, wave = tid >> 6, r32 = lane & 31, hh = lane >> 5;
    const int dir = item & 1, head = (item >> 1) & 3, bl = item >> 3;
    bf16_t* Qh = (bf16_t*)smem;
    bf16_t* Kh = Qh + 32 * QS;
    bf16_t* Kt = Kh + 32 * QS;
    bf16_t* Vt = Kt + DK * TS;
    float* eb = (float*)(Vt + 128 * TS);
    float* tot = eb + DK;
    bf16_t* qraw = (bf16_t*)(tot + 4 * DK);
    bf16_t* fraw = qraw + 32 * DK;
    bf16_t* vraw = fraw + 32 * DK;
    bf16_t* rraw = vraw + 32 * 128;
    const bf16_t* PB = (const bf16_t*)(P.ws + OFF_PB) + (size_t)bl * TB * PW;
    bf16_t* OS = (bf16_t*)(P.ws + (GLA ? OFF_OSG : OFF_KV)) + ((size_t)dir * NTH + (size_t)bl * TB) * 512 + head * 128 + wave * 32;
    const int qcol = (GLA ? C_GQ : C_HQ) + head * DK, fcol = GLA ? (C_GK + head * 64) : ((dir ? C_HF + 512 : C_HF) + head * 128),
              vcol = (GLA ? C_GV : C_HI) + head * 128, rcol = C_GR + dir * 16;
    const int pd = tid & (DK - 1), seg = tid / DK;
    float lbv = 0.f, b2 = 0.f, w2[16];
#pragma unroll
    for (int jx = 0; jx < 16; ++jx) w2[jx] = 0.f;
    if (GLA) {
#pragma unroll
        for (int jx = 0; jx < 16; ++jx) w2[jx] = P.gla_w2[((size_t)(l * 2 + dir) * 16 + jx) * 256 + head * 64 + pd];
        b2 = P.gla_b2[(l * 2 + dir) * 256 + head * 64 + pd];
    } else if (l != 0) { const int cidx = dir * 512 + head * 128 + pd; lbv = sigmoidf_(P.lb_logits[1024 + cidx] - P.lb_logits[cidx]); }
    uint4 pq0, pq1, pf0, pf1, pv0, pv1, pr;
    pq1 = pf1 = pr = make_uint4(0, 0, 0, 0);
#define CH_P0(c) (dir ? ((c) < 8 ? (7 - (c)) * 32 : CTXL + (263 - (c)) * 32) : (c) * 32)
#define ROWP(p0_, i_) ((p0_) + (dir ? 31 - (i_) : (i_)))
#define SC_GLOAD(c) { const int p0_ = CH_P0(c); \
        { const int id = tid, i = id / QCH, ch = id % QCH; const bf16_t* rp = PB + (size_t)ROWP(p0_, i) * PW; pq0 = *(const uint4*)(rp + qcol + ch * 8); pf0 = *(const uint4*)(rp + fcol + ch * 8); } \
        if (!GLA) { const int id = tid + 256, i = id / QCH, ch = id % QCH; const bf16_t* rp = PB + (size_t)ROWP(p0_, i) * PW; pq1 = *(const uint4*)(rp + qcol + ch * 8); pf1 = *(const uint4*)(rp + fcol + ch * 8); } \
        { const int i = tid >> 4, ch = tid & 15; pv0 = *(const uint4*)(PB + (size_t)ROWP(p0_, i) * PW + vcol + ch * 8); pv1 = *(const uint4*)(PB + (size_t)ROWP(p0_, i + 16) * PW + vcol + ch * 8); } \
        if (GLA && tid < 64) { const int i = tid >> 1, ch = tid & 1; pr = *(const uint4*)(PB + (size_t)ROWP(p0_, i) * PW + rcol + ch * 8); } }
    f32x16 ST[NT];
#pragma unroll
    for (int T = 0; T < NT; ++T)
#pragma unroll
        for (int r = 0; r < 16; ++r) ST[T][r] = 0.f;
    SC_GLOAD(0);
    for (int c = 0; c < 264; ++c) {
        __syncthreads();
        { const int id = tid, i = id / QCH, ch = id % QCH; *(uint4*)(qraw + i * DK + ch * 8) = pq0; *(uint4*)(fraw + i * DK + ch * 8) = pf0; }
        if (!GLA) { const int id = tid + 256, i = id / QCH, ch = id % QCH; *(uint4*)(qraw + i * DK + ch * 8) = pq1; *(uint4*)(fraw + i * DK + ch * 8) = pf1; }
        { const int i = tid >> 4, ch = tid & 15; *(uint4*)(vraw + i * 128 + ch * 8) = pv0; *(uint4*)(vraw + (i + 16) * 128 + ch * 8) = pv1; }
        if (GLA && tid < 64) { const int i = tid >> 1, ch = tid & 1; *(uint4*)(rraw + i * 16 + ch * 8) = pr; }
        __syncthreads();
        if (c + 1 < 264) SC_GLOAD(c + 1);
        float bl_[TPS], kk[TPS], qq[TPS];
        float cum = 0.f;
#pragma unroll
        for (int tt = 0; tt < TPS; ++tt) {
            const int i = seg * TPS + tt;
            float la;
            if (GLA) {
                float g = b2;
#pragma unroll
                for (int jx = 0; jx < 16; ++jx) g = fmaf(bf2f(rraw[i * 16 + jx]), w2[jx], g);
                la = (fminf(g, 0.f) - __logf(1.f + __expf(-fabsf(g)))) * 0.0625f;
                kk[tt] = bf2f(fraw[i * DK + pd]);
                qq[tt] = bf2f(qraw[i * DK + pd]) * 0.125f;
            } else {
                const float f = bf2f(fraw[i * DK + pd]);
                const float a = lbv + (1.f - lbv) * sigmoidf_(f);
                la = __logf(a);
                kk[tt] = 1.f - a;
                qq[tt] = siluf_(bf2f(qraw[i * DK + pd])) * 0.08838834764831845f;
            }
            cum += la;
            bl_[tt] = cum;
        }
        tot[seg * DK + pd] = cum;
        __syncthreads();
        {
            float off = 0.f, bend = 0.f;
#pragma unroll
            for (int sg = 0; sg < NSEG; ++sg) { const float tv = tot[sg * DK + pd]; bend += tv; if (sg < seg) off += tv; }
            const float eend = __expf(bend);
            if (seg == 0) eb[pd] = eend;
            float kt[TPS];
#pragma unroll
            for (int tt = 0; tt < TPS; ++tt) {
                const int i = seg * TPS + tt;
                const float b = bl_[tt] + off;
                const float e1 = __expf(b), e2 = __expf(-b);
                const float kh = kk[tt] * e2;
                Qh[i * QS + pd] = f2bf(qq[tt] * e1);
                Kh[i * QS + pd] = f2bf(kh);
                kt[tt] = kh * eend;
            }
#pragma unroll
            for (int g8 = 0; g8 < TPS / 8; ++g8) *(uint4*)(Kt + pd * TS + seg * TPS + g8 * 8) = pack8(kt + g8 * 8);
            const int vc = tid & 127, vs = tid >> 7;
            float vv[16];
#pragma unroll
            for (int tt = 0; tt < 16; ++tt) vv[tt] = bf2f(vraw[(vs * 16 + tt) * 128 + vc]);
            *(uint4*)(Vt + vc * TS + vs * 16) = pack8(vv);
            *(uint4*)(Vt + vc * TS + vs * 16 + 8) = pack8(vv + 8);
        }
        __syncthreads();
        f32x16 st;
#pragma unroll
        for (int r = 0; r < 16; ++r) st[r] = 0.f;
#pragma unroll
        for (int ks = 0; ks < DK / 16; ++ks) {
            const bf16x8 ka = *(const bf16x8*)(Kh + r32 * QS + ks * 16 + hh * 8);
            const bf16x8 qb = *(const bf16x8*)(Qh + r32 * QS + ks * 16 + hh * 8);
            st = __builtin_amdgcn_mfma_f32_32x32x16_bf16(ka, qb, st, 0, 0, 0);
        }
        bf16x8 pfr[2];
#pragma unroll
        for (int sI = 0; sI < 2; ++sI) {
            union { bf16x8 v; unsigned u[4]; } cv;
#pragma unroll
            for (int q = 0; q < 4; ++q) {
                const int ra = 8 * sI + 2 * q, rb = ra + 1;
                const int ja = (ra & 3) + 8 * (ra >> 2) + 4 * hh, jb = (rb & 3) + 8 * (rb >> 2) + 4 * hh;
                cv.u[q] = cvt_pk(ja <= r32 ? st[ra] : 0.f, jb <= r32 ? st[rb] : 0.f);
            }
            pfr[sI] = cv.v;
        }
        f32x16 oT;
#pragma unroll
        for (int r = 0; r < 16; ++r) oT[r] = 0.f;
#pragma unroll
        for (int sI = 0; sI < 2; ++sI) {
            const bf16_t* a = Vt + (wave * 32 + r32) * TS + sI * 16 + 4 * hh;
            union { bf16x8 v; uint2 h[2]; } cv;
            cv.h[0] = *(const uint2*)a; cv.h[1] = *(const uint2*)(a + 8);
            oT = __builtin_amdgcn_mfma_f32_32x32x16_bf16(cv.v, pfr[sI], oT, 0, 0, 0);
        }
#pragma unroll
        for (int T = 0; T < NT; ++T)
#pragma unroll
            for (int sI = 0; sI < 2; ++sI) {
                union { bf16x8 v; unsigned u[4]; } ca;
#pragma unroll
                for (int q = 0; q < 4; ++q) ca.u[q] = cvt_pk(ST[T][8 * sI + 2 * q], ST[T][8 * sI + 2 * q + 1]);
                const bf16_t* b = Qh + r32 * QS + T * 32 + sI * 16 + 4 * hh;
                union { bf16x8 v; uint2 h[2]; } cb;
                cb.h[0] = *(const uint2*)b; cb.h[1] = *(const uint2*)(b + 8);
                oT = __builtin_amdgcn_mfma_f32_32x32x16_bf16(ca.v, cb.v, oT, 0, 0, 0);
            }
#pragma unroll
        for (int T = 0; T < NT; ++T) {
#pragma unroll
            for (int g = 0; g < 4; ++g) {
                const float4 e4 = *(const float4*)(eb + T * 32 + 8 * g + 4 * hh);
                ST[T][4 * g + 0] *= e4.x; ST[T][4 * g + 1] *= e4.y; ST[T][4 * g + 2] *= e4.z; ST[T][4 * g + 3] *= e4.w;
            }
#pragma unroll
            for (int ks = 0; ks < 2; ++ks) {
                const bf16x8 ka = *(const bf16x8*)(Kt + (T * 32 + r32) * TS + ks * 16 + hh * 8);
                const bf16x8 vb = *(const bf16x8*)(Vt + (wave * 32 + r32) * TS + ks * 16 + hh * 8);
                ST[T] = __builtin_amdgcn_mfma_f32_32x32x16_bf16(ka, vb, ST[T], 0, 0, 0);
            }
        }
        {
            const int p = ROWP(CH_P0(c), r32);
            bf16_t* op = OS + (size_t)p * 512 + 4 * hh;
#pragma unroll
            for (int g = 0; g < 4; ++g) { uint2 o; o.x = cvt_pk(oT[4 * g], oT[4 * g + 1]); o.y = cvt_pk(oT[4 * g + 2], oT[4 * g + 3]); *(uint2*)(op + 8 * g) = o; }
        }
    }
#undef CH_P0
#undef ROWP
#undef SC_GLOAD
}


template <bool GLA>
__device__ __forceinline__ void scan3_rest(f32x16 (&ST)[GLA ? 2 : 4], bf16_t* Qh, bf16_t* Kh, bf16_t* Kt, bf16_t* Vt, float* eb, bf16_t* vraw, bf16_t* OS,
                                           int tid, int wave, int r32, int hh, int pd, int seg, int c, int dir) {
    constexpr int DK = GLA ? 64 : 128, NT = DK / 32, QS = DK + 8, TS = 40, NSEG = GLA ? 4 : 2, TPS = 32 / NSEG;
#define CH_P0(c) (dir ? ((c) < 8 ? (7 - (c)) * 32 : CTXL + (263 - (c)) * 32) : (c) * 32)
#define ROWP(p0_, i_) ((p0_) + (dir ? 31 - (i_) : (i_)))
        {
            const float eend = eb[pd];
            float kt[TPS];
#pragma unroll
            for (int tt = 0; tt < TPS; ++tt) kt[tt] = bf2f(Kh[(seg * TPS + tt) * QS + pd]) * eend;
#pragma unroll
            for (int g8 = 0; g8 < TPS / 8; ++g8) *(uint4*)(Kt + pd * TS + seg * TPS + g8 * 8) = pack8(kt + g8 * 8);
            const int vc = tid & 127, vs = tid >> 7;
            float vv[16];
#pragma unroll
            for (int tt = 0; tt < 16; ++tt) vv[tt] = bf2f(vraw[(vs * 16 + tt) * 128 + vc]);
            *(uint4*)(Vt + vc * TS + vs * 16) = pack8(vv);
            *(uint4*)(Vt + vc * TS + vs * 16 + 8) = pack8(vv + 8);
        }
        __syncthreads();
        f32x16 st, stb;
#pragma unroll
        for (int r = 0; r < 16; ++r) { st[r] = 0.f; stb[r] = 0.f; }
        {
            bf16x8 ka[DK / 16], qb[DK / 16];
#pragma unroll
            for (int ks = 0; ks < DK / 16; ++ks) { ka[ks] = *(const bf16x8*)(Kh + r32 * QS + ks * 16 + hh * 8); qb[ks] = *(const bf16x8*)(Qh + r32 * QS + ks * 16 + hh * 8); }
            asm volatile("s_waitcnt lgkmcnt(0)" ::: "memory");
#pragma unroll
            for (int ks = 0; ks < DK / 16; ks += 2) {
                st = __builtin_amdgcn_mfma_f32_32x32x16_bf16(ka[ks], qb[ks], st, 0, 0, 0);
                stb = __builtin_amdgcn_mfma_f32_32x32x16_bf16(ka[ks + 1], qb[ks + 1], stb, 0, 0, 0);
            }
        }
        uint2 vp[2][2], qp[NT][2][2];
#pragma unroll
        for (int sI = 0; sI < 2; ++sI) { const bf16_t* av = Vt + (wave * 32 + r32) * TS + sI * 16 + 4 * hh; vp[sI][0] = *(const uint2*)av; vp[sI][1] = *(const uint2*)(av + 8); }
#pragma unroll
        for (int T = 0; T < NT; ++T)
#pragma unroll
            for (int sI = 0; sI < 2; ++sI) { const bf16_t* bq = Qh + r32 * QS + T * 32 + sI * 16 + 4 * hh; qp[T][sI][0] = *(const uint2*)bq; qp[T][sI][1] = *(const uint2*)(bq + 8); }
#pragma unroll
        for (int r = 0; r < 16; ++r) st[r] += stb[r];
        bf16x8 pfr[2];
#pragma unroll
        for (int sI = 0; sI < 2; ++sI) {
            union { bf16x8 v; unsigned u[4]; } cv;
#pragma unroll
            for (int q = 0; q < 4; ++q) {
                const int ra = 8 * sI + 2 * q, rb = ra + 1;
                const int ja = (ra & 3) + 8 * (ra >> 2) + 4 * hh, jb = (rb & 3) + 8 * (rb >> 2) + 4 * hh;
                cv.u[q] = cvt_pk(ja <= r32 ? st[ra] : 0.f, jb <= r32 ? st[rb] : 0.f);
            }
            pfr[sI] = cv.v;
        }
        asm volatile("s_waitcnt lgkmcnt(0)" ::: "memory");
        f32x16 oT, oTb;
#pragma unroll
        for (int r = 0; r < 16; ++r) { oT[r] = 0.f; oTb[r] = 0.f; }
#pragma unroll
        for (int sI = 0; sI < 2; ++sI) {
            union { bf16x8 v; uint2 h[2]; } cv;
            cv.h[0] = vp[sI][0]; cv.h[1] = vp[sI][1];
            oT = __builtin_amdgcn_mfma_f32_32x32x16_bf16(cv.v, pfr[sI], oT, 0, 0, 0);
        }
#pragma unroll
        for (int T = 0; T < NT; ++T)
#pragma unroll
            for (int sI = 0; sI < 2; ++sI) {
                union { bf16x8 v; unsigned u[4]; } ca;
#pragma unroll
                for (int q = 0; q < 4; ++q) ca.u[q] = cvt_pk(ST[T][8 * sI + 2 * q], ST[T][8 * sI + 2 * q + 1]);
                union { bf16x8 v; uint2 h[2]; } cb;
                cb.h[0] = qp[T][sI][0]; cb.h[1] = qp[T][sI][1];
                if (T & 1) oTb = __builtin_amdgcn_mfma_f32_32x32x16_bf16(ca.v, cb.v, oTb, 0, 0, 0);
                else oT = __builtin_amdgcn_mfma_f32_32x32x16_bf16(ca.v, cb.v, oT, 0, 0, 0);
            }
        {
            bf16x8 kt2[NT][2], vb2[2];
            float4 e4v[NT][4];
#pragma unroll
            for (int ks = 0; ks < 2; ++ks) vb2[ks] = *(const bf16x8*)(Vt + (wave * 32 + r32) * TS + ks * 16 + hh * 8);
#pragma unroll
            for (int T = 0; T < NT; ++T) {
#pragma unroll
                for (int ks = 0; ks < 2; ++ks) kt2[T][ks] = *(const bf16x8*)(Kt + (T * 32 + r32) * TS + ks * 16 + hh * 8);
#pragma unroll
                for (int g = 0; g < 4; ++g) e4v[T][g] = *(const float4*)(eb + T * 32 + 8 * g + 4 * hh);
            }
            asm volatile("s_waitcnt lgkmcnt(0)" ::: "memory");
#pragma unroll
            for (int T = 0; T < NT; ++T) {
#pragma unroll
                for (int g = 0; g < 4; ++g) { ST[T][4 * g + 0] *= e4v[T][g].x; ST[T][4 * g + 1] *= e4v[T][g].y; ST[T][4 * g + 2] *= e4v[T][g].z; ST[T][4 * g + 3] *= e4v[T][g].w; }
#pragma unroll
                for (int ks = 0; ks < 2; ++ks) ST[T] = __builtin_amdgcn_mfma_f32_32x32x16_bf16(kt2[T][ks], vb2[ks], ST[T], 0, 0, 0);
            }
        }
#pragma unroll
        for (int r = 0; r < 16; ++r) oT[r] += oTb[r];
        {
            const int p = ROWP(CH_P0(c), r32);
            bf16_t* op = OS + (size_t)p * 512 + 4 * hh;
#pragma unroll
            for (int g = 0; g < 4; ++g) { uint2 o; o.x = cvt_pk(oT[4 * g], oT[4 * g + 1]); o.y = cvt_pk(oT[4 * g + 2], oT[4 * g + 3]); *(uint2*)(op + 8 * g) = o; }
        }
#undef CH_P0
#undef ROWP
}

template <bool GLA>
__device__ void scan3_item(const Params& P, int l, int item, unsigned char* smem) {
    constexpr int DK = GLA ? 64 : 128, NT = DK / 32, QS = DK + 8, TS = 40, NSEG = GLA ? 4 : 2, TPS = 32 / NSEG, QCH = DK / 8;
    const int tid = tid_opaque(), lane = tid & 63, wave = tid >> 6, r32 = lane & 31, hh = lane >> 5;
    const int dir = item & 1, head = (item >> 1) & 3, bl = item >> 3;
    __builtin_amdgcn_s_setprio(3);
    bf16_t* Qh = (bf16_t*)smem;
    bf16_t* Kh = Qh + 32 * QS;
    bf16_t* Kt = Kh + 32 * QS;
    bf16_t* Vt = Kt + DK * TS;
    float* eb = (float*)(Vt + 128 * TS);
    bf16_t* vraw = (bf16_t*)(eb + DK);
    const bf16_t* PB = (const bf16_t*)(P.ws + OFF_PB) + (size_t)bl * TB * PW;
    bf16_t* OS = (bf16_t*)(P.ws + (GLA ? OFF_OSG : OFF_KV)) + ((size_t)dir * NTH + (size_t)bl * TB) * 512 + head * 128 + wave * 32;
    const bf16_t* qsrc; const bf16_t* ksrc; int qld, kld;
    if (GLA) {
        if (dir == 0) { qsrc = PB + C_GQ + head * 64; qld = PW; ksrc = PB + C_GK + head * 64; kld = PW; }
        else { const bf16_t* X = (const bf16_t*)(P.ws + OFF_XG) + (size_t)bl * TB * 512; qsrc = X + head * 64; qld = 512; ksrc = X + 256 + head * 64; kld = 512; }
    } else {
        if (dir == 0) { qsrc = PB + C_HQ + head * 128; qld = PW; ksrc = PB + C_HF + head * 128; kld = PW; }
        else { qsrc = (const bf16_t*)(P.ws + OFF_XH) + (size_t)bl * TB * 512 + head * 128; qld = 512; ksrc = PB + C_HF + 512 + head * 128; kld = PW; }
    }
    const float* ebsrc = (const float*)(P.ws + (GLA ? OFF_EBG : OFF_EBH)) + ((size_t)(bl * 264) * 2 + dir) * (4 * DK) + head * DK;
    const int vcol = (GLA ? C_GV : C_HI) + head * 128;
    const int pd = tid & (DK - 1), seg = tid / DK;
    uint4 pq0A, pq1A, pk0A, pk1A, pv0A, pv1A, pq0B, pq1B, pk0B, pk1B, pv0B, pv1B; float peA = 0.f, peB = 0.f;
    pq1A = pk1A = pq1B = pk1B = make_uint4(0, 0, 0, 0);
#define CH_P0(c) (dir ? ((c) < 8 ? (7 - (c)) * 32 : CTXL + (263 - (c)) * 32) : (c) * 32)
#define ROWP(p0_, i_) ((p0_) + (dir ? 31 - (i_) : (i_)))
#define SC_GLOAD(c, S) { const int p0_ = CH_P0(c); \
        { const int id = tid, i = id / QCH, ch = id % QCH; const size_t rr_ = (size_t)ROWP(p0_, i); pq0##S = *(const uint4*)(qsrc + rr_ * qld + ch * 8); pk0##S = *(const uint4*)(ksrc + rr_ * kld + ch * 8); } \
        if (!GLA) { const int id = tid + 256, i = id / QCH, ch = id % QCH; const size_t rr_ = (size_t)ROWP(p0_, i); pq1##S = *(const uint4*)(qsrc + rr_ * qld + ch * 8); pk1##S = *(const uint4*)(ksrc + rr_ * kld + ch * 8); } \
        { const int i = tid >> 4, ch = tid & 15; pv0##S = *(const uint4*)(PB + (size_t)ROWP(p0_, i) * PW + vcol + ch * 8); pv1##S = *(const uint4*)(PB + (size_t)ROWP(p0_, i + 16) * PW + vcol + ch * 8); } \
        if (tid < DK) pe##S = ebsrc[(size_t)(p0_ >> 5) * 2 * (4 * DK) + tid]; }
    f32x16 ST[NT];
#pragma unroll
    for (int T = 0; T < NT; ++T)
#pragma unroll
        for (int r = 0; r < 16; ++r) ST[T][r] = 0.f;
#define SC_COPY(S) { \
        { const int id = tid, i = id / QCH, ch = id % QCH; *(uint4*)(Qh + i * QS + ch * 8) = pq0##S; *(uint4*)(Kh + i * QS + ch * 8) = pk0##S; } \
        if (!GLA) { const int id = tid + 256, i = id / QCH, ch = id % QCH; *(uint4*)(Qh + i * QS + ch * 8) = pq1##S; *(uint4*)(Kh + i * QS + ch * 8) = pk1##S; } \
        { const int i = tid >> 4, ch = tid & 15; *(uint4*)(vraw + i * 128 + ch * 8) = pv0##S; *(uint4*)(vraw + (i + 16) * 128 + ch * 8) = pv1##S; } \
        if (tid < DK) eb[tid] = pe##S; }
    SC_GLOAD(0, A);
    SC_GLOAD(1, B);
    for (int c = 0; c < 264; c += 2) {
        __syncthreads();
        SC_COPY(A);
        __syncthreads();
        { const int cl_ = c + 2 < 264 ? c + 2 : 263; SC_GLOAD(cl_, A); asm volatile("" ::: "memory"); }
        scan3_rest<GLA>(ST, Qh, Kh, Kt, Vt, eb, vraw, OS, tid, wave, r32, hh, pd, seg, c, dir);
        __syncthreads();
        SC_COPY(B);
        __syncthreads();
        { const int cl_ = c + 3 < 264 ? c + 3 : 263; SC_GLOAD(cl_, B); asm volatile("" ::: "memory"); }
        scan3_rest<GLA>(ST, Qh, Kh, Kt, Vt, eb, vraw, OS, tid, wave, r32, hh, pd, seg, c + 1, dir);
    }
#undef SC_COPY
#undef CH_P0
#undef ROWP
#undef SC_GLOAD
    __builtin_amdgcn_s_setprio(0);
}

#ifdef ONLYI
#define IT_ON(n) (ONLYI == (n))
#else
#define IT_ON(n) true
#endif
__device__ void phase_mixers(const Params& P, int ph, int l, unsigned char* smem, int mode = 0) {
    constexpr int N_HG = 16, N_GLA = 16, N_ATT = 2 * 8 * 66;
    const int bx = blockIdx.x;
    int my_scan = -1;
    if (mode != 2 && bx < 256 && (bx & 7) == ((bx >> 3) & 7)) my_scan = bx >> 3;
    if (mode == 0 && bx >= 256 && ((bx - 256) & 7) == (((bx - 256) >> 3) & 7)) return;
    for (;;) {
        int it;
        if (my_scan >= 0) { it = my_scan; my_scan = -1; }
        else {
            if (mode == 1) break;
            it = next_item(P, ph) + N_HG + N_GLA;
        }
        if (it >= N_HG + N_GLA + 2 * N_ATT) break;
        if (it < N_HG) { if (IT_ON(0)) scan3_item<false>(P, l, it, smem); continue; }
        it -= N_HG;
        if (it < N_GLA) { if (IT_ON(1)) scan3_item<true>(P, l, it, smem); continue; }
        it -= N_GLA;
        if (it < N_ATT) { const int bl = it / 528, rem = it % 528; if (IT_ON(2)) attn_item<96, false>(P, l, bl, rem / 66, rem % 66, smem); continue; }
        it -= N_ATT;
        { const int bl = it / 528, rem = it % 528; if (IT_ON(3)) attn_item<64, true>(P, l, bl, rem / 66, rem % 66, smem); }
    }
}

__device__ void phase_scanfin(const Params& P, int ph, int l) {
    const int tid = tid_opaque(), lane = tid & 63, wave = tid >> 6;
    bf16_t* PB = (bf16_t*)(P.ws + OFF_PB);
    const bf16_t* OSH = (const bf16_t*)(P.ws + OFF_KV);
    const bf16_t* OSGp = (const bf16_t*)(P.ws + OFF_OSG);
    float gh[8], gg[8];
#pragma unroll
    for (int e = 0; e < 8; ++e) { gh[e] = P.hg_g_o[l * 128 + (lane & 15) * 8 + e]; gg[e] = P.gla_g_o[l * 128 + (lane & 15) * 8 + e]; }
    for (;;) {
        const int u = next_item(P, ph);
        if (u >= NTH / 16) break;
        uint4 ra[8], rb[8], rz[8];
#pragma unroll
        for (int k = 0; k < 8; ++k) {
            const int t = u * 16 + wave * 4 + (k >> 1), mx = k & 1;
            const bf16_t* OS = mx ? OSGp : OSH;
            ra[k] = *(const uint4*)(OS + (size_t)t * 512 + lane * 8);
            rb[k] = *(const uint4*)(OS + ((size_t)NTH + t) * 512 + lane * 8);
            rz[k] = *(const uint4*)(PB + (size_t)t * PW + C_Z + (2 + mx) * 512 + lane * 8);
        }
#pragma unroll
        for (int k = 0; k < 8; ++k) {
            const int t = u * 16 + wave * 4 + (k >> 1), mx = k & 1;
            float a[8], b[8], z[8];
            unpack8(ra[k], a); unpack8(rb[k], b); unpack8(rz[k], z);
            float ss = 0.f;
#pragma unroll
            for (int e = 0; e < 8; ++e) { a[e] += b[e]; ss += a[e] * a[e]; }
            ss += __shfl_xor(ss, 1); ss += __shfl_xor(ss, 2); ss += __shfl_xor(ss, 4); ss += __shfl_xor(ss, 8);
            const float rn = rsqrtf(ss * (1.f / 128.f) + EPS);
#pragma unroll
            for (int e = 0; e < 8; ++e) a[e] = a[e] * rn * (mx ? gg[e] : gh[e]) * siluf_(z[e]);
            *(uint4*)(PB + (size_t)t * PW + C_Z + (2 + mx) * 512 + lane * 8) = pack8(a);
        }
    }
}

__device__ void phase_merge(const Params& P, int ph, int l, unsigned char* smem) {
    const int tid_ = tid_opaque(), lane = tid_ & 63, wave = tid_ >> 6, wr = wave >> 1, wc = wave & 1;
    const bf16_t* H = (const bf16_t*)(P.ws + OFF_H);
    const bf16_t* PB = (const bf16_t*)(P.ws + OFF_PB);
    bf16_t* ACC = (bf16_t*)(P.ws + OFF_KV);
    for (;;) {
        const int u = next_item(P, ph);
        if (u >= 132 * 16) break;
        const int mt = u >> 4, nt = u & 15;
        const int col = nt * 64 + wc * 32 + (lane & 31);
        f32x16 tot[2];
#pragma unroll
        for (int r = 0; r < 16; ++r) { tot[0][r] = 0.f; tot[1][r] = 0.f; }
        for (int br = 0; br < 4; ++br) {
            unsigned gate[2][8];
            f32x16 g[2], pa[2];
#pragma unroll
            for (int r = 0; r < 16; ++r) { g[0][r] = 0.f; g[1][r] = 0.f; pa[0][r] = 0.f; pa[1][r] = 0.f; }
            gemm_pair_n64(g, pa, H + (size_t)mt * 128 * D, D, (const bf16_t*)(P.ws + OFF_WM) + ((size_t)(l * 4 + br) * 1024 + nt * 64) * 1024, 1024, 1024,
                          PB + (size_t)mt * 128 * PW + C_Z + br * 512, PW, (const bf16_t*)(P.ws + OFF_WBR) + ((size_t)(l * 4 + br) * 1024 + nt * 64) * 512, 512, 512, smem);
            {
                const float bm = P.b_merge[(l * 4 + br) * 1024 + col];
#pragma unroll
                for (int mi = 0; mi < 2; ++mi)
#pragma unroll
                    for (int r = 0; r < 8; ++r) gate[mi][r] = cvt_pk(__builtin_amdgcn_rcpf(1.f + __expf(-(g[mi][2 * r] + bm))), __builtin_amdgcn_rcpf(1.f + __expf(-(g[mi][2 * r + 1] + bm))));
            }
#pragma unroll
            for (int mi = 0; mi < 2; ++mi)
#pragma unroll
                for (int r = 0; r < 8; ++r) {
                    tot[mi][2 * r] = fmaf(lo16(gate[mi][r]), pa[mi][2 * r], tot[mi][2 * r]);
                    tot[mi][2 * r + 1] = fmaf(hi16(gate[mi][r]), pa[mi][2 * r + 1], tot[mi][2 * r + 1]);
                }
        }
#pragma unroll
        for (int mi = 0; mi < 2; ++mi)
#pragma unroll
            for (int r = 0; r < 16; ++r) ACC[(size_t)(mt * 128 + ACC_ROW(mi, r)) * 1024 + col] = f2bf(tot[mi][r]);
    }
}

__device__ void phase_out(const Params& P, int ph, int l, int hf, unsigned char* smem) {
    const int tid_ = tid_opaque(), lane = tid_ & 63, wave = tid_ >> 6, wr = wave >> 1, wc = wave & 1;
    const bf16_t* ACC = (const bf16_t*)(P.ws + OFF_KV);
    const float* mod = (const float*)(P.ws + OFF_MOD);
    for (;;) {
        const int u = next_item(P, ph);
        if (u >= 132 * 8) break;
        const int mt = u >> 3, nt = u & 7;
        const int t0 = mt * 128, bl = t0 / TB, p0 = t0 % TB, b = hf * 2 + bl;
        const bool isctx = p0 < CTXL;
        if (isctx && l == 1) continue;
        f32x16 acc[2][2]; zero_acc(acc);
        gemm_tile_pf2(acc, ACC + (size_t)mt * 128 * 1024, 1024, (const bf16_t*)(P.ws + OFF_WO) + ((size_t)l * 1024 + nt * 128) * 1024, 1024, 1024, smem);
        const float* gt = mod + (l * 5 + (isctx ? 4 : b)) * 3072 + 2048 + nt * 128;
        const float* src; float* dst;
        if (isctx) { src = P.ctx + ((size_t)b * CTXL + p0) * D; dst = (float*)(P.ws + OFF_CX1) + ((size_t)b * CTXL + p0) * D; }
        else { const size_t o = ((size_t)b * SEQ + (p0 - CTXL)) * D; src = (l == 0 ? P.x : (const float*)P.out) + o; dst = P.out + o; }
        float rv[2][2][16];
#pragma unroll
        for (int mi = 0; mi < 2; ++mi)
#pragma unroll
            for (int ni = 0; ni < 2; ++ni)
#pragma unroll
                for (int r = 0; r < 16; ++r) rv[mi][ni][r] = src[(size_t)ACC_ROW(mi, r) * D + nt * 128 + ACC_COL(ni)];
#pragma unroll
        for (int mi = 0; mi < 2; ++mi)
#pragma unroll
            for (int ni = 0; ni < 2; ++ni) {
                const int cl = ACC_COL(ni);
                const float g = gt[cl];
#pragma unroll
                for (int r = 0; r < 16; ++r) { const size_t o = (size_t)ACC_ROW(mi, r) * D + nt * 128 + cl; dst[o] = rv[mi][ni][r] + g * acc[mi][ni][r]; }
            }
    }
}

__global__ void __launch_bounds__(256, 2) mega(Params PK) {
    extern __shared__ __attribute__((aligned(16))) unsigned char smem[];
    if (blockIdx.x == 0 && threadIdx.x == 0) {
        Params* T = (Params*)(PK.ws + OFF_TAB);
        T->x = PK.x; T->c = PK.c; T->ctx = PK.ctx; T->c_ctx = PK.c_ctx; T->ada_w = PK.ada_w; T->ada_b = PK.ada_b; T->norm_g = PK.norm_g; T->w_in = PK.w_in;
        T->w_uq = PK.w_uq; T->w_ukv = PK.w_ukv; T->g_cq = PK.g_cq; T->g_ckv = PK.g_ckv; T->g_q = PK.g_q; T->g_k = PK.g_k; T->rpb = PK.rpb; T->ng_q = PK.ng_q; T->ng_k = PK.ng_k;
        T->lb_logits = PK.lb_logits; T->hg_g_o = PK.hg_g_o; T->gla_w2 = PK.gla_w2; T->gla_b2 = PK.gla_b2; T->gla_g_o = PK.gla_g_o; T->w_br = PK.w_br; T->w_merge = PK.w_merge;
        T->b_merge = PK.b_merge; T->w_out = PK.w_out; T->out = PK.out; T->ws = PK.ws; T->ph_lo = PK.ph_lo; T->ph_hi = PK.ph_hi;
    }
    unsigned char* wsb = PK.ws;
    const int ph_lo = PK.ph_lo, ph_hi = PK.ph_hi;
#ifdef PROBE_SUB
    __shared__ long long s_tacc, s_tprev; if (threadIdx.x == 0) { s_tacc = 0; s_tprev = 0; }
#endif
    for (int ph = ph_lo; ph < ph_hi; ++ph) {
#ifndef SPLIT_MIX
        if (ph > 8 && ((ph - 1) & 7) == 0) continue;
#endif
        if (ph > ph_lo) cg::this_grid().sync();
        const Params& P = PK;
#ifdef PROBE_SUB
        if (threadIdx.x == 0) { const long long t_now = wall_clock64();
#ifdef SPLIT_MIX
            const int prev_sub = (ph == 0) ? -1 : (ph == 1 ? 9 : ((ph - 2) % 9));
#else
            const int prev_sub = (ph == 0) ? -1 : (ph == 1 ? 8 : ((ph - 2) & 7));
#endif
            if (prev_sub == PROBE_SUB) s_tacc += t_now - s_tprev; s_tprev = t_now; }
#endif
#ifdef ONLYP
#define PH_ON(n) ((ONLYP >> (n)) & 1)
#else
#define PH_ON(n) true
#endif
        if (ph == 0) { if (PH_ON(8)) phase_prologue(PK, ph, smem); continue; }
#ifdef SPLIT_MIX
        const int q = ph - 1, pass = q / 9, sub9 = q % 9, l = pass >> 1, hf = pass & 1;
        if (sub9 == 4 || sub9 == 5) { phase_mixers(P, ph, l, smem, sub9 - 3); continue; }
        const int sub = sub9 < 4 ? sub9 : sub9 - 1;
        switch (sub) {
            case 0: phase_norm(P, ph, l, hf); break;
            case 1: phase_gemm1(P, ph, l, smem); break;
            case 2: phase_gemm2(P, ph, l, smem); break;
            case 3: phase_finalize(P, ph, l, smem); break;
            case 5: phase_scanfin(P, ph, l); break;
            case 6: phase_merge(P, ph, l, smem); break;
            default: phase_out(P, ph, l, hf, smem); break;
        }
#else
        const int q = ph - 1, pass = q >> 3, sub = q & 7, l = pass >> 1, hf = pass & 1;
        switch (sub) {
            case 0: if (PH_ON(0)) phase_norm(P, ph, l, hf); break;
            case 1: if (PH_ON(1)) phase_gemm1(P, ph, l, smem); break;
            case 2: if (PH_ON(2)) phase_gemm2(P, ph, l, smem); break;
            case 3: if (PH_ON(3)) phase_finalize(P, ph, l, smem); break;
            case 4: if (PH_ON(4)) phase_mixers(P, ph, l, smem); break;
            case 5: if (PH_ON(5)) phase_scanfin(P, ph, l); break;
            case 6: if (PH_ON(6)) phase_merge(P, ph, l, smem); break;
            default: if (PH_ON(7)) { phase_out(P, ph, l, hf, smem); if (pass < 3) phase_norm(P, ph + 40, (pass + 1) >> 1, (pass + 1) & 1); } break;
        }
#endif
    }
#ifdef PROBE_SUB
    cg::this_grid().sync();
    if (threadIdx.x == 0) { const long long t_now = wall_clock64(); if (7 == PROBE_SUB) s_tacc += t_now - s_tprev;
      if (blockIdx.x == 0) { const long long t_acc = s_tacc; const long long t0 = wall_clock64(); while (wall_clock64() - t0 < t_acc) { __builtin_amdgcn_s_sleep(10); } } }
#endif
}

extern "C" void kernel_launch(void* const* d_in, const int* in_sizes, int n_in, void* d_out, int out_size, void* d_ws, size_t ws_size, hipStream_t stream) {
    static int grid = 0;
    if (grid == 0) {
        if (ws_size < WS_END) { fprintf(stderr, "workspace too small: %zu < %zu\n", ws_size, (size_t)WS_END); grid = -1; return; }
        int dev = 0, cus = 0, per_cu = 0;
        hipGetDevice(&dev);
        hipDeviceGetAttribute(&cus, hipDeviceAttributeMultiprocessorCount, dev);
        hipFuncSetAttribute((const void*)mega, hipFuncAttributeMaxDynamicSharedMemorySize, LDS_BYTES);
        hipOccupancyMaxActiveBlocksPerMultiprocessor(&per_cu, (const void*)mega, 256, LDS_BYTES);
        if (per_cu < 1) per_cu = 1;
        if (per_cu > 2) per_cu = 2;
        grid = cus * per_cu;
        (void)hipGetLastError();
    }
    if (grid < 0) return;
    hipMemsetAsync((unsigned char*)d_ws + OFF_CTL, 0, 4096, stream);
    Params p{};
    const float** pp = (const float**)&p;
    for (int i = 0; i < 26; ++i) pp[i] = (const float*)d_in[i];
    p.out = (float*)d_out; p.ws = (unsigned char*)d_ws;
#if SINGLE_LAUNCH
    p.ph_lo = 0; p.ph_hi = NPHASE;
    void* args[] = {&p};
    hipError_t e = hipLaunchCooperativeKernel((const void*)mega, dim3(grid), dim3(256), args, LDS_BYTES, stream);
    if (e != hipSuccess) fprintf(stderr, "cooperative launch failed: %s (grid %d)\n", hipGetErrorString(e), grid);
#else
    for (int ph = 0; ph < NPHASE; ++ph) {
        p.ph_lo = ph; p.ph_hi = ph + 1;
        hipLaunchKernelGGL(mega, dim3(grid), dim3(256), LDS_BYTES, stream, p);
    }
#endif
}
```

```cpp
#include <hip/hip_runtime.h>
#include <hip/hip_cooperative_groups.h>
#include <stdint.h>
#include <stdio.h>
namespace cg = cooperative_groups;

typedef unsigned short bf16_t;
typedef short bf16x8 __attribute__((ext_vector_type(8)));
typedef short bf16x4 __attribute__((ext_vector_type(4)));
typedef float f32x16 __attribute__((ext_vector_type(16)));

#ifndef SINGLE_LAUNCH
#define SINGLE_LAUNCH 1
#endif

constexpr int D = 1024, SEQ = 8192, CTXL = 256, TB = SEQ + CTXL  , NTH = 2 * TB  ;
constexpr int INW = 7104, PW = 7104;
constexpr int C_CQ = 0, C_CKV = 256, C_KR = 384, C_NQ = 416, C_NK = 928, C_NV = 1440, C_HQ = 1952, C_HF = 2464, C_HI = 3488,
              C_GQ = 4000, C_GK = 4256, C_GV = 4512, C_GR = 5024, C_Z = 5056;
constexpr float EPS = 1e-6f;
constexpr float LOG2E = 1.4426950408889634f;
constexpr int LDS_BYTES = 73728;
#ifdef SPLIT_MIX
constexpr int NPHASE = 37;
#else
constexpr int NPHASE = 33;
#endif

constexpr size_t al256(size_t v) { return (v + 255) & ~(size_t)255; }
constexpr size_t OFF_CTL = 0;
constexpr size_t OFF_TAB = 1024;
constexpr size_t OFF_MOD = 4096;
constexpr size_t OFF_CX1 = al256(OFF_MOD + 2 * 5 * 3072 * 4);
constexpr size_t OFF_WIN = al256(OFF_CX1 + (size_t)4 * 256 * 1024 * 4);
constexpr size_t OFF_WM = al256(OFF_WIN + (size_t)2 * 7168 * 1024 * 2);
constexpr size_t OFF_WBR = al256(OFF_WM + (size_t)8 * 1024 * 1024 * 2);
constexpr size_t OFF_WO = al256(OFF_WBR + (size_t)8 * 1024 * 512 * 2);
constexpr size_t OFF_WUQ = al256(OFF_WO + (size_t)2 * 1024 * 1024 * 2);
constexpr size_t OFF_WUKV = al256(OFF_WUQ + (size_t)2 * 768 * 256 * 2);
constexpr size_t OFF_H = al256(OFF_WUKV + (size_t)2 * 1024 * 128 * 2);
constexpr size_t OFF_PB = al256(OFF_H + (size_t)NTH * 1024 * 2);
constexpr size_t OFF_QF = al256(OFF_PB + (size_t)NTH * PW * 2);
constexpr size_t OFF_KV = al256(OFF_QF + (size_t)NTH * 768 * 2);
constexpr size_t OFF_KF = al256(OFF_KV + (size_t)NTH * 1024 * 2);
constexpr size_t OFF_VTM = al256(OFF_KF + (size_t)NTH * 768 * 2);
constexpr size_t OFF_VTN = al256(OFF_VTM + (size_t)2 * 8 * 64 * TB * 2);
constexpr size_t OFF_OSG = al256(OFF_VTN + (size_t)2 * 8 * 64 * TB * 2);
constexpr size_t OFF_XH = al256(OFF_OSG + (size_t)2 * NTH * 512 * 2);
constexpr size_t OFF_XG = al256(OFF_XH + (size_t)NTH * 512 * 2);
constexpr size_t OFF_EBH = al256(OFF_XG + (size_t)NTH * 512 * 2);
constexpr size_t OFF_EBG = al256(OFF_EBH + (size_t)528 * 2 * 512 * 4);
constexpr size_t WS_END = al256(OFF_EBG + (size_t)528 * 2 * 256 * 4);

static_assert(WS_END <= (size_t)512 * 1024 * 1024, "workspace map exceeds 512 MiB");
struct Params {
    const float *x, *c, *ctx, *c_ctx, *ada_w, *ada_b, *norm_g, *w_in, *w_uq, *w_ukv, *g_cq, *g_ckv, *g_q, *g_k, *rpb, *ng_q, *ng_k,
        *lb_logits, *hg_g_o, *gla_w2, *gla_b2, *gla_g_o, *w_br, *w_merge, *b_merge, *w_out;
    float* out;
    unsigned char* ws;
    int ph_lo, ph_hi;
};

__device__ __forceinline__ float bf2f(bf16_t v) { return __uint_as_float(((unsigned)v) << 16); }
typedef float f32x2_t __attribute__((ext_vector_type(2)));
typedef __bf16 bf16x2_t __attribute__((ext_vector_type(2)));
__device__ __forceinline__ unsigned cvt_pk(float lo, float hi) { f32x2_t v = {lo, hi}; bf16x2_t b = __builtin_convertvector(v, bf16x2_t); return __builtin_bit_cast(unsigned, b); }
__device__ __forceinline__ unsigned cvt_pk_asm(float lo, float hi) { unsigned r; asm("s_nop 1\n\tv_cvt_pk_bf16_f32 %0, %1, %2" : "=v"(r) : "v"(lo), "v"(hi)); return r; }
__device__ __forceinline__ bf16_t f2bf(float f) { return (bf16_t)(cvt_pk(f, 0.f) & 0xffffu); }
__device__ __forceinline__ float lo16(unsigned u) { return __uint_as_float(u << 16); }
__device__ __forceinline__ float hi16(unsigned u) { return __uint_as_float(u & 0xffff0000u); }
__device__ __forceinline__ float sigmoidf_(float x) { return __builtin_amdgcn_rcpf(1.f + __expf(-x)); }
__device__ __forceinline__ float siluf_(float x) { return x * __builtin_amdgcn_rcpf(1.f + __expf(-x)); }
__device__ __forceinline__ float wave_sum(float v) {
#pragma unroll
    for (int o = 32; o > 0; o >>= 1) v += __shfl_xor(v, o);
    return v;
}
__device__ __forceinline__ void unpack8(uint4 u, float* f) {
    f[0] = lo16(u.x); f[1] = hi16(u.x); f[2] = lo16(u.y); f[3] = hi16(u.y); f[4] = lo16(u.z); f[5] = hi16(u.z); f[6] = lo16(u.w); f[7] = hi16(u.w);
}
__device__ __forceinline__ uint4 pack8(const float* f) { uint4 u; u.x = cvt_pk(f[0], f[1]); u.y = cvt_pk(f[2], f[3]); u.z = cvt_pk(f[4], f[5]); u.w = cvt_pk(f[6], f[7]); return u; }

__device__ __forceinline__ int tid_opaque() { int t = threadIdx.x; asm volatile("" : "+v"(t)); return t; }
__shared__ int s_item;
__device__ __forceinline__ int next_item(const Params& P, int ph) {
    __syncthreads();
    if (threadIdx.x == 0) s_item = atomicAdd((int*)(P.ws + OFF_CTL) + ph, 1);
    __syncthreads();
    return s_item;
}

constexpr int GS = 72;
__device__ __forceinline__ void gemm_tile(f32x16 (&acc)[2][2], const bf16_t* __restrict__ A, int lda, const bf16_t* __restrict__ Bt, int ldb, int K, unsigned char* smem) {
    const int tid = tid_opaque(), lane = tid & 63, wave = tid >> 6, wr = wave >> 1, wc = wave & 1;
    bf16_t* sA = (bf16_t*)smem;
    bf16_t* sB = sA + 2 * 128 * GS;
    const int lrow = tid >> 3, lch = (tid & 7) * 8;
    uint4 ra[4], rb[4];
    const bf16_t* Ap = A + (size_t)lrow * lda + lch;
    const bf16_t* Bp = Bt + (size_t)lrow * ldb + lch;
#pragma unroll
    for (int i = 0; i < 4; ++i) { ra[i] = *(const uint4*)(Ap + (size_t)(32 * i) * lda); rb[i] = *(const uint4*)(Bp + (size_t)(32 * i) * ldb); }
#pragma unroll
    for (int i = 0; i < 4; ++i) { *(uint4*)(sA + (lrow + 32 * i) * GS + lch) = ra[i]; *(uint4*)(sB + (lrow + 32 * i) * GS + lch) = rb[i]; }
    __syncthreads();
    const int nk = K >> 6;
    const int aoff = (wr * 64 + (lane & 31)) * GS + (lane >> 5) * 8, boff = (wc * 64 + (lane & 31)) * GS + (lane >> 5) * 8;
    for (int kt = 0; kt < nk; ++kt) {
        const bool more = kt + 1 < nk;
        if (more) {
#pragma unroll
            for (int i = 0; i < 4; ++i) { ra[i] = *(const uint4*)(Ap + (size_t)(32 * i) * lda + (kt + 1) * 64); rb[i] = *(const uint4*)(Bp + (size_t)(32 * i) * ldb + (kt + 1) * 64); }
        }
        const bf16_t* a = sA + (kt & 1) * 128 * GS + aoff;
        const bf16_t* b = sB + (kt & 1) * 128 * GS + boff;
#pragma unroll
        for (int ks = 0; ks < 4; ++ks) {
            bf16x8 a0 = *(const bf16x8*)(a + ks * 16), a1 = *(const bf16x8*)(a + 32 * GS + ks * 16);
            bf16x8 b0 = *(const bf16x8*)(b + ks * 16), b1 = *(const bf16x8*)(b + 32 * GS + ks * 16);
            acc[0][0] = __builtin_amdgcn_mfma_f32_32x32x16_bf16(a0, b0, acc[0][0], 0, 0, 0);
            acc[0][1] = __builtin_amdgcn_mfma_f32_32x32x16_bf16(a0, b1, acc[0][1], 0, 0, 0);
            acc[1][0] = __builtin_amdgcn_mfma_f32_32x32x16_bf16(a1, b0, acc[1][0], 0, 0, 0);
            acc[1][1] = __builtin_amdgcn_mfma_f32_32x32x16_bf16(a1, b1, acc[1][1], 0, 0, 0);
        }
        if (more) {
            bf16_t* wa = sA + ((kt + 1) & 1) * 128 * GS;
            bf16_t* wb = sB + ((kt + 1) & 1) * 128 * GS;
#pragma unroll
            for (int i = 0; i < 4; ++i) { *(uint4*)(wa + (lrow + 32 * i) * GS + lch) = ra[i]; *(uint4*)(wb + (lrow + 32 * i) * GS + lch) = rb[i]; }
        }
        __syncthreads();
    }
}

__device__ __forceinline__ void gemm_tile_pf2(f32x16 (&acc)[2][2], const bf16_t* __restrict__ A, int lda, const bf16_t* __restrict__ Bt, int ldb, int K, unsigned char* smem) {
    const int tid = tid_opaque(), lane = tid & 63, wave = tid >> 6, wr = wave >> 1, wc = wave & 1;
    bf16_t* sA = (bf16_t*)smem;
    bf16_t* sB = sA + 2 * 128 * GS;
    const int lrow = tid >> 3, lch = (tid & 7) * 8;
    uint4 pa0, pa1, pa2, pa3, pb0, pb1, pb2, pb3, qa0, qa1, qa2, qa3, qb0, qb1, qb2, qb3;
    const bf16_t* Ap = A + (size_t)lrow * lda + lch;
    const bf16_t* Bp = Bt + (size_t)lrow * ldb + lch;
    const int nk = K >> 6;
#define PF2_LD1(RA, RB, kt_, i) { RA##i = *(const uint4*)(Ap + (size_t)(32 * i) * lda + (kt_) * 64); RB##i = *(const uint4*)(Bp + (size_t)(32 * i) * ldb + (kt_) * 64); }
#define PF2_LOAD(RA, RB, kt_) { PF2_LD1(RA, RB, kt_, 0) PF2_LD1(RA, RB, kt_, 1) PF2_LD1(RA, RB, kt_, 2) PF2_LD1(RA, RB, kt_, 3) }
#define PF2_WR1(RA, RB, i) { *(uint4*)(wa + (lrow + 32 * i) * GS + lch) = RA##i; *(uint4*)(wb + (lrow + 32 * i) * GS + lch) = RB##i; }
#define PF2_WRITE(RA, RB, buf_) { bf16_t* wa = sA + (buf_) * 128 * GS; bf16_t* wb = sB + (buf_) * 128 * GS; PF2_WR1(RA, RB, 0) PF2_WR1(RA, RB, 1) PF2_WR1(RA, RB, 2) PF2_WR1(RA, RB, 3) }
#define PF2_COMPUTE(buf_) { const bf16_t* a = sA + (buf_) * 128 * GS + aoff; const bf16_t* b = sB + (buf_) * 128 * GS + boff; _Pragma("unroll") for (int ks = 0; ks < 4; ++ks) { \
        bf16x8 a0 = *(const bf16x8*)(a + ks * 16), a1 = *(const bf16x8*)(a + 32 * GS + ks * 16); bf16x8 b0 = *(const bf16x8*)(b + ks * 16), b1 = *(const bf16x8*)(b + 32 * GS + ks * 16); \
        acc[0][0] = __builtin_amdgcn_mfma_f32_32x32x16_bf16(a0, b0, acc[0][0], 0, 0, 0); acc[0][1] = __builtin_amdgcn_mfma_f32_32x32x16_bf16(a0, b1, acc[0][1], 0, 0, 0); \
        acc[1][0] = __builtin_amdgcn_mfma_f32_32x32x16_bf16(a1, b0, acc[1][0], 0, 0, 0); acc[1][1] = __builtin_amdgcn_mfma_f32_32x32x16_bf16(a1, b1, acc[1][1], 0, 0, 0); } }
    const int aoff = (wr * 64 + (lane & 31)) * GS + (lane >> 5) * 8, boff = (wc * 64 + (lane & 31)) * GS + (lane >> 5) * 8;
    PF2_LOAD(pa, pb, 0);
    PF2_LOAD(qa, qb, 1);
    PF2_WRITE(pa, pb, 0);
    __syncthreads();
    for (int kt = 0; kt < nk; kt += 2) {
        if (kt + 2 < nk) PF2_LOAD(pa, pb, kt + 2);
        PF2_COMPUTE(0);
        PF2_WRITE(qa, qb, 1);
        __syncthreads();
        if (kt + 3 < nk) PF2_LOAD(qa, qb, kt + 3);
        PF2_COMPUTE(1);
        if (kt + 2 < nk) PF2_WRITE(pa, pb, 0);
        __syncthreads();
    }
#undef PF2_LOAD
#undef PF2_LD1
#undef PF2_WR1
#undef PF2_WRITE
#undef PF2_COMPUTE
}

__device__ __forceinline__ void gemm_tile_n64(f32x16 (&acc)[2], const bf16_t* __restrict__ A, int lda, const bf16_t* __restrict__ Bt, int ldb, int K, unsigned char* smem) {
    const int tid = tid_opaque(), lane = tid & 63, wave = tid >> 6, wr = wave >> 1, wc = wave & 1;
    bf16_t* sA = (bf16_t*)smem;
    bf16_t* sB = sA + 2 * 128 * GS;
    const int lrow = tid >> 3, lch = (tid & 7) * 8;
    uint4 pa0, pa1, pa2, pa3, pb0, pb1, qa0, qa1, qa2, qa3, qb0, qb1;
    const bf16_t* Ap = A + (size_t)lrow * lda + lch;
    const bf16_t* Bp = Bt + (size_t)lrow * ldb + lch;
    const int nk = K >> 6;
#define N64_LOAD(RA, RB, kt_) { RA##0 = *(const uint4*)(Ap + (kt_) * 64); RA##1 = *(const uint4*)(Ap + (size_t)32 * lda + (kt_) * 64); RA##2 = *(const uint4*)(Ap + (size_t)64 * lda + (kt_) * 64); RA##3 = *(const uint4*)(Ap + (size_t)96 * lda + (kt_) * 64); \
        RB##0 = *(const uint4*)(Bp + (kt_) * 64); RB##1 = *(const uint4*)(Bp + (size_t)32 * ldb + (kt_) * 64); }
#define N64_WRITE(RA, RB, buf_) { bf16_t* wa = sA + (buf_) * 128 * GS + lrow * GS + lch; bf16_t* wb = sB + (buf_) * 64 * GS + lrow * GS + lch; \
        *(uint4*)wa = RA##0; *(uint4*)(wa + 32 * GS) = RA##1; *(uint4*)(wa + 64 * GS) = RA##2; *(uint4*)(wa + 96 * GS) = RA##3; *(uint4*)wb = RB##0; *(uint4*)(wb + 32 * GS) = RB##1; }
#define N64_COMPUTE(buf_) { const bf16_t* a = sA + (buf_) * 128 * GS + aoff; const bf16_t* b = sB + (buf_) * 64 * GS + boff; _Pragma("unroll") for (int ks = 0; ks < 4; ++ks) { \
        bf16x8 a0 = *(const bf16x8*)(a + ks * 16), a1 = *(const bf16x8*)(a + 32 * GS + ks * 16); bf16x8 b0 = *(const bf16x8*)(b + ks * 16); \
        acc[0] = __builtin_amdgcn_mfma_f32_32x32x16_bf16(a0, b0, acc[0], 0, 0, 0); acc[1] = __builtin_amdgcn_mfma_f32_32x32x16_bf16(a1, b0, acc[1], 0, 0, 0); } }
    const int aoff = (wr * 64 + (lane & 31)) * GS + (lane >> 5) * 8, boff = (wc * 32 + (lane & 31)) * GS + (lane >> 5) * 8;
    N64_LOAD(pa, pb, 0);
    N64_LOAD(qa, qb, 1);
    N64_WRITE(pa, pb, 0);
    __syncthreads();
    for (int kt = 0; kt < nk; kt += 2) {
        if (kt + 2 < nk) N64_LOAD(pa, pb, kt + 2);
        N64_COMPUTE(0);
        N64_WRITE(qa, qb, 1);
        __syncthreads();
        if (kt + 3 < nk) N64_LOAD(qa, qb, kt + 3);
        N64_COMPUTE(1);
        if (kt + 2 < nk) N64_WRITE(pa, pb, 0);
        __syncthreads();
    }
#undef N64_LOAD
#undef N64_WRITE
#undef N64_COMPUTE
}

__device__ __forceinline__ void gemm_pair_n64(f32x16 (&acc1)[2], f32x16 (&acc2)[2], const bf16_t* __restrict__ A1, int lda1, const bf16_t* __restrict__ B1, int ldb1, int K1,
                                              const bf16_t* __restrict__ A2, int lda2, const bf16_t* __restrict__ B2, int ldb2, int K2, unsigned char* smem) {
    const int tid = tid_opaque(), lane = tid & 63, wave = tid >> 6, wr = wave >> 1, wc = wave & 1;
    bf16_t* sA = (bf16_t*)smem;
    bf16_t* sB = sA + 2 * 128 * GS;
    const int lrow = tid >> 3, lch = (tid & 7) * 8;
    uint4 pa0, pa1, pa2, pa3, pb0, pb1, qa0, qa1, qa2, qa3, qb0, qb1;
    const bf16_t* Ap1 = A1 + (size_t)lrow * lda1 + lch; const bf16_t* Bp1 = B1 + (size_t)lrow * ldb1 + lch;
    const bf16_t* Ap2 = A2 + (size_t)lrow * lda2 + lch; const bf16_t* Bp2 = B2 + (size_t)lrow * ldb2 + lch;
    const int nk1 = K1 >> 6, nk = nk1 + (K2 >> 6);
#define P64_LOAD(RA, RB, kt_) { const bool s2_ = (kt_) >= nk1; const bf16_t* ap_ = s2_ ? Ap2 + ((kt_) - nk1) * 64 : Ap1 + (kt_) * 64; const bf16_t* bp_ = s2_ ? Bp2 + ((kt_) - nk1) * 64 : Bp1 + (kt_) * 64; \
        const size_t la_ = s2_ ? lda2 : lda1, lb_ = s2_ ? ldb2 : ldb1; \
        RA##0 = *(const uint4*)(ap_); RA##1 = *(const uint4*)(ap_ + 32 * la_); RA##2 = *(const uint4*)(ap_ + 64 * la_); RA##3 = *(const uint4*)(ap_ + 96 * la_); \
        RB##0 = *(const uint4*)(bp_); RB##1 = *(const uint4*)(bp_ + 32 * lb_); }
#define P64_WRITE(RA, RB, buf_) { bf16_t* wa = sA + (buf_) * 128 * GS + lrow * GS + lch; bf16_t* wb = sB + (buf_) * 64 * GS + lrow * GS + lch; \
        *(uint4*)wa = RA##0; *(uint4*)(wa + 32 * GS) = RA##1; *(uint4*)(wa + 64 * GS) = RA##2; *(uint4*)(wa + 96 * GS) = RA##3; *(uint4*)wb = RB##0; *(uint4*)(wb + 32 * GS) = RB##1; }
#define P64_COMPUTE(ACC, buf_) { const bf16_t* a = sA + (buf_) * 128 * GS + aoff; const bf16_t* b = sB + (buf_) * 64 * GS + boff; _Pragma("unroll") for (int ks = 0; ks < 4; ++ks) { \
        bf16x8 a0 = *(const bf16x8*)(a + ks * 16), a1 = *(const bf16x8*)(a + 32 * GS + ks * 16); bf16x8 b0 = *(const bf16x8*)(b + ks * 16); \
        ACC[0] = __builtin_amdgcn_mfma_f32_32x32x16_bf16(a0, b0, ACC[0], 0, 0, 0); ACC[1] = __builtin_amdgcn_mfma_f32_32x32x16_bf16(a1, b0, ACC[1], 0, 0, 0); } }
    const int aoff = (wr * 64 + (lane & 31)) * GS + (lane >> 5) * 8, boff = (wc * 32 + (lane & 31)) * GS + (lane >> 5) * 8;
    P64_LOAD(pa, pb, 0);
    P64_LOAD(qa, qb, 1);
    P64_WRITE(pa, pb, 0);
    __syncthreads();
    for (int kt = 0; kt < nk; kt += 2) {
        if (kt + 2 < nk) P64_LOAD(pa, pb, kt + 2);
        if (kt < nk1) P64_COMPUTE(acc1, 0) else P64_COMPUTE(acc2, 0)
        P64_WRITE(qa, qb, 1);
        __syncthreads();
        if (kt + 3 < nk) P64_LOAD(qa, qb, kt + 3);
        if (kt + 1 < nk1) P64_COMPUTE(acc1, 1) else P64_COMPUTE(acc2, 1)
        if (kt + 2 < nk) P64_WRITE(pa, pb, 0);
        __syncthreads();
    }
#undef P64_LOAD
#undef P64_WRITE
#undef P64_COMPUTE
}
__device__ __forceinline__ void zero_acc(f32x16 (&acc)[2][2]) {
#pragma unroll
    for (int i = 0; i < 2; ++i)
#pragma unroll
        for (int j = 0; j < 2; ++j)
#pragma unroll
            for (int r = 0; r < 16; ++r) acc[i][j][r] = 0.f;
}
#define ACC_ROW(mi, r) (wr * 64 + (mi) * 32 + ((r) & 3) + 8 * ((r) >> 2) + 4 * (lane >> 5))
#define ACC_COL(ni) (wc * 64 + (ni) * 32 + (lane & 31))

__device__ void tr_tile(const float* __restrict__ src, int K, int N, int kt, int nt, bf16_t* __restrict__ dst, const float* __restrict__ scale, float* s) {
    const int tid = tid_opaque(), r = tid >> 4, c4 = (tid & 15) * 4;
#pragma unroll
    for (int i = 0; i < 4; ++i) {
        const int k = kt * 64 + r + 16 * i;
        float4 v = *(const float4*)(src + (size_t)k * N + nt * 64 + c4);
        const float sc = scale ? scale[k] : 1.f;
        float* d = s + (r + 16 * i) * 65 + c4;
        d[0] = v.x * sc; d[1] = v.y * sc; d[2] = v.z * sc; d[3] = v.w * sc;
    }
    __syncthreads();
    const int n = tid >> 2, k0 = (tid & 3) * 16;
    float f[16];
#pragma unroll
    for (int j = 0; j < 16; ++j) f[j] = s[(k0 + j) * 65 + n];
    bf16_t* o = dst + (size_t)(nt * 64 + n) * K + kt * 64 + k0;
    *(uint4*)o = pack8(f);
    *(uint4*)(o + 8) = pack8(f + 8);
    __syncthreads();
}
__device__ void phase_prologue(const Params& P, int ph, unsigned char* smem) {
    float* s = (float*)smem;
    const int NTR = 7296, NMOD = 96;
    for (;;) {
        const int u = next_item(P, ph);
        if (u >= NTR + NMOD) break;
        if (u < NMOD) {
            const int l = u / 48, cb = u % 48, tid = threadIdx.x, lane = tid & 63, wave = tid >> 6;
            float* sc = s;
            float* red = s + 5 * 1024;
            for (int i = tid; i < 5 * 1024; i += 256) { const int r = i >> 10, k = i & 1023; const float v = (r < 4) ? P.c[r * 1024 + k] : P.c_ctx[k]; sc[i] = siluf_(v); }
            __syncthreads();
            const int col = cb * 64 + lane;
            float acc[5] = {0.f, 0.f, 0.f, 0.f, 0.f};
            const float* w = P.ada_w + (size_t)l * 1024 * 3072 + col;
#pragma unroll 8
            for (int k = wave * 256; k < wave * 256 + 256; ++k) {
                const float wv = w[(size_t)k * 3072];
#pragma unroll
                for (int r = 0; r < 5; ++r) acc[r] += sc[r * 1024 + k] * wv;
            }
#pragma unroll
            for (int r = 0; r < 5; ++r) red[(wave * 5 + r) * 64 + lane] = acc[r];
            __syncthreads();
            if (wave == 0) {
                float* mod = (float*)(P.ws + OFF_MOD);
#pragma unroll
                for (int r = 0; r < 5; ++r) mod[(l * 5 + r) * 3072 + col] = red[r * 64 + lane] + red[(5 + r) * 64 + lane] + red[(10 + r) * 64 + lane] + red[(15 + r) * 64 + lane] + P.ada_b[l * 3072 + col];
            }
            continue;
        }
        const int v = u - NMOD, l = v / 3648, r = v % 3648;
        if (r < 1776) tr_tile(P.w_in + (size_t)l * 1024 * INW, 1024, INW, r / 111, r % 111, (bf16_t*)(P.ws + OFF_WIN) + (size_t)l * 7168 * 1024, nullptr, s);
        else if (r < 2800) { const int r2 = r - 1776, br = r2 >> 8, t = r2 & 255; tr_tile(P.w_merge + (size_t)(l * 4 + br) * 1024 * 1024, 1024, 1024, t >> 4, t & 15, (bf16_t*)(P.ws + OFF_WM) + (size_t)(l * 4 + br) * 1024 * 1024, nullptr, s); }
        else if (r < 3312) { const int r2 = r - 2800, br = r2 >> 7, t = r2 & 127; tr_tile(P.w_br + (size_t)(l * 4 + br) * 512 * 1024, 512, 1024, t >> 4, t & 15, (bf16_t*)(P.ws + OFF_WBR) + (size_t)(l * 4 + br) * 1024 * 512, nullptr, s); }
        else if (r < 3568) { const int t = r - 3312; tr_tile(P.w_out + (size_t)l * 1024 * 1024, 1024, 1024, t >> 4, t & 15, (bf16_t*)(P.ws + OFF_WO) + (size_t)l * 1024 * 1024, nullptr, s); }
        else if (r < 3616) { const int t = r - 3568; tr_tile(P.w_uq + (size_t)l * 256 * 768, 256, 768, t / 12, t % 12, (bf16_t*)(P.ws + OFF_WUQ) + (size_t)l * 768 * 256, P.g_cq + l * 256, s); }
        else { const int t = r - 3616; tr_tile(P.w_ukv + (size_t)l * 128 * 1024, 128, 1024, t >> 4, t & 15, (bf16_t*)(P.ws + OFF_WUKV) + (size_t)l * 1024 * 128, P.g_ckv + l * 128, s); }
    }
}

__device__ void phase_norm(const Params& P, int ph, int l, int hf) {
    const int tid = tid_opaque(), lane = tid & 63, wave = tid >> 6;
    const float* mod = (const float*)(P.ws + OFF_MOD);
    bf16_t* H = (bf16_t*)(P.ws + OFF_H);
    for (;;) {
        const int u = next_item(P, ph);
        if (u >= NTH / 8) break;
        float4 v[2][4]; int mrr[2];
#pragma unroll
        for (int rr = 0; rr < 2; ++rr) {
            const int t = u * 8 + wave * 2 + rr, bl = t / TB, p = t % TB, b = hf * 2 + bl;
            const float* src;
            if (p < CTXL) { src = (l == 0 ? P.ctx : (const float*)(P.ws + OFF_CX1)) + ((size_t)b * CTXL + p) * D; mrr[rr] = 4; }
            else { src = (l == 0 ? P.x : (const float*)P.out) + ((size_t)b * SEQ + (p - CTXL)) * D; mrr[rr] = b; }
#pragma unroll
            for (int i = 0; i < 4; ++i) v[rr][i] = *(const float4*)(src + lane * 4 + 256 * i);
        }
#pragma unroll
        for (int rr = 0; rr < 2; ++rr) {
            const int t = u * 8 + wave * 2 + rr;
            float ss = 0.f;
#pragma unroll
            for (int i = 0; i < 4; ++i) ss += v[rr][i].x * v[rr][i].x + v[rr][i].y * v[rr][i].y + v[rr][i].z * v[rr][i].z + v[rr][i].w * v[rr][i].w;
            ss = wave_sum(ss);
            const float rstd = rsqrtf(ss * (1.f / D) + EPS);
            const float* sh = mod + (l * 5 + mrr[rr]) * 3072; const float* sc = sh + 1024; const float* g = P.norm_g + l * D;
#pragma unroll
            for (int i = 0; i < 4; ++i) {
                const int c = lane * 4 + 256 * i;
                const float4 gv = *(const float4*)(g + c), s1 = *(const float4*)(sc + c), s0 = *(const float4*)(sh + c);
                uint2 o;
                o.x = cvt_pk(v[rr][i].x * rstd * gv.x * (1.f + s1.x) + s0.x, v[rr][i].y * rstd * gv.y * (1.f + s1.y) + s0.y);
                o.y = cvt_pk(v[rr][i].z * rstd * gv.z * (1.f + s1.z) + s0.z, v[rr][i].w * rstd * gv.w * (1.f + s1.w) + s0.w);
                *(uint2*)(H + (size_t)t * D + c) = o;
            }
        }
    }
}

__device__ void phase_gemm1(const Params& P, int ph, int l, unsigned char* smem) {
    const int tid_ = tid_opaque(), lane = tid_ & 63, wave = tid_ >> 6, wr = wave >> 1, wc = wave & 1;
    const bf16_t* H = (const bf16_t*)(P.ws + OFF_H);
    const bf16_t* W = (const bf16_t*)(P.ws + OFF_WIN) + (size_t)l * 7168 * 1024;
    bf16_t* PB = (bf16_t*)(P.ws + OFF_PB);
    for (;;) {
        const int u = next_item(P, ph);
        if (u >= 132 * 56) break;
        const int mt = u / 56, nt = u % 56;
        f32x16 acc[2][2]; zero_acc(acc);
        gemm_tile_pf2(acc, H + (size_t)mt * 128 * D, D, W + (size_t)nt * 128 * D, D, D, smem);
#pragma unroll
        for (int mi = 0; mi < 2; ++mi)
#pragma unroll
            for (int ni = 0; ni < 2; ++ni) {
                const int col = nt * 128 + ACC_COL(ni);
                if (col < PW) {
#pragma unroll
                    for (int r = 0; r < 16; ++r) PB[(size_t)(mt * 128 + ACC_ROW(mi, r)) * PW + col] = f2bf(acc[mi][ni][r]);
                }
            }
    }
}

__device__ void phase_gemm2(const Params& P, int ph, int l, unsigned char* smem) {
    const int tid_ = tid_opaque(), lane = tid_ & 63, wave = tid_ >> 6, wr = wave >> 1, wc = wave & 1;
    const bf16_t* PB = (const bf16_t*)(P.ws + OFF_PB);
    for (;;) {
        const int u = next_item(P, ph);
        if (u >= 132 * 14) break;
        const int mt = u / 14, n14 = u % 14;
        f32x16 acc[2][2]; zero_acc(acc);
        bf16_t* O; int ldo, nt;
        if (n14 < 6) { nt = n14; O = (bf16_t*)(P.ws + OFF_QF); ldo = 768;
            gemm_tile_pf2(acc, PB + (size_t)mt * 128 * PW + C_CQ, PW, (const bf16_t*)(P.ws + OFF_WUQ) + (size_t)l * 768 * 256 + (size_t)nt * 128 * 256, 256, 256, smem); }
        else { nt = n14 - 6; O = (bf16_t*)(P.ws + OFF_KV); ldo = 1024;
            gemm_tile_pf2(acc, PB + (size_t)mt * 128 * PW + C_CKV, PW, (const bf16_t*)(P.ws + OFF_WUKV) + (size_t)l * 1024 * 128 + (size_t)nt * 128 * 128, 128, 128, smem); }
#pragma unroll
        for (int mi = 0; mi < 2; ++mi)
#pragma unroll
            for (int ni = 0; ni < 2; ++ni)
#pragma unroll
                for (int r = 0; r < 16; ++r) O[(size_t)(mt * 128 + ACC_ROW(mi, r)) * ldo + nt * 128 + ACC_COL(ni)] = f2bf(acc[mi][ni][r]);
    }
}

__device__ void phase_finalize(const Params& P, int ph, int l, unsigned char* smem) {
    const int tid = tid_opaque(), lane = tid & 63, wave = tid >> 6;
    bf16_t* PB = (bf16_t*)(P.ws + OFF_PB);
    bf16_t* QF = (bf16_t*)(P.ws + OFF_QF);
    const bf16_t* KV = (const bf16_t*)(P.ws + OFF_KV);
    bf16_t* KF = (bf16_t*)(P.ws + OFF_KF);
    bf16_t* VTM = (bf16_t*)(P.ws + OFF_VTM);
    bf16_t* VTN = (bf16_t*)(P.ws + OFF_VTN);
    float* rs = (float*)smem;
    const int hd = lane >> 3, j = lane & 7;
    const float invf = __powf(10000.f, -(float)j * 0.125f);
    for (;;) {
        const int u7 = next_item(P, ph);
        if (u7 >= (NTH / 32) * 11) break;
        const int u = u7 / 11, sub = u7 % 11;
        const int t0 = u * 32, bl = t0 / TB, p0 = t0 % TB;
        if (sub >= 1 && sub <= 4) {
        uint2 in_cq[2]; unsigned in_ckv[2]; bf16_t in_q[2][12], in_kv[2][8], in_kr[2][4]; uint4 in_nq[2], in_nk[2];
#pragma unroll
        for (int rr = 0; rr < 2; ++rr) {
            const int tl = (sub - 1) * 8 + wave * 2 + rr, t = t0 + tl;
            const bf16_t* prow = PB + (size_t)t * PW;
            in_cq[rr] = *(const uint2*)(prow + C_CQ + lane * 4);
            in_ckv[rr] = *(const unsigned*)(prow + C_CKV + lane * 2);
            const bf16_t* q = QF + (size_t)t * 768 + hd * 96;
            const bf16_t* kvr = KV + (size_t)t * 1024 + hd * 128;
#pragma unroll
            for (int m = 0; m < 12; ++m) in_q[rr][m] = q[j + 8 * m];
#pragma unroll
            for (int m = 0; m < 8; ++m) in_kv[rr][m] = kvr[j + 8 * m];
#pragma unroll
            for (int m = 0; m < 4; ++m) in_kr[rr][m] = prow[C_KR + j + 8 * m];
            in_nq[rr] = *(const uint4*)(prow + C_NQ + hd * 64 + j * 8);
            in_nk[rr] = *(const uint4*)(prow + C_NK + hd * 64 + j * 8);
        }
#pragma unroll
        for (int rr = 0; rr < 2; ++rr) {
            const int tl = (sub - 1) * 8 + wave * 2 + rr, t = t0 + tl, p = p0 + tl;
            bf16_t* prow = PB + (size_t)t * PW;
            float s1, s2;
            { const uint2 a = in_cq[rr]; const float f0 = lo16(a.x), f1 = hi16(a.x), f2 = lo16(a.y), f3 = hi16(a.y); s1 = f0 * f0 + f1 * f1 + f2 * f2 + f3 * f3;
              const unsigned b = in_ckv[rr]; const float g0 = lo16(b), g1 = hi16(b); s2 = g0 * g0 + g1 * g1; }
            s1 = wave_sum(s1); s2 = wave_sum(s2);
            const float rcq = rsqrtf(s1 * (1.f / 256.f) + EPS), rckv = rsqrtf(s2 * (1.f / 128.f) + EPS);
            {
                bf16_t* q = QF + (size_t)t * 768 + hd * 96;
                float v[12], ss = 0.f;
#pragma unroll
                for (int m = 0; m < 12; ++m) { v[m] = bf2f(in_q[rr][m]) * rcq; ss += v[m] * v[m]; }
                ss += __shfl_xor(ss, 1); ss += __shfl_xor(ss, 2); ss += __shfl_xor(ss, 4);
                const float rn = rsqrtf(ss * (1.f / 96.f) + EPS);
#pragma unroll
                for (int m = 0; m < 12; ++m) q[j + 8 * m] = f2bf(v[m] * rn * P.g_q[l * 96 + j + 8 * m] * (0.10206207261596575f * LOG2E));
            }
            {
                float v[12], ss = 0.f;
#pragma unroll
                for (int m = 0; m < 8; ++m) { v[m] = bf2f(in_kv[rr][m]) * rckv; ss += v[m] * v[m]; }
#pragma unroll
                for (int m = 8; m < 12; ++m) { v[m] = bf2f(in_kr[rr][m - 8]); ss += v[m] * v[m]; }
                ss += __shfl_xor(ss, 1); ss += __shfl_xor(ss, 2); ss += __shfl_xor(ss, 4);
                const float rn = rsqrtf(ss * (1.f / 96.f) + EPS);
#pragma unroll
                for (int m = 0; m < 12; ++m) v[m] = v[m] * rn * P.g_k[l * 96 + j + 8 * m];
                if (p >= CTXL) {
                    const int pos = p - CTXL;
                    const float ar = (float)(pos >> 6) * invf, ac = (float)(pos & 63) * invf;
                    double fr = (double)ar * 0.15915494309189535; fr -= rint(fr);
                    double fc = (double)ac * 0.15915494309189535; fc -= rint(fc);
                    const float sr = __builtin_amdgcn_sinf((float)fr), cr = __builtin_amdgcn_cosf((float)fr);
                    const float sc = __builtin_amdgcn_sinf((float)fc), cc = __builtin_amdgcn_cosf((float)fc);
                    const float x1a = v[8], x2a = v[10], x1b = v[9], x2b = v[11];
                    v[8] = x1a * cr - x2a * sr; v[10] = x1a * sr + x2a * cr;
                    v[9] = x1b * cc - x2b * sc; v[11] = x1b * sc + x2b * cc;
                }
                bf16_t* ko = KF + ((size_t)t * 8 + hd) * 96;
#pragma unroll
                for (int m = 0; m < 12; ++m) ko[j + 8 * m] = f2bf(v[m]);
            }
#pragma unroll
            for (int w = 0; w < 2; ++w) {
                bf16_t* q = prow + (w ? C_NK : C_NQ) + hd * 64 + j * 8;
                const float* g = (w ? P.ng_k : P.ng_q) + l * 64 + j * 8;
                float v[8], ss = 0.f;
                unpack8(w ? in_nk[rr] : in_nq[rr], v);
#pragma unroll
                for (int m = 0; m < 8; ++m) ss += v[m] * v[m];
                ss += __shfl_xor(ss, 1); ss += __shfl_xor(ss, 2); ss += __shfl_xor(ss, 4);
                const float rn = rsqrtf(ss * (1.f / 64.f) + EPS);
#pragma unroll
                for (int m = 0; m < 8; ++m) v[m] = v[m] * rn * g[m] * (w ? 1.f : 0.125f * LOG2E);
                *(uint4*)q = pack8(v);
            }
        }
        } else if (sub == 0) {
        {
            for (int rr = 0; rr < 8; ++rr) {
                const int tl = wave * 8 + rr;
                const unsigned bq = *(const unsigned*)(PB + (size_t)(t0 + tl) * PW + C_CKV + lane * 2);
                const float g0 = lo16(bq), g1 = hi16(bq);
                const float s2 = wave_sum(g0 * g0 + g1 * g1);
                if (lane == 0) rs[tl] = rsqrtf(s2 * (1.f / 128.f) + EPS);
            }
            __syncthreads();
            bf16_t* tile = (bf16_t*)(smem + 8192);
#pragma unroll
            for (int which = 0; which < 2; ++which) {
#pragma unroll
                for (int k8 = 0; k8 < 8; ++k8) {
                    const int id = tid + 256 * k8, i = id >> 6, c8 = id & 63;
                    const bf16_t* src = which ? PB + (size_t)(t0 + i) * PW + C_NV + c8 * 8
                                              : KV + (size_t)(t0 + i) * 1024 + (c8 >> 3) * 128 + 64 + (c8 & 7) * 8;
                    *(uint4*)(tile + i * 512 + c8 * 8) = *(const uint4*)src;
                }
                __syncthreads();
                bf16_t* VT = which ? VTN : VTM;
#pragma unroll
                for (int k8 = 0; k8 < 8; ++k8) {
                    const int id = tid + 256 * k8, r = id >> 2, g = id & 3;
                    float fv[8];
#pragma unroll
                    for (int i = 0; i < 8; ++i) fv[i] = bf2f(tile[(g * 8 + i) * 512 + r]) * (which ? 1.f : rs[g * 8 + i]);
                    *(uint4*)(VT + ((size_t)(bl * 8 + (r >> 6)) * 64 + (r & 63)) * TB + p0 + g * 8) = pack8(fv);
                }
                __syncthreads();
            }
        }
        } else
        {
            const int chunk = t0 >> 5;
            bf16_t* XH = (bf16_t*)(P.ws + OFF_XH);
            bf16_t* XG = (bf16_t*)(P.ws + OFF_XG);
            float* EBH = (float*)(P.ws + OFF_EBH);
            float* EBG = (float*)(P.ws + OFF_EBG);
            bf16_t* base = PB + (size_t)t0 * PW;
            float* rsh = (float*)smem + 256;
            bf16_t* inA = (bf16_t*)(smem + 8192);
            bf16_t* inB = inA + 32 * 128;
            bf16_t* inC = inB + 32 * 128;
            bf16_t* outT = inC + 32 * 128;
#pragma unroll
            for (int k4 = 0; k4 < 4; ++k4) { const int id = tid + 256 * k4, i = id >> 5, jx = id & 31; rsh[id] = bf2f(base[(size_t)i * PW + C_GR + jx]); }
            const int d = tid & 127, dr = tid >> 7;
            { const int grp = sub - 5;
                const bool isg = grp >= 4;
                const int gcol = isg ? (grp - 4) * 128 : grp * 128;
                const int cA = isg ? C_GQ + gcol : C_HQ + gcol, cB = isg ? C_GK + gcol : C_HF + gcol, cC = C_HF + 512 + gcol;
#pragma unroll
                for (int k2 = 0; k2 < 2; ++k2) {
                    const int id = tid + 256 * k2, i = id >> 4, ch = id & 15;
                    const bf16_t* row = base + (size_t)i * PW;
                    *(uint4*)(inA + i * 128 + ch * 8) = *(const uint4*)(row + cA + ch * 8);
                    *(uint4*)(inB + i * 128 + ch * 8) = *(const uint4*)(row + cB + ch * 8);
                    if (!isg) *(uint4*)(inC + i * 128 + ch * 8) = *(const uint4*)(row + cC + ch * 8);
                }
                __syncthreads();
                {
                    const int col = gcol + d;
                    float lb = 0.f, b2 = 0.f, w2[16];
#pragma unroll
                    for (int jx = 0; jx < 16; ++jx) w2[jx] = 0.f;
                    if (isg) {
#pragma unroll
                        for (int jx = 0; jx < 16; ++jx) w2[jx] = P.gla_w2[((size_t)(l * 2 + dr) * 16 + jx) * 256 + col];
                        b2 = P.gla_b2[(l * 2 + dr) * 256 + col];
                    } else if (l != 0) lb = sigmoidf_(P.lb_logits[1024 + dr * 512 + col] - P.lb_logits[dr * 512 + col]);
                    const bf16_t* fsrc = (dr && !isg) ? inC : inB;
                    bf16_t* oq = outT + (dr ? 2 : 0) * 32 * 128;
                    bf16_t* ok = oq + 32 * 128;
                    float cum = 0.f;
#pragma unroll 4
                    for (int sx = 0; sx < 32; ++sx) {
                        const int i = dr ? 31 - sx : sx;
                        const float qv = bf2f(inA[i * 128 + d]), fv = bf2f(fsrc[i * 128 + d]);
                        float qq, kk, la;
                        if (isg) {
                            float g = b2;
#pragma unroll
                            for (int jx = 0; jx < 16; ++jx) g = fmaf(rsh[i * 32 + dr * 16 + jx], w2[jx], g);
                            la = (fminf(g, 0.f) - __logf(1.f + __expf(-fabsf(g)))) * 0.0625f;
                            qq = qv * 0.125f; kk = fv;
                        } else {
                            const float av = lb + (1.f - lb) * sigmoidf_(fv);
                            la = __logf(av); kk = 1.f - av;
                            qq = siluf_(qv) * 0.08838834764831845f;
                        }
                        cum += la;
                        oq[i * 128 + d] = f2bf(qq * __expf(cum));
                        ok[i * 128 + d] = f2bf(kk * __expf(-cum));
                    }
                    if (isg) EBG[(size_t)(chunk * 2 + dr) * 256 + col] = __expf(cum);
                    else EBH[(size_t)(chunk * 2 + dr) * 512 + col] = __expf(cum);
                }
                __syncthreads();
#pragma unroll
                for (int k2 = 0; k2 < 2; ++k2) {
                    const int id = tid + 256 * k2, i = id >> 4, ch = id & 15;
                    bf16_t* row = base + (size_t)i * PW;
                    const uint4 v0 = *(const uint4*)(outT + (0 * 32 + i) * 128 + ch * 8), v1 = *(const uint4*)(outT + (1 * 32 + i) * 128 + ch * 8);
                    const uint4 v2 = *(const uint4*)(outT + (2 * 32 + i) * 128 + ch * 8), v3 = *(const uint4*)(outT + (3 * 32 + i) * 128 + ch * 8);
                    *(uint4*)(row + cA + ch * 8) = v0;
                    *(uint4*)(row + cB + ch * 8) = v1;
                    if (isg) { bf16_t* xr = XG + (size_t)(t0 + i) * 512 + gcol + ch * 8; *(uint4*)xr = v2; *(uint4*)(xr + 256) = v3; }
                    else { *(uint4*)(XH + (size_t)(t0 + i) * 512 + gcol + ch * 8) = v2; *(uint4*)(row + cC + ch * 8) = v3; }
                }
                __syncthreads();
            }
        }
    }
}

template <int DQK, bool NAT>
__device__ void attn_item(const Params& P, int l, int bl, int head, int qb, unsigned char* smem) {
    constexpr int NKS = DQK / 16, KSTR = DQK + 8, VSTR = 68, KCH = DQK / 8, KLD = (DQK * 64 / 8) / 256;
    const int tid = tid_opaque(), lane = tid & 63, wave = tid >> 6, hh = lane >> 5, r32 = lane & 31;
    bf16_t* Ks = (bf16_t*)smem;
    bf16_t* Vs = Ks + 2 * 64 * KSTR;
    float* rpb_s = (float*)(Vs + 2 * 64 * VSTR);
    bf16_t* PB = (bf16_t*)(P.ws + OFF_PB);
    const int rowbase = bl * TB, q_p0 = qb * 128, ql = wave * 32 + r32;
    const bool q_ctx = qb < 2;
    int lt0 = 0, lt1 = 0;
    int qr = 0, qc = 0, r0w = 0, c0 = 0;
    if (!q_ctx) {
        if (NAT) { const int rp = qb - 2, ra = 2 * rp, rb = ra + 1; lt0 = min(max(ra - 4, 0), 120); lt1 = min(max(rb - 4, 0), 120) + 8;
            qr = ra + (wave >> 1); qc = (wave & 1) * 32 + r32; r0w = min(max(qr - 4, 0), 120); c0 = min(max(qc - 8, 0), 48); }
        else { lt0 = 0; lt1 = 128; }
    }
    const int ntiles = 4 + (lt1 - lt0);
    const bf16_t* Kbase; const bf16_t* VT; const bf16_t* qptr; int k_ld;
    if (NAT) { Kbase = PB + (size_t)rowbase * PW + C_NK + head * 64; k_ld = PW; VT = (const bf16_t*)(P.ws + OFF_VTN) + (size_t)(bl * 8 + head) * 64 * TB;
        qptr = PB + (size_t)(rowbase + q_p0 + ql) * PW + C_NQ + head * 64; }
    else { Kbase = (const bf16_t*)(P.ws + OFF_KF) + (size_t)rowbase * 768 + head * 96; k_ld = 768; VT = (const bf16_t*)(P.ws + OFF_VTM) + (size_t)(bl * 8 + head) * 64 * TB;
        qptr = (const bf16_t*)(P.ws + OFF_QF) + (size_t)(rowbase + q_p0 + ql) * 768 + head * 96; }
    if (NAT) { for (int i = tid; i < 465; i += 256) rpb_s[i] = P.rpb[(size_t)(l * 8 + head) * 465 + i] * LOG2E; }
    bf16x8 qf[NKS];
#pragma unroll
    for (int ks = 0; ks < NKS; ++ks) qf[ks] = *(const bf16x8*)(qptr + ks * 16 + hh * 8);
    bf16x8 qrot4 = qf[NKS - 2], qrot5 = qf[NKS - 1];
    if (!NAT && !q_ctx) {
        const int pos = q_p0 - CTXL + ql;
        const float base = hh ? (float)(pos & 63) : (float)(pos >> 6);
#pragma unroll
        for (int jj = 0; jj < 8; ++jj) {
            const float invf = __powf(10000.f, -(float)jj * 0.125f);
            const float ang = base * invf;
            double fr = (double)ang * 0.15915494309189535; fr -= rint(fr);
            const float sn = __builtin_amdgcn_sinf((float)fr), cs = __builtin_amdgcn_cosf((float)fr);
            const float x1 = bf2f((bf16_t)qf[4][jj]), x2 = bf2f((bf16_t)qf[5][jj]);
            qrot4[jj] = (short)f2bf(x1 * cs - x2 * sn);
            qrot5[jj] = (short)f2bf(x1 * sn + x2 * cs);
        }
    }
    float m_run = -1e30f, lsum = 0.f;
    f32x16 oacc[2];
#pragma unroll
    for (int r = 0; r < 16; ++r) { oacc[0][r] = 0.f; oacc[1][r] = 0.f; }
    uint4 kreg0A, kreg1A, kreg2A, vreg0A, vreg1A, kreg0B, kreg1B, kreg2B, vreg0B, vreg1B;
    kreg2A = kreg2B = make_uint4(0, 0, 0, 0);
    const int kid0 = tid, kid1 = tid + 256, kid2 = tid + 512;
    const int krow0 = kid0 / KCH, kch0 = kid0 % KCH, krow1 = kid1 / KCH, kch1 = kid1 % KCH, krow2 = kid2 / KCH, kch2 = kid2 % KCH;
    const int vrow0 = tid >> 3, vch = tid & 7, vrow1 = vrow0 + 32;
#define TILE_P(ti) ((ti) < 4 ? (ti) * 64 : CTXL + (lt0 + (ti) - 4) * 64)
#define GLOAD(ti, S) { const int p_ = TILE_P(ti); \
        kreg0##S = *(const uint4*)(Kbase + (size_t)(p_ + krow0) * k_ld + kch0 * 8); \
        kreg1##S = *(const uint4*)(Kbase + (size_t)(p_ + krow1) * k_ld + kch1 * 8); \
        if (KLD > 2) kreg2##S = *(const uint4*)(Kbase + (size_t)(p_ + krow2) * k_ld + kch2 * 8); \
        vreg0##S = *(const uint4*)(VT + (size_t)vrow0 * TB + p_ + vch * 8); \
        vreg1##S = *(const uint4*)(VT + (size_t)vrow1 * TB + p_ + vch * 8); }
#define SWRITE(buf_, S) { bf16_t* kd_ = Ks + (buf_) * 64 * KSTR; \
        *(uint4*)(kd_ + krow0 * KSTR + kch0 * 8) = kreg0##S; *(uint4*)(kd_ + krow1 * KSTR + kch1 * 8) = kreg1##S; \
        if (KLD > 2) *(uint4*)(kd_ + krow2 * KSTR + kch2 * 8) = kreg2##S; \
        bf16_t* vd_ = Vs + (buf_) * 64 * VSTR + vch * 8; \
        *(uint2*)(vd_ + vrow0 * VSTR) = make_uint2(vreg0##S.x, vreg0##S.y); *(uint2*)(vd_ + vrow0 * VSTR + 4) = make_uint2(vreg0##S.z, vreg0##S.w); \
        *(uint2*)(vd_ + vrow1 * VSTR) = make_uint2(vreg1##S.x, vreg1##S.y); *(uint2*)(vd_ + vrow1 * VSTR + 4) = make_uint2(vreg1##S.z, vreg1##S.w); }
    GLOAD(0, A); SWRITE(0, A);
    { const int t1_ = 1 < ntiles ? 1 : ntiles - 1; GLOAD(t1_, B); }
    __syncthreads();
    for (int ti0 = 0; ti0 < ntiles; ti0 += 2) {
        { const int tl_ = ti0 + 2 < ntiles ? ti0 + 2 : ntiles - 1; GLOAD(tl_, A); asm volatile("" ::: "memory"); }
        { const int ti = ti0; const int buf = 0;
        if (!NAT && ti == 4) { qf[NKS - 2] = qrot4; qf[NKS - 1] = qrot5; }
        const int kr = lt0 + ti - 4;
        const bool active = !NAT || ti < 4 || (kr >= r0w && kr < r0w + 8);
        if (active) {
            const bf16_t* kb = Ks + buf * 64 * KSTR + r32 * KSTR + hh * 8;
            f32x16 st0, st1;
#pragma unroll
            for (int r = 0; r < 16; ++r) { st0[r] = 0.f; st1[r] = 0.f; }
            bf16x8 kf0[NKS], kf1[NKS];
#pragma unroll
            for (int ks = 0; ks < NKS; ++ks) { kf0[ks] = *(const bf16x8*)(kb + ks * 16); kf1[ks] = *(const bf16x8*)(kb + 32 * KSTR + ks * 16); }
            asm volatile("s_waitcnt lgkmcnt(0)" ::: "memory");
#pragma unroll
            for (int ks = 0; ks < NKS; ++ks) {
                st0 = __builtin_amdgcn_mfma_f32_32x32x16_bf16(kf0[ks], qf[ks], st0, 0, 0, 0);
                st1 = __builtin_amdgcn_mfma_f32_32x32x16_bf16(kf1[ks], qf[ks], st1, 0, 0, 0);
            }
            const bf16_t* vb = Vs + buf * 64 * VSTR + r32 * VSTR + 4 * hh;
            uint2 vfr[2][2][2][2];
#pragma unroll
            for (int uu = 0; uu < 2; ++uu)
#pragma unroll
                for (int t = 0; t < 2; ++t)
#pragma unroll
                    for (int s2 = 0; s2 < 2; ++s2) {
                        const bf16_t* a = vb + uu * 32 * VSTR + t * 32 + s2 * 16;
                        vfr[uu][t][s2][0] = *(const uint2*)a; vfr[uu][t][s2][1] = *(const uint2*)(a + 8);
                    }
            float x[32];
#pragma unroll
            for (int r = 0; r < 16; ++r) { x[r] = st0[r]; x[16 + r] = st1[r]; }
            if (NAT && ti >= 4) {
                const int dr = kr - qr + 7;
#pragma unroll
                for (int e = 0; e < 32; ++e) {
                    const int r = e & 15, kc = (e >> 4) * 32 + (r & 3) + 8 * (r >> 2) + 4 * hh;
                    const int dc = min(max(kc - qc, -15), 15) + 15;
                    const bool ok = (kc >= c0) && (kc < c0 + 16);
                    x[e] = ok ? x[e] + rpb_s[dr * 31 + dc] : -1e30f;
                }
            }
            float mx = x[0];
#pragma unroll
            for (int e = 1; e < 32; ++e) mx = fmaxf(mx, x[e]);
            mx = fmaxf(mx, __shfl_xor(mx, 32));
            const float m_new = fmaxf(m_run, mx);
            const bool resc = __ballot(m_new > m_run) != 0ull;
            const float alpha = __builtin_amdgcn_exp2f(m_run - m_new);
            m_run = m_new;
            float ps = 0.f;
#pragma unroll
            for (int e = 0; e < 32; ++e) { x[e] = __builtin_amdgcn_exp2f(x[e] - m_new); ps += x[e]; }
            lsum = lsum * alpha + ps;
            if (resc) {
#pragma unroll
                for (int r = 0; r < 16; ++r) { oacc[0][r] *= alpha; oacc[1][r] *= alpha; }
            }
            bf16x8 pf[2][2];
#pragma unroll
            for (int t = 0; t < 2; ++t)
#pragma unroll
                for (int s = 0; s < 2; ++s) {
                    union { bf16x8 v; unsigned u[4]; } cv;
#pragma unroll
                    for (int q = 0; q < 4; ++q) cv.u[q] = cvt_pk(x[16 * t + 8 * s + 2 * q], x[16 * t + 8 * s + 2 * q + 1]);
                    pf[t][s] = cv.v;
                }
#pragma unroll
            for (int uu = 0; uu < 2; ++uu)
#pragma unroll
                for (int t = 0; t < 2; ++t)
#pragma unroll
                    for (int s = 0; s < 2; ++s) {
                        union { bf16x8 v; uint2 h[2]; } cv;
                        cv.h[0] = vfr[uu][t][s][0]; cv.h[1] = vfr[uu][t][s][1];
                        oacc[uu] = __builtin_amdgcn_mfma_f32_32x32x16_bf16(cv.v, pf[t][s], oacc[uu], 0, 0, 0);
                    }
        }
        }
        SWRITE(1, B);
        __syncthreads();
        if (ti0 + 1 >= ntiles) break;
        { const int tl_ = ti0 + 3 < ntiles ? ti0 + 3 : ntiles - 1; GLOAD(tl_, B); asm volatile("" ::: "memory"); }
        { const int ti = ti0 + 1; const int buf = 1;
        if (!NAT && ti == 4) { qf[NKS - 2] = qrot4; qf[NKS - 1] = qrot5; }
        const int kr = lt0 + ti - 4;
        const bool active = !NAT || ti < 4 || (kr >= r0w && kr < r0w + 8);
        if (active) {
            const bf16_t* kb = Ks + buf * 64 * KSTR + r32 * KSTR + hh * 8;
            f32x16 st0, st1;
#pragma unroll
            for (int r = 0; r < 16; ++r) { st0[r] = 0.f; st1[r] = 0.f; }
            bf16x8 kf0[NKS], kf1[NKS];
#pragma unroll
            for (int ks = 0; ks < NKS; ++ks) { kf0[ks] = *(const bf16x8*)(kb + ks * 16); kf1[ks] = *(const bf16x8*)(kb + 32 * KSTR + ks * 16); }
            asm volatile("s_waitcnt lgkmcnt(0)" ::: "memory");
#pragma unroll
            for (int ks = 0; ks < NKS; ++ks) {
                st0 = __builtin_amdgcn_mfma_f32_32x32x16_bf16(kf0[ks], qf[ks], st0, 0, 0, 0);
                st1 = __builtin_amdgcn_mfma_f32_32x32x16_bf16(kf1[ks], qf[ks], st1, 0, 0, 0);
            }
            const bf16_t* vb = Vs + buf * 64 * VSTR + r32 * VSTR + 4 * hh;
            uint2 vfr[2][2][2][2];
#pragma unroll
            for (int uu = 0; uu < 2; ++uu)
#pragma unroll
                for (int t = 0; t < 2; ++t)
#pragma unroll
                    for (int s2 = 0; s2 < 2; ++s2) {
                        const bf16_t* a = vb + uu * 32 * VSTR + t * 32 + s2 * 16;
                        vfr[uu][t][s2][0] = *(const uint2*)a; vfr[uu][t][s2][1] = *(const uint2*)(a + 8);
                    }
            float x[32];
#pragma unroll
            for (int r = 0; r < 16; ++r) { x[r] = st0[r]; x[16 + r] = st1[r]; }
            if (NAT && ti >= 4) {
                const int dr = kr - qr + 7;
#pragma unroll
                for (int e = 0; e < 32; ++e) {
                    const int r = e & 15, kc = (e >> 4) * 32 + (r & 3) + 8 * (r >> 2) + 4 * hh;
                    const int dc = min(max(kc - qc, -15), 15) + 15;
                    const bool ok = (kc >= c0) && (kc < c0 + 16);
                    x[e] = ok ? x[e] + rpb_s[dr * 31 + dc] : -1e30f;
                }
            }
            float mx = x[0];
#pragma unroll
            for (int e = 1; e < 32; ++e) mx = fmaxf(mx, x[e]);
            mx = fmaxf(mx, __shfl_xor(mx, 32));
            const float m_new = fmaxf(m_run, mx);
            const bool resc = __ballot(m_new > m_run) != 0ull;
            const float alpha = __builtin_amdgcn_exp2f(m_run - m_new);
            m_run = m_new;
            float ps = 0.f;
#pragma unroll
            for (int e = 0; e < 32; ++e) { x[e] = __builtin_amdgcn_exp2f(x[e] - m_new); ps += x[e]; }
            lsum = lsum * alpha + ps;
            if (resc) {
#pragma unroll
                for (int r = 0; r < 16; ++r) { oacc[0][r] *= alpha; oacc[1][r] *= alpha; }
            }
            bf16x8 pf[2][2];
#pragma unroll
            for (int t = 0; t < 2; ++t)
#pragma unroll
                for (int s = 0; s < 2; ++s) {
                    union { bf16x8 v; unsigned u[4]; } cv;
#pragma unroll
                    for (int q = 0; q < 4; ++q) cv.u[q] = cvt_pk(x[16 * t + 8 * s + 2 * q], x[16 * t + 8 * s + 2 * q + 1]);
                    pf[t][s] = cv.v;
                }
#pragma unroll
            for (int uu = 0; uu < 2; ++uu)
#pragma unroll
                for (int t = 0; t < 2; ++t)
#pragma unroll
                    for (int s = 0; s < 2; ++s) {
                        union { bf16x8 v; uint2 h[2]; } cv;
                        cv.h[0] = vfr[uu][t][s][0]; cv.h[1] = vfr[uu][t][s][1];
                        oacc[uu] = __builtin_amdgcn_mfma_f32_32x32x16_bf16(cv.v, pf[t][s], oacc[uu], 0, 0, 0);
                    }
        }
        }
        SWRITE(0, A);
        __syncthreads();
    }
#undef TILE_P
#undef GLOAD
#undef SWRITE
    lsum += __shfl_xor(lsum, 32);
    const float inv = 1.f / lsum;
    bf16_t* zrow = PB + (size_t)(rowbase + q_p0 + ql) * PW + C_Z + (NAT ? 512 : 0) + head * 64;
#pragma unroll
    for (int uu = 0; uu < 2; ++uu)
#pragma unroll
        for (int g = 0; g < 4; ++g) {
            bf16_t* zp = zrow + uu * 32 + 8 * g + 4 * hh;
            const uint2 z = *(const uint2*)zp;
            uint2 o;
            o.x = cvt_pk(oacc[uu][4 * g + 0] * inv * siluf_(lo16(z.x)), oacc[uu][4 * g + 1] * inv * siluf_(hi16(z.x)));
            o.y = cvt_pk(oacc[uu][4 * g + 2] * inv * siluf_(lo16(z.y)), oacc[uu][4 * g + 3] * inv * siluf_(hi16(z.y)));
            *(uint2*)zp = o;
        }
}

__device__ void scan_hg_item(const Params& P, int l, int item, unsigned char* smem) {
    const int tid = tid_opaque(), lane = tid & 63, wave = tid >> 6;
    const int slice = item & 7, dir = (item >> 3) & 1, head = (item >> 4) & 3, bl = item >> 6;
    float* a_s = (float*)smem;
    float* q_s = a_s + 64 * 128;
    float* v_s = q_s + 64 * 128;
    float* o_s = v_s + 64 * 16;
    const bf16_t* PB = (const bf16_t*)(P.ws + OFF_PB) + (size_t)bl * TB * PW;
    bf16_t* OS = (bf16_t*)(P.ws + OFF_KV) + ((size_t)dir * NTH + (size_t)bl * TB) * 512 + head * 128 + slice * 16;
    const int prow = tid >> 4, pd = (tid & 15) * 8;
    float lb[8];
#pragma unroll
    for (int e = 0; e < 8; ++e) {
        const int cidx = dir * 512 + head * 128 + pd + e;
        lb[e] = (l == 0) ? 0.f : sigmoidf_(P.lb_logits[1024 + cidx] - P.lb_logits[cidx]);
    }
    const int fcol = (dir ? C_HF + 512 : C_HF) + head * 128 + pd, qcol = C_HQ + head * 128 + pd, vcol = C_HI + head * 128 + slice * 16 + (tid & 1) * 8;
    uint4 rq[4], rf[4], rv;
    auto chunk_p = [&](int c) { const int ci = dir ? (c < 4 ? 3 - c : 135 - c) : c; return ci * 64; };
    auto gload = [&](int c) {
        const int p = chunk_p(c);
#pragma unroll
        for (int r = 0; r < 4; ++r) { const bf16_t* row = PB + (size_t)(p + prow + 16 * r) * PW; rq[r] = *(const uint4*)(row + qcol); rf[r] = *(const uint4*)(row + fcol); }
        if (tid < 128) rv = *(const uint4*)(PB + (size_t)(p + (tid >> 1)) * PW + vcol);
    };
    const int dg = lane & 15, col = wave * 4 + (lane >> 4);
    float S[8];
#pragma unroll
    for (int e = 0; e < 8; ++e) S[e] = 0.f;
    gload(0);
    for (int c = 0; c < 132; ++c) {
        __syncthreads();
#pragma unroll
        for (int r = 0; r < 4; ++r) {
            float fq[8], ff[8];
            unpack8(rq[r], fq); unpack8(rf[r], ff);
            float* ad = a_s + (prow + 16 * r) * 128 + pd; float* qd = q_s + (prow + 16 * r) * 128 + pd;
#pragma unroll
            for (int e = 0; e < 8; ++e) { ad[e] = lb[e] + (1.f - lb[e]) * sigmoidf_(ff[e]); qd[e] = siluf_(fq[e]) * 0.08838834764831845f; }
        }
        if (tid < 128) { float fv[8]; unpack8(rv, fv); float* vd = v_s + (tid >> 1) * 16 + (tid & 1) * 8;
#pragma unroll
            for (int e = 0; e < 8; ++e) vd[e] = fv[e]; }
        __syncthreads();
        if (c + 1 < 132) gload(c + 1);
        for (int tt = 0; tt < 64; tt += 8) {
            float op[8];
#pragma unroll
            for (int u = 0; u < 8; ++u) {
                const int i = dir ? 63 - (tt + u) : tt + u;
                const float4 a0 = *(const float4*)(a_s + i * 128 + dg * 8), a1 = *(const float4*)(a_s + i * 128 + dg * 8 + 4);
                const float4 q0 = *(const float4*)(q_s + i * 128 + dg * 8), q1 = *(const float4*)(q_s + i * 128 + dg * 8 + 4);
                const float v = v_s[i * 16 + col];
                float o;
                S[0] = fmaf(a0.x, S[0] - v, v); o = q0.x * S[0];
                S[1] = fmaf(a0.y, S[1] - v, v); o = fmaf(q0.y, S[1], o);
                S[2] = fmaf(a0.z, S[2] - v, v); o = fmaf(q0.z, S[2], o);
                S[3] = fmaf(a0.w, S[3] - v, v); o = fmaf(q0.w, S[3], o);
                S[4] = fmaf(a1.x, S[4] - v, v); o = fmaf(q1.x, S[4], o);
                S[5] = fmaf(a1.y, S[5] - v, v); o = fmaf(q1.y, S[5], o);
                S[6] = fmaf(a1.z, S[6] - v, v); o = fmaf(q1.z, S[6], o);
                S[7] = fmaf(a1.w, S[7] - v, v); o = fmaf(q1.w, S[7], o);
                op[u] = o;
            }
            float r4[4], r2[2];
            const bool b8 = dg & 8, b4 = dg & 4, b2 = dg & 2;
#pragma unroll
            for (int k = 0; k < 4; ++k) { const float snd = b8 ? op[k] : op[k + 4], kp = b8 ? op[k + 4] : op[k]; r4[k] = kp + __shfl_xor(snd, 8); }
#pragma unroll
            for (int k = 0; k < 2; ++k) { const float snd = b4 ? r4[k] : r4[k + 2], kp = b4 ? r4[k + 2] : r4[k]; r2[k] = kp + __shfl_xor(snd, 4); }
            float r1; { const float snd = b2 ? r2[0] : r2[1], kp = b2 ? r2[1] : r2[0]; r1 = kp + __shfl_xor(snd, 2); }
            r1 += __shfl_xor(r1, 1);
            if ((dg & 1) == 0) { const int tok = tt + (b8 ? 4 : 0) + (b4 ? 2 : 0) + (b2 ? 1 : 0); const int i = dir ? 63 - tok : tok; o_s[i * 16 + col] = r1; }
        }
        __syncthreads();
        if (tid < 128) {
            const int p = chunk_p(c) + (tid >> 1);
            *(uint4*)(OS + (size_t)p * 512 + (tid & 1) * 8) = pack8(o_s + (tid >> 1) * 16 + (tid & 1) * 8);
        }
    }
}

__device__ void scan_gla_item(const Params& P, int l, int item, unsigned char* smem) {
    const int tid = tid_opaque(), lane = tid & 63, wave = tid >> 6;
    const int slice = item & 3, dir = (item >> 2) & 1, head = (item >> 3) & 3, bl = item >> 5;
    float* a_s = (float*)smem;
    float* q_s = a_s + 64 * 64;
    float* k_s = q_s + 64 * 64;
    float* v_s = k_s + 64 * 64;
    float* o_s = v_s + 64 * 32;
    float* r_s = o_s + 64 * 32;
    const bf16_t* PB = (const bf16_t*)(P.ws + OFF_PB) + (size_t)bl * TB * PW;
    bf16_t* OS = (bf16_t*)(P.ws + OFF_OSG) + ((size_t)dir * NTH + (size_t)bl * TB) * 512 + head * 128 + slice * 32;
    const int gd = tid & 63, gt0 = tid >> 6;
    float w2[16];
#pragma unroll
    for (int jx = 0; jx < 16; ++jx) w2[jx] = P.gla_w2[((size_t)(l * 2 + dir) * 16 + jx) * 256 + head * 64 + gd];
    const float b2 = P.gla_b2[(l * 2 + dir) * 256 + head * 64 + gd];
    uint4 rq[2], rk[2], rv, rr;
    auto chunk_p = [&](int c) { const int ci = dir ? (c < 4 ? 3 - c : 135 - c) : c; return ci * 64; };
    auto gload = [&](int c) {
        const int p = chunk_p(c);
#pragma unroll
        for (int i = 0; i < 2; ++i) { const int id = tid + 256 * i, row = id >> 3, ch = id & 7; const bf16_t* rp = PB + (size_t)(p + row) * PW;
            rq[i] = *(const uint4*)(rp + C_GQ + head * 64 + ch * 8); rk[i] = *(const uint4*)(rp + C_GK + head * 64 + ch * 8); }
        { const int row = tid >> 2, ch = tid & 3; rv = *(const uint4*)(PB + (size_t)(p + row) * PW + C_GV + head * 128 + slice * 32 + ch * 8); }
        if (tid < 128) { const int row = tid >> 1, ch = tid & 1; rr = *(const uint4*)(PB + (size_t)(p + row) * PW + C_GR + dir * 16 + ch * 8); }
    };
    const int dg = lane & 7, col = wave * 8 + (lane >> 3);
    float S[8];
#pragma unroll
    for (int e = 0; e < 8; ++e) S[e] = 0.f;
    gload(0);
    for (int c = 0; c < 132; ++c) {
        __syncthreads();
#pragma unroll
        for (int i = 0; i < 2; ++i) { const int id = tid + 256 * i, row = id >> 3, ch = id & 7; float fq[8], fk[8]; unpack8(rq[i], fq); unpack8(rk[i], fk);
#pragma unroll
            for (int e = 0; e < 8; ++e) { q_s[row * 64 + ch * 8 + e] = fq[e] * 0.125f; k_s[row * 64 + ch * 8 + e] = fk[e]; } }
        { const int row = tid >> 2, ch = tid & 3; float fv[8]; unpack8(rv, fv);
#pragma unroll
            for (int e = 0; e < 8; ++e) v_s[row * 32 + ch * 8 + e] = fv[e]; }
        if (tid < 128) { const int row = tid >> 1, ch = tid & 1; float fr[8]; unpack8(rr, fr);
#pragma unroll
            for (int e = 0; e < 8; ++e) r_s[row * 16 + ch * 8 + e] = fr[e]; }
        __syncthreads();
        if (c + 1 < 132) gload(c + 1);
#pragma unroll 4
        for (int m = 0; m < 16; ++m) {
            const int i = gt0 + 4 * m;
            float g = b2;
#pragma unroll
            for (int jx = 0; jx < 16; ++jx) g = fmaf(r_s[i * 16 + jx], w2[jx], g);
            const float ls = fminf(g, 0.f) - __logf(1.f + __expf(-fabsf(g)));
            a_s[i * 64 + gd] = __expf(ls * 0.0625f);
        }
        __syncthreads();
        for (int tt = 0; tt < 64; tt += 8) {
            float op[8];
#pragma unroll
            for (int u = 0; u < 8; ++u) {
                const int i = dir ? 63 - (tt + u) : tt + u;
                const float4 a0 = *(const float4*)(a_s + i * 64 + dg * 8), a1 = *(const float4*)(a_s + i * 64 + dg * 8 + 4);
                const float4 q0 = *(const float4*)(q_s + i * 64 + dg * 8), q1 = *(const float4*)(q_s + i * 64 + dg * 8 + 4);
                const float4 k0 = *(const float4*)(k_s + i * 64 + dg * 8), k1 = *(const float4*)(k_s + i * 64 + dg * 8 + 4);
                const float v = v_s[i * 32 + col];
                float o;
                S[0] = fmaf(a0.x, S[0], k0.x * v); o = q0.x * S[0];
                S[1] = fmaf(a0.y, S[1], k0.y * v); o = fmaf(q0.y, S[1], o);
                S[2] = fmaf(a0.z, S[2], k0.z * v); o = fmaf(q0.z, S[2], o);
                S[3] = fmaf(a0.w, S[3], k0.w * v); o = fmaf(q0.w, S[3], o);
                S[4] = fmaf(a1.x, S[4], k1.x * v); o = fmaf(q1.x, S[4], o);
                S[5] = fmaf(a1.y, S[5], k1.y * v); o = fmaf(q1.y, S[5], o);
                S[6] = fmaf(a1.z, S[6], k1.z * v); o = fmaf(q1.z, S[6], o);
                S[7] = fmaf(a1.w, S[7], k1.w * v); o = fmaf(q1.w, S[7], o);
                op[u] = o;
            }
            float r4[4], r2[2];
            const bool b4 = dg & 4, b2 = dg & 2, b1 = dg & 1;
#pragma unroll
            for (int k = 0; k < 4; ++k) { const float snd = b4 ? op[k] : op[k + 4], kp = b4 ? op[k + 4] : op[k]; r4[k] = kp + __shfl_xor(snd, 4); }
#pragma unroll
            for (int k = 0; k < 2; ++k) { const float snd = b2 ? r4[k] : r4[k + 2], kp = b2 ? r4[k + 2] : r4[k]; r2[k] = kp + __shfl_xor(snd, 2); }
            float r1; { const float snd = b1 ? r2[0] : r2[1], kp = b1 ? r2[1] : r2[0]; r1 = kp + __shfl_xor(snd, 1); }
            { const int tok = tt + (b4 ? 4 : 0) + (b2 ? 2 : 0) + (b1 ? 1 : 0); const int i = dir ? 63 - tok : tok; o_s[i * 32 + col] = r1; }
        }
        __syncthreads();
        { const int row = tid >> 2, ch = tid & 3; const int p = chunk_p(c) + row;
          *(uint4*)(OS + (size_t)p * 512 + ch * 8) = pack8(o_s + row * 32 + ch * 8); }
    }
}


template <bool GLA>
__device__ void scan2_item(const Params& P, int l, int item, unsigned char* smem) {
    constexpr int DK = GLA ? 64 : 128, NT = DK / 32, QS = DK + 8, TS = 40, NSEG = GLA ? 4 : 2, TPS = 32 / NSEG, QCH = DK / 8;
    const int tid = tid_opaque(), lane = tid & 63, wave = tid >> 6, r32 = lane & 31, hh = lane >> 5;
    const int dir = item & 1, head = (item >> 1) & 3, bl = item >> 3;
    bf16_t* Qh = (bf16_t*)smem;
    bf16_t* Kh = Qh + 32 * QS;
    bf16_t* Kt = Kh + 32 * QS;
    bf16_t* Vt = Kt + DK * TS;
    float* eb = (float*)(Vt + 128 * TS);
    float* tot = eb + DK;
    bf16_t* qraw = (bf16_t*)(tot + 4 * DK);
    bf16_t* fraw = qraw + 32 * DK;
    bf16_t* vraw = fraw + 32 * DK;
    bf16_t* rraw = vraw + 32 * 128;
    const bf16_t* PB = (const bf16_t*)(P.ws + OFF_PB) + (size_t)bl * TB * PW;
    bf16_t* OS = (bf16_t*)(P.ws + (GLA ? OFF_OSG : OFF_KV)) + ((size_t)dir * NTH + (size_t)bl * TB) * 512 + head * 128 + wave * 32;
    const int qcol = (GLA ? C_GQ : C_HQ) + head * DK, fcol = GLA ? (C_GK + head * 64) : ((dir ? C_HF + 512 : C_HF) + head * 128),
              vcol = (GLA ? C_GV : C_HI) + head * 128, rcol = C_GR + dir * 16;
    const int pd = tid & (DK - 1), seg = tid / DK;
    float lbv = 0.f, b2 = 0.f, w2[16];
#pragma unroll
    for (int jx = 0; jx < 16; ++jx) w2[jx] = 0.f;
    if (GLA) {
#pragma unroll
        for (int jx = 0; jx < 16; ++jx) w2[jx] = P.gla_w2[((size_t)(l * 2 + dir) * 16 + jx) * 256 + head * 64 + pd];
        b2 = P.gla_b2[(l * 2 + dir) * 256 + head * 64 + pd];
    } else if (l != 0) { const int cidx = dir * 512 + head * 128 + pd; lbv = sigmoidf_(P.lb_logits[1024 + cidx] - P.lb_logits[cidx]); }
    uint4 pq0, pq1, pf0, pf1, pv0, pv1, pr;
    pq1 = pf1 = pr = make_uint4(0, 0, 0, 0);
#define CH_P0(c) (dir ? ((c) < 8 ? (7 - (c)) * 32 : CTXL + (263 - (c)) * 32) : (c) * 32)
#define ROWP(p0_, i_) ((p0_) + (dir ? 31 - (i_) : (i_)))
#define SC_GLOAD(c) { const int p0_ = CH_P0(c); \
        { const int id = tid, i = id / QCH, ch = id % QCH; const bf16_t* rp = PB + (size_t)ROWP(p0_, i) * PW; pq0 = *(const uint4*)(rp + qcol + ch * 8); pf0 = *(const uint4*)(rp + fcol + ch * 8); } \
        if (!GLA) { const int id = tid + 256, i = id / QCH, ch = id % QCH; const bf16_t* rp = PB + (size_t)ROWP(p0_, i) * PW; pq1 = *(const uint4*)(rp + qcol + ch * 8); pf1 = *(const uint4*)(rp + fcol + ch * 8); } \
        { const int i = tid >> 4, ch = tid & 15; pv0 = *(const uint4*)(PB + (size_t)ROWP(p0_, i) * PW + vcol + ch * 8); pv1 = *(const uint4*)(PB + (size_t)ROWP(p0_, i + 16) * PW + vcol + ch * 8); } \
        if (GLA && tid < 64) { const int i = tid >> 1, ch = tid & 1; pr = *(const uint4*)(PB + (size_t)ROWP(p0_, i) * PW + rcol + ch * 8); } }
    f32x16 ST[NT];
#pragma unroll
    for (int T = 0; T < NT; ++T)
#pragma unroll
        for (int r = 0; r < 16; ++r) ST[T][r] = 0.f;
    SC_GLOAD(0);
    for (int c = 0; c < 264; ++c) {
        __syncthreads();
        { const int id = tid, i = id / QCH, ch = id % QCH; *(uint4*)(qraw + i * DK + ch * 8) = pq0; *(uint4*)(fraw + i * DK + ch * 8) = pf0; }
        if (!GLA) { const int id = tid + 256, i = id / QCH, ch = id % QCH; *(uint4*)(qraw + i * DK + ch * 8) = pq1; *(uint4*)(fraw + i * DK + ch * 8) = pf1; }
        { const int i = tid >> 4, ch = tid & 15; *(uint4*)(vraw + i * 128 + ch * 8) = pv0; *(uint4*)(vraw + (i + 16) * 128 + ch * 8) = pv1; }
        if (GLA && tid < 64) { const int i = tid >> 1, ch = tid & 1; *(uint4*)(rraw + i * 16 + ch * 8) = pr; }
        __syncthreads();
        if (c + 1 < 264) SC_GLOAD(c + 1);
        float bl_[TPS], kk[TPS], qq[TPS];
        float cum = 0.f;
#pragma unroll
        for (int tt = 0; tt < TPS; ++tt) {
            const int i = seg * TPS + tt;
            float la;
            if (GLA) {
                float g = b2;
#pragma unroll
                for (int jx = 0; jx < 16; ++jx) g = fmaf(bf2f(rraw[i * 16 + jx]), w2[jx], g);
                la = (fminf(g, 0.f) - __logf(1.f + __expf(-fabsf(g)))) * 0.0625f;
                kk[tt] = bf2f(fraw[i * DK + pd]);
                qq[tt] = bf2f(qraw[i * DK + pd]) * 0.125f;
            } else {
                const float f = bf2f(fraw[i * DK + pd]);
                const float a = lbv + (1.f - lbv) * sigmoidf_(f);
                la = __logf(a);
                kk[tt] = 1.f - a;
                qq[tt] = siluf_(bf2f(qraw[i * DK + pd])) * 0.08838834764831845f;
            }
            cum += la;
            bl_[tt] = cum;
        }
        tot[seg * DK + pd] = cum;
        __syncthreads();
        {
            float off = 0.f, bend = 0.f;
#pragma unroll
            for (int sg = 0; sg < NSEG; ++sg) { const float tv = tot[sg * DK + pd]; bend += tv; if (sg < seg) off += tv; }
            const float eend = __expf(bend);
            if (seg == 0) eb[pd] = eend;
            float kt[TPS];
#pragma unroll
            for (int tt = 0; tt < TPS; ++tt) {
                const int i = seg * TPS + tt;
                const float b = bl_[tt] + off;
                const float e1 = __expf(b), e2 = __expf(-b);
                const float kh = kk[tt] * e2;
                Qh[i * QS + pd] = f2bf(qq[tt] * e1);
                Kh[i * QS + pd] = f2bf(kh);
                kt[tt] = kh * eend;
            }
#pragma unroll
            for (int g8 = 0; g8 < TPS / 8; ++g8) *(uint4*)(Kt + pd * TS + seg * TPS + g8 * 8) = pack8(kt + g8 * 8);
            const int vc = tid & 127, vs = tid >> 7;
            float vv[16];
#pragma unroll
            for (int tt = 0; tt < 16; ++tt) vv[tt] = bf2f(vraw[(vs * 16 + tt) * 128 + vc]);
            *(uint4*)(Vt + vc * TS + vs * 16) = pack8(vv);
            *(uint4*)(Vt + vc * TS + vs * 16 + 8) = pack8(vv + 8);
        }
        __syncthreads();
        f32x16 st;
#pragma unroll
        for (int r = 0; r < 16; ++r) st[r] = 0.f;
#pragma unroll
        for (int ks = 0; ks < DK / 16; ++ks) {
            const bf16x8 ka = *(const bf16x8*)(Kh + r32 * QS + ks * 16 + hh * 8);
            const bf16x8 qb = *(const bf16x8*)(Qh + r32 * QS + ks * 16 + hh * 8);
            st = __builtin_amdgcn_mfma_f32_32x32x16_bf16(ka, qb, st, 0, 0, 0);
        }
        bf16x8 pfr[2];
#pragma unroll
        for (int sI = 0; sI < 2; ++sI) {
            union { bf16x8 v; unsigned u[4]; } cv;
#pragma unroll
            for (int q = 0; q < 4; ++q) {
                const int ra = 8 * sI + 2 * q, rb = ra + 1;
                const int ja = (ra & 3) + 8 * (ra >> 2) + 4 * hh, jb = (rb & 3) + 8 * (rb >> 2) + 4 * hh;
                cv.u[q] = cvt_pk(ja <= r32 ? st[ra] : 0.f, jb <= r32 ? st[rb] : 0.f);
            }
            pfr[sI] = cv.v;
        }
        f32x16 oT;
#pragma unroll
        for (int r = 0; r < 16; ++r) oT[r] = 0.f;
#pragma unroll
        for (int sI = 0; sI < 2; ++sI) {
            const bf16_t* a = Vt + (wave * 32 + r32) * TS + sI * 16 + 4 * hh;
            union { bf16x8 v; uint2 h[2]; } cv;
            cv.h[0] = *(const uint2*)a; cv.h[1] = *(const uint2*)(a + 8);
            oT = __builtin_amdgcn_mfma_f32_32x32x16_bf16(cv.v, pfr[sI], oT, 0, 0, 0);
        }
#pragma unroll
        for (int T = 0; T < NT; ++T)
#pragma unroll
            for (int sI = 0; sI < 2; ++sI) {
                union { bf16x8 v; unsigned u[4]; } ca;
#pragma unroll
                for (int q = 0; q < 4; ++q) ca.u[q] = cvt_pk(ST[T][8 * sI + 2 * q], ST[T][8 * sI + 2 * q + 1]);
                const bf16_t* b = Qh + r32 * QS + T * 32 + sI * 16 + 4 * hh;
                union { bf16x8 v; uint2 h[2]; } cb;
                cb.h[0] = *(const uint2*)b; cb.h[1] = *(const uint2*)(b + 8);
                oT = __builtin_amdgcn_mfma_f32_32x32x16_bf16(ca.v, cb.v, oT, 0, 0, 0);
            }
#pragma unroll
        for (int T = 0; T < NT; ++T) {
#pragma unroll
            for (int g = 0; g < 4; ++g) {
                const float4 e4 = *(const float4*)(eb + T * 32 + 8 * g + 4 * hh);
                ST[T][4 * g + 0] *= e4.x; ST[T][4 * g + 1] *= e4.y; ST[T][4 * g + 2] *= e4.z; ST[T][4 * g + 3] *= e4.w;
            }
#pragma unroll
            for (int ks = 0; ks < 2; ++ks) {
                const bf16x8 ka = *(const bf16x8*)(Kt + (T * 32 + r32) * TS + ks * 16 + hh * 8);
                const bf16x8 vb = *(const bf16x8*)(Vt + (wave * 32 + r32) * TS + ks * 16 + hh * 8);
                ST[T] = __builtin_amdgcn_mfma_f32_32x32x16_bf16(ka, vb, ST[T], 0, 0, 0);
            }
        }
        {
            const int p = ROWP(CH_P0(c), r32);
            bf16_t* op = OS + (size_t)p * 512 + 4 * hh;
#pragma unroll
            for (int g = 0; g < 4; ++g) { uint2 o; o.x = cvt_pk(oT[4 * g], oT[4 * g + 1]); o.y = cvt_pk(oT[4 * g + 2], oT[4 * g + 3]); *(uint2*)(op + 8 * g) = o; }
        }
    }
#undef CH_P0
#undef ROWP
#undef SC_GLOAD
}


template <bool GLA>
__device__ __forceinline__ void scan3_rest(f32x16 (&ST)[GLA ? 2 : 4], bf16_t* Qh, bf16_t* Kh, bf16_t* Kt, bf16_t* Vt, float* eb, bf16_t* vraw, bf16_t* OS,
                                           int tid, int wave, int r32, int hh, int pd, int seg, int c, int dir) {
    constexpr int DK = GLA ? 64 : 128, NT = DK / 32, QS = DK + 8, TS = 40, NSEG = GLA ? 4 : 2, TPS = 32 / NSEG;
#define CH_P0(c) (dir ? ((c) < 8 ? (7 - (c)) * 32 : CTXL + (263 - (c)) * 32) : (c) * 32)
#define ROWP(p0_, i_) ((p0_) + (dir ? 31 - (i_) : (i_)))
        {
            const float eend = eb[pd];
            float kt[TPS];
#pragma unroll
            for (int tt = 0; tt < TPS; ++tt) kt[tt] = bf2f(Kh[(seg * TPS + tt) * QS + pd]) * eend;
#pragma unroll
            for (int g8 = 0; g8 < TPS / 8; ++g8) *(uint4*)(Kt + pd * TS + seg * TPS + g8 * 8) = pack8(kt + g8 * 8);
            const int vc = tid & 127, vs = tid >> 7;
            float vv[16];
#pragma unroll
            for (int tt = 0; tt < 16; ++tt) vv[tt] = bf2f(vraw[(vs * 16 + tt) * 128 + vc]);
            *(uint4*)(Vt + vc * TS + vs * 16) = pack8(vv);
            *(uint4*)(Vt + vc * TS + vs * 16 + 8) = pack8(vv + 8);
        }
        __syncthreads();
        f32x16 st, stb;
#pragma unroll
        for (int r = 0; r < 16; ++r) { st[r] = 0.f; stb[r] = 0.f; }
        {
            bf16x8 ka[DK / 16], qb[DK / 16];
#pragma unroll
            for (int ks = 0; ks < DK / 16; ++ks) { ka[ks] = *(const bf16x8*)(Kh + r32 * QS + ks * 16 + hh * 8); qb[ks] = *(const bf16x8*)(Qh + r32 * QS + ks * 16 + hh * 8); }
            asm volatile("s_waitcnt lgkmcnt(0)" ::: "memory");
#pragma unroll
            for (int ks = 0; ks < DK / 16; ks += 2) {
                st = __builtin_amdgcn_mfma_f32_32x32x16_bf16(ka[ks], qb[ks], st, 0, 0, 0);
                stb = __builtin_amdgcn_mfma_f32_32x32x16_bf16(ka[ks + 1], qb[ks + 1], stb, 0, 0, 0);
            }
        }
        uint2 vp[2][2], qp[NT][2][2];
#pragma unroll
        for (int sI = 0; sI < 2; ++sI) { const bf16_t* av = Vt + (wave * 32 + r32) * TS + sI * 16 + 4 * hh; vp[sI][0] = *(const uint2*)av; vp[sI][1] = *(const uint2*)(av + 8); }
#pragma unroll
        for (int T = 0; T < NT; ++T)
#pragma unroll
            for (int sI = 0; sI < 2; ++sI) { const bf16_t* bq = Qh + r32 * QS + T * 32 + sI * 16 + 4 * hh; qp[T][sI][0] = *(const uint2*)bq; qp[T][sI][1] = *(const uint2*)(bq + 8); }
#pragma unroll
        for (int r = 0; r < 16; ++r) st[r] += stb[r];
        bf16x8 pfr[2];
#pragma unroll
        for (int sI = 0; sI < 2; ++sI) {
            union { bf16x8 v; unsigned u[4]; } cv;
#pragma unroll
            for (int q = 0; q < 4; ++q) {
                const int ra = 8 * sI + 2 * q, rb = ra + 1;
                const int ja = (ra & 3) + 8 * (ra >> 2) + 4 * hh, jb = (rb & 3) + 8 * (rb >> 2) + 4 * hh;
                cv.u[q] = cvt_pk(ja <= r32 ? st[ra] : 0.f, jb <= r32 ? st[rb] : 0.f);
            }
            pfr[sI] = cv.v;
        }
        asm volatile("s_waitcnt lgkmcnt(0)" ::: "memory");
        f32x16 oT, oTb;
#pragma unroll
        for (int r = 0; r < 16; ++r) { oT[r] = 0.f; oTb[r] = 0.f; }
#pragma unroll
        for (int sI = 0; sI < 2; ++sI) {
            union { bf16x8 v; uint2 h[2]; } cv;
            cv.h[0] = vp[sI][0]; cv.h[1] = vp[sI][1];
            oT = __builtin_amdgcn_mfma_f32_32x32x16_bf16(cv.v, pfr[sI], oT, 0, 0, 0);
        }
#pragma unroll
        for (int T = 0; T < NT; ++T)
#pragma unroll
            for (int sI = 0; sI < 2; ++sI) {
                union { bf16x8 v; unsigned u[4]; } ca;
#pragma unroll
                for (int q = 0; q < 4; ++q) ca.u[q] = cvt_pk(ST[T][8 * sI + 2 * q], ST[T][8 * sI + 2 * q + 1]);
                union { bf16x8 v; uint2 h[2]; } cb;
                cb.h[0] = qp[T][sI][0]; cb.h[1] = qp[T][sI][1];
                if (T & 1) oTb = __builtin_amdgcn_mfma_f32_32x32x16_bf16(ca.v, cb.v, oTb, 0, 0, 0);
                else oT = __builtin_amdgcn_mfma_f32_32x32x16_bf16(ca.v, cb.v, oT, 0, 0, 0);
            }
        {
            bf16x8 kt2[NT][2], vb2[2];
            float4 e4v[NT][4];
#pragma unroll
            for (int ks = 0; ks < 2; ++ks) vb2[ks] = *(const bf16x8*)(Vt + (wave * 32 + r32) * TS + ks * 16 + hh * 8);
#pragma unroll
            for (int T = 0; T < NT; ++T) {
#pragma unroll
                for (int ks = 0; ks < 2; ++ks) kt2[T][ks] = *(const bf16x8*)(Kt + (T * 32 + r32) * TS + ks * 16 + hh * 8);
#pragma unroll
                for (int g = 0; g < 4; ++g) e4v[T][g] = *(const float4*)(eb + T * 32 + 8 * g + 4 * hh);
            }
            asm volatile("s_waitcnt lgkmcnt(0)" ::: "memory");
#pragma unroll
            for (int T = 0; T < NT; ++T) {
#pragma unroll
                for (int g = 0; g < 4; ++g) { ST[T][4 * g + 0] *= e4v[T][g].x; ST[T][4 * g + 1] *= e4v[T][g].y; ST[T][4 * g + 2] *= e4v[T][g].z; ST[T][4 * g + 3] *= e4v[T][g].w; }
#pragma unroll
                for (int ks = 0; ks < 2; ++ks) ST[T] = __builtin_amdgcn_mfma_f32_32x32x16_bf16(kt2[T][ks], vb2[ks], ST[T], 0, 0, 0);
            }
        }
#pragma unroll
        for (int r = 0; r < 16; ++r) oT[r] += oTb[r];
        {
            const int p = ROWP(CH_P0(c), r32);
            bf16_t* op = OS + (size_t)p * 512 + 4 * hh;
#pragma unroll
            for (int g = 0; g < 4; ++g) { uint2 o; o.x = cvt_pk(oT[4 * g], oT[4 * g + 1]); o.y = cvt_pk(oT[4 * g + 2], oT[4 * g + 3]); *(uint2*)(op + 8 * g) = o; }
        }
#undef CH_P0
#undef ROWP
}

template <bool GLA>
__device__ void scan3_item(const Params& P, int l, int item, unsigned char* smem) {
    constexpr int DK = GLA ? 64 : 128, NT = DK / 32, QS = DK + 8, TS = 40, NSEG = GLA ? 4 : 2, TPS = 32 / NSEG, QCH = DK / 8;
    const int tid = tid_opaque(), lane = tid & 63, wave = tid >> 6, r32 = lane & 31, hh = lane >> 5;
    const int dir = item & 1, head = (item >> 1) & 3, bl = item >> 3;
    __builtin_amdgcn_s_setprio(3);
    bf16_t* Qh = (bf16_t*)smem;
    bf16_t* Kh = Qh + 32 * QS;
    bf16_t* Kt = Kh + 32 * QS;
    bf16_t* Vt = Kt + DK * TS;
    float* eb = (float*)(Vt + 128 * TS);
    bf16_t* vraw = (bf16_t*)(eb + DK);
    const bf16_t* PB = (const bf16_t*)(P.ws + OFF_PB) + (size_t)bl * TB * PW;
    bf16_t* OS = (bf16_t*)(P.ws + (GLA ? OFF_OSG : OFF_KV)) + ((size_t)dir * NTH + (size_t)bl * TB) * 512 + head * 128 + wave * 32;
    const bf16_t* qsrc; const bf16_t* ksrc; int qld, kld;
    if (GLA) {
        if (dir == 0) { qsrc = PB + C_GQ + head * 64; qld = PW; ksrc = PB + C_GK + head * 64; kld = PW; }
        else { const bf16_t* X = (const bf16_t*)(P.ws + OFF_XG) + (size_t)bl * TB * 512; qsrc = X + head * 64; qld = 512; ksrc = X + 256 + head * 64; kld = 512; }
    } else {
        if (dir == 0) { qsrc = PB + C_HQ + head * 128; qld = PW; ksrc = PB + C_HF + head * 128; kld = PW; }
        else { qsrc = (const bf16_t*)(P.ws + OFF_XH) + (size_t)bl * TB * 512 + head * 128; qld = 512; ksrc = PB + C_HF + 512 + head * 128; kld = PW; }
    }
    const float* ebsrc = (const float*)(P.ws + (GLA ? OFF_EBG : OFF_EBH)) + ((size_t)(bl * 264) * 2 + dir) * (4 * DK) + head * DK;
    const int vcol = (GLA ? C_GV : C_HI) + head * 128;
    const int pd = tid & (DK - 1), seg = tid / DK;
    uint4 pq0A, pq1A, pk0A, pk1A, pv0A, pv1A, pq0B, pq1B, pk0B, pk1B, pv0B, pv1B; float peA = 0.f, peB = 0.f;
    pq1A = pk1A = pq1B = pk1B = make_uint4(0, 0, 0, 0);
#define CH_P0(c) (dir ? ((c) < 8 ? (7 - (c)) * 32 : CTXL + (263 - (c)) * 32) : (c) * 32)
#define ROWP(p0_, i_) ((p0_) + (dir ? 31 - (i_) : (i_)))
#define SC_GLOAD(c, S) { const int p0_ = CH_P0(c); \
        { const int id = tid, i = id / QCH, ch = id % QCH; const size_t rr_ = (size_t)ROWP(p0_, i); pq0##S = *(const uint4*)(qsrc + rr_ * qld + ch * 8); pk0##S = *(const uint4*)(ksrc + rr_ * kld + ch * 8); } \
        if (!GLA) { const int id = tid + 256, i = id / QCH, ch = id % QCH; const size_t rr_ = (size_t)ROWP(p0_, i); pq1##S = *(const uint4*)(qsrc + rr_ * qld + ch * 8); pk1##S = *(const uint4*)(ksrc + rr_ * kld + ch * 8); } \
        { const int i = tid >> 4, ch = tid & 15; pv0##S = *(const uint4*)(PB + (size_t)ROWP(p0_, i) * PW + vcol + ch * 8); pv1##S = *(const uint4*)(PB + (size_t)ROWP(p0_, i + 16) * PW + vcol + ch * 8); } \
        if (tid < DK) pe##S = ebsrc[(size_t)(p0_ >> 5) * 2 * (4 * DK) + tid]; }
    f32x16 ST[NT];
#pragma unroll
    for (int T = 0; T < NT; ++T)
#pragma unroll
        for (int r = 0; r < 16; ++r) ST[T][r] = 0.f;
#define SC_COPY(S) { \
        { const int id = tid, i = id / QCH, ch = id % QCH; *(uint4*)(Qh + i * QS + ch * 8) = pq0##S; *(uint4*)(Kh + i * QS + ch * 8) = pk0##S; } \
        if (!GLA) { const int id = tid + 256, i = id / QCH, ch = id % QCH; *(uint4*)(Qh + i * QS + ch * 8) = pq1##S; *(uint4*)(Kh + i * QS + ch * 8) = pk1##S; } \
        { const int i = tid >> 4, ch = tid & 15; *(uint4*)(vraw + i * 128 + ch * 8) = pv0##S; *(uint4*)(vraw + (i + 16) * 128 + ch * 8) = pv1##S; } \
        if (tid < DK) eb[tid] = pe##S; }
    SC_GLOAD(0, A);
    SC_GLOAD(1, B);
    for (int c = 0; c < 264; c += 2) {
        __syncthreads();
        SC_COPY(A);
        __syncthreads();
        { const int cl_ = c + 2 < 264 ? c + 2 : 263; SC_GLOAD(cl_, A); asm volatile("" ::: "memory"); }
        scan3_rest<GLA>(ST, Qh, Kh, Kt, Vt, eb, vraw, OS, tid, wave, r32, hh, pd, seg, c, dir);
        __syncthreads();
        SC_COPY(B);
        __syncthreads();
        { const int cl_ = c + 3 < 264 ? c + 3 : 263; SC_GLOAD(cl_, B); asm volatile("" ::: "memory"); }
        scan3_rest<GLA>(ST, Qh, Kh, Kt, Vt, eb, vraw, OS, tid, wave, r32, hh, pd, seg, c + 1, dir);
    }
#undef SC_COPY
#undef CH_P0
#undef ROWP
#undef SC_GLOAD
    __builtin_amdgcn_s_setprio(0);
}

#ifdef ONLYI
#define IT_ON(n) (ONLYI == (n))
#else
#define IT_ON(n) true
#endif
__device__ void phase_mixers(const Params& P, int ph, int l, unsigned char* smem, int mode = 0) {
    constexpr int N_HG = 16, N_GLA = 16, N_ATT = 2 * 8 * 66;
    const int bx = blockIdx.x;
    int my_scan = -1;
    if (mode != 2 && bx < 256 && (bx & 7) == ((bx >> 3) & 7)) my_scan = bx >> 3;
    if (mode == 0 && bx >= 256 && ((bx - 256) & 7) == (((bx - 256) >> 3) & 7)) return;
    for (;;) {
        int it;
        if (my_scan >= 0) { it = my_scan; my_scan = -1; }
        else {
            if (mode == 1) break;
            it = next_item(P, ph) + N_HG + N_GLA;
        }
        if (it >= N_HG + N_GLA + 2 * N_ATT) break;
        if (it < N_HG) { if (IT_ON(0)) scan3_item<false>(P, l, it, smem); continue; }
        it -= N_HG;
        if (it < N_GLA) { if (IT_ON(1)) scan3_item<true>(P, l, it, smem); continue; }
        it -= N_GLA;
        if (it < N_ATT) { const int bl = it / 528, rem = it % 528; if (IT_ON(2)) attn_item<96, false>(P, l, bl, rem / 66, rem % 66, smem); continue; }
        it -= N_ATT;
        { const int bl = it / 528, rem = it % 528; if (IT_ON(3)) attn_item<64, true>(P, l, bl, rem / 66, rem % 66, smem); }
    }
}

__device__ void phase_scanfin(const Params& P, int ph, int l) {
    const int tid = tid_opaque(), lane = tid & 63, wave = tid >> 6;
    bf16_t* PB = (bf16_t*)(P.ws + OFF_PB);
    const bf16_t* OSH = (const bf16_t*)(P.ws + OFF_KV);
    const bf16_t* OSGp = (const bf16_t*)(P.ws + OFF_OSG);
    float gh[8], gg[8];
#pragma unroll
    for (int e = 0; e < 8; ++e) { gh[e] = P.hg_g_o[l * 128 + (lane & 15) * 8 + e]; gg[e] = P.gla_g_o[l * 128 + (lane & 15) * 8 + e]; }
    for (;;) {
        const int u = next_item(P, ph);
        if (u >= NTH / 16) break;
        uint4 ra[8], rb[8], rz[8];
#pragma unroll
        for (int k = 0; k < 8; ++k) {
            const int t = u * 16 + wave * 4 + (k >> 1), mx = k & 1;
            const bf16_t* OS = mx ? OSGp : OSH;
            ra[k] = *(const uint4*)(OS + (size_t)t * 512 + lane * 8);
            rb[k] = *(const uint4*)(OS + ((size_t)NTH + t) * 512 + lane * 8);
            rz[k] = *(const uint4*)(PB + (size_t)t * PW + C_Z + (2 + mx) * 512 + lane * 8);
        }
#pragma unroll
        for (int k = 0; k < 8; ++k) {
            const int t = u * 16 + wave * 4 + (k >> 1), mx = k & 1;
            float a[8], b[8], z[8];
            unpack8(ra[k], a); unpack8(rb[k], b); unpack8(rz[k], z);
            float ss = 0.f;
#pragma unroll
            for (int e = 0; e < 8; ++e) { a[e] += b[e]; ss += a[e] * a[e]; }
            ss += __shfl_xor(ss, 1); ss += __shfl_xor(ss, 2); ss += __shfl_xor(ss, 4); ss += __shfl_xor(ss, 8);
            const float rn = rsqrtf(ss * (1.f / 128.f) + EPS);
#pragma unroll
            for (int e = 0; e < 8; ++e) a[e] = a[e] * rn * (mx ? gg[e] : gh[e]) * siluf_(z[e]);
            *(uint4*)(PB + (size_t)t * PW + C_Z + (2 + mx) * 512 + lane * 8) = pack8(a);
        }
    }
}

__device__ void phase_merge(const Params& P, int ph, int l, unsigned char* smem) {
    const int tid_ = tid_opaque(), lane = tid_ & 63, wave = tid_ >> 6, wr = wave >> 1, wc = wave & 1;
    const bf16_t* H = (const bf16_t*)(P.ws + OFF_H);
    const bf16_t* PB = (const bf16_t*)(P.ws + OFF_PB);
    bf16_t* ACC = (bf16_t*)(P.ws + OFF_KV);
    for (;;) {
        const int u = next_item(P, ph);
        if (u >= 132 * 16) break;
        const int mt = u >> 4, nt = u & 15;
        const int col = nt * 64 + wc * 32 + (lane & 31);
        f32x16 tot[2];
#pragma unroll
        for (int r = 0; r < 16; ++r) { tot[0][r] = 0.f; tot[1][r] = 0.f; }
        for (int br = 0; br < 4; ++br) {
            unsigned gate[2][8];
            f32x16 g[2], pa[2];
#pragma unroll
            for (int r = 0; r < 16; ++r) { g[0][r] = 0.f; g[1][r] = 0.f; pa[0][r] = 0.f; pa[1][r] = 0.f; }
            gemm_pair_n64(g, pa, H + (size_t)mt * 128 * D, D, (const bf16_t*)(P.ws + OFF_WM) + ((size_t)(l * 4 + br) * 1024 + nt * 64) * 1024, 1024, 1024,
                          PB + (size_t)mt * 128 * PW + C_Z + br * 512, PW, (const bf16_t*)(P.ws + OFF_WBR) + ((size_t)(l * 4 + br) * 1024 + nt * 64) * 512, 512, 512, smem);
            {
                const float bm = P.b_merge[(l * 4 + br) * 1024 + col];
#pragma unroll
                for (int mi = 0; mi < 2; ++mi)
#pragma unroll
                    for (int r = 0; r < 8; ++r) gate[mi][r] = cvt_pk(__builtin_amdgcn_rcpf(1.f + __expf(-(g[mi][2 * r] + bm))), __builtin_amdgcn_rcpf(1.f + __expf(-(g[mi][2 * r + 1] + bm))));
            }
#pragma unroll
            for (int mi = 0; mi < 2; ++mi)
#pragma unroll
                for (int r = 0; r < 8; ++r) {
                    tot[mi][2 * r] = fmaf(lo16(gate[mi][r]), pa[mi][2 * r], tot[mi][2 * r]);
                    tot[mi][2 * r + 1] = fmaf(hi16(gate[mi][r]), pa[mi][2 * r + 1], tot[mi][2 * r + 1]);
                }
        }
#pragma unroll
        for (int mi = 0; mi < 2; ++mi)
#pragma unroll
            for (int r = 0; r < 16; ++r) ACC[(size_t)(mt * 128 + ACC_ROW(mi, r)) * 1024 + col] = f2bf(tot[mi][r]);
    }
}

__device__ void phase_out(const Params& P, int ph, int l, int hf, unsigned char* smem) {
    const int tid_ = tid_opaque(), lane = tid_ & 63, wave = tid_ >> 6, wr = wave >> 1, wc = wave & 1;
    const bf16_t* ACC = (const bf16_t*)(P.ws + OFF_KV);
    const float* mod = (const float*)(P.ws + OFF_MOD);
    for (;;) {
        const int u = next_item(P, ph);
        if (u >= 132 * 8) break;
        const int mt = u >> 3, nt = u & 7;
        const int t0 = mt * 128, bl = t0 / TB, p0 = t0 % TB, b = hf * 2 + bl;
        const bool isctx = p0 < CTXL;
        if (isctx && l == 1) continue;
        f32x16 acc[2][2]; zero_acc(acc);
        gemm_tile_pf2(acc, ACC + (size_t)mt * 128 * 1024, 1024, (const bf16_t*)(P.ws + OFF_WO) + ((size_t)l * 1024 + nt * 128) * 1024, 1024, 1024, smem);
        const float* gt = mod + (l * 5 + (isctx ? 4 : b)) * 3072 + 2048 + nt * 128;
        const float* src; float* dst;
        if (isctx) { src = P.ctx + ((size_t)b * CTXL + p0) * D; dst = (float*)(P.ws + OFF_CX1) + ((size_t)b * CTXL + p0) * D; }
        else { const size_t o = ((size_t)b * SEQ + (p0 - CTXL)) * D; src = (l == 0 ? P.x : (const float*)P.out) + o; dst = P.out + o; }
        float rv[2][2][16];
#pragma unroll
        for (int mi = 0; mi < 2; ++mi)
#pragma unroll
            for (int ni = 0; ni < 2; ++ni)
#pragma unroll
                for (int r = 0; r < 16; ++r) rv[mi][ni][r] = src[(size_t)ACC_ROW(mi, r) * D + nt * 128 + ACC_COL(ni)];
#pragma unroll
        for (int mi = 0; mi < 2; ++mi)
#pragma unroll
            for (int ni = 0; ni < 2; ++ni) {
                const int cl = ACC_COL(ni);
                const float g = gt[cl];
#pragma unroll
                for (int r = 0; r < 16; ++r) { const size_t o = (size_t)ACC_ROW(mi, r) * D + nt * 128 + cl; dst[o] = rv[mi][ni][r] + g * acc[mi][ni][r]; }
            }
    }
}

__global__ void __launch_bounds__(256, 2) mega(Params PK) {
    extern __shared__ __attribute__((aligned(16))) unsigned char smem[];
    if (blockIdx.x == 0 && threadIdx.x == 0) {
        Params* T = (Params*)(PK.ws + OFF_TAB);
        T->x = PK.x; T->c = PK.c; T->ctx = PK.ctx; T->c_ctx = PK.c_ctx; T->ada_w = PK.ada_w; T->ada_b = PK.ada_b; T->norm_g = PK.norm_g; T->w_in = PK.w_in;
        T->w_uq = PK.w_uq; T->w_ukv = PK.w_ukv; T->g_cq = PK.g_cq; T->g_ckv = PK.g_ckv; T->g_q = PK.g_q; T->g_k = PK.g_k; T->rpb = PK.rpb; T->ng_q = PK.ng_q; T->ng_k = PK.ng_k;
        T->lb_logits = PK.lb_logits; T->hg_g_o = PK.hg_g_o; T->gla_w2 = PK.gla_w2; T->gla_b2 = PK.gla_b2; T->gla_g_o = PK.gla_g_o; T->w_br = PK.w_br; T->w_merge = PK.w_merge;
        T->b_merge = PK.b_merge; T->w_out = PK.w_out; T->out = PK.out; T->ws = PK.ws; T->ph_lo = PK.ph_lo; T->ph_hi = PK.ph_hi;
    }
    unsigned char* wsb = PK.ws;
    const int ph_lo = PK.ph_lo, ph_hi = PK.ph_hi;
#ifdef PROBE_SUB
    __shared__ long long s_tacc, s_tprev; if (threadIdx.x == 0) { s_tacc = 0; s_tprev = 0; }
#endif
    for (int ph = ph_lo; ph < ph_hi; ++ph) {
#ifndef SPLIT_MIX
        if (ph > 8 && ((ph - 1) & 7) == 0) continue;
#endif
        if (ph > ph_lo) cg::this_grid().sync();
        const Params& P = PK;
#ifdef PROBE_SUB
        if (threadIdx.x == 0) { const long long t_now = wall_clock64();
#ifdef SPLIT_MIX
            const int prev_sub = (ph == 0) ? -1 : (ph == 1 ? 9 : ((ph - 2) % 9));
#else
            const int prev_sub = (ph == 0) ? -1 : (ph == 1 ? 8 : ((ph - 2) & 7));
#endif
            if (prev_sub == PROBE_SUB) s_tacc += t_now - s_tprev; s_tprev = t_now; }
#endif
#ifdef ONLYP
#define PH_ON(n) ((ONLYP >> (n)) & 1)
#else
#define PH_ON(n) true
#endif
        if (ph == 0) { if (PH_ON(8)) phase_prologue(PK, ph, smem); continue; }
#ifdef SPLIT_MIX
        const int q = ph - 1, pass = q / 9, sub9 = q % 9, l = pass >> 1, hf = pass & 1;
        if (sub9 == 4 || sub9 == 5) { phase_mixers(P, ph, l, smem, sub9 - 3); continue; }
        const int sub = sub9 < 4 ? sub9 : sub9 - 1;
        switch (sub) {
            case 0: phase_norm(P, ph, l, hf); break;
            case 1: phase_gemm1(P, ph, l, smem); break;
            case 2: phase_gemm2(P, ph, l, smem); break;
            case 3: phase_finalize(P, ph, l, smem); break;
            case 5: phase_scanfin(P, ph, l); break;
            case 6: phase_merge(P, ph, l, smem); break;
            default: phase_out(P, ph, l, hf, smem); break;
        }
#else
        const int q = ph - 1, pass = q >> 3, sub = q & 7, l = pass >> 1, hf = pass & 1;
        switch (sub) {
            case 0: if (PH_ON(0)) phase_norm(P, ph, l, hf); break;
            case 1: if (PH_ON(1)) phase_gemm1(P, ph, l, smem); break;
            case 2: if (PH_ON(2)) phase_gemm2(P, ph, l, smem); break;
            case 3: if (PH_ON(3)) phase_finalize(P, ph, l, smem); break;
            case 4: if (PH_ON(4)) phase_mixers(P, ph, l, smem); break;
            case 5: if (PH_ON(5)) phase_scanfin(P, ph, l); break;
            case 6: if (PH_ON(6)) phase_merge(P, ph, l, smem); break;
            default: if (PH_ON(7)) { phase_out(P, ph, l, hf, smem); if (pass < 3) phase_norm(P, ph + 40, (pass + 1) >> 1, (pass + 1) & 1); } break;
        }
#endif
    }
#ifdef PROBE_SUB
    cg::this_grid().sync();
    if (threadIdx.x == 0) { const long long t_now = wall_clock64(); if (7 == PROBE_SUB) s_tacc += t_now - s_tprev;
      if (blockIdx.x == 0) { const long long t_acc = s_tacc; const long long t0 = wall_clock64(); while (wall_clock64() - t0 < t_acc) { __builtin_amdgcn_s_sleep(10); } } }
#endif
}

extern "C" void kernel_launch(void* const* d_in, const int* in_sizes, int n_in, void* d_out, int out_size, void* d_ws, size_t ws_size, hipStream_t stream) {
    static int grid = 0;
    if (grid == 0) {
        if (ws_size < WS_END) { fprintf(stderr, "workspace too small: %zu < %zu\n", ws_size, (size_t)WS_END); grid = -1; return; }
        int dev = 0, cus = 0, per_cu = 0;
        hipGetDevice(&dev);
        hipDeviceGetAttribute(&cus, hipDeviceAttributeMultiprocessorCount, dev);
        hipFuncSetAttribute((const void*)mega, hipFuncAttributeMaxDynamicSharedMemorySize, LDS_BYTES);
        hipOccupancyMaxActiveBlocksPerMultiprocessor(&per_cu, (const void*)mega, 256, LDS_BYTES);
        if (per_cu < 1) per_cu = 1;
        if (per_cu > 2) per_cu = 2;
        grid = cus * per_cu;
        (void)hipGetLastError();
    }
    if (grid < 0) return;
    hipMemsetAsync((unsigned char*)d_ws + OFF_CTL, 0, 4096, stream);
    Params p{};
    const float** pp = (const float**)&p;
    for (int i = 0; i < 26; ++i) pp[i] = (const float*)d_in[i];
    p.out = (float*)d_out; p.ws = (unsigned char*)d_ws;
#if SINGLE_LAUNCH
    p.ph_lo = 0; p.ph_hi = NPHASE;
    void* args[] = {&p};
    hipError_t e = hipLaunchCooperativeKernel((const void*)mega, dim3(grid), dim3(256), args, LDS_BYTES, stream);
    if (e != hipSuccess) fprintf(stderr, "cooperative launch failed: %s (grid %d)\n", hipGetErrorString(e), grid);
#else
    for (int ph = 0; ph < NPHASE; ++ph) {
        p.ph_lo = ph; p.ph_hi = ph + 1;
        hipLaunchKernelGGL(mega, dim3(grid), dim3(256), LDS_BYTES, stream, p);
    }
#endif
}
```

```cpp
#include <hip/hip_runtime.h>
#include <hip/hip_cooperative_groups.h>
#include <stdint.h>
#include <stdio.h>
namespace cg = cooperative_groups;

typedef unsigned short bf16_t;
typedef short bf16x8 __attribute__((ext_vector_type(8)));
typedef short bf16x4 __attribute__((ext_vector_type(4)));
typedef float f32x16 __attribute__((ext_vector_type(16)));

#ifndef SINGLE_LAUNCH
#define SINGLE_LAUNCH 1
#endif

constexpr int D = 1024, SEQ = 8192, CTXL = 256, TB = SEQ + CTXL  , NTH = 2 * TB  ;
constexpr int INW = 7104, PW = 7104;
constexpr int C_CQ = 0, C_CKV = 256, C_KR = 384, C_NQ = 416, C_NK = 928, C_NV = 1440, C_HQ = 1952, C_HF = 2464, C_HI = 3488,
              C_GQ = 4000, C_GK = 4256, C_GV = 4512, C_GR = 5024, C_Z = 5056;
constexpr float EPS = 1e-6f;
constexpr float LOG2E = 1.4426950408889634f;
constexpr int LDS_BYTES = 73728;
#ifdef SPLIT_MIX
constexpr int NPHASE = 37;
#else
constexpr int NPHASE = 33;
#endif

constexpr size_t al256(size_t v) { return (v + 255) & ~(size_t)255; }
constexpr size_t OFF_CTL = 0;
constexpr size_t OFF_TAB = 1024;
constexpr size_t OFF_MOD = 4096;
constexpr size_t OFF_CX1 = al256(OFF_MOD + 2 * 5 * 3072 * 4);
constexpr size_t OFF_WIN = al256(OFF_CX1 + (size_t)4 * 256 * 1024 * 4);
constexpr size_t OFF_WM = al256(OFF_WIN + (size_t)2 * 7168 * 1024 * 2);
constexpr size_t OFF_WBR = al256(OFF_WM + (size_t)8 * 1024 * 1024 * 2);
constexpr size_t OFF_WO = al256(OFF_WBR + (size_t)8 * 1024 * 512 * 2);
constexpr size_t OFF_WUQ = al256(OFF_WO + (size_t)2 * 1024 * 1024 * 2);
constexpr size_t OFF_WUKV = al256(OFF_WUQ + (size_t)2 * 768 * 256 * 2);
constexpr size_t OFF_H = al256(OFF_WUKV + (size_t)2 * 1024 * 128 * 2);
constexpr size_t OFF_PB = al256(OFF_H + (size_t)NTH * 1024 * 2);
constexpr size_t OFF_QF = al256(OFF_PB + (size_t)NTH * PW * 2);
constexpr size_t OFF_KV = al256(OFF_QF + (size_t)NTH * 768 * 2);
constexpr size_t OFF_KF = al256(OFF_KV + (size_t)NTH * 1024 * 2);
constexpr size_t OFF_VTM = al256(OFF_KF + (size_t)NTH * 768 * 2);
constexpr size_t OFF_VTN = al256(OFF_VTM + (size_t)2 * 8 * 64 * TB * 2);
constexpr size_t OFF_OSG = al256(OFF_VTN + (size_t)2 * 8 * 64 * TB * 2);
constexpr size_t OFF_XH = al256(OFF_OSG + (size_t)2 * NTH * 512 * 2);
constexpr size_t OFF_XG = al256(OFF_XH + (size_t)NTH * 512 * 2);
constexpr size_t OFF_EBH = al256(OFF_XG + (size_t)NTH * 512 * 2);
constexpr size_t OFF_EBG = al256(OFF_EBH + (size_t)528 * 2 * 512 * 4);
constexpr size_t WS_END = al256(OFF_EBG + (size_t)528 * 2 * 256 * 4);

static_assert(WS_END <= (size_t)512 * 1024 * 1024, "workspace map exceeds 512 MiB");
struct Params {
    const float *x, *c, *ctx, *c_ctx, *ada_w, *ada_b, *norm_g, *w_in, *w_uq, *w_ukv, *g_cq, *g_ckv, *g_q, *g_k, *rpb, *ng_q, *ng_k,
        *lb_logits, *hg_g_o, *gla_w2, *gla_b2, *gla_g_o, *w_br, *w_merge, *b_merge, *w_out;
    float* out;
    unsigned char* ws;
    int ph_lo, ph_hi;
};

__device__ __forceinline__ float bf2f(bf16_t v) { return __uint_as_float(((unsigned)v) << 16); }
typedef float f32x2_t __attribute__((ext_vector_type(2)));
typedef __bf16 bf16x2_t __attribute__((ext_vector_type(2)));
__device__ __forceinline__ unsigned cvt_pk(float lo, float hi) { f32x2_t v = {lo, hi}; bf16x2_t b = __builtin_convertvector(v, bf16x2_t); return __builtin_bit_cast(unsigned, b); }
__device__ __forceinline__ unsigned cvt_pk_asm(float lo, float hi) { unsigned r; asm("s_nop 1\n\tv_cvt_pk_bf16_f32 %0, %1, %2" : "=v"(r) : "v"(lo), "v"(hi)); return r; }
__device__ __forceinline__ bf16_t f2bf(float f) { return (bf16_t)(cvt_pk(f, 0.f) & 0xffffu); }
__device__ __forceinline__ float lo16(unsigned u) { return __uint_as_float(u << 16); }
__device__ __forceinline__ float hi16(unsigned u) { return __uint_as_float(u & 0xffff0000u); }
__device__ __forceinline__ float sigmoidf_(float x) { return __builtin_amdgcn_rcpf(1.f + __expf(-x)); }
__device__ __forceinline__ float siluf_(float x) { return x * __builtin_amdgcn_rcpf(1.f + __expf(-x)); }
__device__ __forceinline__ float wave_sum(float v) {
#pragma unroll
    for (int o = 32; o > 0; o >>= 1) v += __shfl_xor(v, o);
    return v;
}
__device__ __forceinline__ void unpack8(uint4 u, float* f) {
    f[0] = lo16(u.x); f[1] = hi16(u.x); f[2] = lo16(u.y); f[3] = hi16(u.y); f[4] = lo16(u.z); f[5] = hi16(u.z); f[6] = lo16(u.w); f[7] = hi16(u.w);
}
__device__ __forceinline__ uint4 pack8(const float* f) { uint4 u; u.x = cvt_pk(f[0], f[1]); u.y = cvt_pk(f[2], f[3]); u.z = cvt_pk(f[4], f[5]); u.w = cvt_pk(f[6], f[7]); return u; }

__device__ __forceinline__ int tid_opaque() { int t = threadIdx.x; asm volatile("" : "+v"(t)); return t; }
__shared__ int s_item;
__device__ __forceinline__ int next_item(const Params& P, int ph) {
    __syncthreads();
    if (threadIdx.x == 0) s_item = atomicAdd((int*)(P.ws + OFF_CTL) + ph, 1);
    __syncthreads();
    return s_item;
}

constexpr int GS = 72;
__device__ __forceinline__ void gemm_tile(f32x16 (&acc)[2][2], const bf16_t* __restrict__ A, int lda, const bf16_t* __restrict__ Bt, int ldb, int K, unsigned char* smem) {
    const int tid = tid_opaque(), lane = tid & 63, wave = tid >> 6, wr = wave >> 1, wc = wave & 1;
    bf16_t* sA = (bf16_t*)smem;
    bf16_t* sB = sA + 2 * 128 * GS;
    const int lrow = tid >> 3, lch = (tid & 7) * 8;
    uint4 ra[4], rb[4];
    const bf16_t* Ap = A + (size_t)lrow * lda + lch;
    const bf16_t* Bp = Bt + (size_t)lrow * ldb + lch;
#pragma unroll
    for (int i = 0; i < 4; ++i) { ra[i] = *(const uint4*)(Ap + (size_t)(32 * i) * lda); rb[i] = *(const uint4*)(Bp + (size_t)(32 * i) * ldb); }
#pragma unroll
    for (int i = 0; i < 4; ++i) { *(uint4*)(sA + (lrow + 32 * i) * GS + lch) = ra[i]; *(uint4*)(sB + (lrow + 32 * i) * GS + lch) = rb[i]; }
    __syncthreads();
    const int nk = K >> 6;
    const int aoff = (wr * 64 + (lane & 31)) * GS + (lane >> 5) * 8, boff = (wc * 64 + (lane & 31)) * GS + (lane >> 5) * 8;
    for (int kt = 0; kt < nk; ++kt) {
        const bool more = kt + 1 < nk;
        if (more) {
#pragma unroll
            for (int i = 0; i < 4; ++i) { ra[i] = *(const uint4*)(Ap + (size_t)(32 * i) * lda + (kt + 1) * 64); rb[i] = *(const uint4*)(Bp + (size_t)(32 * i) * ldb + (kt + 1) * 64); }
        }
        const bf16_t* a = sA + (kt & 1) * 128 * GS + aoff;
        const bf16_t* b = sB + (kt & 1) * 128 * GS + boff;
#pragma unroll
        for (int ks = 0; ks < 4; ++ks) {
            bf16x8 a0 = *(const bf16x8*)(a + ks * 16), a1 = *(const bf16x8*)(a + 32 * GS + ks * 16);
            bf16x8 b0 = *(const bf16x8*)(b + ks * 16), b1 = *(const bf16x8*)(b + 32 * GS + ks * 16);
            acc[0][0] = __builtin_amdgcn_mfma_f32_32x32x16_bf16(a0, b0, acc[0][0], 0, 0, 0);
            acc[0][1] = __builtin_amdgcn_mfma_f32_32x32x16_bf16(a0, b1, acc[0][1], 0, 0, 0);
            acc[1][0] = __builtin_amdgcn_mfma_f32_32x32x16_bf16(a1, b0, acc[1][0], 0, 0, 0);
            acc[1][1] = __builtin_amdgcn_mfma_f32_32x32x16_bf16(a1, b1, acc[1][1], 0, 0, 0);
        }
        if (more) {
            bf16_t* wa = sA + ((kt + 1) & 1) * 128 * GS;
            bf16_t* wb = sB + ((kt + 1) & 1) * 128 * GS;
#pragma unroll
            for (int i = 0; i < 4; ++i) { *(uint4*)(wa + (lrow + 32 * i) * GS + lch) = ra[i]; *(uint4*)(wb + (lrow + 32 * i) * GS + lch) = rb[i]; }
        }
        __syncthreads();
    }
}

__device__ __forceinline__ void gemm_tile_pf2(f32x16 (&acc)[2][2], const bf16_t* __restrict__ A, int lda, const bf16_t* __restrict__ Bt, int ldb, int K, unsigned char* smem) {
    const int tid = tid_opaque(), lane = tid & 63, wave = tid >> 6, wr = wave >> 1, wc = wave & 1;
    bf16_t* sA = (bf16_t*)smem;
    bf16_t* sB = sA + 2 * 128 * GS;
    const int lrow = tid >> 3, lch = (tid & 7) * 8;
    uint4 pa0, pa1, pa2, pa3, pb0, pb1, pb2, pb3, qa0, qa1, qa2, qa3, qb0, qb1, qb2, qb3;
    const bf16_t* Ap = A + (size_t)lrow * lda + lch;
    const bf16_t* Bp = Bt + (size_t)lrow * ldb + lch;
    const int nk = K >> 6;
#define PF2_LD1(RA, RB, kt_, i) { RA##i = *(const uint4*)(Ap + (size_t)(32 * i) * lda + (kt_) * 64); RB##i = *(const uint4*)(Bp + (size_t)(32 * i) * ldb + (kt_) * 64); }
#define PF2_LOAD(RA, RB, kt_) { PF2_LD1(RA, RB, kt_, 0) PF2_LD1(RA, RB, kt_, 1) PF2_LD1(RA, RB, kt_, 2) PF2_LD1(RA, RB, kt_, 3) }
#define PF2_WR1(RA, RB, i) { *(uint4*)(wa + (lrow + 32 * i) * GS + lch) = RA##i; *(uint4*)(wb + (lrow + 32 * i) * GS + lch) = RB##i; }
#define PF2_WRITE(RA, RB, buf_) { bf16_t* wa = sA + (buf_) * 128 * GS; bf16_t* wb = sB + (buf_) * 128 * GS; PF2_WR1(RA, RB, 0) PF2_WR1(RA, RB, 1) PF2_WR1(RA, RB, 2) PF2_WR1(RA, RB, 3) }
#define PF2_COMPUTE(buf_) { const bf16_t* a = sA + (buf_) * 128 * GS + aoff; const bf16_t* b = sB + (buf_) * 128 * GS + boff; _Pragma("unroll") for (int ks = 0; ks < 4; ++ks) { \
        bf16x8 a0 = *(const bf16x8*)(a + ks * 16), a1 = *(const bf16x8*)(a + 32 * GS + ks * 16); bf16x8 b0 = *(const bf16x8*)(b + ks * 16), b1 = *(const bf16x8*)(b + 32 * GS + ks * 16); \
        acc[0][0] = __builtin_amdgcn_mfma_f32_32x32x16_bf16(a0, b0, acc[0][0], 0, 0, 0); acc[0][1] = __builtin_amdgcn_mfma_f32_32x32x16_bf16(a0, b1, acc[0][1], 0, 0, 0); \
        acc[1][0] = __builtin_amdgcn_mfma_f32_32x32x16_bf16(a1, b0, acc[1][0], 0, 0, 0); acc[1][1] = __builtin_amdgcn_mfma_f32_32x32x16_bf16(a1, b1, acc[1][1], 0, 0, 0); } }
    const int aoff = (wr * 64 + (lane & 31)) * GS + (lane >> 5) * 8, boff = (wc * 64 + (lane & 31)) * GS + (lane >> 5) * 8;
    PF2_LOAD(pa, pb, 0);
    PF2_LOAD(qa, qb, 1);
    PF2_WRITE(pa, pb, 0);
    __syncthreads();
    for (int kt = 0; kt < nk; kt += 2) {
        if (kt + 2 < nk) PF2_LOAD(pa, pb, kt + 2);
        PF2_COMPUTE(0);
        PF2_WRITE(qa, qb, 1);
        __syncthreads();
        if (kt + 3 < nk) PF2_LOAD(qa, qb, kt + 3);
        PF2_COMPUTE(1);
        if (kt + 2 < nk) PF2_WRITE(pa, pb, 0);
        __syncthreads();
    }
#undef PF2_LOAD
#undef PF2_LD1
#undef PF2_WR1
#undef PF2_WRITE
#undef PF2_COMPUTE
}

__device__ __forceinline__ void gemm_tile_n64(f32x16 (&acc)[2], const bf16_t* __restrict__ A, int lda, const bf16_t* __restrict__ Bt, int ldb, int K, unsigned char* smem) {
    const int tid = tid_opaque(), lane = tid & 63, wave = tid >> 6, wr = wave >> 1, wc = wave & 1;
    bf16_t* sA = (bf16_t*)smem;
    bf16_t* sB = sA + 2 * 128 * GS;
    const int lrow = tid >> 3, lch = (tid & 7) * 8;
    uint4 pa0, pa1, pa2, pa3, pb0, pb1, qa0, qa1, qa2, qa3, qb0, qb1;
    const bf16_t* Ap = A + (size_t)lrow * lda + lch;
    const bf16_t* Bp = Bt + (size_t)lrow * ldb + lch;
    const int nk = K >> 6;
#define N64_LOAD(RA, RB, kt_) { RA##0 = *(const uint4*)(Ap + (kt_) * 64); RA##1 = *(const uint4*)(Ap + (size_t)32 * lda + (kt_) * 64); RA##2 = *(const uint4*)(Ap + (size_t)64 * lda + (kt_) * 64); RA##3 = *(const uint4*)(Ap + (size_t)96 * lda + (kt_) * 64); \
        RB##0 = *(const uint4*)(Bp + (kt_) * 64); RB##1 = *(const uint4*)(Bp + (size_t)32 * ldb + (kt_) * 64); }
#define N64_WRITE(RA, RB, buf_) { bf16_t* wa = sA + (buf_) * 128 * GS + lrow * GS + lch; bf16_t* wb = sB + (buf_) * 64 * GS + lrow * GS + lch; \
        *(uint4*)wa = RA##0; *(uint4*)(wa + 32 * GS) = RA##1; *(uint4*)(wa + 64 * GS) = RA##2; *(uint4*)(wa + 96 * GS) = RA##3; *(uint4*)wb = RB##0; *(uint4*)(wb + 32 * GS) = RB##1; }
#define N64_COMPUTE(buf_) { const bf16_t* a = sA + (buf_) * 128 * GS + aoff; const bf16_t* b = sB + (buf_) * 64 * GS + boff; _Pragma("unroll") for (int ks = 0; ks < 4; ++ks) { \
        bf16x8 a0 = *(const bf16x8*)(a + ks * 16), a1 = *(const bf16x8*)(a + 32 * GS + ks * 16); bf16x8 b0 = *(const bf16x8*)(b + ks * 16); \
        acc[0] = __builtin_amdgcn_mfma_f32_32x32x16_bf16(a0, b0, acc[0], 0, 0, 0); acc[1] = __builtin_amdgcn_mfma_f32_32x32x16_bf16(a1, b0, acc[1], 0, 0, 0); } }
    const int aoff = (wr * 64 + (lane & 31)) * GS + (lane >> 5) * 8, boff = (wc * 32 + (lane & 31)) * GS + (lane >> 5) * 8;
    N64_LOAD(pa, pb, 0);
    N64_LOAD(qa, qb, 1);
    N64_WRITE(pa, pb, 0);
    __syncthreads();
    for (int kt = 0; kt < nk; kt += 2) {
        if (kt + 2 < nk) N64_LOAD(pa, pb, kt + 2);
        N64_COMPUTE(0);
        N64_WRITE(qa, qb, 1);
        __syncthreads();
        if (kt + 3 < nk) N64_LOAD(qa, qb, kt + 3);
        N64_COMPUTE(1);
        if (kt + 2 < nk) N64_WRITE(pa, pb, 0);
        __syncthreads();
    }
#undef N64_LOAD
#undef N64_WRITE
#undef N64_COMPUTE
}

__device__ __forceinline__ void gemm_pair_n64(f32x16 (&acc1)[2], f32x16 (&acc2)[2], const bf16_t* __restrict__ A1, int lda1, const bf16_t* __restrict__ B1, int ldb1, int K1,
                                              const bf16_t* __restrict__ A2, int lda2, const bf16_t* __restrict__ B2, int ldb2, int K2, unsigned char* smem) {
    const int tid = tid_opaque(), lane = tid & 63, wave = tid >> 6, wr = wave >> 1, wc = wave & 1;
    bf16_t* sA = (bf16_t*)smem;
    bf16_t* sB = sA + 2 * 128 * GS;
    const int lrow = tid >> 3, lch = (tid & 7) * 8;
    uint4 pa0, pa1, pa2, pa3, pb0, pb1, qa0, qa1, qa2, qa3, qb0, qb1;
    const bf16_t* Ap1 = A1 + (size_t)lrow * lda1 + lch; const bf16_t* Bp1 = B1 + (size_t)lrow * ldb1 + lch;
    const bf16_t* Ap2 = A2 + (size_t)lrow * lda2 + lch; const bf16_t* Bp2 = B2 + (size_t)lrow * ldb2 + lch;
    const int nk1 = K1 >> 6, nk = nk1 + (K2 >> 6);
#define P64_LOAD(RA, RB, kt_) { const bool s2_ = (kt_) >= nk1; const bf16_t* ap_ = s2_ ? Ap2 + ((kt_) - nk1) * 64 : Ap1 + (kt_) * 64; const bf16_t* bp_ = s2_ ? Bp2 + ((kt_) - nk1) * 64 : Bp1 + (kt_) * 64; \
        const size_t la_ = s2_ ? lda2 : lda1, lb_ = s2_ ? ldb2 : ldb1; \
        RA##0 = *(const uint4*)(ap_); RA##1 = *(const uint4*)(ap_ + 32 * la_); RA##2 = *(const uint4*)(ap_ + 64 * la_); RA##3 = *(const uint4*)(ap_ + 96 * la_); \
        RB##0 = *(const uint4*)(bp_); RB##1 = *(const uint4*)(bp_ + 32 * lb_); }
#define P64_WRITE(RA, RB, buf_) { bf16_t* wa = sA + (buf_) * 128 * GS + lrow * GS + lch; bf16_t* wb = sB + (buf_) * 64 * GS + lrow * GS + lch; \
        *(uint4*)wa = RA##0; *(uint4*)(wa + 32 * GS) = RA##1; *(uint4*)(wa + 64 * GS) = RA##2; *(uint4*)(wa + 96 * GS) = RA##3; *(uint4*)wb = RB##0; *(uint4*)(wb + 32 * GS) = RB##1; }
#define P64_COMPUTE(ACC, buf_) { const bf16_t* a = sA + (buf_) * 128 * GS + aoff; const bf16_t* b = sB + (buf_) * 64 * GS + boff; _Pragma("unroll") for (int ks = 0; ks < 4; ++ks) { \
        bf16x8 a0 = *(const bf16x8*)(a + ks * 16), a1 = *(const bf16x8*)(a + 32 * GS + ks * 16); bf16x8 b0 = *(const bf16x8*)(b + ks * 16); \
        ACC[0] = __builtin_amdgcn_mfma_f32_32x32x16_bf16(a0, b0, ACC[0], 0, 0, 0); ACC[1] = __builtin_amdgcn_mfma_f32_32x32x16_bf16(a1, b0, ACC[1], 0, 0, 0); } }
    const int aoff = (wr * 64 + (lane & 31)) * GS + (lane >> 5) * 8, boff = (wc * 32 + (lane & 31)) * GS + (lane >> 5) * 8;
    P64_LOAD(pa, pb, 0);
    P64_LOAD(qa, qb, 1);
    P64_WRITE(pa, pb, 0);
    __syncthreads();
    for (int kt = 0; kt < nk; kt += 2) {
        if (kt + 2 < nk) P64_LOAD(pa, pb, kt + 2);
        if (kt < nk1) P64_COMPUTE(acc1, 0) else P64_COMPUTE(acc2, 0)
        P64_WRITE(qa, qb, 1);
        __syncthreads();
        if (kt + 3 < nk) P64_LOAD(qa, qb, kt + 3);
        if (kt + 1 < nk1) P64_COMPUTE(acc1, 1) else P64_COMPUTE(acc2, 1)
        if (kt + 2 < nk) P64_WRITE(pa, pb, 0);
        __syncthreads();
    }
#undef P64_LOAD
#undef P64_WRITE
#undef P64_COMPUTE
}
__device__ __forceinline__ void zero_acc(f32x16 (&acc)[2][2]) {
#pragma unroll
    for (int i = 0; i < 2; ++i)
#pragma unroll
        for (int j = 0; j < 2; ++j)
#pragma unroll
            for (int r = 0; r < 16; ++r) acc[i][j][r] = 0.f;
}
#define ACC_ROW(mi, r) (wr * 64 + (mi) * 32 + ((r) & 3) + 8 * ((r) >> 2) + 4 * (lane >> 5))
#define ACC_COL(ni) (wc * 64 + (ni) * 32 + (lane & 31))

__device__ void tr_tile(const float* __restrict__ src, int K, int N, int kt, int nt, bf16_t* __restrict__ dst, const float* __restrict__ scale, float* s) {
    const int tid = tid_opaque(), r = tid >> 4, c4 = (tid & 15) * 4;
#pragma unroll
    for (int i = 0; i < 4; ++i) {
        const int k = kt * 64 + r + 16 * i;
        float4 v = *(const float4*)(src + (size_t)k * N + nt * 64 + c4);
        const float sc = scale ? scale[k] : 1.f;
        float* d = s + (r + 16 * i) * 65 + c4;
        d[0] = v.x * sc; d[1] = v.y * sc; d[2] = v.z * sc; d[3] = v.w * sc;
    }
    __syncthreads();
    const int n = tid >> 2, k0 = (tid & 3) * 16;
    float f[16];
#pragma unroll
    for (int j = 0; j < 16; ++j) f[j] = s[(k0 + j) * 65 + n];
    bf16_t* o = dst + (size_t)(nt * 64 + n) * K + kt * 64 + k0;
    *(uint4*)o = pack8(f);
    *(uint4*)(o + 8) = pack8(f + 8);
    __syncthreads();
}
__device__ void phase_prologue(const Params& P, int ph, unsigned char* smem) {
    float* s = (float*)smem;
    const int NTR = 7296, NMOD = 96;
    for (;;) {
        const int u = next_item(P, ph);
        if (u >= NTR + NMOD) break;
        if (u < NMOD) {
            const int l = u / 48, cb = u % 48, tid = threadIdx.x, lane = tid & 63, wave = tid >> 6;
            float* sc = s;
            float* red = s + 5 * 1024;
            for (int i = tid; i < 5 * 1024; i += 256) { const int r = i >> 10, k = i & 1023; const float v = (r < 4) ? P.c[r * 1024 + k] : P.c_ctx[k]; sc[i] = siluf_(v); }
            __syncthreads();
            const int col = cb * 64 + lane;
            float acc[5] = {0.f, 0.f, 0.f, 0.f, 0.f};
            const float* w = P.ada_w + (size_t)l * 1024 * 3072 + col;
#pragma unroll 8
            for (int k = wave * 256; k < wave * 256 + 256; ++k) {
                const float wv = w[(size_t)k * 3072];
#pragma unroll
                for (int r = 0; r < 5; ++r) acc[r] += sc[r * 1024 + k] * wv;
            }
#pragma unroll
            for (int r = 0; r < 5; ++r) red[(wave * 5 + r) * 64 + lane] = acc[r];
            __syncthreads();
            if (wave == 0) {
                float* mod = (float*)(P.ws + OFF_MOD);
#pragma unroll
                for (int r = 0; r < 5; ++r) mod[(l * 5 + r) * 3072 + col] = red[r * 64 + lane] + red[(5 + r) * 64 + lane] + red[(10 + r) * 64 + lane] + red[(15 + r) * 64 + lane] + P.ada_b[l * 3072 + col];
            }
            continue;
        }
        const int v = u - NMOD, l = v / 3648, r = v % 3648;
        if (r < 1776) tr_tile(P.w_in + (size_t)l * 1024 * INW, 1024, INW, r / 111, r % 111, (bf16_t*)(P.ws + OFF_WIN) + (size_t)l * 7168 * 1024, nullptr, s);
        else if (r < 2800) { const int r2 = r - 1776, br = r2 >> 8, t = r2 & 255; tr_tile(P.w_merge + (size_t)(l * 4 + br) * 1024 * 1024, 1024, 1024, t >> 4, t & 15, (bf16_t*)(P.ws + OFF_WM) + (size_t)(l * 4 + br) * 1024 * 1024, nullptr, s); }
        else if (r < 3312) { const int r2 = r - 2800, br = r2 >> 7, t = r2 & 127; tr_tile(P.w_br + (size_t)(l * 4 + br) * 512 * 1024, 512, 1024, t >> 4, t & 15, (bf16_t*)(P.ws + OFF_WBR) + (size_t)(l * 4 + br) * 1024 * 512, nullptr, s); }
        else if (r < 3568) { const int t = r - 3312; tr_tile(P.w_out + (size_t)l * 1024 * 1024, 1024, 1024, t >> 4, t & 15, (bf16_t*)(P.ws + OFF_WO) + (size_t)l * 1024 * 1024, nullptr, s); }
        else if (r < 3616) { const int t = r - 3568; tr_tile(P.w_uq + (size_t)l * 256 * 768, 256, 768, t / 12, t % 12, (bf16_t*)(P.ws + OFF_WUQ) + (size_t)l * 768 * 256, P.g_cq + l * 256, s); }
        else { const int t = r - 3616; tr_tile(P.w_ukv + (size_t)l * 128 * 1024, 128, 1024, t >> 4, t & 15, (bf16_t*)(P.ws + OFF_WUKV) + (size_t)l * 1024 * 128, P.g_ckv + l * 128, s); }
    }
}

__device__ void phase_norm(const Params& P, int ph, int l, int hf) {
    const int tid = tid_opaque(), lane = tid & 63, wave = tid >> 6;
    const float* mod = (const float*)(P.ws + OFF_MOD);
    bf16_t* H = (bf16_t*)(P.ws + OFF_H);
    for (;;) {
        const int u = next_item(P, ph);
        if (u >= NTH / 8) break;
        float4 v[2][4]; int mrr[2];
#pragma unroll
        for (int rr = 0; rr < 2; ++rr) {
            const int t = u * 8 + wave * 2 + rr, bl = t / TB, p = t % TB, b = hf * 2 + bl;
            const float* src;
            if (p < CTXL) { src = (l == 0 ? P.ctx : (const float*)(P.ws + OFF_CX1)) + ((size_t)b * CTXL + p) * D; mrr[rr] = 4; }
            else { src = (l == 0 ? P.x : (const float*)P.out) + ((size_t)b * SEQ + (p - CTXL)) * D; mrr[rr] = b; }
#pragma unroll
            for (int i = 0; i < 4; ++i) v[rr][i] = *(const float4*)(src + lane * 4 + 256 * i);
        }
#pragma unroll
        for (int rr = 0; rr < 2; ++rr) {
            const int t = u * 8 + wave * 2 + rr;
            float ss = 0.f;
#pragma unroll
            for (int i = 0; i < 4; ++i) ss += v[rr][i].x * v[rr][i].x + v[rr][i].y * v[rr][i].y + v[rr][i].z * v[rr][i].z + v[rr][i].w * v[rr][i].w;
            ss = wave_sum(ss);
            const float rstd = rsqrtf(ss * (1.f / D) + EPS);
            const float* sh = mod + (l * 5 + mrr[rr]) * 3072; const float* sc = sh + 1024; const float* g = P.norm_g + l * D;
#pragma unroll
            for (int i = 0; i < 4; ++i) {
                const int c = lane * 4 + 256 * i;
                const float4 gv = *(const float4*)(g + c), s1 = *(const float4*)(sc + c), s0 = *(const float4*)(sh + c);
                uint2 o;
                o.x = cvt_pk(v[rr][i].x * rstd * gv.x * (1.f + s1.x) + s0.x, v[rr][i].y * rstd * gv.y * (1.f + s1.y) + s0.y);
                o.y = cvt_pk(v[rr][i].z * rstd * gv.z * (1.f + s1.z) + s0.z, v[rr][i].w * rstd * gv.w * (1.f + s1.w) + s0.w);
                *(uint2*)(H + (size_t)t * D + c) = o;
            }
        }
    }
}

__device__ void phase_gemm1(const Params& P, int ph, int l, unsigned char* smem) {
    const int tid_ = tid_opaque(), lane = tid_ & 63, wave = tid_ >> 6, wr = wave >> 1, wc = wave & 1;
    const bf16_t* H = (const bf16_t*)(P.ws + OFF_H);
    const bf16_t* W = (const bf16_t*)(P.ws + OFF_WIN) + (size_t)l * 7168 * 1024;
    bf16_t* PB = (bf16_t*)(P.ws + OFF_PB);
    for (;;) {
        const int u = next_item(P, ph);
        if (u >= 132 * 56) break;
        const int mt = u / 56, nt = u % 56;
        f32x16 acc[2][2]; zero_acc(acc);
        gemm_tile_pf2(acc, H + (size_t)mt * 128 * D, D, W + (size_t)nt * 128 * D, D, D, smem);
#pragma unroll
        for (int mi = 0; mi < 2; ++mi)
#pragma unroll
            for (int ni = 0; ni < 2; ++ni) {
                const int col = nt * 128 + ACC_COL(ni);
                if (col < PW) {
#pragma unroll
                    for (int r = 0; r < 16; ++r) PB[(size_t)(mt * 128 + ACC_ROW(mi, r)) * PW + col] = f2bf(acc[mi][ni][r]);
                }
            }
    }
}

__device__ void phase_gemm2(const Params& P, int ph, int l, unsigned char* smem) {
    const int tid_ = tid_opaque(), lane = tid_ & 63, wave = tid_ >> 6, wr = wave >> 1, wc = wave & 1;
    const bf16_t* PB = (const bf16_t*)(P.ws + OFF_PB);
    for (;;) {
        const int u = next_item(P, ph);
        if (u >= 132 * 14) break;
        const int mt = u / 14, n14 = u % 14;
        f32x16 acc[2][2]; zero_acc(acc);
        bf16_t* O; int ldo, nt;
        if (n14 < 6) { nt = n14; O = (bf16_t*)(P.ws + OFF_QF); ldo = 768;
            gemm_tile_pf2(acc, PB + (size_t)mt * 128 * PW + C_CQ, PW, (const bf16_t*)(P.ws + OFF_WUQ) + (size_t)l * 768 * 256 + (size_t)nt * 128 * 256, 256, 256, smem); }
        else { nt = n14 - 6; O = (bf16_t*)(P.ws + OFF_KV); ldo = 1024;
            gemm_tile_pf2(acc, PB + (size_t)mt * 128 * PW + C_CKV, PW, (const bf16_t*)(P.ws + OFF_WUKV) + (size_t)l * 1024 * 128 + (size_t)nt * 128 * 128, 128, 128, smem); }
#pragma unroll
        for (int mi = 0; mi < 2; ++mi)
#pragma unroll
            for (int ni = 0; ni < 2; ++ni)
#pragma unroll
                for (int r = 0; r < 16; ++r) O[(size_t)(mt * 128 + ACC_ROW(mi, r)) * ldo + nt * 128 + ACC_COL(ni)] = f2bf(acc[mi][ni][r]);
    }
}

__device__ void phase_finalize(const Params& P, int ph, int l, unsigned char* smem) {
    const int tid = tid_opaque(), lane = tid & 63, wave = tid >> 6;
    bf16_t* PB = (bf16_t*)(P.ws + OFF_PB);
    bf16_t* QF = (bf16_t*)(P.ws + OFF_QF);
    const bf16_t* KV = (const bf16_t*)(P.ws + OFF_KV);
    bf16_t* KF = (bf16_t*)(P.ws + OFF_KF);
    bf16_t* VTM = (bf16_t*)(P.ws + OFF_VTM);
    bf16_t* VTN = (bf16_t*)(P.ws + OFF_VTN);
    float* rs = (float*)smem;
    const int hd = lane >> 3, j = lane & 7;
    const float invf = __powf(10000.f, -(float)j * 0.125f);
    for (;;) {
        const int u7 = next_item(P, ph);
        if (u7 >= (NTH / 32) * 11) break;
        const int u = u7 / 11, sub = u7 % 11;
        const int t0 = u * 32, bl = t0 / TB, p0 = t0 % TB;
        if (sub >= 1 && sub <= 4) {
        uint2 in_cq[2]; unsigned in_ckv[2]; bf16_t in_q[2][12], in_kv[2][8], in_kr[2][4]; uint4 in_nq[2], in_nk[2];
#pragma unroll
        for (int rr = 0; rr < 2; ++rr) {
            const int tl = (sub - 1) * 8 + wave * 2 + rr, t = t0 + tl;
            const bf16_t* prow = PB + (size_t)t * PW;
            in_cq[rr] = *(const uint2*)(prow + C_CQ + lane * 4);
            in_ckv[rr] = *(const unsigned*)(prow + C_CKV + lane * 2);
            const bf16_t* q = QF + (size_t)t * 768 + hd * 96;
            const bf16_t* kvr = KV + (size_t)t * 1024 + hd * 128;
#pragma unroll
            for (int m = 0; m < 12; ++m) in_q[rr][m] = q[j + 8 * m];
#pragma unroll
            for (int m = 0; m < 8; ++m) in_kv[rr][m] = kvr[j + 8 * m];
#pragma unroll
            for (int m = 0; m < 4; ++m) in_kr[rr][m] = prow[C_KR + j + 8 * m];
            in_nq[rr] = *(const uint4*)(prow + C_NQ + hd * 64 + j * 8);
            in_nk[rr] = *(const uint4*)(prow + C_NK + hd * 64 + j * 8);
        }
#pragma unroll
        for (int rr = 0; rr < 2; ++rr) {
            const int tl = (sub - 1) * 8 + wave * 2 + rr, t = t0 + tl, p = p0 + tl;
            bf16_t* prow = PB + (size_t)t * PW;
            float s1, s2;
            { const uint2 a = in_cq[rr]; const float f0 = lo16(a.x), f1 = hi16(a.x), f2 = lo16(a.y), f3 = hi16(a.y); s1 = f0 * f0 + f1 * f1 + f2 * f2 + f3 * f3;
              const unsigned b = in_ckv[rr]; const float g0 = lo16(b), g1 = hi16(b); s2 = g0 * g0 + g1 * g1; }
            s1 = wave_sum(s1); s2 = wave_sum(s2);
            const float rcq = rsqrtf(s1 * (1.f / 256.f) + EPS), rckv = rsqrtf(s2 * (1.f / 128.f) + EPS);
            {
                bf16_t* q = QF + (size_t)t * 768 + hd * 96;
                float v[12], ss = 0.f;
#pragma unroll
                for (int m = 0; m < 12; ++m) { v[m] = bf2f(in_q[rr][m]) * rcq; ss += v[m] * v[m]; }
                ss += __shfl_xor(ss, 1); ss += __shfl_xor(ss, 2); ss += __shfl_xor(ss, 4);
                const float rn = rsqrtf(ss * (1.f / 96.f) + EPS);
#pragma unroll
                for (int m = 0; m < 12; ++m) q[j + 8 * m] = f2bf(v[m] * rn * P.g_q[l * 96 + j + 8 * m] * (0.10206207261596575f * LOG2E));
            }
            {
                float v[12], ss = 0.f;
#pragma unroll
                for (int m = 0; m < 8; ++m) { v[m] = bf2f(in_kv[rr][m]) * rckv; ss += v[m] * v[m]; }
#pragma unroll
                for (int m = 8; m < 12; ++m) { v[m] = bf2f(in_kr[rr][m - 8]); ss += v[m] * v[m]; }
                ss += __shfl_xor(ss, 1); ss += __shfl_xor(ss, 2); ss += __shfl_xor(ss, 4);
                const float rn = rsqrtf(ss * (1.f / 96.f) + EPS);
#pragma unroll
                for (int m = 0; m < 12; ++m) v[m] = v[m] * rn * P.g_k[l * 96 + j + 8 * m];
                if (p >= CTXL) {
                    const int pos = p - CTXL;
                    const float ar = (float)(pos >> 6) * invf, ac = (float)(pos & 63) * invf;
                    double fr = (double)ar * 0.15915494309189535; fr -= rint(fr);
                    double fc = (double)ac * 0.15915494309189535; fc -= rint(fc);
                    const float sr = __builtin_amdgcn_sinf((float)fr), cr = __builtin_amdgcn_cosf((float)fr);
                    const float sc = __builtin_amdgcn_sinf((float)fc), cc = __builtin_amdgcn_cosf((float)fc);
                    const float x1a = v[8], x2a = v[10], x1b = v[9], x2b = v[11];
                    v[8] = x1a * cr - x2a * sr; v[10] = x1a * sr + x2a * cr;
                    v[9] = x1b * cc - x2b * sc; v[11] = x1b * sc + x2b * cc;
                }
                bf16_t* ko = KF + ((size_t)t * 8 + hd) * 96;
#pragma unroll
                for (int m = 0; m < 12; ++m) ko[j + 8 * m] = f2bf(v[m]);
            }
#pragma unroll
            for (int w = 0; w < 2; ++w) {
                bf16_t* q = prow + (w ? C_NK : C_NQ) + hd * 64 + j * 8;
                const float* g = (w ? P.ng_k : P.ng_q) + l * 64 + j * 8;
                float v[8], ss = 0.f;
                unpack8(w ? in_nk[rr] : in_nq[rr], v);
#pragma unroll
                for (int m = 0; m < 8; ++m) ss += v[m] * v[m];
                ss += __shfl_xor(ss, 1); ss += __shfl_xor(ss, 2); ss += __shfl_xor(ss, 4);
                const float rn = rsqrtf(ss * (1.f / 64.f) + EPS);
#pragma unroll
                for (int m = 0; m < 8; ++m) v[m] = v[m] * rn * g[m] * (w ? 1.f : 0.125f * LOG2E);
                *(uint4*)q = pack8(v);
            }
        }
        } else if (sub == 0) {
        {
            for (int rr = 0; rr < 8; ++rr) {
                const int tl = wave * 8 + rr;
                const unsigned bq = *(const unsigned*)(PB + (size_t)(t0 + tl) * PW + C_CKV + lane * 2);
                const float g0 = lo16(bq), g1 = hi16(bq);
                const float s2 = wave_sum(g0 * g0 + g1 * g1);
                if (lane == 0) rs[tl] = rsqrtf(s2 * (1.f / 128.f) + EPS);
            }
            __syncthreads();
            bf16_t* tile = (bf16_t*)(smem + 8192);
#pragma unroll
            for (int which = 0; which < 2; ++which) {
#pragma unroll
                for (int k8 = 0; k8 < 8; ++k8) {
                    const int id = tid + 256 * k8, i = id >> 6, c8 = id & 63;
                    const bf16_t* src = which ? PB + (size_t)(t0 + i) * PW + C_NV + c8 * 8
                                              : KV + (size_t)(t0 + i) * 1024 + (c8 >> 3) * 128 + 64 + (c8 & 7) * 8;
                    *(uint4*)(tile + i * 512 + c8 * 8) = *(const uint4*)src;
                }
                __syncthreads();
                bf16_t* VT = which ? VTN : VTM;
#pragma unroll
                for (int k8 = 0; k8 < 8; ++k8) {
                    const int id = tid + 256 * k8, r = id >> 2, g = id & 3;
                    float fv[8];
#pragma unroll
                    for (int i = 0; i < 8; ++i) fv[i] = bf2f(tile[(g * 8 + i) * 512 + r]) * (which ? 1.f : rs[g * 8 + i]);
                    *(uint4*)(VT + ((size_t)(bl * 8 + (r >> 6)) * 64 + (r & 63)) * TB + p0 + g * 8) = pack8(fv);
                }
                __syncthreads();
            }
        }
        } else
        {
            const int chunk = t0 >> 5;
            bf16_t* XH = (bf16_t*)(P.ws + OFF_XH);
            bf16_t* XG = (bf16_t*)(P.ws + OFF_XG);
            float* EBH = (float*)(P.ws + OFF_EBH);
            float* EBG = (float*)(P.ws + OFF_EBG);
            bf16_t* base = PB + (size_t)t0 * PW;
            float* rsh = (float*)smem + 256;
            bf16_t* inA = (bf16_t*)(smem + 8192);
            bf16_t* inB = inA + 32 * 128;
            bf16_t* inC = inB + 32 * 128;
            bf16_t* outT = inC + 32 * 128;
#pragma unroll
            for (int k4 = 0; k4 < 4; ++k4) { const int id = tid + 256 * k4, i = id >> 5, jx = id & 31; rsh[id] = bf2f(base[(size_t)i * PW + C_GR + jx]); }
            const int d = tid & 127, dr = tid >> 7;
            { const int grp = sub - 5;
                const bool isg = grp >= 4;
                const int gcol = isg ? (grp - 4) * 128 : grp * 128;
                const int cA = isg ? C_GQ + gcol : C_HQ + gcol, cB = isg ? C_GK + gcol : C_HF + gcol, cC = C_HF + 512 + gcol;
#pragma unroll
                for (int k2 = 0; k2 < 2; ++k2) {
                    const int id = tid + 256 * k2, i = id >> 4, ch = id & 15;
                    const bf16_t* row = base + (size_t)i * PW;
                    *(uint4*)(inA + i * 128 + ch * 8) = *(const uint4*)(row + cA + ch * 8);
                    *(uint4*)(inB + i * 128 + ch * 8) = *(const uint4*)(row + cB + ch * 8);
                    if (!isg) *(uint4*)(inC + i * 128 + ch * 8) = *(const uint4*)(row + cC + ch * 8);
                }
                __syncthreads();
                {
                    const int col = gcol + d;
                    float lb = 0.f, b2 = 0.f, w2[16];
#pragma unroll
                    for (int jx = 0; jx < 16; ++jx) w2[jx] = 0.f;
                    if (isg) {
#pragma unroll
                        for (int jx = 0; jx < 16; ++jx) w2[jx] = P.gla_w2[((size_t)(l * 2 + dr) * 16 + jx) * 256 + col];
                        b2 = P.gla_b2[(l * 2 + dr) * 256 + col];
                    } else if (l != 0) lb = sigmoidf_(P.lb_logits[1024 + dr * 512 + col] - P.lb_logits[dr * 512 + col]);
                    const bf16_t* fsrc = (dr && !isg) ? inC : inB;
                    bf16_t* oq = outT + (dr ? 2 : 0) * 32 * 128;
                    bf16_t* ok = oq + 32 * 128;
                    float cum = 0.f;
#pragma unroll 4
                    for (int sx = 0; sx < 32; ++sx) {
                        const int i = dr ? 31 - sx : sx;
                        const float qv = bf2f(inA[i * 128 + d]), fv = bf2f(fsrc[i * 128 + d]);
                        float qq, kk, la;
                        if (isg) {
                            float g = b2;
#pragma unroll
                            for (int jx = 0; jx < 16; ++jx) g = fmaf(rsh[i * 32 + dr * 16 + jx], w2[jx], g);
                            la = (fminf(g, 0.f) - __logf(1.f + __expf(-fabsf(g)))) * 0.0625f;
                            qq = qv * 0.125f; kk = fv;
                        } else {
                            const float av = lb + (1.f - lb) * sigmoidf_(fv);
                            la = __logf(av); kk = 1.f - av;
                            qq = siluf_(qv) * 0.08838834764831845f;
                        }
                        cum += la;
                        oq[i * 128 + d] = f2bf(qq * __expf(cum));
                        ok[i * 128 + d] = f2bf(kk * __expf(-cum));
                    }
                    if (isg) EBG[(size_t)(chunk * 2 + dr) * 256 + col] = __expf(cum);
                    else EBH[(size_t)(chunk * 2 + dr) * 512 + col] = __expf(cum);
                }
                __syncthreads();
#pragma unroll
                for (int k2 = 0; k2 < 2; ++k2) {
                    const int id = tid + 256 * k2, i = id >> 4, ch = id & 15;
                    bf16_t* row = base + (size_t)i * PW;
                    const uint4 v0 = *(const uint4*)(outT + (0 * 32 + i) * 128 + ch * 8), v1 = *(const uint4*)(outT + (1 * 32 + i) * 128 + ch * 8);
                    const uint4 v2 = *(const uint4*)(outT + (2 * 32 + i) * 128 + ch * 8), v3 = *(const uint4*)(outT + (3 * 32 + i) * 128 + ch * 8);
                    *(uint4*)(row + cA + ch * 8) = v0;
                    *(uint4*)(row + cB + ch * 8) = v1;
                    if (isg) { bf16_t* xr = XG + (size_t)(t0 + i) * 512 + gcol + ch * 8; *(uint4*)xr = v2; *(uint4*)(xr + 256) = v3; }
                    else { *(uint4*)(XH + (size_t)(t0 + i) * 512 + gcol + ch * 8) = v2; *(uint4*)(row + cC + ch * 8) = v3; }
                }
                __syncthreads();
            }
        }
    }
}

template <int DQK, bool NAT>
__device__ void attn_item(const Params& P, int l, int bl, int head, int qb, unsigned char* smem) {
    constexpr int NKS = DQK / 16, KSTR = DQK + 8, VSTR = 68, KCH = DQK / 8, KLD = (DQK * 64 / 8) / 256;
    const int tid = tid_opaque(), lane = tid & 63, wave = tid >> 6, hh = lane >> 5, r32 = lane & 31;
    bf16_t* Ks = (bf16_t*)smem;
    bf16_t* Vs = Ks + 2 * 64 * KSTR;
    float* rpb_s = (float*)(Vs + 2 * 64 * VSTR);
    bf16_t* PB = (bf16_t*)(P.ws + OFF_PB);
    const int rowbase = bl * TB, q_p0 = qb * 128, ql = wave * 32 + r32;
    const bool q_ctx = qb < 2;
    int lt0 = 0, lt1 = 0;
    int qr = 0, qc = 0, r0w = 0, c0 = 0;
    if (!q_ctx) {
        if (NAT) { const int rp = qb - 2, ra = 2 * rp, rb = ra + 1; lt0 = min(max(ra - 4, 0), 120); lt1 = min(max(rb - 4, 0), 120) + 8;
            qr = ra + (wave >> 1); qc = (wave & 1) * 32 + r32; r0w = min(max(qr - 4, 0), 120); c0 = min(max(qc - 8, 0), 48); }
        else { lt0 = 0; lt1 = 128; }
    }
    const int ntiles = 4 + (lt1 - lt0);
    const bf16_t* Kbase; const bf16_t* VT; const bf16_t* qptr; int k_ld;
    if (NAT) { Kbase = PB + (size_t)rowbase * PW + C_NK + head * 64; k_ld = PW; VT = (const bf16_t*)(P.ws + OFF_VTN) + (size_t)(bl * 8 + head) * 64 * TB;
        qptr = PB + (size_t)(rowbase + q_p0 + ql) * PW + C_NQ + head * 64; }
    else { Kbase = (const bf16_t*)(P.ws + OFF_KF) + (size_t)rowbase * 768 + head * 96; k_ld = 768; VT = (const bf16_t*)(P.ws + OFF_VTM) + (size_t)(bl * 8 + head) * 64 * TB;
        qptr = (const bf16_t*)(P.ws + OFF_QF) + (size_t)(rowbase + q_p0 + ql) * 768 + head * 96; }
    if (NAT) { for (int i = tid; i < 465; i += 256) rpb_s[i] = P.rpb[(size_t)(l * 8 + head) * 465 + i] * LOG2E; }
    bf16x8 qf[NKS];
#pragma unroll
    for (int ks = 0; ks < NKS; ++ks) qf[ks] = *(const bf16x8*)(qptr + ks * 16 + hh * 8);
    bf16x8 qrot4 = qf[NKS - 2], qrot5 = qf[NKS - 1];
    if (!NAT && !q_ctx) {
        const int pos = q_p0 - CTXL + ql;
        const float base = hh ? (float)(pos & 63) : (float)(pos >> 6);
#pragma unroll
        for (int jj = 0; jj < 8; ++jj) {
            const float invf = __powf(10000.f, -(float)jj * 0.125f);
            const float ang = base * invf;
            double fr = (double)ang * 0.15915494309189535; fr -= rint(fr);
            const float sn = __builtin_amdgcn_sinf((float)fr), cs = __builtin_amdgcn_cosf((float)fr);
            const float x1 = bf2f((bf16_t)qf[4][jj]), x2 = bf2f((bf16_t)qf[5][jj]);
            qrot4[jj] = (short)f2bf(x1 * cs - x2 * sn);
            qrot5[jj] = (short)f2bf(x1 * sn + x2 * cs);
        }
    }
    float m_run = -1e30f, lsum = 0.f;
    f32x16 oacc[2];
#pragma unroll
    for (int r = 0; r < 16; ++r) { oacc[0][r] = 0.f; oacc[1][r] = 0.f; }
    uint4 kreg0A, kreg1A, kreg2A, vreg0A, vreg1A, kreg0B, kreg1B, kreg2B, vreg0B, vreg1B;
    kreg2A = kreg2B = make_uint4(0, 0, 0, 0);
    const int kid0 = tid, kid1 = tid + 256, kid2 = tid + 512;
    const int krow0 = kid0 / KCH, kch0 = kid0 % KCH, krow1 = kid1 / KCH, kch1 = kid1 % KCH, krow2 = kid2 / KCH, kch2 = kid2 % KCH;
    const int vrow0 = tid >> 3, vch = tid & 7, vrow1 = vrow0 + 32;
#define TILE_P(ti) ((ti) < 4 ? (ti) * 64 : CTXL + (lt0 + (ti) - 4) * 64)
#define GLOAD(ti, S) { const int p_ = TILE_P(ti); \
        kreg0##S = *(const uint4*)(Kbase + (size_t)(p_ + krow0) * k_ld + kch0 * 8); \
        kreg1##S = *(const uint4*)(Kbase + (size_t)(p_ + krow1) * k_ld + kch1 * 8); \
        if (KLD > 2) kreg2##S = *(const uint4*)(Kbase + (size_t)(p_ + krow2) * k_ld + kch2 * 8); \
        vreg0##S = *(const uint4*)(VT + (size_t)vrow0 * TB + p_ + vch * 8); \
        vreg1##S = *(const uint4*)(VT + (size_t)vrow1 * TB + p_ + vch * 8); }
#define SWRITE(buf_, S) { bf16_t* kd_ = Ks + (buf_) * 64 * KSTR; \
        *(uint4*)(kd_ + krow0 * KSTR + kch0 * 8) = kreg0##S; *(uint4*)(kd_ + krow1 * KSTR + kch1 * 8) = kreg1##S; \
        if (KLD > 2) *(uint4*)(kd_ + krow2 * KSTR + kch2 * 8) = kreg2##S; \
        bf16_t* vd_ = Vs + (buf_) * 64 * VSTR + vch * 8; \
        *(uint2*)(vd_ + vrow0 * VSTR) = make_uint2(vreg0##S.x, vreg0##S.y); *(uint2*)(vd_ + vrow0 * VSTR + 4) = make_uint2(vreg0##S.z, vreg0##S.w); \
        *(uint2*)(vd_ + vrow1 * VSTR) = make_uint2(vreg1##S.x, vreg1##S.y); *(uint2*)(vd_ + vrow1 * VSTR + 4) = make_uint2(vreg1##S.z, vreg1##S.w); }
    GLOAD(0, A); SWRITE(0, A);
    { const int t1_ = 1 < ntiles ? 1 : ntiles - 1; GLOAD(t1_, B); }
    __syncthreads();
    for (int ti0 = 0; ti0 < ntiles; ti0 += 2) {
        { const int tl_ = ti0 + 2 < ntiles ? ti0 + 2 : ntiles - 1; GLOAD(tl_, A); asm volatile("" ::: "memory"); }
        { const int ti = ti0; const int buf = 0;
        if (!NAT && ti == 4) { qf[NKS - 2] = qrot4; qf[NKS - 1] = qrot5; }
        const int kr = lt0 + ti - 4;
        const bool active = !NAT || ti < 4 || (kr >= r0w && kr < r0w + 8);
        if (active) {
            const bf16_t* kb = Ks + buf * 64 * KSTR + r32 * KSTR + hh * 8;
            f32x16 st0, st1;
#pragma unroll
            for (int r = 0; r < 16; ++r) { st0[r] = 0.f; st1[r] = 0.f; }
            bf16x8 kf0[NKS], kf1[NKS];
#pragma unroll
            for (int ks = 0; ks < NKS; ++ks) { kf0[ks] = *(const bf16x8*)(kb + ks * 16); kf1[ks] = *(const bf16x8*)(kb + 32 * KSTR + ks * 16); }
            asm volatile("s_waitcnt lgkmcnt(0)" ::: "memory");
#pragma unroll
            for (int ks = 0; ks < NKS; ++ks) {
                st0 = __builtin_amdgcn_mfma_f32_32x32x16_bf16(kf0[ks], qf[ks], st0, 0, 0, 0);
                st1 = __builtin_amdgcn_mfma_f32_32x32x16_bf16(kf1[ks], qf[ks], st1, 0, 0, 0);
            }
            const bf16_t* vb = Vs + buf * 64 * VSTR + r32 * VSTR + 4 * hh;
            uint2 vfr[2][2][2][2];
#pragma unroll
            for (int uu = 0; uu < 2; ++uu)
#pragma unroll
                for (int t = 0; t < 2; ++t)
#pragma unroll
                    for (int s2 = 0; s2 < 2; ++s2) {
                        const bf16_t* a = vb + uu * 32 * VSTR + t * 32 + s2 * 16;
                        vfr[uu][t][s2][0] = *(const uint2*)a; vfr[uu][t][s2][1] = *(const uint2*)(a + 8);
                    }
            float x[32];
#pragma unroll
            for (int r = 0; r < 16; ++r) { x[r] = st0[r]; x[16 + r] = st1[r]; }
            if (NAT && ti >= 4) {
                const int dr = kr - qr + 7;
#pragma unroll
                for (int e = 0; e < 32; ++e) {
                    const int r = e & 15, kc = (e >> 4) * 32 + (r & 3) + 8 * (r >> 2) + 4 * hh;
                    const int dc = min(max(kc - qc, -15), 15) + 15;
                    const bool ok = (kc >= c0) && (kc < c0 + 16);
                    x[e] = ok ? x[e] + rpb_s[dr * 31 + dc] : -1e30f;
                }
            }
            float mx = x[0];
#pragma unroll
            for (int e = 1; e < 32; ++e) mx = fmaxf(mx, x[e]);
            mx = fmaxf(mx, __shfl_xor(mx, 32));
            const float m_new = fmaxf(m_run, mx);
            const bool resc = __ballot(m_new > m_run) != 0ull;
            const float alpha = __builtin_amdgcn_exp2f(m_run - m_new);
            m_run = m_new;
            float ps = 0.f;
#pragma unroll
            for (int e = 0; e < 32; ++e) { x[e] = __builtin_amdgcn_exp2f(x[e] - m_new); ps += x[e]; }
            lsum = lsum * alpha + ps;
            if (resc) {
#pragma unroll
                for (int r = 0; r < 16; ++r) { oacc[0][r] *= alpha; oacc[1][r] *= alpha; }
            }
            bf16x8 pf[2][2];
#pragma unroll
            for (int t = 0; t < 2; ++t)
#pragma unroll
                for (int s = 0; s < 2; ++s) {
                    union { bf16x8 v; unsigned u[4]; } cv;
#pragma unroll
                    for (int q = 0; q < 4; ++q) cv.u[q] = cvt_pk(x[16 * t + 8 * s + 2 * q], x[16 * t + 8 * s + 2 * q + 1]);
                    pf[t][s] = cv.v;
                }
#pragma unroll
            for (int uu = 0; uu < 2; ++uu)
#pragma unroll
                for (int t = 0; t < 2; ++t)
#pragma unroll
                    for (int s = 0; s < 2; ++s) {
                        union { bf16x8 v; uint2 h[2]; } cv;
                        cv.h[0] = vfr[uu][t][s][0]; cv.h[1] = vfr[uu][t][s][1];
                        oacc[uu] = __builtin_amdgcn_mfma_f32_32x32x16_bf16(cv.v, pf[t][s], oacc[uu], 0, 0, 0);
                    }
        }
        }
        SWRITE(1, B);
        __syncthreads();
        if (ti0 + 1 >= ntiles) break;
        { const int tl_ = ti0 + 3 < ntiles ? ti0 + 3 : ntiles - 1; GLOAD(tl_, B); asm volatile("" ::: "memory"); }
        { const int ti = ti0 + 1; const int buf = 1;
        if (!NAT && ti == 4) { qf[NKS - 2] = qrot4; qf[NKS - 1] = qrot5; }
        const int kr = lt0 + ti - 4;
        const bool active = !NAT || ti < 4 || (kr >= r0w && kr < r0w + 8);
        if (active) {
            const bf16_t* kb = Ks + buf * 64 * KSTR + r32 * KSTR + hh * 8;
            f32x16 st0, st1;
#pragma unroll
            for (int r = 0; r < 16; ++r) { st0[r] = 0.f; st1[r] = 0.f; }
            bf16x8 kf0[NKS], kf1[NKS];
#pragma unroll
            for (int ks = 0; ks < NKS; ++ks) { kf0[ks] = *(const bf16x8*)(kb + ks * 16); kf1[ks] = *(const bf16x8*)(kb + 32 * KSTR + ks * 16); }
            asm volatile("s_waitcnt lgkmcnt(0)" ::: "memory");
#pragma unroll
            for (int ks = 0; ks < NKS; ++ks) {
                st0 = __builtin_amdgcn_mfma_f32_32x32x16_bf16(kf0[ks], qf[ks], st0, 0, 0, 0);
                st1 = __builtin_amdgcn_mfma_f32_32x32x16_bf16(kf1[ks], qf[ks], st1, 0, 0, 0);
            }
            const bf16_t* vb = Vs + buf * 64 * VSTR + r32 * VSTR + 4 * hh;
            uint2 vfr[2][2][2][2];
#pragma unroll
            for (int uu = 0; uu < 2; ++uu)
#pragma unroll
                for (int t = 0; t < 2; ++t)
#pragma unroll
                    for (int s2 = 0; s2 < 2; ++s2) {
                        const bf16_t* a = vb + uu * 32 * VSTR + t * 32 + s2 * 16;
                        vfr[uu][t][s2][0] = *(const uint2*)a; vfr[uu][t][s2][1] = *(const uint2*)(a + 8);
                    }
            float x[32];
#pragma unroll
            for (int r = 0; r < 16; ++r) { x[r] = st0[r]; x[16 + r] = st1[r]; }
            if (NAT && ti >= 4) {
                const int dr = kr - qr + 7;
#pragma unroll
                for (int e = 0; e < 32; ++e) {
                    const int r = e & 15, kc = (e >> 4) * 32 + (r & 3) + 8 * (r >> 2) + 4 * hh;
                    const int dc = min(max(kc - qc, -15), 15) + 15;
                    const bool ok = (kc >= c0) && (kc < c0 + 16);
                    x[e] = ok ? x[e] + rpb_s[dr * 31 + dc] : -1e30f;
                }
            }
            float mx = x[0];
#pragma unroll
            for (int e = 1; e < 32; ++e) mx = fmaxf(mx, x[e]);
            mx = fmaxf(mx, __shfl_xor(mx, 32));
            const float m_new = fmaxf(m_run, mx);
            const bool resc = __ballot(m_new > m_run) != 0ull;
            const float alpha = __builtin_amdgcn_exp2f(m_run - m_new);
            m_run = m_new;
            float ps = 0.f;
#pragma unroll
            for (int e = 0; e < 32; ++e) { x[e] = __builtin_amdgcn_exp2f(x[e] - m_new); ps += x[e]; }
            lsum = lsum * alpha + ps;
            if (resc) {
#pragma unroll
                for (int r = 0; r < 16; ++r) { oacc[0][r] *= alpha; oacc[1][r] *= alpha; }
            }
            bf16x8 pf[2][2];
#pragma unroll
            for (int t = 0; t < 2; ++t)
#pragma unroll
                for (int s = 0; s < 2; ++s) {
                    union { bf16x8 v; unsigned u[4]; } cv;
#pragma unroll
                    for (int q = 0; q < 4; ++q) cv.u[q] = cvt_pk(x[16 * t + 8 * s + 2 * q], x[16 * t + 8 * s + 2 * q + 1]);
                    pf[t][s] = cv.v;
                }
#pragma unroll
            for (int uu = 0; uu < 2; ++uu)
#pragma unroll
                for (int t = 0; t < 2; ++t)
#pragma unroll
                    for (int s = 0; s < 2; ++s) {
                        union { bf16x8 v; uint2 h[2]; } cv;
                        cv.h[0] = vfr[uu][t][s][0]; cv.h[1] = vfr[uu][t][s][1];
                        oacc[uu] = __builtin_amdgcn_mfma_f32_32x32x16_bf16(cv.v, pf[t][s], oacc[uu], 0, 0, 0);
                    }
        }
        }
        SWRITE(0, A);
        __syncthreads();
    }
#undef TILE_P
#undef GLOAD
#undef SWRITE
    lsum += __shfl_xor(lsum, 32);
    const float inv = 1.f / lsum;
    bf16_t* zrow = PB + (size_t)(rowbase + q_p0 + ql) * PW + C_Z + (NAT ? 512 : 0) + head * 64;
#pragma unroll
    for (int uu = 0; uu < 2; ++uu)
#pragma unroll
        for (int g = 0; g < 4; ++g) {
            bf16_t* zp = zrow + uu * 32 + 8 * g + 4 * hh;
            const uint2 z = *(const uint2*)zp;
            uint2 o;
            o.x = cvt_pk(oacc[uu][4 * g + 0] * inv * siluf_(lo16(z.x)), oacc[uu][4 * g + 1] * inv * siluf_(hi16(z.x)));
            o.y = cvt_pk(oacc[uu][4 * g + 2] * inv * siluf_(lo16(z.y)), oacc[uu][4 * g + 3] * inv * siluf_(hi16(z.y)));
            *(uint2*)zp = o;
        }
}

__device__ void scan_hg_item(const Params& P, int l, int item, unsigned char* smem) {
    const int tid = tid_opaque(), lane = tid & 63, wave = tid >> 6;
    const int slice = item & 7, dir = (item >> 3) & 1, head = (item >> 4) & 3, bl = item >> 6;
    float* a_s = (float*)smem;
    float* q_s = a_s + 64 * 128;
    float* v_s = q_s + 64 * 128;
    float* o_s = v_s + 64 * 16;
    const bf16_t* PB = (const bf16_t*)(P.ws + OFF_PB) + (size_t)bl * TB * PW;
    bf16_t* OS = (bf16_t*)(P.ws + OFF_KV) + ((size_t)dir * NTH + (size_t)bl * TB) * 512 + head * 128 + slice * 16;
    const int prow = tid >> 4, pd = (tid & 15) * 8;
    float lb[8];
#pragma unroll
    for (int e = 0; e < 8; ++e) {
        const int cidx = dir * 512 + head * 128 + pd + e;
        lb[e] = (l == 0) ? 0.f : sigmoidf_(P.lb_logits[1024 + cidx] - P.lb_logits[cidx]);
    }
    const int fcol = (dir ? C_HF + 512 : C_HF) + head * 128 + pd, qcol = C_HQ + head * 128 + pd, vcol = C_HI + head * 128 + slice * 16 + (tid & 1) * 8;
    uint4 rq[4], rf[4], rv;
    auto chunk_p = [&](int c) { const int ci = dir ? (c < 4 ? 3 - c : 135 - c) : c; return ci * 64; };
    auto gload = [&](int c) {
        const int p = chunk_p(c);
#pragma unroll
        for (int r = 0; r < 4; ++r) { const bf16_t* row = PB + (size_t)(p + prow + 16 * r) * PW; rq[r] = *(const uint4*)(row + qcol); rf[r] = *(const uint4*)(row + fcol); }
        if (tid < 128) rv = *(const uint4*)(PB + (size_t)(p + (tid >> 1)) * PW + vcol);
    };
    const int dg = lane & 15, col = wave * 4 + (lane >> 4);
    float S[8];
#pragma unroll
    for (int e = 0; e < 8; ++e) S[e] = 0.f;
    gload(0);
    for (int c = 0; c < 132; ++c) {
        __syncthreads();
#pragma unroll
        for (int r = 0; r < 4; ++r) {
            float fq[8], ff[8];
            unpack8(rq[r], fq); unpack8(rf[r], ff);
            float* ad = a_s + (prow + 16 * r) * 128 + pd; float* qd = q_s + (prow + 16 * r) * 128 + pd;
#pragma unroll
            for (int e = 0; e < 8; ++e) { ad[e] = lb[e] + (1.f - lb[e]) * sigmoidf_(ff[e]); qd[e] = siluf_(fq[e]) * 0.08838834764831845f; }
        }
        if (tid < 128) { float fv[8]; unpack8(rv, fv); float* vd = v_s + (tid >> 1) * 16 + (tid & 1) * 8;
#pragma unroll
            for (int e = 0; e < 8; ++e) vd[e] = fv[e]; }
        __syncthreads();
        if (c + 1 < 132) gload(c + 1);
        for (int tt = 0; tt < 64; tt += 8) {
            float op[8];
#pragma unroll
            for (int u = 0; u < 8; ++u) {
                const int i = dir ? 63 - (tt + u) : tt + u;
                const float4 a0 = *(const float4*)(a_s + i * 128 + dg * 8), a1 = *(const float4*)(a_s + i * 128 + dg * 8 + 4);
                const float4 q0 = *(const float4*)(q_s + i * 128 + dg * 8), q1 = *(const float4*)(q_s + i * 128 + dg * 8 + 4);
                const float v = v_s[i * 16 + col];
                float o;
                S[0] = fmaf(a0.x, S[0] - v, v); o = q0.x * S[0];
                S[1] = fmaf(a0.y, S[1] - v, v); o = fmaf(q0.y, S[1], o);
                S[2] = fmaf(a0.z, S[2] - v, v); o = fmaf(q0.z, S[2], o);
                S[3] = fmaf(a0.w, S[3] - v, v); o = fmaf(q0.w, S[3], o);
                S[4] = fmaf(a1.x, S[4] - v, v); o = fmaf(q1.x, S[4], o);
                S[5] = fmaf(a1.y, S[5] - v, v); o = fmaf(q1.y, S[5], o);
                S[6] = fmaf(a1.z, S[6] - v, v); o = fmaf(q1.z, S[6], o);
                S[7] = fmaf(a1.w, S[7] - v, v); o = fmaf(q1.w, S[7], o);
                op[u] = o;
            }
            float r4[4], r2[2];
            const bool b8 = dg & 8, b4 = dg & 4, b2 = dg & 2;
#pragma unroll
            for (int k = 0; k < 4; ++k) { const float snd = b8 ? op[k] : op[k + 4], kp = b8 ? op[k + 4] : op[k]; r4[k] = kp + __shfl_xor(snd, 8); }
#pragma unroll
            for (int k = 0; k < 2; ++k) { const float snd = b4 ? r4[k] : r4[k + 2], kp = b4 ? r4[k + 2] : r4[k]; r2[k] = kp + __shfl_xor(snd, 4); }
            float r1; { const float snd = b2 ? r2[0] : r2[1], kp = b2 ? r2[1] : r2[0]; r1 = kp + __shfl_xor(snd, 2); }
            r1 += __shfl_xor(r1, 1);
            if ((dg & 1) == 0) { const int tok = tt + (b8 ? 4 : 0) + (b4 ? 2 : 0) + (b2 ? 1 : 0); const int i = dir ? 63 - tok : tok; o_s[i * 16 + col] = r1; }
        }
        __syncthreads();
        if (tid < 128) {
            const int p = chunk_p(c) + (tid >> 1);
            *(uint4*)(OS + (size_t)p * 512 + (tid & 1) * 8) = pack8(o_s + (tid >> 1) * 16 + (tid & 1) * 8);
        }
    }
}

__device__ void scan_gla_item(const Params& P, int l, int item, unsigned char* smem) {
    const int tid = tid_opaque(), lane = tid & 63, wave = tid >> 6;
    const int slice = item & 3, dir = (item >> 2) & 1, head = (item >> 3) & 3, bl = item >> 5;
    float* a_s = (float*)smem;
    float* q_s = a_s + 64 * 64;
    float* k_s = q_s + 64 * 64;
    float* v_s = k_s + 64 * 64;
    float* o_s = v_s + 64 * 32;
    float* r_s = o_s + 64 * 32;
    const bf16_t* PB = (const bf16_t*)(P.ws + OFF_PB) + (size_t)bl * TB * PW;
    bf16_t* OS = (bf16_t*)(P.ws + OFF_OSG) + ((size_t)dir * NTH + (size_t)bl * TB) * 512 + head * 128 + slice * 32;
    const int gd = tid & 63, gt0 = tid >> 6;
    float w2[16];
#pragma unroll
    for (int jx = 0; jx < 16; ++jx) w2[jx] = P.gla_w2[((size_t)(l * 2 + dir) * 16 + jx) * 256 + head * 64 + gd];
    const float b2 = P.gla_b2[(l * 2 + dir) * 256 + head * 64 + gd];
    uint4 rq[2], rk[2], rv, rr;
    auto chunk_p = [&](int c) { const int ci = dir ? (c < 4 ? 3 - c : 135 - c) : c; return ci * 64; };
    auto gload = [&](int c) {
        const int p = chunk_p(c);
#pragma unroll
        for (int i = 0; i < 2; ++i) { const int id = tid + 256 * i, row = id >> 3, ch = id & 7; const bf16_t* rp = PB + (size_t)(p + row) * PW;
            rq[i] = *(const uint4*)(rp + C_GQ + head * 64 + ch * 8); rk[i] = *(const uint4*)(rp + C_GK + head * 64 + ch * 8); }
        { const int row = tid >> 2, ch = tid & 3; rv = *(const uint4*)(PB + (size_t)(p + row) * PW + C_GV + head * 128 + slice * 32 + ch * 8); }
        if (tid < 128) { const int row = tid >> 1, ch = tid & 1; rr = *(const uint4*)(PB + (size_t)(p + row) * PW + C_GR + dir * 16 + ch * 8); }
    };
    const int dg = lane & 7, col = wave * 8 + (lane >> 3);
    float S[8];
#pragma unroll
    for (int e = 0; e < 8; ++e) S[e] = 0.f;
    gload(0);
    for (int c = 0; c < 132; ++c) {
        __syncthreads();
#pragma unroll
        for (int i = 0; i < 2; ++i) { const int id = tid + 256 * i, row = id >> 3, ch = id & 7; float fq[8], fk[8]; unpack8(rq[i], fq); unpack8(rk[i], fk);
#pragma unroll
            for (int e = 0; e < 8; ++e) { q_s[row * 64 + ch * 8 + e] = fq[e] * 0.125f; k_s[row * 64 + ch * 8 + e] = fk[e]; } }
        { const int row = tid >> 2, ch = tid & 3; float fv[8]; unpack8(rv, fv);
#pragma unroll
            for (int e = 0; e < 8; ++e) v_s[row * 32 + ch * 8 + e] = fv[e]; }
        if (tid < 128) { const int row = tid >> 1, ch = tid & 1; float fr[8]; unpack8(rr, fr);
#pragma unroll
            for (int e = 0; e < 8; ++e) r_s[row * 16 + ch * 8 + e] = fr[e]; }
        __syncthreads();
        if (c + 1 < 132) gload(c + 1);
#pragma unroll 4
        for (int m = 0; m < 16; ++m) {
            const int i = gt0 + 4 * m;
            float g = b2;
#pragma unroll
            for (int jx = 0; jx < 16; ++jx) g = fmaf(r_s[i * 16 + jx], w2[jx], g);
            const float ls = fminf(g, 0.f) - __logf(1.f + __expf(-fabsf(g)));
            a_s[i * 64 + gd] = __expf(ls * 0.0625f);
        }
        __syncthreads();
        for (int tt = 0; tt < 64; tt += 8) {
            float op[8];
#pragma unroll
            for (int u = 0; u < 8; ++u) {
                const int i = dir ? 63 - (tt + u) : tt + u;
                const float4 a0 = *(const float4*)(a_s + i * 64 + dg * 8), a1 = *(const float4*)(a_s + i * 64 + dg * 8 + 4);
                const float4 q0 = *(const float4*)(q_s + i * 64 + dg * 8), q1 = *(const float4*)(q_s + i * 64 + dg * 8 + 4);
                const float4 k0 = *(const float4*)(k_s + i * 64 + dg * 8), k1 = *(const float4*)(k_s + i * 64 + dg * 8 + 4);
                const float v = v_s[i * 32 + col];
                float o;
                S[0] = fmaf(a0.x, S[0], k0.x * v); o = q0.x * S[0];
                S[1] = fmaf(a0.y, S[1], k0.y * v); o = fmaf(q0.y, S[1], o);
                S[2] = fmaf(a0.z, S[2], k0.z * v); o = fmaf(q0.z, S[2], o);
                S[3] = fmaf(a0.w, S[3], k0.w * v); o = fmaf(q0.w, S[3], o);
                S[4] = fmaf(a1.x, S[4], k1.x * v); o = fmaf(q1.x, S[4], o);
                S[5] = fmaf(a1.y, S[5], k1.y * v); o = fmaf(q1.y, S[5], o);
                S[6] = fmaf(a1.z, S[6], k1.z * v); o = fmaf(q1.z, S[6], o);
                S[7] = fmaf(a1.w, S[7], k1.w * v); o = fmaf(q1.w, S[7], o);
                op[u] = o;
            }
            float r4[4], r2[2];
            const bool b4 = dg & 4, b2 = dg & 2, b1 = dg & 1;
#pragma unroll
            for (int k = 0; k < 4; ++k) { const float snd = b4 ? op[k] : op[k + 4], kp = b4 ? op[k + 4] : op[k]; r4[k] = kp + __shfl_xor(snd, 4); }
#pragma unroll
            for (int k = 0; k < 2; ++k) { const float snd = b2 ? r4[k] : r4[k + 2], kp = b2 ? r4[k + 2] : r4[k]; r2[k] = kp + __shfl_xor(snd, 2); }
            float r1; { const float snd = b1 ? r2[0] : r2[1], kp = b1 ? r2[1] : r2[0]; r1 = kp + __shfl_xor(snd, 1); }
            { const int tok = tt + (b4 ? 4 : 0) + (b2 ? 2 : 0) + (b1 ? 1 : 0); const int i = dir ? 63 - tok : tok; o_s[i * 32 + col] = r1; }
        }
        __syncthreads();
        { const int row = tid >> 2, ch = tid & 3; const int p = chunk_p(c) + row;
          *(uint4*)(OS + (size_t)p * 512 + ch * 8) = pack8(o_s + row * 32 + ch * 8); }
    }
}


template <bool GLA>
__device__ void scan2_item(const Params& P, int l, int item, unsigned char* smem) {
    constexpr int DK = GLA ? 64 : 128, NT = DK / 32, QS = DK + 8, TS = 40, NSEG = GLA ? 4 : 2, TPS = 32 / NSEG, QCH = DK / 8;
    const int tid = tid_opaque(), lane = tid & 63, wave = tid >> 6, r32 = lane & 31, hh = lane >> 5;
    const int dir = item & 1, head = (item >> 1) & 3, bl = item >> 3;
    bf16_t* Qh = (bf16_t*)smem;
    bf16_t* Kh = Qh + 32 * QS;
    bf16_t* Kt = Kh + 32 * QS;
    bf16_t* Vt = Kt + DK * TS;
    float* eb = (float*)(Vt + 128 * TS);
    float* tot = eb + DK;
    bf16_t* qraw = (bf16_t*)(tot + 4 * DK);
    bf16_t* fraw = qraw + 32 * DK;
    bf16_t* vraw = fraw + 32 * DK;
    bf16_t* rraw = vraw + 32 * 128;
    const bf16_t* PB = (const bf16_t*)(P.ws + OFF_PB) + (size_t)bl * TB * PW;
    bf16_t* OS = (bf16_t*)(P.ws + (GLA ? OFF_OSG : OFF_KV)) + ((size_t)dir * NTH + (size_t)bl * TB) * 512 + head * 128 + wave * 32;
    const int qcol = (GLA ? C_GQ : C_HQ) + head * DK, fcol = GLA ? (C_GK + head * 64) : ((dir ? C_HF + 512 : C_HF) + head * 128),
              vcol = (GLA ? C_GV : C_HI) + head * 128, rcol = C_GR + dir * 16;
    const int pd = tid & (DK - 1), seg = tid / DK;
    float lbv = 0.f, b2 = 0.f, w2[16];
#pragma unroll
    for (int jx = 0; jx < 16; ++jx) w2[jx] = 0.f;
    if (GLA) {
#pragma unroll
        for (int jx = 0; jx < 16; ++jx) w2[jx] = P.gla_w2[((size_t)(l * 2 + dir) * 16 + jx) * 256 + head * 64 + pd];
        b2 = P.gla_b2[(l * 2 + dir) * 256 + head * 64 + pd];
    } else if (l != 0) { const int cidx = dir * 512 + head * 128 + pd; lbv = sigmoidf_(P.lb_logits[1024 + cidx] - P.lb_logits[cidx]); }
    uint4 pq0, pq1, pf0, pf1, pv0, pv1, pr;
    pq1 = pf1 = pr = make_uint4(0, 0, 0, 0);
#define CH_P0(c) (dir ? ((c) < 8 ? (7 - (c)) * 32 : CTXL + (263 - (c)) * 32) : (c) * 32)
#define ROWP(p0_, i_) ((p0_) + (dir ? 31 - (i_) : (i_)))
#define SC_GLOAD(c) { const int p0_ = CH_P0(c); \
        { const int id = tid, i = id / QCH, ch = id % QCH; const bf16_t* rp = PB + (size_t)ROWP(p0_, i) * PW; pq0 = *(const uint4*)(rp + qcol + ch * 8); pf0 = *(const uint4*)(rp + fcol + ch * 8); } \
        if (!GLA) { const int id = tid + 256, i = id / QCH, ch = id % QCH; const bf16_t* rp = PB + (size_t)ROWP(p0_, i) * PW; pq1 = *(const uint4*)(rp + qcol + ch * 8); pf1 = *(const uint4*)(rp + fcol + ch * 8); } \
        { const int i = tid >> 4, ch = tid & 15; pv0 = *(const uint4*)(PB + (size_t)ROWP(p0_, i) * PW + vcol + ch * 8); pv1 = *(const uint4*)(PB + (size_t)ROWP(p0_, i + 16) * PW + vcol + ch * 8); } \
        if (GLA && tid < 64) { const int i = tid >> 1, ch = tid & 1; pr = *(const uint4*)(PB + (size_t)ROWP(p0_, i) * PW + rcol + ch * 8); } }
    f32x16 ST[NT];
#pragma unroll
    for (int T = 0; T < NT; ++T)
#pragma unroll
        for (int r = 0; r < 16; ++r) ST[T][r] = 0.f;
    SC_GLOAD(0);
    for (int c = 0; c < 264; ++c) {
        __syncthreads();
        { const int id = tid, i = id / QCH, ch = id % QCH; *(uint4*)(qraw + i * DK + ch * 8) = pq0; *(uint4*)(fraw + i * DK + ch * 8) = pf0; }
        if (!GLA) { const int id = tid + 256, i = id / QCH, ch = id % QCH; *(uint4*)(qraw + i * DK + ch * 8) = pq1; *(uint4*)(fraw + i * DK + ch * 8) = pf1; }
        { const int i = tid >> 4, ch = tid & 15; *(uint4*)(vraw + i * 128 + ch * 8) = pv0; *(uint4*)(vraw + (i + 16) * 128 + ch * 8) = pv1; }
        if (GLA && tid < 64) { const int i = tid >> 1, ch = tid & 1; *(uint4*)(rraw + i * 16 + ch * 8) = pr; }
        __syncthreads();
        if (c + 1 < 264) SC_GLOAD(c + 1);
        float bl_[TPS], kk[TPS], qq[TPS];
        float cum = 0.f;
#pragma unroll
        for (int tt = 0; tt < TPS; ++tt) {
            const int i = seg * TPS + tt;
            float la;
            if (GLA) {
                float g = b2;
#pragma unroll
                for (int jx = 0; jx < 16; ++jx) g = fmaf(bf2f(rraw[i * 16 + jx]), w2[jx], g);
                la = (fminf(g, 0.f) - __logf(1.f + __expf(-fabsf(g)))) * 0.0625f;
                kk[tt] = bf2f(fraw[i * DK + pd]);
                qq[tt] = bf2f(qraw[i * DK + pd]) * 0.125f;
            } else {
                const float f = bf2f(fraw[i * DK + pd]);
                const float a = lbv + (1.f - lbv) * sigmoidf_(f);
                la = __logf(a);
                kk[tt] = 1.f - a;
                qq[tt] = siluf_(bf2f(qraw[i * DK + pd])) * 0.08838834764831845f;
            }
            cum += la;
            bl_[tt] = cum;
        }
        tot[seg * DK + pd] = cum;
        __syncthreads();
        {
            float off = 0.f, bend = 0.f;
#pragma unroll
            for (int sg = 0; sg < NSEG; ++sg) { const float tv = tot[sg * DK + pd]; bend += tv; if (sg < seg) off += tv; }
            const float eend = __expf(bend);
            if (seg == 0) eb[pd] = eend;
            float kt[TPS];
#pragma unroll
            for (int tt = 0; tt < TPS; ++tt) {
                const int i = seg * TPS + tt;
                const float b = bl_[tt] + off;
                const float e1 = __expf(b), e2 = __expf(-b);
                const float kh = kk[tt] * e2;
                Qh[i * QS + pd] = f2bf(qq[tt] * e1);
                Kh[i * QS + pd] = f2bf(kh);
                kt[tt] = kh * eend;
            }
#pragma unroll
            for (int g8 = 0; g8 < TPS / 8; ++g8) *(uint4*)(Kt + pd * TS + seg * TPS + g8 * 8) = pack8(kt + g8 * 8);
            const int vc = tid & 127, vs = tid >> 7;
            float vv[16];
#pragma unroll
            for (int tt = 0; tt < 16; ++tt) vv[tt] = bf2f(vraw[(vs * 16 + tt) * 128 + vc]);
            *(uint4*)(Vt + vc * TS + vs * 16) = pack8(vv);
            *(uint4*)(Vt + vc * TS + vs * 16 + 8) = pack8(vv + 8);
        }
        __syncthreads();
        f32x16 st;
#pragma unroll
        for (int r = 0; r < 16; ++r) st[r] = 0.f;
#pragma unroll
        for (int ks = 0; ks < DK / 16; ++ks) {
            const bf16x8 ka = *(const bf16x8*)(Kh + r32 * QS + ks * 16 + hh * 8);
            const bf16x8 qb = *(const bf16x8*)(Qh + r32 * QS + ks * 16 + hh * 8);
            st = __builtin_amdgcn_mfma_f32_32x32x16_bf16(ka, qb, st, 0, 0, 0);
        }
        bf16x8 pfr[2];
#pragma unroll
        for (int sI = 0; sI < 2; ++sI) {
            union { bf16x8 v; unsigned u[4]; } cv;
#pragma unroll
            for (int q = 0; q < 4; ++q) {
                const int ra = 8 * sI + 2 * q, rb = ra + 1;
                const int ja = (ra & 3) + 8 * (ra >> 2) + 4 * hh, jb = (rb & 3) + 8 * (rb >> 2) + 4 * hh;
                cv.u[q] = cvt_pk(ja <= r32 ? st[ra] : 0.f, jb <= r32 ? st[rb] : 0.f);
            }
            pfr[sI] = cv.v;
        }
        f32x16 oT;
#pragma unroll
        for (int r = 0; r < 16; ++r) oT[r] = 0.f;
#pragma unroll
        for (int sI = 0; sI < 2; ++sI) {
            const bf16_t* a = Vt + (wave * 32 + r32) * TS + sI * 16 + 4 * hh;
            union { bf16x8 v; uint2 h[2]; } cv;
            cv.h[0] = *(const uint2*)a; cv.h[1] = *(const uint2*)(a + 8);
            oT = __builtin_amdgcn_mfma_f32_32x32x16_bf16(cv.v, pfr[sI], oT, 0, 0, 0);
        }
#pragma unroll
        for (int T = 0; T < NT; ++T)
#pragma unroll
            for (int sI = 0; sI < 2; ++sI) {
                union { bf16x8 v; unsigned u[4]; } ca;
#pragma unroll
                for (int q = 0; q < 4; ++q) ca.u[q] = cvt_pk(ST[T][8 * sI + 2 * q], ST[T][8 * sI + 2 * q + 1]);
                const bf16_t* b = Qh + r32 * QS + T * 32 + sI * 16 + 4 * hh;
                union { bf16x8 v; uint2 h[2]; } cb;
                cb.h[0] = *(const uint2*)b; cb.h[1] = *(const uint2*)(b + 8);
                oT = __builtin_amdgcn_mfma_f32_32x32x16_bf16(ca.v, cb.v, oT, 0, 0, 0);
            }
#pragma unroll
        for (int T = 0; T < NT; ++T) {
#pragma unroll
            for (int g = 0; g < 4; ++g) {
                const float4 e4 = *(const float4*)(eb + T * 32 + 8 * g + 4 * hh);
                ST[T][4 * g + 0] *= e4.x; ST[T][4 * g + 1] *= e4.y; ST[T][4 * g + 2] *= e4.z; ST[T][4 * g + 3] *= e4.w;
            }
#pragma unroll
            for (int ks = 0; ks < 2; ++ks) {
                const bf16x8 ka = *(const bf16x8*)(Kt + (T * 32 + r32) * TS + ks * 16 + hh * 8);
                const bf16x8 vb = *(const bf16x8*)(Vt + (wave * 32 + r32) * TS + ks * 16 + hh * 8);
                ST[T] = __builtin_amdgcn_mfma_f32_32x32x16_bf16(ka, vb, ST[T], 0, 0, 0);
            }
        }
        {
            const int p = ROWP(CH_P0(c), r32);
            bf16_t* op = OS + (size_t)p * 512 + 4 * hh;
#pragma unroll
            for (int g = 0; g < 4; ++g) { uint2 o; o.x = cvt_pk(oT[4 * g], oT[4 * g + 1]); o.y = cvt_pk(oT[4 * g + 2], oT[4 * g + 3]); *(uint2*)(op + 8 * g) = o; }
        }
    }
#undef CH_P0
#undef ROWP
#undef SC_GLOAD
}


template <bool GLA>
__device__ __forceinline__ void scan3_build(f32x16 (&ST)[GLA ? 2 : 4], bf16_t* Qh, bf16_t* Kh, bf16_t* Kt, bf16_t* Vt, float* eb, bf16_t* vraw, bf16_t* OS,
                                           int tid, int wave, int r32, int hh, int pd, int seg, int c, int dir) {
    constexpr int DK = GLA ? 64 : 128, NT = DK / 32, QS = DK + 8, TS = 40, NSEG = GLA ? 4 : 2, TPS = 32 / NSEG;
#define CH_P0(c) (dir ? ((c) < 8 ? (7 - (c)) * 32 : CTXL + (263 - (c)) * 32) : (c) * 32)
#define ROWP(p0_, i_) ((p0_) + (dir ? 31 - (i_) : (i_)))
        {
            const float eend = eb[pd];
            float kt[TPS];
#pragma unroll
            for (int tt = 0; tt < TPS; ++tt) kt[tt] = bf2f(Kh[(seg * TPS + tt) * QS + pd]) * eend;
#pragma unroll
            for (int g8 = 0; g8 < TPS / 8; ++g8) *(uint4*)(Kt + pd * TS + seg * TPS + g8 * 8) = pack8(kt + g8 * 8);
            const int vc = tid & 127, vs = tid >> 7;
            float vv[16];
#pragma unroll
            for (int tt = 0; tt < 16; ++tt) vv[tt] = bf2f(vraw[(vs * 16 + tt) * 128 + vc]);
            *(uint4*)(Vt + vc * TS + vs * 16) = pack8(vv);
            *(uint4*)(Vt + vc * TS + vs * 16 + 8) = pack8(vv + 8);
        }
#undef CH_P0
#undef ROWP
}

template <bool GLA>
__device__ __forceinline__ void scan3_mfma(f32x16 (&ST)[GLA ? 2 : 4], bf16_t* Qh, bf16_t* Kh, bf16_t* Kt, bf16_t* Vt, float* eb, bf16_t* vraw, bf16_t* OS,
                                           int tid, int wave, int r32, int hh, int pd, int seg, int c, int dir) {
    constexpr int DK = GLA ? 64 : 128, NT = DK / 32, QS = DK + 8, TS = 40, NSEG = GLA ? 4 : 2, TPS = 32 / NSEG;
#define CH_P0(c) (dir ? ((c) < 8 ? (7 - (c)) * 32 : CTXL + (263 - (c)) * 32) : (c) * 32)
#define ROWP(p0_, i_) ((p0_) + (dir ? 31 - (i_) : (i_)))
        f32x16 st, stb;
#pragma unroll
        for (int r = 0; r < 16; ++r) { st[r] = 0.f; stb[r] = 0.f; }
        {
            bf16x8 ka[DK / 16], qb[DK / 16];
#pragma unroll
            for (int ks = 0; ks < DK / 16; ++ks) { ka[ks] = *(const bf16x8*)(Kh + r32 * QS + ks * 16 + hh * 8); qb[ks] = *(const bf16x8*)(Qh + r32 * QS + ks * 16 + hh * 8); }
            asm volatile("s_waitcnt lgkmcnt(0)" ::: "memory");
#pragma unroll
            for (int ks = 0; ks < DK / 16; ks += 2) {
                st = __builtin_amdgcn_mfma_f32_32x32x16_bf16(ka[ks], qb[ks], st, 0, 0, 0);
                stb = __builtin_amdgcn_mfma_f32_32x32x16_bf16(ka[ks + 1], qb[ks + 1], stb, 0, 0, 0);
            }
        }
        uint2 vp[2][2], qp[NT][2][2];
#pragma unroll
        for (int sI = 0; sI < 2; ++sI) { const bf16_t* av = Vt + (wave * 32 + r32) * TS + sI * 16 + 4 * hh; vp[sI][0] = *(const uint2*)av; vp[sI][1] = *(const uint2*)(av + 8); }
#pragma unroll
        for (int T = 0; T < NT; ++T)
#pragma unroll
            for (int sI = 0; sI < 2; ++sI) { const bf16_t* bq = Qh + r32 * QS + T * 32 + sI * 16 + 4 * hh; qp[T][sI][0] = *(const uint2*)bq; qp[T][sI][1] = *(const uint2*)(bq + 8); }
#pragma unroll
        for (int r = 0; r < 16; ++r) st[r] += stb[r];
        bf16x8 pfr[2];
#pragma unroll
        for (int sI = 0; sI < 2; ++sI) {
            union { bf16x8 v; unsigned u[4]; } cv;
#pragma unroll
            for (int q = 0; q < 4; ++q) {
                const int ra = 8 * sI + 2 * q, rb = ra + 1;
                const int ja = (ra & 3) + 8 * (ra >> 2) + 4 * hh, jb = (rb & 3) + 8 * (rb >> 2) + 4 * hh;
                cv.u[q] = cvt_pk(ja <= r32 ? st[ra] : 0.f, jb <= r32 ? st[rb] : 0.f);
            }
            pfr[sI] = cv.v;
        }
        asm volatile("s_waitcnt lgkmcnt(0)" ::: "memory");
        f32x16 oT, oTb;
#pragma unroll
        for (int r = 0; r < 16; ++r) { oT[r] = 0.f; oTb[r] = 0.f; }
#pragma unroll
        for (int sI = 0; sI < 2; ++sI) {
            union { bf16x8 v; uint2 h[2]; } cv;
            cv.h[0] = vp[sI][0]; cv.h[1] = vp[sI][1];
            oT = __builtin_amdgcn_mfma_f32_32x32x16_bf16(cv.v, pfr[sI], oT, 0, 0, 0);
        }
#pragma unroll
        for (int T = 0; T < NT; ++T)
#pragma unroll
            for (int sI = 0; sI < 2; ++sI) {
                union { bf16x8 v; unsigned u[4]; } ca;
#pragma unroll
                for (int q = 0; q < 4; ++q) ca.u[q] = cvt_pk(ST[T][8 * sI + 2 * q], ST[T][8 * sI + 2 * q + 1]);
                union { bf16x8 v; uint2 h[2]; } cb;
                cb.h[0] = qp[T][sI][0]; cb.h[1] = qp[T][sI][1];
                if (T & 1) oTb = __builtin_amdgcn_mfma_f32_32x32x16_bf16(ca.v, cb.v, oTb, 0, 0, 0);
                else oT = __builtin_amdgcn_mfma_f32_32x32x16_bf16(ca.v, cb.v, oT, 0, 0, 0);
            }
        {
            bf16x8 kt2[NT][2], vb2[2];
            float4 e4v[NT][4];
#pragma unroll
            for (int ks = 0; ks < 2; ++ks) vb2[ks] = *(const bf16x8*)(Vt + (wave * 32 + r32) * TS + ks * 16 + hh * 8);
#pragma unroll
            for (int T = 0; T < NT; ++T) {
#pragma unroll
                for (int ks = 0; ks < 2; ++ks) kt2[T][ks] = *(const bf16x8*)(Kt + (T * 32 + r32) * TS + ks * 16 + hh * 8);
#pragma unroll
                for (int g = 0; g < 4; ++g) e4v[T][g] = *(const float4*)(eb + T * 32 + 8 * g + 4 * hh);
            }
            asm volatile("s_waitcnt lgkmcnt(0)" ::: "memory");
#pragma unroll
            for (int T = 0; T < NT; ++T) {
#pragma unroll
                for (int g = 0; g < 4; ++g) { ST[T][4 * g + 0] *= e4v[T][g].x; ST[T][4 * g + 1] *= e4v[T][g].y; ST[T][4 * g + 2] *= e4v[T][g].z; ST[T][4 * g + 3] *= e4v[T][g].w; }
#pragma unroll
                for (int ks = 0; ks < 2; ++ks) ST[T] = __builtin_amdgcn_mfma_f32_32x32x16_bf16(kt2[T][ks], vb2[ks], ST[T], 0, 0, 0);
            }
        }
#pragma unroll
        for (int r = 0; r < 16; ++r) oT[r] += oTb[r];
        {
            const int p = ROWP(CH_P0(c), r32);
            bf16_t* op = OS + (size_t)p * 512 + 4 * hh;
#pragma unroll
            for (int g = 0; g < 4; ++g) { uint2 o; o.x = cvt_pk(oT[4 * g], oT[4 * g + 1]); o.y = cvt_pk(oT[4 * g + 2], oT[4 * g + 3]); *(uint2*)(op + 8 * g) = o; }
        }
#undef CH_P0
#undef ROWP
}

template <bool GLA>
__device__ void scan3_item(const Params& P, int l, int item, unsigned char* smem) {
    constexpr int DK = GLA ? 64 : 128, NT = DK / 32, QS = DK + 8, TS = 40, NSEG = GLA ? 4 : 2, TPS = 32 / NSEG, QCH = DK / 8;
    const int tid = tid_opaque(), lane = tid & 63, wave = tid >> 6, r32 = lane & 31, hh = lane >> 5;
    const int dir = item & 1, head = (item >> 1) & 3, bl = item >> 3;
    __builtin_amdgcn_s_setprio(3);
    bf16_t* Qh0 = (bf16_t*)smem;
    bf16_t* Kh0 = Qh0 + 32 * QS;
    bf16_t* Qh1 = Kh0 + 32 * QS;
    bf16_t* Kh1 = Qh1 + 32 * QS;
    bf16_t* Kt = Kh1 + 32 * QS;
    bf16_t* Vt = Kt + DK * TS;
    float* eb0 = (float*)(Vt + 128 * TS);
    float* eb1 = eb0 + DK;
    bf16_t* vraw = (bf16_t*)(eb1 + DK);
    const bf16_t* PB = (const bf16_t*)(P.ws + OFF_PB) + (size_t)bl * TB * PW;
    bf16_t* OS = (bf16_t*)(P.ws + (GLA ? OFF_OSG : OFF_KV)) + ((size_t)dir * NTH + (size_t)bl * TB) * 512 + head * 128 + wave * 32;
    const bf16_t* qsrc; const bf16_t* ksrc; int qld, kld;
    if (GLA) {
        if (dir == 0) { qsrc = PB + C_GQ + head * 64; qld = PW; ksrc = PB + C_GK + head * 64; kld = PW; }
        else { const bf16_t* X = (const bf16_t*)(P.ws + OFF_XG) + (size_t)bl * TB * 512; qsrc = X + head * 64; qld = 512; ksrc = X + 256 + head * 64; kld = 512; }
    } else {
        if (dir == 0) { qsrc = PB + C_HQ + head * 128; qld = PW; ksrc = PB + C_HF + head * 128; kld = PW; }
        else { qsrc = (const bf16_t*)(P.ws + OFF_XH) + (size_t)bl * TB * 512 + head * 128; qld = 512; ksrc = PB + C_HF + 512 + head * 128; kld = PW; }
    }
    const float* ebsrc = (const float*)(P.ws + (GLA ? OFF_EBG : OFF_EBH)) + ((size_t)(bl * 264) * 2 + dir) * (4 * DK) + head * DK;
    const int vcol = (GLA ? C_GV : C_HI) + head * 128;
    const int pd = tid & (DK - 1), seg = tid / DK;
    uint4 pq0A, pq1A, pk0A, pk1A, pv0A, pv1A, pq0B, pq1B, pk0B, pk1B, pv0B, pv1B; float peA = 0.f, peB = 0.f;
    pq1A = pk1A = pq1B = pk1B = make_uint4(0, 0, 0, 0);
#define CH_P0(c) (dir ? ((c) < 8 ? (7 - (c)) * 32 : CTXL + (263 - (c)) * 32) : (c) * 32)
#define ROWP(p0_, i_) ((p0_) + (dir ? 31 - (i_) : (i_)))
#define SC_GLOAD(c, S) { const int p0_ = CH_P0(c); \
        { const int id = tid, i = id / QCH, ch = id % QCH; const size_t rr_ = (size_t)ROWP(p0_, i); pq0##S = *(const uint4*)(qsrc + rr_ * qld + ch * 8); pk0##S = *(const uint4*)(ksrc + rr_ * kld + ch * 8); } \
        if (!GLA) { const int id = tid + 256, i = id / QCH, ch = id % QCH; const size_t rr_ = (size_t)ROWP(p0_, i); pq1##S = *(const uint4*)(qsrc + rr_ * qld + ch * 8); pk1##S = *(const uint4*)(ksrc + rr_ * kld + ch * 8); } \
        { const int i = tid >> 4, ch = tid & 15; pv0##S = *(const uint4*)(PB + (size_t)ROWP(p0_, i) * PW + vcol + ch * 8); pv1##S = *(const uint4*)(PB + (size_t)ROWP(p0_, i + 16) * PW + vcol + ch * 8); } \
        if (tid < DK) pe##S = ebsrc[(size_t)(p0_ >> 5) * 2 * (4 * DK) + tid]; }
    f32x16 ST[NT];
#pragma unroll
    for (int T = 0; T < NT; ++T)
#pragma unroll
        for (int r = 0; r < 16; ++r) ST[T][r] = 0.f;
#define SC_COPY(S, QH, KH, EB) { \
        { const int id = tid, i = id / QCH, ch = id % QCH; *(uint4*)(QH + i * QS + ch * 8) = pq0##S; *(uint4*)(KH + i * QS + ch * 8) = pk0##S; } \
        if (!GLA) { const int id = tid + 256, i = id / QCH, ch = id % QCH; *(uint4*)(QH + i * QS + ch * 8) = pq1##S; *(uint4*)(KH + i * QS + ch * 8) = pk1##S; } \
        { const int i = tid >> 4, ch = tid & 15; *(uint4*)(vraw + i * 128 + ch * 8) = pv0##S; *(uint4*)(vraw + (i + 16) * 128 + ch * 8) = pv1##S; } \
        if (tid < DK) EB[tid] = pe##S; }
    SC_GLOAD(0, A);
    SC_GLOAD(1, B);
    SC_COPY(A, Qh0, Kh0, eb0);
    SC_GLOAD(2, A);
    for (int c = 0; c < 264; c += 2) {
        __syncthreads();
        scan3_build<GLA>(ST, Qh0, Kh0, Kt, Vt, eb0, vraw, OS, tid, wave, r32, hh, pd, seg, c, dir);
        __syncthreads();
        SC_COPY(B, Qh1, Kh1, eb1);
        { const int cl_ = c + 3 < 264 ? c + 3 : 263; SC_GLOAD(cl_, B); asm volatile("" ::: "memory"); }
        scan3_mfma<GLA>(ST, Qh0, Kh0, Kt, Vt, eb0, vraw, OS, tid, wave, r32, hh, pd, seg, c, dir);
        __syncthreads();
        scan3_build<GLA>(ST, Qh1, Kh1, Kt, Vt, eb1, vraw, OS, tid, wave, r32, hh, pd, seg, c + 1, dir);
        __syncthreads();
        SC_COPY(A, Qh0, Kh0, eb0);
        { const int cl_ = c + 4 < 264 ? c + 4 : 263; SC_GLOAD(cl_, A); asm volatile("" ::: "memory"); }
        scan3_mfma<GLA>(ST, Qh1, Kh1, Kt, Vt, eb1, vraw, OS, tid, wave, r32, hh, pd, seg, c + 1, dir);
    }
#undef SC_COPY
#undef CH_P0
#undef ROWP
#undef SC_GLOAD
    __builtin_amdgcn_s_setprio(0);
}

#ifdef ONLYI
#define IT_ON(n) (ONLYI == (n))
#else
#define IT_ON(n) true
#endif
__device__ void phase_mixers(const Params& P, int ph, int l, unsigned char* smem, int mode = 0) {
    constexpr int N_HG = 16, N_GLA = 16, N_ATT = 2 * 8 * 66;
    const int bx = blockIdx.x;
    int my_scan = -1;
    if (mode != 2 && bx < 256 && (bx & 7) == ((bx >> 3) & 7)) my_scan = bx >> 3;
    if (mode == 0 && bx >= 256 && ((bx - 256) & 7) == (((bx - 256) >> 3) & 7)) return;
    for (;;) {
        int it;
        if (my_scan >= 0) { it = my_scan; my_scan = -1; }
        else {
            if (mode == 1) break;
            it = next_item(P, ph) + N_HG + N_GLA;
        }
        if (it >= N_HG + N_GLA + 2 * N_ATT) break;
        if (it < N_HG) { if (IT_ON(0)) scan3_item<false>(P, l, it, smem); continue; }
        it -= N_HG;
        if (it < N_GLA) { if (IT_ON(1)) scan3_item<true>(P, l, it, smem); continue; }
        it -= N_GLA;
        if (it < N_ATT) { const int bl = it / 528, rem = it % 528; if (IT_ON(2)) attn_item<96, false>(P, l, bl, rem / 66, rem % 66, smem); continue; }
        it -= N_ATT;
        { const int bl = it / 528, rem = it % 528; if (IT_ON(3)) attn_item<64, true>(P, l, bl, rem / 66, rem % 66, smem); }
    }
}

__device__ void phase_scanfin(const Params& P, int ph, int l) {
    const int tid = tid_opaque(), lane = tid & 63, wave = tid >> 6;
    bf16_t* PB = (bf16_t*)(P.ws + OFF_PB);
    const bf16_t* OSH = (const bf16_t*)(P.ws + OFF_KV);
    const bf16_t* OSGp = (const bf16_t*)(P.ws + OFF_OSG);
    float gh[8], gg[8];
#pragma unroll
    for (int e = 0; e < 8; ++e) { gh[e] = P.hg_g_o[l * 128 + (lane & 15) * 8 + e]; gg[e] = P.gla_g_o[l * 128 + (lane & 15) * 8 + e]; }
    for (;;) {
        const int u = next_item(P, ph);
        if (u >= NTH / 16) break;
        uint4 ra[8], rb[8], rz[8];
#pragma unroll
        for (int k = 0; k < 8; ++k) {
            const int t = u * 16 + wave * 4 + (k >> 1), mx = k & 1;
            const bf16_t* OS = mx ? OSGp : OSH;
            ra[k] = *(const uint4*)(OS + (size_t)t * 512 + lane * 8);
            rb[k] = *(const uint4*)(OS + ((size_t)NTH + t) * 512 + lane * 8);
            rz[k] = *(const uint4*)(PB + (size_t)t * PW + C_Z + (2 + mx) * 512 + lane * 8);
        }
#pragma unroll
        for (int k = 0; k < 8; ++k) {
            const int t = u * 16 + wave * 4 + (k >> 1), mx = k & 1;
            float a[8], b[8], z[8];
            unpack8(ra[k], a); unpack8(rb[k], b); unpack8(rz[k], z);
            float ss = 0.f;
#pragma unroll
            for (int e = 0; e < 8; ++e) { a[e] += b[e]; ss += a[e] * a[e]; }
            ss += __shfl_xor(ss, 1); ss += __shfl_xor(ss, 2); ss += __shfl_xor(ss, 4); ss += __shfl_xor(ss, 8);
            const float rn = rsqrtf(ss * (1.f / 128.f) + EPS);
#pragma unroll
            for (int e = 0; e < 8; ++e) a[e] = a[e] * rn * (mx ? gg[e] : gh[e]) * siluf_(z[e]);
            *(uint4*)(PB + (size_t)t * PW + C_Z + (2 + mx) * 512 + lane * 8) = pack8(a);
        }
    }
}

__device__ void phase_merge(const Params& P, int ph, int l, unsigned char* smem) {
    const int tid_ = tid_opaque(), lane = tid_ & 63, wave = tid_ >> 6, wr = wave >> 1, wc = wave & 1;
    const bf16_t* H = (const bf16_t*)(P.ws + OFF_H);
    const bf16_t* PB = (const bf16_t*)(P.ws + OFF_PB);
    bf16_t* ACC = (bf16_t*)(P.ws + OFF_KV);
    for (;;) {
        const int u = next_item(P, ph);
        if (u >= 132 * 16) break;
        const int mt = u >> 4, nt = u & 15;
        const int col = nt * 64 + wc * 32 + (lane & 31);
        f32x16 tot[2];
#pragma unroll
        for (int r = 0; r < 16; ++r) { tot[0][r] = 0.f; tot[1][r] = 0.f; }
        for (int br = 0; br < 4; ++br) {
            unsigned gate[2][8];
            f32x16 g[2], pa[2];
#pragma unroll
            for (int r = 0; r < 16; ++r) { g[0][r] = 0.f; g[1][r] = 0.f; pa[0][r] = 0.f; pa[1][r] = 0.f; }
            gemm_pair_n64(g, pa, H + (size_t)mt * 128 * D, D, (const bf16_t*)(P.ws + OFF_WM) + ((size_t)(l * 4 + br) * 1024 + nt * 64) * 1024, 1024, 1024,
                          PB + (size_t)mt * 128 * PW + C_Z + br * 512, PW, (const bf16_t*)(P.ws + OFF_WBR) + ((size_t)(l * 4 + br) * 1024 + nt * 64) * 512, 512, 512, smem);
            {
                const float bm = P.b_merge[(l * 4 + br) * 1024 + col];
#pragma unroll
                for (int mi = 0; mi < 2; ++mi)
#pragma unroll
                    for (int r = 0; r < 8; ++r) gate[mi][r] = cvt_pk(__builtin_amdgcn_rcpf(1.f + __expf(-(g[mi][2 * r] + bm))), __builtin_amdgcn_rcpf(1.f + __expf(-(g[mi][2 * r + 1] + bm))));
            }
#pragma unroll
            for (int mi = 0; mi < 2; ++mi)
#pragma unroll
                for (int r = 0; r < 8; ++r) {
                    tot[mi][2 * r] = fmaf(lo16(gate[mi][r]), pa[mi][2 * r], tot[mi][2 * r]);
                    tot[mi][2 * r + 1] = fmaf(hi16(gate[mi][r]), pa[mi][2 * r + 1], tot[mi][2 * r + 1]);
                }
        }
#pragma unroll
        for (int mi = 0; mi < 2; ++mi)
#pragma unroll
            for (int r = 0; r < 16; ++r) ACC[(size_t)(mt * 128 + ACC_ROW(mi, r)) * 1024 + col] = f2bf(tot[mi][r]);
    }
}

__device__ void phase_out(const Params& P, int ph, int l, int hf, unsigned char* smem) {
    const int tid_ = tid_opaque(), lane = tid_ & 63, wave = tid_ >> 6, wr = wave >> 1, wc = wave & 1;
    const bf16_t* ACC = (const bf16_t*)(P.ws + OFF_KV);
    const float* mod = (const float*)(P.ws + OFF_MOD);
    for (;;) {
        const int u = next_item(P, ph);
        if (u >= 132 * 8) break;
        const int mt = u >> 3, nt = u & 7;
        const int t0 = mt * 128, bl = t0 / TB, p0 = t0 % TB, b = hf * 2 + bl;
        const bool isctx = p0 < CTXL;
        if (isctx && l == 1) continue;
        f32x16 acc[2][2]; zero_acc(acc);
        gemm_tile_pf2(acc, ACC + (size_t)mt * 128 * 1024, 1024, (const bf16_t*)(P.ws + OFF_WO) + ((size_t)l * 1024 + nt * 128) * 1024, 1024, 1024, smem);
        const float* gt = mod + (l * 5 + (isctx ? 4 : b)) * 3072 + 2048 + nt * 128;
        const float* src; float* dst;
        if (isctx) { src = P.ctx + ((size_t)b * CTXL + p0) * D; dst = (float*)(P.ws + OFF_CX1) + ((size_t)b * CTXL + p0) * D; }
        else { const size_t o = ((size_t)b * SEQ + (p0 - CTXL)) * D; src = (l == 0 ? P.x : (const float*)P.out) + o; dst = P.out + o; }
        float rv[2][2][16];
#pragma unroll
        for (int mi = 0; mi < 2; ++mi)
#pragma unroll
            for (int ni = 0; ni < 2; ++ni)
#pragma unroll
                for (int r = 0; r < 16; ++r) rv[mi][ni][r] = src[(size_t)ACC_ROW(mi, r) * D + nt * 128 + ACC_COL(ni)];
#pragma unroll
        for (int mi = 0; mi < 2; ++mi)
#pragma unroll
            for (int ni = 0; ni < 2; ++ni) {
                const int cl = ACC_COL(ni);
                const float g = gt[cl];
#pragma unroll
                for (int r = 0; r < 16; ++r) { const size_t o = (size_t)ACC_ROW(mi, r) * D + nt * 128 + cl; dst[o] = rv[mi][ni][r] + g * acc[mi][ni][r]; }
            }
    }
}

__global__ void __launch_bounds__(256, 2) mega(Params PK) {
    extern __shared__ __attribute__((aligned(16))) unsigned char smem[];
    if (blockIdx.x == 0 && threadIdx.x == 0) {
        Params* T = (Params*)(PK.ws + OFF_TAB);
        T->x = PK.x; T->c = PK.c; T->ctx = PK.ctx; T->c_ctx = PK.c_ctx; T->ada_w = PK.ada_w; T->ada_b = PK.ada_b; T->norm_g = PK.norm_g; T->w_in = PK.w_in;
        T->w_uq = PK.w_uq; T->w_ukv = PK.w_ukv; T->g_cq = PK.g_cq; T->g_ckv = PK.g_ckv; T->g_q = PK.g_q; T->g_k = PK.g_k; T->rpb = PK.rpb; T->ng_q = PK.ng_q; T->ng_k = PK.ng_k;
        T->lb_logits = PK.lb_logits; T->hg_g_o = PK.hg_g_o; T->gla_w2 = PK.gla_w2; T->gla_b2 = PK.gla_b2; T->gla_g_o = PK.gla_g_o; T->w_br = PK.w_br; T->w_merge = PK.w_merge;
        T->b_merge = PK.b_merge; T->w_out = PK.w_out; T->out = PK.out; T->ws = PK.ws; T->ph_lo = PK.ph_lo; T->ph_hi = PK.ph_hi;
    }
    unsigned char* wsb = PK.ws;
    const int ph_lo = PK.ph_lo, ph_hi = PK.ph_hi;
#ifdef PROBE_SUB
    __shared__ long long s_tacc, s_tprev; if (threadIdx.x == 0) { s_tacc = 0; s_tprev = 0; }
#endif
    for (int ph = ph_lo; ph < ph_hi; ++ph) {
#ifndef SPLIT_MIX
        if (ph > 8 && ((ph - 1) & 7) == 0) continue;
#endif
        if (ph > ph_lo) cg::this_grid().sync();
        const Params& P = PK;
#ifdef PROBE_SUB
        if (threadIdx.x == 0) { const long long t_now = wall_clock64();
#ifdef SPLIT_MIX
            const int prev_sub = (ph == 0) ? -1 : (ph == 1 ? 9 : ((ph - 2) % 9));
#else
            const int prev_sub = (ph == 0) ? -1 : (ph == 1 ? 8 : ((ph - 2) & 7));
#endif
            if (prev_sub == PROBE_SUB) s_tacc += t_now - s_tprev; s_tprev = t_now; }
#endif
#ifdef ONLYP
#define PH_ON(n) ((ONLYP >> (n)) & 1)
#else
#define PH_ON(n) true
#endif
        if (ph == 0) { if (PH_ON(8)) phase_prologue(PK, ph, smem); continue; }
#ifdef SPLIT_MIX
        const int q = ph - 1, pass = q / 9, sub9 = q % 9, l = pass >> 1, hf = pass & 1;
        if (sub9 == 4 || sub9 == 5) { phase_mixers(P, ph, l, smem, sub9 - 3); continue; }
        const int sub = sub9 < 4 ? sub9 : sub9 - 1;
        switch (sub) {
            case 0: phase_norm(P, ph, l, hf); break;
            case 1: phase_gemm1(P, ph, l, smem); break;
            case 2: phase_gemm2(P, ph, l, smem); break;
            case 3: phase_finalize(P, ph, l, smem); break;
            case 5: phase_scanfin(P, ph, l); break;
            case 6: phase_merge(P, ph, l, smem); break;
            default: phase_out(P, ph, l, hf, smem); break;
        }
#else
        const int q = ph - 1, pass = q >> 3, sub = q & 7, l = pass >> 1, hf = pass & 1;
        switch (sub) {
            case 0: if (PH_ON(0)) phase_norm(P, ph, l, hf); break;
            case 1: if (PH_ON(1)) phase_gemm1(P, ph, l, smem); break;
            case 2: if (PH_ON(2)) phase_gemm2(P, ph, l, smem); break;
            case 3: if (PH_ON(3)) phase_finalize(P, ph, l, smem); break;
            case 4: if (PH_ON(4)) phase_mixers(P, ph, l, smem); break;
            case 5: if (PH_ON(5)) phase_scanfin(P, ph, l); break;
            case 6: if (PH_ON(6)) phase_merge(P, ph, l, smem); break;
            default: if (PH_ON(7)) { phase_out(P, ph, l, hf, smem); if (pass < 3) phase_norm(P, ph + 40, (pass + 1) >> 1, (pass + 1) & 1); } break;
        }
#endif
    }
#ifdef PROBE_SUB
    cg::this_grid().sync();
    if (threadIdx.x == 0) { const long long t_now = wall_clock64(); if (7 == PROBE_SUB) s_tacc += t_now - s_tprev;
      if (blockIdx.x == 0) { const long long t_acc = s_tacc; const long long t0 = wall_clock64(); while (wall_clock64() - t0 < t_acc) { __builtin_amdgcn_s_sleep(10); } } }
#endif
}

extern "C" void kernel_launch(void* const* d_in, const int* in_sizes, int n_in, void* d_out, int out_size, void* d_ws, size_t ws_size, hipStream_t stream) {
    static int grid = 0;
    if (grid == 0) {
        if (ws_size < WS_END) { fprintf(stderr, "workspace too small: %zu < %zu\n", ws_size, (size_t)WS_END); grid = -1; return; }
        int dev = 0, cus = 0, per_cu = 0;
        hipGetDevice(&dev);
        hipDeviceGetAttribute(&cus, hipDeviceAttributeMultiprocessorCount, dev);
        hipFuncSetAttribute((const void*)mega, hipFuncAttributeMaxDynamicSharedMemorySize, LDS_BYTES);
        hipOccupancyMaxActiveBlocksPerMultiprocessor(&per_cu, (const void*)mega, 256, LDS_BYTES);
        if (per_cu < 1) per_cu = 1;
        if (per_cu > 2) per_cu = 2;
        grid = cus * per_cu;
        (void)hipGetLastError();
    }
    if (grid < 0) return;
    hipMemsetAsync((unsigned char*)d_ws + OFF_CTL, 0, 4096, stream);
    Params p{};
    const float** pp = (const float**)&p;
    for (int i = 0; i < 26; ++i) pp[i] = (const float*)d_in[i];
    p.out = (float*)d_out; p.ws = (unsigned char*)d_ws;
#if SINGLE_LAUNCH
    p.ph_lo = 0; p.ph_hi = NPHASE;
    void* args[] = {&p};
    hipError_t e = hipLaunchCooperativeKernel((const void*)mega, dim3(grid), dim3(256), args, LDS_BYTES, stream);
    if (e != hipSuccess) fprintf(stderr, "cooperative launch failed: %s (grid %d)\n", hipGetErrorString(e), grid);
#else
    for (int ph = 0; ph < NPHASE; ++ph) {
        p.ph_lo = ph; p.ph_hi = ph + 1;
        hipLaunchKernelGGL(mega, dim3(grid), dim3(256), LDS_BYTES, stream, p);
    }
#endif
}
```

```cpp
#include <hip/hip_runtime.h>
#include <hip/hip_cooperative_groups.h>
#include <stdint.h>
#include <stdio.h>
namespace cg = cooperative_groups;

typedef unsigned short bf16_t;
typedef short bf16x8 __attribute__((ext_vector_type(8)));
typedef short bf16x4 __attribute__((ext_vector_type(4)));
typedef float f32x16 __attribute__((ext_vector_type(16)));

#ifndef SINGLE_LAUNCH
#define SINGLE_LAUNCH 1
#endif

constexpr int D = 1024, SEQ = 8192, CTXL = 256, TB = SEQ + CTXL  , NTH = 2 * TB  ;
constexpr int INW = 7104, PW = 7104;
constexpr int C_CQ = 0, C_CKV = 256, C_KR = 384, C_NQ = 416, C_NK = 928, C_NV = 1440, C_HQ = 1952, C_HF = 2464, C_HI = 3488,
              C_GQ = 4000, C_GK = 4256, C_GV = 4512, C_GR = 5024, C_Z = 5056;
constexpr float EPS = 1e-6f;
constexpr float LOG2E = 1.4426950408889634f;
constexpr int LDS_BYTES = 73728;
#ifdef SPLIT_MIX
constexpr int NPHASE = 37;
#else
constexpr int NPHASE = 33;
#endif

constexpr size_t al256(size_t v) { return (v + 255) & ~(size_t)255; }
constexpr size_t OFF_CTL = 0;
constexpr size_t OFF_TAB = 1024;
constexpr size_t OFF_MOD = 4096;
constexpr size_t OFF_CX1 = al256(OFF_MOD + 2 * 5 * 3072 * 4);
constexpr size_t OFF_WIN = al256(OFF_CX1 + (size_t)4 * 256 * 1024 * 4);
constexpr size_t OFF_WM = al256(OFF_WIN + (size_t)2 * 7168 * 1024 * 2);
constexpr size_t OFF_WBR = al256(OFF_WM + (size_t)8 * 1024 * 1024 * 2);
constexpr size_t OFF_WO = al256(OFF_WBR + (size_t)8 * 1024 * 512 * 2);
constexpr size_t OFF_WUQ = al256(OFF_WO + (size_t)2 * 1024 * 1024 * 2);
constexpr size_t OFF_WUKV = al256(OFF_WUQ + (size_t)2 * 768 * 256 * 2);
constexpr size_t OFF_H = al256(OFF_WUKV + (size_t)2 * 1024 * 128 * 2);
constexpr size_t OFF_PB = al256(OFF_H + (size_t)NTH * 1024 * 2);
constexpr size_t OFF_QF = al256(OFF_PB + (size_t)NTH * PW * 2);
constexpr size_t OFF_KV = al256(OFF_QF + (size_t)NTH * 768 * 2);
constexpr size_t OFF_KF = al256(OFF_KV + (size_t)NTH * 1024 * 2);
constexpr size_t OFF_VTM = al256(OFF_KF + (size_t)NTH * 768 * 2);
constexpr size_t OFF_VTN = al256(OFF_VTM + (size_t)2 * 8 * 64 * TB * 2);
constexpr size_t OFF_OSG = al256(OFF_VTN + (size_t)2 * 8 * 64 * TB * 2);
constexpr size_t OFF_XH = al256(OFF_OSG + (size_t)2 * NTH * 512 * 2);
constexpr size_t OFF_XG = al256(OFF_XH + (size_t)NTH * 512 * 2);
constexpr size_t OFF_EBH = al256(OFF_XG + (size_t)NTH * 512 * 2);
constexpr size_t OFF_EBG = al256(OFF_EBH + (size_t)528 * 2 * 512 * 4);
constexpr size_t WS_END = al256(OFF_EBG + (size_t)528 * 2 * 256 * 4);

static_assert(WS_END <= (size_t)512 * 1024 * 1024, "workspace map exceeds 512 MiB");
struct Params {
    const float *x, *c, *ctx, *c_ctx, *ada_w, *ada_b, *norm_g, *w_in, *w_uq, *w_ukv, *g_cq, *g_ckv, *g_q, *g_k, *rpb, *ng_q, *ng_k,
        *lb_logits, *hg_g_o, *gla_w2, *gla_b2, *gla_g_o, *w_br, *w_merge, *b_merge, *w_out;
    float* out;
    unsigned char* ws;
    int ph_lo, ph_hi;
};

__device__ __forceinline__ float bf2f(bf16_t v) { return __uint_as_float(((unsigned)v) << 16); }
typedef float f32x2_t __attribute__((ext_vector_type(2)));
typedef __bf16 bf16x2_t __attribute__((ext_vector_type(2)));
__device__ __forceinline__ unsigned cvt_pk(float lo, float hi) { f32x2_t v = {lo, hi}; bf16x2_t b = __builtin_convertvector(v, bf16x2_t); return __builtin_bit_cast(unsigned, b); }
__device__ __forceinline__ unsigned cvt_pk_asm(float lo, float hi) { unsigned r; asm("s_nop 1\n\tv_cvt_pk_bf16_f32 %0, %1, %2" : "=v"(r) : "v"(lo), "v"(hi)); return r; }
__device__ __forceinline__ bf16_t f2bf(float f) { return (bf16_t)(cvt_pk(f, 0.f) & 0xffffu); }
__device__ __forceinline__ float lo16(unsigned u) { return __uint_as_float(u << 16); }
__device__ __forceinline__ float hi16(unsigned u) { return __uint_as_float(u & 0xffff0000u); }
__device__ __forceinline__ float sigmoidf_(float x) { return __builtin_amdgcn_rcpf(1.f + __expf(-x)); }
__device__ __forceinline__ float siluf_(float x) { return x * __builtin_amdgcn_rcpf(1.f + __expf(-x)); }
__device__ __forceinline__ float wave_sum(float v) {
#pragma unroll
    for (int o = 32; o > 0; o >>= 1) v += __shfl_xor(v, o);
    return v;
}
__device__ __forceinline__ void unpack8(uint4 u, float* f) {
    f[0] = lo16(u.x); f[1] = hi16(u.x); f[2] = lo16(u.y); f[3] = hi16(u.y); f[4] = lo16(u.z); f[5] = hi16(u.z); f[6] = lo16(u.w); f[7] = hi16(u.w);
}
__device__ __forceinline__ uint4 pack8(const float* f) { uint4 u; u.x = cvt_pk(f[0], f[1]); u.y = cvt_pk(f[2], f[3]); u.z = cvt_pk(f[4], f[5]); u.w = cvt_pk(f[6], f[7]); return u; }

__device__ __forceinline__ int tid_opaque() { int t = threadIdx.x; asm volatile("" : "+v"(t)); return t; }
__shared__ int s_item;
__device__ __forceinline__ int next_item(const Params& P, int ph) {
    __syncthreads();
    if (threadIdx.x == 0) s_item = atomicAdd((int*)(P.ws + OFF_CTL) + ph, 1);
    __syncthreads();
    return s_item;
}

constexpr int GS = 72;
__device__ __forceinline__ void gemm_tile(f32x16 (&acc)[2][2], const bf16_t* __restrict__ A, int lda, const bf16_t* __restrict__ Bt, int ldb, int K, unsigned char* smem) {
    const int tid = tid_opaque(), lane = tid & 63, wave = tid >> 6, wr = wave >> 1, wc = wave & 1;
    bf16_t* sA = (bf16_t*)smem;
    bf16_t* sB = sA + 2 * 128 * GS;
    const int lrow = tid >> 3, lch = (tid & 7) * 8;
    uint4 ra[4], rb[4];
    const bf16_t* Ap = A + (size_t)lrow * lda + lch;
    const bf16_t* Bp = Bt + (size_t)lrow * ldb + lch;
#pragma unroll
    for (int i = 0; i < 4; ++i) { ra[i] = *(const uint4*)(Ap + (size_t)(32 * i) * lda); rb[i] = *(const uint4*)(Bp + (size_t)(32 * i) * ldb); }
#pragma unroll
    for (int i = 0; i < 4; ++i) { *(uint4*)(sA + (lrow + 32 * i) * GS + lch) = ra[i]; *(uint4*)(sB + (lrow + 32 * i) * GS + lch) = rb[i]; }
    __syncthreads();
    const int nk = K >> 6;
    const int aoff = (wr * 64 + (lane & 31)) * GS + (lane >> 5) * 8, boff = (wc * 64 + (lane & 31)) * GS + (lane >> 5) * 8;
    for (int kt = 0; kt < nk; ++kt) {
        const bool more = kt + 1 < nk;
        if (more) {
#pragma unroll
            for (int i = 0; i < 4; ++i) { ra[i] = *(const uint4*)(Ap + (size_t)(32 * i) * lda + (kt + 1) * 64); rb[i] = *(const uint4*)(Bp + (size_t)(32 * i) * ldb + (kt + 1) * 64); }
        }
        const bf16_t* a = sA + (kt & 1) * 128 * GS + aoff;
        const bf16_t* b = sB + (kt & 1) * 128 * GS + boff;
#pragma unroll
        for (int ks = 0; ks < 4; ++ks) {
            bf16x8 a0 = *(const bf16x8*)(a + ks * 16), a1 = *(const bf16x8*)(a + 32 * GS + ks * 16);
            bf16x8 b0 = *(const bf16x8*)(b + ks * 16), b1 = *(const bf16x8*)(b + 32 * GS + ks * 16);
            acc[0][0] = __builtin_amdgcn_mfma_f32_32x32x16_bf16(a0, b0, acc[0][0], 0, 0, 0);
            acc[0][1] = __builtin_amdgcn_mfma_f32_32x32x16_bf16(a0, b1, acc[0][1], 0, 0, 0);
            acc[1][0] = __builtin_amdgcn_mfma_f32_32x32x16_bf16(a1, b0, acc[1][0], 0, 0, 0);
            acc[1][1] = __builtin_amdgcn_mfma_f32_32x32x16_bf16(a1, b1, acc[1][1], 0, 0, 0);
        }
        if (more) {
            bf16_t* wa = sA + ((kt + 1) & 1) * 128 * GS;
            bf16_t* wb = sB + ((kt + 1) & 1) * 128 * GS;
#pragma unroll
            for (int i = 0; i < 4; ++i) { *(uint4*)(wa + (lrow + 32 * i) * GS + lch) = ra[i]; *(uint4*)(wb + (lrow + 32 * i) * GS + lch) = rb[i]; }
        }
        __syncthreads();
    }
}

__device__ __forceinline__ void gemm_tile_pf2(f32x16 (&acc)[2][2], const bf16_t* __restrict__ A, int lda, const bf16_t* __restrict__ Bt, int ldb, int K, unsigned char* smem) {
    const int tid = tid_opaque(), lane = tid & 63, wave = tid >> 6, wr = wave >> 1, wc = wave & 1;
    bf16_t* sA = (bf16_t*)smem;
    bf16_t* sB = sA + 2 * 128 * GS;
    const int lrow = tid >> 3, lch = (tid & 7) * 8;
    uint4 pa0, pa1, pa2, pa3, pb0, pb1, pb2, pb3, qa0, qa1, qa2, qa3, qb0, qb1, qb2, qb3;
    const bf16_t* Ap = A + (size_t)lrow * lda + lch;
    const bf16_t* Bp = Bt + (size_t)lrow * ldb + lch;
    const int nk = K >> 6;
#define PF2_LD1(RA, RB, kt_, i) { RA##i = *(const uint4*)(Ap + (size_t)(32 * i) * lda + (kt_) * 64); RB##i = *(const uint4*)(Bp + (size_t)(32 * i) * ldb + (kt_) * 64); }
#define PF2_LOAD(RA, RB, kt_) { PF2_LD1(RA, RB, kt_, 0) PF2_LD1(RA, RB, kt_, 1) PF2_LD1(RA, RB, kt_, 2) PF2_LD1(RA, RB, kt_, 3) }
#define PF2_WR1(RA, RB, i) { *(uint4*)(wa + (lrow + 32 * i) * GS + lch) = RA##i; *(uint4*)(wb + (lrow + 32 * i) * GS + lch) = RB##i; }
#define PF2_WRITE(RA, RB, buf_) { bf16_t* wa = sA + (buf_) * 128 * GS; bf16_t* wb = sB + (buf_) * 128 * GS; PF2_WR1(RA, RB, 0) PF2_WR1(RA, RB, 1) PF2_WR1(RA, RB, 2) PF2_WR1(RA, RB, 3) }
#define PF2_COMPUTE(buf_) { const bf16_t* a = sA + (buf_) * 128 * GS + aoff; const bf16_t* b = sB + (buf_) * 128 * GS + boff; _Pragma("unroll") for (int ks = 0; ks < 4; ++ks) { \
        bf16x8 a0 = *(const bf16x8*)(a + ks * 16), a1 = *(const bf16x8*)(a + 32 * GS + ks * 16); bf16x8 b0 = *(const bf16x8*)(b + ks * 16), b1 = *(const bf16x8*)(b + 32 * GS + ks * 16); \
        acc[0][0] = __builtin_amdgcn_mfma_f32_32x32x16_bf16(a0, b0, acc[0][0], 0, 0, 0); acc[0][1] = __builtin_amdgcn_mfma_f32_32x32x16_bf16(a0, b1, acc[0][1], 0, 0, 0); \
        acc[1][0] = __builtin_amdgcn_mfma_f32_32x32x16_bf16(a1, b0, acc[1][0], 0, 0, 0); acc[1][1] = __builtin_amdgcn_mfma_f32_32x32x16_bf16(a1, b1, acc[1][1], 0, 0, 0); } }
    const int aoff = (wr * 64 + (lane & 31)) * GS + (lane >> 5) * 8, boff = (wc * 64 + (lane & 31)) * GS + (lane >> 5) * 8;
    PF2_LOAD(pa, pb, 0);
    PF2_LOAD(qa, qb, 1);
    PF2_WRITE(pa, pb, 0);
    __syncthreads();
    for (int kt = 0; kt < nk; kt += 2) {
        if (kt + 2 < nk) PF2_LOAD(pa, pb, kt + 2);
        PF2_COMPUTE(0);
        PF2_WRITE(qa, qb, 1);
        __syncthreads();
        if (kt + 3 < nk) PF2_LOAD(qa, qb, kt + 3);
        PF2_COMPUTE(1);
        if (kt + 2 < nk) PF2_WRITE(pa, pb, 0);
        __syncthreads();
    }
#undef PF2_LOAD
#undef PF2_LD1
#undef PF2_WR1
#undef PF2_WRITE
#undef PF2_COMPUTE
}

__device__ __forceinline__ void gemm_tile_n64(f32x16 (&acc)[2], const bf16_t* __restrict__ A, int lda, const bf16_t* __restrict__ Bt, int ldb, int K, unsigned char* smem) {
    const int tid = tid_opaque(), lane = tid & 63, wave = tid >> 6, wr = wave >> 1, wc = wave & 1;
    bf16_t* sA = (bf16_t*)smem;
    bf16_t* sB = sA + 2 * 128 * GS;
    const int lrow = tid >> 3, lch = (tid & 7) * 8;
    uint4 pa0, pa1, pa2, pa3, pb0, pb1, qa0, qa1, qa2, qa3, qb0, qb1;
    const bf16_t* Ap = A + (size_t)lrow * lda + lch;
    const bf16_t* Bp = Bt + (size_t)lrow * ldb + lch;
    const int nk = K >> 6;
#define N64_LOAD(RA, RB, kt_) { RA##0 = *(const uint4*)(Ap + (kt_) * 64); RA##1 = *(const uint4*)(Ap + (size_t)32 * lda + (kt_) * 64); RA##2 = *(const uint4*)(Ap + (size_t)64 * lda + (kt_) * 64); RA##3 = *(const uint4*)(Ap + (size_t)96 * lda + (kt_) * 64); \
        RB##0 = *(const uint4*)(Bp + (kt_) * 64); RB##1 = *(const uint4*)(Bp + (size_t)32 * ldb + (kt_) * 64); }
#define N64_WRITE(RA, RB, buf_) { bf16_t* wa = sA + (buf_) * 128 * GS + lrow * GS + lch; bf16_t* wb = sB + (buf_) * 64 * GS + lrow * GS + lch; \
        *(uint4*)wa = RA##0; *(uint4*)(wa + 32 * GS) = RA##1; *(uint4*)(wa + 64 * GS) = RA##2; *(uint4*)(wa + 96 * GS) = RA##3; *(uint4*)wb = RB##0; *(uint4*)(wb + 32 * GS) = RB##1; }
#define N64_COMPUTE(buf_) { const bf16_t* a = sA + (buf_) * 128 * GS + aoff; const bf16_t* b = sB + (buf_) * 64 * GS + boff; _Pragma("unroll") for (int ks = 0; ks < 4; ++ks) { \
        bf16x8 a0 = *(const bf16x8*)(a + ks * 16), a1 = *(const bf16x8*)(a + 32 * GS + ks * 16); bf16x8 b0 = *(const bf16x8*)(b + ks * 16); \
        acc[0] = __builtin_amdgcn_mfma_f32_32x32x16_bf16(a0, b0, acc[0], 0, 0, 0); acc[1] = __builtin_amdgcn_mfma_f32_32x32x16_bf16(a1, b0, acc[1], 0, 0, 0); } }
    const int aoff = (wr * 64 + (lane & 31)) * GS + (lane >> 5) * 8, boff = (wc * 32 + (lane & 31)) * GS + (lane >> 5) * 8;
    N64_LOAD(pa, pb, 0);
    N64_LOAD(qa, qb, 1);
    N64_WRITE(pa, pb, 0);
    __syncthreads();
    for (int kt = 0; kt < nk; kt += 2) {
        if (kt + 2 < nk) N64_LOAD(pa, pb, kt + 2);
        N64_COMPUTE(0);
        N64_WRITE(qa, qb, 1);
        __syncthreads();
        if (kt + 3 < nk) N64_LOAD(qa, qb, kt + 3);
        N64_COMPUTE(1);
        if (kt + 2 < nk) N64_WRITE(pa, pb, 0);
        __syncthreads();
    }
#undef N64_LOAD
#undef N64_WRITE
#undef N64_COMPUTE
}

__device__ __forceinline__ void gemm_pair_n64(f32x16 (&acc1)[2], f32x16 (&acc2)[2], const bf16_t* __restrict__ A1, int lda1, const bf16_t* __restrict__ B1, int ldb1, int K1,
                                              const bf16_t* __restrict__ A2, int lda2, const bf16_t* __restrict__ B2, int ldb2, int K2, unsigned char* smem) {
    const int tid = tid_opaque(), lane = tid & 63, wave = tid >> 6, wr = wave >> 1, wc = wave & 1;
    bf16_t* sA = (bf16_t*)smem;
    bf16_t* sB = sA + 2 * 128 * GS;
    const int lrow = tid >> 3, lch = (tid & 7) * 8;
    uint4 pa0, pa1, pa2, pa3, pb0, pb1, qa0, qa1, qa2, qa3, qb0, qb1;
    const bf16_t* Ap1 = A1 + (size_t)lrow * lda1 + lch; const bf16_t* Bp1 = B1 + (size_t)lrow * ldb1 + lch;
    const bf16_t* Ap2 = A2 + (size_t)lrow * lda2 + lch; const bf16_t* Bp2 = B2 + (size_t)lrow * ldb2 + lch;
    const int nk1 = K1 >> 6, nk = nk1 + (K2 >> 6);
#define P64_LOAD(RA, RB, kt_) { const bool s2_ = (kt_) >= nk1; const bf16_t* ap_ = s2_ ? Ap2 + ((kt_) - nk1) * 64 : Ap1 + (kt_) * 64; const bf16_t* bp_ = s2_ ? Bp2 + ((kt_) - nk1) * 64 : Bp1 + (kt_) * 64; \
        const size_t la_ = s2_ ? lda2 : lda1, lb_ = s2_ ? ldb2 : ldb1; \
        RA##0 = *(const uint4*)(ap_); RA##1 = *(const uint4*)(ap_ + 32 * la_); RA##2 = *(const uint4*)(ap_ + 64 * la_); RA##3 = *(const uint4*)(ap_ + 96 * la_); \
        RB##0 = *(const uint4*)(bp_); RB##1 = *(const uint4*)(bp_ + 32 * lb_); }
#define P64_WRITE(RA, RB, buf_) { bf16_t* wa = sA + (buf_) * 128 * GS + lrow * GS + lch; bf16_t* wb = sB + (buf_) * 64 * GS + lrow * GS + lch; \
        *(uint4*)wa = RA##0; *(uint4*)(wa + 32 * GS) = RA##1; *(uint4*)(wa + 64 * GS) = RA##2; *(uint4*)(wa + 96 * GS) = RA##3; *(uint4*)wb = RB##0; *(uint4*)(wb + 32 * GS) = RB##1; }
#define P64_COMPUTE(ACC, buf_) { const bf16_t* a = sA + (buf_) * 128 * GS + aoff; const bf16_t* b = sB + (buf_) * 64 * GS + boff; _Pragma("unroll") for (int ks = 0; ks < 4; ++ks) { \
        bf16x8 a0 = *(const bf16x8*)(a + ks * 16), a1 = *(const bf16x8*)(a + 32 * GS + ks * 16); bf16x8 b0 = *(const bf16x8*)(b + ks * 16); \
        ACC[0] = __builtin_amdgcn_mfma_f32_32x32x16_bf16(a0, b0, ACC[0], 0, 0, 0); ACC[1] = __builtin_amdgcn_mfma_f32_32x32x16_bf16(a1, b0, ACC[1], 0, 0, 0); } }
    const int aoff = (wr * 64 + (lane & 31)) * GS + (lane >> 5) * 8, boff = (wc * 32 + (lane & 31)) * GS + (lane >> 5) * 8;
    P64_LOAD(pa, pb, 0);
    P64_LOAD(qa, qb, 1);
    P64_WRITE(pa, pb, 0);
    __syncthreads();
    for (int kt = 0; kt < nk; kt += 2) {
        if (kt + 2 < nk) P64_LOAD(pa, pb, kt + 2);
        if (kt < nk1) P64_COMPUTE(acc1, 0) else P64_COMPUTE(acc2, 0)
        P64_WRITE(qa, qb, 1);
        __syncthreads();
        if (kt + 3 < nk) P64_LOAD(qa, qb, kt + 3);
        if (kt + 1 < nk1) P64_COMPUTE(acc1, 1) else P64_COMPUTE(acc2, 1)
        if (kt + 2 < nk) P64_WRITE(pa, pb, 0);
        __syncthreads();
    }
#undef P64_LOAD
#undef P64_WRITE
#undef P64_COMPUTE
}
__device__ __forceinline__ void zero_acc(f32x16 (&acc)[2][2]) {
#pragma unroll
    for (int i = 0; i < 2; ++i)
#pragma unroll
        for (int j = 0; j < 2; ++j)
#pragma unroll
            for (int r = 0; r < 16; ++r) acc[i][j][r] = 0.f;
}
#define ACC_ROW(mi, r) (wr * 64 + (mi) * 32 + ((r) & 3) + 8 * ((r) >> 2) + 4 * (lane >> 5))
#define ACC_COL(ni) (wc * 64 + (ni) * 32 + (lane & 31))

__device__ void tr_tile(const float* __restrict__ src, int K, int N, int kt, int nt, bf16_t* __restrict__ dst, const float* __restrict__ scale, float* s) {
    const int tid = tid_opaque(), r = tid >> 4, c4 = (tid & 15) * 4;
#pragma unroll
    for (int i = 0; i < 4; ++i) {
        const int k = kt * 64 + r + 16 * i;
        float4 v = *(const float4*)(src + (size_t)k * N + nt * 64 + c4);
        const float sc = scale ? scale[k] : 1.f;
        float* d = s + (r + 16 * i) * 65 + c4;
        d[0] = v.x * sc; d[1] = v.y * sc; d[2] = v.z * sc; d[3] = v.w * sc;
    }
    __syncthreads();
    const int n = tid >> 2, k0 = (tid & 3) * 16;
    float f[16];
#pragma unroll
    for (int j = 0; j < 16; ++j) f[j] = s[(k0 + j) * 65 + n];
    bf16_t* o = dst + (size_t)(nt * 64 + n) * K + kt * 64 + k0;
    *(uint4*)o = pack8(f);
    *(uint4*)(o + 8) = pack8(f + 8);
    __syncthreads();
}
__device__ void phase_prologue(const Params& P, int ph, unsigned char* smem) {
    float* s = (float*)smem;
    const int NTR = 7296, NMOD = 96;
    for (;;) {
        const int u = next_item(P, ph);
        if (u >= NTR + NMOD) break;
        if (u < NMOD) {
            const int l = u / 48, cb = u % 48, tid = threadIdx.x, lane = tid & 63, wave = tid >> 6;
            float* sc = s;
            float* red = s + 5 * 1024;
            for (int i = tid; i < 5 * 1024; i += 256) { const int r = i >> 10, k = i & 1023; const float v = (r < 4) ? P.c[r * 1024 + k] : P.c_ctx[k]; sc[i] = siluf_(v); }
            __syncthreads();
            const int col = cb * 64 + lane;
            float acc[5] = {0.f, 0.f, 0.f, 0.f, 0.f};
            const float* w = P.ada_w + (size_t)l * 1024 * 3072 + col;
#pragma unroll 8
            for (int k = wave * 256; k < wave * 256 + 256; ++k) {
                const float wv = w[(size_t)k * 3072];
#pragma unroll
                for (int r = 0; r < 5; ++r) acc[r] += sc[r * 1024 + k] * wv;
            }
#pragma unroll
            for (int r = 0; r < 5; ++r) red[(wave * 5 + r) * 64 + lane] = acc[r];
            __syncthreads();
            if (wave == 0) {
                float* mod = (float*)(P.ws + OFF_MOD);
#pragma unroll
                for (int r = 0; r < 5; ++r) mod[(l * 5 + r) * 3072 + col] = red[r * 64 + lane] + red[(5 + r) * 64 + lane] + red[(10 + r) * 64 + lane] + red[(15 + r) * 64 + lane] + P.ada_b[l * 3072 + col];
            }
            continue;
        }
        const int v = u - NMOD, l = v / 3648, r = v % 3648;
        if (r < 1776) tr_tile(P.w_in + (size_t)l * 1024 * INW, 1024, INW, r / 111, r % 111, (bf16_t*)(P.ws + OFF_WIN) + (size_t)l * 7168 * 1024, nullptr, s);
        else if (r < 2800) { const int r2 = r - 1776, br = r2 >> 8, t = r2 & 255; tr_tile(P.w_merge + (size_t)(l * 4 + br) * 1024 * 1024, 1024, 1024, t >> 4, t & 15, (bf16_t*)(P.ws + OFF_WM) + (size_t)(l * 4 + br) * 1024 * 1024, nullptr, s); }
        else if (r < 3312) { const int r2 = r - 2800, br = r2 >> 7, t = r2 & 127; tr_tile(P.w_br + (size_t)(l * 4 + br) * 512 * 1024, 512, 1024, t >> 4, t & 15, (bf16_t*)(P.ws + OFF_WBR) + (size_t)(l * 4 + br) * 1024 * 512, nullptr, s); }
        else if (r < 3568) { const int t = r - 3312; tr_tile(P.w_out + (size_t)l * 1024 * 1024, 1024, 1024, t >> 4, t & 15, (bf16_t*)(P.ws + OFF_WO) + (size_t)l * 1024 * 1024, nullptr, s); }
        else if (r < 3616) { const int t = r - 3568; tr_tile(P.w_uq + (size_t)l * 256 * 768, 256, 768, t / 12, t % 12, (bf16_t*)(P.ws + OFF_WUQ) + (size_t)l * 768 * 256, P.g_cq + l * 256, s); }
        else { const int t = r - 3616; tr_tile(P.w_ukv + (size_t)l * 128 * 1024, 128, 1024, t >> 4, t & 15, (bf16_t*)(P.ws + OFF_WUKV) + (size_t)l * 1024 * 128, P.g_ckv + l * 128, s); }
    }
}

__device__ void phase_norm(const Params& P, int ph, int l, int hf) {
    const int tid = tid_opaque(), lane = tid & 63, wave = tid >> 6;
    const float* mod = (const float*)(P.ws + OFF_MOD);
    bf16_t* H = (bf16_t*)(P.ws + OFF_H);
    for (;;) {
        const int u = next_item(P, ph);
        if (u >= NTH / 8) break;
        float4 v[2][4]; int mrr[2];
#pragma unroll
        for (int rr = 0; rr < 2; ++rr) {
            const int t = u * 8 + wave * 2 + rr, bl = t / TB, p = t % TB, b = hf * 2 + bl;
            const float* src;
            if (p < CTXL) { src = (l == 0 ? P.ctx : (const float*)(P.ws + OFF_CX1)) + ((size_t)b * CTXL + p) * D; mrr[rr] = 4; }
            else { src = (l == 0 ? P.x : (const float*)P.out) + ((size_t)b * SEQ + (p - CTXL)) * D; mrr[rr] = b; }
#pragma unroll
            for (int i = 0; i < 4; ++i) v[rr][i] = *(const float4*)(src + lane * 4 + 256 * i);
        }
#pragma unroll
        for (int rr = 0; rr < 2; ++rr) {
            const int t = u * 8 + wave * 2 + rr;
            float ss = 0.f;
#pragma unroll
            for (int i = 0; i < 4; ++i) ss += v[rr][i].x * v[rr][i].x + v[rr][i].y * v[rr][i].y + v[rr][i].z * v[rr][i].z + v[rr][i].w * v[rr][i].w;
            ss = wave_sum(ss);
            const float rstd = rsqrtf(ss * (1.f / D) + EPS);
            const float* sh = mod + (l * 5 + mrr[rr]) * 3072; const float* sc = sh + 1024; const float* g = P.norm_g + l * D;
#pragma unroll
            for (int i = 0; i < 4; ++i) {
                const int c = lane * 4 + 256 * i;
                const float4 gv = *(const float4*)(g + c), s1 = *(const float4*)(sc + c), s0 = *(const float4*)(sh + c);
                uint2 o;
                o.x = cvt_pk(v[rr][i].x * rstd * gv.x * (1.f + s1.x) + s0.x, v[rr][i].y * rstd * gv.y * (1.f + s1.y) + s0.y);
                o.y = cvt_pk(v[rr][i].z * rstd * gv.z * (1.f + s1.z) + s0.z, v[rr][i].w * rstd * gv.w * (1.f + s1.w) + s0.w);
                *(uint2*)(H + (size_t)t * D + c) = o;
            }
        }
    }
}

__device__ void phase_gemm1(const Params& P, int ph, int l, unsigned char* smem) {
    const int tid_ = tid_opaque(), lane = tid_ & 63, wave = tid_ >> 6, wr = wave >> 1, wc = wave & 1;
    const bf16_t* H = (const bf16_t*)(P.ws + OFF_H);
    const bf16_t* W = (const bf16_t*)(P.ws + OFF_WIN) + (size_t)l * 7168 * 1024;
    bf16_t* PB = (bf16_t*)(P.ws + OFF_PB);
    for (;;) {
        const int u = next_item(P, ph);
        if (u >= 132 * 56) break;
        const int mt = u / 56, nt = u % 56;
        f32x16 acc[2][2]; zero_acc(acc);
        gemm_tile_pf2(acc, H + (size_t)mt * 128 * D, D, W + (size_t)nt * 128 * D, D, D, smem);
#pragma unroll
        for (int mi = 0; mi < 2; ++mi)
#pragma unroll
            for (int ni = 0; ni < 2; ++ni) {
                const int col = nt * 128 + ACC_COL(ni);
                if (col < PW) {
#pragma unroll
                    for (int r = 0; r < 16; ++r) PB[(size_t)(mt * 128 + ACC_ROW(mi, r)) * PW + col] = f2bf(acc[mi][ni][r]);
                }
            }
    }
}

__device__ void phase_gemm2(const Params& P, int ph, int l, unsigned char* smem) {
    const int tid_ = tid_opaque(), lane = tid_ & 63, wave = tid_ >> 6, wr = wave >> 1, wc = wave & 1;
    const bf16_t* PB = (const bf16_t*)(P.ws + OFF_PB);
    for (;;) {
        const int u = next_item(P, ph);
        if (u >= 132 * 14) break;
        const int mt = u / 14, n14 = u % 14;
        f32x16 acc[2][2]; zero_acc(acc);
        bf16_t* O; int ldo, nt;
        if (n14 < 6) { nt = n14; O = (bf16_t*)(P.ws + OFF_QF); ldo = 768;
            gemm_tile_pf2(acc, PB + (size_t)mt * 128 * PW + C_CQ, PW, (const bf16_t*)(P.ws + OFF_WUQ) + (size_t)l * 768 * 256 + (size_t)nt * 128 * 256, 256, 256, smem); }
        else { nt = n14 - 6; O = (bf16_t*)(P.ws + OFF_KV); ldo = 1024;
            gemm_tile_pf2(acc, PB + (size_t)mt * 128 * PW + C_CKV, PW, (const bf16_t*)(P.ws + OFF_WUKV) + (size_t)l * 1024 * 128 + (size_t)nt * 128 * 128, 128, 128, smem); }
#pragma unroll
        for (int mi = 0; mi < 2; ++mi)
#pragma unroll
            for (int ni = 0; ni < 2; ++ni)
#pragma unroll
                for (int r = 0; r < 16; ++r) O[(size_t)(mt * 128 + ACC_ROW(mi, r)) * ldo + nt * 128 + ACC_COL(ni)] = f2bf(acc[mi][ni][r]);
    }
}

__device__ void phase_finalize(const Params& P, int ph, int l, unsigned char* smem) {
    const int tid = tid_opaque(), lane = tid & 63, wave = tid >> 6;
    bf16_t* PB = (bf16_t*)(P.ws + OFF_PB);
    bf16_t* QF = (bf16_t*)(P.ws + OFF_QF);
    const bf16_t* KV = (const bf16_t*)(P.ws + OFF_KV);
    bf16_t* KF = (bf16_t*)(P.ws + OFF_KF);
    bf16_t* VTM = (bf16_t*)(P.ws + OFF_VTM);
    bf16_t* VTN = (bf16_t*)(P.ws + OFF_VTN);
    float* rs = (float*)smem;
    const int hd = lane >> 3, j = lane & 7;
    const float invf = __powf(10000.f, -(float)j * 0.125f);
    for (;;) {
        const int u7 = next_item(P, ph);
        if (u7 >= (NTH / 32) * 11) break;
        const int u = u7 / 11, sub = u7 % 11;
        const int t0 = u * 32, bl = t0 / TB, p0 = t0 % TB;
        if (sub >= 1 && sub <= 4) {
        uint2 in_cq[2]; unsigned in_ckv[2]; bf16_t in_q[2][12], in_kv[2][8], in_kr[2][4]; uint4 in_nq[2], in_nk[2];
#pragma unroll
        for (int rr = 0; rr < 2; ++rr) {
            const int tl = (sub - 1) * 8 + wave * 2 + rr, t = t0 + tl;
            const bf16_t* prow = PB + (size_t)t * PW;
            in_cq[rr] = *(const uint2*)(prow + C_CQ + lane * 4);
            in_ckv[rr] = *(const unsigned*)(prow + C_CKV + lane * 2);
            const bf16_t* q = QF + (size_t)t * 768 + hd * 96;
            const bf16_t* kvr = KV + (size_t)t * 1024 + hd * 128;
#pragma unroll
            for (int m = 0; m < 12; ++m) in_q[rr][m] = q[j + 8 * m];
#pragma unroll
            for (int m = 0; m < 8; ++m) in_kv[rr][m] = kvr[j + 8 * m];
#pragma unroll
            for (int m = 0; m < 4; ++m) in_kr[rr][m] = prow[C_KR + j + 8 * m];
            in_nq[rr] = *(const uint4*)(prow + C_NQ + hd * 64 + j * 8);
            in_nk[rr] = *(const uint4*)(prow + C_NK + hd * 64 + j * 8);
        }
#pragma unroll
        for (int rr = 0; rr < 2; ++rr) {
            const int tl = (sub - 1) * 8 + wave * 2 + rr, t = t0 + tl, p = p0 + tl;
            bf16_t* prow = PB + (size_t)t * PW;
            float s1, s2;
            { const uint2 a = in_cq[rr]; const float f0 = lo16(a.x), f1 = hi16(a.x), f2 = lo16(a.y), f3 = hi16(a.y); s1 = f0 * f0 + f1 * f1 + f2 * f2 + f3 * f3;
              const unsigned b = in_ckv[rr]; const float g0 = lo16(b), g1 = hi16(b); s2 = g0 * g0 + g1 * g1; }
            s1 = wave_sum(s1); s2 = wave_sum(s2);
            const float rcq = rsqrtf(s1 * (1.f / 256.f) + EPS), rckv = rsqrtf(s2 * (1.f / 128.f) + EPS);
            {
                bf16_t* q = QF + (size_t)t * 768 + hd * 96;
                float v[12], ss = 0.f;
#pragma unroll
                for (int m = 0; m < 12; ++m) { v[m] = bf2f(in_q[rr][m]) * rcq; ss += v[m] * v[m]; }
                ss += __shfl_xor(ss, 1); ss += __shfl_xor(ss, 2); ss += __shfl_xor(ss, 4);
                const float rn = rsqrtf(ss * (1.f / 96.f) + EPS);
#pragma unroll
                for (int m = 0; m < 12; ++m) q[j + 8 * m] = f2bf(v[m] * rn * P.g_q[l * 96 + j + 8 * m] * (0.10206207261596575f * LOG2E));
            }
            {
                float v[12], ss = 0.f;
#pragma unroll
                for (int m = 0; m < 8; ++m) { v[m] = bf2f(in_kv[rr][m]) * rckv; ss += v[m] * v[m]; }
#pragma unroll
                for (int m = 8; m < 12; ++m) { v[m] = bf2f(in_kr[rr][m - 8]); ss += v[m] * v[m]; }
                ss += __shfl_xor(ss, 1); ss += __shfl_xor(ss, 2); ss += __shfl_xor(ss, 4);
                const float rn = rsqrtf(ss * (1.f / 96.f) + EPS);
#pragma unroll
                for (int m = 0; m < 12; ++m) v[m] = v[m] * rn * P.g_k[l * 96 + j + 8 * m];
                if (p >= CTXL) {
                    const int pos = p - CTXL;
                    const float ar = (float)(pos >> 6) * invf, ac = (float)(pos & 63) * invf;
                    double fr = (double)ar * 0.15915494309189535; fr -= rint(fr);
                    double fc = (double)ac * 0.15915494309189535; fc -= rint(fc);
                    const float sr = __builtin_amdgcn_sinf((float)fr), cr = __builtin_amdgcn_cosf((float)fr);
                    const float sc = __builtin_amdgcn_sinf((float)fc), cc = __builtin_amdgcn_cosf((float)fc);
                    const float x1a = v[8], x2a = v[10], x1b = v[9], x2b = v[11];
                    v[8] = x1a * cr - x2a * sr; v[10] = x1a * sr + x2a * cr;
                    v[9] = x1b * cc - x2b * sc; v[11] = x1b * sc + x2b * cc;
                }
                bf16_t* ko = KF + ((size_t)t * 8 + hd) * 96;
#pragma unroll
                for (int m = 0; m < 12; ++m) ko[j + 8 * m] = f2bf(v[m]);
            }
#pragma unroll
            for (int w = 0; w < 2; ++w) {
                bf16_t* q = prow + (w ? C_NK : C_NQ) + hd * 64 + j * 8;
                const float* g = (w ? P.ng_k : P.ng_q) + l * 64 + j * 8;
                float v[8], ss = 0.f;
                unpack8(w ? in_nk[rr] : in_nq[rr], v);
#pragma unroll
                for (int m = 0; m < 8; ++m) ss += v[m] * v[m];
                ss += __shfl_xor(ss, 1); ss += __shfl_xor(ss, 2); ss += __shfl_xor(ss, 4);
                const float rn = rsqrtf(ss * (1.f / 64.f) + EPS);
#pragma unroll
                for (int m = 0; m < 8; ++m) v[m] = v[m] * rn * g[m] * (w ? 1.f : 0.125f * LOG2E);
                *(uint4*)q = pack8(v);
            }
        }
        } else if (sub == 0) {
        {
            for (int rr = 0; rr < 8; ++rr) {
                const int tl = wave * 8 + rr;
                const unsigned bq = *(const unsigned*)(PB + (size_t)(t0 + tl) * PW + C_CKV + lane * 2);
                const float g0 = lo16(bq), g1 = hi16(bq);
                const float s2 = wave_sum(g0 * g0 + g1 * g1);
                if (lane == 0) rs[tl] = rsqrtf(s2 * (1.f / 128.f) + EPS);
            }
            __syncthreads();
            bf16_t* tile = (bf16_t*)(smem + 8192);
#pragma unroll
            for (int which = 0; which < 2; ++which) {
#pragma unroll
                for (int k8 = 0; k8 < 8; ++k8) {
                    const int id = tid + 256 * k8, i = id >> 6, c8 = id & 63;
                    const bf16_t* src = which ? PB + (size_t)(t0 + i) * PW + C_NV + c8 * 8
                                              : KV + (size_t)(t0 + i) * 1024 + (c8 >> 3) * 128 + 64 + (c8 & 7) * 8;
                    *(uint4*)(tile + i * 512 + c8 * 8) = *(const uint4*)src;
                }
                __syncthreads();
                bf16_t* VT = which ? VTN : VTM;
#pragma unroll
                for (int k8 = 0; k8 < 8; ++k8) {
                    const int id = tid + 256 * k8, r = id >> 2, g = id & 3;
                    float fv[8];
#pragma unroll
                    for (int i = 0; i < 8; ++i) fv[i] = bf2f(tile[(g * 8 + i) * 512 + r]) * (which ? 1.f : rs[g * 8 + i]);
                    *(uint4*)(VT + ((size_t)(bl * 8 + (r >> 6)) * 64 + (r & 63)) * TB + p0 + g * 8) = pack8(fv);
                }
                __syncthreads();
            }
        }
        } else
        {
            const int chunk = t0 >> 5;
            bf16_t* XH = (bf16_t*)(P.ws + OFF_XH);
            bf16_t* XG = (bf16_t*)(P.ws + OFF_XG);
            float* EBH = (float*)(P.ws + OFF_EBH);
            float* EBG = (float*)(P.ws + OFF_EBG);
            bf16_t* base = PB + (size_t)t0 * PW;
            float* rsh = (float*)smem + 256;
            bf16_t* inA = (bf16_t*)(smem + 8192);
            bf16_t* inB = inA + 32 * 128;
            bf16_t* inC = inB + 32 * 128;
            bf16_t* outT = inC + 32 * 128;
#pragma unroll
            for (int k4 = 0; k4 < 4; ++k4) { const int id = tid + 256 * k4, i = id >> 5, jx = id & 31; rsh[id] = bf2f(base[(size_t)i * PW + C_GR + jx]); }
            const int d = tid & 127, dr = tid >> 7;
            { const int grp = sub - 5;
                const bool isg = grp >= 4;
                const int gcol = isg ? (grp - 4) * 128 : grp * 128;
                const int cA = isg ? C_GQ + gcol : C_HQ + gcol, cB = isg ? C_GK + gcol : C_HF + gcol, cC = C_HF + 512 + gcol;
#pragma unroll
                for (int k2 = 0; k2 < 2; ++k2) {
                    const int id = tid + 256 * k2, i = id >> 4, ch = id & 15;
                    const bf16_t* row = base + (size_t)i * PW;
                    *(uint4*)(inA + i * 128 + ch * 8) = *(const uint4*)(row + cA + ch * 8);
                    *(uint4*)(inB + i * 128 + ch * 8) = *(const uint4*)(row + cB + ch * 8);
                    if (!isg) *(uint4*)(inC + i * 128 + ch * 8) = *(const uint4*)(row + cC + ch * 8);
                }
                __syncthreads();
                {
                    const int col = gcol + d;
                    float lb = 0.f, b2 = 0.f, w2[16];
#pragma unroll
                    for (int jx = 0; jx < 16; ++jx) w2[jx] = 0.f;
                    if (isg) {
#pragma unroll
                        for (int jx = 0; jx < 16; ++jx) w2[jx] = P.gla_w2[((size_t)(l * 2 + dr) * 16 + jx) * 256 + col];
                        b2 = P.gla_b2[(l * 2 + dr) * 256 + col];
                    } else if (l != 0) lb = sigmoidf_(P.lb_logits[1024 + dr * 512 + col] - P.lb_logits[dr * 512 + col]);
                    const bf16_t* fsrc = (dr && !isg) ? inC : inB;
                    bf16_t* oq = outT + (dr ? 2 : 0) * 32 * 128;
                    bf16_t* ok = oq + 32 * 128;
                    float cum = 0.f;
#pragma unroll 4
                    for (int sx = 0; sx < 32; ++sx) {
                        const int i = dr ? 31 - sx : sx;
                        const float qv = bf2f(inA[i * 128 + d]), fv = bf2f(fsrc[i * 128 + d]);
                        float qq, kk, la;
                        if (isg) {
                            float g = b2;
#pragma unroll
                            for (int jx = 0; jx < 16; ++jx) g = fmaf(rsh[i * 32 + dr * 16 + jx], w2[jx], g);
                            la = (fminf(g, 0.f) - __logf(1.f + __expf(-fabsf(g)))) * 0.0625f;
                            qq = qv * 0.125f; kk = fv;
                        } else {
                            const float av = lb + (1.f - lb) * sigmoidf_(fv);
                            la = __logf(av); kk = 1.f - av;
                            qq = siluf_(qv) * 0.08838834764831845f;
                        }
                        cum += la;
                        oq[i * 128 + d] = f2bf(qq * __expf(cum));
                        ok[i * 128 + d] = f2bf(kk * __expf(-cum));
                    }
                    if (isg) EBG[(size_t)(chunk * 2 + dr) * 256 + col] = __expf(cum);
                    else EBH[(size_t)(chunk * 2 + dr) * 512 + col] = __expf(cum);
                }
                __syncthreads();
#pragma unroll
                for (int k2 = 0; k2 < 2; ++k2) {
                    const int id = tid + 256 * k2, i = id >> 4, ch = id & 15;
                    bf16_t* row = base + (size_t)i * PW;
                    const uint4 v0 = *(const uint4*)(outT + (0 * 32 + i) * 128 + ch * 8), v1 = *(const uint4*)(outT + (1 * 32 + i) * 128 + ch * 8);
                    const uint4 v2 = *(const uint4*)(outT + (2 * 32 + i) * 128 + ch * 8), v3 = *(const uint4*)(outT + (3 * 32 + i) * 128 + ch * 8);
                    *(uint4*)(row + cA + ch * 8) = v0;
                    *(uint4*)(row + cB + ch * 8) = v1;
                    if (isg) { bf16_t* xr = XG + (size_t)(t0 + i) * 512 + gcol + ch * 8; *(uint4*)xr = v2; *(uint4*)(xr + 256) = v3; }
                    else { *(uint4*)(XH + (size_t)(t0 + i) * 512 + gcol + ch * 8) = v2; *(uint4*)(row + cC + ch * 8) = v3; }
                }
                __syncthreads();
            }
        }
    }
}

template <int DQK, bool NAT>
__device__ void attn_item(const Params& P, int l, int bl, int head, int qb, unsigned char* smem) {
    constexpr int NKS = DQK / 16, KSTR = DQK + 8, VSTR = 68, KCH = DQK / 8, KLD = (DQK * 64 / 8) / 256;
    const int tid = tid_opaque(), lane = tid & 63, wave = tid >> 6, hh = lane >> 5, r32 = lane & 31;
    bf16_t* Ks = (bf16_t*)smem;
    bf16_t* Vs = Ks + 2 * 64 * KSTR;
    float* rpb_s = (float*)(Vs + 2 * 64 * VSTR);
    bf16_t* PB = (bf16_t*)(P.ws + OFF_PB);
    const int rowbase = bl * TB, q_p0 = qb * 128, ql = wave * 32 + r32;
    const bool q_ctx = qb < 2;
    int lt0 = 0, lt1 = 0;
    int qr = 0, qc = 0, r0w = 0, c0 = 0;
    if (!q_ctx) {
        if (NAT) { const int rp = qb - 2, ra = 2 * rp, rb = ra + 1; lt0 = min(max(ra - 4, 0), 120); lt1 = min(max(rb - 4, 0), 120) + 8;
            qr = ra + (wave >> 1); qc = (wave & 1) * 32 + r32; r0w = min(max(qr - 4, 0), 120); c0 = min(max(qc - 8, 0), 48); }
        else { lt0 = 0; lt1 = 128; }
    }
    const int ntiles = 4 + (lt1 - lt0);
    const bf16_t* Kbase; const bf16_t* VT; const bf16_t* qptr; int k_ld;
    if (NAT) { Kbase = PB + (size_t)rowbase * PW + C_NK + head * 64; k_ld = PW; VT = (const bf16_t*)(P.ws + OFF_VTN) + (size_t)(bl * 8 + head) * 64 * TB;
        qptr = PB + (size_t)(rowbase + q_p0 + ql) * PW + C_NQ + head * 64; }
    else { Kbase = (const bf16_t*)(P.ws + OFF_KF) + (size_t)rowbase * 768 + head * 96; k_ld = 768; VT = (const bf16_t*)(P.ws + OFF_VTM) + (size_t)(bl * 8 + head) * 64 * TB;
        qptr = (const bf16_t*)(P.ws + OFF_QF) + (size_t)(rowbase + q_p0 + ql) * 768 + head * 96; }
    if (NAT) { for (int i = tid; i < 465; i += 256) rpb_s[i] = P.rpb[(size_t)(l * 8 + head) * 465 + i] * LOG2E; }
    bf16x8 qf[NKS];
#pragma unroll
    for (int ks = 0; ks < NKS; ++ks) qf[ks] = *(const bf16x8*)(qptr + ks * 16 + hh * 8);
    bf16x8 qrot4 = qf[NKS - 2], qrot5 = qf[NKS - 1];
    if (!NAT && !q_ctx) {
        const int pos = q_p0 - CTXL + ql;
        const float base = hh ? (float)(pos & 63) : (float)(pos >> 6);
#pragma unroll
        for (int jj = 0; jj < 8; ++jj) {
            const float invf = __powf(10000.f, -(float)jj * 0.125f);
            const float ang = base * invf;
            double fr = (double)ang * 0.15915494309189535; fr -= rint(fr);
            const float sn = __builtin_amdgcn_sinf((float)fr), cs = __builtin_amdgcn_cosf((float)fr);
            const float x1 = bf2f((bf16_t)qf[4][jj]), x2 = bf2f((bf16_t)qf[5][jj]);
            qrot4[jj] = (short)f2bf(x1 * cs - x2 * sn);
            qrot5[jj] = (short)f2bf(x1 * sn + x2 * cs);
        }
    }
    float m_run = -1e30f, lsum = 0.f;
    f32x16 oacc[2];
#pragma unroll
    for (int r = 0; r < 16; ++r) { oacc[0][r] = 0.f; oacc[1][r] = 0.f; }
    uint4 kreg0A, kreg1A, kreg2A, vreg0A, vreg1A, kreg0B, kreg1B, kreg2B, vreg0B, vreg1B;
    kreg2A = kreg2B = make_uint4(0, 0, 0, 0);
    const int kid0 = tid, kid1 = tid + 256, kid2 = tid + 512;
    const int krow0 = kid0 / KCH, kch0 = kid0 % KCH, krow1 = kid1 / KCH, kch1 = kid1 % KCH, krow2 = kid2 / KCH, kch2 = kid2 % KCH;
    const int vrow0 = tid >> 3, vch = tid & 7, vrow1 = vrow0 + 32;
#define TILE_P(ti) ((ti) < 4 ? (ti) * 64 : CTXL + (lt0 + (ti) - 4) * 64)
#define GLOAD(ti, S) { const int p_ = TILE_P(ti); \
        kreg0##S = *(const uint4*)(Kbase + (size_t)(p_ + krow0) * k_ld + kch0 * 8); \
        kreg1##S = *(const uint4*)(Kbase + (size_t)(p_ + krow1) * k_ld + kch1 * 8); \
        if (KLD > 2) kreg2##S = *(const uint4*)(Kbase + (size_t)(p_ + krow2) * k_ld + kch2 * 8); \
        vreg0##S = *(const uint4*)(VT + (size_t)vrow0 * TB + p_ + vch * 8); \
        vreg1##S = *(const uint4*)(VT + (size_t)vrow1 * TB + p_ + vch * 8); }
#define SWRITE(buf_, S) { bf16_t* kd_ = Ks + (buf_) * 64 * KSTR; \
        *(uint4*)(kd_ + krow0 * KSTR + kch0 * 8) = kreg0##S; *(uint4*)(kd_ + krow1 * KSTR + kch1 * 8) = kreg1##S; \
        if (KLD > 2) *(uint4*)(kd_ + krow2 * KSTR + kch2 * 8) = kreg2##S; \
        bf16_t* vd_ = Vs + (buf_) * 64 * VSTR + vch * 8; \
        *(uint2*)(vd_ + vrow0 * VSTR) = make_uint2(vreg0##S.x, vreg0##S.y); *(uint2*)(vd_ + vrow0 * VSTR + 4) = make_uint2(vreg0##S.z, vreg0##S.w); \
        *(uint2*)(vd_ + vrow1 * VSTR) = make_uint2(vreg1##S.x, vreg1##S.y); *(uint2*)(vd_ + vrow1 * VSTR + 4) = make_uint2(vreg1##S.z, vreg1##S.w); }
    GLOAD(0, A); SWRITE(0, A);
    { const int t1_ = 1 < ntiles ? 1 : ntiles - 1; GLOAD(t1_, B); }
    __syncthreads();
    for (int ti0 = 0; ti0 < ntiles; ti0 += 2) {
        { const int tl_ = ti0 + 2 < ntiles ? ti0 + 2 : ntiles - 1; GLOAD(tl_, A); asm volatile("" ::: "memory"); }
        { const int ti = ti0; const int buf = 0;
        if (!NAT && ti == 4) { qf[NKS - 2] = qrot4; qf[NKS - 1] = qrot5; }
        const int kr = lt0 + ti - 4;
        const bool active = !NAT || ti < 4 || (kr >= r0w && kr < r0w + 8);
        if (active) {
            const bf16_t* kb = Ks + buf * 64 * KSTR + r32 * KSTR + hh * 8;
            f32x16 st0, st1;
#pragma unroll
            for (int r = 0; r < 16; ++r) { st0[r] = 0.f; st1[r] = 0.f; }
            bf16x8 kf0[NKS], kf1[NKS];
#pragma unroll
            for (int ks = 0; ks < NKS; ++ks) { kf0[ks] = *(const bf16x8*)(kb + ks * 16); kf1[ks] = *(const bf16x8*)(kb + 32 * KSTR + ks * 16); }
            asm volatile("s_waitcnt lgkmcnt(0)" ::: "memory");
#pragma unroll
            for (int ks = 0; ks < NKS; ++ks) {
                st0 = __builtin_amdgcn_mfma_f32_32x32x16_bf16(kf0[ks], qf[ks], st0, 0, 0, 0);
                st1 = __builtin_amdgcn_mfma_f32_32x32x16_bf16(kf1[ks], qf[ks], st1, 0, 0, 0);
            }
            const bf16_t* vb = Vs + buf * 64 * VSTR + r32 * VSTR + 4 * hh;
            uint2 vfr[2][2][2][2];
#pragma unroll
            for (int uu = 0; uu < 2; ++uu)
#pragma unroll
                for (int t = 0; t < 2; ++t)
#pragma unroll
                    for (int s2 = 0; s2 < 2; ++s2) {
                        const bf16_t* a = vb + uu * 32 * VSTR + t * 32 + s2 * 16;
                        vfr[uu][t][s2][0] = *(const uint2*)a; vfr[uu][t][s2][1] = *(const uint2*)(a + 8);
                    }
            float x[32];
#pragma unroll
            for (int r = 0; r < 16; ++r) { x[r] = st0[r]; x[16 + r] = st1[r]; }
            if (NAT && ti >= 4) {
                const int dr = kr - qr + 7;
#pragma unroll
                for (int e = 0; e < 32; ++e) {
                    const int r = e & 15, kc = (e >> 4) * 32 + (r & 3) + 8 * (r >> 2) + 4 * hh;
                    const int dc = min(max(kc - qc, -15), 15) + 15;
                    const bool ok = (kc >= c0) && (kc < c0 + 16);
                    x[e] = ok ? x[e] + rpb_s[dr * 31 + dc] : -1e30f;
                }
            }
            float mx = x[0];
#pragma unroll
            for (int e = 1; e < 32; ++e) mx = fmaxf(mx, x[e]);
            mx = fmaxf(mx, __shfl_xor(mx, 32));
            if (__ballot(mx > m_run + 8.f) != 0ull) {
                const float m_new = fmaxf(m_run, mx);
                const float alpha = __builtin_amdgcn_exp2f(m_run - m_new);
                m_run = m_new;
                lsum *= alpha;
#pragma unroll
                for (int r = 0; r < 16; ++r) { oacc[0][r] *= alpha; oacc[1][r] *= alpha; }
            }
            float ps = 0.f;
#pragma unroll
            for (int e = 0; e < 32; ++e) { x[e] = __builtin_amdgcn_exp2f(x[e] - m_run); ps += x[e]; }
            lsum += ps;
            bf16x8 pf[2][2];
#pragma unroll
            for (int t = 0; t < 2; ++t)
#pragma unroll
                for (int s = 0; s < 2; ++s) {
                    union { bf16x8 v; unsigned u[4]; } cv;
#pragma unroll
                    for (int q = 0; q < 4; ++q) cv.u[q] = cvt_pk(x[16 * t + 8 * s + 2 * q], x[16 * t + 8 * s + 2 * q + 1]);
                    pf[t][s] = cv.v;
                }
#pragma unroll
            for (int uu = 0; uu < 2; ++uu)
#pragma unroll
                for (int t = 0; t < 2; ++t)
#pragma unroll
                    for (int s = 0; s < 2; ++s) {
                        union { bf16x8 v; uint2 h[2]; } cv;
                        cv.h[0] = vfr[uu][t][s][0]; cv.h[1] = vfr[uu][t][s][1];
                        oacc[uu] = __builtin_amdgcn_mfma_f32_32x32x16_bf16(cv.v, pf[t][s], oacc[uu], 0, 0, 0);
                    }
        }
        }
        SWRITE(1, B);
        __syncthreads();
        if (ti0 + 1 >= ntiles) break;
        { const int tl_ = ti0 + 3 < ntiles ? ti0 + 3 : ntiles - 1; GLOAD(tl_, B); asm volatile("" ::: "memory"); }
        { const int ti = ti0 + 1; const int buf = 1;
        if (!NAT && ti == 4) { qf[NKS - 2] = qrot4; qf[NKS - 1] = qrot5; }
        const int kr = lt0 + ti - 4;
        const bool active = !NAT || ti < 4 || (kr >= r0w && kr < r0w + 8);
        if (active) {
            const bf16_t* kb = Ks + buf * 64 * KSTR + r32 * KSTR + hh * 8;
            f32x16 st0, st1;
#pragma unroll
            for (int r = 0; r < 16; ++r) { st0[r] = 0.f; st1[r] = 0.f; }
            bf16x8 kf0[NKS], kf1[NKS];
#pragma unroll
            for (int ks = 0; ks < NKS; ++ks) { kf0[ks] = *(const bf16x8*)(kb + ks * 16); kf1[ks] = *(const bf16x8*)(kb + 32 * KSTR + ks * 16); }
            asm volatile("s_waitcnt lgkmcnt(0)" ::: "memory");
#pragma unroll
            for (int ks = 0; ks < NKS; ++ks) {
                st0 = __builtin_amdgcn_mfma_f32_32x32x16_bf16(kf0[ks], qf[ks], st0, 0, 0, 0);
                st1 = __builtin_amdgcn_mfma_f32_32x32x16_bf16(kf1[ks], qf[ks], st1, 0, 0, 0);
            }
            const bf16_t* vb = Vs + buf * 64 * VSTR + r32 * VSTR + 4 * hh;
            uint2 vfr[2][2][2][2];
#pragma unroll
            for (int uu = 0; uu < 2; ++uu)
#pragma unroll
                for (int t = 0; t < 2; ++t)
#pragma unroll
                    for (int s2 = 0; s2 < 2; ++s2) {
                        const bf16_t* a = vb + uu * 32 * VSTR + t * 32 + s2 * 16;
                        vfr[uu][t][s2][0] = *(const uint2*)a; vfr[uu][t][s2][1] = *(const uint2*)(a + 8);
                    }
            float x[32];
#pragma unroll
            for (int r = 0; r < 16; ++r) { x[r] = st0[r]; x[16 + r] = st1[r]; }
            if (NAT && ti >= 4) {
                const int dr = kr - qr + 7;
#pragma unroll
                for (int e = 0; e < 32; ++e) {
                    const int r = e & 15, kc = (e >> 4) * 32 + (r & 3) + 8 * (r >> 2) + 4 * hh;
                    const int dc = min(max(kc - qc, -15), 15) + 15;
                    const bool ok = (kc >= c0) && (kc < c0 + 16);
                    x[e] = ok ? x[e] + rpb_s[dr * 31 + dc] : -1e30f;
                }
            }
            float mx = x[0];
#pragma unroll
            for (int e = 1; e < 32; ++e) mx = fmaxf(mx, x[e]);
            mx = fmaxf(mx, __shfl_xor(mx, 32));
            if (__ballot(mx > m_run + 8.f) != 0ull) {
                const float m_new = fmaxf(m_run, mx);
                const float alpha = __builtin_amdgcn_exp2f(m_run - m_new);
                m_run = m_new;
                lsum *= alpha;
#pragma unroll
                for (int r = 0; r < 16; ++r) { oacc[0][r] *= alpha; oacc[1][r] *= alpha; }
            }
            float ps = 0.f;
#pragma unroll
            for (int e = 0; e < 32; ++e) { x[e] = __builtin_amdgcn_exp2f(x[e] - m_run); ps += x[e]; }
            lsum += ps;
            bf16x8 pf[2][2];
#pragma unroll
            for (int t = 0; t < 2; ++t)
#pragma unroll
                for (int s = 0; s < 2; ++s) {
                    union { bf16x8 v; unsigned u[4]; } cv;
#pragma unroll
                    for (int q = 0; q < 4; ++q) cv.u[q] = cvt_pk(x[16 * t + 8 * s + 2 * q], x[16 * t + 8 * s + 2 * q + 1]);
                    pf[t][s] = cv.v;
                }
#pragma unroll
            for (int uu = 0; uu < 2; ++uu)
#pragma unroll
                for (int t = 0; t < 2; ++t)
#pragma unroll
                    for (int s = 0; s < 2; ++s) {
                        union { bf16x8 v; uint2 h[2]; } cv;
                        cv.h[0] = vfr[uu][t][s][0]; cv.h[1] = vfr[uu][t][s][1];
                        oacc[uu] = __builtin_amdgcn_mfma_f32_32x32x16_bf16(cv.v, pf[t][s], oacc[uu], 0, 0, 0);
                    }
        }
        }
        SWRITE(0, A);
        __syncthreads();
    }
#undef TILE_P
#undef GLOAD
#undef SWRITE
    lsum += __shfl_xor(lsum, 32);
    const float inv = 1.f / lsum;
    bf16_t* zrow = PB + (size_t)(rowbase + q_p0 + ql) * PW + C_Z + (NAT ? 512 : 0) + head * 64;
#pragma unroll
    for (int uu = 0; uu < 2; ++uu)
#pragma unroll
        for (int g = 0; g < 4; ++g) {
            bf16_t* zp = zrow + uu * 32 + 8 * g + 4 * hh;
            const uint2 z = *(const uint2*)zp;
            uint2 o;
            o.x = cvt_pk(oacc[uu][4 * g + 0] * inv * siluf_(lo16(z.x)), oacc[uu][4 * g + 1] * inv * siluf_(hi16(z.x)));
            o.y = cvt_pk(oacc[uu][4 * g + 2] * inv * siluf_(lo16(z.y)), oacc[uu][4 * g + 3] * inv * siluf_(hi16(z.y)));
            *(uint2*)zp = o;
        }
}

__device__ void scan_hg_item(const Params& P, int l, int item, unsigned char* smem) {
    const int tid = tid_opaque(), lane = tid & 63, wave = tid >> 6;
    const int slice = item & 7, dir = (item >> 3) & 1, head = (item >> 4) & 3, bl = item >> 6;
    float* a_s = (float*)smem;
    float* q_s = a_s + 64 * 128;
    float* v_s = q_s + 64 * 128;
    float* o_s = v_s + 64 * 16;
    const bf16_t* PB = (const bf16_t*)(P.ws + OFF_PB) + (size_t)bl * TB * PW;
    bf16_t* OS = (bf16_t*)(P.ws + OFF_KV) + ((size_t)dir * NTH + (size_t)bl * TB) * 512 + head * 128 + slice * 16;
    const int prow = tid >> 4, pd = (tid & 15) * 8;
    float lb[8];
#pragma unroll
    for (int e = 0; e < 8; ++e) {
        const int cidx = dir * 512 + head * 128 + pd + e;
        lb[e] = (l == 0) ? 0.f : sigmoidf_(P.lb_logits[1024 + cidx] - P.lb_logits[cidx]);
    }
    const int fcol = (dir ? C_HF + 512 : C_HF) + head * 128 + pd, qcol = C_HQ + head * 128 + pd, vcol = C_HI + head * 128 + slice * 16 + (tid & 1) * 8;
    uint4 rq[4], rf[4], rv;
    auto chunk_p = [&](int c) { const int ci = dir ? (c < 4 ? 3 - c : 135 - c) : c; return ci * 64; };
    auto gload = [&](int c) {
        const int p = chunk_p(c);
#pragma unroll
        for (int r = 0; r < 4; ++r) { const bf16_t* row = PB + (size_t)(p + prow + 16 * r) * PW; rq[r] = *(const uint4*)(row + qcol); rf[r] = *(const uint4*)(row + fcol); }
        if (tid < 128) rv = *(const uint4*)(PB + (size_t)(p + (tid >> 1)) * PW + vcol);
    };
    const int dg = lane & 15, col = wave * 4 + (lane >> 4);
    float S[8];
#pragma unroll
    for (int e = 0; e < 8; ++e) S[e] = 0.f;
    gload(0);
    for (int c = 0; c < 132; ++c) {
        __syncthreads();
#pragma unroll
        for (int r = 0; r < 4; ++r) {
            float fq[8], ff[8];
            unpack8(rq[r], fq); unpack8(rf[r], ff);
            float* ad = a_s + (prow + 16 * r) * 128 + pd; float* qd = q_s + (prow + 16 * r) * 128 + pd;
#pragma unroll
            for (int e = 0; e < 8; ++e) { ad[e] = lb[e] + (1.f - lb[e]) * sigmoidf_(ff[e]); qd[e] = siluf_(fq[e]) * 0.08838834764831845f; }
        }
        if (tid < 128) { float fv[8]; unpack8(rv, fv); float* vd = v_s + (tid >> 1) * 16 + (tid & 1) * 8;
#pragma unroll
            for (int e = 0; e < 8; ++e) vd[e] = fv[e]; }
        __syncthreads();
        if (c + 1 < 132) gload(c + 1);
        for (int tt = 0; tt < 64; tt += 8) {
            float op[8];
#pragma unroll
            for (int u = 0; u < 8; ++u) {
                const int i = dir ? 63 - (tt + u) : tt + u;
                const float4 a0 = *(const float4*)(a_s + i * 128 + dg * 8), a1 = *(const float4*)(a_s + i * 128 + dg * 8 + 4);
                const float4 q0 = *(const float4*)(q_s + i * 128 + dg * 8), q1 = *(const float4*)(q_s + i * 128 + dg * 8 + 4);
                const float v = v_s[i * 16 + col];
                float o;
                S[0] = fmaf(a0.x, S[0] - v, v); o = q0.x * S[0];
                S[1] = fmaf(a0.y, S[1] - v, v); o = fmaf(q0.y, S[1], o);
                S[2] = fmaf(a0.z, S[2] - v, v); o = fmaf(q0.z, S[2], o);
                S[3] = fmaf(a0.w, S[3] - v, v); o = fmaf(q0.w, S[3], o);
                S[4] = fmaf(a1.x, S[4] - v, v); o = fmaf(q1.x, S[4], o);
                S[5] = fmaf(a1.y, S[5] - v, v); o = fmaf(q1.y, S[5], o);
                S[6] = fmaf(a1.z, S[6] - v, v); o = fmaf(q1.z, S[6], o);
                S[7] = fmaf(a1.w, S[7] - v, v); o = fmaf(q1.w, S[7], o);
                op[u] = o;
            }
            float r4[4], r2[2];
            const bool b8 = dg & 8, b4 = dg & 4, b2 = dg & 2;
#pragma unroll
            for (int k = 0; k < 4; ++k) { const float snd = b8 ? op[k] : op[k + 4], kp = b8 ? op[k + 4] : op[k]; r4[k] = kp + __shfl_xor(snd, 8); }
#pragma unroll
            for (int k = 0; k < 2; ++k) { const float snd = b4 ? r4[k] : r4[k + 2], kp = b4 ? r4[k + 2] : r4[k]; r2[k] = kp + __shfl_xor(snd, 4); }
            float r1; { const float snd = b2 ? r2[0] : r2[1], kp = b2 ? r2[1] : r2[0]; r1 = kp + __shfl_xor(snd, 2); }
            r1 += __shfl_xor(r1, 1);
            if ((dg & 1) == 0) { const int tok = tt + (b8 ? 4 : 0) + (b4 ? 2 : 0) + (b2 ? 1 : 0); const int i = dir ? 63 - tok : tok; o_s[i * 16 + col] = r1; }
        }
        __syncthreads();
        if (tid < 128) {
            const int p = chunk_p(c) + (tid >> 1);
            *(uint4*)(OS + (size_t)p * 512 + (tid & 1) * 8) = pack8(o_s + (tid >> 1) * 16 + (tid & 1) * 8);
        }
    }
}

__device__ void scan_gla_item(const Params& P, int l, int item, unsigned char* smem) {
    const int tid = tid_opaque(), lane = tid & 63, wave = tid >> 6;
    const int slice = item & 3, dir = (item >> 2) & 1, head = (item >> 3) & 3, bl = item >> 5;
    float* a_s = (float*)smem;
    float* q_s = a_s + 64 * 64;
    float* k_s = q_s + 64 * 64;
    float* v_s = k_s + 64 * 64;
    float* o_s = v_s + 64 * 32;
    float* r_s = o_s + 64 * 32;
    const bf16_t* PB = (const bf16_t*)(P.ws + OFF_PB) + (size_t)bl * TB * PW;
    bf16_t* OS = (bf16_t*)(P.ws + OFF_OSG) + ((size_t)dir * NTH + (size_t)bl * TB) * 512 + head * 128 + slice * 32;
    const int gd = tid & 63, gt0 = tid >> 6;
    float w2[16];
#pragma unroll
    for (int jx = 0; jx < 16; ++jx) w2[jx] = P.gla_w2[((size_t)(l * 2 + dir) * 16 + jx) * 256 + head * 64 + gd];
    const float b2 = P.gla_b2[(l * 2 + dir) * 256 + head * 64 + gd];
    uint4 rq[2], rk[2], rv, rr;
    auto chunk_p = [&](int c) { const int ci = dir ? (c < 4 ? 3 - c : 135 - c) : c; return ci * 64; };
    auto gload = [&](int c) {
        const int p = chunk_p(c);
#pragma unroll
        for (int i = 0; i < 2; ++i) { const int id = tid + 256 * i, row = id >> 3, ch = id & 7; const bf16_t* rp = PB + (size_t)(p + row) * PW;
            rq[i] = *(const uint4*)(rp + C_GQ + head * 64 + ch * 8); rk[i] = *(const uint4*)(rp + C_GK + head * 64 + ch * 8); }
        { const int row = tid >> 2, ch = tid & 3; rv = *(const uint4*)(PB + (size_t)(p + row) * PW + C_GV + head * 128 + slice * 32 + ch * 8); }
        if (tid < 128) { const int row = tid >> 1, ch = tid & 1; rr = *(const uint4*)(PB + (size_t)(p + row) * PW + C_GR + dir * 16 + ch * 8); }
    };
    const int dg = lane & 7, col = wave * 8 + (lane >> 3);
    float S[8];
#pragma unroll
    for (int e = 0; e < 8; ++e) S[e] = 0.f;
    gload(0);
    for (int c = 0; c < 132; ++c) {
        __syncthreads();
#pragma unroll
        for (int i = 0; i < 2; ++i) { const int id = tid + 256 * i, row = id >> 3, ch = id & 7; float fq[8], fk[8]; unpack8(rq[i], fq); unpack8(rk[i], fk);
#pragma unroll
            for (int e = 0; e < 8; ++e) { q_s[row * 64 + ch * 8 + e] = fq[e] * 0.125f; k_s[row * 64 + ch * 8 + e] = fk[e]; } }
        { const int row = tid >> 2, ch = tid & 3; float fv[8]; unpack8(rv, fv);
#pragma unroll
            for (int e = 0; e < 8; ++e) v_s[row * 32 + ch * 8 + e] = fv[e]; }
        if (tid < 128) { const int row = tid >> 1, ch = tid & 1; float fr[8]; unpack8(rr, fr);
#pragma unroll
            for (int e = 0; e < 8; ++e) r_s[row * 16 + ch * 8 + e] = fr[e]; }
        __syncthreads();
        if (c + 1 < 132) gload(c + 1);
#pragma unroll 4
        for (int m = 0; m < 16; ++m) {
            const int i = gt0 + 4 * m;
            float g = b2;
#pragma unroll
            for (int jx = 0; jx < 16; ++jx) g = fmaf(r_s[i * 16 + jx], w2[jx], g);
            const float ls = fminf(g, 0.f) - __logf(1.f + __expf(-fabsf(g)));
            a_s[i * 64 + gd] = __expf(ls * 0.0625f);
        }
        __syncthreads();
        for (int tt = 0; tt < 64; tt += 8) {
            float op[8];
#pragma unroll
            for (int u = 0; u < 8; ++u) {
                const int i = dir ? 63 - (tt + u) : tt + u;
                const float4 a0 = *(const float4*)(a_s + i * 64 + dg * 8), a1 = *(const float4*)(a_s + i * 64 + dg * 8 + 4);
                const float4 q0 = *(const float4*)(q_s + i * 64 + dg * 8), q1 = *(const float4*)(q_s + i * 64 + dg * 8 + 4);
                const float4 k0 = *(const float4*)(k_s + i * 64 + dg * 8), k1 = *(const float4*)(k_s + i * 64 + dg * 8 + 4);
                const float v = v_s[i * 32 + col];
                float o;
                S[0] = fmaf(a0.x, S[0], k0.x * v); o = q0.x * S[0];
                S[1] = fmaf(a0.y, S[1], k0.y * v); o = fmaf(q0.y, S[1], o);
                S[2] = fmaf(a0.z, S[2], k0.z * v); o = fmaf(q0.z, S[2], o);
                S[3] = fmaf(a0.w, S[3], k0.w * v); o = fmaf(q0.w, S[3], o);
                S[4] = fmaf(a1.x, S[4], k1.x * v); o = fmaf(q1.x, S[4], o);
                S[5] = fmaf(a1.y, S[5], k1.y * v); o = fmaf(q1.y, S[5], o);
                S[6] = fmaf(a1.z, S[6], k1.z * v); o = fmaf(q1.z, S[6], o);
                S[7] = fmaf(a1.w, S[7], k1.w * v); o = fmaf(q1.w, S[7], o);
                op[u] = o;
            }
            float r4[4], r2[2];
            const bool b4 = dg & 4, b2 = dg & 2, b1 = dg & 1;
#pragma unroll
            for (int k = 0; k < 4; ++k) { const float snd = b4 ? op[k] : op[k + 4], kp = b4 ? op[k + 4] : op[k]; r4[k] = kp + __shfl_xor(snd, 4); }
#pragma unroll
            for (int k = 0; k < 2; ++k) { const float snd = b2 ? r4[k] : r4[k + 2], kp = b2 ? r4[k + 2] : r4[k]; r2[k] = kp + __shfl_xor(snd, 2); }
            float r1; { const float snd = b1 ? r2[0] : r2[1], kp = b1 ? r2[1] : r2[0]; r1 = kp + __shfl_xor(snd, 1); }
            { const int tok = tt + (b4 ? 4 : 0) + (b2 ? 2 : 0) + (b1 ? 1 : 0); const int i = dir ? 63 - tok : tok; o_s[i * 32 + col] = r1; }
        }
        __syncthreads();
        { const int row = tid >> 2, ch = tid & 3; const int p = chunk_p(c) + row;
          *(uint4*)(OS + (size_t)p * 512 + ch * 8) = pack8(o_s + row * 32 + ch * 8); }
    }
}


template <bool GLA>
__device__ void scan2_item(const Params& P, int l, int item, unsigned char* smem) {
    constexpr int DK = GLA ? 64 : 128, NT = DK / 32, QS = DK + 8, TS = 40, NSEG = GLA ? 4 : 2, TPS = 32 / NSEG, QCH = DK / 8;
    const int tid = tid_opaque(), lane = tid & 63, wave = tid >> 6, r32 = lane & 31, hh = lane >> 5;
    const int dir = item & 1, head = (item >> 1) & 3, bl = item >> 3;
    bf16_t* Qh = (bf16_t*)smem;
    bf16_t* Kh = Qh + 32 * QS;
    bf16_t* Kt = Kh + 32 * QS;
    bf16_t* Vt = Kt + DK * TS;
    float* eb = (float*)(Vt + 128 * TS);
    float* tot = eb + DK;
    bf16_t* qraw = (bf16_t*)(tot + 4 * DK);
    bf16_t* fraw = qraw + 32 * DK;
    bf16_t* vraw = fraw + 32 * DK;
    bf16_t* rraw = vraw + 32 * 128;
    const bf16_t* PB = (const bf16_t*)(P.ws + OFF_PB) + (size_t)bl * TB * PW;
    bf16_t* OS = (bf16_t*)(P.ws + (GLA ? OFF_OSG : OFF_KV)) + ((size_t)dir * NTH + (size_t)bl * TB) * 512 + head * 128 + wave * 32;
    const int qcol = (GLA ? C_GQ : C_HQ) + head * DK, fcol = GLA ? (C_GK + head * 64) : ((dir ? C_HF + 512 : C_HF) + head * 128),
              vcol = (GLA ? C_GV : C_HI) + head * 128, rcol = C_GR + dir * 16;
    const int pd = tid & (DK - 1), seg = tid / DK;
    float lbv = 0.f, b2 = 0.f, w2[16];
#pragma unroll
    for (int jx = 0; jx < 16; ++jx) w2[jx] = 0.f;
    if (GLA) {
#pragma unroll
        for (int jx = 0; jx < 16; ++jx) w2[jx] = P.gla_w2[((size_t)(l * 2 + dir) * 16 + jx) * 256 + head * 64 + pd];
        b2 = P.gla_b2[(l * 2 + dir) * 256 + head * 64 + pd];
    } else if (l != 0) { const int cidx = dir * 512 + head * 128 + pd; lbv = sigmoidf_(P.lb_logits[1024 + cidx] - P.lb_logits[cidx]); }
    uint4 pq0, pq1, pf0, pf1, pv0, pv1, pr;
    pq1 = pf1 = pr = make_uint4(0, 0, 0, 0);
#define CH_P0(c) (dir ? ((c) < 8 ? (7 - (c)) * 32 : CTXL + (263 - (c)) * 32) : (c) * 32)
#define ROWP(p0_, i_) ((p0_) + (dir ? 31 - (i_) : (i_)))
#define SC_GLOAD(c) { const int p0_ = CH_P0(c); \
        { const int id = tid, i = id / QCH, ch = id % QCH; const bf16_t* rp = PB + (size_t)ROWP(p0_, i) * PW; pq0 = *(const uint4*)(rp + qcol + ch * 8); pf0 = *(const uint4*)(rp + fcol + ch * 8); } \
        if (!GLA) { const int id = tid + 256, i = id / QCH, ch = id % QCH; const bf16_t* rp = PB + (size_t)ROWP(p0_, i) * PW; pq1 = *(const uint4*)(rp + qcol + ch * 8); pf1 = *(const uint4*)(rp + fcol + ch * 8); } \
        { const int i = tid >> 4, ch = tid & 15; pv0 = *(const uint4*)(PB + (size_t)ROWP(p0_, i) * PW + vcol + ch * 8); pv1 = *(const uint4*)(PB + (size_t)ROWP(p0_, i + 16) * PW + vcol + ch * 8); } \
        if (GLA && tid < 64) { const int i = tid >> 1, ch = tid & 1; pr = *(const uint4*)(PB + (size_t)ROWP(p0_, i) * PW + rcol + ch * 8); } }
    f32x16 ST[NT];
#pragma unroll
    for (int T = 0; T < NT; ++T)
#pragma unroll
        for (int r = 0; r < 16; ++r) ST[T][r] = 0.f;
    SC_GLOAD(0);
    for (int c = 0; c < 264; ++c) {
        __syncthreads();
        { const int id = tid, i = id / QCH, ch = id % QCH; *(uint4*)(qraw + i * DK + ch * 8) = pq0; *(uint4*)(fraw + i * DK + ch * 8) = pf0; }
        if (!GLA) { const int id = tid + 256, i = id / QCH, ch = id % QCH; *(uint4*)(qraw + i * DK + ch * 8) = pq1; *(uint4*)(fraw + i * DK + ch * 8) = pf1; }
        { const int i = tid >> 4, ch = tid & 15; *(uint4*)(vraw + i * 128 + ch * 8) = pv0; *(uint4*)(vraw + (i + 16) * 128 + ch * 8) = pv1; }
        if (GLA && tid < 64) { const int i = tid >> 1, ch = tid & 1; *(uint4*)(rraw + i * 16 + ch * 8) = pr; }
        __syncthreads();
        if (c + 1 < 264) SC_GLOAD(c + 1);
        float bl_[TPS], kk[TPS], qq[TPS];
        float cum = 0.f;
#pragma unroll
        for (int tt = 0; tt < TPS; ++tt) {
            const int i = seg * TPS + tt;
            float la;
            if (GLA) {
                float g = b2;
#pragma unroll
                for (int jx = 0; jx < 16; ++jx) g = fmaf(bf2f(rraw[i * 16 + jx]), w2[jx], g);
                la = (fminf(g, 0.f) - __logf(1.f + __expf(-fabsf(g)))) * 0.0625f;
                kk[tt] = bf2f(fraw[i * DK + pd]);
                qq[tt] = bf2f(qraw[i * DK + pd]) * 0.125f;
            } else {
                const float f = bf2f(fraw[i * DK + pd]);
                const float a = lbv + (1.f - lbv) * sigmoidf_(f);
                la = __logf(a);
                kk[tt] = 1.f - a;
                qq[tt] = siluf_(bf2f(qraw[i * DK + pd])) * 0.08838834764831845f;
            }
            cum += la;
            bl_[tt] = cum;
        }
        tot[seg * DK + pd] = cum;
        __syncthreads();
        {
            float off = 0.f, bend = 0.f;
#pragma unroll
            for (int sg = 0; sg < NSEG; ++sg) { const float tv = tot[sg * DK + pd]; bend += tv; if (sg < seg) off += tv; }
            const float eend = __expf(bend);
            if (seg == 0) eb[pd] = eend;
            float kt[TPS];
#pragma unroll
            for (int tt = 0; tt < TPS; ++tt) {
                const int i = seg * TPS + tt;
                const float b = bl_[tt] + off;
                const float e1 = __expf(b), e2 = __expf(-b);
                const float kh = kk[tt] * e2;
                Qh[i * QS + pd] = f2bf(qq[tt] * e1);
                Kh[i * QS + pd] = f2bf(kh);
                kt[tt] = kh * eend;
            }
#pragma unroll
            for (int g8 = 0; g8 < TPS / 8; ++g8) *(uint4*)(Kt + pd * TS + seg * TPS + g8 * 8) = pack8(kt + g8 * 8);
            const int vc = tid & 127, vs = tid >> 7;
            float vv[16];
#pragma unroll
            for (int tt = 0; tt < 16; ++tt) vv[tt] = bf2f(vraw[(vs * 16 + tt) * 128 + vc]);
            *(uint4*)(Vt + vc * TS + vs * 16) = pack8(vv);
            *(uint4*)(Vt + vc * TS + vs * 16 + 8) = pack8(vv + 8);
        }
        __syncthreads();
        f32x16 st;
#pragma unroll
        for (int r = 0; r < 16; ++r) st[r] = 0.f;
#pragma unroll
        for (int ks = 0; ks < DK / 16; ++ks) {
            const bf16x8 ka = *(const bf16x8*)(Kh + r32 * QS + ks * 16 + hh * 8);
            const bf16x8 qb = *(const bf16x8*)(Qh + r32 * QS + ks * 16 + hh * 8);
            st = __builtin_amdgcn_mfma_f32_32x32x16_bf16(ka, qb, st, 0, 0, 0);
        }
        bf16x8 pfr[2];
#pragma unroll
        for (int sI = 0; sI < 2; ++sI) {
            union { bf16x8 v; unsigned u[4]; } cv;
#pragma unroll
            for (int q = 0; q < 4; ++q) {
                const int ra = 8 * sI + 2 * q, rb = ra + 1;
                const int ja = (ra & 3) + 8 * (ra >> 2) + 4 * hh, jb = (rb & 3) + 8 * (rb >> 2) + 4 * hh;
                cv.u[q] = cvt_pk(ja <= r32 ? st[ra] : 0.f, jb <= r32 ? st[rb] : 0.f);
            }
            pfr[sI] = cv.v;
        }
        f32x16 oT;
#pragma unroll
        for (int r = 0; r < 16; ++r) oT[r] = 0.f;
#pragma unroll
        for (int sI = 0; sI < 2; ++sI) {
            const bf16_t* a = Vt + (wave * 32 + r32) * TS + sI * 16 + 4 * hh;
            union { bf16x8 v; uint2 h[2]; } cv;
            cv.h[0] = *(const uint2*)a; cv.h[1] = *(const uint2*)(a + 8);
            oT = __builtin_amdgcn_mfma_f32_32x32x16_bf16(cv.v, pfr[sI], oT, 0, 0, 0);
        }
#pragma unroll
        for (int T = 0; T < NT; ++T)
#pragma unroll
            for (int sI = 0; sI < 2; ++sI) {
                union { bf16x8 v; unsigned u[4]; } ca;
#pragma unroll
                for (int q = 0; q < 4; ++q) ca.u[q] = cvt_pk(ST[T][8 * sI + 2 * q], ST[T][8 * sI + 2 * q + 1]);
                const bf16_t* b = Qh + r32 * QS + T * 32 + sI * 16 + 4 * hh;
                union { bf16x8 v; uint2 h[2]; } cb;
                cb.h[0] = *(const uint2*)b; cb.h[1] = *(const uint2*)(b + 8);
                oT = __builtin_amdgcn_mfma_f32_32x32x16_bf16(ca.v, cb.v, oT, 0, 0, 0);
            }
#pragma unroll
        for (int T = 0; T < NT; ++T) {
#pragma unroll
            for (int g = 0; g < 4; ++g) {
                const float4 e4 = *(const float4*)(eb + T * 32 + 8 * g + 4 * hh);
                ST[T][4 * g + 0] *= e4.x; ST[T][4 * g + 1] *= e4.y; ST[T][4 * g + 2] *= e4.z; ST[T][4 * g + 3] *= e4.w;
            }
#pragma unroll
            for (int ks = 0; ks < 2; ++ks) {
                const bf16x8 ka = *(const bf16x8*)(Kt + (T * 32 + r32) * TS + ks * 16 + hh * 8);
                const bf16x8 vb = *(const bf16x8*)(Vt + (wave * 32 + r32) * TS + ks * 16 + hh * 8);
                ST[T] = __builtin_amdgcn_mfma_f32_32x32x16_bf16(ka, vb, ST[T], 0, 0, 0);
            }
        }
        {
            const int p = ROWP(CH_P0(c), r32);
            bf16_t* op = OS + (size_t)p * 512 + 4 * hh;
#pragma unroll
            for (int g = 0; g < 4; ++g) { uint2 o; o.x = cvt_pk(oT[4 * g], oT[4 * g + 1]); o.y = cvt_pk(oT[4 * g + 2], oT[4 * g + 3]); *(uint2*)(op + 8 * g) = o; }
        }
    }
#undef CH_P0
#undef ROWP
#undef SC_GLOAD
}


template <bool GLA>
__device__ __forceinline__ void scan3_build(f32x16 (&ST)[GLA ? 2 : 4], bf16_t* Qh, bf16_t* Kh, bf16_t* Kt, bf16_t* Vt, float* eb, bf16_t* vraw, bf16_t* OS,
                                           int tid, int wave, int r32, int hh, int pd, int seg, int c, int dir) {
    constexpr int DK = GLA ? 64 : 128, NT = DK / 32, QS = DK + 8, TS = 40, NSEG = GLA ? 4 : 2, TPS = 32 / NSEG;
#define CH_P0(c) (dir ? ((c) < 8 ? (7 - (c)) * 32 : CTXL + (263 - (c)) * 32) : (c) * 32)
#define ROWP(p0_, i_) ((p0_) + (dir ? 31 - (i_) : (i_)))
        {
            const float eend = eb[pd];
            float kt[TPS];
#pragma unroll
            for (int tt = 0; tt < TPS; ++tt) kt[tt] = bf2f(Kh[(seg * TPS + tt) * QS + pd]) * eend;
#pragma unroll
            for (int g8 = 0; g8 < TPS / 8; ++g8) *(uint4*)(Kt + pd * TS + seg * TPS + g8 * 8) = pack8(kt + g8 * 8);
            const int vc = tid & 127, vs = tid >> 7;
            float vv[16];
#pragma unroll
            for (int tt = 0; tt < 16; ++tt) vv[tt] = bf2f(vraw[(vs * 16 + tt) * 128 + vc]);
            *(uint4*)(Vt + vc * TS + vs * 16) = pack8(vv);
            *(uint4*)(Vt + vc * TS + vs * 16 + 8) = pack8(vv + 8);
        }
#undef CH_P0
#undef ROWP
}

template <bool GLA>
__device__ __forceinline__ void scan3_mfma(f32x16 (&ST)[GLA ? 2 : 4], bf16_t* Qh, bf16_t* Kh, bf16_t* Kt, bf16_t* Vt, float* eb, bf16_t* vraw, bf16_t* OS,
                                           int tid, int wave, int r32, int hh, int pd, int seg, int c, int dir) {
    constexpr int DK = GLA ? 64 : 128, NT = DK / 32, QS = DK + 8, TS = 40, NSEG = GLA ? 4 : 2, TPS = 32 / NSEG;
#define CH_P0(c) (dir ? ((c) < 8 ? (7 - (c)) * 32 : CTXL + (263 - (c)) * 32) : (c) * 32)
#define ROWP(p0_, i_) ((p0_) + (dir ? 31 - (i_) : (i_)))
        f32x16 st, stb;
#pragma unroll
        for (int r = 0; r < 16; ++r) { st[r] = 0.f; stb[r] = 0.f; }
        {
            bf16x8 ka[DK / 16], qb[DK / 16];
#pragma unroll
            for (int ks = 0; ks < DK / 16; ++ks) { ka[ks] = *(const bf16x8*)(Kh + r32 * QS + ks * 16 + hh * 8); qb[ks] = *(const bf16x8*)(Qh + r32 * QS + ks * 16 + hh * 8); }
            asm volatile("s_waitcnt lgkmcnt(0)" ::: "memory");
#pragma unroll
            for (int ks = 0; ks < DK / 16; ks += 2) {
                st = __builtin_amdgcn_mfma_f32_32x32x16_bf16(ka[ks], qb[ks], st, 0, 0, 0);
                stb = __builtin_amdgcn_mfma_f32_32x32x16_bf16(ka[ks + 1], qb[ks + 1], stb, 0, 0, 0);
            }
        }
        uint2 vp[2][2], qp[NT][2][2];
#pragma unroll
        for (int sI = 0; sI < 2; ++sI) { const bf16_t* av = Vt + (wave * 32 + r32) * TS + sI * 16 + 4 * hh; vp[sI][0] = *(const uint2*)av; vp[sI][1] = *(const uint2*)(av + 8); }
#pragma unroll
        for (int T = 0; T < NT; ++T)
#pragma unroll
            for (int sI = 0; sI < 2; ++sI) { const bf16_t* bq = Qh + r32 * QS + T * 32 + sI * 16 + 4 * hh; qp[T][sI][0] = *(const uint2*)bq; qp[T][sI][1] = *(const uint2*)(bq + 8); }
#pragma unroll
        for (int r = 0; r < 16; ++r) st[r] += stb[r];
        bf16x8 pfr[2];
#pragma unroll
        for (int sI = 0; sI < 2; ++sI) {
            union { bf16x8 v; unsigned u[4]; } cv;
#pragma unroll
            for (int q = 0; q < 4; ++q) {
                const int ra = 8 * sI + 2 * q, rb = ra + 1;
                const int ja = (ra & 3) + 8 * (ra >> 2) + 4 * hh, jb = (rb & 3) + 8 * (rb >> 2) + 4 * hh;
                cv.u[q] = cvt_pk(ja <= r32 ? st[ra] : 0.f, jb <= r32 ? st[rb] : 0.f);
            }
            pfr[sI] = cv.v;
        }
        asm volatile("s_waitcnt lgkmcnt(0)" ::: "memory");
        f32x16 oT, oTb;
#pragma unroll
        for (int r = 0; r < 16; ++r) { oT[r] = 0.f; oTb[r] = 0.f; }
#pragma unroll
        for (int sI = 0; sI < 2; ++sI) {
            union { bf16x8 v; uint2 h[2]; } cv;
            cv.h[0] = vp[sI][0]; cv.h[1] = vp[sI][1];
            oT = __builtin_amdgcn_mfma_f32_32x32x16_bf16(cv.v, pfr[sI], oT, 0, 0, 0);
        }
#pragma unroll
        for (int T = 0; T < NT; ++T)
#pragma unroll
            for (int sI = 0; sI < 2; ++sI) {
                union { bf16x8 v; unsigned u[4]; } ca;
#pragma unroll
                for (int q = 0; q < 4; ++q) ca.u[q] = cvt_pk(ST[T][8 * sI + 2 * q], ST[T][8 * sI + 2 * q + 1]);
                union { bf16x8 v; uint2 h[2]; } cb;
                cb.h[0] = qp[T][sI][0]; cb.h[1] = qp[T][sI][1];
                if (T & 1) oTb = __builtin_amdgcn_mfma_f32_32x32x16_bf16(ca.v, cb.v, oTb, 0, 0, 0);
                else oT = __builtin_amdgcn_mfma_f32_32x32x16_bf16(ca.v, cb.v, oT, 0, 0, 0);
            }
        {
            bf16x8 kt2[NT][2], vb2[2];
            float4 e4v[NT][4];
#pragma unroll
            for (int ks = 0; ks < 2; ++ks) vb2[ks] = *(const bf16x8*)(Vt + (wave * 32 + r32) * TS + ks * 16 + hh * 8);
#pragma unroll
            for (int T = 0; T < NT; ++T) {
#pragma unroll
                for (int ks = 0; ks < 2; ++ks) kt2[T][ks] = *(const bf16x8*)(Kt + (T * 32 + r32) * TS + ks * 16 + hh * 8);
#pragma unroll
                for (int g = 0; g < 4; ++g) e4v[T][g] = *(const float4*)(eb + T * 32 + 8 * g + 4 * hh);
            }
            asm volatile("s_waitcnt lgkmcnt(0)" ::: "memory");
#pragma unroll
            for (int T = 0; T < NT; ++T) {
#pragma unroll
                for (int g = 0; g < 4; ++g) { ST[T][4 * g + 0] *= e4v[T][g].x; ST[T][4 * g + 1] *= e4v[T][g].y; ST[T][4 * g + 2] *= e4v[T][g].z; ST[T][4 * g + 3] *= e4v[T][g].w; }
#pragma unroll
                for (int ks = 0; ks < 2; ++ks) ST[T] = __builtin_amdgcn_mfma_f32_32x32x16_bf16(kt2[T][ks], vb2[ks], ST[T], 0, 0, 0);
            }
        }
#pragma unroll
        for (int r = 0; r < 16; ++r) oT[r] += oTb[r];
        {
            const int p = ROWP(CH_P0(c), r32);
            bf16_t* op = OS + (size_t)p * 512 + 4 * hh;
#pragma unroll
            for (int g = 0; g < 4; ++g) { uint2 o; o.x = cvt_pk(oT[4 * g], oT[4 * g + 1]); o.y = cvt_pk(oT[4 * g + 2], oT[4 * g + 3]); *(uint2*)(op + 8 * g) = o; }
        }
#undef CH_P0
#undef ROWP
}

template <bool GLA>
__device__ void scan3_item(const Params& P, int l, int item, unsigned char* smem) {
    constexpr int DK = GLA ? 64 : 128, NT = DK / 32, QS = DK + 8, TS = 40, NSEG = GLA ? 4 : 2, TPS = 32 / NSEG, QCH = DK / 8;
    const int tid = tid_opaque(), lane = tid & 63, wave = tid >> 6, r32 = lane & 31, hh = lane >> 5;
    const int dir = item & 1, head = (item >> 1) & 3, bl = item >> 3;
    __builtin_amdgcn_s_setprio(3);
    bf16_t* Qh0 = (bf16_t*)smem;
    bf16_t* Kh0 = Qh0 + 32 * QS;
    bf16_t* Qh1 = Kh0 + 32 * QS;
    bf16_t* Kh1 = Qh1 + 32 * QS;
    bf16_t* Kt = Kh1 + 32 * QS;
    bf16_t* Vt = Kt + DK * TS;
    float* eb0 = (float*)(Vt + 128 * TS);
    float* eb1 = eb0 + DK;
    bf16_t* vraw = (bf16_t*)(eb1 + DK);
    const bf16_t* PB = (const bf16_t*)(P.ws + OFF_PB) + (size_t)bl * TB * PW;
    bf16_t* OS = (bf16_t*)(P.ws + (GLA ? OFF_OSG : OFF_KV)) + ((size_t)dir * NTH + (size_t)bl * TB) * 512 + head * 128 + wave * 32;
    const bf16_t* qsrc; const bf16_t* ksrc; int qld, kld;
    if (GLA) {
        if (dir == 0) { qsrc = PB + C_GQ + head * 64; qld = PW; ksrc = PB + C_GK + head * 64; kld = PW; }
        else { const bf16_t* X = (const bf16_t*)(P.ws + OFF_XG) + (size_t)bl * TB * 512; qsrc = X + head * 64; qld = 512; ksrc = X + 256 + head * 64; kld = 512; }
    } else {
        if (dir == 0) { qsrc = PB + C_HQ + head * 128; qld = PW; ksrc = PB + C_HF + head * 128; kld = PW; }
        else { qsrc = (const bf16_t*)(P.ws + OFF_XH) + (size_t)bl * TB * 512 + head * 128; qld = 512; ksrc = PB + C_HF + 512 + head * 128; kld = PW; }
    }
    const float* ebsrc = (const float*)(P.ws + (GLA ? OFF_EBG : OFF_EBH)) + ((size_t)(bl * 264) * 2 + dir) * (4 * DK) + head * DK;
    const int vcol = (GLA ? C_GV : C_HI) + head * 128;
    const int pd = tid & (DK - 1), seg = tid / DK;
    uint4 pq0A, pq1A, pk0A, pk1A, pv0A, pv1A, pq0B, pq1B, pk0B, pk1B, pv0B, pv1B; float peA = 0.f, peB = 0.f;
    pq1A = pk1A = pq1B = pk1B = make_uint4(0, 0, 0, 0);
#define CH_P0(c) (dir ? ((c) < 8 ? (7 - (c)) * 32 : CTXL + (263 - (c)) * 32) : (c) * 32)
#define ROWP(p0_, i_) ((p0_) + (dir ? 31 - (i_) : (i_)))
#define SC_GLOAD(c, S) { const int p0_ = CH_P0(c); \
        { const int id = tid, i = id / QCH, ch = id % QCH; const size_t rr_ = (size_t)ROWP(p0_, i); pq0##S = *(const uint4*)(qsrc + rr_ * qld + ch * 8); pk0##S = *(const uint4*)(ksrc + rr_ * kld + ch * 8); } \
        if (!GLA) { const int id = tid + 256, i = id / QCH, ch = id % QCH; const size_t rr_ = (size_t)ROWP(p0_, i); pq1##S = *(const uint4*)(qsrc + rr_ * qld + ch * 8); pk1##S = *(const uint4*)(ksrc + rr_ * kld + ch * 8); } \
        { const int i = tid >> 4, ch = tid & 15; pv0##S = *(const uint4*)(PB + (size_t)ROWP(p0_, i) * PW + vcol + ch * 8); pv1##S = *(const uint4*)(PB + (size_t)ROWP(p0_, i + 16) * PW + vcol + ch * 8); } \
        if (tid < DK) pe##S = ebsrc[(size_t)(p0_ >> 5) * 2 * (4 * DK) + tid]; }
    f32x16 ST[NT];
#pragma unroll
    for (int T = 0; T < NT; ++T)
#pragma unroll
        for (int r = 0; r < 16; ++r) ST[T][r] = 0.f;
#define SC_COPY(S, QH, KH, EB) { \
        { const int id = tid, i = id / QCH, ch = id % QCH; *(uint4*)(QH + i * QS + ch * 8) = pq0##S; *(uint4*)(KH + i * QS + ch * 8) = pk0##S; } \
        if (!GLA) { const int id = tid + 256, i = id / QCH, ch = id % QCH; *(uint4*)(QH + i * QS + ch * 8) = pq1##S; *(uint4*)(KH + i * QS + ch * 8) = pk1##S; } \
        { const int i = tid >> 4, ch = tid & 15; *(uint4*)(vraw + i * 128 + ch * 8) = pv0##S; *(uint4*)(vraw + (i + 16) * 128 + ch * 8) = pv1##S; } \
        if (tid < DK) EB[tid] = pe##S; }
    SC_GLOAD(0, A);
    SC_GLOAD(1, B);
    SC_COPY(A, Qh0, Kh0, eb0);
    SC_GLOAD(2, A);
    for (int c = 0; c < 264; c += 2) {
        __syncthreads();
        scan3_build<GLA>(ST, Qh0, Kh0, Kt, Vt, eb0, vraw, OS, tid, wave, r32, hh, pd, seg, c, dir);
        __syncthreads();
        SC_COPY(B, Qh1, Kh1, eb1);
        { const int cl_ = c + 3 < 264 ? c + 3 : 263; SC_GLOAD(cl_, B); asm volatile("" ::: "memory"); }
        scan3_mfma<GLA>(ST, Qh0, Kh0, Kt, Vt, eb0, vraw, OS, tid, wave, r32, hh, pd, seg, c, dir);
        __syncthreads();
        scan3_build<GLA>(ST, Qh1, Kh1, Kt, Vt, eb1, vraw, OS, tid, wave, r32, hh, pd, seg, c + 1, dir);
        __syncthreads();
        SC_COPY(A, Qh0, Kh0, eb0);
        { const int cl_ = c + 4 < 264 ? c + 4 : 263; SC_GLOAD(cl_, A); asm volatile("" ::: "memory"); }
        scan3_mfma<GLA>(ST, Qh1, Kh1, Kt, Vt, eb1, vraw, OS, tid, wave, r32, hh, pd, seg, c + 1, dir);
    }
#undef SC_COPY
#undef CH_P0
#undef ROWP
#undef SC_GLOAD
    __builtin_amdgcn_s_setprio(0);
}

#ifdef ONLYI
#define IT_ON(n) (ONLYI == (n))
#else
#define IT_ON(n) true
#endif
__device__ void phase_mixers(const Params& P, int ph, int l, unsigned char* smem, int mode = 0) {
    constexpr int N_HG = 16, N_GLA = 16, N_ATT = 2 * 8 * 66;
    const int bx = blockIdx.x;
    int my_scan = -1;
    if (mode != 2 && bx < 256 && (bx & 7) == ((bx >> 3) & 7)) my_scan = bx >> 3;
    if (mode == 0 && bx >= 256 && ((bx - 256) & 7) == (((bx - 256) >> 3) & 7)) return;
    for (;;) {
        int it;
        if (my_scan >= 0) { it = my_scan; my_scan = -1; }
        else {
            if (mode == 1) break;
            it = next_item(P, ph) + N_HG + N_GLA;
        }
        if (it >= N_HG + N_GLA + 2 * N_ATT) break;
        if (it < N_HG) { if (IT_ON(0)) scan3_item<false>(P, l, it, smem); continue; }
        it -= N_HG;
        if (it < N_GLA) { if (IT_ON(1)) scan3_item<true>(P, l, it, smem); continue; }
        it -= N_GLA;
        if (it < N_ATT) { const int bl = it / 528, rem = it % 528; if (IT_ON(2)) attn_item<96, false>(P, l, bl, rem / 66, rem % 66, smem); continue; }
        it -= N_ATT;
        { const int bl = it / 528, rem = it % 528; if (IT_ON(3)) attn_item<64, true>(P, l, bl, rem / 66, rem % 66, smem); }
    }
}

__device__ void phase_scanfin(const Params& P, int ph, int l) {
    const int tid = tid_opaque(), lane = tid & 63, wave = tid >> 6;
    bf16_t* PB = (bf16_t*)(P.ws + OFF_PB);
    const bf16_t* OSH = (const bf16_t*)(P.ws + OFF_KV);
    const bf16_t* OSGp = (const bf16_t*)(P.ws + OFF_OSG);
    float gh[8], gg[8];
#pragma unroll
    for (int e = 0; e < 8; ++e) { gh[e] = P.hg_g_o[l * 128 + (lane & 15) * 8 + e]; gg[e] = P.gla_g_o[l * 128 + (lane & 15) * 8 + e]; }
    for (;;) {
        const int u = next_item(P, ph);
        if (u >= NTH / 16) break;
        uint4 ra[8], rb[8], rz[8];
#pragma unroll
        for (int k = 0; k < 8; ++k) {
            const int t = u * 16 + wave * 4 + (k >> 1), mx = k & 1;
            const bf16_t* OS = mx ? OSGp : OSH;
            ra[k] = *(const uint4*)(OS + (size_t)t * 512 + lane * 8);
            rb[k] = *(const uint4*)(OS + ((size_t)NTH + t) * 512 + lane * 8);
            rz[k] = *(const uint4*)(PB + (size_t)t * PW + C_Z + (2 + mx) * 512 + lane * 8);
        }
#pragma unroll
        for (int k = 0; k < 8; ++k) {
            const int t = u * 16 + wave * 4 + (k >> 1), mx = k & 1;
            float a[8], b[8], z[8];
            unpack8(ra[k], a); unpack8(rb[k], b); unpack8(rz[k], z);
            float ss = 0.f;
#pragma unroll
            for (int e = 0; e < 8; ++e) { a[e] += b[e]; ss += a[e] * a[e]; }
            ss += __shfl_xor(ss, 1); ss += __shfl_xor(ss, 2); ss += __shfl_xor(ss, 4); ss += __shfl_xor(ss, 8);
            const float rn = rsqrtf(ss * (1.f / 128.f) + EPS);
#pragma unroll
            for (int e = 0; e < 8; ++e) a[e] = a[e] * rn * (mx ? gg[e] : gh[e]) * siluf_(z[e]);
            *(uint4*)(PB + (size_t)t * PW + C_Z + (2 + mx) * 512 + lane * 8) = pack8(a);
        }
    }
}

__device__ void phase_merge(const Params& P, int ph, int l, unsigned char* smem) {
    const int tid_ = tid_opaque(), lane = tid_ & 63, wave = tid_ >> 6, wr = wave >> 1, wc = wave & 1;
    const bf16_t* H = (const bf16_t*)(P.ws + OFF_H);
    const bf16_t* PB = (const bf16_t*)(P.ws + OFF_PB);
    bf16_t* ACC = (bf16_t*)(P.ws + OFF_KV);
    for (;;) {
        const int u = next_item(P, ph);
        if (u >= 132 * 16) break;
        const int mt = u >> 4, nt = u & 15;
        const int col = nt * 64 + wc * 32 + (lane & 31);
        f32x16 tot[2];
#pragma unroll
        for (int r = 0; r < 16; ++r) { tot[0][r] = 0.f; tot[1][r] = 0.f; }
        for (int br = 0; br < 4; ++br) {
            unsigned gate[2][8];
            f32x16 g[2], pa[2];
#pragma unroll
            for (int r = 0; r < 16; ++r) { g[0][r] = 0.f; g[1][r] = 0.f; pa[0][r] = 0.f; pa[1][r] = 0.f; }
            gemm_pair_n64(g, pa, H + (size_t)mt * 128 * D, D, (const bf16_t*)(P.ws + OFF_WM) + ((size_t)(l * 4 + br) * 1024 + nt * 64) * 1024, 1024, 1024,
                          PB + (size_t)mt * 128 * PW + C_Z + br * 512, PW, (const bf16_t*)(P.ws + OFF_WBR) + ((size_t)(l * 4 + br) * 1024 + nt * 64) * 512, 512, 512, smem);
            {
                const float bm = P.b_merge[(l * 4 + br) * 1024 + col];
#pragma unroll
                for (int mi = 0; mi < 2; ++mi)
#pragma unroll
                    for (int r = 0; r < 8; ++r) gate[mi][r] = cvt_pk(__builtin_amdgcn_rcpf(1.f + __expf(-(g[mi][2 * r] + bm))), __builtin_amdgcn_rcpf(1.f + __expf(-(g[mi][2 * r + 1] + bm))));
            }
#pragma unroll
            for (int mi = 0; mi < 2; ++mi)
#pragma unroll
                for (int r = 0; r < 8; ++r) {
                    tot[mi][2 * r] = fmaf(lo16(gate[mi][r]), pa[mi][2 * r], tot[mi][2 * r]);
                    tot[mi][2 * r + 1] = fmaf(hi16(gate[mi][r]), pa[mi][2 * r + 1], tot[mi][2 * r + 1]);
                }
        }
#pragma unroll
        for (int mi = 0; mi < 2; ++mi)
#pragma unroll
            for (int r = 0; r < 16; ++r) ACC[(size_t)(mt * 128 + ACC_ROW(mi, r)) * 1024 + col] = f2bf(tot[mi][r]);
    }
}

__device__ void phase_out(const Params& P, int ph, int l, int hf, unsigned char* smem) {
    const int tid_ = tid_opaque(), lane = tid_ & 63, wave = tid_ >> 6, wr = wave >> 1, wc = wave & 1;
    const bf16_t* ACC = (const bf16_t*)(P.ws + OFF_KV);
    const float* mod = (const float*)(P.ws + OFF_MOD);
    for (;;) {
        const int u = next_item(P, ph);
        if (u >= 132 * 8) break;
        const int mt = u >> 3, nt = u & 7;
        const int t0 = mt * 128, bl = t0 / TB, p0 = t0 % TB, b = hf * 2 + bl;
        const bool isctx = p0 < CTXL;
        if (isctx && l == 1) continue;
        f32x16 acc[2][2]; zero_acc(acc);
        gemm_tile_pf2(acc, ACC + (size_t)mt * 128 * 1024, 1024, (const bf16_t*)(P.ws + OFF_WO) + ((size_t)l * 1024 + nt * 128) * 1024, 1024, 1024, smem);
        const float* gt = mod + (l * 5 + (isctx ? 4 : b)) * 3072 + 2048 + nt * 128;
        const float* src; float* dst;
        if (isctx) { src = P.ctx + ((size_t)b * CTXL + p0) * D; dst = (float*)(P.ws + OFF_CX1) + ((size_t)b * CTXL + p0) * D; }
        else { const size_t o = ((size_t)b * SEQ + (p0 - CTXL)) * D; src = (l == 0 ? P.x : (const float*)P.out) + o; dst = P.out + o; }
        float rv[2][2][16];
#pragma unroll
        for (int mi = 0; mi < 2; ++mi)
#pragma unroll
            for (int ni = 0; ni < 2; ++ni)
#pragma unroll
                for (int r = 0; r < 16; ++r) rv[mi][ni][r] = src[(size_t)ACC_ROW(mi, r) * D + nt * 128 + ACC_COL(ni)];
#pragma unroll
        for (int mi = 0; mi < 2; ++mi)
#pragma unroll
            for (int ni = 0; ni < 2; ++ni) {
                const int cl = ACC_COL(ni);
                const float g = gt[cl];
#pragma unroll
                for (int r = 0; r < 16; ++r) { const size_t o = (size_t)ACC_ROW(mi, r) * D + nt * 128 + cl; dst[o] = rv[mi][ni][r] + g * acc[mi][ni][r]; }
            }
    }
}

__global__ void __launch_bounds__(256, 2) mega(Params PK) {
    extern __shared__ __attribute__((aligned(16))) unsigned char smem[];
    if (blockIdx.x == 0 && threadIdx.x == 0) {
        Params* T = (Params*)(PK.ws + OFF_TAB);
        T->x = PK.x; T->c = PK.c; T->ctx = PK.ctx; T->c_ctx = PK.c_ctx; T->ada_w = PK.ada_w; T->ada_b = PK.ada_b; T->norm_g = PK.norm_g; T->w_in = PK.w_in;
        T->w_uq = PK.w_uq; T->w_ukv = PK.w_ukv; T->g_cq = PK.g_cq; T->g_ckv = PK.g_ckv; T->g_q = PK.g_q; T->g_k = PK.g_k; T->rpb = PK.rpb; T->ng_q = PK.ng_q; T->ng_k = PK.ng_k;
        T->lb_logits = PK.lb_logits; T->hg_g_o = PK.hg_g_o; T->gla_w2 = PK.gla_w2; T->gla_b2 = PK.gla_b2; T->gla_g_o = PK.gla_g_o; T->w_br = PK.w_br; T->w_merge = PK.w_merge;
        T->b_merge = PK.b_merge; T->w_out = PK.w_out; T->out = PK.out; T->ws = PK.ws; T->ph_lo = PK.ph_lo; T->ph_hi = PK.ph_hi;
    }
    unsigned char* wsb = PK.ws;
    const int ph_lo = PK.ph_lo, ph_hi = PK.ph_hi;
#ifdef PROBE_SUB
    __shared__ long long s_tacc, s_tprev; if (threadIdx.x == 0) { s_tacc = 0; s_tprev = 0; }
#endif
    for (int ph = ph_lo; ph < ph_hi; ++ph) {
#ifndef SPLIT_MIX
        if (ph > 8 && ((ph - 1) & 7) == 0) continue;
#endif
        if (ph > ph_lo) cg::this_grid().sync();
        const Params& P = PK;
#ifdef PROBE_SUB
        if (threadIdx.x == 0) { const long long t_now = wall_clock64();
#ifdef SPLIT_MIX
            const int prev_sub = (ph == 0) ? -1 : (ph == 1 ? 9 : ((ph - 2) % 9));
#else
            const int prev_sub = (ph == 0) ? -1 : (ph == 1 ? 8 : ((ph - 2) & 7));
#endif
            if (prev_sub == PROBE_SUB) s_tacc += t_now - s_tprev; s_tprev = t_now; }
#endif
#ifdef ONLYP
#define PH_ON(n) ((ONLYP >> (n)) & 1)
#else
#define PH_ON(n) true
#endif
        if (ph == 0) { if (PH_ON(8)) phase_prologue(PK, ph, smem); continue; }
#ifdef SPLIT_MIX
        const int q = ph - 1, pass = q / 9, sub9 = q % 9, l = pass >> 1, hf = pass & 1;
        if (sub9 == 4 || sub9 == 5) { phase_mixers(P, ph, l, smem, sub9 - 3); continue; }
        const int sub = sub9 < 4 ? sub9 : sub9 - 1;
        switch (sub) {
            case 0: phase_norm(P, ph, l, hf); break;
            case 1: phase_gemm1(P, ph, l, smem); break;
            case 2: phase_gemm2(P, ph, l, smem); break;
            case 3: phase_finalize(P, ph, l, smem); break;
            case 5: phase_scanfin(P, ph, l); break;
            case 6: phase_merge(P, ph, l, smem); break;
            default: phase_out(P, ph, l, hf, smem); break;
        }
#else
        const int q = ph - 1, pass = q >> 3, sub = q & 7, l = pass >> 1, hf = pass & 1;
        switch (sub) {
            case 0: if (PH_ON(0)) phase_norm(P, ph, l, hf); break;
            case 1: if (PH_ON(1)) phase_gemm1(P, ph, l, smem); break;
            case 2: if (PH_ON(2)) phase_gemm2(P, ph, l, smem); break;
            case 3: if (PH_ON(3)) phase_finalize(P, ph, l, smem); break;
            case 4: if (PH_ON(4)) phase_mixers(P, ph, l, smem); break;
            case 5: if (PH_ON(5)) phase_scanfin(P, ph, l); break;
            case 6: if (PH_ON(6)) phase_merge(P, ph, l, smem); break;
            default: if (PH_ON(7)) { phase_out(P, ph, l, hf, smem); if (pass < 3) phase_norm(P, ph + 40, (pass + 1) >> 1, (pass + 1) & 1); } break;
        }
#endif
    }
#ifdef PROBE_SUB
    cg::this_grid().sync();
    if (threadIdx.x == 0) { const long long t_now = wall_clock64(); if (7 == PROBE_SUB) s_tacc += t_now - s_tprev;
      if (blockIdx.x == 0) { const long long t_acc = s_tacc; const long long t0 = wall_clock64(); while (wall_clock64() - t0 < t_acc) { __builtin_amdgcn_s_sleep(10); } } }
#endif
}

extern "C" void kernel_launch(void* const* d_in, const int* in_sizes, int n_in, void* d_out, int out_size, void* d_ws, size_t ws_size, hipStream_t stream) {
    static int grid = 0;
    if (grid == 0) {
        if (ws_size < WS_END) { fprintf(stderr, "workspace too small: %zu < %zu\n", ws_size, (size_t)WS_END); grid = -1; return; }
        int dev = 0, cus = 0, per_cu = 0;
        hipGetDevice(&dev);
        hipDeviceGetAttribute(&cus, hipDeviceAttributeMultiprocessorCount, dev);
        hipFuncSetAttribute((const void*)mega, hipFuncAttributeMaxDynamicSharedMemorySize, LDS_BYTES);
        hipOccupancyMaxActiveBlocksPerMultiprocessor(&per_cu, (const void*)mega, 256, LDS_BYTES);
        if (per_cu < 1) per_cu = 1;
        if (per_cu > 2) per_cu = 2;
        grid = cus * per_cu;
        (void)hipGetLastError();
    }
    if (grid < 0) return;
    hipMemsetAsync((unsigned char*)d_ws + OFF_CTL, 0, 4096, stream);
    Params p{};
    const float** pp = (const float**)&p;
    for (int i = 0; i < 26; ++i) pp[i] = (const float*)d_in[i];
    p.out = (float*)d_out; p.ws = (unsigned char*)d_ws;
#if SINGLE_LAUNCH
    p.ph_lo = 0; p.ph_hi = NPHASE;
    void* args[] = {&p};
    hipError_t e = hipLaunchCooperativeKernel((const void*)mega, dim3(grid), dim3(256), args, LDS_BYTES, stream);
    if (e != hipSuccess) fprintf(stderr, "cooperative launch failed: %s (grid %d)\n", hipGetErrorString(e), grid);
#else
    for (int ph = 0; ph < NPHASE; ++ph) {
        p.ph_lo = ph; p.ph_hi = ph + 1;
        hipLaunchKernelGGL(mega, dim3(grid), dim3(256), LDS_BYTES, stream, p);
    }
#endif
}
```
